# Optimizing an MI355X kernel written in HIP

```python
import math
import jax, jax.numpy as jnp
from jax import lax
import numpy as np

D_MODEL = 2048
BATCH = 4
SEQ = 4096
DEPTH = 2

D_FOURIER = D_MODEL // 2
FOURIER_GROUPS = 8
FOURIER_GROUP_DIM = D_FOURIER // FOURIER_GROUPS
V_HEAD_DIM = 128
D_ATTN = D_MODEL // 2
N_HEADS = D_ATTN // V_HEAD_DIM
QK_NOPE_DIM = 128
QK_ROPE_DIM = 64
QK_HEAD_DIM = QK_NOPE_DIM + QK_ROPE_DIM
Q_LORA_RANK = D_MODEL // 4
KV_LORA_RANK = D_MODEL // 8
D_MIX = D_FOURIER + D_ATTN
IN_SPLITS = (D_FOURIER, D_FOURIER, Q_LORA_RANK, KV_LORA_RANK, QK_ROPE_DIM, D_ATTN)
D_IN = sum(IN_SPLITS)
ROPE_THETA = 10000.0
Q_BLOCK = 128
NORM_EPS = 1e-6
DEEPNORM_ALPHA = (2 * DEPTH) ** 0.25
DEEPNORM_BETA = (8 * DEPTH) ** -0.25

kernel_name = "hybrid_fnet_mla_deepnorm_adaln"


def _layernorm(x, g=None, b=None):
    xf = x.astype(jnp.float32)
    mu = jnp.mean(xf, axis=-1, keepdims=True)
    var = jnp.mean(jnp.square(xf - mu), axis=-1, keepdims=True)
    y = (xf - mu) * lax.rsqrt(var + NORM_EPS)
    if g is not None:
        y = y * g.astype(jnp.float32) + b.astype(jnp.float32)
    return y.astype(x.dtype)


def _rmsnorm(x, g):
    xf = x.astype(jnp.float32)
    y = xf * lax.rsqrt(jnp.mean(jnp.square(xf), axis=-1, keepdims=True) + NORM_EPS)
    return (y * g.astype(jnp.float32)).astype(x.dtype)


def _rope_tables(positions, dtype):
    inv_freq = ROPE_THETA ** (-jnp.arange(0, QK_ROPE_DIM, 2, dtype=jnp.float32) / QK_ROPE_DIM)
    ang = positions.astype(jnp.float32)[..., None] * inv_freq
    return jnp.cos(ang).astype(dtype), jnp.sin(ang).astype(dtype)


def _apply_rope(x, cos, sin):
    x1, x2 = jnp.split(x, 2, axis=-1)
    return jnp.concatenate([x1 * cos - x2 * sin, x2 * cos + x1 * sin], axis=-1)


def _fourier_mix(u, w_fmix):
    B, S, _ = u.shape
    ug = u.reshape(B, S, FOURIER_GROUPS, FOURIER_GROUP_DIM).astype(jnp.float32)
    f = jnp.real(jnp.fft.fftn(ug, axes=(1, 3), norm="ortho")).astype(u.dtype)
    y = jnp.einsum("bsgc,gcd->bsgd", f, w_fmix)
    return y.reshape(B, S, D_FOURIER)


def _mla_attention(q_nope, q_rope, k_nope, k_rope, v):
    B, S, H, _ = q_nope.shape
    nb = S // Q_BLOCK
    scale = 1.0 / math.sqrt(QK_HEAD_DIM)
    qn = q_nope.reshape(B, nb, Q_BLOCK, H, QK_NOPE_DIM).transpose(1, 0, 2, 3, 4)
    qr = q_rope.reshape(B, nb, Q_BLOCK, H, QK_ROPE_DIM).transpose(1, 0, 2, 3, 4)

    def block(args):
        qn_b, qr_b = args
        s = (jnp.einsum("bqhd,bkhd->bhqk", qn_b, k_nope)
             + jnp.einsum("bqhr,bkr->bhqk", qr_b, k_rope)).astype(jnp.float32) * scale
        p = jax.nn.softmax(s, axis=-1).astype(v.dtype)
        return jnp.einsum("bhqk,bkhd->bqhd", p, v)

    o = lax.map(block, (qn, qr))
    return o.transpose(1, 0, 2, 3, 4).reshape(B, S, H * V_HEAD_DIM)


def setup_inputs(seed: int = 0) -> dict:
    key = jax.random.key(seed)
    ks = jax.random.split(key, 16)
    f32 = jnp.float32
    x = jax.random.normal(ks[0], (BATCH, SEQ, D_MODEL), f32)
    c = jax.random.normal(ks[1], (BATCH, D_MODEL), f32)
    offs = jax.random.randint(ks[2], (BATCH, 1), 0, SEQ, dtype=jnp.int32)
    positions = (jnp.arange(SEQ, dtype=jnp.int32)[None, :] + offs).astype(jnp.int32)
    w_ada = jax.random.normal(ks[3], (DEPTH, D_MODEL, 3 * D_MODEL), f32) * D_MODEL ** -0.5
    b_ada = 0.02 * jax.random.normal(ks[4], (DEPTH, 3 * D_MODEL), f32)
    w_in = jax.random.normal(ks[5], (DEPTH, D_MODEL, D_IN), f32) * D_MODEL ** -0.5
    q_norm = 1.0 + 0.02 * jax.random.normal(ks[6], (DEPTH, Q_LORA_RANK), f32)
    w_q_b = jax.random.normal(ks[7], (DEPTH, Q_LORA_RANK, N_HEADS * QK_HEAD_DIM), f32) * Q_LORA_RANK ** -0.5
    kv_norm = 1.0 + 0.02 * jax.random.normal(ks[8], (DEPTH, KV_LORA_RANK), f32)
    w_kv_b = jax.random.normal(ks[9], (DEPTH, KV_LORA_RANK, N_HEADS * (QK_NOPE_DIM + V_HEAD_DIM)), f32) * KV_LORA_RANK ** -0.5
    w_fmix = jax.random.normal(ks[10], (DEPTH, FOURIER_GROUPS, FOURIER_GROUP_DIM, FOURIER_GROUP_DIM), f32) * FOURIER_GROUP_DIM ** -0.5
    w_out = jax.random.normal(ks[11], (DEPTH, D_MIX, D_MODEL), f32) * (D_MIX ** -0.5 * DEEPNORM_BETA)
    ln_g = 1.0 + 0.02 * jax.random.normal(ks[12], (DEPTH, D_MODEL), f32)
    ln_b = 0.02 * jax.random.normal(ks[13], (DEPTH, D_MODEL), f32)
    return {"x": x, "c": c, "positions": positions, "w_ada": w_ada, "b_ada": b_ada,
            "w_in": w_in, "q_norm": q_norm, "w_q_b": w_q_b, "kv_norm": kv_norm,
            "w_kv_b": w_kv_b, "w_fmix": w_fmix, "w_out": w_out, "ln_g": ln_g, "ln_b": ln_b}


def reference(x, c, positions, w_ada, b_ada, w_in, q_norm, w_q_b, kv_norm, w_kv_b,
              w_fmix, w_out, ln_g, ln_b):
    B, S, D = x.shape
    cos, sin = _rope_tables(positions, x.dtype)
    cos_q, sin_q = cos[:, :, None, :], sin[:, :, None, :]
    c_act = jax.nn.silu(c)
    split_pts = list(np.cumsum(IN_SPLITS)[:-1])
    for l in range(DEPTH):
        mod = c_act @ w_ada[l] + b_ada[l]
        shift, scale, gate = jnp.split(mod, 3, axis=-1)
        h = _layernorm(x) * (1.0 + scale[:, None, :]) + shift[:, None, :]
        p = h @ w_in[l]
        u_f, z_f, cq, ckv, k_r, z_a = jnp.split(p, split_pts, axis=-1)
        y_f = _fourier_mix(u_f, w_fmix[l]) * jax.nn.silu(z_f)
        q = (_rmsnorm(cq, q_norm[l]) @ w_q_b[l]).reshape(B, S, N_HEADS, QK_HEAD_DIM)
        q_nope, q_rope = q[..., :QK_NOPE_DIM], _apply_rope(q[..., QK_NOPE_DIM:], cos_q, sin_q)
        kv = (_rmsnorm(ckv, kv_norm[l]) @ w_kv_b[l]).reshape(B, S, N_HEADS, QK_NOPE_DIM + V_HEAD_DIM)
        k_nope, v = kv[..., :QK_NOPE_DIM], kv[..., QK_NOPE_DIM:]
        k_rope = _apply_rope(k_r, cos, sin)
        y_a = _mla_attention(q_nope, q_rope, k_nope, k_rope, v) * jax.nn.silu(z_a)
        y = jnp.concatenate([y_f, y_a], axis=-1) @ w_out[l]
        x = _layernorm(DEEPNORM_ALPHA * x + gate[:, None, :] * y, ln_g[l], ln_b[l])
    return x
```

```cpp
#define IMPL_GEMM 0
#define IMPL_ATTN 0
#define IMPL_FFT 0
#define N_LAUNCH_MODE 0
#include <hip/hip_runtime.h>
#include <cstdio>
#include <cstdint>

#ifndef N_LAUNCH_MODE
#define N_LAUNCH_MODE 1
#endif
#ifndef IMPL_GEMM
#define IMPL_GEMM 1
#endif
#ifndef IMPL_ATTN
#define IMPL_ATTN 1
#endif
#ifndef IMPL_FFT
#define IMPL_FFT 1
#endif

#define LAS __attribute__((address_space(3)))
typedef unsigned short bf16_t;
typedef short bf16x8 __attribute__((ext_vector_type(8)));
typedef short s16x4 __attribute__((ext_vector_type(4)));
typedef float f32x4 __attribute__((ext_vector_type(4)));
typedef float f32x2 __attribute__((ext_vector_type(2)));
typedef float f32x16 __attribute__((ext_vector_type(16)));
typedef unsigned u32x4 __attribute__((ext_vector_type(4)));
typedef unsigned u32x2 __attribute__((ext_vector_type(2)));

constexpr int NB = 4, SEQ = 4096, DM = 2048, MTOK = NB * SEQ, DEPTH = 2;
constexpr int DF = 1024, NG = 8, GD = 128, NH = 8, DV = 128, DNOPE = 128, DROPE = 64, DQK = 192, QLR = 512, KVLR = 256;
constexpr int NIN = 3904, NINP = 4096;
constexpr int NQ = NH * DQK  , NKV = NH * (DNOPE + DV)  ;
constexpr float NORM_EPS = 1e-6f;
constexpr float DN_ALPHA = 1.4142135623730951f;
constexpr float ATT_SCALE = 0.07216878364870322f;

__device__ __forceinline__ float bf2f(bf16_t b) { return __uint_as_float(((unsigned)b) << 16); }
__device__ __forceinline__ bf16_t f2bf(float f) { unsigned u = __float_as_uint(f); u += 0x7FFFu + ((u >> 16) & 1u); return (bf16_t)(u >> 16); }
__device__ __forceinline__ unsigned cvt_pk_bf16(float lo, float hi) { unsigned r; asm volatile("v_cvt_pk_bf16_f32 %0, %1, %2" : "=v"(r) : "v"(lo), "v"(hi)); return r; }
__device__ __forceinline__ float silu_f(float z) { return z * __builtin_amdgcn_rcpf(1.0f + __builtin_amdgcn_exp2f(-1.4426950408889634f * z)); }
__device__ __forceinline__ float wave_sum(float v) { for (int o = 32; o > 0; o >>= 1) v += __shfl_xor(v, o); return v; }
__device__ __forceinline__ float wave_max(float v) { for (int o = 32; o > 0; o >>= 1) v = fmaxf(v, __shfl_xor(v, o)); return v; }

constexpr size_t al256(size_t x) { return (x + 255) / 256 * 256; }
constexpr size_t WS_CTL  = 0;
constexpr size_t CTL_BYTES = 16384;
constexpr size_t WS_MOD  = WS_CTL + CTL_BYTES;
constexpr size_t WS_RSQ  = WS_MOD + al256((size_t)DEPTH * NB * 3 * DM * 4);
constexpr size_t WS_RCOS = WS_RSQ + al256((size_t)DEPTH * MTOK * 2 * 4);
constexpr size_t WS_RSIN = WS_RCOS + (size_t)MTOK * 32 * 4;
constexpr size_t WS_D1   = WS_RSIN + (size_t)MTOK * 32 * 4;
constexpr size_t WS_D2   = WS_D1 + 128 * 64 * 2;
constexpr size_t WS_WCAT = WS_D2 + 128 * 128 * 2;
constexpr size_t WS_WIN  = WS_WCAT + (size_t)DEPTH * NG * 128 * 256 * 2;
constexpr size_t WS_WOUT = WS_WIN + (size_t)DEPTH * NINP * DM * 2;
constexpr size_t WS_WQ   = WS_WOUT + (size_t)DEPTH * DM * DM * 2;
constexpr size_t WS_WKV  = WS_WQ + (size_t)DEPTH * NQ * QLR * 2;
constexpr size_t WS_H    = WS_WKV + (size_t)DEPTH * NKV * KVLR * 2;
constexpr size_t WS_U    = WS_H + (size_t)MTOK * DM * 2;
constexpr size_t WS_MIX  = WS_U + (size_t)MTOK * DF * 2;
constexpr size_t WS_CQ   = WS_MIX + (size_t)MTOK * DM * 2;
constexpr size_t WS_CKV  = WS_CQ + (size_t)MTOK * QLR * 2;
constexpr size_t WS_KR   = WS_CKV + (size_t)MTOK * KVLR * 2;
constexpr size_t WS_Q    = WS_KR + (size_t)MTOK * 64 * 2;
constexpr size_t WS_KV   = WS_Q + (size_t)MTOK * NQ * 2;
constexpr size_t WS_R    = WS_KV + (size_t)MTOK * NKV * 2;
constexpr size_t WS_END  = WS_R + (size_t)MTOK * DM * 4;
static_assert(WS_END <= (size_t)4 * MTOK * DM * 4, "workspace map exceeds 4 x largest tensor");

constexpr int RING_BYTES = 131072, MISC_OFF = RING_BYTES, LDS_BYTES = RING_BYTES + 256;
constexpr int NTHREADS = 512;

namespace pg8 {
#define PG8_LAS __attribute__((address_space(3)))
constexpr int BM = 256, BK = 64, HALF = 128, HTB = HALF * BK * 2  , STAGE_BYTES = 8 * HTB, NXCD = 8, WGM = 8;
static_assert(STAGE_BYTES <= RING_BYTES, "GEMM stage ring must fit the LDS phase scratch");

__host__ __device__ __forceinline__ int lds_byte(int r, int c) { const int st = (r >> 4) * 2 + (c >> 5), rr = r & 15, cc = c & 31, ob = rr * 64 + cc * 2; return st * 1024 + (ob ^ (((ob >> 9) & 1) << 5)); }
__host__ __device__ __forceinline__ void stage_rc(int b, int& R, int& C) { const int st = b / 1024, sb = b % 1024, swz = sb ^ (((sb >> 9) & 1) << 5); R = (st >> 1) * 16 + swz / 64; C = (st & 1) * 32 + (swz % 64) / 2; }
__host__ __device__ __forceinline__ int perm32(int rho) { const int n = rho >> 4, i = rho & 15; return 8 * (i >> 2) + 4 * n + (i & 3); }

struct Unit { int pm, pn; };
struct Gemm { const bf16_t* A; const bf16_t* Bt; int M, N, K; };

struct StaticOrder {
    int nM, nN, nwg, G, c;
    __host__ __device__ void init(int M, int N, int G_, int c_) { nM = M / BM; nN = N / BM; nwg = nM * nN; G = G_; c = c_; }
    __host__ __device__ bool next(int i, Unit& u) const {
        const long L = (long)i * G + c; if (L >= nwg) return false;
        int wgid = (int)L; { const int q = nwg / NXCD, r = nwg % NXCD, xcd = wgid % NXCD, off = wgid / NXCD; wgid = (xcd < r ? xcd * (q + 1) : r * (q + 1) + (xcd - r) * q) + off; }
        const int nig = WGM * nN, gid = wgid / nig, fm = gid * WGM, gsz = (nM - fm) < WGM ? (nM - fm) : WGM;
        u.pm = fm + ((wgid % nig) % gsz); u.pn = (wgid % nig) / gsz; return true;
    }
    __device__ __forceinline__ void a_ready(const Unit&) const {}
    __device__ __forceinline__ void done(const Unit&) const {}
};
struct SplitOrder {
    int G, c, nN, kind;
    __device__ void init(int G_, int c_, int nN_, int kind_) { G = G_; c = c_; nN = nN_; kind = kind_; }
    __device__ bool next(int i, Unit& u) const {
        if (G != 256) { const int L = i * G + c; if (L >= 64 * nN) return false; u.pm = L / nN; u.pn = L % nN; return true; }
        const int x = c & 7, v = c >> 3; int li;
        if (kind == 0) { if (v < 16) { if (i >= 2) return false; li = 2 * v + i; } else { if (i >= 1) return false; li = 32 + (v - 16); } }
        else           { if (v < 16) { if (i >= 1) return false; li = v; } else { if (i >= 3) return false; li = 16 + 3 * (v - 16) + i; } }
        u.pm = 8 * x + li / nN; u.pn = li % nN; return true;
    }
    __device__ __forceinline__ void a_ready(const Unit&) const {}
    __device__ __forceinline__ void done(const Unit&) const {}
};
template <class Epi, class Sched, bool ALIGN_EPI = false, bool SP2 = false>
__device__ __forceinline__ void gemm_phase(PG8_LAS unsigned char* lds, const Gemm g, const Sched& S, const Epi& E, const int tid) {
    const int wid = __builtin_amdgcn_readfirstlane(tid >> 6), lane = tid & 63, wr = wid >> 2, wc = wid & 3, fr = lane & 15, fq = lane >> 4;
    const int K = g.K, nt = K / BK;
    unsigned voffA[2], voffB[2];
#pragma unroll
    for (int i = 0; i < 2; ++i) { int R, C; stage_rc(tid * 16 + i * 8192, R, C); const int Rb = Epi::PERM ? ((R & ~31) + perm32(R & 31)) : R;
        voffA[i] = (unsigned)(R * K + C) * 2u; voffB[i] = (unsigned)(Rb * K + C) * 2u; }
    const size_t kstep = (size_t)(BK * 2);
    const size_t hstep = (size_t)HALF * K * 2;
    const size_t tstep = 2 * hstep;
    const unsigned ldsw = (unsigned)wid * 1024u;
    const int aoff = lds_byte(wr * 64 + fr, fq * 8), boff = lds_byte(wc * 32 + fr, fq * 8);
#define PG8_SA(b, h) (((b) * 2 + (h)) * HTB)
#define PG8_SB(b, h) ((4 + (b) * 2 + (h)) * HTB)
#define PG8_STAGE(bufoff, gbase, voff) do { _Pragma("unroll") for (int _i = 0; _i < 2; ++_i) \
        __builtin_amdgcn_global_load_lds((const unsigned*)((const char*)(gbase) + (voff)[_i]), (PG8_LAS unsigned*)(lds + (bufoff) + ldsw + _i * 8192), 16, 0, 0); } while (0)
#define PG8_LDA(dst, b, h) do { _Pragma("unroll") for (int m = 0; m < 4; ++m) _Pragma("unroll") for (int k = 0; k < 2; ++k) dst[m][k] = *(const PG8_LAS bf16x8*)(lds + PG8_SA(b, h) + aoff + m * 2048 + k * 1024); } while (0)
#define PG8_LDB(dst, b, h) do { _Pragma("unroll") for (int n = 0; n < 2; ++n) _Pragma("unroll") for (int k = 0; k < 2; ++k) dst[n][k] = *(const PG8_LAS bf16x8*)(lds + PG8_SB(b, h) + boff + n * 2048 + k * 1024); } while (0)
#define PG8_MMA(ai, bj, At, Bt) do { __builtin_amdgcn_s_setprio(1); _Pragma("unroll") for (int m = 0; m < 4; ++m) _Pragma("unroll") for (int n = 0; n < 2; ++n) _Pragma("unroll") for (int k = 0; k < 2; ++k) \
        acc[ai][bj][m][n] = __builtin_amdgcn_mfma_f32_16x16x32_bf16(Bt[n][k], At[m][k], acc[ai][bj][m][n], 0, 0, 0); __builtin_amdgcn_s_setprio(0); } while (0)
#define PG8_WAIT_V(n) asm volatile("s_waitcnt vmcnt(" #n ")" ::: "memory")
#define PG8_WAIT_L(n) asm volatile("s_waitcnt lgkmcnt(" #n ")" ::: "memory")
#define PG8_BAR __builtin_amdgcn_s_barrier()
#define PG8_SCHED __builtin_amdgcn_sched_barrier(0)
    Unit cur, nxt; int ui = 0;
    if (!S.next(0, cur)) return;
    f32x4 acc[2][2][4][2];
#pragma unroll
    for (int a = 0; a < 2; ++a)
#pragma unroll
        for (int b = 0; b < 2; ++b)
#pragma unroll
            for (int m = 0; m < 4; ++m)
#pragma unroll
                for (int n = 0; n < 2; ++n) acc[a][b][m][n] = (f32x4){0.f, 0.f, 0.f, 0.f};
    bf16x8 At[4][2], B0[2][2], B1[2][2];
    const char* cA = (const char*)g.A + (size_t)cur.pm * tstep; const char* cB = (const char*)g.Bt + (size_t)cur.pn * tstep;
    S.a_ready(cur);
    if constexpr (SP2) {
        PG8_STAGE(PG8_SB(0, 0), cB, voffB); PG8_STAGE(PG8_SB(0, 1), cB + hstep, voffB); PG8_STAGE(PG8_SA(0, 0), cA, voffA); PG8_STAGE(PG8_SA(0, 1), cA + hstep, voffA);
        if (wr == 1) PG8_BAR;
        PG8_WAIT_V(2); PG8_BAR;
        PG8_STAGE(PG8_SB(1, 0), cB + kstep, voffB); PG8_STAGE(PG8_SA(1, 0), cA + kstep, voffA); PG8_STAGE(PG8_SB(1, 1), cB + hstep + kstep, voffB);
        PG8_WAIT_V(6); PG8_BAR;
    } else {
        PG8_STAGE(PG8_SB(0, 0), cB, voffB); PG8_STAGE(PG8_SA(0, 0), cA, voffA); PG8_STAGE(PG8_SB(0, 1), cB + hstep, voffB); PG8_STAGE(PG8_SA(0, 1), cA + hstep, voffA);
        if (wr == 1) PG8_BAR;
        PG8_WAIT_V(4); PG8_BAR;
        PG8_STAGE(PG8_SB(1, 0), cB + kstep, voffB); PG8_STAGE(PG8_SA(1, 0), cA + kstep, voffA); PG8_STAGE(PG8_SB(1, 1), cB + hstep + kstep, voffB);
        PG8_WAIT_V(6); PG8_BAR;
    }
    for (;;) {
        const bool has_next = S.next(ui + 1, nxt);
        const char* nA = has_next ? (const char*)g.A + (size_t)nxt.pm * tstep : cA; const char* nB = has_next ? (const char*)g.Bt + (size_t)nxt.pn * tstep : cB;
        for (int t = 0; t < nt; t += 2) {
            const bool last = (t == nt - 2);
            const char* a1 = cA + (size_t)(t + 1) * kstep;
            const char* a2 = last ? nA : cA + (size_t)(t + 2) * kstep; const char* b2 = last ? nB : cB + (size_t)(t + 2) * kstep;
            const char* a3 = a2 + kstep; const char* b3 = b2 + kstep;
            if (last && has_next) S.a_ready(nxt);
            if constexpr (SP2) {
            PG8_LDB(B0, 0, 0); PG8_LDB(B1, 0, 1); PG8_SCHED; PG8_LDA(At, 0, 0); PG8_STAGE(PG8_SA(1, 1), a1 + hstep, voffA);
            PG8_WAIT_V(8); PG8_WAIT_L(0); PG8_BAR; PG8_MMA(0, 0, At, B0); PG8_MMA(0, 1, At, B1); PG8_BAR; PG8_SCHED;
            PG8_LDA(At, 0, 1); PG8_STAGE(PG8_SB(0, 0), b2, voffB); PG8_STAGE(PG8_SB(0, 1), b2 + hstep, voffB); PG8_STAGE(PG8_SA(0, 0), a2, voffA);
            PG8_WAIT_V(8); PG8_WAIT_L(0); PG8_BAR; PG8_MMA(1, 0, At, B0); PG8_MMA(1, 1, At, B1); PG8_BAR; PG8_SCHED;
            PG8_LDB(B0, 1, 0); PG8_LDB(B1, 1, 1); PG8_SCHED; PG8_LDA(At, 1, 0); PG8_STAGE(PG8_SA(0, 1), a2 + hstep, voffA);
            PG8_WAIT_V(8); PG8_WAIT_L(0); PG8_BAR; PG8_MMA(0, 0, At, B0); PG8_MMA(0, 1, At, B1); PG8_BAR; PG8_SCHED;
            PG8_LDA(At, 1, 1); PG8_STAGE(PG8_SB(1, 0), b3, voffB); PG8_STAGE(PG8_SB(1, 1), b3 + hstep, voffB); PG8_STAGE(PG8_SA(1, 0), a3, voffA);
            PG8_WAIT_V(8); PG8_WAIT_L(0); PG8_BAR; PG8_MMA(1, 0, At, B0); PG8_MMA(1, 1, At, B1); PG8_BAR; PG8_SCHED;
            } else {
            PG8_LDB(B0, 0, 0); PG8_SCHED; PG8_LDA(At, 0, 0); PG8_STAGE(PG8_SA(1, 1), a1 + hstep, voffA);
            PG8_WAIT_L(8); PG8_BAR; PG8_WAIT_L(0); PG8_MMA(0, 0, At, B0); PG8_BAR; PG8_SCHED;
            PG8_LDB(B1, 0, 1); PG8_STAGE(PG8_SB(0, 0), b2, voffB);
            PG8_BAR; PG8_WAIT_L(0); PG8_MMA(0, 1, At, B1); PG8_BAR;
            PG8_LDA(At, 0, 1); PG8_STAGE(PG8_SA(0, 0), a2, voffA);
            PG8_BAR; PG8_WAIT_L(0); PG8_MMA(1, 0, At, B0); PG8_BAR; PG8_SCHED;
            PG8_STAGE(PG8_SB(0, 1), b2 + hstep, voffB);
            PG8_WAIT_V(6); PG8_BAR; PG8_MMA(1, 1, At, B1); PG8_BAR;
            PG8_LDB(B0, 1, 0); PG8_SCHED; PG8_LDA(At, 1, 0); PG8_STAGE(PG8_SA(0, 1), a2 + hstep, voffA);
            PG8_WAIT_L(8); PG8_BAR; PG8_WAIT_L(0); PG8_MMA(0, 0, At, B0); PG8_BAR; PG8_SCHED;
            PG8_LDB(B1, 1, 1); PG8_STAGE(PG8_SB(1, 0), b3, voffB);
            PG8_BAR; PG8_WAIT_L(0); PG8_MMA(0, 1, At, B1); PG8_BAR;
            PG8_LDA(At, 1, 1); PG8_STAGE(PG8_SA(1, 0), a3, voffA);
            PG8_BAR; PG8_WAIT_L(0); PG8_MMA(1, 0, At, B0); PG8_BAR; PG8_SCHED;
            PG8_STAGE(PG8_SB(1, 1), b3 + hstep, voffB);
            PG8_WAIT_V(6); PG8_BAR; PG8_MMA(1, 1, At, B1); PG8_BAR;
            }
        }
        if constexpr (ALIGN_EPI) { if (wr == 0) PG8_BAR; }
        if constexpr (!Epi::AFTER_DRAIN) { E(acc, cur, wr, wc, fr, fq); S.done(cur); }
        if (!has_next) break;
#pragma unroll
        for (int a = 0; a < 2; ++a)
#pragma unroll
            for (int b = 0; b < 2; ++b)
#pragma unroll
                for (int m = 0; m < 4; ++m)
#pragma unroll
                    for (int n = 0; n < 2; ++n) acc[a][b][m][n] = (f32x4){0.f, 0.f, 0.f, 0.f};
        cur = nxt; cA = nA; cB = nB; ++ui;
        if constexpr (ALIGN_EPI) { if (wr == 1) PG8_BAR; }
    }
    PG8_WAIT_V(0);
    if constexpr (!ALIGN_EPI) { if (wr == 0) PG8_BAR; }
    PG8_BAR;
    if constexpr (Epi::AFTER_DRAIN) { E.fused(acc, cur, wr, wc, fr, fq, lds, wid, lane); S.done(cur); }
#undef PG8_SA
#undef PG8_SB
#undef PG8_STAGE
#undef PG8_LDA
#undef PG8_LDB
#undef PG8_MMA
#undef PG8_WAIT_V
#undef PG8_WAIT_L
#undef PG8_BAR
#undef PG8_SCHED
}

template <class Epi, class Sched>
__device__ __forceinline__ void gemm_phase_naive(const Gemm g, const Sched& S, const Epi& E, const int tid) {
    const int wid = __builtin_amdgcn_readfirstlane(tid >> 6), lane = tid & 63, wr = wid >> 2, wc = wid & 3, fr = lane & 15, fq = lane >> 4;
    const int K = g.K;
    Unit cur;
    for (int ui = 0; S.next(ui, cur); ++ui) {
        f32x4 acc[2][2][4][2];
#pragma unroll
        for (int ai = 0; ai < 2; ++ai)
#pragma unroll
            for (int m = 0; m < 4; ++m) {
                const bf16_t* arow = g.A + (size_t)(cur.pm * BM + ai * HALF + wr * 64 + m * 16 + fr) * K;
#pragma unroll
                for (int bj = 0; bj < 2; ++bj)
#pragma unroll
                    for (int n = 0; n < 2; ++n) {
                        const int col = cur.pn * BM + bj * HALF + wc * 32 + (Epi::PERM ? (8 * fq + 4 * n) : (16 * n + 4 * fq));
                        const bf16_t* brow = g.Bt + (size_t)col * K;
                        float s0 = 0.f, s1 = 0.f, s2 = 0.f, s3 = 0.f;
#pragma unroll 1
                        for (int k = 0; k < K; k += 8) {
                            const bf16x8 av = *(const bf16x8*)(arow + k);
                            const bf16x8 b0 = *(const bf16x8*)(brow + k), b1 = *(const bf16x8*)(brow + K + k), b2 = *(const bf16x8*)(brow + 2 * K + k), b3 = *(const bf16x8*)(brow + 3 * K + k);
#pragma unroll
                            for (int e = 0; e < 8; ++e) { const float a = bf2f((bf16_t)av[e]);
                                s0 += a * bf2f((bf16_t)b0[e]); s1 += a * bf2f((bf16_t)b1[e]); s2 += a * bf2f((bf16_t)b2[e]); s3 += a * bf2f((bf16_t)b3[e]); }
                        }
                        acc[ai][bj][m][n] = (f32x4){s0, s1, s2, s3};
                    }
            }
        E(acc, cur, wr, wc, fr, fq);
    }
}
}
#ifndef PG8_SP2
#define PG8_SP2 true
#endif
#ifndef PG8_ALIGN
#define PG8_ALIGN true
#endif
typedef f32x4 AccT[2][2][4][2];

__device__ __forceinline__ void store8_bf16(bf16_t* p, f32x4 v0, f32x4 v1) {
    u32x4 w; w.x = cvt_pk_bf16(v0[0], v0[1]); w.y = cvt_pk_bf16(v0[2], v0[3]); w.z = cvt_pk_bf16(v1[0], v1[1]); w.w = cvt_pk_bf16(v1[2], v1[3]); *(u32x4*)p = w;
}
__device__ __forceinline__ void store4_bf16(bf16_t* p, f32x4 v) { u32x2 w; w.x = cvt_pk_bf16(v[0], v[1]); w.y = cvt_pk_bf16(v[2], v[3]); *(u32x2*)p = w; }
__device__ __forceinline__ f32x4 silu4(f32x4 v) { return (f32x4){silu_f(v[0]), silu_f(v[1]), silu_f(v[2]), silu_f(v[3])}; }
__device__ __forceinline__ float sq4(f32x4 v) { return (v[0] * v[0] + v[1] * v[1]) + (v[2] * v[2] + v[3] * v[3]); }

struct EpiIn {
    static constexpr bool PERM = true, AFTER_DRAIN = false;
    bf16_t* U; bf16_t* MIX; bf16_t* CQ; bf16_t* CKV; bf16_t* KR; float* rsq; const float* rcos; const float* rsin;
    template <int ACT> __device__ __forceinline__ void plain(const AccT& acc, bf16_t* base, int ldc, int row0, int col0) const {
#pragma unroll
        for (int ai = 0; ai < 2; ++ai)
#pragma unroll
            for (int m = 0; m < 4; ++m) { bf16_t* rowp = base + (size_t)(row0 + ai * 128 + m * 16) * ldc + col0;
#pragma unroll
                for (int bj = 0; bj < 2; ++bj) { f32x4 v0 = acc[ai][bj][m][0], v1 = acc[ai][bj][m][1]; if (ACT) { v0 = silu4(v0); v1 = silu4(v1); } store8_bf16(rowp + bj * 128, v0, v1); } }
    }
    __device__ __forceinline__ void sumsq(const AccT& acc, int row0, int which, int fq) const {
#pragma unroll
        for (int ai = 0; ai < 2; ++ai)
#pragma unroll
            for (int m = 0; m < 4; ++m) { float s = (sq4(acc[ai][0][m][0]) + sq4(acc[ai][0][m][1])) + (sq4(acc[ai][1][m][0]) + sq4(acc[ai][1][m][1]));
                s += __shfl_xor(s, 16); s += __shfl_xor(s, 32);
                if (fq == 0) atomicAdd(rsq + (size_t)(row0 + ai * 128 + m * 16) * 2 + which, s); }
    }
    __device__ __forceinline__ void operator()(const AccT& acc, const pg8::Unit& u, int wr, int wc, int fr, int fq) const {
        const int row0 = u.pm * 256 + wr * 64 + fr, pn = u.pn, cw = wc * 32 + 8 * fq;
        if (pn < 4) plain<0>(acc, U, DF, row0, pn * 256 + cw);
        else if (pn < 8) plain<1>(acc, MIX, DM, row0, (pn - 4) * 256 + cw);
        else if (pn < 10) { plain<0>(acc, CQ, QLR, row0, (pn - 8) * 256 + cw); sumsq(acc, row0, 0, fq); }
        else if (pn == 10) { plain<0>(acc, CKV, KVLR, row0, cw); sumsq(acc, row0, 1, fq); }
        else if (pn == 11) {
            if (wc < 2) { const int i0 = 16 * wc + 4 * fq;
#pragma unroll
                for (int ai = 0; ai < 2; ++ai)
#pragma unroll
                    for (int m = 0; m < 4; ++m) { const size_t row = (size_t)(row0 + ai * 128 + m * 16);
                        const f32x4 c = *(const f32x4*)(rcos + row * 32 + i0), s = *(const f32x4*)(rsin + row * 32 + i0), x1 = acc[ai][0][m][0], x2 = acc[ai][0][m][1];
                        store4_bf16(KR + row * 64 + i0, x1 * c - x2 * s); store4_bf16(KR + row * 64 + 32 + i0, x2 * c + x1 * s); } }
        }
        else plain<1>(acc, MIX, DM, row0, DF + (pn - 12) * 256 + cw);
    }
};
struct EpiQ {
    static constexpr bool PERM = true, AFTER_DRAIN = false;
    bf16_t* Q; const float* rsq; const float* rcos; const float* rsin;
    __device__ __forceinline__ void operator()(const AccT& acc, const pg8::Unit& u, int wr, int wc, int fr, int fq) const {
        const int row0 = u.pm * 256 + wr * 64 + fr;
#pragma unroll
        for (int ai = 0; ai < 2; ++ai)
#pragma unroll
            for (int m = 0; m < 4; ++m) { const size_t row = (size_t)(row0 + ai * 128 + m * 16);
                const float rs = rsqrtf(rsq[row * 2 + 0] * (1.0f / QLR) + NORM_EPS);
#pragma unroll
                for (int bj = 0; bj < 2; ++bj) { const int G = u.pn * 8 + bj * 4 + wc, head = G / 6, g6 = G - head * 6;
                    const f32x4 v0 = acc[ai][bj][m][0] * rs, v1 = acc[ai][bj][m][1] * rs;
                    if (g6 < 4) store8_bf16(Q + row * NQ + head * DQK + g6 * 32 + 8 * fq, v0, v1);
                    else { const int i0 = 16 * (g6 - 4) + 4 * fq; const f32x4 c = *(const f32x4*)(rcos + row * 32 + i0), s = *(const f32x4*)(rsin + row * 32 + i0);
                        store4_bf16(Q + row * NQ + head * DQK + 128 + i0, v0 * c - v1 * s); store4_bf16(Q + row * NQ + head * DQK + 160 + i0, v1 * c + v0 * s); } } }
    }
};
struct EpiKV {
    static constexpr bool PERM = true, AFTER_DRAIN = false;
    bf16_t* KV; const float* rsq;
    __device__ __forceinline__ void operator()(const AccT& acc, const pg8::Unit& u, int wr, int wc, int fr, int fq) const {
        const int row0 = u.pm * 256 + wr * 64 + fr, col0 = u.pn * 256 + wc * 32 + 8 * fq;
#pragma unroll
        for (int ai = 0; ai < 2; ++ai)
#pragma unroll
            for (int m = 0; m < 4; ++m) { const size_t row = (size_t)(row0 + ai * 128 + m * 16);
                const float rs = rsqrtf(rsq[row * 2 + 1] * (1.0f / KVLR) + NORM_EPS);
#pragma unroll
                for (int bj = 0; bj < 2; ++bj) store8_bf16(KV + row * NKV + col0 + bj * 128, acc[ai][bj][m][0] * rs, acc[ai][bj][m][1] * rs); }
    }
};
struct EpiOut {
    static constexpr bool PERM = false, AFTER_DRAIN = false;
    const float* xres; float* R; const float* gate;
    __device__ __forceinline__ void operator()(const AccT& acc, const pg8::Unit& u, int wr, int wc, int fr, int fq) const {
        const int row0 = u.pm * 256 + wr * 64 + fr, col0 = u.pn * 256 + wc * 32 + 4 * fq;
        const float* gp = gate + (size_t)(u.pm >> 4) * (3 * DM) + col0;
        f32x4 gv[2][2];
#pragma unroll
        for (int bj = 0; bj < 2; ++bj)
#pragma unroll
            for (int n = 0; n < 2; ++n) gv[bj][n] = *(const f32x4*)(gp + bj * 128 + n * 16);
#pragma unroll
        for (int ai = 0; ai < 2; ++ai)
#pragma unroll
            for (int m = 0; m < 4; ++m) { const size_t off = (size_t)(row0 + ai * 128 + m * 16) * DM + col0;
#pragma unroll
                for (int bj = 0; bj < 2; ++bj)
#pragma unroll
                    for (int n = 0; n < 2; ++n) { const f32x4 xs = *(const f32x4*)(xres + off + bj * 128 + n * 16);
                        *(f32x4*)(R + off + bj * 128 + n * 16) = xs * DN_ALPHA + gv[bj][n] * acc[ai][bj][m][n]; }
                asm volatile("" ::: "memory"); }
    }
};
#define XB_TMO      128
#define XB_XCNT(j)  (256  + 64 * (j))
#define XB_XSUB(j)  (1280 + 64 * (j))
#define XB_XGEN(j)  (2304 + 64 * (j))
#define XB_TOP      3328
#define XB_TOPGEN   3392
#define XCD_BAR_WORDS 3456
#define XB_SPIN_CAP (1u << 22)
static_assert(XCD_BAR_WORDS * 4 <= CTL_BYTES, "barrier words must fit the control region");
__device__ __forceinline__ unsigned xb_ld(unsigned* p)              { return __hip_atomic_load(p, __ATOMIC_RELAXED, __HIP_MEMORY_SCOPE_AGENT); }
__device__ __forceinline__ unsigned xb_add(unsigned* p, unsigned v) { return __hip_atomic_fetch_add(p, v, __ATOMIC_RELAXED, __HIP_MEMORY_SCOPE_AGENT); }
__device__ __forceinline__ unsigned xb_xcc_id() { return (unsigned)__builtin_amdgcn_s_getreg((3 << 11) | 20) & 0xFu; }
#define XB_SPIN(cond, bar) do { unsigned _sp = 0; while (cond) { __builtin_amdgcn_s_sleep(1); \
    if ((++_sp & 255u) == 0u) { if (xb_ld(&(bar)[XB_TMO])) break; if (_sp > XB_SPIN_CAP) { atomicAdd(&(bar)[XB_TMO], 1u); break; } } } } while (0)
struct XcdBarrier { unsigned* bar; unsigned x; volatile LAS unsigned* st; };
__device__ __forceinline__ XcdBarrier xcd_barrier_post(unsigned* bar, volatile LAS unsigned* st) {
    XcdBarrier b; b.bar = bar; b.x = xb_xcc_id(); b.st = st;
    if (threadIdx.x == 0) (void)xb_add(&bar[XB_XCNT(b.x)], 1u);
    return b;
}
__device__ __forceinline__ void xcd_barrier_complete(unsigned* bar, unsigned x, unsigned& nloc, unsigned& nx) {
    const unsigned G = gridDim.x * gridDim.y * gridDim.z;
    unsigned sum, cnt, mine, sp = 0u;
    for (;;) {
        sum = 0u; cnt = 0u; mine = 0u;
#pragma unroll
        for (unsigned j = 0; j < 16; ++j) { const unsigned c = xb_ld(&bar[XB_XCNT(j)]); sum += c; cnt += (c > 0u) ? 1u : 0u; mine = (j == x) ? c : mine; }
        if (sum == G) break;
        __builtin_amdgcn_s_sleep(1);
        if ((++sp & 255u) == 0u) { if (xb_ld(&bar[XB_TMO])) break; if (sp > XB_SPIN_CAP) { atomicAdd(&bar[XB_TMO], 1u); break; } }
    }
    nloc = mine > 0u ? mine : 1u; nx = cnt > 0u ? cnt : 1u;
}
__device__ __forceinline__ void xcd_barrier(const XcdBarrier& b) {
    asm volatile("s_waitcnt vmcnt(0)" ::: "memory");
    __syncthreads();
    if (threadIdx.x == 0) {
        unsigned* bar = b.bar;
        __builtin_amdgcn_s_waitcnt(0);
        unsigned nloc = b.st[0], nx = b.st[1];
        if (nloc == 0u) { xcd_barrier_complete(bar, b.x, nloc, nx); b.st[0] = nloc; b.st[1] = nx; }
        const unsigned old = xb_add(&bar[XB_XSUB(b.x)], 1u);
        const unsigned gen = old / nloc;
        if (old + 1u == (gen + 1u) * nloc) {
            __builtin_amdgcn_fence(__ATOMIC_RELEASE, "agent");
            asm volatile("s_waitcnt vmcnt(0)" ::: "memory");
            const unsigned og = xb_add(&bar[XB_TOP], 1u);
            const unsigned tg = og / nx;
            if (og + 1u == (tg + 1u) * nx) xb_add(&bar[XB_TOPGEN], 1u);
            else XB_SPIN(xb_ld(&bar[XB_TOPGEN]) == tg, bar);
            __builtin_amdgcn_fence(__ATOMIC_ACQUIRE, "agent");
            xb_add(&bar[XB_XGEN(b.x)], 1u);
            asm volatile("s_waitcnt vmcnt(0)" ::: "memory");
        } else {
            XB_SPIN(xb_ld(&bar[XB_XGEN(b.x)]) == gen, bar);
            __builtin_amdgcn_fence(__ATOMIC_ACQUIRE, "agent");
            asm volatile("s_waitcnt vmcnt(0)" ::: "memory");
        }
    }
    __syncthreads();
}
struct Frame {
    const float* in[14]; float* out; unsigned char* ws;
    LAS unsigned char* lds; char* ldsg;
    int tid, lane, wave, G, bx, vcu;
};
#define WSP(T, off) ((T*)(F.ws + (off)))

__device__ __forceinline__ int src_in(int n) {
    if (n < 2816) return n;
    if (n < 3072) { const int c = n - 2816, bj = c >> 7, wc = (c >> 5) & 3, c32 = c & 31; if (bj || wc >= 2) return -1;
        const int fq = c32 >> 3, nn = (c32 >> 2) & 1, j = c32 & 3; return 2816 + 32 * nn + 16 * wc + 4 * fq + j; }
    return n - 192;
}
__device__ __forceinline__ int src_q(int n) {
    const int G = n >> 5, c32 = n & 31, head = G / 6, g6 = G - head * 6;
    if (g6 < 4) return head * DQK + g6 * 32 + c32;
    const int fq = c32 >> 3, nn = (c32 >> 2) & 1, j = c32 & 3; return head * DQK + 128 + 32 * nn + 16 * (g6 - 4) + 4 * fq + j;
}
__device__ __forceinline__ void p0_weights(const Frame& F) {
    constexpr int TIN = 1024, TOUT = 512, TQ = 96, TKV = 64, TL = TIN + TOUT + TQ + TKV;
    LAS unsigned* T = (LAS unsigned*)F.lds;
    const int tid = F.tid, n_l = tid & 63, kp = tid >> 6;
    for (int it = F.bx; it < DEPTH * TL; it += F.G) {
        const int l = it / TL; int r = it - l * TL, kind, nt, kt, Nsrc, K; const float* W; const float* ksc = nullptr; bf16_t* Bt;
        if (r < TIN) { kind = 0; nt = r >> 4; kt = r & 15; W = F.in[5] + (size_t)l * DM * NIN; Nsrc = NIN; K = DM; Bt = WSP(bf16_t, WS_WIN) + (size_t)l * NINP * DM; }
        else if (r < TIN + TOUT) { r -= TIN; kind = 1; nt = r >> 4; kt = r & 15; W = F.in[11] + (size_t)l * DM * DM; Nsrc = DM; K = DM; Bt = WSP(bf16_t, WS_WOUT) + (size_t)l * DM * DM; }
        else if (r < TIN + TOUT + TQ) { r -= TIN + TOUT; kind = 2; nt = r >> 2; kt = r & 3; W = F.in[7] + (size_t)l * QLR * NQ; Nsrc = NQ; K = QLR; ksc = F.in[6] + l * QLR; Bt = WSP(bf16_t, WS_WQ) + (size_t)l * NQ * QLR; }
        else { r -= TIN + TOUT + TQ; kind = 3; nt = r >> 1; kt = r & 1; W = F.in[9] + (size_t)l * KVLR * NKV; Nsrc = NKV; K = KVLR; ksc = F.in[8] + l * KVLR; Bt = WSP(bf16_t, WS_WKV) + (size_t)l * NKV * KVLR; }
        const int n0 = nt * 64, k0 = kt * 128, n = n0 + n_l;
        const int src = kind == 0 ? src_in(n) : (kind == 2 ? src_q(n) : n);
        float v0[8], v1[8];
#pragma unroll
        for (int i = 0; i < 8; ++i) { const int k = k0 + 2 * (kp + 8 * i);
            v0[i] = src >= 0 ? W[(size_t)k * Nsrc + src] : 0.f; v1[i] = src >= 0 ? W[(size_t)(k + 1) * Nsrc + src] : 0.f;
            if (ksc) { v0[i] *= ksc[k]; v1[i] *= ksc[k + 1]; } }
#pragma unroll
        for (int i = 0; i < 8; ++i) T[n_l * 66 + kp + 8 * i] = cvt_pk_bf16(v0[i], v1[i]);
        __syncthreads();
#pragma unroll
        for (int i = 0; i < 2; ++i) { const int c = tid + 512 * i, nn = c >> 4, kc = c & 15;
            const u32x2 a = *(const LAS u32x2*)(T + nn * 66 + kc * 4), b = *(const LAS u32x2*)(T + nn * 66 + kc * 4 + 2);
            *(u32x4*)(Bt + (size_t)(n0 + nn) * K + k0 + kc * 8) = (u32x4){a.x, a.y, b.x, b.y}; }
        __syncthreads();
    }
}
__device__ __forceinline__ void p0_mod(const Frame& F) {
    if (F.bx >= DEPTH * 96) return;
    LAS float* sc = (LAS float*)F.lds;
    LAS float* red = (LAS float*)(F.lds + 32768);
    const int tid = F.tid;
    for (int i = tid; i < NB * DM; i += NTHREADS) sc[i] = silu_f(F.in[1][i]);
    __syncthreads();
    float* mod = WSP(float, WS_MOD);
    for (int it = F.bx; it < DEPTH * 96; it += F.G) {
        const int l = it / 96, col0 = (it - l * 96) * 64, cg = tid & 15, kl = tid >> 4;
        f32x4 acc[4] = {};
        const float* wp = F.in[3] + (size_t)l * DM * (3 * DM) + col0 + cg * 4;
        for (int k = kl; k < DM; k += 32) { const f32x4 w = *(const f32x4*)(wp + (size_t)k * (3 * DM));
#pragma unroll
            for (int b = 0; b < 4; ++b) acc[b] += w * sc[b * DM + k]; }
#pragma unroll
        for (int b = 0; b < 4; ++b)
#pragma unroll
            for (int j = 0; j < 4; ++j) red[(kl * 16 + cg) * 16 + b * 4 + j] = acc[b][j];
        __syncthreads();
        if (tid < 256) { const int cg2 = tid >> 4, v = tid & 15, b = v >> 2, j = v & 3; float s = 0.f;
            for (int q = 0; q < 32; ++q) s += red[(q * 16 + cg2) * 16 + v];
            const int col = col0 + cg2 * 4 + j; mod[(size_t)(l * NB + b) * (3 * DM) + col] = s + F.in[4][l * (3 * DM) + col]; }
        __syncthreads();
    }
}
__device__ __forceinline__ void p0_tables(const Frame& F) {
    constexpr double INVF2PI[32] = {
    0.15915494309189535, 0.11934937021124886, 0.08949940160889101, 0.06711508300522726,
    0.050329212104487035, 0.03774158471741977, 0.0283021958306234, 0.02122365276477766,
    0.015915494309189534, 0.011934937021124886, 0.008949940160889102, 0.006711508300522725,
    0.005032921210448704, 0.003774158471741977, 0.00283021958306234, 0.0021223652764777662,
    0.0015915494309189536, 0.0011934937021124885, 0.0008949940160889102, 0.0006711508300522726,
    0.0005032921210448703, 0.00037741584717419774, 0.00028302195830623395, 0.0002122365276477766,
    0.00015915494309189535, 0.00011934937021124886, 8.949940160889102e-05, 6.711508300522725e-05,
    5.0329212104487035e-05, 3.774158471741978e-05, 2.8302195830623396e-05, 2.122365276477766e-05};
    const int gid = F.bx * NTHREADS + F.tid, NT = F.G * NTHREADS;
    const int* pos = (const int*)F.in[2]; float* rc = WSP(float, WS_RCOS); float* rs = WSP(float, WS_RSIN);
    for (int idx = gid; idx < MTOK * 32; idx += NT) { const int i = idx & 31; double t = (double)pos[idx >> 5] * INVF2PI[i]; t -= floor(t);
        float sn, cs; sincospif((float)(2.0 * t), &sn, &cs); rc[idx] = cs; rs[idx] = sn; }
    bf16_t* D1 = WSP(bf16_t, WS_D1); bf16_t* D2 = WSP(bf16_t, WS_D2);
    for (int idx = gid; idx < 128 * 64; idx += NT) { const int s1 = idx & 63, rr = idx >> 6, ri = rr >> 6, s1p = rr & 63; float sn, cs; sincospif((float)((s1 * s1p) & 63) * (1.0f / 32.0f), &sn, &cs);
        D1[idx] = f2bf((ri ? -sn : cs) * 0.125f); }
    for (int idx = gid; idx < 128 * 128; idx += NT) { const int kk = idx & 127, rr = idx >> 7, ri = kk >> 6, s2 = kk & 63, ro = rr >> 6, s2p = rr & 63; float sn, cs; sincospif((float)((s2 * s2p) & 63) * (1.0f / 32.0f), &sn, &cs);
        const float v = ro == 0 ? (ri == 0 ? cs : sn) : (ri == 0 ? -sn : cs); D2[idx] = f2bf(v * 0.125f); }
    float* rsq = WSP(float, WS_RSQ);
    for (int idx = gid; idx < DEPTH * MTOK * 2; idx += NT) rsq[idx] = 0.f;
    LAS float* ct = (LAS float*)F.lds; LAS float* st = ct + 128;
    if (F.tid < 128) { float sn, cs; sincospif((float)F.tid * (1.0f / 64.0f), &sn, &cs); ct[F.tid] = cs * 0.08838834764831845f; st[F.tid] = sn * 0.08838834764831845f; }
    __syncthreads();
    bf16_t* wcat = WSP(bf16_t, WS_WCAT);
    for (int idx = gid; idx < DEPTH * NG * 128 * 256; idx += NT) { const int k = idx & 255, d = (idx >> 8) & 127, lg = idx >> 15, ro = k >> 7, c = k & 127;
        const float* w = F.in[10] + (size_t)lg * 128 * 128 + d; LAS float* tb = ro ? st : ct; float s = 0.f;
        for (int cp = 0; cp < 128; ++cp) s += tb[(c * cp) & 127] * w[cp * 128];
        wcat[idx] = f2bf(s); }
    __syncthreads();
}
__device__ __forceinline__ void row_stats(const f32x4 (&v)[8], float& mean, float& rstd) {
    float s = 0.f;
#pragma unroll
    for (int i = 0; i < 8; ++i) s += (v[i][0] + v[i][1]) + (v[i][2] + v[i][3]);
    mean = wave_sum(s) * (1.0f / DM); float q = 0.f;
#pragma unroll
    for (int i = 0; i < 8; ++i) { const f32x4 d = v[i] - mean; q += (d[0] * d[0] + d[1] * d[1]) + (d[2] * d[2] + d[3] * d[3]); }
    rstd = rsqrtf(wave_sum(q) * (1.0f / DM) + NORM_EPS);
}
__device__ __forceinline__ void p_ln_first(const Frame& F) {
    const float* x = F.in[0]; const float* mod = WSP(float, WS_MOD); bf16_t* H = WSP(bf16_t, WS_H);
    for (int row = F.bx * 8 + F.wave; row < MTOK; row += F.G * 8) {
        f32x4 v[8]; const float* xr = x + (size_t)row * DM + F.lane * 4;
#pragma unroll
        for (int i = 0; i < 8; ++i) v[i] = *(const f32x4*)(xr + i * 256);
        float mean, rstd; row_stats(v, mean, rstd);
        const float* mp = mod + (size_t)(row >> 12) * (3 * DM) + F.lane * 4;
#pragma unroll
        for (int i = 0; i < 8; ++i) { const f32x4 sh = *(const f32x4*)(mp + i * 256), sc = *(const f32x4*)(mp + DM + i * 256);
            store4_bf16(H + (size_t)row * DM + F.lane * 4 + i * 256, (v[i] - mean) * rstd * (sc + 1.0f) + sh); }
    }
}
template <bool NEXT> __device__ __forceinline__ void p_ln_post(const Frame& F, int l) {
    float* R = WSP(float, WS_R); float* dst = NEXT ? R : F.out; const float* g = F.in[12] + l * DM; const float* bb = F.in[13] + l * DM;
    const float* mod = WSP(float, WS_MOD) + (size_t)(l + 1) * NB * (3 * DM); bf16_t* H = WSP(bf16_t, WS_H);
    for (int row = F.bx * 8 + F.wave; row < MTOK; row += F.G * 8) {
        f32x4 v[8]; const float* xr = R + (size_t)row * DM + F.lane * 4;
#pragma unroll
        for (int i = 0; i < 8; ++i) v[i] = *(const f32x4*)(xr + i * 256);
        float mean, rstd; row_stats(v, mean, rstd);
#pragma unroll
        for (int i = 0; i < 8; ++i) { v[i] = (v[i] - mean) * rstd * *(const f32x4*)(g + F.lane * 4 + i * 256) + *(const f32x4*)(bb + F.lane * 4 + i * 256);
            *(f32x4*)(dst + (size_t)row * DM + F.lane * 4 + i * 256) = v[i]; }
        if (NEXT) { row_stats(v, mean, rstd); const float* mp = mod + (size_t)(row >> 12) * (3 * DM) + F.lane * 4;
#pragma unroll
            for (int i = 0; i < 8; ++i) { const f32x4 sh = *(const f32x4*)(mp + i * 256), sc = *(const f32x4*)(mp + DM + i * 256);
                store4_bf16(H + (size_t)row * DM + F.lane * 4 + i * 256, (v[i] - mean) * rstd * (sc + 1.0f) + sh); } }
    }
}
__device__ __forceinline__ void fft1_naive(const Frame& F) {
    const bf16_t* U = WSP(bf16_t, WS_U); const bf16_t* D1 = WSP(bf16_t, WS_D1); bf16_t* Z = WSP(bf16_t, WS_H);
    const int gid = F.bx * NTHREADS + F.tid, NT = F.G * NTHREADS;
    for (int idx = gid; idx < NB * 64 * NG * 64 * 128; idx += NT) {
        const int c = idx & 127, s2 = (idx >> 7) & 63, g = (idx >> 13) & 7, s1p = (idx >> 16) & 63, b = idx >> 22;
        float yr = 0.f, yi = 0.f;
        for (int s1 = 0; s1 < 64; ++s1) { const float u = bf2f(U[(size_t)(b * SEQ + 64 * s1 + s2) * DF + g * 128 + c]); yr += bf2f(D1[s1p * 64 + s1]) * u; yi += bf2f(D1[(64 + s1p) * 64 + s1]) * u; }
        float st, ct; sincospif((float)(s2 * s1p) * (1.0f / 2048.0f), &st, &ct);
        const size_t zo = ((((size_t)(b * 64 + s1p) * NG + g) * 2) * 64 + s2) * 128 + c;
        Z[zo] = f2bf(yr * ct + yi * st); Z[zo + 64 * 128] = f2bf(yi * ct - yr * st);
    }
}
__device__ __forceinline__ void fft2_naive(const Frame& F, int l) {
    const bf16_t* Z = WSP(bf16_t, WS_H); const bf16_t* D2 = WSP(bf16_t, WS_D2); const bf16_t* wcat = WSP(bf16_t, WS_WCAT) + (size_t)l * NG * 128 * 256; bf16_t* MIX = WSP(bf16_t, WS_MIX);
    LAS float* Xs = (LAS float*)F.lds;
    for (int it = F.bx; it < NB * 64 * NG; it += F.G) {
        const int g = it & 7, s1p = (it >> 3) & 63, b = it >> 9;
        const bf16_t* Zb = Z + ((size_t)(b * 64 + s1p) * NG + g) * 2 * 64 * 128;
        for (int i = 0; i < 32; ++i) { const int o = F.tid + 512 * i, c = o & 127, rr = o >> 7; float s = 0.f;
            for (int k = 0; k < 128; ++k) s += bf2f(D2[rr * 128 + k]) * bf2f(Zb[k * 128 + c]);
            Xs[rr * 128 + c] = bf2f(f2bf(s)); }
        __syncthreads();
        for (int i = 0; i < 16; ++i) { const int o = F.tid + 512 * i, d = o & 127, s2p = o >> 7; float s = 0.f;
            const bf16_t* wr = wcat + (size_t)(g * 128 + d) * 256;
            for (int k = 0; k < 256; ++k) s += Xs[((k >> 7) * 64 + s2p) * 128 + (k & 127)] * bf2f(wr[k]);
            const size_t mo = (size_t)(b * SEQ + s1p + 64 * s2p) * DM + g * 128 + d;
            MIX[mo] = f2bf(s * bf2f(MIX[mo])); }
        __syncthreads();
    }
}
__device__ __forceinline__ void attn_naive(const Frame& F) {
    const bf16_t* Q = WSP(bf16_t, WS_Q); const bf16_t* KV = WSP(bf16_t, WS_KV); const bf16_t* KR = WSP(bf16_t, WS_KR); bf16_t* MIX = WSP(bf16_t, WS_MIX);
    LAS float* qs = (LAS float*)F.lds + F.wave * 192;
    for (int it = F.bx * 8 + F.wave; it < MTOK * NH * 2; it += F.G * 8) {
        const int dh = it & 1, h = (it >> 1) & 7, tok = it >> 4, b = tok >> 12;
        __builtin_amdgcn_wave_barrier(); asm volatile("" ::: "memory");
        for (int e = 0; e < 3; ++e) qs[F.lane + 64 * e] = bf2f(Q[(size_t)tok * NQ + h * DQK + F.lane + 64 * e]);
        asm volatile("s_waitcnt lgkmcnt(0)" ::: "memory"); __builtin_amdgcn_wave_barrier();
        float m = -1e30f, lsum = 0.f; float o[64];
#pragma unroll
        for (int d = 0; d < 64; ++d) o[d] = 0.f;
        for (int t = 0; t < 64; ++t) {
            const size_t key = (size_t)b * SEQ + F.lane + 64 * t; const bf16_t* kn = KV + key * NKV + h * 256; const bf16_t* kr = KR + key * 64;
            float s = 0.f;
#pragma unroll 2
            for (int c = 0; c < 16; ++c) { const bf16x8 kv = *(const bf16x8*)(kn + c * 8);
#pragma unroll
                for (int e = 0; e < 8; ++e) s += qs[c * 8 + e] * bf2f((bf16_t)kv[e]); }
#pragma unroll 2
            for (int c = 0; c < 8; ++c) { const bf16x8 kv = *(const bf16x8*)(kr + c * 8);
#pragma unroll
                for (int e = 0; e < 8; ++e) s += qs[128 + c * 8 + e] * bf2f((bf16_t)kv[e]); }
            s *= ATT_SCALE; const float mn = fmaxf(m, s), a = __expf(m - mn), p = __expf(s - mn); lsum = lsum * a + p; m = mn;
#pragma unroll
            for (int c = 0; c < 8; ++c) { const bf16x8 vv = *(const bf16x8*)(kn + 128 + dh * 64 + c * 8);
#pragma unroll
                for (int e = 0; e < 8; ++e) o[c * 8 + e] = o[c * 8 + e] * a + p * bf2f((bf16_t)vv[e]); }
        }
        const float Mx = wave_max(m), f = __expf(m - Mx); const float L = wave_sum(lsum * f);
        float keep0 = 0.f;
#pragma unroll
        for (int d = 0; d < 64; ++d) { const float od = wave_sum(o[d] * f); if (F.lane == d) keep0 = od; }
        const size_t mo = (size_t)tok * DM + DF + h * 128 + dh * 64 + F.lane;
        MIX[mo] = f2bf(keep0 / L * bf2f(MIX[mo]));
    }
}
#ifndef DIAG_ONLY
#define DIAG_ONLY -1
#endif
#define DIAG_EN(k) (DIAG_ONLY < 0 || DIAG_ONLY == (k))
struct Args { const float* in[14]; float* out; unsigned char* ws; int ph_lo, ph_hi; };
constexpr int N_PHASES = 2 + 5 * DEPTH;

template <class Epi, class Sched> __device__ __forceinline__ void run_gemm(const Frame& F, const pg8::Gemm& g, const Sched& S, const Epi& E) {
#if IMPL_GEMM
    pg8::gemm_phase<Epi, Sched, PG8_ALIGN, PG8_SP2>(F.lds, g, S, E, F.tid);
#else
    pg8::gemm_phase_naive<Epi, Sched>(g, S, E, F.tid);
#endif
}

#define PH_IN(k) (lo <= (k) && (k) < hi)
#define PH_SEAM(k) do { if (PH_IN(k) && PH_IN((k) + 1)) xcd_barrier(bar); } while (0)
#define PH_ENTER() do { int _t = threadIdx.x; asm volatile("" : "+v"(_t)); F.tid = _t; F.lane = _t & 63; } while (0)

template <int L> __device__ __forceinline__ void layer_phases(Frame& F, const int lo, const int hi, const XcdBarrier& bar) {
    constexpr int P = 2 + 5 * L;
    float* rsq = WSP(float, WS_RSQ) + (size_t)L * MTOK * 2;
    if (PH_IN(P + 0) && DIAG_EN(2)) {
        PH_ENTER();
        pg8::Gemm g{WSP(bf16_t, WS_H), WSP(bf16_t, WS_WIN) + (size_t)L * NINP * DM, MTOK, NINP, DM};
        pg8::StaticOrder S; S.init(MTOK, NINP, F.G, F.bx);
        EpiIn E{WSP(bf16_t, WS_U), WSP(bf16_t, WS_MIX), WSP(bf16_t, WS_CQ), WSP(bf16_t, WS_CKV), WSP(bf16_t, WS_KR), rsq, WSP(float, WS_RCOS), WSP(float, WS_RSIN)};
        run_gemm(F, g, S, E);
    }
    PH_SEAM(P + 0);
    if (PH_IN(P + 1) && DIAG_EN(3)) {
        PH_ENTER();
        { pg8::Gemm g{WSP(bf16_t, WS_CQ), WSP(bf16_t, WS_WQ) + (size_t)L * NQ * QLR, MTOK, NQ, QLR};
          pg8::SplitOrder S; S.init(F.G, F.bx, NQ / 256, 0);
          EpiQ E{WSP(bf16_t, WS_Q), rsq, WSP(float, WS_RCOS), WSP(float, WS_RSIN)};
          run_gemm(F, g, S, E); }
        { pg8::Gemm g{WSP(bf16_t, WS_CKV), WSP(bf16_t, WS_WKV) + (size_t)L * NKV * KVLR, MTOK, NKV, KVLR};
          pg8::SplitOrder S; S.init(F.G, F.bx, NKV / 256, 1);
          EpiKV E{WSP(bf16_t, WS_KV), rsq};
          run_gemm(F, g, S, E); }
#if IMPL_FFT
        fft1_fast(F);
#else
        fft1_naive(F);
#endif
    }
    PH_SEAM(P + 1);
    if (PH_IN(P + 2) && DIAG_EN(4)) {
        PH_ENTER();
#if IMPL_ATTN
        attn_fast(F);
#else
        attn_naive(F);
#endif
        __syncthreads();
#if IMPL_FFT
        fft2_fast(F, L);
#else
        fft2_naive(F, L);
#endif
    }
    PH_SEAM(P + 2);
    if (PH_IN(P + 3) && DIAG_EN(5)) {
        PH_ENTER();
        pg8::Gemm g{WSP(bf16_t, WS_MIX), WSP(bf16_t, WS_WOUT) + (size_t)L * DM * DM, MTOK, DM, DM};
        pg8::StaticOrder S; S.init(MTOK, DM, F.G, F.bx);
        EpiOut E{L == 0 ? F.in[0] : WSP(float, WS_R), WSP(float, WS_R), WSP(float, WS_MOD) + (size_t)L * NB * (3 * DM) + 2 * DM};
        run_gemm(F, g, S, E);
    }
    PH_SEAM(P + 3);
    if (PH_IN(P + 4) && DIAG_EN(6)) {
        PH_ENTER();
        if (L + 1 < DEPTH) p_ln_post<true>(F, L); else p_ln_post<false>(F, L);
    }
    PH_SEAM(P + 4);
}

__global__ void __launch_bounds__(NTHREADS, 2) fwd_kernel(Args args) {
    extern __shared__ __attribute__((aligned(16))) unsigned char lds[];
    Frame F;
    F.in[0] = args.in[0]; F.in[1] = args.in[1]; F.in[2] = args.in[2]; F.in[3] = args.in[3]; F.in[4] = args.in[4]; F.in[5] = args.in[5]; F.in[6] = args.in[6]; F.in[7] = args.in[7]; F.in[8] = args.in[8]; F.in[9] = args.in[9]; F.in[10] = args.in[10]; F.in[11] = args.in[11]; F.in[12] = args.in[12]; F.in[13] = args.in[13];
    F.out = args.out; F.ws = args.ws; F.lds = (LAS unsigned char*)lds; F.ldsg = (char*)lds;
    F.tid = threadIdx.x; F.lane = F.tid & 63; F.wave = __builtin_amdgcn_readfirstlane(F.tid >> 6); F.G = gridDim.x; F.bx = blockIdx.x;
    F.vcu = (F.G % 8 == 0) ? (F.bx % 8) * (F.G / 8) + F.bx / 8 : F.bx;
    volatile LAS unsigned* MISC = (volatile LAS unsigned*)(F.lds + MISC_OFF);
    if (F.tid < 64) MISC[F.tid] = 0u;
    __syncthreads();
    const int lo = args.ph_lo, hi = args.ph_hi;
    XcdBarrier bar; bar.bar = WSP(unsigned, WS_CTL); bar.x = 0; bar.st = MISC;
    if (hi - lo > 1) bar = xcd_barrier_post(WSP(unsigned, WS_CTL), MISC);
    if (PH_IN(0) && DIAG_EN(0)) { PH_ENTER(); p0_weights(F); p0_mod(F); p0_tables(F); }
    PH_SEAM(0);
    if (PH_IN(1) && DIAG_EN(1)) { PH_ENTER(); p_ln_first(F); }
    PH_SEAM(1);
    layer_phases<0>(F, lo, hi, bar);
    layer_phases<1>(F, lo, hi, bar);
}

extern "C" void kernel_launch(void* const* d_in, const int* in_sizes, int n_in, void* d_out, int out_size, void* d_ws, size_t ws_size, hipStream_t stream) {
    static int grid = 0;
    if (grid == 0) {
        if (n_in != 14 || in_sizes[0] != MTOK * DM || out_size != MTOK * DM || ws_size < WS_END) {
            fprintf(stderr, "kernel_launch: shape mismatch (n_in %d, in0 %d, out %d, ws %zu, need ws >= %zu); nothing launched\n", n_in, n_in > 0 ? in_sizes[0] : -1, out_size, ws_size, (size_t)WS_END); grid = -1; return; }
        int dev = 0, cus = 0, per_cu = 0;
        if (hipGetDevice(&dev) != hipSuccess || hipDeviceGetAttribute(&cus, hipDeviceAttributeMultiprocessorCount, dev) != hipSuccess) { grid = -1; return; }
        if (hipFuncSetAttribute((const void*)fwd_kernel, hipFuncAttributeMaxDynamicSharedMemorySize, LDS_BYTES) != hipSuccess) { fprintf(stderr, "kernel_launch: hipFuncSetAttribute failed\n"); grid = -1; return; }
        if (hipOccupancyMaxActiveBlocksPerMultiprocessor(&per_cu, (const void*)fwd_kernel, NTHREADS, LDS_BYTES) != hipSuccess || per_cu < 1) { fprintf(stderr, "kernel_launch: occupancy query failed (%d)\n", per_cu); (void)hipGetLastError(); per_cu = 1; }
        if (per_cu > 1) per_cu = 1;
        grid = cus * per_cu;
    }
    if (grid < 0) return;
    if (hipMemsetAsync((char*)d_ws + WS_CTL, 0, CTL_BYTES, stream) != hipSuccess) { fprintf(stderr, "kernel_launch: hipMemsetAsync failed\n"); return; }
    Args a{};
    for (int i = 0; i < 14; ++i) a.in[i] = (const float*)d_in[i];
    a.out = (float*)d_out; a.ws = (unsigned char*)d_ws;
#if N_LAUNCH_MODE
    a.ph_lo = 0; a.ph_hi = N_PHASES;
    hipLaunchKernelGGL(fwd_kernel, dim3(grid), dim3(NTHREADS), LDS_BYTES, stream, a);
#else
    for (int ph = 0; ph < N_PHASES; ++ph) { a.ph_lo = ph; a.ph_hi = ph + 1; hipLaunchKernelGGL(fwd_kernel, dim3(grid), dim3(NTHREADS), LDS_BYTES, stream, a); }
#endif
    const hipError_t le = hipPeekAtLastError();
    if (le != hipSuccess) fprintf(stderr, "kernel_launch: launch failed: %s (grid %d)\n", hipGetErrorName(le), grid);
}
```

```cpp
#define IMPL_GEMM 1
#define IMPL_ATTN 1
#define IMPL_FFT 3
#define N_LAUNCH_MODE 1
#include <hip/hip_runtime.h>
#include <cstdio>
#include <cstdint>

#ifndef N_LAUNCH_MODE
#define N_LAUNCH_MODE 1
#endif
#ifndef IMPL_GEMM
#define IMPL_GEMM 1
#endif
#ifndef IMPL_ATTN
#define IMPL_ATTN 1
#endif
#ifndef IMPL_FFT
#define IMPL_FFT 3
#endif

#define LAS __attribute__((address_space(3)))
typedef unsigned short bf16_t;
typedef short bf16x8 __attribute__((ext_vector_type(8)));
typedef short s16x4 __attribute__((ext_vector_type(4)));
typedef float f32x4 __attribute__((ext_vector_type(4)));
typedef float f32x2 __attribute__((ext_vector_type(2)));
typedef float f32x16 __attribute__((ext_vector_type(16)));
typedef unsigned u32x4 __attribute__((ext_vector_type(4)));
typedef unsigned u32x2 __attribute__((ext_vector_type(2)));

constexpr int NB = 4, SEQ = 4096, DM = 2048, MTOK = NB * SEQ, DEPTH = 2;
constexpr int DF = 1024, NG = 8, GD = 128, NH = 8, DV = 128, DNOPE = 128, DROPE = 64, DQK = 192, QLR = 512, KVLR = 256;
constexpr int NIN = 3904, NINP = 4096;
constexpr int NQ = NH * DQK  , NKV = NH * (DNOPE + DV)  ;
constexpr float NORM_EPS = 1e-6f;
constexpr float DN_ALPHA = 1.4142135623730951f;
constexpr float ATT_SCALE = 0.07216878364870322f;

__device__ __forceinline__ float bf2f(bf16_t b) { return __uint_as_float(((unsigned)b) << 16); }
__device__ __forceinline__ bf16_t f2bf(float f) { unsigned u = __float_as_uint(f); u += 0x7FFFu + ((u >> 16) & 1u); return (bf16_t)(u >> 16); }
typedef __bf16 bf16v2_t __attribute__((ext_vector_type(2)));
__device__ __forceinline__ unsigned cvt_pk_bf16(float lo, float hi) { const f32x2 v = {lo, hi}; return __builtin_bit_cast(unsigned, __builtin_convertvector(v, bf16v2_t)); }
__device__ __forceinline__ float silu_f(float z) { return z * __builtin_amdgcn_rcpf(1.0f + __builtin_amdgcn_exp2f(-1.4426950408889634f * z)); }
__device__ __forceinline__ float wave_sum(float v) { for (int o = 32; o > 0; o >>= 1) v += __shfl_xor(v, o); return v; }
__device__ __forceinline__ float wave_max(float v) { for (int o = 32; o > 0; o >>= 1) v = fmaxf(v, __shfl_xor(v, o)); return v; }

constexpr size_t al256(size_t x) { return (x + 255) / 256 * 256; }
constexpr size_t WS_CTL  = 0;
constexpr size_t CTL_BYTES = 16384;
constexpr size_t WS_MOD  = WS_CTL + CTL_BYTES;
constexpr size_t WS_RSQ  = WS_MOD + al256((size_t)DEPTH * NB * 3 * DM * 4);
constexpr size_t WS_RCOS = WS_RSQ + al256((size_t)DEPTH * MTOK * 2 * 4);
constexpr size_t WS_RSIN = WS_RCOS + (size_t)MTOK * 32 * 4;
constexpr size_t WS_D1   = WS_RSIN + (size_t)MTOK * 32 * 4;
constexpr size_t WS_D2   = WS_D1 + 128 * 64 * 2;
constexpr size_t WS_WCAT = WS_D2 + 128 * 128 * 2;
constexpr size_t WS_WIN  = WS_WCAT + (size_t)DEPTH * NG * 128 * 256 * 2;
constexpr size_t WS_WOUT = WS_WIN + (size_t)DEPTH * NINP * DM * 2;
constexpr size_t WS_WQ   = WS_WOUT + (size_t)DEPTH * DM * DM * 2;
constexpr size_t WS_WKV  = WS_WQ + (size_t)DEPTH * NQ * QLR * 2;
constexpr size_t WS_H    = WS_WKV + (size_t)DEPTH * NKV * KVLR * 2;
constexpr size_t WS_U    = WS_H + (size_t)MTOK * DM * 2;
constexpr size_t WS_MIX  = WS_U + (size_t)MTOK * DF * 2;
constexpr size_t WS_CQ   = WS_MIX + (size_t)MTOK * DM * 2;
constexpr size_t WS_CKV  = WS_CQ + (size_t)MTOK * QLR * 2;
constexpr size_t WS_KR   = WS_CKV + (size_t)MTOK * KVLR * 2;
constexpr size_t WS_Q    = WS_KR + (size_t)MTOK * 64 * 2;
constexpr size_t WS_KV   = WS_Q + (size_t)MTOK * NQ * 2;
constexpr size_t WS_R    = WS_KV + (size_t)MTOK * NKV * 2;
constexpr size_t WS_END  = WS_R + (size_t)MTOK * DM * 4;
static_assert(WS_END <= (size_t)4 * MTOK * DM * 4, "workspace map exceeds 4 x largest tensor");

constexpr int RING_BYTES = 155648, MISC_OFF = RING_BYTES, LDS_BYTES = RING_BYTES + 256;
constexpr int NTHREADS = 512;

namespace pg8 {
#define PG8_LAS __attribute__((address_space(3)))
constexpr int BM = 256, BK = 64, HALF = 128, HTB = HALF * BK * 2  , STAGE_BYTES = 8 * HTB, NXCD = 8, WGM = 8;
static_assert(STAGE_BYTES <= RING_BYTES, "GEMM stage ring must fit the LDS phase scratch");

__host__ __device__ __forceinline__ int lds_byte(int r, int c) { const int st = (r >> 4) * 2 + (c >> 5), rr = r & 15, cc = c & 31, ob = rr * 64 + cc * 2; return st * 1024 + (ob ^ (((ob >> 9) & 1) << 5)); }
__host__ __device__ __forceinline__ void stage_rc(int b, int& R, int& C) { const int st = b / 1024, sb = b % 1024, swz = sb ^ (((sb >> 9) & 1) << 5); R = (st >> 1) * 16 + swz / 64; C = (st & 1) * 32 + (swz % 64) / 2; }
__host__ __device__ __forceinline__ int perm32(int rho) { const int n = rho >> 4, i = rho & 15; return 8 * (i >> 2) + 4 * n + (i & 3); }

struct Unit { int pm, pn; };
struct Gemm { const bf16_t* A; const bf16_t* Bt; int M, N, K; };

struct StaticOrder {
    int nM, nN, nwg, G, c;
    __host__ __device__ void init(int M, int N, int G_, int c_) { nM = M / BM; nN = N / BM; nwg = nM * nN; G = G_; c = c_; }
    __host__ __device__ bool next(int i, Unit& u) const {
        const long L = (long)i * G + c; if (L >= nwg) return false;
        int wgid = (int)L; { const int q = nwg / NXCD, r = nwg % NXCD, xcd = wgid % NXCD, off = wgid / NXCD; wgid = (xcd < r ? xcd * (q + 1) : r * (q + 1) + (xcd - r) * q) + off; }
        const int nig = WGM * nN, gid = wgid / nig, fm = gid * WGM, gsz = (nM - fm) < WGM ? (nM - fm) : WGM;
        u.pm = fm + ((wgid % nig) % gsz); u.pn = (wgid % nig) / gsz; return true;
    }
    __device__ __forceinline__ void a_ready(const Unit&) const {}
    __device__ __forceinline__ void done(const Unit&) const {}
};
struct SplitOrder {
    int G, c, nN, kind;
    __device__ void init(int G_, int c_, int nN_, int kind_) { G = G_; c = c_; nN = nN_; kind = kind_; }
    __device__ bool next(int i, Unit& u) const {
        if (G != 256) { const int L = i * G + c; if (L >= 64 * nN) return false; u.pm = L / nN; u.pn = L % nN; return true; }
        const int x = c & 7, v = c >> 3; int li;
        if (kind == 0) { if (v < 16) { if (i >= 2) return false; li = 2 * v + i; } else { if (i >= 1) return false; li = 32 + (v - 16); } }
        else           { if (v < 16) { if (i >= 1) return false; li = v; } else { if (i >= 3) return false; li = 16 + 3 * (v - 16) + i; } }
        u.pm = 8 * x + li / nN; u.pn = li % nN; return true;
    }
    __device__ __forceinline__ void a_ready(const Unit&) const {}
    __device__ __forceinline__ void done(const Unit&) const {}
};
template <class Epi, class Sched, bool ALIGN_EPI = false, bool SP2 = false>
__device__ __forceinline__ void gemm_phase(PG8_LAS unsigned char* lds, const Gemm g, const Sched& S, const Epi& E, const int tid) {
    const int wid = __builtin_amdgcn_readfirstlane(tid >> 6), lane = tid & 63, wr = wid >> 2, wc = wid & 3, fr = lane & 15, fq = lane >> 4;
    const int K = g.K, nt = K / BK;
    unsigned voffA[2], voffB[2];
#pragma unroll
    for (int i = 0; i < 2; ++i) { int R, C; stage_rc(tid * 16 + i * 8192, R, C); const int Rb = Epi::PERM ? ((R & ~31) + perm32(R & 31)) : R;
        voffA[i] = (unsigned)(R * K + C) * 2u; voffB[i] = (unsigned)(Rb * K + C) * 2u; }
    const size_t kstep = (size_t)(BK * 2);
    const size_t hstep = (size_t)HALF * K * 2;
    const size_t tstep = 2 * hstep;
    const unsigned ldsw = (unsigned)wid * 1024u;
    const int aoff = lds_byte(wr * 64 + fr, fq * 8), boff = lds_byte(wc * 32 + fr, fq * 8);
#define PG8_SA(b, h) (((b) * 2 + (h)) * HTB)
#define PG8_SB(b, h) ((4 + (b) * 2 + (h)) * HTB)
#define PG8_STAGE(bufoff, gbase, voff) do { _Pragma("unroll") for (int _i = 0; _i < 2; ++_i) \
        __builtin_amdgcn_global_load_lds((const unsigned*)((const char*)(gbase) + (voff)[_i]), (PG8_LAS unsigned*)(lds + (bufoff) + ldsw + _i * 8192), 16, 0, 0); } while (0)
#define PG8_LDA(dst, b, h) do { _Pragma("unroll") for (int m = 0; m < 4; ++m) _Pragma("unroll") for (int k = 0; k < 2; ++k) dst[m][k] = *(const PG8_LAS bf16x8*)(lds + PG8_SA(b, h) + aoff + m * 2048 + k * 1024); } while (0)
#define PG8_LDB(dst, b, h) do { _Pragma("unroll") for (int n = 0; n < 2; ++n) _Pragma("unroll") for (int k = 0; k < 2; ++k) dst[n][k] = *(const PG8_LAS bf16x8*)(lds + PG8_SB(b, h) + boff + n * 2048 + k * 1024); } while (0)
#define PG8_MMA(ai, bj, At, Bt) do { __builtin_amdgcn_s_setprio(1); _Pragma("unroll") for (int m = 0; m < 4; ++m) _Pragma("unroll") for (int n = 0; n < 2; ++n) _Pragma("unroll") for (int k = 0; k < 2; ++k) \
        acc[ai][bj][m][n] = __builtin_amdgcn_mfma_f32_16x16x32_bf16(Bt[n][k], At[m][k], acc[ai][bj][m][n], 0, 0, 0); __builtin_amdgcn_s_setprio(0); } while (0)
#define PG8_WAIT_V(n) asm volatile("s_waitcnt vmcnt(" #n ")" ::: "memory")
#define PG8_WAIT_L(n) asm volatile("s_waitcnt lgkmcnt(" #n ")" ::: "memory")
#define PG8_BAR __builtin_amdgcn_s_barrier()
#define PG8_SCHED __builtin_amdgcn_sched_barrier(0)
    Unit cur, nxt; int ui = 0;
    if (!S.next(0, cur)) return;
    f32x4 acc[2][2][4][2];
#pragma unroll
    for (int a = 0; a < 2; ++a)
#pragma unroll
        for (int b = 0; b < 2; ++b)
#pragma unroll
            for (int m = 0; m < 4; ++m)
#pragma unroll
                for (int n = 0; n < 2; ++n) acc[a][b][m][n] = (f32x4){0.f, 0.f, 0.f, 0.f};
    bf16x8 At[4][2], B0[2][2], B1[2][2];
    const char* cA = (const char*)g.A + (size_t)cur.pm * tstep; const char* cB = (const char*)g.Bt + (size_t)cur.pn * tstep;
    S.a_ready(cur);
    if constexpr (SP2) {
        PG8_STAGE(PG8_SB(0, 0), cB, voffB); PG8_STAGE(PG8_SB(0, 1), cB + hstep, voffB); PG8_STAGE(PG8_SA(0, 0), cA, voffA); PG8_STAGE(PG8_SA(0, 1), cA + hstep, voffA);
        if (wr == 1) PG8_BAR;
        PG8_WAIT_V(2); PG8_BAR;
        PG8_STAGE(PG8_SB(1, 0), cB + kstep, voffB); PG8_STAGE(PG8_SA(1, 0), cA + kstep, voffA); PG8_STAGE(PG8_SB(1, 1), cB + hstep + kstep, voffB);
        PG8_WAIT_V(6); PG8_BAR;
    } else {
        PG8_STAGE(PG8_SB(0, 0), cB, voffB); PG8_STAGE(PG8_SA(0, 0), cA, voffA); PG8_STAGE(PG8_SB(0, 1), cB + hstep, voffB); PG8_STAGE(PG8_SA(0, 1), cA + hstep, voffA);
        if (wr == 1) PG8_BAR;
        PG8_WAIT_V(4); PG8_BAR;
        PG8_STAGE(PG8_SB(1, 0), cB + kstep, voffB); PG8_STAGE(PG8_SA(1, 0), cA + kstep, voffA); PG8_STAGE(PG8_SB(1, 1), cB + hstep + kstep, voffB);
        PG8_WAIT_V(6); PG8_BAR;
    }
    for (;;) {
        const bool has_next = S.next(ui + 1, nxt);
        const char* nA = has_next ? (const char*)g.A + (size_t)nxt.pm * tstep : cA; const char* nB = has_next ? (const char*)g.Bt + (size_t)nxt.pn * tstep : cB;
        for (int t = 0; t < nt; t += 2) {
            const bool last = (t == nt - 2);
            const char* a1 = cA + (size_t)(t + 1) * kstep;
            const char* a2 = last ? nA : cA + (size_t)(t + 2) * kstep; const char* b2 = last ? nB : cB + (size_t)(t + 2) * kstep;
            const char* a3 = a2 + kstep; const char* b3 = b2 + kstep;
            if (last && has_next) S.a_ready(nxt);
            if constexpr (SP2) {
            PG8_LDB(B0, 0, 0); PG8_LDB(B1, 0, 1); PG8_SCHED; PG8_LDA(At, 0, 0); PG8_STAGE(PG8_SA(1, 1), a1 + hstep, voffA);
            PG8_WAIT_V(8); PG8_WAIT_L(0); PG8_BAR; PG8_MMA(0, 0, At, B0); PG8_MMA(0, 1, At, B1); PG8_BAR; PG8_SCHED;
            PG8_LDA(At, 0, 1); PG8_STAGE(PG8_SB(0, 0), b2, voffB); PG8_STAGE(PG8_SB(0, 1), b2 + hstep, voffB); PG8_STAGE(PG8_SA(0, 0), a2, voffA);
            PG8_WAIT_V(8); PG8_WAIT_L(0); PG8_BAR; PG8_MMA(1, 0, At, B0); PG8_MMA(1, 1, At, B1); PG8_BAR; PG8_SCHED;
            PG8_LDB(B0, 1, 0); PG8_LDB(B1, 1, 1); PG8_SCHED; PG8_LDA(At, 1, 0); PG8_STAGE(PG8_SA(0, 1), a2 + hstep, voffA);
            PG8_WAIT_V(8); PG8_WAIT_L(0); PG8_BAR; PG8_MMA(0, 0, At, B0); PG8_MMA(0, 1, At, B1); PG8_BAR; PG8_SCHED;
            PG8_LDA(At, 1, 1); PG8_STAGE(PG8_SB(1, 0), b3, voffB); PG8_STAGE(PG8_SB(1, 1), b3 + hstep, voffB); PG8_STAGE(PG8_SA(1, 0), a3, voffA);
            PG8_WAIT_V(8); PG8_WAIT_L(0); PG8_BAR; PG8_MMA(1, 0, At, B0); PG8_MMA(1, 1, At, B1); PG8_BAR; PG8_SCHED;
            } else {
            PG8_LDB(B0, 0, 0); PG8_SCHED; PG8_LDA(At, 0, 0); PG8_STAGE(PG8_SA(1, 1), a1 + hstep, voffA);
            PG8_WAIT_L(8); PG8_BAR; PG8_WAIT_L(0); PG8_MMA(0, 0, At, B0); PG8_BAR; PG8_SCHED;
            PG8_LDB(B1, 0, 1); PG8_STAGE(PG8_SB(0, 0), b2, voffB);
            PG8_BAR; PG8_WAIT_L(0); PG8_MMA(0, 1, At, B1); PG8_BAR;
            PG8_LDA(At, 0, 1); PG8_STAGE(PG8_SA(0, 0), a2, voffA);
            PG8_BAR; PG8_WAIT_L(0); PG8_MMA(1, 0, At, B0); PG8_BAR; PG8_SCHED;
            PG8_STAGE(PG8_SB(0, 1), b2 + hstep, voffB);
            PG8_WAIT_V(6); PG8_BAR; PG8_MMA(1, 1, At, B1); PG8_BAR;
            PG8_LDB(B0, 1, 0); PG8_SCHED; PG8_LDA(At, 1, 0); PG8_STAGE(PG8_SA(0, 1), a2 + hstep, voffA);
            PG8_WAIT_L(8); PG8_BAR; PG8_WAIT_L(0); PG8_MMA(0, 0, At, B0); PG8_BAR; PG8_SCHED;
            PG8_LDB(B1, 1, 1); PG8_STAGE(PG8_SB(1, 0), b3, voffB);
            PG8_BAR; PG8_WAIT_L(0); PG8_MMA(0, 1, At, B1); PG8_BAR;
            PG8_LDA(At, 1, 1); PG8_STAGE(PG8_SA(1, 0), a3, voffA);
            PG8_BAR; PG8_WAIT_L(0); PG8_MMA(1, 0, At, B0); PG8_BAR; PG8_SCHED;
            PG8_STAGE(PG8_SB(1, 1), b3 + hstep, voffB);
            PG8_WAIT_V(6); PG8_BAR; PG8_MMA(1, 1, At, B1); PG8_BAR;
            }
        }
        if constexpr (ALIGN_EPI) { if (wr == 0) PG8_BAR; }
        if constexpr (!Epi::AFTER_DRAIN) { E(acc, cur, wr, wc, fr, fq); S.done(cur); }
        if (!has_next) break;
#pragma unroll
        for (int a = 0; a < 2; ++a)
#pragma unroll
            for (int b = 0; b < 2; ++b)
#pragma unroll
                for (int m = 0; m < 4; ++m)
#pragma unroll
                    for (int n = 0; n < 2; ++n) acc[a][b][m][n] = (f32x4){0.f, 0.f, 0.f, 0.f};
        cur = nxt; cA = nA; cB = nB; ++ui;
        if constexpr (ALIGN_EPI) { if (wr == 1) PG8_BAR; }
    }
    PG8_WAIT_V(0);
    if constexpr (!ALIGN_EPI) { if (wr == 0) PG8_BAR; }
    PG8_BAR;
    if constexpr (Epi::AFTER_DRAIN) { E.fused(acc, cur, wr, wc, fr, fq, lds, wid, lane); S.done(cur); }
#undef PG8_SA
#undef PG8_SB
#undef PG8_STAGE
#undef PG8_LDA
#undef PG8_LDB
#undef PG8_MMA
#undef PG8_WAIT_V
#undef PG8_WAIT_L
#undef PG8_BAR
#undef PG8_SCHED
}

template <class Epi, class Sched>
__device__ __forceinline__ void gemm_phase_naive(const Gemm g, const Sched& S, const Epi& E, const int tid) {
    const int wid = __builtin_amdgcn_readfirstlane(tid >> 6), lane = tid & 63, wr = wid >> 2, wc = wid & 3, fr = lane & 15, fq = lane >> 4;
    const int K = g.K;
    Unit cur;
    for (int ui = 0; S.next(ui, cur); ++ui) {
        f32x4 acc[2][2][4][2];
#pragma unroll
        for (int ai = 0; ai < 2; ++ai)
#pragma unroll
            for (int m = 0; m < 4; ++m) {
                const bf16_t* arow = g.A + (size_t)(cur.pm * BM + ai * HALF + wr * 64 + m * 16 + fr) * K;
#pragma unroll
                for (int bj = 0; bj < 2; ++bj)
#pragma unroll
                    for (int n = 0; n < 2; ++n) {
                        const int col = cur.pn * BM + bj * HALF + wc * 32 + (Epi::PERM ? (8 * fq + 4 * n) : (16 * n + 4 * fq));
                        const bf16_t* brow = g.Bt + (size_t)col * K;
                        float s0 = 0.f, s1 = 0.f, s2 = 0.f, s3 = 0.f;
#pragma unroll 1
                        for (int k = 0; k < K; k += 8) {
                            const bf16x8 av = *(const bf16x8*)(arow + k);
                            const bf16x8 b0 = *(const bf16x8*)(brow + k), b1 = *(const bf16x8*)(brow + K + k), b2 = *(const bf16x8*)(brow + 2 * K + k), b3 = *(const bf16x8*)(brow + 3 * K + k);
#pragma unroll
                            for (int e = 0; e < 8; ++e) { const float a = bf2f((bf16_t)av[e]);
                                s0 += a * bf2f((bf16_t)b0[e]); s1 += a * bf2f((bf16_t)b1[e]); s2 += a * bf2f((bf16_t)b2[e]); s3 += a * bf2f((bf16_t)b3[e]); }
                        }
                        acc[ai][bj][m][n] = (f32x4){s0, s1, s2, s3};
                    }
            }
        E(acc, cur, wr, wc, fr, fq);
    }
}
}
#ifndef PG8_SP2
#define PG8_SP2 true
#endif
#ifndef PG8_ALIGN
#define PG8_ALIGN true
#endif
typedef f32x4 AccT[2][2][4][2];

__device__ __forceinline__ void store8_bf16(bf16_t* p, f32x4 v0, f32x4 v1) {
    u32x4 w; w.x = cvt_pk_bf16(v0[0], v0[1]); w.y = cvt_pk_bf16(v0[2], v0[3]); w.z = cvt_pk_bf16(v1[0], v1[1]); w.w = cvt_pk_bf16(v1[2], v1[3]); *(u32x4*)p = w;
}
__device__ __forceinline__ void store4_bf16(bf16_t* p, f32x4 v) { u32x2 w; w.x = cvt_pk_bf16(v[0], v[1]); w.y = cvt_pk_bf16(v[2], v[3]); *(u32x2*)p = w; }
__device__ __forceinline__ f32x4 silu4(f32x4 v) { return (f32x4){silu_f(v[0]), silu_f(v[1]), silu_f(v[2]), silu_f(v[3])}; }
__device__ __forceinline__ float sq4(f32x4 v) { return (v[0] * v[0] + v[1] * v[1]) + (v[2] * v[2] + v[3] * v[3]); }

struct EpiIn {
    static constexpr bool PERM = true, AFTER_DRAIN = false;
    bf16_t* U; bf16_t* MIX; bf16_t* CQ; bf16_t* CKV; bf16_t* KR; float* rsq; const float* rcos; const float* rsin;
    template <int ACT> __device__ __forceinline__ void plain(const AccT& acc, bf16_t* base, int ldc, int row0, int col0) const {
#pragma unroll
        for (int ai = 0; ai < 2; ++ai)
#pragma unroll
            for (int m = 0; m < 4; ++m) { bf16_t* rowp = base + (size_t)(row0 + ai * 128 + m * 16) * ldc + col0;
#pragma unroll
                for (int bj = 0; bj < 2; ++bj) { f32x4 v0 = acc[ai][bj][m][0], v1 = acc[ai][bj][m][1]; if (ACT) { v0 = silu4(v0); v1 = silu4(v1); } store8_bf16(rowp + bj * 128, v0, v1); } }
    }
    __device__ __forceinline__ void sumsq(const AccT& acc, int row0, int which, int fq) const {
#pragma unroll
        for (int ai = 0; ai < 2; ++ai)
#pragma unroll
            for (int m = 0; m < 4; ++m) { float s = (sq4(acc[ai][0][m][0]) + sq4(acc[ai][0][m][1])) + (sq4(acc[ai][1][m][0]) + sq4(acc[ai][1][m][1]));
                s += __shfl_xor(s, 16); s += __shfl_xor(s, 32);
                if (fq == 0) atomicAdd(rsq + (size_t)(row0 + ai * 128 + m * 16) * 2 + which, s); }
    }
    __device__ __forceinline__ void operator()(const AccT& acc, const pg8::Unit& u, int wr, int wc, int fr, int fq) const {
        const int row0 = u.pm * 256 + wr * 64 + fr, pn = u.pn, cw = wc * 32 + 8 * fq;
        if (pn < 4) plain<0>(acc, U, DF, row0, pn * 256 + cw);
        else if (pn < 8) plain<1>(acc, MIX, DM, row0, (pn - 4) * 256 + cw);
        else if (pn < 10) { plain<0>(acc, CQ, QLR, row0, (pn - 8) * 256 + cw); sumsq(acc, row0, 0, fq); }
        else if (pn == 10) { plain<0>(acc, CKV, KVLR, row0, cw); sumsq(acc, row0, 1, fq); }
        else if (pn == 11) {
            if (wc < 2) { const int i0 = 16 * wc + 4 * fq;
#pragma unroll
                for (int ai = 0; ai < 2; ++ai)
#pragma unroll
                    for (int m = 0; m < 4; ++m) { const size_t row = (size_t)(row0 + ai * 128 + m * 16);
                        const f32x4 c = *(const f32x4*)(rcos + row * 32 + i0), s = *(const f32x4*)(rsin + row * 32 + i0), x1 = acc[ai][0][m][0], x2 = acc[ai][0][m][1];
                        store4_bf16(KR + row * 64 + i0, x1 * c - x2 * s); store4_bf16(KR + row * 64 + 32 + i0, x2 * c + x1 * s); } }
        }
        else plain<1>(acc, MIX, DM, row0, DF + (pn - 12) * 256 + cw);
    }
};
struct EpiQ {
    static constexpr bool PERM = true, AFTER_DRAIN = false;
    bf16_t* Q; const float* rsq; const float* rcos; const float* rsin;
    __device__ __forceinline__ void operator()(const AccT& acc, const pg8::Unit& u, int wr, int wc, int fr, int fq) const {
        const int row0 = u.pm * 256 + wr * 64 + fr;
#pragma unroll
        for (int ai = 0; ai < 2; ++ai)
#pragma unroll
            for (int m = 0; m < 4; ++m) { const size_t row = (size_t)(row0 + ai * 128 + m * 16);
                const float rs = rsqrtf(rsq[row * 2 + 0] * (1.0f / QLR) + NORM_EPS);
#pragma unroll
                for (int bj = 0; bj < 2; ++bj) { const int G = u.pn * 8 + bj * 4 + wc, head = G / 6, g6 = G - head * 6;
                    const f32x4 v0 = acc[ai][bj][m][0] * rs, v1 = acc[ai][bj][m][1] * rs;
                    if (g6 < 4) store8_bf16(Q + row * NQ + head * DQK + g6 * 32 + 8 * fq, v0, v1);
                    else { const int i0 = 16 * (g6 - 4) + 4 * fq; const f32x4 c = *(const f32x4*)(rcos + row * 32 + i0), s = *(const f32x4*)(rsin + row * 32 + i0);
                        store4_bf16(Q + row * NQ + head * DQK + 128 + i0, v0 * c - v1 * s); store4_bf16(Q + row * NQ + head * DQK + 160 + i0, v1 * c + v0 * s); } } }
    }
};
struct EpiKV {
    static constexpr bool PERM = true, AFTER_DRAIN = false;
    bf16_t* KV; const float* rsq;
    __device__ __forceinline__ void operator()(const AccT& acc, const pg8::Unit& u, int wr, int wc, int fr, int fq) const {
        const int row0 = u.pm * 256 + wr * 64 + fr, col0 = u.pn * 256 + wc * 32 + 8 * fq;
#pragma unroll
        for (int ai = 0; ai < 2; ++ai)
#pragma unroll
            for (int m = 0; m < 4; ++m) { const size_t row = (size_t)(row0 + ai * 128 + m * 16);
                const float rs = rsqrtf(rsq[row * 2 + 1] * (1.0f / KVLR) + NORM_EPS);
#pragma unroll
                for (int bj = 0; bj < 2; ++bj) store8_bf16(KV + row * NKV + col0 + bj * 128, acc[ai][bj][m][0] * rs, acc[ai][bj][m][1] * rs); }
    }
};
struct EpiOut {
    static constexpr bool PERM = false, AFTER_DRAIN = false;
    const float* xres; float* R; const float* gate;
    __device__ __forceinline__ void operator()(const AccT& acc, const pg8::Unit& u, int wr, int wc, int fr, int fq) const {
        const int row0 = u.pm * 256 + wr * 64 + fr, col0 = u.pn * 256 + wc * 32 + 4 * fq;
        const float* gp = gate + (size_t)(u.pm >> 4) * (3 * DM) + col0;
        f32x4 gv[2][2];
#pragma unroll
        for (int bj = 0; bj < 2; ++bj)
#pragma unroll
            for (int n = 0; n < 2; ++n) gv[bj][n] = *(const f32x4*)(gp + bj * 128 + n * 16);
#pragma unroll
        for (int ai = 0; ai < 2; ++ai)
#pragma unroll
            for (int m = 0; m < 4; ++m) { const size_t off = (size_t)(row0 + ai * 128 + m * 16) * DM + col0;
#pragma unroll
                for (int bj = 0; bj < 2; ++bj)
#pragma unroll
                    for (int n = 0; n < 2; ++n) { const f32x4 xs = *(const f32x4*)(xres + off + bj * 128 + n * 16);
                        *(f32x4*)(R + off + bj * 128 + n * 16) = xs * DN_ALPHA + gv[bj][n] * acc[ai][bj][m][n]; }
                asm volatile("" ::: "memory"); }
    }
};
#define XB_TMO      128
#define XB_XCNT(j)  (256  + 64 * (j))
#define XB_XSUB(j)  (1280 + 64 * (j))
#define XB_XGEN(j)  (2304 + 64 * (j))
#define XB_TOP      3328
#define XB_TOPGEN   3392
#define XCD_BAR_WORDS 3456
#define XB_SPIN_CAP (1u << 22)
static_assert(XCD_BAR_WORDS * 4 <= CTL_BYTES, "barrier words must fit the control region");
__device__ __forceinline__ unsigned xb_ld(unsigned* p)              { return __hip_atomic_load(p, __ATOMIC_RELAXED, __HIP_MEMORY_SCOPE_AGENT); }
__device__ __forceinline__ unsigned xb_add(unsigned* p, unsigned v) { return __hip_atomic_fetch_add(p, v, __ATOMIC_RELAXED, __HIP_MEMORY_SCOPE_AGENT); }
__device__ __forceinline__ unsigned xb_xcc_id() { return (unsigned)__builtin_amdgcn_s_getreg((3 << 11) | 20) & 0xFu; }
#define XB_SPIN(cond, bar) do { unsigned _sp = 0; while (cond) { __builtin_amdgcn_s_sleep(1); \
    if ((++_sp & 255u) == 0u) { if (xb_ld(&(bar)[XB_TMO])) break; if (_sp > XB_SPIN_CAP) { atomicAdd(&(bar)[XB_TMO], 1u); break; } } } } while (0)
struct XcdBarrier { unsigned* bar; unsigned x; volatile LAS unsigned* st; };
__device__ __forceinline__ XcdBarrier xcd_barrier_post(unsigned* bar, volatile LAS unsigned* st) {
    XcdBarrier b; b.bar = bar; b.x = xb_xcc_id(); b.st = st;
    if (threadIdx.x == 0) (void)xb_add(&bar[XB_XCNT(b.x)], 1u);
    return b;
}
__device__ __forceinline__ void xcd_barrier_complete(unsigned* bar, unsigned x, unsigned& nloc, unsigned& nx) {
    const unsigned G = gridDim.x * gridDim.y * gridDim.z;
    unsigned sum, cnt, mine, sp = 0u;
    for (;;) {
        sum = 0u; cnt = 0u; mine = 0u;
#pragma unroll
        for (unsigned j = 0; j < 16; ++j) { const unsigned c = xb_ld(&bar[XB_XCNT(j)]); sum += c; cnt += (c > 0u) ? 1u : 0u; mine = (j == x) ? c : mine; }
        if (sum == G) break;
        __builtin_amdgcn_s_sleep(1);
        if ((++sp & 255u) == 0u) { if (xb_ld(&bar[XB_TMO])) break; if (sp > XB_SPIN_CAP) { atomicAdd(&bar[XB_TMO], 1u); break; } }
    }
    nloc = mine > 0u ? mine : 1u; nx = cnt > 0u ? cnt : 1u;
}
__device__ __forceinline__ void xcd_barrier(const XcdBarrier& b) {
    asm volatile("s_waitcnt vmcnt(0)" ::: "memory");
    __syncthreads();
    if (threadIdx.x == 0) {
        unsigned* bar = b.bar;
        __builtin_amdgcn_s_waitcnt(0);
        unsigned nloc = b.st[0], nx = b.st[1];
        if (nloc == 0u) { xcd_barrier_complete(bar, b.x, nloc, nx); b.st[0] = nloc; b.st[1] = nx; }
        const unsigned old = xb_add(&bar[XB_XSUB(b.x)], 1u);
        const unsigned gen = old / nloc;
        if (old + 1u == (gen + 1u) * nloc) {
            __builtin_amdgcn_fence(__ATOMIC_RELEASE, "agent");
            asm volatile("s_waitcnt vmcnt(0)" ::: "memory");
            const unsigned og = xb_add(&bar[XB_TOP], 1u);
            const unsigned tg = og / nx;
            if (og + 1u == (tg + 1u) * nx) xb_add(&bar[XB_TOPGEN], 1u);
            else XB_SPIN(xb_ld(&bar[XB_TOPGEN]) == tg, bar);
            __builtin_amdgcn_fence(__ATOMIC_ACQUIRE, "agent");
            xb_add(&bar[XB_XGEN(b.x)], 1u);
            asm volatile("s_waitcnt vmcnt(0)" ::: "memory");
        } else {
            XB_SPIN(xb_ld(&bar[XB_XGEN(b.x)]) == gen, bar);
            __builtin_amdgcn_fence(__ATOMIC_ACQUIRE, "agent");
            asm volatile("s_waitcnt vmcnt(0)" ::: "memory");
        }
    }
    __syncthreads();
}
struct Frame {
    const float* in[14]; float* out; unsigned char* ws;
    LAS unsigned char* lds; char* ldsg;
    int tid, lane, wave, G, bx, vcu;
};
#define WSP(T, off) ((T*)(F.ws + (off)))

__device__ __forceinline__ int src_in(int n) {
    if (n < 2816) return n;
    if (n < 3072) { const int c = n - 2816, bj = c >> 7, wc = (c >> 5) & 3, c32 = c & 31; if (bj || wc >= 2) return -1;
        const int fq = c32 >> 3, nn = (c32 >> 2) & 1, j = c32 & 3; return 2816 + 32 * nn + 16 * wc + 4 * fq + j; }
    return n - 192;
}
__device__ __forceinline__ int src_q(int n) {
    const int G = n >> 5, c32 = n & 31, head = G / 6, g6 = G - head * 6;
    if (g6 < 4) return head * DQK + g6 * 32 + c32;
    const int fq = c32 >> 3, nn = (c32 >> 2) & 1, j = c32 & 3; return head * DQK + 128 + 32 * nn + 16 * (g6 - 4) + 4 * fq + j;
}
__device__ __forceinline__ void p0_weights(const Frame& F) {
    constexpr int TIN = 1024, TOUT = 512, TQ = 96, TKV = 64, TL = TIN + TOUT + TQ + TKV;
    LAS unsigned* T = (LAS unsigned*)F.lds;
    const int tid = F.tid, n_l = tid & 63, kp = tid >> 6;
    for (int it = F.bx; it < DEPTH * TL; it += F.G) {
        const int l = it / TL; int r = it - l * TL, kind, nt, kt, Nsrc, K; const float* W; const float* ksc = nullptr; bf16_t* Bt;
        if (r < TIN) { kind = 0; nt = r >> 4; kt = r & 15; W = F.in[5] + (size_t)l * DM * NIN; Nsrc = NIN; K = DM; Bt = WSP(bf16_t, WS_WIN) + (size_t)l * NINP * DM; }
        else if (r < TIN + TOUT) { r -= TIN; kind = 1; nt = r >> 4; kt = r & 15; W = F.in[11] + (size_t)l * DM * DM; Nsrc = DM; K = DM; Bt = WSP(bf16_t, WS_WOUT) + (size_t)l * DM * DM; }
        else if (r < TIN + TOUT + TQ) { r -= TIN + TOUT; kind = 2; nt = r >> 2; kt = r & 3; W = F.in[7] + (size_t)l * QLR * NQ; Nsrc = NQ; K = QLR; ksc = F.in[6] + l * QLR; Bt = WSP(bf16_t, WS_WQ) + (size_t)l * NQ * QLR; }
        else { r -= TIN + TOUT + TQ; kind = 3; nt = r >> 1; kt = r & 1; W = F.in[9] + (size_t)l * KVLR * NKV; Nsrc = NKV; K = KVLR; ksc = F.in[8] + l * KVLR; Bt = WSP(bf16_t, WS_WKV) + (size_t)l * NKV * KVLR; }
        const int n0 = nt * 64, k0 = kt * 128, n = n0 + n_l;
        const int src = kind == 0 ? src_in(n) : (kind == 2 ? src_q(n) : n);
        float v0[8], v1[8];
#pragma unroll
        for (int i = 0; i < 8; ++i) { const int k = k0 + 2 * (kp + 8 * i);
            v0[i] = src >= 0 ? W[(size_t)k * Nsrc + src] : 0.f; v1[i] = src >= 0 ? W[(size_t)(k + 1) * Nsrc + src] : 0.f;
            if (ksc) { v0[i] *= ksc[k]; v1[i] *= ksc[k + 1]; } }
#pragma unroll
        for (int i = 0; i < 8; ++i) T[n_l * 66 + kp + 8 * i] = cvt_pk_bf16(v0[i], v1[i]);
        __syncthreads();
#pragma unroll
        for (int i = 0; i < 2; ++i) { const int c = tid + 512 * i, nn = c >> 4, kc = c & 15;
            const u32x2 a = *(const LAS u32x2*)(T + nn * 66 + kc * 4), b = *(const LAS u32x2*)(T + nn * 66 + kc * 4 + 2);
            *(u32x4*)(Bt + (size_t)(n0 + nn) * K + k0 + kc * 8) = (u32x4){a.x, a.y, b.x, b.y}; }
        __syncthreads();
    }
}
__device__ __forceinline__ void p0_mod(const Frame& F) {
    if (F.bx >= DEPTH * 96) return;
    LAS float* sc = (LAS float*)F.lds;
    LAS float* red = (LAS float*)(F.lds + 32768);
    const int tid = F.tid;
    for (int i = tid; i < NB * DM; i += NTHREADS) sc[i] = silu_f(F.in[1][i]);
    __syncthreads();
    float* mod = WSP(float, WS_MOD);
    for (int it = F.bx; it < DEPTH * 96; it += F.G) {
        const int l = it / 96, col0 = (it - l * 96) * 64, cg = tid & 15, kl = tid >> 4;
        f32x4 acc[4] = {};
        const float* wp = F.in[3] + (size_t)l * DM * (3 * DM) + col0 + cg * 4;
        for (int k = kl; k < DM; k += 32) { const f32x4 w = *(const f32x4*)(wp + (size_t)k * (3 * DM));
#pragma unroll
            for (int b = 0; b < 4; ++b) acc[b] += w * sc[b * DM + k]; }
#pragma unroll
        for (int b = 0; b < 4; ++b)
#pragma unroll
            for (int j = 0; j < 4; ++j) red[(kl * 16 + cg) * 16 + b * 4 + j] = acc[b][j];
        __syncthreads();
        if (tid < 256) { const int cg2 = tid >> 4, v = tid & 15, b = v >> 2, j = v & 3; float s = 0.f;
            for (int q = 0; q < 32; ++q) s += red[(q * 16 + cg2) * 16 + v];
            const int col = col0 + cg2 * 4 + j; mod[(size_t)(l * NB + b) * (3 * DM) + col] = s + F.in[4][l * (3 * DM) + col]; }
        __syncthreads();
    }
}
__device__ __forceinline__ void p0_tables(const Frame& F) {
    constexpr double INVF2PI[32] = {
    0.15915494309189535, 0.11934937021124886, 0.08949940160889101, 0.06711508300522726,
    0.050329212104487035, 0.03774158471741977, 0.0283021958306234, 0.02122365276477766,
    0.015915494309189534, 0.011934937021124886, 0.008949940160889102, 0.006711508300522725,
    0.005032921210448704, 0.003774158471741977, 0.00283021958306234, 0.0021223652764777662,
    0.0015915494309189536, 0.0011934937021124885, 0.0008949940160889102, 0.0006711508300522726,
    0.0005032921210448703, 0.00037741584717419774, 0.00028302195830623395, 0.0002122365276477766,
    0.00015915494309189535, 0.00011934937021124886, 8.949940160889102e-05, 6.711508300522725e-05,
    5.0329212104487035e-05, 3.774158471741978e-05, 2.8302195830623396e-05, 2.122365276477766e-05};
    const int gid = F.bx * NTHREADS + F.tid, NT = F.G * NTHREADS;
    const int* pos = (const int*)F.in[2]; float* rc = WSP(float, WS_RCOS); float* rs = WSP(float, WS_RSIN);
    for (int idx = gid; idx < MTOK * 32; idx += NT) { const int i = idx & 31; double t = (double)pos[idx >> 5] * INVF2PI[i]; t -= floor(t);
        float sn, cs; sincospif((float)(2.0 * t), &sn, &cs); rc[idx] = cs; rs[idx] = sn; }
    bf16_t* D1 = WSP(bf16_t, WS_D1); bf16_t* D2 = WSP(bf16_t, WS_D2);
    for (int idx = gid; idx < 128 * 64; idx += NT) { const int s1 = idx & 63, rr = idx >> 6, ri = rr >> 6, s1p = rr & 63; float sn, cs; sincospif((float)((s1 * s1p) & 63) * (1.0f / 32.0f), &sn, &cs);
        D1[idx] = f2bf((ri ? -sn : cs) * 0.125f); }
    for (int idx = gid; idx < 128 * 128; idx += NT) { const int kk = idx & 127, rr = idx >> 7, ri = kk >> 6, s2 = kk & 63, ro = rr >> 6, s2p = rr & 63; float sn, cs; sincospif((float)((s2 * s2p) & 63) * (1.0f / 32.0f), &sn, &cs);
        const float v = ro == 0 ? (ri == 0 ? cs : sn) : (ri == 0 ? -sn : cs); D2[idx] = f2bf(v * 0.125f); }
    float* rsq = WSP(float, WS_RSQ);
    for (int idx = gid; idx < DEPTH * MTOK * 2; idx += NT) rsq[idx] = 0.f;
    LAS float* ct = (LAS float*)F.lds; LAS float* st = ct + 128;
    if (F.tid < 128) { float sn, cs; sincospif((float)F.tid * (1.0f / 64.0f), &sn, &cs); ct[F.tid] = cs * 0.08838834764831845f; st[F.tid] = sn * 0.08838834764831845f; }
    __syncthreads();
    bf16_t* wcat = WSP(bf16_t, WS_WCAT);
    for (int idx = gid; idx < DEPTH * NG * 128 * 256; idx += NT) { const int k = idx & 255, d = (idx >> 8) & 127, lg = idx >> 15, ro = k >> 7, c = k & 127;
        const float* w = F.in[10] + (size_t)lg * 128 * 128 + d; LAS float* tb = ro ? st : ct; float s = 0.f;
        for (int cp = 0; cp < 128; ++cp) s += tb[(c * cp) & 127] * w[cp * 128];
        wcat[idx] = f2bf(s); }
    __syncthreads();
}
__device__ __forceinline__ void row_stats(const f32x4 (&v)[8], float& mean, float& rstd) {
    float s = 0.f;
#pragma unroll
    for (int i = 0; i < 8; ++i) s += (v[i][0] + v[i][1]) + (v[i][2] + v[i][3]);
    mean = wave_sum(s) * (1.0f / DM); float q = 0.f;
#pragma unroll
    for (int i = 0; i < 8; ++i) { const f32x4 d = v[i] - mean; q += (d[0] * d[0] + d[1] * d[1]) + (d[2] * d[2] + d[3] * d[3]); }
    rstd = rsqrtf(wave_sum(q) * (1.0f / DM) + NORM_EPS);
}
__device__ __forceinline__ void p_ln_first(const Frame& F) {
    const float* x = F.in[0]; const float* mod = WSP(float, WS_MOD); bf16_t* H = WSP(bf16_t, WS_H);
    for (int row = F.bx * 8 + F.wave; row < MTOK; row += F.G * 8) {
        f32x4 v[8]; const float* xr = x + (size_t)row * DM + F.lane * 4;
#pragma unroll
        for (int i = 0; i < 8; ++i) v[i] = *(const f32x4*)(xr + i * 256);
        float mean, rstd; row_stats(v, mean, rstd);
        const float* mp = mod + (size_t)(row >> 12) * (3 * DM) + F.lane * 4;
#pragma unroll
        for (int i = 0; i < 8; ++i) { const f32x4 sh = *(const f32x4*)(mp + i * 256), sc = *(const f32x4*)(mp + DM + i * 256);
            store4_bf16(H + (size_t)row * DM + F.lane * 4 + i * 256, (v[i] - mean) * rstd * (sc + 1.0f) + sh); }
    }
}
template <bool NEXT> __device__ __forceinline__ void p_ln_post(const Frame& F, int l) {
    float* R = WSP(float, WS_R); float* dst = NEXT ? R : F.out; const float* g = F.in[12] + l * DM; const float* bb = F.in[13] + l * DM;
    const float* mod = WSP(float, WS_MOD) + (size_t)(l + 1) * NB * (3 * DM); bf16_t* H = WSP(bf16_t, WS_H);
    for (int row = F.bx * 8 + F.wave; row < MTOK; row += F.G * 8) {
        f32x4 v[8]; const float* xr = R + (size_t)row * DM + F.lane * 4;
#pragma unroll
        for (int i = 0; i < 8; ++i) v[i] = *(const f32x4*)(xr + i * 256);
        float mean, rstd; row_stats(v, mean, rstd);
#pragma unroll
        for (int i = 0; i < 8; ++i) { v[i] = (v[i] - mean) * rstd * *(const f32x4*)(g + F.lane * 4 + i * 256) + *(const f32x4*)(bb + F.lane * 4 + i * 256);
            *(f32x4*)(dst + (size_t)row * DM + F.lane * 4 + i * 256) = v[i]; }
        if (NEXT) { row_stats(v, mean, rstd); const float* mp = mod + (size_t)(row >> 12) * (3 * DM) + F.lane * 4;
#pragma unroll
            for (int i = 0; i < 8; ++i) { const f32x4 sh = *(const f32x4*)(mp + i * 256), sc = *(const f32x4*)(mp + DM + i * 256);
                store4_bf16(H + (size_t)row * DM + F.lane * 4 + i * 256, (v[i] - mean) * rstd * (sc + 1.0f) + sh); } }
    }
}
__device__ __forceinline__ void fft1_naive(const Frame& F) {
    const bf16_t* U = WSP(bf16_t, WS_U); const bf16_t* D1 = WSP(bf16_t, WS_D1); bf16_t* Z = WSP(bf16_t, WS_H);
    const int gid = F.bx * NTHREADS + F.tid, NT = F.G * NTHREADS;
    for (int idx = gid; idx < NB * 64 * NG * 64 * 128; idx += NT) {
        const int c = idx & 127, s2 = (idx >> 7) & 63, g = (idx >> 13) & 7, s1p = (idx >> 16) & 63, b = idx >> 22;
        float yr = 0.f, yi = 0.f;
        for (int s1 = 0; s1 < 64; ++s1) { const float u = bf2f(U[(size_t)(b * SEQ + 64 * s1 + s2) * DF + g * 128 + c]); yr += bf2f(D1[s1p * 64 + s1]) * u; yi += bf2f(D1[(64 + s1p) * 64 + s1]) * u; }
        float st, ct; sincospif((float)(s2 * s1p) * (1.0f / 2048.0f), &st, &ct);
        const size_t zo = ((((size_t)(b * 64 + s1p) * NG + g) * 2) * 64 + s2) * 128 + c;
        Z[zo] = f2bf(yr * ct + yi * st); Z[zo + 64 * 128] = f2bf(yi * ct - yr * st);
    }
}
__device__ __forceinline__ void fft2_naive(const Frame& F, int l) {
    const bf16_t* Z = WSP(bf16_t, WS_H); const bf16_t* D2 = WSP(bf16_t, WS_D2); const bf16_t* wcat = WSP(bf16_t, WS_WCAT) + (size_t)l * NG * 128 * 256; bf16_t* MIX = WSP(bf16_t, WS_MIX);
    LAS float* Xs = (LAS float*)F.lds;
    for (int it = F.bx; it < NB * 64 * NG; it += F.G) {
        const int g = it & 7, s1p = (it >> 3) & 63, b = it >> 9;
        const bf16_t* Zb = Z + ((size_t)(b * 64 + s1p) * NG + g) * 2 * 64 * 128;
        for (int i = 0; i < 32; ++i) { const int o = F.tid + 512 * i, c = o & 127, rr = o >> 7; float s = 0.f;
            for (int k = 0; k < 128; ++k) s += bf2f(D2[rr * 128 + k]) * bf2f(Zb[k * 128 + c]);
            Xs[rr * 128 + c] = bf2f(f2bf(s)); }
        __syncthreads();
        for (int i = 0; i < 16; ++i) { const int o = F.tid + 512 * i, d = o & 127, s2p = o >> 7; float s = 0.f;
            const bf16_t* wr = wcat + (size_t)(g * 128 + d) * 256;
            for (int k = 0; k < 256; ++k) s += Xs[((k >> 7) * 64 + s2p) * 128 + (k & 127)] * bf2f(wr[k]);
            const size_t mo = (size_t)(b * SEQ + s1p + 64 * s2p) * DM + g * 128 + d;
            MIX[mo] = f2bf(s * bf2f(MIX[mo])); }
        __syncthreads();
    }
}
__device__ __forceinline__ void attn_naive(const Frame& F) {
    const bf16_t* Q = WSP(bf16_t, WS_Q); const bf16_t* KV = WSP(bf16_t, WS_KV); const bf16_t* KR = WSP(bf16_t, WS_KR); bf16_t* MIX = WSP(bf16_t, WS_MIX);
    LAS float* qs = (LAS float*)F.lds + F.wave * 192;
    for (int it = F.bx * 8 + F.wave; it < MTOK * NH * 2; it += F.G * 8) {
        const int dh = it & 1, h = (it >> 1) & 7, tok = it >> 4, b = tok >> 12;
        __builtin_amdgcn_wave_barrier(); asm volatile("" ::: "memory");
        for (int e = 0; e < 3; ++e) qs[F.lane + 64 * e] = bf2f(Q[(size_t)tok * NQ + h * DQK + F.lane + 64 * e]);
        asm volatile("s_waitcnt lgkmcnt(0)" ::: "memory"); __builtin_amdgcn_wave_barrier();
        float m = -1e30f, lsum = 0.f; float o[64];
#pragma unroll
        for (int d = 0; d < 64; ++d) o[d] = 0.f;
        for (int t = 0; t < 64; ++t) {
            const size_t key = (size_t)b * SEQ + F.lane + 64 * t; const bf16_t* kn = KV + key * NKV + h * 256; const bf16_t* kr = KR + key * 64;
            float s = 0.f;
#pragma unroll 2
            for (int c = 0; c < 16; ++c) { const bf16x8 kv = *(const bf16x8*)(kn + c * 8);
#pragma unroll
                for (int e = 0; e < 8; ++e) s += qs[c * 8 + e] * bf2f((bf16_t)kv[e]); }
#pragma unroll 2
            for (int c = 0; c < 8; ++c) { const bf16x8 kv = *(const bf16x8*)(kr + c * 8);
#pragma unroll
                for (int e = 0; e < 8; ++e) s += qs[128 + c * 8 + e] * bf2f((bf16_t)kv[e]); }
            s *= ATT_SCALE; const float mn = fmaxf(m, s), a = __expf(m - mn), p = __expf(s - mn); lsum = lsum * a + p; m = mn;
#pragma unroll
            for (int c = 0; c < 8; ++c) { const bf16x8 vv = *(const bf16x8*)(kn + 128 + dh * 64 + c * 8);
#pragma unroll
                for (int e = 0; e < 8; ++e) o[c * 8 + e] = o[c * 8 + e] * a + p * bf2f((bf16_t)vv[e]); }
        }
        const float Mx = wave_max(m), f = __expf(m - Mx); const float L = wave_sum(lsum * f);
        float keep0 = 0.f;
#pragma unroll
        for (int d = 0; d < 64; ++d) { const float od = wave_sum(o[d] * f); if (F.lane == d) keep0 = od; }
        const size_t mo = (size_t)tok * DM + DF + h * 128 + dh * 64 + F.lane;
        MIX[mo] = f2bf(keep0 / L * bf2f(MIX[mo]));
    }
}
namespace att {
constexpr int NW = 8, QBLK = 32, KVBLK = 64;
#ifndef ATT_SDEPTH
#define ATT_SDEPTH 1
#endif
constexpr int SDEPTH = ATT_SDEPTH;
constexpr float THR = 8.f;
constexpr int SHM_V = KVBLK * 128 * 2, SHM_KN = KVBLK * 128 * 2, SHM_KR = KVBLK * 64 * 2;
#ifndef ATT_QLDS
#define ATT_QLDS 0
#endif
constexpr int QLDS = ATT_QLDS, QREG = 12 - QLDS;
constexpr int OFF_V = 0, OFF_KN = 2 * SHM_V, OFF_KR = OFF_KN + 2 * SHM_KN, OFF_WS = OFF_KR + 2 * SHM_KR, OFF_QL = OFF_WS + NW * 64 * 4, SHM_ATTN = OFF_QL + NW * QLDS * 1024;
static_assert(SHM_ATTN <= RING_BYTES, "attention LDS must fit the phase scratch");
#define KSWZ(row, colB) ((row) * 256 + ((colB) ^ (((row) & 15) << 4)))
#define RSWZ(row, ch) ((row) * 128 + ((((ch) ^ (((row) >> 1) & 7))) << 4))
#define SBAR() __builtin_amdgcn_sched_barrier(0)
__device__ __forceinline__ int crow(int r, int hi) { return (r & 3) + 8 * (r >> 2) + 4 * hi; }
__device__ __forceinline__ unsigned cvtpk(float lo, float hi) { unsigned r; asm volatile("v_cvt_pk_bf16_f32 %0, %1, %2" : "=v"(r) : "v"(lo), "v"(hi)); return r; }
__device__ __forceinline__ bf16x8 ld8(const bf16_t* p) { return *reinterpret_cast<const bf16x8*>(p); }

__device__ __forceinline__ void partialSM(f32x16& p0, f32x16& p1, float& m_reg, float& mn, float& alpha) {
  constexpr float C = ATT_SCALE * 1.4426950408889634f;
  float pmax = p0[0]; for (int r = 1; r < 16; ++r) pmax = fmaxf(pmax, p0[r]); for (int r = 0; r < 16; ++r) pmax = fmaxf(pmax, p1[r]);
  { auto rr = __builtin_amdgcn_permlane32_swap(__float_as_uint(pmax), __float_as_uint(pmax), false, false);
    pmax = fmaxf(__uint_as_float(rr[0]), __uint_as_float(rr[1])); }
  if (__builtin_expect(__all(pmax - m_reg <= THR / ATT_SCALE), 1)) { mn = m_reg; alpha = 1.f; }
  else { mn = fmaxf(m_reg, pmax); alpha = __builtin_amdgcn_exp2f((m_reg - mn) * C); m_reg = mn; }
  float mnC = -mn * C;
  for (int r = 0; r < 16; ++r) p0[r] = fmaf(p0[r], C, mnC); for (int r = 0; r < 16; ++r) p1[r] = fmaf(p1[r], C, mnC);
  for (int r = 0; r < 16; ++r) p0[r] = __builtin_amdgcn_exp2f(p0[r]);
}
__device__ __forceinline__ void finishSM(f32x16& p0, f32x16& p1, float alpha, float& l_reg, bf16x8& pa0, bf16x8& pa1, bf16x8& pa2, bf16x8& pa3) {
  for (int r = 0; r < 16; ++r) p1[r] = __builtin_amdgcn_exp2f(p1[r]);
  float ps = 0; for (int r = 0; r < 16; ++r) ps += p0[r]; for (int r = 0; r < 16; ++r) ps += p1[r];
  { auto rr = __builtin_amdgcn_permlane32_swap(__float_as_uint(ps), __float_as_uint(ps), false, false);
    ps = __uint_as_float(rr[0]) + __uint_as_float(rr[1]); }
  l_reg = l_reg * alpha + ps;
#define PK4(P, BASE, OUT) do { unsigned a0 = cvtpk(P[BASE + 0], P[BASE + 1]), a1 = cvtpk(P[BASE + 2], P[BASE + 3]);   \
    unsigned b0 = cvtpk(P[BASE + 4], P[BASE + 5]), b1 = cvtpk(P[BASE + 6], P[BASE + 7]);                              \
    auto r0 = __builtin_amdgcn_permlane32_swap(a0, b0, false, false); auto r1 = __builtin_amdgcn_permlane32_swap(a1, b1, false, false); \
    u32x4 w = {r0[0], r1[0], r0[1], r1[1]}; OUT = *reinterpret_cast<bf16x8*>(&w); } while (0)
  PK4(p0, 0, pa0); PK4(p0, 8, pa1); PK4(p1, 0, pa2); PK4(p1, 8, pa3);
#undef PK4
}
__device__ __forceinline__ bf16x8 qfrag(const bf16x8* qr, const char* ql, int d0) { return *reinterpret_cast<const bf16x8*>(ql + (d0 - QREG) * 1024); }
__device__ __forceinline__ void qkt(f32x16& p0, f32x16& p1, const char* Kn, const char* Kr, const bf16x8* qr, const char* ql, int r32, int hi) {
  p0 = f32x16{}; p1 = f32x16{};
#pragma unroll
  for (int d0 = 0; d0 < 8; ++d0) { int cb = (d0 * 16 + hi * 8) * 2;
    bf16x8 b0 = *reinterpret_cast<const bf16x8*>(Kn + KSWZ(r32, cb));
    bf16x8 b1 = *reinterpret_cast<const bf16x8*>(Kn + KSWZ(32 + r32, cb));
    bf16x8 q = d0 < QREG ? qr[d0 < QREG ? d0 : 0] : qfrag(qr, ql, d0);
    p0 = __builtin_amdgcn_mfma_f32_32x32x16_bf16(b0, q, p0, 0, 0, 0);
    p1 = __builtin_amdgcn_mfma_f32_32x32x16_bf16(b1, q, p1, 0, 0, 0); }
#pragma unroll
  for (int d0 = 0; d0 < 4; ++d0) { int ch = d0 * 2 + hi;
    bf16x8 b0 = *reinterpret_cast<const bf16x8*>(Kr + RSWZ(r32, ch));
    bf16x8 b1 = *reinterpret_cast<const bf16x8*>(Kr + RSWZ(32 + r32, ch));
    bf16x8 q = (8 + d0) < QREG ? qr[(8 + d0) < QREG ? (8 + d0) : 0] : qfrag(qr, ql, 8 + d0);
    p0 = __builtin_amdgcn_mfma_f32_32x32x16_bf16(b0, q, p0, 0, 0, 0);
    p1 = __builtin_amdgcn_mfma_f32_32x32x16_bf16(b1, q, p1, 0, 0, 0); }
}
__device__ __forceinline__ int v_st(int k, int c) { const int kk = (k & ~0xC) | ((k & 4) << 1) | ((k & 8) >> 1); return ((kk >> 3) * 4 + (c >> 5)) * 512 + ((kk & 7) * 32 + (c & 31)) * 2; }
__device__ __forceinline__ int v_rd_base(int lane) { return ((lane & 3) << 3) | (((lane >> 2) & 3) << 6) | (((lane >> 4) & 1) << 5) | (((lane >> 5) & 1) << 8); }
constexpr int v_rd_off(int d0, int ks, int half) { return d0 * 512 + ks * 4096 + half * 2048; }
template <int OFF> __device__ __forceinline__ s16x4 tr_read(int vb) {
  s16x4 r; asm volatile("ds_read_b64_tr_b16 %0, %1 offset:%2" : "=&v"(r) : "v"(vb), "i"(OFF) : "memory"); return r;
}
#define TRPK(L, H) (bf16x8){L[0], L[1], L[2], L[3], H[0], H[1], H[2], H[3]}
template <int D0> __device__ __forceinline__ void pv_one(f32x16& od, int vb, bf16x8 pa0, bf16x8 pa1, bf16x8 pa2, bf16x8 pa3) {
  const s16x4 l0 = tr_read<v_rd_off(D0, 0, 0)>(vb), h0 = tr_read<v_rd_off(D0, 0, 1)>(vb), l1 = tr_read<v_rd_off(D0, 1, 0)>(vb), h1 = tr_read<v_rd_off(D0, 1, 1)>(vb);
  const s16x4 l2 = tr_read<v_rd_off(D0, 2, 0)>(vb), h2 = tr_read<v_rd_off(D0, 2, 1)>(vb), l3 = tr_read<v_rd_off(D0, 3, 0)>(vb), h3 = tr_read<v_rd_off(D0, 3, 1)>(vb);
  asm volatile("s_waitcnt lgkmcnt(0)" ::: "memory"); SBAR();
  od = __builtin_amdgcn_mfma_f32_32x32x16_bf16(pa0, TRPK(l0, h0), od, 0, 0, 0);
  od = __builtin_amdgcn_mfma_f32_32x32x16_bf16(pa1, TRPK(l1, h1), od, 0, 0, 0);
  od = __builtin_amdgcn_mfma_f32_32x32x16_bf16(pa2, TRPK(l2, h2), od, 0, 0, 0);
  od = __builtin_amdgcn_mfma_f32_32x32x16_bf16(pa3, TRPK(l3, h3), od, 0, 0, 0);
}
__device__ __forceinline__ void pv_d0(f32x16* o, int vb, bf16x8 pa0, bf16x8 pa1, bf16x8 pa2, bf16x8 pa3) {
  pv_one<0>(o[0], vb, pa0, pa1, pa2, pa3); pv_one<1>(o[1], vb, pa0, pa1, pa2, pa3); pv_one<2>(o[2], vb, pa0, pa1, pa2, pa3); pv_one<3>(o[3], vb, pa0, pa1, pa2, pa3);
}

__device__ __forceinline__ void attn_body(const bf16_t* __restrict__ Qb, const bf16_t* __restrict__ Kn, const bf16_t* __restrict__ Kr,
                                          bf16_t* __restrict__ Gm, int seq, char* lds, int tid) {
  const int wid = tid >> 6, lane = tid & 63, r32 = lane & 31, hi = lane >> 5;
  char* V_lds = lds + OFF_V; char* K_lds = lds + OFF_KN; char* R_lds = lds + OFF_KR;
  float* ws = (float*)(lds + OFF_WS) + wid * 64; float* li_l = ws; float* al_l = ws + 32;
  float m_reg = -1e30f, l_reg = 0; f32x16 o[4] = {}; bf16x8 qr[QREG > 0 ? QREG : 1];
  char* ql = lds + OFF_QL + wid * (QLDS * 1024) + lane * 16;
  const unsigned qoff = (unsigned)((wid * QBLK + r32) * NQ + hi * 8) * 2u;
#pragma unroll
  for (int d0 = 0; d0 < 12; ++d0) { const bf16x8 qv = *(const bf16x8*)((const char*)Qb + qoff + d0 * 32); if (d0 < QREG) qr[d0 < QREG ? d0 : 0] = qv; else *reinterpret_cast<bf16x8*>(ql + (d0 - QREG) * 1024) = qv; }
  const int sr = tid >> 4, sc = (tid & 15) * 8, vst0 = v_st(sr, sc), vst1 = v_st(32 + sr, sc);
  const int rr_ = tid >> 3, rc_ = tid & 7;
  const int vb0 = (int)(uintptr_t)V_lds + v_rd_base(lane);
  struct { bf16x8 vs0, vs1, ks0, ks1, kr; } sr_[SDEPTH];
  const unsigned voff = (unsigned)(sr * NKV + sc) * 2u, voffr = (unsigned)(rr_ * 64 + rc_ * 8) * 2u;
#define SLOAD(i, k0) do { const char* kb_ = (const char*)(Kn + (long)(k0) * NKV); const char* rb_ = (const char*)(Kr + (long)(k0) * 64); \
    sr_[i].vs0 = *(const bf16x8*)(kb_ + 256 + voff); sr_[i].vs1 = *(const bf16x8*)(kb_ + (32 * NKV * 2 + 256) + voff); \
    sr_[i].ks0 = *(const bf16x8*)(kb_ + voff); sr_[i].ks1 = *(const bf16x8*)(kb_ + 32 * NKV * 2 + voff); \
    sr_[i].kr = *(const bf16x8*)(rb_ + voffr); } while (0)
#define SWRITE(b, i) do { *(bf16x8*)(V_lds + (b) * SHM_V + vst0) = sr_[i].vs0;          \
    *(bf16x8*)(V_lds + (b) * SHM_V + vst1) = sr_[i].vs1; int kc = sc * 2;               \
    *(bf16x8*)(K_lds + (b) * SHM_KN + KSWZ(sr, kc)) = sr_[i].ks0;                       \
    *(bf16x8*)(K_lds + (b) * SHM_KN + KSWZ(32 + sr, kc)) = sr_[i].ks1;                  \
    *(bf16x8*)(R_lds + (b) * SHM_KR + RSWZ(rr_, rc_)) = sr_[i].kr; } while (0)
#define SWAIT() do { if constexpr (SDEPTH == 2) asm volatile("s_waitcnt vmcnt(5)" ::: "memory"); else asm volatile("s_waitcnt vmcnt(0)" ::: "memory"); } while (0)
#define RESC(a) do { if (__any((a) < 1.f)) { if (hi == 0) al_l[r32] = (a); asm volatile("s_waitcnt lgkmcnt(0)" ::: "memory"); \
    for (int d = 0; d < 4; ++d) for (int r = 0; r < 16; ++r) o[d][r] *= al_l[crow(r, hi)]; } } while (0)
  f32x16 pA0, pA1, pB0, pB1; float mnA, mnB, alA, alB; bf16x8 pa0, pa1, pa2, pa3; const int NT = seq / KVBLK;
  constexpr int SE = 0, SO = SDEPTH - 1;
  SLOAD(SE, 0); asm volatile("s_waitcnt vmcnt(0)" ::: "memory"); SWRITE(0, SE); __syncthreads();
  qkt(pA0, pA1, K_lds, R_lds, qr, ql, r32, hi); partialSM(pA0, pA1, m_reg, mnA, alA);
  SLOAD(SO, KVBLK); if constexpr (SDEPTH == 2) { if (2 < NT) SLOAD(SE, 2 * KVBLK); }
  SWAIT(); SWRITE(1, SO); __syncthreads();
  for (int j = 1; j + 1 < NT; j += 2) {
    SBAR(); qkt(pB0, pB1, K_lds + SHM_KN, R_lds + SHM_KR, qr, ql, r32, hi);
    finishSM(pA0, pA1, alA, l_reg, pa0, pa1, pa2, pa3); SBAR();
    SLOAD(SO, (j + SDEPTH) * KVBLK); SBAR();
    pv_d0(o, vb0, pa0, pa1, pa2, pa3); partialSM(pB0, pB1, m_reg, mnB, alB);
    __syncthreads(); SWAIT(); SWRITE(0, SE);
    RESC(alB); __syncthreads();
    SBAR(); qkt(pA0, pA1, K_lds, R_lds, qr, ql, r32, hi);
    finishSM(pB0, pB1, alB, l_reg, pa0, pa1, pa2, pa3); SBAR();
    if (SDEPTH == 1 || j + 3 < NT) SLOAD(SE, (j + 1 + SDEPTH) * KVBLK); SBAR();
    pv_d0(o, vb0 + (int)SHM_V, pa0, pa1, pa2, pa3); partialSM(pA0, pA1, m_reg, mnA, alA);
    __syncthreads(); SWAIT(); SWRITE(1, SO);
    RESC(alA); __syncthreads();
  }
  SBAR(); qkt(pB0, pB1, K_lds + SHM_KN, R_lds + SHM_KR, qr, ql, r32, hi);
  finishSM(pA0, pA1, alA, l_reg, pa0, pa1, pa2, pa3); SBAR();
  pv_d0(o, vb0, pa0, pa1, pa2, pa3); partialSM(pB0, pB1, m_reg, mnB, alB);
  __syncthreads(); RESC(alB);
  finishSM(pB0, pB1, alB, l_reg, pa0, pa1, pa2, pa3); SBAR();
  pv_d0(o, vb0 + (int)SHM_V, pa0, pa1, pa2, pa3);
  if (hi == 0) li_l[r32] = l_reg; asm volatile("s_waitcnt lgkmcnt(0)" ::: "memory");
  float rli[16];
#pragma unroll
  for (int r = 0; r < 16; ++r) rli[r] = __builtin_amdgcn_rcpf(li_l[crow(r, hi)]);
  const unsigned goff = (unsigned)((wid * QBLK + 4 * hi) * DM + r32) * 2u;
#pragma unroll
  for (int r = 0; r < 16; ++r) { char* gr = (char*)Gm + (size_t)((r & 3) + 8 * (r >> 2)) * (DM * 2);
#pragma unroll
    for (int d0 = 0; d0 < 4; ++d0) { bf16_t* gp = (bf16_t*)(gr + goff + d0 * 64); *gp = f2bf(o[d0][r] * rli[r] * bf2f(*gp)); }
    asm volatile("" ::: "memory"); }
#undef SLOAD
#undef SWRITE
#undef SWAIT
#undef RESC
}
}

__device__ __forceinline__ void attn_fast(const Frame& F) {
    const bf16_t* Q = WSP(bf16_t, WS_Q); const bf16_t* KV = WSP(bf16_t, WS_KV); const bf16_t* KR = WSP(bf16_t, WS_KR); bf16_t* MIX = WSP(bf16_t, WS_MIX);
    for (int it = F.vcu; it < NB * NH * (SEQ / 256); it += F.G) {
        const int qb = it & 15, p = it >> 4, h = p & 7, b = p >> 3;
        const size_t t0 = (size_t)b * SEQ, q0 = t0 + (size_t)qb * 256;
        int t = F.tid; asm volatile("" : "+v"(t));
        att::attn_body(Q + q0 * NQ + h * DQK, KV + t0 * NKV + h * 256, KR + t0 * 64, MIX + q0 * DM + DF + h * 128, SEQ, F.ldsg, t);
        __syncthreads();
    }
}
namespace fft {
using att::v_st; using att::v_rd_base; using att::v_rd_off; using att::tr_read; using att::crow;
constexpr int OPITCH = 272;
constexpr int F1_T = 0, F1_OUT = 16384, F1_END = F1_OUT + 128 * OPITCH;
constexpr int XPITCH = 528;
constexpr int F2_Z = 0, F2_XL = 32768, F2_YL = F2_XL + 64 * XPITCH, F2_D2 = F2_YL + 64 * XPITCH, F2_END = F2_D2 + 128 * OPITCH;
static_assert(F1_END <= RING_BYTES && F2_END <= RING_BYTES, "FFT LDS must fit the phase scratch");
}
__device__ __forceinline__ void fft1_fast(const Frame& F) {
    using namespace fft;
    const bf16_t* U = WSP(bf16_t, WS_U); const bf16_t* D1 = WSP(bf16_t, WS_D1); bf16_t* Z = WSP(bf16_t, WS_H);
    const int tid = F.tid, wid = tid >> 6, lane = tid & 63, r32 = lane & 31, hi = lane >> 5, half = wid & 1, cb = wid >> 1;
    char* lds = F.ldsg;
    bf16x8 bfr[2][4];
#pragma unroll
    for (int ri = 0; ri < 2; ++ri)
#pragma unroll
        for (int ks = 0; ks < 4; ++ks) bfr[ri][ks] = *(const bf16x8*)(D1 + (ri * 64 + half * 32 + r32) * 64 + 16 * ks + 8 * hi);
    const int sr = tid >> 4, sc = (tid & 15) * 8, vst0 = v_st(sr, sc), vst1 = v_st(32 + sr, sc);
    const int vb = (int)(uintptr_t)(lds + F1_T) + v_rd_base(lane) + cb * 512;
    const int s1p = half * 32 + r32;
    int it = F.bx; if (it >= NB * 64 * NG) return;
    bf16x8 u0, u1;
#define F1_LOAD(IT) do { const int g_ = (IT) & 7, s2_ = ((IT) >> 3) & 63, b_ = (IT) >> 9; const bf16_t* up = U + ((size_t)(b_ * SEQ + s2_)) * DF + g_ * 128 + sc; \
        u0 = *(const bf16x8*)(up + (size_t)(64 * sr) * DF); u1 = *(const bf16x8*)(up + (size_t)(64 * (sr + 32)) * DF); } while (0)
    F1_LOAD(it);
    for (; it < NB * 64 * NG; it += F.G) {
        const int g = it & 7, s2 = (it >> 3) & 63, b = it >> 9;
        *(bf16x8*)(lds + F1_T + vst0) = u0; *(bf16x8*)(lds + F1_T + vst1) = u1;
        __syncthreads();
        if (it + F.G < NB * 64 * NG) F1_LOAD(it + F.G);
        f32x16 acc0 = {}, acc1 = {};
        { const s16x4 l0 = tr_read<v_rd_off(0, 0, 0)>(vb), h0 = tr_read<v_rd_off(0, 0, 1)>(vb), l1 = tr_read<v_rd_off(0, 1, 0)>(vb), h1 = tr_read<v_rd_off(0, 1, 1)>(vb);
          const s16x4 l2 = tr_read<v_rd_off(0, 2, 0)>(vb), h2 = tr_read<v_rd_off(0, 2, 1)>(vb), l3 = tr_read<v_rd_off(0, 3, 0)>(vb), h3 = tr_read<v_rd_off(0, 3, 1)>(vb);
          asm volatile("s_waitcnt lgkmcnt(0)" ::: "memory"); __builtin_amdgcn_sched_barrier(0);
          acc0 = __builtin_amdgcn_mfma_f32_32x32x16_bf16(TRPK(l0, h0), bfr[0][0], acc0, 0, 0, 0); acc1 = __builtin_amdgcn_mfma_f32_32x32x16_bf16(TRPK(l0, h0), bfr[1][0], acc1, 0, 0, 0);
          acc0 = __builtin_amdgcn_mfma_f32_32x32x16_bf16(TRPK(l1, h1), bfr[0][1], acc0, 0, 0, 0); acc1 = __builtin_amdgcn_mfma_f32_32x32x16_bf16(TRPK(l1, h1), bfr[1][1], acc1, 0, 0, 0);
          acc0 = __builtin_amdgcn_mfma_f32_32x32x16_bf16(TRPK(l2, h2), bfr[0][2], acc0, 0, 0, 0); acc1 = __builtin_amdgcn_mfma_f32_32x32x16_bf16(TRPK(l2, h2), bfr[1][2], acc1, 0, 0, 0);
          acc0 = __builtin_amdgcn_mfma_f32_32x32x16_bf16(TRPK(l3, h3), bfr[0][3], acc0, 0, 0, 0); acc1 = __builtin_amdgcn_mfma_f32_32x32x16_bf16(TRPK(l3, h3), bfr[1][3], acc1, 0, 0, 0); }
        float st, ct; sincospif((float)(s2 * s1p) * (1.0f / 2048.0f), &st, &ct);
        char* o0 = lds + F1_OUT + s1p * OPITCH + (cb * 32 + 4 * hi) * 2; char* o1 = o0 + 64 * OPITCH;
#pragma unroll
        for (int q = 0; q < 4; ++q) { float zr[4], zi[4];
#pragma unroll
            for (int j = 0; j < 4; ++j) { const float yr = acc0[4 * q + j], yi = acc1[4 * q + j]; zr[j] = yr * ct + yi * st; zi[j] = yi * ct - yr * st; }
            *(u32x2*)(o0 + q * 16) = (u32x2){cvt_pk_bf16(zr[0], zr[1]), cvt_pk_bf16(zr[2], zr[3])};
            *(u32x2*)(o1 + q * 16) = (u32x2){cvt_pk_bf16(zi[0], zi[1]), cvt_pk_bf16(zi[2], zi[3])}; }
        __syncthreads();
#pragma unroll
        for (int i = 0; i < 4; ++i) { const int q = tid + 512 * i, row = q >> 4, c16 = q & 15, ri = row >> 6, sp = row & 63;
            const u32x4 v = *(const u32x4*)(lds + F1_OUT + row * OPITCH + c16 * 16);
            *(u32x4*)(Z + (((((size_t)(b * 64 + sp) * NG + g) * 2 + ri) * 64 + s2) * 128) + c16 * 8) = v; }
    }
#undef F1_LOAD
    __syncthreads();
}
__device__ __forceinline__ void fft2_fast(const Frame& F, int l) {
    using namespace fft;
    const bf16_t* Z = WSP(bf16_t, WS_H); const bf16_t* D2 = WSP(bf16_t, WS_D2); const bf16_t* wcat = WSP(bf16_t, WS_WCAT) + (size_t)l * NG * 128 * 256; bf16_t* MIX = WSP(bf16_t, WS_MIX);
    const int tid = F.tid, wid = tid >> 6, lane = tid & 63, r32 = lane & 31, hi = lane >> 5, cb = wid & 3, h2 = wid >> 2;
    char* lds = F.ldsg;
    int it = F.bx; if (it >= NB * 64 * NG) return;
#pragma unroll
    for (int i = 0; i < 4; ++i) { const int q = tid + 512 * i, row = q >> 4, c16 = q & 15; *(u32x4*)(lds + F2_D2 + row * OPITCH + c16 * 16) = *(const u32x4*)(D2 + row * 128 + c16 * 8); }
    const int sr = tid >> 4, sc = (tid & 15) * 8, vst0 = v_st(sr, sc), vst1 = v_st(32 + sr, sc);
    const int vb = (int)(uintptr_t)(lds + F2_Z) + v_rd_base(lane) + cb * 512;
    bf16x8 wfr[16]; int gcur = -1;
    bf16x8 z0, z1, z2, z3, g0, g1;
#define F2_LOAD(IT) do { const int g_ = (IT) & 7, sp_ = ((IT) >> 3) & 63, b_ = (IT) >> 9; const bf16_t* zp = Z + ((size_t)(b_ * 64 + sp_) * NG + g_) * (2 * 64 * 128) + sr * 128 + sc; \
        z0 = *(const bf16x8*)(zp); z1 = *(const bf16x8*)(zp + 32 * 128); z2 = *(const bf16x8*)(zp + 64 * 128); z3 = *(const bf16x8*)(zp + 96 * 128); \
        const bf16_t* mp = MIX + ((size_t)(b_ * SEQ + sp_ + 64 * (tid >> 4))) * DM + g_ * 128 + (tid & 15) * 8; g0 = *(const bf16x8*)(mp); g1 = *(const bf16x8*)(mp + (size_t)(64 * 32) * DM); } while (0)
    F2_LOAD(it);
    for (; it < NB * 64 * NG; it += F.G) {
        const int g = it & 7, sp = (it >> 3) & 63, b = it >> 9;
        if (g != gcur) { gcur = g;
#pragma unroll
            for (int ks = 0; ks < 16; ++ks) wfr[ks] = *(const bf16x8*)(wcat + (size_t)(g * 128 + cb * 32 + r32) * 256 + 16 * ks + 8 * hi); }
        *(bf16x8*)(lds + F2_Z + vst0) = z0; *(bf16x8*)(lds + F2_Z + vst1) = z1; *(bf16x8*)(lds + F2_Z + 16384 + vst0) = z2; *(bf16x8*)(lds + F2_Z + 16384 + vst1) = z3;
        const bf16x8 gg0 = g0, gg1 = g1;
        __syncthreads();
        if (it + F.G < NB * 64 * NG) F2_LOAD(it + F.G);
#if defined(FFT2_P1_NAIVE)
        { const bf16_t* Zb = Z + ((size_t)(b * 64 + sp) * NG + g) * (2 * 64 * 128);
          for (int i = 0; i < 32; ++i) { const int o = tid + 512 * i, c = o & 127, rr = o >> 7; float s_ = 0.f;
              for (int k = 0; k < 128; ++k) s_ += bf2f(D2[rr * 128 + k]) * bf2f(Zb[k * 128 + c]);
              *(bf16_t*)(lds + F2_XL + (rr & 63) * XPITCH + ((rr >> 6) * 128 + c) * 2) = f2bf(s_); } }
#else
        f32x16 x0 = {}, x1 = {};
        const char* d2p = lds + F2_D2 + (h2 * 32 + r32) * OPITCH + 16 * hi;
#pragma unroll
        for (int t = 0; t < 2; ++t) {
            const int vbt = vb + t * 16384;
            const s16x4 l0 = tr_read<v_rd_off(0, 0, 0)>(vbt), h0 = tr_read<v_rd_off(0, 0, 1)>(vbt), l1 = tr_read<v_rd_off(0, 1, 0)>(vbt), h1 = tr_read<v_rd_off(0, 1, 1)>(vbt);
            const s16x4 l2 = tr_read<v_rd_off(0, 2, 0)>(vbt), h2_ = tr_read<v_rd_off(0, 2, 1)>(vbt), l3 = tr_read<v_rd_off(0, 3, 0)>(vbt), h3 = tr_read<v_rd_off(0, 3, 1)>(vbt);
            bf16x8 e0[4], e1[4];
#pragma unroll
            for (int ks = 0; ks < 4; ++ks) { e0[ks] = *(const bf16x8*)(d2p + (t * 4 + ks) * 32); e1[ks] = *(const bf16x8*)(d2p + 64 * OPITCH + (t * 4 + ks) * 32); }
            asm volatile("s_waitcnt lgkmcnt(0)" ::: "memory"); __builtin_amdgcn_sched_barrier(0);
            x0 = __builtin_amdgcn_mfma_f32_32x32x16_bf16(TRPK(l0, h0), e0[0], x0, 0, 0, 0); x1 = __builtin_amdgcn_mfma_f32_32x32x16_bf16(TRPK(l0, h0), e1[0], x1, 0, 0, 0);
            x0 = __builtin_amdgcn_mfma_f32_32x32x16_bf16(TRPK(l1, h1), e0[1], x0, 0, 0, 0); x1 = __builtin_amdgcn_mfma_f32_32x32x16_bf16(TRPK(l1, h1), e1[1], x1, 0, 0, 0);
            x0 = __builtin_amdgcn_mfma_f32_32x32x16_bf16(TRPK(l2, h2_), e0[2], x0, 0, 0, 0); x1 = __builtin_amdgcn_mfma_f32_32x32x16_bf16(TRPK(l2, h2_), e1[2], x1, 0, 0, 0);
            x0 = __builtin_amdgcn_mfma_f32_32x32x16_bf16(TRPK(l3, h3), e0[3], x0, 0, 0, 0); x1 = __builtin_amdgcn_mfma_f32_32x32x16_bf16(TRPK(l3, h3), e1[3], x1, 0, 0, 0);
        }
        { char* xr = lds + F2_XL + (h2 * 32 + r32) * XPITCH + (cb * 32 + 4 * hi) * 2;
#pragma unroll
          for (int q = 0; q < 4; ++q) { *(u32x2*)(xr + q * 16) = (u32x2){cvt_pk_bf16(x0[4 * q], x0[4 * q + 1]), cvt_pk_bf16(x0[4 * q + 2], x0[4 * q + 3])};
              *(u32x2*)(xr + 256 + q * 16) = (u32x2){cvt_pk_bf16(x1[4 * q], x1[4 * q + 1]), cvt_pk_bf16(x1[4 * q + 2], x1[4 * q + 3])}; } }
#endif
        __syncthreads();
#if defined(FFT2_P2_NAIVE)
        for (int i = 0; i < 16; ++i) { const int o = tid + 512 * i, d = o & 127, s2p = o >> 7; float s_ = 0.f;
            const bf16_t* wr_ = wcat + (size_t)(g * 128 + d) * 256;
            for (int k = 0; k < 256; ++k) s_ += bf2f(*(const bf16_t*)(lds + F2_XL + s2p * XPITCH + k * 2)) * bf2f(wr_[k]);
            *(float*)(lds + F2_YL + s2p * XPITCH + d * 4) = s_; }
#else
        f32x16 y = {};
        { const char* xb = lds + F2_XL + (h2 * 32 + r32) * XPITCH + 16 * hi;
#pragma unroll
          for (int ks = 0; ks < 16; ++ks) { const bf16x8 xf = *(const bf16x8*)(xb + ks * 32); y = __builtin_amdgcn_mfma_f32_32x32x16_bf16(wfr[ks], xf, y, 0, 0, 0); } }
        { char* yr = lds + F2_YL + (h2 * 32 + r32) * XPITCH + (cb * 32 + 4 * hi) * 4;
#pragma unroll
          for (int q = 0; q < 4; ++q) *(f32x4*)(yr + q * 32) = (f32x4){y[4 * q], y[4 * q + 1], y[4 * q + 2], y[4 * q + 3]}; }
#endif
        __syncthreads();
#pragma unroll
        for (int i = 0; i < 2; ++i) { const int row = (tid >> 4) + 32 * i, c8 = (tid & 15) * 8; const bf16x8 gv = i ? gg1 : gg0;
            const f32x4 ya = *(const f32x4*)(lds + F2_YL + row * XPITCH + c8 * 4), yb = *(const f32x4*)(lds + F2_YL + row * XPITCH + c8 * 4 + 16);
            f32x4 ga = {bf2f((bf16_t)gv[0]), bf2f((bf16_t)gv[1]), bf2f((bf16_t)gv[2]), bf2f((bf16_t)gv[3])}, gb = {bf2f((bf16_t)gv[4]), bf2f((bf16_t)gv[5]), bf2f((bf16_t)gv[6]), bf2f((bf16_t)gv[7])};
            store8_bf16(MIX + ((size_t)(b * SEQ + sp + 64 * row)) * DM + g * 128 + c8, ya * ga, yb * gb); }
    }
#undef F2_LOAD
    __syncthreads();
}
#ifndef DIAG_ONLY
#define DIAG_ONLY -1
#endif
#define DIAG_EN(k) (DIAG_ONLY < 0 || DIAG_ONLY == (k))
struct Args { const float* in[14]; float* out; unsigned char* ws; int ph_lo, ph_hi; };
constexpr int N_PHASES = 2 + 5 * DEPTH;

template <class Epi, class Sched> __device__ __forceinline__ void run_gemm(const Frame& F, const pg8::Gemm& g, const Sched& S, const Epi& E) {
#if IMPL_GEMM
    pg8::gemm_phase<Epi, Sched, PG8_ALIGN, PG8_SP2>(F.lds, g, S, E, F.tid);
#else
    pg8::gemm_phase_naive<Epi, Sched>(g, S, E, F.tid);
#endif
}

#define PH_IN(k) (lo <= (k) && (k) < hi)
#define PH_SEAM(k) do { if (PH_IN(k) && PH_IN((k) + 1)) xcd_barrier(bar); } while (0)
#define PH_ENTER() do { int _t = threadIdx.x; asm volatile("" : "+v"(_t)); F.tid = _t; F.lane = _t & 63; } while (0)

template <int L> __device__ __forceinline__ void layer_phases(Frame& F, const int lo, const int hi, const XcdBarrier& bar) {
    constexpr int P = 2 + 5 * L;
    float* rsq = WSP(float, WS_RSQ) + (size_t)L * MTOK * 2;
    if (PH_IN(P + 0) && DIAG_EN(2)) {
        PH_ENTER();
        pg8::Gemm g{WSP(bf16_t, WS_H), WSP(bf16_t, WS_WIN) + (size_t)L * NINP * DM, MTOK, NINP, DM};
        pg8::StaticOrder S; S.init(MTOK, NINP, F.G, F.bx);
        EpiIn E{WSP(bf16_t, WS_U), WSP(bf16_t, WS_MIX), WSP(bf16_t, WS_CQ), WSP(bf16_t, WS_CKV), WSP(bf16_t, WS_KR), rsq, WSP(float, WS_RCOS), WSP(float, WS_RSIN)};
        run_gemm(F, g, S, E);
    }
    PH_SEAM(P + 0);
    if (PH_IN(P + 1) && DIAG_EN(3)) {
        PH_ENTER();
        { pg8::Gemm g{WSP(bf16_t, WS_CQ), WSP(bf16_t, WS_WQ) + (size_t)L * NQ * QLR, MTOK, NQ, QLR};
          pg8::SplitOrder S; S.init(F.G, F.bx, NQ / 256, 0);
          EpiQ E{WSP(bf16_t, WS_Q), rsq, WSP(float, WS_RCOS), WSP(float, WS_RSIN)};
          run_gemm(F, g, S, E); }
        { pg8::Gemm g{WSP(bf16_t, WS_CKV), WSP(bf16_t, WS_WKV) + (size_t)L * NKV * KVLR, MTOK, NKV, KVLR};
          pg8::SplitOrder S; S.init(F.G, F.bx, NKV / 256, 1);
          EpiKV E{WSP(bf16_t, WS_KV), rsq};
          run_gemm(F, g, S, E); }
#if IMPL_FFT & 1
        fft1_fast(F);
#else
        fft1_naive(F);
#endif
    }
    PH_SEAM(P + 1);
    if (PH_IN(P + 2) && DIAG_EN(4)) {
        PH_ENTER();
#if IMPL_ATTN
        attn_fast(F);
#else
        attn_naive(F);
#endif
        __syncthreads();
#if IMPL_FFT & 2
        fft2_fast(F, L);
#else
        fft2_naive(F, L);
#endif
    }
    PH_SEAM(P + 2);
    if (PH_IN(P + 3) && DIAG_EN(5)) {
        PH_ENTER();
        pg8::Gemm g{WSP(bf16_t, WS_MIX), WSP(bf16_t, WS_WOUT) + (size_t)L * DM * DM, MTOK, DM, DM};
        pg8::StaticOrder S; S.init(MTOK, DM, F.G, F.bx);
        EpiOut E{L == 0 ? F.in[0] : WSP(float, WS_R), WSP(float, WS_R), WSP(float, WS_MOD) + (size_t)L * NB * (3 * DM) + 2 * DM};
        run_gemm(F, g, S, E);
    }
    PH_SEAM(P + 3);
    if (PH_IN(P + 4) && DIAG_EN(6)) {
        PH_ENTER();
        if (L + 1 < DEPTH) p_ln_post<true>(F, L); else p_ln_post<false>(F, L);
    }
    PH_SEAM(P + 4);
}

__global__ void __launch_bounds__(NTHREADS, 2) fwd_kernel(Args args) {
    extern __shared__ __attribute__((aligned(16))) unsigned char lds[];
    Frame F;
    F.in[0] = args.in[0]; F.in[1] = args.in[1]; F.in[2] = args.in[2]; F.in[3] = args.in[3]; F.in[4] = args.in[4]; F.in[5] = args.in[5]; F.in[6] = args.in[6]; F.in[7] = args.in[7]; F.in[8] = args.in[8]; F.in[9] = args.in[9]; F.in[10] = args.in[10]; F.in[11] = args.in[11]; F.in[12] = args.in[12]; F.in[13] = args.in[13];
    F.out = args.out; F.ws = args.ws; F.lds = (LAS unsigned char*)lds; F.ldsg = (char*)lds;
    F.tid = threadIdx.x; F.lane = F.tid & 63; F.wave = __builtin_amdgcn_readfirstlane(F.tid >> 6); F.G = gridDim.x; F.bx = blockIdx.x;
    F.vcu = (F.G % 8 == 0) ? (F.bx % 8) * (F.G / 8) + F.bx / 8 : F.bx;
    volatile LAS unsigned* MISC = (volatile LAS unsigned*)(F.lds + MISC_OFF);
    if (F.tid < 64) MISC[F.tid] = 0u;
    __syncthreads();
    const int lo = args.ph_lo, hi = args.ph_hi;
    XcdBarrier bar; bar.bar = WSP(unsigned, WS_CTL); bar.x = 0; bar.st = MISC;
    if (hi - lo > 1) bar = xcd_barrier_post(WSP(unsigned, WS_CTL), MISC);
    if (PH_IN(0) && DIAG_EN(0)) { PH_ENTER(); p0_weights(F); p0_mod(F); p0_tables(F); }
    PH_SEAM(0);
    if (PH_IN(1) && DIAG_EN(1)) { PH_ENTER(); p_ln_first(F); }
    PH_SEAM(1);
    layer_phases<0>(F, lo, hi, bar);
    layer_phases<1>(F, lo, hi, bar);
}

extern "C" void kernel_launch(void* const* d_in, const int* in_sizes, int n_in, void* d_out, int out_size, void* d_ws, size_t ws_size, hipStream_t stream) {
    static int grid = 0;
    if (grid == 0) {
        if (n_in != 14 || in_sizes[0] != MTOK * DM || out_size != MTOK * DM || ws_size < WS_END) {
            fprintf(stderr, "kernel_launch: shape mismatch (n_in %d, in0 %d, out %d, ws %zu, need ws >= %zu); nothing launched\n", n_in, n_in > 0 ? in_sizes[0] : -1, out_size, ws_size, (size_t)WS_END); grid = -1; return; }
        int dev = 0, cus = 0, per_cu = 0;
        if (hipGetDevice(&dev) != hipSuccess || hipDeviceGetAttribute(&cus, hipDeviceAttributeMultiprocessorCount, dev) != hipSuccess) { grid = -1; return; }
        if (hipFuncSetAttribute((const void*)fwd_kernel, hipFuncAttributeMaxDynamicSharedMemorySize, LDS_BYTES) != hipSuccess) { fprintf(stderr, "kernel_launch: hipFuncSetAttribute failed\n"); grid = -1; return; }
        if (hipOccupancyMaxActiveBlocksPerMultiprocessor(&per_cu, (const void*)fwd_kernel, NTHREADS, LDS_BYTES) != hipSuccess || per_cu < 1) { fprintf(stderr, "kernel_launch: occupancy query failed (%d)\n", per_cu); (void)hipGetLastError(); per_cu = 1; }
        if (per_cu > 1) per_cu = 1;
        grid = cus * per_cu;
    }
    if (grid < 0) return;
    if (hipMemsetAsync((char*)d_ws + WS_CTL, 0, CTL_BYTES, stream) != hipSuccess) { fprintf(stderr, "kernel_launch: hipMemsetAsync failed\n"); return; }
    Args a{};
    for (int i = 0; i < 14; ++i) a.in[i] = (const float*)d_in[i];
    a.out = (float*)d_out; a.ws = (unsigned char*)d_ws;
#if N_LAUNCH_MODE
    a.ph_lo = 0; a.ph_hi = N_PHASES;
    hipLaunchKernelGGL(fwd_kernel, dim3(grid), dim3(NTHREADS), LDS_BYTES, stream, a);
#else
    for (int ph = 0; ph < N_PHASES; ++ph) { a.ph_lo = ph; a.ph_hi = ph + 1; hipLaunchKernelGGL(fwd_kernel, dim3(grid), dim3(NTHREADS), LDS_BYTES, stream, a); }
#endif
    const hipError_t le = hipPeekAtLastError();
    if (le != hipSuccess) fprintf(stderr, "kernel_launch: launch failed: %s (grid %d)\n", hipGetErrorName(le), grid);
}
```

```cpp
#define IMPL_GEMM 1
#define IMPL_ATTN 1
#define IMPL_FFT 3
#define N_LAUNCH_MODE 1
#include <hip/hip_runtime.h>
#include <cstdio>
#include <cstdint>

#ifndef N_LAUNCH_MODE
#define N_LAUNCH_MODE 1
#endif
#ifndef IMPL_GEMM
#define IMPL_GEMM 1
#endif
#ifndef IMPL_ATTN
#define IMPL_ATTN 1
#endif
#ifndef IMPL_FFT
#define IMPL_FFT 3
#endif

#define LAS __attribute__((address_space(3)))
typedef unsigned short bf16_t;
typedef short bf16x8 __attribute__((ext_vector_type(8)));
typedef short s16x4 __attribute__((ext_vector_type(4)));
typedef float f32x4 __attribute__((ext_vector_type(4)));
typedef float f32x2 __attribute__((ext_vector_type(2)));
typedef float f32x16 __attribute__((ext_vector_type(16)));
typedef unsigned u32x4 __attribute__((ext_vector_type(4)));
typedef unsigned u32x2 __attribute__((ext_vector_type(2)));

constexpr int NB = 4, SEQ = 4096, DM = 2048, MTOK = NB * SEQ, DEPTH = 2;
constexpr int DF = 1024, NG = 8, GD = 128, NH = 8, DV = 128, DNOPE = 128, DROPE = 64, DQK = 192, QLR = 512, KVLR = 256;
constexpr int NIN = 3904, NINP = 4096;
constexpr int NQ = NH * DQK  , NKV = NH * (DNOPE + DV)  ;
constexpr float NORM_EPS = 1e-6f;
constexpr float DN_ALPHA = 1.4142135623730951f;
constexpr float ATT_SCALE = 0.07216878364870322f;

__device__ __forceinline__ float bf2f(bf16_t b) { return __uint_as_float(((unsigned)b) << 16); }
__device__ __forceinline__ bf16_t f2bf(float f) { unsigned u = __float_as_uint(f); u += 0x7FFFu + ((u >> 16) & 1u); return (bf16_t)(u >> 16); }
typedef __bf16 bf16v2_t __attribute__((ext_vector_type(2)));
__device__ __forceinline__ unsigned cvt_pk_bf16(float lo, float hi) { const f32x2 v = {lo, hi}; return __builtin_bit_cast(unsigned, __builtin_convertvector(v, bf16v2_t)); }
__device__ __forceinline__ float silu_f(float z) { return z * __builtin_amdgcn_rcpf(1.0f + __builtin_amdgcn_exp2f(-1.4426950408889634f * z)); }
__device__ __forceinline__ float wave_sum(float v) { for (int o = 32; o > 0; o >>= 1) v += __shfl_xor(v, o); return v; }
__device__ __forceinline__ float wave_max(float v) { for (int o = 32; o > 0; o >>= 1) v = fmaxf(v, __shfl_xor(v, o)); return v; }

constexpr size_t al256(size_t x) { return (x + 255) / 256 * 256; }
constexpr size_t WS_CTL  = 0;
constexpr size_t CTL_BYTES = 16384;
constexpr size_t WS_MOD  = WS_CTL + CTL_BYTES;
constexpr size_t WS_RSQ  = WS_MOD + al256((size_t)DEPTH * NB * 3 * DM * 4);
constexpr size_t WS_RCOS = WS_RSQ + al256((size_t)DEPTH * MTOK * 2 * 4);
constexpr size_t WS_RSIN = WS_RCOS + (size_t)MTOK * 32 * 4;
constexpr size_t WS_D1   = WS_RSIN + (size_t)MTOK * 32 * 4;
constexpr size_t WS_D2   = WS_D1 + 128 * 64 * 2;
constexpr size_t WS_WCAT = WS_D2 + 128 * 128 * 2;
constexpr size_t WS_WIN  = WS_WCAT + (size_t)DEPTH * NG * 128 * 256 * 2;
constexpr size_t WS_WOUT = WS_WIN + (size_t)DEPTH * NINP * DM * 2;
constexpr size_t WS_WQ   = WS_WOUT + (size_t)DEPTH * DM * DM * 2;
constexpr size_t WS_WKV  = WS_WQ + (size_t)DEPTH * NQ * QLR * 2;
constexpr size_t WS_H    = WS_WKV + (size_t)DEPTH * NKV * KVLR * 2;
constexpr size_t WS_U    = WS_H + (size_t)MTOK * DM * 2;
constexpr size_t WS_MIX  = WS_U + (size_t)MTOK * DF * 2;
constexpr size_t WS_CQ   = WS_MIX + (size_t)MTOK * DM * 2;
constexpr size_t WS_CKV  = WS_CQ + (size_t)MTOK * QLR * 2;
constexpr size_t WS_KR   = WS_CKV + (size_t)MTOK * KVLR * 2;
constexpr size_t WS_Q    = WS_KR + (size_t)MTOK * 64 * 2;
constexpr size_t WS_KV   = WS_Q + (size_t)MTOK * NQ * 2;
constexpr size_t WS_R    = WS_KV + (size_t)MTOK * NKV * 2;
constexpr size_t WS_END  = WS_R + (size_t)MTOK * DM * 4;
static_assert(WS_END <= (size_t)4 * MTOK * DM * 4, "workspace map exceeds 4 x largest tensor");

constexpr int RING_BYTES = 155648, MISC_OFF = RING_BYTES, LDS_BYTES = RING_BYTES + 256;
constexpr int NTHREADS = 512;

namespace pg8 {
#define PG8_LAS __attribute__((address_space(3)))
constexpr int BM = 256, BK = 64, HALF = 128, HTB = HALF * BK * 2  , STAGE_BYTES = 8 * HTB, NXCD = 8, WGM = 8;
static_assert(STAGE_BYTES <= RING_BYTES, "GEMM stage ring must fit the LDS phase scratch");

__host__ __device__ __forceinline__ int lds_byte(int r, int c) { const int st = (r >> 4) * 2 + (c >> 5), rr = r & 15, cc = c & 31, ob = rr * 64 + cc * 2; return st * 1024 + (ob ^ (((ob >> 9) & 1) << 5)); }
__host__ __device__ __forceinline__ void stage_rc(int b, int& R, int& C) { const int st = b / 1024, sb = b % 1024, swz = sb ^ (((sb >> 9) & 1) << 5); R = (st >> 1) * 16 + swz / 64; C = (st & 1) * 32 + (swz % 64) / 2; }
__host__ __device__ __forceinline__ int perm32(int rho) { const int n = rho >> 4, i = rho & 15; return 8 * (i >> 2) + 4 * n + (i & 3); }

struct Unit { int pm, pn; };
struct Gemm { const bf16_t* A; const bf16_t* Bt; int M, N, K; };

struct StaticOrder {
    int nM, nN, nwg, G, c;
    __host__ __device__ void init(int M, int N, int G_, int c_) { nM = M / BM; nN = N / BM; nwg = nM * nN; G = G_; c = c_; }
    __host__ __device__ bool next(int i, Unit& u) const {
        const long L = (long)i * G + c; if (L >= nwg) return false;
        int wgid = (int)L; { const int q = nwg / NXCD, r = nwg % NXCD, xcd = wgid % NXCD, off = wgid / NXCD; wgid = (xcd < r ? xcd * (q + 1) : r * (q + 1) + (xcd - r) * q) + off; }
        const int nig = WGM * nN, gid = wgid / nig, fm = gid * WGM, gsz = (nM - fm) < WGM ? (nM - fm) : WGM;
        u.pm = fm + ((wgid % nig) % gsz); u.pn = (wgid % nig) / gsz; return true;
    }
    __device__ __forceinline__ void a_ready(const Unit&) const {}
    __device__ __forceinline__ void done(const Unit&) const {}
};
struct SplitOrder {
    int G, c, nN, kind;
    __device__ void init(int G_, int c_, int nN_, int kind_) { G = G_; c = c_; nN = nN_; kind = kind_; }
    __device__ bool next(int i, Unit& u) const {
        if (G != 256) { const int L = i * G + c; if (L >= 64 * nN) return false; u.pm = L / nN; u.pn = L % nN; return true; }
        const int x = c & 7, v = c >> 3; int li;
        if (kind == 0) { if (v < 16) { if (i >= 2) return false; li = 2 * v + i; } else { if (i >= 1) return false; li = 32 + (v - 16); } }
        else           { if (v < 16) { if (i >= 1) return false; li = v; } else { if (i >= 3) return false; li = 16 + 3 * (v - 16) + i; } }
        u.pm = 8 * x + li / nN; u.pn = li % nN; return true;
    }
    __device__ __forceinline__ void a_ready(const Unit&) const {}
    __device__ __forceinline__ void done(const Unit&) const {}
};
template <class Epi, class Sched, bool ALIGN_EPI = false, bool SP2 = false>
__device__ __forceinline__ void gemm_phase(PG8_LAS unsigned char* lds, const Gemm g, const Sched& S, const Epi& E, const int tid) {
    const int wid = __builtin_amdgcn_readfirstlane(tid >> 6), lane = tid & 63, wr = wid >> 2, wc = wid & 3, fr = lane & 15, fq = lane >> 4;
    const int K = g.K, nt = K / BK;
    unsigned voffA[2], voffB[2];
#pragma unroll
    for (int i = 0; i < 2; ++i) { int R, C; stage_rc(tid * 16 + i * 8192, R, C); const int Rb = Epi::PERM ? ((R & ~31) + perm32(R & 31)) : R;
        voffA[i] = (unsigned)(R * K + C) * 2u; voffB[i] = (unsigned)(Rb * K + C) * 2u; }
    const size_t kstep = (size_t)(BK * 2);
    const size_t hstep = (size_t)HALF * K * 2;
    const size_t tstep = 2 * hstep;
    const unsigned ldsw = (unsigned)wid * 1024u;
    const int aoff = lds_byte(wr * 64 + fr, fq * 8), boff = lds_byte(wc * 32 + fr, fq * 8);
#define PG8_SA(b, h) (((b) * 2 + (h)) * HTB)
#define PG8_SB(b, h) ((4 + (b) * 2 + (h)) * HTB)
#define PG8_STAGE(bufoff, gbase, voff) do { _Pragma("unroll") for (int _i = 0; _i < 2; ++_i) \
        __builtin_amdgcn_global_load_lds((const unsigned*)((const char*)(gbase) + (voff)[_i]), (PG8_LAS unsigned*)(lds + (bufoff) + ldsw + _i * 8192), 16, 0, 0); } while (0)
#define PG8_LDA(dst, b, h) do { _Pragma("unroll") for (int m = 0; m < 4; ++m) _Pragma("unroll") for (int k = 0; k < 2; ++k) dst[m][k] = *(const PG8_LAS bf16x8*)(lds + PG8_SA(b, h) + aoff + m * 2048 + k * 1024); } while (0)
#define PG8_LDB(dst, b, h) do { _Pragma("unroll") for (int n = 0; n < 2; ++n) _Pragma("unroll") for (int k = 0; k < 2; ++k) dst[n][k] = *(const PG8_LAS bf16x8*)(lds + PG8_SB(b, h) + boff + n * 2048 + k * 1024); } while (0)
#define PG8_MMA(ai, bj, At, Bt) do { __builtin_amdgcn_s_setprio(1); _Pragma("unroll") for (int m = 0; m < 4; ++m) _Pragma("unroll") for (int n = 0; n < 2; ++n) _Pragma("unroll") for (int k = 0; k < 2; ++k) \
        acc[ai][bj][m][n] = __builtin_amdgcn_mfma_f32_16x16x32_bf16(Bt[n][k], At[m][k], acc[ai][bj][m][n], 0, 0, 0); __builtin_amdgcn_s_setprio(0); } while (0)
#define PG8_WAIT_V(n) asm volatile("s_waitcnt vmcnt(" #n ")" ::: "memory")
#define PG8_WAIT_L(n) asm volatile("s_waitcnt lgkmcnt(" #n ")" ::: "memory")
#define PG8_BAR __builtin_amdgcn_s_barrier()
#define PG8_SCHED __builtin_amdgcn_sched_barrier(0)
    Unit cur, nxt; int ui = 0;
    if (!S.next(0, cur)) return;
    f32x4 acc[2][2][4][2];
#pragma unroll
    for (int a = 0; a < 2; ++a)
#pragma unroll
        for (int b = 0; b < 2; ++b)
#pragma unroll
            for (int m = 0; m < 4; ++m)
#pragma unroll
                for (int n = 0; n < 2; ++n) acc[a][b][m][n] = (f32x4){0.f, 0.f, 0.f, 0.f};
    bf16x8 At[4][2], B0[2][2], B1[2][2];
    const char* cA = (const char*)g.A + (size_t)cur.pm * tstep; const char* cB = (const char*)g.Bt + (size_t)cur.pn * tstep;
    S.a_ready(cur);
    if constexpr (SP2) {
        PG8_STAGE(PG8_SB(0, 0), cB, voffB); PG8_STAGE(PG8_SB(0, 1), cB + hstep, voffB); PG8_STAGE(PG8_SA(0, 0), cA, voffA); PG8_STAGE(PG8_SA(0, 1), cA + hstep, voffA);
        if (wr == 1) PG8_BAR;
        PG8_WAIT_V(2); PG8_BAR;
        PG8_STAGE(PG8_SB(1, 0), cB + kstep, voffB); PG8_STAGE(PG8_SA(1, 0), cA + kstep, voffA); PG8_STAGE(PG8_SB(1, 1), cB + hstep + kstep, voffB);
        PG8_WAIT_V(6); PG8_BAR;
    } else {
        PG8_STAGE(PG8_SB(0, 0), cB, voffB); PG8_STAGE(PG8_SA(0, 0), cA, voffA); PG8_STAGE(PG8_SB(0, 1), cB + hstep, voffB); PG8_STAGE(PG8_SA(0, 1), cA + hstep, voffA);
        if (wr == 1) PG8_BAR;
        PG8_WAIT_V(4); PG8_BAR;
        PG8_STAGE(PG8_SB(1, 0), cB + kstep, voffB); PG8_STAGE(PG8_SA(1, 0), cA + kstep, voffA); PG8_STAGE(PG8_SB(1, 1), cB + hstep + kstep, voffB);
        PG8_WAIT_V(6); PG8_BAR;
    }
    for (;;) {
        const bool has_next = S.next(ui + 1, nxt);
        const char* nA = has_next ? (const char*)g.A + (size_t)nxt.pm * tstep : cA; const char* nB = has_next ? (const char*)g.Bt + (size_t)nxt.pn * tstep : cB;
        for (int t = 0; t < nt; t += 2) {
            const bool last = (t == nt - 2);
            const char* a1 = cA + (size_t)(t + 1) * kstep;
            const char* a2 = last ? nA : cA + (size_t)(t + 2) * kstep; const char* b2 = last ? nB : cB + (size_t)(t + 2) * kstep;
            const char* a3 = a2 + kstep; const char* b3 = b2 + kstep;
            if (last && has_next) S.a_ready(nxt);
            if constexpr (SP2) {
            PG8_LDB(B0, 0, 0); PG8_LDB(B1, 0, 1); PG8_SCHED; PG8_LDA(At, 0, 0); PG8_STAGE(PG8_SA(1, 1), a1 + hstep, voffA);
            PG8_WAIT_V(8); PG8_WAIT_L(0); PG8_BAR; PG8_MMA(0, 0, At, B0); PG8_MMA(0, 1, At, B1); PG8_BAR; PG8_SCHED;
            PG8_LDA(At, 0, 1); PG8_STAGE(PG8_SB(0, 0), b2, voffB); PG8_STAGE(PG8_SB(0, 1), b2 + hstep, voffB); PG8_STAGE(PG8_SA(0, 0), a2, voffA);
            PG8_WAIT_V(8); PG8_WAIT_L(0); PG8_BAR; PG8_MMA(1, 0, At, B0); PG8_MMA(1, 1, At, B1); PG8_BAR; PG8_SCHED;
            PG8_LDB(B0, 1, 0); PG8_LDB(B1, 1, 1); PG8_SCHED; PG8_LDA(At, 1, 0); PG8_STAGE(PG8_SA(0, 1), a2 + hstep, voffA);
            PG8_WAIT_V(8); PG8_WAIT_L(0); PG8_BAR; PG8_MMA(0, 0, At, B0); PG8_MMA(0, 1, At, B1); PG8_BAR; PG8_SCHED;
            PG8_LDA(At, 1, 1); PG8_STAGE(PG8_SB(1, 0), b3, voffB); PG8_STAGE(PG8_SB(1, 1), b3 + hstep, voffB); PG8_STAGE(PG8_SA(1, 0), a3, voffA);
            PG8_WAIT_V(8); PG8_WAIT_L(0); PG8_BAR; PG8_MMA(1, 0, At, B0); PG8_MMA(1, 1, At, B1); PG8_BAR; PG8_SCHED;
            } else {
            PG8_LDB(B0, 0, 0); PG8_SCHED; PG8_LDA(At, 0, 0); PG8_STAGE(PG8_SA(1, 1), a1 + hstep, voffA);
            PG8_WAIT_L(8); PG8_BAR; PG8_WAIT_L(0); PG8_MMA(0, 0, At, B0); PG8_BAR; PG8_SCHED;
            PG8_LDB(B1, 0, 1); PG8_STAGE(PG8_SB(0, 0), b2, voffB);
            PG8_BAR; PG8_WAIT_L(0); PG8_MMA(0, 1, At, B1); PG8_BAR;
            PG8_LDA(At, 0, 1); PG8_STAGE(PG8_SA(0, 0), a2, voffA);
            PG8_BAR; PG8_WAIT_L(0); PG8_MMA(1, 0, At, B0); PG8_BAR; PG8_SCHED;
            PG8_STAGE(PG8_SB(0, 1), b2 + hstep, voffB);
            PG8_WAIT_V(6); PG8_BAR; PG8_MMA(1, 1, At, B1); PG8_BAR;
            PG8_LDB(B0, 1, 0); PG8_SCHED; PG8_LDA(At, 1, 0); PG8_STAGE(PG8_SA(0, 1), a2 + hstep, voffA);
            PG8_WAIT_L(8); PG8_BAR; PG8_WAIT_L(0); PG8_MMA(0, 0, At, B0); PG8_BAR; PG8_SCHED;
            PG8_LDB(B1, 1, 1); PG8_STAGE(PG8_SB(1, 0), b3, voffB);
            PG8_BAR; PG8_WAIT_L(0); PG8_MMA(0, 1, At, B1); PG8_BAR;
            PG8_LDA(At, 1, 1); PG8_STAGE(PG8_SA(1, 0), a3, voffA);
            PG8_BAR; PG8_WAIT_L(0); PG8_MMA(1, 0, At, B0); PG8_BAR; PG8_SCHED;
            PG8_STAGE(PG8_SB(1, 1), b3 + hstep, voffB);
            PG8_WAIT_V(6); PG8_BAR; PG8_MMA(1, 1, At, B1); PG8_BAR;
            }
        }
        if constexpr (ALIGN_EPI) { if (wr == 0) PG8_BAR; }
        if constexpr (!Epi::AFTER_DRAIN) { E(acc, cur, wr, wc, fr, fq); S.done(cur); }
        if (!has_next) break;
#pragma unroll
        for (int a = 0; a < 2; ++a)
#pragma unroll
            for (int b = 0; b < 2; ++b)
#pragma unroll
                for (int m = 0; m < 4; ++m)
#pragma unroll
                    for (int n = 0; n < 2; ++n) acc[a][b][m][n] = (f32x4){0.f, 0.f, 0.f, 0.f};
        cur = nxt; cA = nA; cB = nB; ++ui;
        if constexpr (ALIGN_EPI) { if (wr == 1) PG8_BAR; }
    }
    PG8_WAIT_V(0);
    if constexpr (!ALIGN_EPI) { if (wr == 0) PG8_BAR; }
    PG8_BAR;
    if constexpr (Epi::AFTER_DRAIN) { E.fused(acc, cur, wr, wc, fr, fq, lds, wid, lane); S.done(cur); }
#undef PG8_SA
#undef PG8_SB
#undef PG8_STAGE
#undef PG8_LDA
#undef PG8_LDB
#undef PG8_MMA
#undef PG8_WAIT_V
#undef PG8_WAIT_L
#undef PG8_BAR
#undef PG8_SCHED
}

template <class Epi, class Sched>
__device__ __forceinline__ void gemm_phase_naive(const Gemm g, const Sched& S, const Epi& E, const int tid) {
    const int wid = __builtin_amdgcn_readfirstlane(tid >> 6), lane = tid & 63, wr = wid >> 2, wc = wid & 3, fr = lane & 15, fq = lane >> 4;
    const int K = g.K;
    Unit cur;
    for (int ui = 0; S.next(ui, cur); ++ui) {
        f32x4 acc[2][2][4][2];
#pragma unroll
        for (int ai = 0; ai < 2; ++ai)
#pragma unroll
            for (int m = 0; m < 4; ++m) {
                const bf16_t* arow = g.A + (size_t)(cur.pm * BM + ai * HALF + wr * 64 + m * 16 + fr) * K;
#pragma unroll
                for (int bj = 0; bj < 2; ++bj)
#pragma unroll
                    for (int n = 0; n < 2; ++n) {
                        const int col = cur.pn * BM + bj * HALF + wc * 32 + (Epi::PERM ? (8 * fq + 4 * n) : (16 * n + 4 * fq));
                        const bf16_t* brow = g.Bt + (size_t)col * K;
                        float s0 = 0.f, s1 = 0.f, s2 = 0.f, s3 = 0.f;
#pragma unroll 1
                        for (int k = 0; k < K; k += 8) {
                            const bf16x8 av = *(const bf16x8*)(arow + k);
                            const bf16x8 b0 = *(const bf16x8*)(brow + k), b1 = *(const bf16x8*)(brow + K + k), b2 = *(const bf16x8*)(brow + 2 * K + k), b3 = *(const bf16x8*)(brow + 3 * K + k);
#pragma unroll
                            for (int e = 0; e < 8; ++e) { const float a = bf2f((bf16_t)av[e]);
                                s0 += a * bf2f((bf16_t)b0[e]); s1 += a * bf2f((bf16_t)b1[e]); s2 += a * bf2f((bf16_t)b2[e]); s3 += a * bf2f((bf16_t)b3[e]); }
                        }
                        acc[ai][bj][m][n] = (f32x4){s0, s1, s2, s3};
                    }
            }
        E(acc, cur, wr, wc, fr, fq);
    }
}
}
#ifndef PG8_SP2
#define PG8_SP2 true
#endif
#ifndef PG8_ALIGN
#define PG8_ALIGN true
#endif
typedef f32x4 AccT[2][2][4][2];

__device__ __forceinline__ void store8_bf16(bf16_t* p, f32x4 v0, f32x4 v1) {
    u32x4 w; w.x = cvt_pk_bf16(v0[0], v0[1]); w.y = cvt_pk_bf16(v0[2], v0[3]); w.z = cvt_pk_bf16(v1[0], v1[1]); w.w = cvt_pk_bf16(v1[2], v1[3]); *(u32x4*)p = w;
}
__device__ __forceinline__ void store4_bf16(bf16_t* p, f32x4 v) { u32x2 w; w.x = cvt_pk_bf16(v[0], v[1]); w.y = cvt_pk_bf16(v[2], v[3]); *(u32x2*)p = w; }
__device__ __forceinline__ f32x4 silu4(f32x4 v) { return (f32x4){silu_f(v[0]), silu_f(v[1]), silu_f(v[2]), silu_f(v[3])}; }
__device__ __forceinline__ float sq4(f32x4 v) { return (v[0] * v[0] + v[1] * v[1]) + (v[2] * v[2] + v[3] * v[3]); }

struct EpiIn {
    static constexpr bool PERM = true, AFTER_DRAIN = false;
    bf16_t* U; bf16_t* MIX; bf16_t* CQ; bf16_t* CKV; bf16_t* KR; float* rsq; const float* rcos; const float* rsin;
    template <int ACT> __device__ __forceinline__ void plain(const AccT& acc, bf16_t* base, int ldc, int row0, int col0) const {
#pragma unroll
        for (int ai = 0; ai < 2; ++ai)
#pragma unroll
            for (int m = 0; m < 4; ++m) { bf16_t* rowp = base + (size_t)(row0 + ai * 128 + m * 16) * ldc + col0;
#pragma unroll
                for (int bj = 0; bj < 2; ++bj) { f32x4 v0 = acc[ai][bj][m][0], v1 = acc[ai][bj][m][1]; if (ACT) { v0 = silu4(v0); v1 = silu4(v1); } store8_bf16(rowp + bj * 128, v0, v1); } }
    }
    __device__ __forceinline__ void sumsq(const AccT& acc, int row0, int which, int fq) const {
#pragma unroll
        for (int ai = 0; ai < 2; ++ai)
#pragma unroll
            for (int m = 0; m < 4; ++m) { float s = (sq4(acc[ai][0][m][0]) + sq4(acc[ai][0][m][1])) + (sq4(acc[ai][1][m][0]) + sq4(acc[ai][1][m][1]));
                s += __shfl_xor(s, 16); s += __shfl_xor(s, 32);
                if (fq == 0) atomicAdd(rsq + (size_t)(row0 + ai * 128 + m * 16) * 2 + which, s); }
    }
    __device__ __forceinline__ void operator()(const AccT& acc, const pg8::Unit& u, int wr, int wc, int fr, int fq) const {
        const int row0 = u.pm * 256 + wr * 64 + fr, pn = u.pn, cw = wc * 32 + 8 * fq;
        if (pn < 4) plain<0>(acc, U, DF, row0, pn * 256 + cw);
        else if (pn < 8) plain<1>(acc, MIX, DM, row0, (pn - 4) * 256 + cw);
        else if (pn < 10) { plain<0>(acc, CQ, QLR, row0, (pn - 8) * 256 + cw); sumsq(acc, row0, 0, fq); }
        else if (pn == 10) { plain<0>(acc, CKV, KVLR, row0, cw); sumsq(acc, row0, 1, fq); }
        else if (pn == 11) {
            if (wc < 2) { const int i0 = 16 * wc + 4 * fq;
#pragma unroll
                for (int ai = 0; ai < 2; ++ai)
#pragma unroll
                    for (int m = 0; m < 4; ++m) { const size_t row = (size_t)(row0 + ai * 128 + m * 16);
                        const f32x4 c = *(const f32x4*)(rcos + row * 32 + i0), s = *(const f32x4*)(rsin + row * 32 + i0), x1 = acc[ai][0][m][0], x2 = acc[ai][0][m][1];
                        store4_bf16(KR + row * 64 + i0, x1 * c - x2 * s); store4_bf16(KR + row * 64 + 32 + i0, x2 * c + x1 * s); } }
        }
        else plain<1>(acc, MIX, DM, row0, DF + (pn - 12) * 256 + cw);
    }
};
struct EpiQ {
    static constexpr bool PERM = true, AFTER_DRAIN = false;
    bf16_t* Q; const float* rsq; const float* rcos; const float* rsin;
    __device__ __forceinline__ void operator()(const AccT& acc, const pg8::Unit& u, int wr, int wc, int fr, int fq) const {
        const int row0 = u.pm * 256 + wr * 64 + fr;
#pragma unroll
        for (int ai = 0; ai < 2; ++ai)
#pragma unroll
            for (int m = 0; m < 4; ++m) { const size_t row = (size_t)(row0 + ai * 128 + m * 16);
                const float rs = rsqrtf(rsq[row * 2 + 0] * (1.0f / QLR) + NORM_EPS);
#pragma unroll
                for (int bj = 0; bj < 2; ++bj) { const int G = u.pn * 8 + bj * 4 + wc, head = G / 6, g6 = G - head * 6;
                    const f32x4 v0 = acc[ai][bj][m][0] * rs, v1 = acc[ai][bj][m][1] * rs;
                    if (g6 < 4) store8_bf16(Q + row * NQ + head * DQK + g6 * 32 + 8 * fq, v0, v1);
                    else { const int i0 = 16 * (g6 - 4) + 4 * fq; const f32x4 c = *(const f32x4*)(rcos + row * 32 + i0), s = *(const f32x4*)(rsin + row * 32 + i0);
                        store4_bf16(Q + row * NQ + head * DQK + 128 + i0, v0 * c - v1 * s); store4_bf16(Q + row * NQ + head * DQK + 160 + i0, v1 * c + v0 * s); } } }
    }
};
struct EpiKV {
    static constexpr bool PERM = true, AFTER_DRAIN = false;
    bf16_t* KV; const float* rsq;
    __device__ __forceinline__ void operator()(const AccT& acc, const pg8::Unit& u, int wr, int wc, int fr, int fq) const {
        const int row0 = u.pm * 256 + wr * 64 + fr, col0 = u.pn * 256 + wc * 32 + 8 * fq;
#pragma unroll
        for (int ai = 0; ai < 2; ++ai)
#pragma unroll
            for (int m = 0; m < 4; ++m) { const size_t row = (size_t)(row0 + ai * 128 + m * 16);
                const float rs = rsqrtf(rsq[row * 2 + 1] * (1.0f / KVLR) + NORM_EPS);
#pragma unroll
                for (int bj = 0; bj < 2; ++bj) store8_bf16(KV + row * NKV + col0 + bj * 128, acc[ai][bj][m][0] * rs, acc[ai][bj][m][1] * rs); }
    }
};
struct EpiOut {
    static constexpr bool PERM = true, AFTER_DRAIN = false;
    bf16_t* GY; const float* gate;
    __device__ __forceinline__ void operator()(const AccT& acc, const pg8::Unit& u, int wr, int wc, int fr, int fq) const {
        const int row0 = u.pm * 256 + wr * 64 + fr, col0 = u.pn * 256 + wc * 32 + 8 * fq;
        const float* gp = gate + (size_t)(u.pm >> 4) * (3 * DM) + col0;
        f32x4 gv[2][2];
#pragma unroll
        for (int bj = 0; bj < 2; ++bj)
#pragma unroll
            for (int n = 0; n < 2; ++n) gv[bj][n] = *(const f32x4*)(gp + bj * 128 + n * 4);
#pragma unroll
        for (int ai = 0; ai < 2; ++ai)
#pragma unroll
            for (int m = 0; m < 4; ++m) { bf16_t* rowp = GY + (size_t)(row0 + ai * 128 + m * 16) * DM + col0;
#pragma unroll
                for (int bj = 0; bj < 2; ++bj) store8_bf16(rowp + bj * 128, gv[bj][0] * acc[ai][bj][m][0], gv[bj][1] * acc[ai][bj][m][1]); }
    }
};
#define XB_TMO      128
#define XB_XCNT(j)  (256  + 64 * (j))
#define XB_XSUB(j)  (1280 + 64 * (j))
#define XB_XGEN(j)  (2304 + 64 * (j))
#define XB_TOP      3328
#define XB_TOPGEN   3392
#define XCD_BAR_WORDS 3456
#define XB_SPIN_CAP (1u << 22)
static_assert(XCD_BAR_WORDS * 4 <= CTL_BYTES, "barrier words must fit the control region");
__device__ __forceinline__ unsigned xb_ld(unsigned* p)              { return __hip_atomic_load(p, __ATOMIC_RELAXED, __HIP_MEMORY_SCOPE_AGENT); }
__device__ __forceinline__ unsigned xb_add(unsigned* p, unsigned v) { return __hip_atomic_fetch_add(p, v, __ATOMIC_RELAXED, __HIP_MEMORY_SCOPE_AGENT); }
__device__ __forceinline__ unsigned xb_xcc_id() { return (unsigned)__builtin_amdgcn_s_getreg((3 << 11) | 20) & 0xFu; }
#define XB_SPIN(cond, bar) do { unsigned _sp = 0; while (cond) { __builtin_amdgcn_s_sleep(1); \
    if ((++_sp & 255u) == 0u) { if (xb_ld(&(bar)[XB_TMO])) break; if (_sp > XB_SPIN_CAP) { atomicAdd(&(bar)[XB_TMO], 1u); break; } } } } while (0)
struct XcdBarrier { unsigned* bar; unsigned x; volatile LAS unsigned* st; };
__device__ __forceinline__ XcdBarrier xcd_barrier_post(unsigned* bar, volatile LAS unsigned* st) {
    XcdBarrier b; b.bar = bar; b.x = xb_xcc_id(); b.st = st;
    if (threadIdx.x == 0) (void)xb_add(&bar[XB_XCNT(b.x)], 1u);
    return b;
}
__device__ __forceinline__ void xcd_barrier_complete(unsigned* bar, unsigned x, unsigned& nloc, unsigned& nx) {
    const unsigned G = gridDim.x * gridDim.y * gridDim.z;
    unsigned sum, cnt, mine, sp = 0u;
    for (;;) {
        sum = 0u; cnt = 0u; mine = 0u;
#pragma unroll
        for (unsigned j = 0; j < 16; ++j) { const unsigned c = xb_ld(&bar[XB_XCNT(j)]); sum += c; cnt += (c > 0u) ? 1u : 0u; mine = (j == x) ? c : mine; }
        if (sum == G) break;
        __builtin_amdgcn_s_sleep(1);
        if ((++sp & 255u) == 0u) { if (xb_ld(&bar[XB_TMO])) break; if (sp > XB_SPIN_CAP) { atomicAdd(&bar[XB_TMO], 1u); break; } }
    }
    nloc = mine > 0u ? mine : 1u; nx = cnt > 0u ? cnt : 1u;
}
__device__ __forceinline__ void xcd_barrier(const XcdBarrier& b) {
    asm volatile("s_waitcnt vmcnt(0)" ::: "memory");
    __syncthreads();
    if (threadIdx.x == 0) {
        unsigned* bar = b.bar;
        __builtin_amdgcn_s_waitcnt(0);
        unsigned nloc = b.st[0], nx = b.st[1];
        if (nloc == 0u) { xcd_barrier_complete(bar, b.x, nloc, nx); b.st[0] = nloc; b.st[1] = nx; }
        const unsigned old = xb_add(&bar[XB_XSUB(b.x)], 1u);
        const unsigned gen = old / nloc;
        if (old + 1u == (gen + 1u) * nloc) {
            __builtin_amdgcn_fence(__ATOMIC_RELEASE, "agent");
            asm volatile("s_waitcnt vmcnt(0)" ::: "memory");
            const unsigned og = xb_add(&bar[XB_TOP], 1u);
            const unsigned tg = og / nx;
            if (og + 1u == (tg + 1u) * nx) xb_add(&bar[XB_TOPGEN], 1u);
            else XB_SPIN(xb_ld(&bar[XB_TOPGEN]) == tg, bar);
            __builtin_amdgcn_fence(__ATOMIC_ACQUIRE, "agent");
            xb_add(&bar[XB_XGEN(b.x)], 1u);
            asm volatile("s_waitcnt vmcnt(0)" ::: "memory");
        } else {
            XB_SPIN(xb_ld(&bar[XB_XGEN(b.x)]) == gen, bar);
            __builtin_amdgcn_fence(__ATOMIC_ACQUIRE, "agent");
            asm volatile("s_waitcnt vmcnt(0)" ::: "memory");
        }
    }
    __syncthreads();
}
struct Frame {
    const float* in[14]; float* out; unsigned char* ws;
    LAS unsigned char* lds; char* ldsg;
    int tid, lane, wave, G, bx, vcu; size_t mix_off;
};
#define WSP(T, off) ((T*)(F.ws + (off)))

__device__ __forceinline__ int src_in(int n) {
    if (n < 2816) return n;
    if (n < 3072) { const int c = n - 2816, bj = c >> 7, wc = (c >> 5) & 3, c32 = c & 31; if (bj || wc >= 2) return -1;
        const int fq = c32 >> 3, nn = (c32 >> 2) & 1, j = c32 & 3; return 2816 + 32 * nn + 16 * wc + 4 * fq + j; }
    return n - 192;
}
__device__ __forceinline__ int src_q(int n) {
    const int G = n >> 5, c32 = n & 31, head = G / 6, g6 = G - head * 6;
    if (g6 < 4) return head * DQK + g6 * 32 + c32;
    const int fq = c32 >> 3, nn = (c32 >> 2) & 1, j = c32 & 3; return head * DQK + 128 + 32 * nn + 16 * (g6 - 4) + 4 * fq + j;
}
__device__ __forceinline__ void p0_weights(const Frame& F) {
    constexpr int TIN = 1024, TOUT = 512, TQ = 96, TKV = 64, TL = TIN + TOUT + TQ + TKV;
    LAS unsigned* T = (LAS unsigned*)F.lds;
    const int tid = F.tid, n4 = (tid & 15) * 4, kp = tid >> 4;
    for (int it = F.bx; it < DEPTH * TL; it += F.G) {
        const int l = it / TL; int r = it - l * TL, kind, nt, kt, Nsrc, K; const float* W; const float* ksc = nullptr; bf16_t* Bt;
        if (r < TIN) { kind = 0; nt = r >> 4; kt = r & 15; W = F.in[5] + (size_t)l * DM * NIN; Nsrc = NIN; K = DM; Bt = WSP(bf16_t, WS_WIN) + (size_t)l * NINP * DM; }
        else if (r < TIN + TOUT) { r -= TIN; kind = 1; nt = r >> 4; kt = r & 15; W = F.in[11] + (size_t)l * DM * DM; Nsrc = DM; K = DM; Bt = WSP(bf16_t, WS_WOUT) + (size_t)l * DM * DM; }
        else if (r < TIN + TOUT + TQ) { r -= TIN + TOUT; kind = 2; nt = r >> 2; kt = r & 3; W = F.in[7] + (size_t)l * QLR * NQ; Nsrc = NQ; K = QLR; ksc = F.in[6] + l * QLR; Bt = WSP(bf16_t, WS_WQ) + (size_t)l * NQ * QLR; }
        else { r -= TIN + TOUT + TQ; kind = 3; nt = r >> 1; kt = r & 1; W = F.in[9] + (size_t)l * KVLR * NKV; Nsrc = NKV; K = KVLR; ksc = F.in[8] + l * KVLR; Bt = WSP(bf16_t, WS_WKV) + (size_t)l * NKV * KVLR; }
        const int n0 = nt * 64, k0 = kt * 128, n = n0 + n4;
        const int src = kind == 0 ? src_in(n) : (kind == 2 ? src_q(n) : n);
        f32x4 v0[2], v1[2];
#pragma unroll
        for (int i = 0; i < 2; ++i) { const int k = k0 + 2 * (kp + 32 * i);
            v0[i] = src >= 0 ? *(const f32x4*)(W + (size_t)k * Nsrc + src) : (f32x4){0.f, 0.f, 0.f, 0.f}; v1[i] = src >= 0 ? *(const f32x4*)(W + (size_t)(k + 1) * Nsrc + src) : (f32x4){0.f, 0.f, 0.f, 0.f};
            if (ksc) { v0[i] *= ksc[k]; v1[i] *= ksc[k + 1]; } }
#pragma unroll
        for (int i = 0; i < 2; ++i)
#pragma unroll
            for (int e = 0; e < 4; ++e) T[(n4 + e) * 66 + kp + 32 * i] = cvt_pk_bf16(v0[i][e], v1[i][e]);
        __syncthreads();
#pragma unroll
        for (int i = 0; i < 2; ++i) { const int c = tid + 512 * i, nn = c >> 4, kc = c & 15;
            const u32x2 a = *(const LAS u32x2*)(T + nn * 66 + kc * 4), b = *(const LAS u32x2*)(T + nn * 66 + kc * 4 + 2);
            *(u32x4*)(Bt + (size_t)(n0 + nn) * K + k0 + kc * 8) = (u32x4){a.x, a.y, b.x, b.y}; }
        __syncthreads();
    }
}
__device__ __forceinline__ void p0_mod(const Frame& F) {
    if (F.bx >= DEPTH * 96) return;
    LAS float* sc = (LAS float*)F.lds;
    LAS float* red = (LAS float*)(F.lds + 32768);
    const int tid = F.tid;
    for (int i = tid; i < NB * DM; i += NTHREADS) sc[i] = silu_f(F.in[1][i]);
    __syncthreads();
    float* mod = WSP(float, WS_MOD);
    for (int it = F.bx; it < DEPTH * 96; it += F.G) {
        const int l = it / 96, col0 = (it - l * 96) * 64, cg = tid & 15, kl = tid >> 4;
        f32x4 acc[4] = {};
        const float* wp = F.in[3] + (size_t)l * DM * (3 * DM) + col0 + cg * 4;
        for (int k = kl; k < DM; k += 32) { const f32x4 w = *(const f32x4*)(wp + (size_t)k * (3 * DM));
#pragma unroll
            for (int b = 0; b < 4; ++b) acc[b] += w * sc[b * DM + k]; }
#pragma unroll
        for (int b = 0; b < 4; ++b)
#pragma unroll
            for (int j = 0; j < 4; ++j) red[(kl * 16 + cg) * 16 + b * 4 + j] = acc[b][j];
        __syncthreads();
        if (tid < 256) { const int cg2 = tid >> 4, v = tid & 15, b = v >> 2, j = v & 3; float s = 0.f;
            for (int q = 0; q < 32; ++q) s += red[(q * 16 + cg2) * 16 + v];
            const int col = col0 + cg2 * 4 + j; mod[(size_t)(l * NB + b) * (3 * DM) + col] = s + F.in[4][l * (3 * DM) + col]; }
        __syncthreads();
    }
}
__device__ __forceinline__ void p0_tables(const Frame& F) {
    constexpr double INVF2PI[32] = {
    0.15915494309189535, 0.11934937021124886, 0.08949940160889101, 0.06711508300522726,
    0.050329212104487035, 0.03774158471741977, 0.0283021958306234, 0.02122365276477766,
    0.015915494309189534, 0.011934937021124886, 0.008949940160889102, 0.006711508300522725,
    0.005032921210448704, 0.003774158471741977, 0.00283021958306234, 0.0021223652764777662,
    0.0015915494309189536, 0.0011934937021124885, 0.0008949940160889102, 0.0006711508300522726,
    0.0005032921210448703, 0.00037741584717419774, 0.00028302195830623395, 0.0002122365276477766,
    0.00015915494309189535, 0.00011934937021124886, 8.949940160889102e-05, 6.711508300522725e-05,
    5.0329212104487035e-05, 3.774158471741978e-05, 2.8302195830623396e-05, 2.122365276477766e-05};
    const int gid = F.bx * NTHREADS + F.tid, NT = F.G * NTHREADS;
    const int* pos = (const int*)F.in[2]; float* rc = WSP(float, WS_RCOS); float* rs = WSP(float, WS_RSIN);
    for (int idx = gid; idx < MTOK * 32; idx += NT) { const int i = idx & 31; double t = (double)pos[idx >> 5] * INVF2PI[i]; t -= floor(t);
        float sn, cs; sincospif((float)(2.0 * t), &sn, &cs); rc[idx] = cs; rs[idx] = sn; }
    bf16_t* D1 = WSP(bf16_t, WS_D1); bf16_t* D2 = WSP(bf16_t, WS_D2);
    for (int idx = gid; idx < 128 * 64; idx += NT) { const int s1 = idx & 63, rr = idx >> 6, ri = rr >> 6, s1p = rr & 63; float sn, cs; sincospif((float)((s1 * s1p) & 63) * (1.0f / 32.0f), &sn, &cs);
        D1[idx] = f2bf((ri ? -sn : cs) * 0.125f); }
    for (int idx = gid; idx < 128 * 128; idx += NT) { const int kk = idx & 127, rr = idx >> 7, ri = kk >> 6, s2 = kk & 63, ro = rr >> 6, s2p = rr & 63; float sn, cs; sincospif((float)((s2 * s2p) & 63) * (1.0f / 32.0f), &sn, &cs);
        const float v = ro == 0 ? (ri == 0 ? cs : sn) : (ri == 0 ? -sn : cs); D2[idx] = f2bf(v * 0.125f); }
    float* rsq = WSP(float, WS_RSQ);
    for (int idx = gid; idx < DEPTH * MTOK * 2; idx += NT) rsq[idx] = 0.f;
    LAS float* ct = (LAS float*)F.lds; LAS float* st = ct + 128;
    if (F.tid < 128) { float sn, cs; sincospif((float)F.tid * (1.0f / 64.0f), &sn, &cs); ct[F.tid] = cs * 0.08838834764831845f; st[F.tid] = sn * 0.08838834764831845f; }
    __syncthreads();
    bf16_t* wcat = WSP(bf16_t, WS_WCAT);
    for (int idx = gid; idx < DEPTH * NG * 128 * 256; idx += NT) { const int k = idx & 255, d = (idx >> 8) & 127, lg = idx >> 15, ro = k >> 7, c = k & 127;
        const float* w = F.in[10] + (size_t)lg * 128 * 128 + d; LAS float* tb = ro ? st : ct; float s = 0.f;
        for (int cp = 0; cp < 128; ++cp) s += tb[(c * cp) & 127] * w[cp * 128];
        wcat[idx] = f2bf(s); }
    __syncthreads();
}
__device__ __forceinline__ void row_stats(const f32x4 (&v)[8], float& mean, float& rstd) {
    float s = 0.f;
#pragma unroll
    for (int i = 0; i < 8; ++i) s += (v[i][0] + v[i][1]) + (v[i][2] + v[i][3]);
    mean = wave_sum(s) * (1.0f / DM); float q = 0.f;
#pragma unroll
    for (int i = 0; i < 8; ++i) { const f32x4 d = v[i] - mean; q += (d[0] * d[0] + d[1] * d[1]) + (d[2] * d[2] + d[3] * d[3]); }
    rstd = rsqrtf(wave_sum(q) * (1.0f / DM) + NORM_EPS);
}
__device__ __forceinline__ void p_ln_first(const Frame& F) {
    const float* x = F.in[0]; const float* mod = WSP(float, WS_MOD); bf16_t* H = WSP(bf16_t, WS_H);
    const int step = F.G * 8; int row = F.bx * 8 + F.wave;
    f32x4 v[8], vn[8];
    if (row < MTOK) { const float* xr = x + (size_t)row * DM + F.lane * 4;
#pragma unroll
        for (int i = 0; i < 8; ++i) vn[i] = *(const f32x4*)(xr + i * 256); }
    for (; row < MTOK; row += step) {
#pragma unroll
        for (int i = 0; i < 8; ++i) v[i] = vn[i];
        if (row + step < MTOK) { const float* xr = x + (size_t)(row + step) * DM + F.lane * 4;
#pragma unroll
            for (int i = 0; i < 8; ++i) vn[i] = *(const f32x4*)(xr + i * 256); }
        float mean, rstd; row_stats(v, mean, rstd);
        const float* mp = mod + (size_t)(row >> 12) * (3 * DM) + F.lane * 4;
#pragma unroll
        for (int i = 0; i < 8; ++i) { const f32x4 sh = *(const f32x4*)(mp + i * 256), sc = *(const f32x4*)(mp + DM + i * 256);
            store4_bf16(H + (size_t)row * DM + F.lane * 4 + i * 256, (v[i] - mean) * rstd * (sc + 1.0f) + sh); }
    }
}
template <bool NEXT> __device__ __forceinline__ void p_ln_post(const Frame& F, int l) {
    const float* xs = l == 0 ? F.in[0] : WSP(float, WS_R); float* dst = NEXT ? WSP(float, WS_R) : F.out; const float* g = F.in[12] + l * DM; const float* bb = F.in[13] + l * DM;
    const float* mod = WSP(float, WS_MOD) + (size_t)(l + 1) * NB * (3 * DM); bf16_t* H = WSP(bf16_t, WS_H);
    const int step = F.G * 8; int row = F.bx * 8 + F.wave;
    f32x4 v[8], vn[8]; u32x2 gy[8], gyn[8];
    if (row < MTOK) { const float* xr = xs + (size_t)row * DM + F.lane * 4; const bf16_t* gr = H + (size_t)row * DM + F.lane * 4;
#pragma unroll
        for (int i = 0; i < 8; ++i) { vn[i] = *(const f32x4*)(xr + i * 256); gyn[i] = *(const u32x2*)(gr + i * 256); } }
    for (; row < MTOK; row += step) {
#pragma unroll
        for (int i = 0; i < 8; ++i) { const u32x2 q = gyn[i];
            v[i] = vn[i] * DN_ALPHA + (f32x4){__uint_as_float(q.x << 16), __uint_as_float(q.x & 0xffff0000u), __uint_as_float(q.y << 16), __uint_as_float(q.y & 0xffff0000u)}; }
        if (row + step < MTOK) { const float* xr = xs + (size_t)(row + step) * DM + F.lane * 4; const bf16_t* gr = H + (size_t)(row + step) * DM + F.lane * 4;
#pragma unroll
            for (int i = 0; i < 8; ++i) { vn[i] = *(const f32x4*)(xr + i * 256); gyn[i] = *(const u32x2*)(gr + i * 256); } }
        float mean, rstd; row_stats(v, mean, rstd);
#pragma unroll
        for (int i = 0; i < 8; ++i) { v[i] = (v[i] - mean) * rstd * *(const f32x4*)(g + F.lane * 4 + i * 256) + *(const f32x4*)(bb + F.lane * 4 + i * 256);
            *(f32x4*)(dst + (size_t)row * DM + F.lane * 4 + i * 256) = v[i]; }
        if (NEXT) { row_stats(v, mean, rstd); const float* mp = mod + (size_t)(row >> 12) * (3 * DM) + F.lane * 4;
#pragma unroll
            for (int i = 0; i < 8; ++i) { const f32x4 sh = *(const f32x4*)(mp + i * 256), sc = *(const f32x4*)(mp + DM + i * 256);
                store4_bf16(H + (size_t)row * DM + F.lane * 4 + i * 256, (v[i] - mean) * rstd * (sc + 1.0f) + sh); } }
    }
}
__device__ __forceinline__ void fft1_naive(const Frame& F) {
    const bf16_t* U = WSP(bf16_t, WS_U); const bf16_t* D1 = WSP(bf16_t, WS_D1); bf16_t* Z = WSP(bf16_t, WS_H);
    const int gid = F.bx * NTHREADS + F.tid, NT = F.G * NTHREADS;
    for (int idx = gid; idx < NB * 64 * NG * 64 * 128; idx += NT) {
        const int c = idx & 127, s2 = (idx >> 7) & 63, g = (idx >> 13) & 7, s1p = (idx >> 16) & 63, b = idx >> 22;
        float yr = 0.f, yi = 0.f;
        for (int s1 = 0; s1 < 64; ++s1) { const float u = bf2f(U[(size_t)(b * SEQ + 64 * s1 + s2) * DF + g * 128 + c]); yr += bf2f(D1[s1p * 64 + s1]) * u; yi += bf2f(D1[(64 + s1p) * 64 + s1]) * u; }
        float st, ct; sincospif((float)(s2 * s1p) * (1.0f / 2048.0f), &st, &ct);
        const size_t zo = ((((size_t)(b * 64 + s1p) * NG + g) * 2) * 64 + s2) * 128 + c;
        Z[zo] = f2bf(yr * ct + yi * st); Z[zo + 64 * 128] = f2bf(yi * ct - yr * st);
    }
}
__device__ __forceinline__ void fft2_naive(const Frame& F, int l) {
    const bf16_t* Z = WSP(bf16_t, WS_H); const bf16_t* D2 = WSP(bf16_t, WS_D2); const bf16_t* wcat = WSP(bf16_t, WS_WCAT) + (size_t)l * NG * 128 * 256; bf16_t* MIX = WSP(bf16_t, WS_MIX);
    LAS float* Xs = (LAS float*)F.lds;
    for (int it = F.bx; it < NB * 64 * NG; it += F.G) {
        const int g = it & 7, s1p = (it >> 3) & 63, b = it >> 9;
        const bf16_t* Zb = Z + ((size_t)(b * 64 + s1p) * NG + g) * 2 * 64 * 128;
        for (int i = 0; i < 32; ++i) { const int o = F.tid + 512 * i, c = o & 127, rr = o >> 7; float s = 0.f;
            for (int k = 0; k < 128; ++k) s += bf2f(D2[rr * 128 + k]) * bf2f(Zb[k * 128 + c]);
            Xs[rr * 128 + c] = bf2f(f2bf(s)); }
        __syncthreads();
        for (int i = 0; i < 16; ++i) { const int o = F.tid + 512 * i, d = o & 127, s2p = o >> 7; float s = 0.f;
            const bf16_t* wr = wcat + (size_t)(g * 128 + d) * 256;
            for (int k = 0; k < 256; ++k) s += Xs[((k >> 7) * 64 + s2p) * 128 + (k & 127)] * bf2f(wr[k]);
            const size_t mo = (size_t)(b * SEQ + s1p + 64 * s2p) * DM + g * 128 + d;
            MIX[mo] = f2bf(s * bf2f(MIX[mo])); }
        __syncthreads();
    }
}
__device__ __forceinline__ void attn_naive(const Frame& F) {
    const bf16_t* Q = WSP(bf16_t, WS_Q); const bf16_t* KV = WSP(bf16_t, WS_KV); const bf16_t* KR = WSP(bf16_t, WS_KR); bf16_t* MIX = WSP(bf16_t, WS_MIX);
    LAS float* qs = (LAS float*)F.lds + F.wave * 192;
    for (int it = F.bx * 8 + F.wave; it < MTOK * NH * 2; it += F.G * 8) {
        const int dh = it & 1, h = (it >> 1) & 7, tok = it >> 4, b = tok >> 12;
        __builtin_amdgcn_wave_barrier(); asm volatile("" ::: "memory");
        for (int e = 0; e < 3; ++e) qs[F.lane + 64 * e] = bf2f(Q[(size_t)tok * NQ + h * DQK + F.lane + 64 * e]);
        asm volatile("s_waitcnt lgkmcnt(0)" ::: "memory"); __builtin_amdgcn_wave_barrier();
        float m = -1e30f, lsum = 0.f; float o[64];
#pragma unroll
        for (int d = 0; d < 64; ++d) o[d] = 0.f;
        for (int t = 0; t < 64; ++t) {
            const size_t key = (size_t)b * SEQ + F.lane + 64 * t; const bf16_t* kn = KV + key * NKV + h * 256; const bf16_t* kr = KR + key * 64;
            float s = 0.f;
#pragma unroll 2
            for (int c = 0; c < 16; ++c) { const bf16x8 kv = *(const bf16x8*)(kn + c * 8);
#pragma unroll
                for (int e = 0; e < 8; ++e) s += qs[c * 8 + e] * bf2f((bf16_t)kv[e]); }
#pragma unroll 2
            for (int c = 0; c < 8; ++c) { const bf16x8 kv = *(const bf16x8*)(kr + c * 8);
#pragma unroll
                for (int e = 0; e < 8; ++e) s += qs[128 + c * 8 + e] * bf2f((bf16_t)kv[e]); }
            s *= ATT_SCALE; const float mn = fmaxf(m, s), a = __expf(m - mn), p = __expf(s - mn); lsum = lsum * a + p; m = mn;
#pragma unroll
            for (int c = 0; c < 8; ++c) { const bf16x8 vv = *(const bf16x8*)(kn + 128 + dh * 64 + c * 8);
#pragma unroll
                for (int e = 0; e < 8; ++e) o[c * 8 + e] = o[c * 8 + e] * a + p * bf2f((bf16_t)vv[e]); }
        }
        const float Mx = wave_max(m), f = __expf(m - Mx); const float L = wave_sum(lsum * f);
        float keep0 = 0.f;
#pragma unroll
        for (int d = 0; d < 64; ++d) { const float od = wave_sum(o[d] * f); if (F.lane == d) keep0 = od; }
        const size_t mo = (size_t)tok * DM + DF + h * 128 + dh * 64 + F.lane;
        MIX[mo] = f2bf(keep0 / L * bf2f(MIX[mo]));
    }
}
namespace att {
constexpr int NW = 8, QBLK = 32, KVBLK = 64;
#ifndef ATT_SDEPTH
#define ATT_SDEPTH 1
#endif
constexpr int SDEPTH = ATT_SDEPTH;
constexpr float THR = 8.f;
constexpr int SHM_V = KVBLK * 128 * 2, SHM_KN = KVBLK * 128 * 2, SHM_KR = KVBLK * 64 * 2;
#ifndef ATT_QLDS
#define ATT_QLDS 2
#endif
constexpr int QLDS = ATT_QLDS, QREG = 12 - QLDS;
constexpr int OFF_V = 0, OFF_KN = 2 * SHM_V, OFF_KR = OFF_KN + 2 * SHM_KN, OFF_WS = OFF_KR + 2 * SHM_KR, OFF_QL = OFF_WS + NW * 64 * 4, OFF_OT = 0, OT_PITCH = 272, SHM_ATTN = OFF_QL + NW * QLDS * 1024;
static_assert(NW * 32 * OT_PITCH <= OFF_WS, "O tiles reuse the K/V buffers");
static_assert(SHM_ATTN <= RING_BYTES, "attention LDS must fit the phase scratch");
#define KSWZ(row, colB) ((row) * 256 + ((colB) ^ (((row) & 15) << 4)))
#define RSWZ(row, ch) ((row) * 128 + ((((ch) ^ (((row) >> 1) & 7))) << 4))
#define SBAR() __builtin_amdgcn_sched_barrier(0)
__device__ __forceinline__ int crow(int r, int hi) { return (r & 3) + 8 * (r >> 2) + 4 * hi; }
__device__ __forceinline__ unsigned cvtpk(float lo, float hi) { unsigned r; asm volatile("v_cvt_pk_bf16_f32 %0, %1, %2" : "=v"(r) : "v"(lo), "v"(hi)); return r; }
__device__ __forceinline__ bf16x8 ld8(const bf16_t* p) { return *reinterpret_cast<const bf16x8*>(p); }

__device__ __forceinline__ void partialSM(f32x16& p0, f32x16& p1, float& m_reg, float& mn, float& alpha) {
  constexpr float C = ATT_SCALE * 1.4426950408889634f;
  float pmax = p0[0]; for (int r = 1; r < 16; ++r) pmax = fmaxf(pmax, p0[r]); for (int r = 0; r < 16; ++r) pmax = fmaxf(pmax, p1[r]);
  { auto rr = __builtin_amdgcn_permlane32_swap(__float_as_uint(pmax), __float_as_uint(pmax), false, false);
    pmax = fmaxf(__uint_as_float(rr[0]), __uint_as_float(rr[1])); }
  if (__builtin_expect(__all(pmax - m_reg <= THR / ATT_SCALE), 1)) { mn = m_reg; alpha = 1.f; }
  else { mn = fmaxf(m_reg, pmax); alpha = __builtin_amdgcn_exp2f((m_reg - mn) * C); m_reg = mn; }
  float mnC = -mn * C;
  for (int r = 0; r < 16; ++r) p0[r] = fmaf(p0[r], C, mnC); for (int r = 0; r < 16; ++r) p1[r] = fmaf(p1[r], C, mnC);
  for (int r = 0; r < 16; ++r) p0[r] = __builtin_amdgcn_exp2f(p0[r]);
}
__device__ __forceinline__ void finishSM(f32x16& p0, f32x16& p1, float alpha, float& l_reg, bf16x8& pa0, bf16x8& pa1, bf16x8& pa2, bf16x8& pa3) {
  for (int r = 0; r < 16; ++r) p1[r] = __builtin_amdgcn_exp2f(p1[r]);
  float ps = 0; for (int r = 0; r < 16; ++r) ps += p0[r]; for (int r = 0; r < 16; ++r) ps += p1[r];
  { auto rr = __builtin_amdgcn_permlane32_swap(__float_as_uint(ps), __float_as_uint(ps), false, false);
    ps = __uint_as_float(rr[0]) + __uint_as_float(rr[1]); }
  l_reg = l_reg * alpha + ps;
#define PK4(P, BASE, OUT) do { unsigned a0 = cvtpk(P[BASE + 0], P[BASE + 1]), a1 = cvtpk(P[BASE + 2], P[BASE + 3]);   \
    unsigned b0 = cvtpk(P[BASE + 4], P[BASE + 5]), b1 = cvtpk(P[BASE + 6], P[BASE + 7]);                              \
    auto r0 = __builtin_amdgcn_permlane32_swap(a0, b0, false, false); auto r1 = __builtin_amdgcn_permlane32_swap(a1, b1, false, false); \
    u32x4 w = {r0[0], r1[0], r0[1], r1[1]}; OUT = *reinterpret_cast<bf16x8*>(&w); } while (0)
  PK4(p0, 0, pa0); PK4(p0, 8, pa1); PK4(p1, 0, pa2); PK4(p1, 8, pa3);
#undef PK4
}
__device__ __forceinline__ bf16x8 qfrag(const bf16x8* qr, const char* ql, int d0) { return *reinterpret_cast<const bf16x8*>(ql + (d0 - QREG) * 1024); }
__device__ __forceinline__ void qkt(f32x16& p0, f32x16& p1, const char* Kn, const char* Kr, const bf16x8* qr, const char* ql, int r32, int hi) {
  p0 = f32x16{}; p1 = f32x16{};
#pragma unroll
  for (int d0 = 0; d0 < 8; ++d0) { int cb = (d0 * 16 + hi * 8) * 2;
    bf16x8 b0 = *reinterpret_cast<const bf16x8*>(Kn + KSWZ(r32, cb));
    bf16x8 b1 = *reinterpret_cast<const bf16x8*>(Kn + KSWZ(32 + r32, cb));
    bf16x8 q = d0 < QREG ? qr[d0 < QREG ? d0 : 0] : qfrag(qr, ql, d0);
    p0 = __builtin_amdgcn_mfma_f32_32x32x16_bf16(b0, q, p0, 0, 0, 0);
    p1 = __builtin_amdgcn_mfma_f32_32x32x16_bf16(b1, q, p1, 0, 0, 0); }
#pragma unroll
  for (int d0 = 0; d0 < 4; ++d0) { int ch = d0 * 2 + hi;
    bf16x8 b0 = *reinterpret_cast<const bf16x8*>(Kr + RSWZ(r32, ch));
    bf16x8 b1 = *reinterpret_cast<const bf16x8*>(Kr + RSWZ(32 + r32, ch));
    bf16x8 q = (8 + d0) < QREG ? qr[(8 + d0) < QREG ? (8 + d0) : 0] : qfrag(qr, ql, 8 + d0);
    p0 = __builtin_amdgcn_mfma_f32_32x32x16_bf16(b0, q, p0, 0, 0, 0);
    p1 = __builtin_amdgcn_mfma_f32_32x32x16_bf16(b1, q, p1, 0, 0, 0); }
}
__device__ __forceinline__ int v_st(int k, int c) { const int kk = (k & ~0xC) | ((k & 4) << 1) | ((k & 8) >> 1); return ((kk >> 3) * 4 + (c >> 5)) * 512 + ((kk & 7) * 32 + (c & 31)) * 2; }
__device__ __forceinline__ int v_rd_base(int lane) { return ((lane & 3) << 3) | (((lane >> 2) & 3) << 6) | (((lane >> 4) & 1) << 5) | (((lane >> 5) & 1) << 8); }
constexpr int v_rd_off(int d0, int ks, int half) { return d0 * 512 + ks * 4096 + half * 2048; }
template <int OFF> __device__ __forceinline__ s16x4 tr_read(int vb) {
  s16x4 r; asm volatile("ds_read_b64_tr_b16 %0, %1 offset:%2" : "=&v"(r) : "v"(vb), "i"(OFF) : "memory"); return r;
}
#define TRPK(L, H) (bf16x8){L[0], L[1], L[2], L[3], H[0], H[1], H[2], H[3]}
template <int D0> __device__ __forceinline__ void pv_one(f32x16& od, int vb, bf16x8 pa0, bf16x8 pa1, bf16x8 pa2, bf16x8 pa3) {
  const s16x4 l0 = tr_read<v_rd_off(D0, 0, 0)>(vb), h0 = tr_read<v_rd_off(D0, 0, 1)>(vb), l1 = tr_read<v_rd_off(D0, 1, 0)>(vb), h1 = tr_read<v_rd_off(D0, 1, 1)>(vb);
  const s16x4 l2 = tr_read<v_rd_off(D0, 2, 0)>(vb), h2 = tr_read<v_rd_off(D0, 2, 1)>(vb), l3 = tr_read<v_rd_off(D0, 3, 0)>(vb), h3 = tr_read<v_rd_off(D0, 3, 1)>(vb);
  asm volatile("s_waitcnt lgkmcnt(0)" ::: "memory"); SBAR();
  od = __builtin_amdgcn_mfma_f32_32x32x16_bf16(pa0, TRPK(l0, h0), od, 0, 0, 0);
  od = __builtin_amdgcn_mfma_f32_32x32x16_bf16(pa1, TRPK(l1, h1), od, 0, 0, 0);
  od = __builtin_amdgcn_mfma_f32_32x32x16_bf16(pa2, TRPK(l2, h2), od, 0, 0, 0);
  od = __builtin_amdgcn_mfma_f32_32x32x16_bf16(pa3, TRPK(l3, h3), od, 0, 0, 0);
}
__device__ __forceinline__ void pv_d0(f32x16* o, int vb, bf16x8 pa0, bf16x8 pa1, bf16x8 pa2, bf16x8 pa3) {
  pv_one<0>(o[0], vb, pa0, pa1, pa2, pa3); pv_one<1>(o[1], vb, pa0, pa1, pa2, pa3); pv_one<2>(o[2], vb, pa0, pa1, pa2, pa3); pv_one<3>(o[3], vb, pa0, pa1, pa2, pa3);
}

template <int VAR>
__device__ __forceinline__ void attn_body(const bf16_t* __restrict__ Qb, const bf16_t* __restrict__ Kn, const bf16_t* __restrict__ Kr,
                                          bf16_t* __restrict__ Gm, int seq, char* lds, int tid) {
  const int wid = tid >> 6, lane = tid & 63, r32 = lane & 31, hi = lane >> 5;
  char* V_lds = lds + OFF_V; char* K_lds = lds + OFF_KN; char* R_lds = lds + OFF_KR;
  float* ws = (float*)(lds + OFF_WS) + wid * 64; float* li_l = ws; float* al_l = ws + 32;
  float m_reg = -1e30f, l_reg = 0; f32x16 o[4] = {}; bf16x8 qr[QREG > 0 ? QREG : 1];
  char* ql = lds + OFF_QL + wid * (QLDS * 1024) + lane * 16;
  const unsigned qoff = (unsigned)((wid * QBLK + r32) * NQ + hi * 8) * 2u;
#pragma unroll
  for (int d0 = 0; d0 < 12; ++d0) { const bf16x8 qv = *(const bf16x8*)((const char*)Qb + qoff + d0 * 32); if (d0 < QREG) qr[d0 < QREG ? d0 : 0] = qv; else *reinterpret_cast<bf16x8*>(ql + (d0 - QREG) * 1024) = qv; }
  const int sr = tid >> 4, sc = (tid & 15) * 8, vst0 = v_st(sr, sc), vst1 = v_st(32 + sr, sc);
  const int rr_ = tid >> 3, rc_ = tid & 7;
  const int vb0 = (int)(uintptr_t)V_lds + v_rd_base(lane);
  struct { bf16x8 vs0, vs1, ks0, ks1, kr; } sr_[SDEPTH];
  const unsigned voff = (unsigned)(sr * NKV + sc) * 2u, voffr = (unsigned)(rr_ * 64 + rc_ * 8) * 2u;
#define SLOAD(i, k0) do { const char* kb_ = (const char*)(Kn + (long)(k0) * NKV); const char* rb_ = (const char*)(Kr + (long)(k0) * 64); \
    sr_[i].vs0 = *(const bf16x8*)(kb_ + 256 + voff); sr_[i].vs1 = *(const bf16x8*)(kb_ + (32 * NKV * 2 + 256) + voff); \
    sr_[i].ks0 = *(const bf16x8*)(kb_ + voff); sr_[i].ks1 = *(const bf16x8*)(kb_ + 32 * NKV * 2 + voff); \
    sr_[i].kr = *(const bf16x8*)(rb_ + voffr); } while (0)
#define SWRITE(b, i) do { *(bf16x8*)(V_lds + (b) * SHM_V + vst0) = sr_[i].vs0;          \
    *(bf16x8*)(V_lds + (b) * SHM_V + vst1) = sr_[i].vs1; int kc = sc * 2;               \
    *(bf16x8*)(K_lds + (b) * SHM_KN + KSWZ(sr, kc)) = sr_[i].ks0;                       \
    *(bf16x8*)(K_lds + (b) * SHM_KN + KSWZ(32 + sr, kc)) = sr_[i].ks1;                  \
    *(bf16x8*)(R_lds + (b) * SHM_KR + RSWZ(rr_, rc_)) = sr_[i].kr; } while (0)
#define SLOADV(i, k0) do { if constexpr (VAR != 4) SLOAD(i, k0); } while (0)
#define SWRITEV(b, i) do { if constexpr (VAR != 4) SWRITE(b, i); } while (0)
#define SWAIT() do { if constexpr (SDEPTH == 2) asm volatile("s_waitcnt vmcnt(5)" ::: "memory"); else asm volatile("s_waitcnt vmcnt(0)" ::: "memory"); } while (0)
#define RESC(a) do { if (__any((a) < 1.f)) { if (hi == 0) al_l[r32] = (a); asm volatile("s_waitcnt lgkmcnt(0)" ::: "memory"); \
    for (int d = 0; d < 4; ++d) for (int r = 0; r < 16; ++r) o[d][r] *= al_l[crow(r, hi)]; } } while (0)
  f32x16 pA0, pA1, pB0, pB1; float mnA, mnB, alA, alB; bf16x8 pa0, pa1, pa2, pa3; const int NT = seq / KVBLK;
#define QKT(P0, P1, KN, KR) do { if constexpr (VAR == 3) { P0 = o[0]; P1 = o[1]; } else qkt(P0, P1, KN, KR, qr, ql, r32, hi); } while (0)
#define PSM(P0, P1, MN, AL) do { if constexpr (VAR == 1) { MN = m_reg; AL = 1.f; } else partialSM(P0, P1, m_reg, MN, AL); } while (0)
#define FSM(P0, P1, AL) do { if constexpr (VAR == 1) { pa0 = __builtin_bit_cast(bf16x8, (f32x4){P0[0], P0[1], P0[2], P0[3]}); pa1 = __builtin_bit_cast(bf16x8, (f32x4){P0[4], P0[5], P0[6], P0[7]}); \
      pa2 = __builtin_bit_cast(bf16x8, (f32x4){P1[0], P1[1], P1[2], P1[3]}); pa3 = __builtin_bit_cast(bf16x8, (f32x4){P1[4], P1[5], P1[6], P1[7]}); l_reg += P0[8] + P1[9]; } \
    else finishSM(P0, P1, AL, l_reg, pa0, pa1, pa2, pa3); } while (0)
#define PVD(VB) do { if constexpr (VAR == 2) { o[0][0] += __builtin_bit_cast(f32x4, pa0)[0]; o[1][1] += __builtin_bit_cast(f32x4, pa1)[1]; o[2][2] += __builtin_bit_cast(f32x4, pa2)[2]; o[3][3] += __builtin_bit_cast(f32x4, pa3)[3]; } else pv_d0(o, VB, pa0, pa1, pa2, pa3); } while (0)
#define SYNC() do { if constexpr (VAR != 5) __syncthreads(); } while (0)
  constexpr int SE = 0, SO = SDEPTH - 1;
  SLOAD(SE, 0); asm volatile("s_waitcnt vmcnt(0)" ::: "memory"); SWRITE(0, SE); SYNC();
  QKT(pA0, pA1, K_lds, R_lds); PSM(pA0, pA1, mnA, alA);
  SLOAD(SO, KVBLK); if constexpr (SDEPTH == 2) { if (2 < NT) SLOAD(SE, 2 * KVBLK); }
  SWAIT(); SWRITE(1, SO); SYNC();
  for (int j = 1; j + 1 < NT; j += 2) {
    SBAR(); QKT(pB0, pB1, K_lds + SHM_KN, R_lds + SHM_KR);
    FSM(pA0, pA1, alA); SBAR();
    SLOADV(SO, (j + SDEPTH) * KVBLK); SBAR();
    PVD(vb0); PSM(pB0, pB1, mnB, alB);
    SYNC(); SWAIT(); SWRITEV(0, SE);
    RESC(alB); SYNC();
    SBAR(); QKT(pA0, pA1, K_lds, R_lds);
    FSM(pB0, pB1, alB); SBAR();
    if (SDEPTH == 1 || j + 3 < NT) SLOADV(SE, (j + 1 + SDEPTH) * KVBLK); SBAR();
    PVD(vb0 + (int)SHM_V); PSM(pA0, pA1, mnA, alA);
    SYNC(); SWAIT(); SWRITEV(1, SO);
    RESC(alA); SYNC();
  }
  SBAR(); QKT(pB0, pB1, K_lds + SHM_KN, R_lds + SHM_KR);
  FSM(pA0, pA1, alA); SBAR();
  PVD(vb0); PSM(pB0, pB1, mnB, alB);
  SYNC(); RESC(alB);
  FSM(pB0, pB1, alB); SBAR();
  PVD(vb0 + (int)SHM_V);
  SBAR(); asm volatile("" ::: "memory");
  u32x4 gt[8]; const int grow = lane >> 4, gc16 = lane & 15;
  bf16_t* Gw = Gm + (size_t)(wid * QBLK + grow) * DM + gc16 * 8;
#pragma unroll
  for (int i = 0; i < 8; ++i) gt[i] = *(const u32x4*)(Gw + (size_t)(4 * i) * DM);
  if (hi == 0) li_l[r32] = l_reg;
  __syncthreads();
  char* ot = lds + OFF_OT + wid * (32 * OT_PITCH);
#pragma unroll
  for (int r = 0; r < 16; ++r) { const float rl = __builtin_amdgcn_rcpf(li_l[crow(r, hi)]); char* orow = ot + crow(r, hi) * OT_PITCH + r32 * 2;
#pragma unroll
    for (int d0 = 0; d0 < 4; ++d0) *(bf16_t*)(orow + d0 * 64) = f2bf(o[d0][r] * rl); }
  asm volatile("s_waitcnt lgkmcnt(0)" ::: "memory");
#pragma unroll
  for (int i = 0; i < 8; ++i) { const u32x4 ov = *(const u32x4*)(ot + (grow + 4 * i) * OT_PITCH + gc16 * 16); const u32x4 gv = gt[i]; u32x4 w;
#pragma unroll
    for (int e = 0; e < 4; ++e) { const float a0 = __uint_as_float(ov[e] << 16) * __uint_as_float(gv[e] << 16), a1 = __uint_as_float(ov[e] & 0xffff0000u) * __uint_as_float(gv[e] & 0xffff0000u); w[e] = cvt_pk_bf16(a0, a1); }
    *(u32x4*)(Gw + (size_t)(4 * i) * DM) = w; }
#undef SLOAD
#undef SLOADV
#undef SWRITEV
#undef QKT
#undef PSM
#undef FSM
#undef PVD
#undef SYNC
#undef SWRITE
#undef SWAIT
#undef RESC
}
}

template <int VAR = 0>
__device__ __forceinline__ void attn_fast(const Frame& F) {
    const bf16_t* Q = WSP(bf16_t, WS_Q); const bf16_t* KV = WSP(bf16_t, WS_KV); const bf16_t* KR = WSP(bf16_t, WS_KR); bf16_t* MIX = WSP(bf16_t, F.mix_off);
    for (int it = F.vcu; it < NB * NH * (SEQ / 256); it += F.G) {
        const int qb = it & 15, p = it >> 4, h = p & 7, b = p >> 3;
        const size_t t0 = (size_t)b * SEQ, q0 = t0 + (size_t)qb * 256;
        int t = F.tid; asm volatile("" : "+v"(t));
        att::attn_body<VAR>(Q + q0 * NQ + h * DQK, KV + t0 * NKV + h * 256, KR + t0 * 64, MIX + q0 * DM + DF + h * 128, SEQ, F.ldsg, t);
        __syncthreads();
    }
}
namespace fft {
using att::v_st; using att::v_rd_base; using att::v_rd_off; using att::tr_read; using att::crow;
constexpr int OPITCH = 272;
constexpr int F1_T = 0, F1_OUT = 16384, F1_END = F1_OUT + 128 * OPITCH;
constexpr int XPITCH = 528;
constexpr int F2_Z = 0, F2_XL = 32768, F2_YL = F2_XL + 64 * XPITCH, F2_D2 = F2_YL + 64 * XPITCH, F2_END = F2_D2 + 128 * OPITCH;
static_assert(F1_END <= RING_BYTES && F2_END <= RING_BYTES, "FFT LDS must fit the phase scratch");
}
__device__ __forceinline__ void fft1_fast(const Frame& F) {
    using namespace fft;
    const bf16_t* U = WSP(bf16_t, WS_U); const bf16_t* D1 = WSP(bf16_t, WS_D1); bf16_t* Z = WSP(bf16_t, WS_H);
    const int tid = F.tid, wid = tid >> 6, lane = tid & 63, r32 = lane & 31, hi = lane >> 5, half = wid & 1, cb = wid >> 1;
    char* lds = F.ldsg;
    bf16x8 bfr[2][4];
#pragma unroll
    for (int ri = 0; ri < 2; ++ri)
#pragma unroll
        for (int ks = 0; ks < 4; ++ks) bfr[ri][ks] = *(const bf16x8*)(D1 + (ri * 64 + half * 32 + r32) * 64 + 16 * ks + 8 * hi);
    const int sr = tid >> 4, sc = (tid & 15) * 8, vst0 = v_st(sr, sc), vst1 = v_st(32 + sr, sc);
    const int vb = (int)(uintptr_t)(lds + F1_T) + v_rd_base(lane) + cb * 512;
    const int s1p = half * 32 + r32;
    int it = F.bx; if (it >= NB * 64 * NG) return;
    bf16x8 u0, u1;
#define F1_LOAD(IT) do { const int g_ = (IT) & 7, s2_ = ((IT) >> 3) & 63, b_ = (IT) >> 9; const bf16_t* up = U + ((size_t)(b_ * SEQ + s2_)) * DF + g_ * 128 + sc; \
        u0 = *(const bf16x8*)(up + (size_t)(64 * sr) * DF); u1 = *(const bf16x8*)(up + (size_t)(64 * (sr + 32)) * DF); } while (0)
    F1_LOAD(it);
    for (; it < NB * 64 * NG; it += F.G) {
        const int g = it & 7, s2 = (it >> 3) & 63, b = it >> 9;
        *(bf16x8*)(lds + F1_T + vst0) = u0; *(bf16x8*)(lds + F1_T + vst1) = u1;
        __syncthreads();
        if (it + F.G < NB * 64 * NG) F1_LOAD(it + F.G);
        f32x16 acc0 = {}, acc1 = {};
        { const s16x4 l0 = tr_read<v_rd_off(0, 0, 0)>(vb), h0 = tr_read<v_rd_off(0, 0, 1)>(vb), l1 = tr_read<v_rd_off(0, 1, 0)>(vb), h1 = tr_read<v_rd_off(0, 1, 1)>(vb);
          const s16x4 l2 = tr_read<v_rd_off(0, 2, 0)>(vb), h2 = tr_read<v_rd_off(0, 2, 1)>(vb), l3 = tr_read<v_rd_off(0, 3, 0)>(vb), h3 = tr_read<v_rd_off(0, 3, 1)>(vb);
          asm volatile("s_waitcnt lgkmcnt(0)" ::: "memory"); __builtin_amdgcn_sched_barrier(0);
          acc0 = __builtin_amdgcn_mfma_f32_32x32x16_bf16(TRPK(l0, h0), bfr[0][0], acc0, 0, 0, 0); acc1 = __builtin_amdgcn_mfma_f32_32x32x16_bf16(TRPK(l0, h0), bfr[1][0], acc1, 0, 0, 0);
          acc0 = __builtin_amdgcn_mfma_f32_32x32x16_bf16(TRPK(l1, h1), bfr[0][1], acc0, 0, 0, 0); acc1 = __builtin_amdgcn_mfma_f32_32x32x16_bf16(TRPK(l1, h1), bfr[1][1], acc1, 0, 0, 0);
          acc0 = __builtin_amdgcn_mfma_f32_32x32x16_bf16(TRPK(l2, h2), bfr[0][2], acc0, 0, 0, 0); acc1 = __builtin_amdgcn_mfma_f32_32x32x16_bf16(TRPK(l2, h2), bfr[1][2], acc1, 0, 0, 0);
          acc0 = __builtin_amdgcn_mfma_f32_32x32x16_bf16(TRPK(l3, h3), bfr[0][3], acc0, 0, 0, 0); acc1 = __builtin_amdgcn_mfma_f32_32x32x16_bf16(TRPK(l3, h3), bfr[1][3], acc1, 0, 0, 0); }
        float st, ct; sincospif((float)(s2 * s1p) * (1.0f / 2048.0f), &st, &ct);
        char* o0 = lds + F1_OUT + s1p * OPITCH + (cb * 32 + 4 * hi) * 2; char* o1 = o0 + 64 * OPITCH;
#pragma unroll
        for (int q = 0; q < 4; ++q) { float zr[4], zi[4];
#pragma unroll
            for (int j = 0; j < 4; ++j) { const float yr = acc0[4 * q + j], yi = acc1[4 * q + j]; zr[j] = yr * ct + yi * st; zi[j] = yi * ct - yr * st; }
            *(u32x2*)(o0 + q * 16) = (u32x2){cvt_pk_bf16(zr[0], zr[1]), cvt_pk_bf16(zr[2], zr[3])};
            *(u32x2*)(o1 + q * 16) = (u32x2){cvt_pk_bf16(zi[0], zi[1]), cvt_pk_bf16(zi[2], zi[3])}; }
        __syncthreads();
#pragma unroll
        for (int i = 0; i < 4; ++i) { const int q = tid + 512 * i, row = q >> 4, c16 = q & 15, ri = row >> 6, sp = row & 63;
            const u32x4 v = *(const u32x4*)(lds + F1_OUT + row * OPITCH + c16 * 16);
            *(u32x4*)(Z + (((((size_t)(b * 64 + sp) * NG + g) * 2 + ri) * 64 + s2) * 128) + c16 * 8) = v; }
    }
#undef F1_LOAD
    __syncthreads();
}
__device__ __forceinline__ void fft2_fast(const Frame& F, int l) {
    using namespace fft;
    const bf16_t* Z = WSP(bf16_t, WS_H); const bf16_t* D2 = WSP(bf16_t, WS_D2); const bf16_t* wcat = WSP(bf16_t, WS_WCAT) + (size_t)l * NG * 128 * 256; bf16_t* MIX = WSP(bf16_t, F.mix_off);
    const int tid = F.tid, wid = tid >> 6, lane = tid & 63, r32 = lane & 31, hi = lane >> 5, cb = wid & 3, h2 = wid >> 2;
    char* lds = F.ldsg;
    int it = F.bx; if (it >= NB * 64 * NG) return;
#pragma unroll
    for (int i = 0; i < 4; ++i) { const int q = tid + 512 * i, row = q >> 4, c16 = q & 15; *(u32x4*)(lds + F2_D2 + row * OPITCH + c16 * 16) = *(const u32x4*)(D2 + row * 128 + c16 * 8); }
    const int sr = tid >> 4, sc = (tid & 15) * 8, vst0 = v_st(sr, sc), vst1 = v_st(32 + sr, sc);
    const int vb = (int)(uintptr_t)(lds + F2_Z) + v_rd_base(lane) + cb * 512;
    bf16x8 wfr[16]; int gcur = -1;
    bf16x8 z0, z1, z2, z3, g0, g1;
#define F2_LOAD(IT) do { const int g_ = (IT) & 7, sp_ = ((IT) >> 3) & 63, b_ = (IT) >> 9; const bf16_t* zp = Z + ((size_t)(b_ * 64 + sp_) * NG + g_) * (2 * 64 * 128) + sr * 128 + sc; \
        z0 = *(const bf16x8*)(zp); z1 = *(const bf16x8*)(zp + 32 * 128); z2 = *(const bf16x8*)(zp + 64 * 128); z3 = *(const bf16x8*)(zp + 96 * 128); \
        const bf16_t* mp = MIX + ((size_t)(b_ * SEQ + sp_ + 64 * (tid >> 4))) * DM + g_ * 128 + (tid & 15) * 8; g0 = *(const bf16x8*)(mp); g1 = *(const bf16x8*)(mp + (size_t)(64 * 32) * DM); } while (0)
    F2_LOAD(it);
    for (; it < NB * 64 * NG; it += F.G) {
        const int g = it & 7, sp = (it >> 3) & 63, b = it >> 9;
        if (g != gcur) { gcur = g;
#pragma unroll
            for (int ks = 0; ks < 16; ++ks) wfr[ks] = *(const bf16x8*)(wcat + (size_t)(g * 128 + cb * 32 + r32) * 256 + 16 * ks + 8 * hi); }
        *(bf16x8*)(lds + F2_Z + vst0) = z0; *(bf16x8*)(lds + F2_Z + vst1) = z1; *(bf16x8*)(lds + F2_Z + 16384 + vst0) = z2; *(bf16x8*)(lds + F2_Z + 16384 + vst1) = z3;
        const bf16x8 gg0 = g0, gg1 = g1;
        __syncthreads();
        if (it + F.G < NB * 64 * NG) F2_LOAD(it + F.G);
#if defined(FFT2_P1_NAIVE)
        { const bf16_t* Zb = Z + ((size_t)(b * 64 + sp) * NG + g) * (2 * 64 * 128);
          for (int i = 0; i < 32; ++i) { const int o = tid + 512 * i, c = o & 127, rr = o >> 7; float s_ = 0.f;
              for (int k = 0; k < 128; ++k) s_ += bf2f(D2[rr * 128 + k]) * bf2f(Zb[k * 128 + c]);
              *(bf16_t*)(lds + F2_XL + (rr & 63) * XPITCH + ((rr >> 6) * 128 + c) * 2) = f2bf(s_); } }
#else
        f32x16 x0 = {}, x1 = {};
        const char* d2p = lds + F2_D2 + (h2 * 32 + r32) * OPITCH + 16 * hi;
#pragma unroll
        for (int t = 0; t < 2; ++t) {
            const int vbt = vb + t * 16384;
            const s16x4 l0 = tr_read<v_rd_off(0, 0, 0)>(vbt), h0 = tr_read<v_rd_off(0, 0, 1)>(vbt), l1 = tr_read<v_rd_off(0, 1, 0)>(vbt), h1 = tr_read<v_rd_off(0, 1, 1)>(vbt);
            const s16x4 l2 = tr_read<v_rd_off(0, 2, 0)>(vbt), h2_ = tr_read<v_rd_off(0, 2, 1)>(vbt), l3 = tr_read<v_rd_off(0, 3, 0)>(vbt), h3 = tr_read<v_rd_off(0, 3, 1)>(vbt);
            bf16x8 e0[4], e1[4];
#pragma unroll
            for (int ks = 0; ks < 4; ++ks) { e0[ks] = *(const bf16x8*)(d2p + (t * 4 + ks) * 32); e1[ks] = *(const bf16x8*)(d2p + 64 * OPITCH + (t * 4 + ks) * 32); }
            asm volatile("s_waitcnt lgkmcnt(0)" ::: "memory"); __builtin_amdgcn_sched_barrier(0);
            x0 = __builtin_amdgcn_mfma_f32_32x32x16_bf16(TRPK(l0, h0), e0[0], x0, 0, 0, 0); x1 = __builtin_amdgcn_mfma_f32_32x32x16_bf16(TRPK(l0, h0), e1[0], x1, 0, 0, 0);
            x0 = __builtin_amdgcn_mfma_f32_32x32x16_bf16(TRPK(l1, h1), e0[1], x0, 0, 0, 0); x1 = __builtin_amdgcn_mfma_f32_32x32x16_bf16(TRPK(l1, h1), e1[1], x1, 0, 0, 0);
            x0 = __builtin_amdgcn_mfma_f32_32x32x16_bf16(TRPK(l2, h2_), e0[2], x0, 0, 0, 0); x1 = __builtin_amdgcn_mfma_f32_32x32x16_bf16(TRPK(l2, h2_), e1[2], x1, 0, 0, 0);
            x0 = __builtin_amdgcn_mfma_f32_32x32x16_bf16(TRPK(l3, h3), e0[3], x0, 0, 0, 0); x1 = __builtin_amdgcn_mfma_f32_32x32x16_bf16(TRPK(l3, h3), e1[3], x1, 0, 0, 0);
        }
        { char* xr = lds + F2_XL + (h2 * 32 + r32) * XPITCH + (cb * 32 + 4 * hi) * 2;
#pragma unroll
          for (int q = 0; q < 4; ++q) { *(u32x2*)(xr + q * 16) = (u32x2){cvt_pk_bf16(x0[4 * q], x0[4 * q + 1]), cvt_pk_bf16(x0[4 * q + 2], x0[4 * q + 3])};
              *(u32x2*)(xr + 256 + q * 16) = (u32x2){cvt_pk_bf16(x1[4 * q], x1[4 * q + 1]), cvt_pk_bf16(x1[4 * q + 2], x1[4 * q + 3])}; } }
#endif
        __syncthreads();
#if defined(FFT2_P2_NAIVE)
        for (int i = 0; i < 16; ++i) { const int o = tid + 512 * i, d = o & 127, s2p = o >> 7; float s_ = 0.f;
            const bf16_t* wr_ = wcat + (size_t)(g * 128 + d) * 256;
            for (int k = 0; k < 256; ++k) s_ += bf2f(*(const bf16_t*)(lds + F2_XL + s2p * XPITCH + k * 2)) * bf2f(wr_[k]);
            *(float*)(lds + F2_YL + s2p * XPITCH + d * 4) = s_; }
#else
        f32x16 y = {};
        { const char* xb = lds + F2_XL + (h2 * 32 + r32) * XPITCH + 16 * hi;
#pragma unroll
          for (int ks = 0; ks < 16; ++ks) { const bf16x8 xf = *(const bf16x8*)(xb + ks * 32); y = __builtin_amdgcn_mfma_f32_32x32x16_bf16(wfr[ks], xf, y, 0, 0, 0); } }
        { char* yr = lds + F2_YL + (h2 * 32 + r32) * XPITCH + (cb * 32 + 4 * hi) * 4;
#pragma unroll
          for (int q = 0; q < 4; ++q) *(f32x4*)(yr + q * 32) = (f32x4){y[4 * q], y[4 * q + 1], y[4 * q + 2], y[4 * q + 3]}; }
#endif
        __syncthreads();
#pragma unroll
        for (int i = 0; i < 2; ++i) { const int row = (tid >> 4) + 32 * i, c8 = (tid & 15) * 8; const bf16x8 gv = i ? gg1 : gg0;
            const f32x4 ya = *(const f32x4*)(lds + F2_YL + row * XPITCH + c8 * 4), yb = *(const f32x4*)(lds + F2_YL + row * XPITCH + c8 * 4 + 16);
            f32x4 ga = {bf2f((bf16_t)gv[0]), bf2f((bf16_t)gv[1]), bf2f((bf16_t)gv[2]), bf2f((bf16_t)gv[3])}, gb = {bf2f((bf16_t)gv[4]), bf2f((bf16_t)gv[5]), bf2f((bf16_t)gv[6]), bf2f((bf16_t)gv[7])};
            store8_bf16(MIX + ((size_t)(b * SEQ + sp + 64 * row)) * DM + g * 128 + c8, ya * ga, yb * gb); }
    }
#undef F2_LOAD
    __syncthreads();
}
#ifndef DIAG_ONLY
#define DIAG_ONLY -1
#endif
#define DIAG_EN(k) (DIAG_ONLY < 0 || DIAG_ONLY == (k))
#ifndef PROBE_VAR
#define PROBE_VAR 0
#endif
#ifndef PROBE_REP
#define PROBE_REP -1
#endif
struct Args { const float* in[14]; float* out; unsigned char* ws; int ph_lo, ph_hi; };
constexpr int N_PHASES = 2 + 5 * DEPTH;

template <class Epi, class Sched> __device__ __forceinline__ void run_gemm(const Frame& F, const pg8::Gemm& g, const Sched& S, const Epi& E) {
#if IMPL_GEMM
    pg8::gemm_phase<Epi, Sched, PG8_ALIGN, PG8_SP2>(F.lds, g, S, E, F.tid);
#else
    pg8::gemm_phase_naive<Epi, Sched>(g, S, E, F.tid);
#endif
}

#define PH_IN(k) (lo <= (k) && (k) < hi)
#define PH_SEAM(k) do { if (PH_IN(k) && PH_IN((k) + 1)) xcd_barrier(bar); } while (0)
#define PH_ENTER() do { int _t = threadIdx.x; asm volatile("" : "+v"(_t)); F.tid = _t; F.lane = _t & 63; } while (0)

template <int L> __device__ __forceinline__ void layer_phases(Frame& F, const int lo, const int hi, const XcdBarrier& bar) {
    constexpr int P = 2 + 5 * L;
    float* rsq = WSP(float, WS_RSQ) + (size_t)L * MTOK * 2;
    if (PH_IN(P + 0) && DIAG_EN(2)) {
        PH_ENTER();
        pg8::Gemm g{WSP(bf16_t, WS_H), WSP(bf16_t, WS_WIN) + (size_t)L * NINP * DM, MTOK, NINP, DM};
        pg8::StaticOrder S; S.init(MTOK, NINP, F.G, F.bx);
        EpiIn E{WSP(bf16_t, WS_U), WSP(bf16_t, WS_MIX), WSP(bf16_t, WS_CQ), WSP(bf16_t, WS_CKV), WSP(bf16_t, WS_KR), rsq, WSP(float, WS_RCOS), WSP(float, WS_RSIN)};
        run_gemm(F, g, S, E);
        if (PROBE_REP == 2 && L == 0) { xcd_barrier(bar); EpiIn E2 = E; E2.rsq = WSP(float, WS_R); run_gemm(F, g, S, E2); }
    }
    PH_SEAM(P + 0);
    if (PH_IN(P + 1) && DIAG_EN(3)) {
        PH_ENTER();
        { pg8::Gemm g{WSP(bf16_t, WS_CQ), WSP(bf16_t, WS_WQ) + (size_t)L * NQ * QLR, MTOK, NQ, QLR};
          pg8::SplitOrder S; S.init(F.G, F.bx, NQ / 256, 0);
          EpiQ E{WSP(bf16_t, WS_Q), rsq, WSP(float, WS_RCOS), WSP(float, WS_RSIN)};
          run_gemm(F, g, S, E); }
        { pg8::Gemm g{WSP(bf16_t, WS_CKV), WSP(bf16_t, WS_WKV) + (size_t)L * NKV * KVLR, MTOK, NKV, KVLR};
          pg8::SplitOrder S; S.init(F.G, F.bx, NKV / 256, 1);
          EpiKV E{WSP(bf16_t, WS_KV), rsq};
          run_gemm(F, g, S, E); }
        if (PROBE_REP == 3 && L == 0) { xcd_barrier(bar);
          { pg8::Gemm g{WSP(bf16_t, WS_CQ), WSP(bf16_t, WS_WQ) + (size_t)L * NQ * QLR, MTOK, NQ, QLR}; pg8::SplitOrder S; S.init(F.G, F.bx, NQ / 256, 0); EpiQ E{WSP(bf16_t, WS_Q), rsq, WSP(float, WS_RCOS), WSP(float, WS_RSIN)}; run_gemm(F, g, S, E); }
          { pg8::Gemm g{WSP(bf16_t, WS_CKV), WSP(bf16_t, WS_WKV) + (size_t)L * NKV * KVLR, MTOK, NKV, KVLR}; pg8::SplitOrder S; S.init(F.G, F.bx, NKV / 256, 1); EpiKV E{WSP(bf16_t, WS_KV), rsq}; run_gemm(F, g, S, E); } }
#if IMPL_FFT & 1
        fft1_fast(F);
#else
        fft1_naive(F);
#endif
        if (PROBE_REP == 7 && L == 0) { xcd_barrier(bar); fft1_fast(F); }
    }
    PH_SEAM(P + 1);
    if (PH_IN(P + 2) && DIAG_EN(4)) {
        PH_ENTER();
#if IMPL_ATTN
        attn_fast(F);
        if (PROBE_REP == 4 && L == 0) { __syncthreads(); F.mix_off = WS_R; attn_fast<PROBE_VAR>(F); F.mix_off = WS_MIX; }
#else
        attn_naive(F);
#endif
        __syncthreads();
#if IMPL_FFT & 2
        fft2_fast(F, L);
        if (PROBE_REP == 8 && L == 0) { __syncthreads(); F.mix_off = WS_R; fft2_fast(F, L); F.mix_off = WS_MIX; }
#else
        fft2_naive(F, L);
#endif
    }
    PH_SEAM(P + 2);
    if (PH_IN(P + 3) && DIAG_EN(5)) {
        PH_ENTER();
        pg8::Gemm g{WSP(bf16_t, WS_MIX), WSP(bf16_t, WS_WOUT) + (size_t)L * DM * DM, MTOK, DM, DM};
        pg8::StaticOrder S; S.init(MTOK, DM, F.G, F.bx);
        EpiOut E{WSP(bf16_t, WS_H), WSP(float, WS_MOD) + (size_t)L * NB * (3 * DM) + 2 * DM};
        run_gemm(F, g, S, E);
        if (PROBE_REP == 5 && L == 0) { xcd_barrier(bar); run_gemm(F, g, S, E); }
    }
    PH_SEAM(P + 3);
    if (PH_IN(P + 4) && DIAG_EN(6)) {
        PH_ENTER();
        if (L + 1 < DEPTH) p_ln_post<true>(F, L); else p_ln_post<false>(F, L);
        if (PROBE_REP == 6 && L + 1 == DEPTH) { xcd_barrier(bar); p_ln_post<false>(F, L); }
    }
    PH_SEAM(P + 4);
}

__global__ void __launch_bounds__(NTHREADS, 2) fwd_kernel(Args args) {
    extern __shared__ __attribute__((aligned(16))) unsigned char lds[];
    Frame F;
    F.in[0] = args.in[0]; F.in[1] = args.in[1]; F.in[2] = args.in[2]; F.in[3] = args.in[3]; F.in[4] = args.in[4]; F.in[5] = args.in[5]; F.in[6] = args.in[6]; F.in[7] = args.in[7]; F.in[8] = args.in[8]; F.in[9] = args.in[9]; F.in[10] = args.in[10]; F.in[11] = args.in[11]; F.in[12] = args.in[12]; F.in[13] = args.in[13];
    F.out = args.out; F.ws = args.ws; F.lds = (LAS unsigned char*)lds; F.ldsg = (char*)lds;
    F.tid = threadIdx.x; F.lane = F.tid & 63; F.wave = __builtin_amdgcn_readfirstlane(F.tid >> 6); F.G = gridDim.x; F.bx = blockIdx.x;
    F.vcu = (F.G % 8 == 0) ? (F.bx % 8) * (F.G / 8) + F.bx / 8 : F.bx; F.mix_off = WS_MIX;
    volatile LAS unsigned* MISC = (volatile LAS unsigned*)(F.lds + MISC_OFF);
    if (F.tid < 64) MISC[F.tid] = 0u;
    __syncthreads();
    const int lo = args.ph_lo, hi = args.ph_hi;
    XcdBarrier bar; bar.bar = WSP(unsigned, WS_CTL); bar.x = 0; bar.st = MISC;
    if (hi - lo > 1) bar = xcd_barrier_post(WSP(unsigned, WS_CTL), MISC);
    if (PH_IN(0) && DIAG_EN(0)) { PH_ENTER(); p0_weights(F); p0_mod(F); p0_tables(F); if (PROBE_REP == 0) { xcd_barrier(bar); p0_weights(F); p0_mod(F); p0_tables(F); } }
    PH_SEAM(0);
    if (PH_IN(1) && DIAG_EN(1)) { PH_ENTER(); p_ln_first(F); if (PROBE_REP == 1) { xcd_barrier(bar); p_ln_first(F); } }
    PH_SEAM(1);
    layer_phases<0>(F, lo, hi, bar);
    layer_phases<1>(F, lo, hi, bar);
}

extern "C" void kernel_launch(void* const* d_in, const int* in_sizes, int n_in, void* d_out, int out_size, void* d_ws, size_t ws_size, hipStream_t stream) {
    static int grid = 0;
    if (grid == 0) {
        if (n_in != 14 || in_sizes[0] != MTOK * DM || out_size != MTOK * DM || ws_size < WS_END) {
            fprintf(stderr, "kernel_launch: shape mismatch (n_in %d, in0 %d, out %d, ws %zu, need ws >= %zu); nothing launched\n", n_in, n_in > 0 ? in_sizes[0] : -1, out_size, ws_size, (size_t)WS_END); grid = -1; return; }
        int dev = 0, cus = 0, per_cu = 0;
        if (hipGetDevice(&dev) != hipSuccess || hipDeviceGetAttribute(&cus, hipDeviceAttributeMultiprocessorCount, dev) != hipSuccess) { grid = -1; return; }
        if (hipFuncSetAttribute((const void*)fwd_kernel, hipFuncAttributeMaxDynamicSharedMemorySize, LDS_BYTES) != hipSuccess) { fprintf(stderr, "kernel_launch: hipFuncSetAttribute failed\n"); grid = -1; return; }
        if (hipOccupancyMaxActiveBlocksPerMultiprocessor(&per_cu, (const void*)fwd_kernel, NTHREADS, LDS_BYTES) != hipSuccess || per_cu < 1) { fprintf(stderr, "kernel_launch: occupancy query failed (%d)\n", per_cu); (void)hipGetLastError(); per_cu = 1; }
        if (per_cu > 1) per_cu = 1;
        grid = cus * per_cu;
    }
    if (grid < 0) return;
    if (hipMemsetAsync((char*)d_ws + WS_CTL, 0, CTL_BYTES, stream) != hipSuccess) { fprintf(stderr, "kernel_launch: hipMemsetAsync failed\n"); return; }
    Args a{};
    for (int i = 0; i < 14; ++i) a.in[i] = (const float*)d_in[i];
    a.out = (float*)d_out; a.ws = (unsigned char*)d_ws;
#if N_LAUNCH_MODE
    a.ph_lo = 0; a.ph_hi = N_PHASES;
    hipLaunchKernelGGL(fwd_kernel, dim3(grid), dim3(NTHREADS), LDS_BYTES, stream, a);
#else
    for (int ph = 0; ph < N_PHASES; ++ph) { a.ph_lo = ph; a.ph_hi = ph + 1; hipLaunchKernelGGL(fwd_kernel, dim3(grid), dim3(NTHREADS), LDS_BYTES, stream, a); }
#endif
    const hipError_t le = hipPeekAtLastError();
    if (le != hipSuccess) fprintf(stderr, "kernel_launch: launch failed: %s (grid %d)\n", hipGetErrorName(le), grid);
}
```

```cpp
#define IMPL_GEMM 1
#define IMPL_ATTN 1
#define IMPL_FFT 3
#define N_LAUNCH_MODE 1
#include <hip/hip_runtime.h>
#include <cstdio>
#include <cstdint>

#ifndef PROBE_CHECK
#define PROBE_CHECK 0
#endif
#ifndef N_LAUNCH_MODE
#define N_LAUNCH_MODE 1
#endif
#ifndef IMPL_GEMM
#define IMPL_GEMM 1
#endif
#ifndef IMPL_ATTN
#define IMPL_ATTN 1
#endif
#ifndef IMPL_FFT
#define IMPL_FFT 3
#endif

#define LAS __attribute__((address_space(3)))
typedef unsigned short bf16_t;
typedef short bf16x8 __attribute__((ext_vector_type(8)));
typedef short s16x4 __attribute__((ext_vector_type(4)));
typedef float f32x4 __attribute__((ext_vector_type(4)));
typedef float f32x2 __attribute__((ext_vector_type(2)));
typedef float f32x16 __attribute__((ext_vector_type(16)));
typedef unsigned u32x4 __attribute__((ext_vector_type(4)));
typedef unsigned u32x2 __attribute__((ext_vector_type(2)));

constexpr int NB = 4, SEQ = 4096, DM = 2048, MTOK = NB * SEQ, DEPTH = 2;
constexpr int DF = 1024, NG = 8, GD = 128, NH = 8, DV = 128, DNOPE = 128, DROPE = 64, DQK = 192, QLR = 512, KVLR = 256;
constexpr int NIN = 3904, NINP = 4096;
constexpr int NQ = NH * DQK  , NKV = NH * (DNOPE + DV)  ;
constexpr float NORM_EPS = 1e-6f;
constexpr float DN_ALPHA = 1.4142135623730951f;
constexpr float ATT_SCALE = 0.07216878364870322f;

__device__ __forceinline__ float bf2f(bf16_t b) { return __uint_as_float(((unsigned)b) << 16); }
__device__ __forceinline__ bf16_t f2bf(float f) { unsigned u = __float_as_uint(f); u += 0x7FFFu + ((u >> 16) & 1u); return (bf16_t)(u >> 16); }
typedef __bf16 bf16v2_t __attribute__((ext_vector_type(2)));
__device__ __forceinline__ unsigned cvt_pk_bf16(float lo, float hi) { const f32x2 v = {lo, hi}; return __builtin_bit_cast(unsigned, __builtin_convertvector(v, bf16v2_t)); }
__device__ __forceinline__ float silu_f(float z) { return z * __builtin_amdgcn_rcpf(1.0f + __builtin_amdgcn_exp2f(-1.4426950408889634f * z)); }
__device__ __forceinline__ float wave_sum(float v) { for (int o = 32; o > 0; o >>= 1) v += __shfl_xor(v, o); return v; }
__device__ __forceinline__ float wave_max(float v) { for (int o = 32; o > 0; o >>= 1) v = fmaxf(v, __shfl_xor(v, o)); return v; }

constexpr size_t al256(size_t x) { return (x + 255) / 256 * 256; }
constexpr size_t WS_CTL  = 0;
constexpr size_t CTL_BYTES = 16384;
constexpr size_t WS_MOD  = WS_CTL + CTL_BYTES;
constexpr size_t WS_RSQ  = WS_MOD + al256((size_t)DEPTH * NB * 3 * DM * 4);
constexpr size_t WS_RCOS = WS_RSQ + al256((size_t)DEPTH * MTOK * 2 * 4);
constexpr size_t WS_RSIN = WS_RCOS + (size_t)MTOK * 32 * 4;
constexpr size_t WS_D1   = WS_RSIN + (size_t)MTOK * 32 * 4;
constexpr size_t WS_D2   = WS_D1 + 128 * 64 * 2;
constexpr size_t WS_WCAT = WS_D2 + 128 * 128 * 2;
constexpr size_t WS_WIN  = WS_WCAT + (size_t)DEPTH * NG * 128 * 256 * 2;
constexpr size_t WS_WOUT = WS_WIN + (size_t)DEPTH * NINP * DM * 2;
constexpr size_t WS_WQ   = WS_WOUT + (size_t)DEPTH * DM * DM * 2;
constexpr size_t WS_WKV  = WS_WQ + (size_t)DEPTH * NQ * QLR * 2;
constexpr size_t WS_H    = WS_WKV + (size_t)DEPTH * NKV * KVLR * 2;
constexpr size_t WS_U    = WS_H + (size_t)MTOK * DM * 2;
constexpr size_t WS_MIX  = WS_U + (size_t)MTOK * DF * 2;
constexpr size_t WS_CQ   = WS_MIX + (size_t)MTOK * DM * 2;
constexpr size_t WS_CKV  = WS_CQ + (size_t)MTOK * QLR * 2;
constexpr size_t WS_KR   = WS_CKV + (size_t)MTOK * KVLR * 2;
constexpr size_t WS_Q    = WS_KR + (size_t)MTOK * 64 * 2;
constexpr size_t WS_KV   = WS_Q + (size_t)MTOK * NQ * 2;
constexpr size_t WS_R    = WS_KV + (size_t)MTOK * NKV * 2;
constexpr size_t WS_END  = WS_R + (size_t)MTOK * DM * 4;
static_assert(WS_END <= (size_t)4 * MTOK * DM * 4, "workspace map exceeds 4 x largest tensor");

constexpr int RING_BYTES = 155648, MISC_OFF = RING_BYTES, LDS_BYTES = RING_BYTES + 256;
constexpr int NTHREADS = 512;

namespace pg8 {
#define PG8_LAS __attribute__((address_space(3)))
constexpr int BM = 256, BK = 64, HALF = 128, HTB = HALF * BK * 2  , STAGE_BYTES = 8 * HTB, NXCD = 8, WGM = 8;
static_assert(STAGE_BYTES <= RING_BYTES, "GEMM stage ring must fit the LDS phase scratch");

__host__ __device__ __forceinline__ int lds_byte(int r, int c) { const int st = (r >> 4) * 2 + (c >> 5), rr = r & 15, cc = c & 31, ob = rr * 64 + cc * 2; return st * 1024 + (ob ^ (((ob >> 9) & 1) << 5)); }
__host__ __device__ __forceinline__ void stage_rc(int b, int& R, int& C) { const int st = b / 1024, sb = b % 1024, swz = sb ^ (((sb >> 9) & 1) << 5); R = (st >> 1) * 16 + swz / 64; C = (st & 1) * 32 + (swz % 64) / 2; }
__host__ __device__ __forceinline__ int perm32(int rho) { const int n = rho >> 4, i = rho & 15; return 8 * (i >> 2) + 4 * n + (i & 3); }

struct Unit { int pm, pn; };
struct Gemm { const bf16_t* A; const bf16_t* Bt; int M, N, K; };

struct StaticOrder {
    int nM, nN, nwg, G, c;
    __host__ __device__ void init(int M, int N, int G_, int c_) { nM = M / BM; nN = N / BM; nwg = nM * nN; G = G_; c = c_; }
    __host__ __device__ bool next(int i, Unit& u) const {
        const long L = (long)i * G + c; if (L >= nwg) return false;
        int wgid = (int)L; { const int q = nwg / NXCD, r = nwg % NXCD, xcd = wgid % NXCD, off = wgid / NXCD; wgid = (xcd < r ? xcd * (q + 1) : r * (q + 1) + (xcd - r) * q) + off; }
        const int nig = WGM * nN, gid = wgid / nig, fm = gid * WGM, gsz = (nM - fm) < WGM ? (nM - fm) : WGM;
        u.pm = fm + ((wgid % nig) % gsz); u.pn = (wgid % nig) / gsz; return true;
    }
    __device__ __forceinline__ void a_ready(const Unit&) const {}
    __device__ __forceinline__ void done(const Unit&) const {}
};
struct SplitOrder {
    int G, c, nN, kind;
    __device__ void init(int G_, int c_, int nN_, int kind_) { G = G_; c = c_; nN = nN_; kind = kind_; }
    __device__ bool next(int i, Unit& u) const {
        if (G != 256) { const int L = i * G + c; if (L >= 64 * nN) return false; u.pm = L / nN; u.pn = L % nN; return true; }
        const int x = c & 7, v = c >> 3; int li;
        if (kind == 0) { if (v < 16) { if (i >= 2) return false; li = 2 * v + i; } else { if (i >= 1) return false; li = 32 + (v - 16); } }
        else           { if (v < 16) { if (i >= 1) return false; li = v; } else { if (i >= 3) return false; li = 16 + 3 * (v - 16) + i; } }
        u.pm = 8 * x + li / nN; u.pn = li % nN; return true;
    }
    __device__ __forceinline__ void a_ready(const Unit&) const {}
    __device__ __forceinline__ void done(const Unit&) const {}
};
template <class Epi, class Sched, bool ALIGN_EPI = false, bool SP2 = false>
__device__ __forceinline__ void gemm_phase(PG8_LAS unsigned char* lds, const Gemm g, const Sched& S, const Epi& E, const int tid) {
    const int wid = __builtin_amdgcn_readfirstlane(tid >> 6), lane = tid & 63, wr = wid >> 2, wc = wid & 3, fr = lane & 15, fq = lane >> 4;
    const int K = g.K, nt = K / BK;
    unsigned voffA[2], voffB[2];
#pragma unroll
    for (int i = 0; i < 2; ++i) { int R, C; stage_rc(tid * 16 + i * 8192, R, C); const int Rb = Epi::PERM ? ((R & ~31) + perm32(R & 31)) : R;
        voffA[i] = (unsigned)(R * K + C) * 2u; voffB[i] = (unsigned)(Rb * K + C) * 2u; }
    const size_t kstep = (size_t)(BK * 2);
    const size_t hstep = (size_t)HALF * K * 2;
    const size_t tstep = 2 * hstep;
    const unsigned ldsw = (unsigned)wid * 1024u;
    const int aoff = lds_byte(wr * 64 + fr, fq * 8), boff = lds_byte(wc * 32 + fr, fq * 8);
#define PG8_SA(b, h) (((b) * 2 + (h)) * HTB)
#define PG8_SB(b, h) ((4 + (b) * 2 + (h)) * HTB)
#define PG8_STAGE(bufoff, gbase, voff) do { _Pragma("unroll") for (int _i = 0; _i < 2; ++_i) \
        __builtin_amdgcn_global_load_lds((const unsigned*)((const char*)(gbase) + (voff)[_i]), (PG8_LAS unsigned*)(lds + (bufoff) + ldsw + _i * 8192), 16, 0, 0); } while (0)
#define PG8_LDA(dst, b, h) do { _Pragma("unroll") for (int m = 0; m < 4; ++m) _Pragma("unroll") for (int k = 0; k < 2; ++k) dst[m][k] = *(const PG8_LAS bf16x8*)(lds + PG8_SA(b, h) + aoff + m * 2048 + k * 1024); } while (0)
#define PG8_LDB(dst, b, h) do { _Pragma("unroll") for (int n = 0; n < 2; ++n) _Pragma("unroll") for (int k = 0; k < 2; ++k) dst[n][k] = *(const PG8_LAS bf16x8*)(lds + PG8_SB(b, h) + boff + n * 2048 + k * 1024); } while (0)
#define PG8_MMA(ai, bj, At, Bt) do { __builtin_amdgcn_s_setprio(1); _Pragma("unroll") for (int m = 0; m < 4; ++m) _Pragma("unroll") for (int n = 0; n < 2; ++n) _Pragma("unroll") for (int k = 0; k < 2; ++k) \
        acc[ai][bj][m][n] = __builtin_amdgcn_mfma_f32_16x16x32_bf16(Bt[n][k], At[m][k], acc[ai][bj][m][n], 0, 0, 0); __builtin_amdgcn_s_setprio(0); } while (0)
#define PG8_WAIT_V(n) asm volatile("s_waitcnt vmcnt(" #n ")" ::: "memory")
#define PG8_WAIT_L(n) asm volatile("s_waitcnt lgkmcnt(" #n ")" ::: "memory")
#define PG8_BAR __builtin_amdgcn_s_barrier()
#define PG8_SCHED __builtin_amdgcn_sched_barrier(0)
    Unit cur, nxt; int ui = 0;
    if (!S.next(0, cur)) return;
    f32x4 acc[2][2][4][2];
#pragma unroll
    for (int a = 0; a < 2; ++a)
#pragma unroll
        for (int b = 0; b < 2; ++b)
#pragma unroll
            for (int m = 0; m < 4; ++m)
#pragma unroll
                for (int n = 0; n < 2; ++n) acc[a][b][m][n] = (f32x4){0.f, 0.f, 0.f, 0.f};
    bf16x8 At[4][2], B0[2][2], B1[2][2];
    const char* cA = (const char*)g.A + (size_t)cur.pm * tstep; const char* cB = (const char*)g.Bt + (size_t)cur.pn * tstep;
    S.a_ready(cur);
    if constexpr (SP2) {
        PG8_STAGE(PG8_SB(0, 0), cB, voffB); PG8_STAGE(PG8_SB(0, 1), cB + hstep, voffB); PG8_STAGE(PG8_SA(0, 0), cA, voffA); PG8_STAGE(PG8_SA(0, 1), cA + hstep, voffA);
        if (wr == 1) PG8_BAR;
        PG8_WAIT_V(2); PG8_BAR;
        PG8_STAGE(PG8_SB(1, 0), cB + kstep, voffB); PG8_STAGE(PG8_SA(1, 0), cA + kstep, voffA); PG8_STAGE(PG8_SB(1, 1), cB + hstep + kstep, voffB);
        PG8_WAIT_V(6); PG8_BAR;
    } else {
        PG8_STAGE(PG8_SB(0, 0), cB, voffB); PG8_STAGE(PG8_SA(0, 0), cA, voffA); PG8_STAGE(PG8_SB(0, 1), cB + hstep, voffB); PG8_STAGE(PG8_SA(0, 1), cA + hstep, voffA);
        if (wr == 1) PG8_BAR;
        PG8_WAIT_V(4); PG8_BAR;
        PG8_STAGE(PG8_SB(1, 0), cB + kstep, voffB); PG8_STAGE(PG8_SA(1, 0), cA + kstep, voffA); PG8_STAGE(PG8_SB(1, 1), cB + hstep + kstep, voffB);
        PG8_WAIT_V(6); PG8_BAR;
    }
    for (;;) {
        const bool has_next = S.next(ui + 1, nxt);
        const char* nA = has_next ? (const char*)g.A + (size_t)nxt.pm * tstep : cA; const char* nB = has_next ? (const char*)g.Bt + (size_t)nxt.pn * tstep : cB;
        for (int t = 0; t < nt; t += 2) {
            const bool last = (t == nt - 2);
            const char* a1 = cA + (size_t)(t + 1) * kstep;
            const char* a2 = last ? nA : cA + (size_t)(t + 2) * kstep; const char* b2 = last ? nB : cB + (size_t)(t + 2) * kstep;
            const char* a3 = a2 + kstep; const char* b3 = b2 + kstep;
            if (last && has_next) S.a_ready(nxt);
            if constexpr (SP2) {
            PG8_LDB(B0, 0, 0); PG8_LDB(B1, 0, 1); PG8_SCHED; PG8_LDA(At, 0, 0); PG8_STAGE(PG8_SA(1, 1), a1 + hstep, voffA);
            PG8_WAIT_V(8); PG8_WAIT_L(0); PG8_BAR; PG8_MMA(0, 0, At, B0); PG8_MMA(0, 1, At, B1); PG8_BAR; PG8_SCHED;
            PG8_LDA(At, 0, 1); PG8_STAGE(PG8_SB(0, 0), b2, voffB); PG8_STAGE(PG8_SB(0, 1), b2 + hstep, voffB); PG8_STAGE(PG8_SA(0, 0), a2, voffA);
            PG8_WAIT_V(8); PG8_WAIT_L(0); PG8_BAR; PG8_MMA(1, 0, At, B0); PG8_MMA(1, 1, At, B1); PG8_BAR; PG8_SCHED;
            PG8_LDB(B0, 1, 0); PG8_LDB(B1, 1, 1); PG8_SCHED; PG8_LDA(At, 1, 0); PG8_STAGE(PG8_SA(0, 1), a2 + hstep, voffA);
            PG8_WAIT_V(8); PG8_WAIT_L(0); PG8_BAR; PG8_MMA(0, 0, At, B0); PG8_MMA(0, 1, At, B1); PG8_BAR; PG8_SCHED;
            PG8_LDA(At, 1, 1); PG8_STAGE(PG8_SB(1, 0), b3, voffB); PG8_STAGE(PG8_SB(1, 1), b3 + hstep, voffB); PG8_STAGE(PG8_SA(1, 0), a3, voffA);
            PG8_WAIT_V(8); PG8_WAIT_L(0); PG8_BAR; PG8_MMA(1, 0, At, B0); PG8_MMA(1, 1, At, B1); PG8_BAR; PG8_SCHED;
            } else {
            PG8_LDB(B0, 0, 0); PG8_SCHED; PG8_LDA(At, 0, 0); PG8_STAGE(PG8_SA(1, 1), a1 + hstep, voffA);
            PG8_WAIT_L(8); PG8_BAR; PG8_WAIT_L(0); PG8_MMA(0, 0, At, B0); PG8_BAR; PG8_SCHED;
            PG8_LDB(B1, 0, 1); PG8_STAGE(PG8_SB(0, 0), b2, voffB);
            PG8_BAR; PG8_WAIT_L(0); PG8_MMA(0, 1, At, B1); PG8_BAR;
            PG8_LDA(At, 0, 1); PG8_STAGE(PG8_SA(0, 0), a2, voffA);
            PG8_BAR; PG8_WAIT_L(0); PG8_MMA(1, 0, At, B0); PG8_BAR; PG8_SCHED;
            PG8_STAGE(PG8_SB(0, 1), b2 + hstep, voffB);
            PG8_WAIT_V(6); PG8_BAR; PG8_MMA(1, 1, At, B1); PG8_BAR;
            PG8_LDB(B0, 1, 0); PG8_SCHED; PG8_LDA(At, 1, 0); PG8_STAGE(PG8_SA(0, 1), a2 + hstep, voffA);
            PG8_WAIT_L(8); PG8_BAR; PG8_WAIT_L(0); PG8_MMA(0, 0, At, B0); PG8_BAR; PG8_SCHED;
            PG8_LDB(B1, 1, 1); PG8_STAGE(PG8_SB(1, 0), b3, voffB);
            PG8_BAR; PG8_WAIT_L(0); PG8_MMA(0, 1, At, B1); PG8_BAR;
            PG8_LDA(At, 1, 1); PG8_STAGE(PG8_SA(1, 0), a3, voffA);
            PG8_BAR; PG8_WAIT_L(0); PG8_MMA(1, 0, At, B0); PG8_BAR; PG8_SCHED;
            PG8_STAGE(PG8_SB(1, 1), b3 + hstep, voffB);
            PG8_WAIT_V(6); PG8_BAR; PG8_MMA(1, 1, At, B1); PG8_BAR;
            }
        }
        if constexpr (ALIGN_EPI) { if (wr == 0) PG8_BAR; }
        if constexpr (!Epi::AFTER_DRAIN) { E(acc, cur, wr, wc, fr, fq); S.done(cur); }
        if (!has_next) break;
#pragma unroll
        for (int a = 0; a < 2; ++a)
#pragma unroll
            for (int b = 0; b < 2; ++b)
#pragma unroll
                for (int m = 0; m < 4; ++m)
#pragma unroll
                    for (int n = 0; n < 2; ++n) acc[a][b][m][n] = (f32x4){0.f, 0.f, 0.f, 0.f};
        cur = nxt; cA = nA; cB = nB; ++ui;
        if constexpr (ALIGN_EPI) { if (wr == 1) PG8_BAR; }
    }
    PG8_WAIT_V(0);
    if constexpr (!ALIGN_EPI) { if (wr == 0) PG8_BAR; }
    PG8_BAR;
    if constexpr (Epi::AFTER_DRAIN) { E.fused(acc, cur, wr, wc, fr, fq, lds, wid, lane); S.done(cur); }
#undef PG8_SA
#undef PG8_SB
#undef PG8_STAGE
#undef PG8_LDA
#undef PG8_LDB
#undef PG8_MMA
#undef PG8_WAIT_V
#undef PG8_WAIT_L
#undef PG8_BAR
#undef PG8_SCHED
}

template <class Epi, class Sched>
__device__ __forceinline__ void gemm_phase_naive(const Gemm g, const Sched& S, const Epi& E, const int tid) {
    const int wid = __builtin_amdgcn_readfirstlane(tid >> 6), lane = tid & 63, wr = wid >> 2, wc = wid & 3, fr = lane & 15, fq = lane >> 4;
    const int K = g.K;
    Unit cur;
    for (int ui = 0; S.next(ui, cur); ++ui) {
        f32x4 acc[2][2][4][2];
#pragma unroll
        for (int ai = 0; ai < 2; ++ai)
#pragma unroll
            for (int m = 0; m < 4; ++m) {
                const bf16_t* arow = g.A + (size_t)(cur.pm * BM + ai * HALF + wr * 64 + m * 16 + fr) * K;
#pragma unroll
                for (int bj = 0; bj < 2; ++bj)
#pragma unroll
                    for (int n = 0; n < 2; ++n) {
                        const int col = cur.pn * BM + bj * HALF + wc * 32 + (Epi::PERM ? (8 * fq + 4 * n) : (16 * n + 4 * fq));
                        const bf16_t* brow = g.Bt + (size_t)col * K;
                        float s0 = 0.f, s1 = 0.f, s2 = 0.f, s3 = 0.f;
#pragma unroll 1
                        for (int k = 0; k < K; k += 8) {
                            const bf16x8 av = *(const bf16x8*)(arow + k);
                            const bf16x8 b0 = *(const bf16x8*)(brow + k), b1 = *(const bf16x8*)(brow + K + k), b2 = *(const bf16x8*)(brow + 2 * K + k), b3 = *(const bf16x8*)(brow + 3 * K + k);
#pragma unroll
                            for (int e = 0; e < 8; ++e) { const float a = bf2f((bf16_t)av[e]);
                                s0 += a * bf2f((bf16_t)b0[e]); s1 += a * bf2f((bf16_t)b1[e]); s2 += a * bf2f((bf16_t)b2[e]); s3 += a * bf2f((bf16_t)b3[e]); }
                        }
                        acc[ai][bj][m][n] = (f32x4){s0, s1, s2, s3};
                    }
            }
        E(acc, cur, wr, wc, fr, fq);
    }
}
}
#ifndef PG8_SP2
#define PG8_SP2 true
#endif
#ifndef PG8_ALIGN
#define PG8_ALIGN true
#endif
typedef f32x4 AccT[2][2][4][2];

__device__ __forceinline__ void store8_bf16(bf16_t* p, f32x4 v0, f32x4 v1) {
    u32x4 w; w.x = cvt_pk_bf16(v0[0], v0[1]); w.y = cvt_pk_bf16(v0[2], v0[3]); w.z = cvt_pk_bf16(v1[0], v1[1]); w.w = cvt_pk_bf16(v1[2], v1[3]); *(u32x4*)p = w;
}
__device__ __forceinline__ void store4_bf16(bf16_t* p, f32x4 v) { u32x2 w; w.x = cvt_pk_bf16(v[0], v[1]); w.y = cvt_pk_bf16(v[2], v[3]); *(u32x2*)p = w; }
__device__ __forceinline__ f32x4 silu4(f32x4 v) { return (f32x4){silu_f(v[0]), silu_f(v[1]), silu_f(v[2]), silu_f(v[3])}; }
__device__ __forceinline__ float sq4(f32x4 v) { return (v[0] * v[0] + v[1] * v[1]) + (v[2] * v[2] + v[3] * v[3]); }

struct EpiIn {
    static constexpr bool PERM = true, AFTER_DRAIN = false;
    bf16_t* U; bf16_t* MIX; bf16_t* CQ; bf16_t* CKV; bf16_t* KR; float* rsq; const float* rcos; const float* rsin;
    template <int ACT> __device__ __forceinline__ void plain(const AccT& acc, bf16_t* base, int ldc, int row0, int col0) const {
#pragma unroll
        for (int ai = 0; ai < 2; ++ai)
#pragma unroll
            for (int m = 0; m < 4; ++m) { bf16_t* rowp = base + (size_t)(row0 + ai * 128 + m * 16) * ldc + col0;
#pragma unroll
                for (int bj = 0; bj < 2; ++bj) { f32x4 v0 = acc[ai][bj][m][0], v1 = acc[ai][bj][m][1]; if (ACT) { v0 = silu4(v0); v1 = silu4(v1); } store8_bf16(rowp + bj * 128, v0, v1); } }
    }
    __device__ __forceinline__ void sumsq(const AccT& acc, int row0, int which, int fq) const {
#pragma unroll
        for (int ai = 0; ai < 2; ++ai)
#pragma unroll
            for (int m = 0; m < 4; ++m) { float s = (sq4(acc[ai][0][m][0]) + sq4(acc[ai][0][m][1])) + (sq4(acc[ai][1][m][0]) + sq4(acc[ai][1][m][1]));
                s += __shfl_xor(s, 16); s += __shfl_xor(s, 32);
                if (fq == 0) atomicAdd(rsq + (size_t)(row0 + ai * 128 + m * 16) * 2 + which, s); }
    }
    __device__ __forceinline__ void operator()(const AccT& acc, const pg8::Unit& u, int wr, int wc, int fr, int fq) const {
        const int row0 = u.pm * 256 + wr * 64 + fr, pn = u.pn, cw = wc * 32 + 8 * fq;
        if (pn < 4) plain<0>(acc, U, DF, row0, pn * 256 + cw);
        else if (pn < 8) plain<1>(acc, MIX, DM, row0, (pn - 4) * 256 + cw);
        else if (pn < 10) { plain<0>(acc, CQ, QLR, row0, (pn - 8) * 256 + cw); sumsq(acc, row0, 0, fq); }
        else if (pn == 10) { plain<0>(acc, CKV, KVLR, row0, cw); sumsq(acc, row0, 1, fq); }
        else if (pn == 11) {
            if (wc < 2) { const int i0 = 16 * wc + 4 * fq;
#pragma unroll
                for (int ai = 0; ai < 2; ++ai)
#pragma unroll
                    for (int m = 0; m < 4; ++m) { const size_t row = (size_t)(row0 + ai * 128 + m * 16);
                        const f32x4 c = *(const f32x4*)(rcos + row * 32 + i0), s = *(const f32x4*)(rsin + row * 32 + i0), x1 = acc[ai][0][m][0], x2 = acc[ai][0][m][1];
                        store4_bf16(KR + row * 64 + i0, x1 * c - x2 * s); store4_bf16(KR + row * 64 + 32 + i0, x2 * c + x1 * s); } }
        }
        else plain<1>(acc, MIX, DM, row0, DF + (pn - 12) * 256 + cw);
    }
};
struct EpiQ {
    static constexpr bool PERM = true, AFTER_DRAIN = false;
    bf16_t* Q; const float* rsq; const float* rcos; const float* rsin;
    __device__ __forceinline__ void operator()(const AccT& acc, const pg8::Unit& u, int wr, int wc, int fr, int fq) const {
        const int row0 = u.pm * 256 + wr * 64 + fr;
#pragma unroll
        for (int ai = 0; ai < 2; ++ai)
#pragma unroll
            for (int m = 0; m < 4; ++m) { const size_t row = (size_t)(row0 + ai * 128 + m * 16);
                const float rs = rsqrtf(rsq[row * 2 + 0] * (1.0f / QLR) + NORM_EPS);
#pragma unroll
                for (int bj = 0; bj < 2; ++bj) { const int G = u.pn * 8 + bj * 4 + wc, head = G / 6, g6 = G - head * 6;
                    const f32x4 v0 = acc[ai][bj][m][0] * rs, v1 = acc[ai][bj][m][1] * rs;
                    if (g6 < 4) store8_bf16(Q + row * NQ + head * DQK + g6 * 32 + 8 * fq, v0, v1);
                    else { const int i0 = 16 * (g6 - 4) + 4 * fq; const f32x4 c = *(const f32x4*)(rcos + row * 32 + i0), s = *(const f32x4*)(rsin + row * 32 + i0);

#if defined(PROBE_NEG) && PROBE_NEG == 1
                        store4_bf16(Q + row * NQ + head * DQK + 128 + i0, v0 * c + v1 * s); store4_bf16(Q + row * NQ + head * DQK + 160 + i0, v1 * c - v0 * s);
#else
                        store4_bf16(Q + row * NQ + head * DQK + 128 + i0, v0 * c - v1 * s); store4_bf16(Q + row * NQ + head * DQK + 160 + i0, v1 * c + v0 * s);
#endif
                    } } }
    }
};
struct EpiKV {
    static constexpr bool PERM = true, AFTER_DRAIN = false;
    bf16_t* KV; const float* rsq;
    __device__ __forceinline__ void operator()(const AccT& acc, const pg8::Unit& u, int wr, int wc, int fr, int fq) const {
        const int row0 = u.pm * 256 + wr * 64 + fr, col0 = u.pn * 256 + wc * 32 + 8 * fq;
#pragma unroll
        for (int ai = 0; ai < 2; ++ai)
#pragma unroll
            for (int m = 0; m < 4; ++m) { const size_t row = (size_t)(row0 + ai * 128 + m * 16);
                const float rs = rsqrtf(rsq[row * 2 + 1] * (1.0f / KVLR) + NORM_EPS);
#pragma unroll
                for (int bj = 0; bj < 2; ++bj) store8_bf16(KV + row * NKV + col0 + bj * 128, acc[ai][bj][m][0] * rs, acc[ai][bj][m][1] * rs); }
    }
};
struct EpiOut {
    static constexpr bool PERM = true, AFTER_DRAIN = false;
    bf16_t* GY; const float* gate;
    __device__ __forceinline__ void operator()(const AccT& acc, const pg8::Unit& u, int wr, int wc, int fr, int fq) const {
        const int row0 = u.pm * 256 + wr * 64 + fr, col0 = u.pn * 256 + wc * 32 + 8 * fq;
        const float* gp = gate + (size_t)(u.pm >> 4) * (3 * DM) + col0;
        f32x4 gv[2][2];
#pragma unroll
        for (int bj = 0; bj < 2; ++bj)
#pragma unroll
            for (int n = 0; n < 2; ++n) gv[bj][n] = *(const f32x4*)(gp + bj * 128 + n * 4);
#pragma unroll
        for (int ai = 0; ai < 2; ++ai)
#pragma unroll
            for (int m = 0; m < 4; ++m) { bf16_t* rowp = GY + (size_t)(row0 + ai * 128 + m * 16) * DM + col0;
#pragma unroll
                for (int bj = 0; bj < 2; ++bj) store8_bf16(rowp + bj * 128, gv[bj][0] * acc[ai][bj][m][0], gv[bj][1] * acc[ai][bj][m][1]); }
    }
};

struct EpiNone {
    static constexpr bool PERM = true, AFTER_DRAIN = false;
    __device__ __forceinline__ void operator()(const AccT& acc, const pg8::Unit& u, int wr, int wc, int fr, int fq) const {
#pragma unroll
        for (int ai = 0; ai < 2; ++ai)
#pragma unroll
            for (int bj = 0; bj < 2; ++bj)
#pragma unroll
                for (int m = 0; m < 4; ++m)
#pragma unroll
                    for (int n = 0; n < 2; ++n) asm volatile("" :: "v"(acc[ai][bj][m][n]));
    }
};
#define XB_TMO      128
#define XB_XCNT(j)  (256  + 64 * (j))
#define XB_XSUB(j)  (1280 + 64 * (j))
#define XB_XGEN(j)  (2304 + 64 * (j))
#define XB_TOP      3328
#define XB_TOPGEN   3392
#define XCD_BAR_WORDS 3456
#define XB_SPIN_CAP (1u << 22)
static_assert(XCD_BAR_WORDS * 4 <= CTL_BYTES, "barrier words must fit the control region");
__device__ __forceinline__ unsigned xb_ld(unsigned* p)              { return __hip_atomic_load(p, __ATOMIC_RELAXED, __HIP_MEMORY_SCOPE_AGENT); }
__device__ __forceinline__ unsigned xb_add(unsigned* p, unsigned v) { return __hip_atomic_fetch_add(p, v, __ATOMIC_RELAXED, __HIP_MEMORY_SCOPE_AGENT); }
__device__ __forceinline__ unsigned xb_xcc_id() { return (unsigned)__builtin_amdgcn_s_getreg((3 << 11) | 20) & 0xFu; }
#define XB_SPIN(cond, bar) do { unsigned _sp = 0; while (cond) { __builtin_amdgcn_s_sleep(1); \
    if ((++_sp & 255u) == 0u) { if (xb_ld(&(bar)[XB_TMO])) break; if (_sp > XB_SPIN_CAP) { atomicAdd(&(bar)[XB_TMO], 1u); break; } } } } while (0)
struct XcdBarrier { unsigned* bar; unsigned x; volatile LAS unsigned* st; };
__device__ __forceinline__ XcdBarrier xcd_barrier_post(unsigned* bar, volatile LAS unsigned* st) {
    XcdBarrier b; b.bar = bar; b.x = xb_xcc_id(); b.st = st;
    if (threadIdx.x == 0) (void)xb_add(&bar[XB_XCNT(b.x)], 1u);
    return b;
}
__device__ __forceinline__ void xcd_barrier_complete(unsigned* bar, unsigned x, unsigned& nloc, unsigned& nx) {
    const unsigned G = gridDim.x * gridDim.y * gridDim.z;
    unsigned sum, cnt, mine, sp = 0u;
    for (;;) {
        sum = 0u; cnt = 0u; mine = 0u;
#pragma unroll
        for (unsigned j = 0; j < 16; ++j) { const unsigned c = xb_ld(&bar[XB_XCNT(j)]); sum += c; cnt += (c > 0u) ? 1u : 0u; mine = (j == x) ? c : mine; }
        if (sum == G) break;
        __builtin_amdgcn_s_sleep(1);
        if ((++sp & 255u) == 0u) { if (xb_ld(&bar[XB_TMO])) break; if (sp > XB_SPIN_CAP) { atomicAdd(&bar[XB_TMO], 1u); break; } }
    }
    nloc = mine > 0u ? mine : 1u; nx = cnt > 0u ? cnt : 1u;
}
__device__ __forceinline__ void xcd_barrier(const XcdBarrier& b) {
    asm volatile("s_waitcnt vmcnt(0)" ::: "memory");
    __syncthreads();
    if (threadIdx.x == 0) {
        unsigned* bar = b.bar;
        __builtin_amdgcn_s_waitcnt(0);
        unsigned nloc = b.st[0], nx = b.st[1];
        if (nloc == 0u) { xcd_barrier_complete(bar, b.x, nloc, nx); b.st[0] = nloc; b.st[1] = nx; }
        const unsigned old = xb_add(&bar[XB_XSUB(b.x)], 1u);
        const unsigned gen = old / nloc;
        if (old + 1u == (gen + 1u) * nloc) {
            __builtin_amdgcn_fence(__ATOMIC_RELEASE, "agent");
            asm volatile("s_waitcnt vmcnt(0)" ::: "memory");
            const unsigned og = xb_add(&bar[XB_TOP], 1u);
            const unsigned tg = og / nx;
            if (og + 1u == (tg + 1u) * nx) xb_add(&bar[XB_TOPGEN], 1u);
            else XB_SPIN(xb_ld(&bar[XB_TOPGEN]) == tg, bar);
            __builtin_amdgcn_fence(__ATOMIC_ACQUIRE, "agent");
            xb_add(&bar[XB_XGEN(b.x)], 1u);
            asm volatile("s_waitcnt vmcnt(0)" ::: "memory");
        } else {
            XB_SPIN(xb_ld(&bar[XB_XGEN(b.x)]) == gen, bar);
            __builtin_amdgcn_fence(__ATOMIC_ACQUIRE, "agent");
            asm volatile("s_waitcnt vmcnt(0)" ::: "memory");
        }
    }
    __syncthreads();
}
struct Frame {
    const float* in[14]; float* out; unsigned char* ws;
    LAS unsigned char* lds; char* ldsg;
    int tid, lane, wave, G, bx, vcu; size_t mix_off;
};
#define WSP(T, off) ((T*)(F.ws + (off)))

__device__ __forceinline__ int src_in(int n) {
    if (n < 2816) return n;
    if (n < 3072) { const int c = n - 2816, bj = c >> 7, wc = (c >> 5) & 3, c32 = c & 31; if (bj || wc >= 2) return -1;
        const int fq = c32 >> 3, nn = (c32 >> 2) & 1, j = c32 & 3; return 2816 + 32 * nn + 16 * wc + 4 * fq + j; }
    return n - 192;
}
__device__ __forceinline__ int src_q(int n) {
    const int G = n >> 5, c32 = n & 31, head = G / 6, g6 = G - head * 6;
    if (g6 < 4) return head * DQK + g6 * 32 + c32;
    const int fq = c32 >> 3, nn = (c32 >> 2) & 1, j = c32 & 3; return head * DQK + 128 + 32 * nn + 16 * (g6 - 4) + 4 * fq + j;
}
__device__ __forceinline__ void p0_weights(const Frame& F) {
    constexpr int TIN = 512, TOUT = 256, TQ = 48, TKV = 32, TL = TIN + TOUT + TQ + TKV;
    LAS unsigned* T = (LAS unsigned*)F.lds;
    const int tid = F.tid, n4 = (tid & 15) * 4, kp = tid >> 4;
    for (int it = F.bx; it < DEPTH * TL; it += F.G) {
        const int l = it / TL; int r = it - l * TL, kind, nt, kt, Nsrc, K; const float* W; const float* ksc = nullptr; bf16_t* Bt;
        if (r < TIN) { kind = 0; nt = r >> 3; kt = r & 7; W = F.in[5] + (size_t)l * DM * NIN; Nsrc = NIN; K = DM; Bt = WSP(bf16_t, WS_WIN) + (size_t)l * NINP * DM; }
        else if (r < TIN + TOUT) { r -= TIN; kind = 1; nt = r >> 3; kt = r & 7; W = F.in[11] + (size_t)l * DM * DM; Nsrc = DM; K = DM; Bt = WSP(bf16_t, WS_WOUT) + (size_t)l * DM * DM; }
        else if (r < TIN + TOUT + TQ) { r -= TIN + TOUT; kind = 2; nt = r >> 1; kt = r & 1; W = F.in[7] + (size_t)l * QLR * NQ; Nsrc = NQ; K = QLR; ksc = F.in[6] + l * QLR; Bt = WSP(bf16_t, WS_WQ) + (size_t)l * NQ * QLR; }
        else { r -= TIN + TOUT + TQ; kind = 3; nt = r; kt = 0; W = F.in[9] + (size_t)l * KVLR * NKV; Nsrc = NKV; K = KVLR; ksc = F.in[8] + l * KVLR; Bt = WSP(bf16_t, WS_WKV) + (size_t)l * NKV * KVLR; }
        const int n0 = nt * 64, k0 = kt * 256, n = n0 + n4;
        const int src = kind == 0 ? src_in(n) : (kind == 2 ? src_q(n) : n);
        f32x4 v0[4], v1[4];
#pragma unroll
        for (int i = 0; i < 4; ++i) { const int k = k0 + 2 * (kp + 32 * i);
            v0[i] = src >= 0 ? *(const f32x4*)(W + (size_t)k * Nsrc + src) : (f32x4){0.f, 0.f, 0.f, 0.f}; v1[i] = src >= 0 ? *(const f32x4*)(W + (size_t)(k + 1) * Nsrc + src) : (f32x4){0.f, 0.f, 0.f, 0.f}; }
        if (ksc) {
#pragma unroll
            for (int i = 0; i < 4; ++i) { const int k = k0 + 2 * (kp + 32 * i); v0[i] *= ksc[k]; v1[i] *= ksc[k + 1]; } }
#pragma unroll
        for (int i = 0; i < 4; ++i)
#pragma unroll
            for (int e = 0; e < 4; ++e) T[(n4 + e) * 130 + kp + 32 * i] = cvt_pk_bf16(v0[i][e], v1[i][e]);
        __syncthreads();
#pragma unroll
        for (int i = 0; i < 4; ++i) { const int c = tid + 512 * i, nn = c >> 5, kc = c & 31;
            const u32x2 a = *(const LAS u32x2*)(T + nn * 130 + kc * 4), b = *(const LAS u32x2*)(T + nn * 130 + kc * 4 + 2);
            *(u32x4*)(Bt + (size_t)(n0 + nn) * K + k0 + kc * 8) = (u32x4){a.x, a.y, b.x, b.y}; }
        __syncthreads();
    }
}
__device__ __forceinline__ void p0_mod(const Frame& F) {
    LAS float* red = (LAS float*)(F.lds + 32768);
    const int tid = F.tid;
    float* mod = WSP(float, WS_MOD); const float* cc = F.in[1];
    for (int it = F.bx; it < DEPTH * 96 * 4; it += F.G) {
        const int l = it / 384, rem = it - l * 384, kq = rem & 3, col0 = (rem >> 2) * 64, cg = tid & 15, kl = tid >> 4;
        f32x4 acc[4] = {};
        const float* wp = F.in[3] + ((size_t)l * DM + kq * 512 + kl) * (3 * DM) + col0 + cg * 4;
        f32x4 w[16];
#pragma unroll
        for (int i = 0; i < 16; ++i) w[i] = *(const f32x4*)(wp + (size_t)(32 * i) * (3 * DM));
#pragma unroll
        for (int i = 0; i < 16; ++i) { const int k = kq * 512 + kl + 32 * i;
#pragma unroll
            for (int b = 0; b < 4; ++b) acc[b] += w[i] * silu_f(cc[b * DM + k]); }
#pragma unroll
        for (int b = 0; b < 4; ++b)
#pragma unroll
            for (int j = 0; j < 4; ++j) red[(kl * 16 + cg) * 16 + b * 4 + j] = acc[b][j];
        __syncthreads();
        if (tid < 256) { const int cg2 = tid >> 4, v = tid & 15, b = v >> 2, j = v & 3; float s = 0.f;
            for (int q = 0; q < 32; ++q) s += red[(q * 16 + cg2) * 16 + v];
            const int col = col0 + cg2 * 4 + j; if (kq == 0) s += F.in[4][l * (3 * DM) + col];
            atomicAdd(mod + (size_t)(l * NB + b) * (3 * DM) + col, s); }
        __syncthreads();
    }
}
__device__ __forceinline__ void p0_tables(const Frame& F) {
    constexpr double INVF2PI[32] = {
    0.15915494309189535, 0.11934937021124886, 0.08949940160889101, 0.06711508300522726,
    0.050329212104487035, 0.03774158471741977, 0.0283021958306234, 0.02122365276477766,
    0.015915494309189534, 0.011934937021124886, 0.008949940160889102, 0.006711508300522725,
    0.005032921210448704, 0.003774158471741977, 0.00283021958306234, 0.0021223652764777662,
    0.0015915494309189536, 0.0011934937021124885, 0.0008949940160889102, 0.0006711508300522726,
    0.0005032921210448703, 0.00037741584717419774, 0.00028302195830623395, 0.0002122365276477766,
    0.00015915494309189535, 0.00011934937021124886, 8.949940160889102e-05, 6.711508300522725e-05,
    5.0329212104487035e-05, 3.774158471741978e-05, 2.8302195830623396e-05, 2.122365276477766e-05};
    const int gid = F.bx * NTHREADS + F.tid, NT = F.G * NTHREADS;
    const int* pos = (const int*)F.in[2]; float* rc = WSP(float, WS_RCOS); float* rs = WSP(float, WS_RSIN);
    for (int idx = gid; idx < MTOK * 32; idx += NT) { const int i = idx & 31; double t = (double)pos[idx >> 5] * INVF2PI[i]; t -= floor(t);
        float sn, cs; sincospif((float)(2.0 * t), &sn, &cs); rc[idx] = cs; rs[idx] = sn; }
    bf16_t* D1 = WSP(bf16_t, WS_D1); bf16_t* D2 = WSP(bf16_t, WS_D2);
    for (int idx = gid; idx < 128 * 64; idx += NT) { const int s1 = idx & 63, rr = idx >> 6, ri = rr >> 6, s1p = rr & 63; float sn, cs; sincospif((float)((s1 * s1p) & 63) * (1.0f / 32.0f), &sn, &cs);
        D1[idx] = f2bf((ri ? -sn : cs) * 0.125f); }
    for (int idx = gid; idx < 128 * 128; idx += NT) { const int kk = idx & 127, rr = idx >> 7, ri = kk >> 6, s2 = kk & 63, ro = rr >> 6, s2p = rr & 63; float sn, cs; sincospif((float)((s2 * s2p) & 63) * (1.0f / 32.0f), &sn, &cs);
        const float v = ro == 0 ? (ri == 0 ? cs : sn) : (ri == 0 ? -sn : cs); D2[idx] = f2bf(v * 0.125f); }
    float* rsq = WSP(float, WS_RSQ);
    for (int idx = gid; idx < DEPTH * MTOK * 2; idx += NT) rsq[idx] = 0.f;
    LAS float* ct = (LAS float*)F.lds; LAS float* st = ct + 128;
    if (F.tid < 128) { float sn, cs; sincospif((float)F.tid * (1.0f / 64.0f), &sn, &cs); ct[F.tid] = cs * 0.08838834764831845f; st[F.tid] = sn * 0.08838834764831845f; }
    __syncthreads();
    bf16_t* wcat = WSP(bf16_t, WS_WCAT);
    for (int t = gid; t < DEPTH * NG * 128 * 64; t += NT) { const int k4 = (t & 63) * 4, d = (t >> 6) & 127, lg = t >> 13, ro = k4 >> 7, c0 = k4 & 127;
        const float* w = F.in[10] + (size_t)lg * 128 * 128 + d; LAS float* tb = ro ? st : ct; f32x4 s = {0.f, 0.f, 0.f, 0.f};
        for (int cp0 = 0; cp0 < 128; cp0 += 16) { float wv[16];
#pragma unroll
            for (int u = 0; u < 16; ++u) wv[u] = w[(cp0 + u) * 128];
#pragma unroll
            for (int u = 0; u < 16; ++u) { const int cp = cp0 + u; s += (f32x4){tb[(c0 * cp) & 127], tb[((c0 + 1) * cp) & 127], tb[((c0 + 2) * cp) & 127], tb[((c0 + 3) * cp) & 127]} * wv[u]; } }
        u32x2 o; o.x = cvt_pk_bf16(s[0], s[1]); o.y = cvt_pk_bf16(s[2], s[3]);
        *(u32x2*)(wcat + ((size_t)lg * 128 + d) * 256 + k4) = o; }
    __syncthreads();
}
__device__ __forceinline__ void row_stats(const f32x4 (&v)[8], float& mean, float& rstd) {
    float s = 0.f;
#pragma unroll
    for (int i = 0; i < 8; ++i) s += (v[i][0] + v[i][1]) + (v[i][2] + v[i][3]);
    mean = wave_sum(s) * (1.0f / DM); float q = 0.f;
#pragma unroll
    for (int i = 0; i < 8; ++i) { const f32x4 d = v[i] - mean; q += (d[0] * d[0] + d[1] * d[1]) + (d[2] * d[2] + d[3] * d[3]); }
    rstd = rsqrtf(wave_sum(q) * (1.0f / DM) + NORM_EPS);
}
__device__ __forceinline__ void p_ln_first(const Frame& F) {
    const float* x = F.in[0]; const float* mod = WSP(float, WS_MOD); bf16_t* H = WSP(bf16_t, WS_H);
    const int step = F.G * 8; int row = F.bx * 8 + F.wave;
    f32x4 v[8], vn[8];
    if (row < MTOK) { const float* xr = x + (size_t)row * DM + F.lane * 4;
#pragma unroll
        for (int i = 0; i < 8; ++i) vn[i] = *(const f32x4*)(xr + i * 256); }
    for (; row < MTOK; row += step) {
#pragma unroll
        for (int i = 0; i < 8; ++i) v[i] = vn[i];
        if (row + step < MTOK) { const float* xr = x + (size_t)(row + step) * DM + F.lane * 4;
#pragma unroll
            for (int i = 0; i < 8; ++i) vn[i] = *(const f32x4*)(xr + i * 256); }
        float mean, rstd; row_stats(v, mean, rstd);
        const float* mp = mod + (size_t)(row >> 12) * (3 * DM) + F.lane * 4;
#pragma unroll
        for (int i = 0; i < 8; ++i) { const f32x4 sh = *(const f32x4*)(mp + i * 256), sc = *(const f32x4*)(mp + DM + i * 256);
            store4_bf16(H + (size_t)row * DM + F.lane * 4 + i * 256, (v[i] - mean) * rstd * (sc + 1.0f) + sh); }
    }
}
template <bool NEXT> __device__ __forceinline__ void p_ln_post(const Frame& F, int l) {
    const float* xs = l == 0 ? F.in[0] : WSP(float, WS_R); float* dst = NEXT ? WSP(float, WS_R) : F.out; const float* g = F.in[12] + l * DM; const float* bb = F.in[13] + l * DM;
    const float* mod = WSP(float, WS_MOD) + (size_t)(l + 1) * NB * (3 * DM); bf16_t* H = WSP(bf16_t, WS_H);
    const int step = F.G * 8; int row = F.bx * 8 + F.wave;
    f32x4 v[8], vn[8]; u32x2 gy[8], gyn[8];
    if (row < MTOK) { const float* xr = xs + (size_t)row * DM + F.lane * 4; const bf16_t* gr = H + (size_t)row * DM + F.lane * 4;
#pragma unroll
        for (int i = 0; i < 8; ++i) { vn[i] = *(const f32x4*)(xr + i * 256); gyn[i] = *(const u32x2*)(gr + i * 256); } }
    for (; row < MTOK; row += step) {
#pragma unroll
        for (int i = 0; i < 8; ++i) { const u32x2 q = gyn[i];
            v[i] = vn[i] * DN_ALPHA + (f32x4){__uint_as_float(q.x << 16), __uint_as_float(q.x & 0xffff0000u), __uint_as_float(q.y << 16), __uint_as_float(q.y & 0xffff0000u)}; }
        if (row + step < MTOK) { const float* xr = xs + (size_t)(row + step) * DM + F.lane * 4; const bf16_t* gr = H + (size_t)(row + step) * DM + F.lane * 4;
#pragma unroll
            for (int i = 0; i < 8; ++i) { vn[i] = *(const f32x4*)(xr + i * 256); gyn[i] = *(const u32x2*)(gr + i * 256); } }
        float mean, rstd; row_stats(v, mean, rstd);
#pragma unroll
        for (int i = 0; i < 8; ++i) { v[i] = (v[i] - mean) * rstd * *(const f32x4*)(g + F.lane * 4 + i * 256) + *(const f32x4*)(bb + F.lane * 4 + i * 256);
            *(f32x4*)(dst + (size_t)row * DM + F.lane * 4 + i * 256) = v[i]; }
        if (NEXT) { row_stats(v, mean, rstd); const float* mp = mod + (size_t)(row >> 12) * (3 * DM) + F.lane * 4;
#pragma unroll
            for (int i = 0; i < 8; ++i) { const f32x4 sh = *(const f32x4*)(mp + i * 256), sc = *(const f32x4*)(mp + DM + i * 256);
                store4_bf16(H + (size_t)row * DM + F.lane * 4 + i * 256, (v[i] - mean) * rstd * (sc + 1.0f) + sh); } }
    }
}
__device__ __forceinline__ void fft1_naive(const Frame& F) {
    const bf16_t* U = WSP(bf16_t, WS_U); const bf16_t* D1 = WSP(bf16_t, WS_D1); bf16_t* Z = WSP(bf16_t, WS_H);
    const int gid = F.bx * NTHREADS + F.tid, NT = F.G * NTHREADS;
    for (int idx = gid; idx < NB * 64 * NG * 64 * 128; idx += NT) {
        const int c = idx & 127, s2 = (idx >> 7) & 63, g = (idx >> 13) & 7, s1p = (idx >> 16) & 63, b = idx >> 22;
        float yr = 0.f, yi = 0.f;
        for (int s1 = 0; s1 < 64; ++s1) { const float u = bf2f(U[(size_t)(b * SEQ + 64 * s1 + s2) * DF + g * 128 + c]); yr += bf2f(D1[s1p * 64 + s1]) * u; yi += bf2f(D1[(64 + s1p) * 64 + s1]) * u; }
        float st, ct; sincospif((float)(s2 * s1p) * (1.0f / 2048.0f), &st, &ct);
        const size_t zo = ((((size_t)(b * 64 + s1p) * NG + g) * 2) * 64 + s2) * 128 + c;
        Z[zo] = f2bf(yr * ct + yi * st); Z[zo + 64 * 128] = f2bf(yi * ct - yr * st);
    }
}
__device__ __forceinline__ void fft2_naive(const Frame& F, int l) {
    const bf16_t* Z = WSP(bf16_t, WS_H); const bf16_t* D2 = WSP(bf16_t, WS_D2); const bf16_t* wcat = WSP(bf16_t, WS_WCAT) + (size_t)l * NG * 128 * 256; bf16_t* MIX = WSP(bf16_t, WS_MIX);
    LAS float* Xs = (LAS float*)F.lds;
    for (int it = F.bx; it < NB * 64 * NG; it += F.G) {
        const int g = it & 7, s1p = (it >> 3) & 63, b = it >> 9;
        const bf16_t* Zb = Z + ((size_t)(b * 64 + s1p) * NG + g) * 2 * 64 * 128;
        for (int i = 0; i < 32; ++i) { const int o = F.tid + 512 * i, c = o & 127, rr = o >> 7; float s = 0.f;
            for (int k = 0; k < 128; ++k) s += bf2f(D2[rr * 128 + k]) * bf2f(Zb[k * 128 + c]);
            Xs[rr * 128 + c] = bf2f(f2bf(s)); }
        __syncthreads();
        for (int i = 0; i < 16; ++i) { const int o = F.tid + 512 * i, d = o & 127, s2p = o >> 7; float s = 0.f;
            const bf16_t* wr = wcat + (size_t)(g * 128 + d) * 256;
            for (int k = 0; k < 256; ++k) s += Xs[((k >> 7) * 64 + s2p) * 128 + (k & 127)] * bf2f(wr[k]);
            const size_t mo = (size_t)(b * SEQ + s1p + 64 * s2p) * DM + g * 128 + d;
            MIX[mo] = f2bf(s * bf2f(MIX[mo])); }
        __syncthreads();
    }
}
__device__ __forceinline__ void attn_naive(const Frame& F) {
    const bf16_t* Q = WSP(bf16_t, WS_Q); const bf16_t* KV = WSP(bf16_t, WS_KV); const bf16_t* KR = WSP(bf16_t, WS_KR); bf16_t* MIX = WSP(bf16_t, WS_MIX);
    LAS float* qs = (LAS float*)F.lds + F.wave * 192;
    for (int it = F.bx * 8 + F.wave; it < MTOK * NH * 2; it += F.G * 8) {
        const int dh = it & 1, h = (it >> 1) & 7, tok = it >> 4, b = tok >> 12;
        __builtin_amdgcn_wave_barrier(); asm volatile("" ::: "memory");
        for (int e = 0; e < 3; ++e) qs[F.lane + 64 * e] = bf2f(Q[(size_t)tok * NQ + h * DQK + F.lane + 64 * e]);
        asm volatile("s_waitcnt lgkmcnt(0)" ::: "memory"); __builtin_amdgcn_wave_barrier();
        float m = -1e30f, lsum = 0.f; float o[64];
#pragma unroll
        for (int d = 0; d < 64; ++d) o[d] = 0.f;
        for (int t = 0; t < 64; ++t) {
            const size_t key = (size_t)b * SEQ + F.lane + 64 * t; const bf16_t* kn = KV + key * NKV + h * 256; const bf16_t* kr = KR + key * 64;
            float s = 0.f;
#pragma unroll 2
            for (int c = 0; c < 16; ++c) { const bf16x8 kv = *(const bf16x8*)(kn + c * 8);
#pragma unroll
                for (int e = 0; e < 8; ++e) s += qs[c * 8 + e] * bf2f((bf16_t)kv[e]); }
#pragma unroll 2
            for (int c = 0; c < 8; ++c) { const bf16x8 kv = *(const bf16x8*)(kr + c * 8);
#pragma unroll
                for (int e = 0; e < 8; ++e) s += qs[128 + c * 8 + e] * bf2f((bf16_t)kv[e]); }
            s *= ATT_SCALE; const float mn = fmaxf(m, s), a = __expf(m - mn), p = __expf(s - mn); lsum = lsum * a + p; m = mn;
#pragma unroll
            for (int c = 0; c < 8; ++c) { const bf16x8 vv = *(const bf16x8*)(kn + 128 + dh * 64 + c * 8);
#pragma unroll
                for (int e = 0; e < 8; ++e) o[c * 8 + e] = o[c * 8 + e] * a + p * bf2f((bf16_t)vv[e]); }
        }
        const float Mx = wave_max(m), f = __expf(m - Mx); const float L = wave_sum(lsum * f);
        float keep0 = 0.f;
#pragma unroll
        for (int d = 0; d < 64; ++d) { const float od = wave_sum(o[d] * f); if (F.lane == d) keep0 = od; }
        const size_t mo = (size_t)tok * DM + DF + h * 128 + dh * 64 + F.lane;
        MIX[mo] = f2bf(keep0 / L * bf2f(MIX[mo]));
    }
}
namespace att {
constexpr int NW = 8, QBLK = 32, KVBLK = 64;
#ifndef ATT_SDEPTH
#define ATT_SDEPTH 1
#endif
constexpr int SDEPTH = ATT_SDEPTH;
constexpr float THR = 8.f;
constexpr int SHM_V = KVBLK * 128 * 2, SHM_KN = KVBLK * 128 * 2, SHM_KR = KVBLK * 64 * 2;
#ifndef ATT_QLDS
#define ATT_QLDS 6
#endif
constexpr int QLDS = ATT_QLDS, QREG = 12 - QLDS;
constexpr int OFF_V = 0, OFF_KN = 2 * SHM_V, OFF_KR = OFF_KN + 2 * SHM_KN, OFF_WS = OFF_KR + 2 * SHM_KR, OFF_QL = OFF_WS + NW * 64 * 4, OFF_OT = 0, OT_PITCH = 272, SHM_ATTN = OFF_QL + NW * QLDS * 1024;
static_assert(NW * 32 * OT_PITCH <= OFF_WS, "O tiles reuse the K/V buffers");
static_assert(SHM_ATTN <= RING_BYTES, "attention LDS must fit the phase scratch");
#define KSWZ(row, colB) ((row) * 256 + ((colB) ^ (((row) & 15) << 4)))
#define RSWZ(row, ch) ((row) * 128 + ((((ch) ^ (((row) >> 1) & 7))) << 4))
#define SBAR() __builtin_amdgcn_sched_barrier(0)
__device__ __forceinline__ int crow(int r, int hi) { return (r & 3) + 8 * (r >> 2) + 4 * hi; }
__device__ __forceinline__ unsigned cvtpk(float lo, float hi) { unsigned r; asm volatile("v_cvt_pk_bf16_f32 %0, %1, %2" : "=v"(r) : "v"(lo), "v"(hi)); return r; }
__device__ __forceinline__ bf16x8 ld8(const bf16_t* p) { return *reinterpret_cast<const bf16x8*>(p); }

__device__ __forceinline__ void partialSM(f32x16& p0, f32x16& p1, float& m_reg, float& mn, float& alpha) {
#if defined(PROBE_NEG) && PROBE_NEG == 2
  constexpr float C = ATT_SCALE * 1.4426950408889634f * 1.3f;
#else
  constexpr float C = ATT_SCALE * 1.4426950408889634f;
#endif
  float pmax = p0[0]; for (int r = 1; r < 16; ++r) pmax = fmaxf(pmax, p0[r]); for (int r = 0; r < 16; ++r) pmax = fmaxf(pmax, p1[r]);
  { auto rr = __builtin_amdgcn_permlane32_swap(__float_as_uint(pmax), __float_as_uint(pmax), false, false);
    pmax = fmaxf(__uint_as_float(rr[0]), __uint_as_float(rr[1])); }
  if (__builtin_expect(__all(pmax - m_reg <= THR / ATT_SCALE), 1)) { mn = m_reg; alpha = 1.f; }
  else { mn = fmaxf(m_reg, pmax); alpha = __builtin_amdgcn_exp2f((m_reg - mn) * C); m_reg = mn; }
  float mnC = -mn * C;
  for (int r = 0; r < 16; ++r) p0[r] = fmaf(p0[r], C, mnC); for (int r = 0; r < 16; ++r) p1[r] = fmaf(p1[r], C, mnC);
  for (int r = 0; r < 16; ++r) p0[r] = __builtin_amdgcn_exp2f(p0[r]);
}
__device__ __forceinline__ void finishSM(f32x16& p0, f32x16& p1, float alpha, float& l_reg, bf16x8& pa0, bf16x8& pa1, bf16x8& pa2, bf16x8& pa3) {
  for (int r = 0; r < 16; ++r) p1[r] = __builtin_amdgcn_exp2f(p1[r]);
  float ps = 0; for (int r = 0; r < 16; ++r) ps += p0[r]; for (int r = 0; r < 16; ++r) ps += p1[r];
  { auto rr = __builtin_amdgcn_permlane32_swap(__float_as_uint(ps), __float_as_uint(ps), false, false);
    ps = __uint_as_float(rr[0]) + __uint_as_float(rr[1]); }
  l_reg = l_reg * alpha + ps;
#define PK4(P, BASE, OUT) do { unsigned a0 = cvtpk(P[BASE + 0], P[BASE + 1]), a1 = cvtpk(P[BASE + 2], P[BASE + 3]);   \
    unsigned b0 = cvtpk(P[BASE + 4], P[BASE + 5]), b1 = cvtpk(P[BASE + 6], P[BASE + 7]);                              \
    auto r0 = __builtin_amdgcn_permlane32_swap(a0, b0, false, false); auto r1 = __builtin_amdgcn_permlane32_swap(a1, b1, false, false); \
    u32x4 w = {r0[0], r1[0], r0[1], r1[1]}; OUT = *reinterpret_cast<bf16x8*>(&w); } while (0)
  PK4(p0, 0, pa0); PK4(p0, 8, pa1); PK4(p1, 0, pa2); PK4(p1, 8, pa3);
#undef PK4
}
__device__ __forceinline__ bf16x8 qfrag(const char* ql, int d0) { return *reinterpret_cast<const bf16x8*>(ql + (d0 - QREG) * 1024); }
__device__ __forceinline__ void kfrag(bf16x8& a, bf16x8& b, const char* Kn, const char* Kr, int d0, int r32, int hi) {
  if (d0 < 8) { const int cb = (d0 * 16 + hi * 8) * 2; a = *reinterpret_cast<const bf16x8*>(Kn + KSWZ(r32, cb)); b = *reinterpret_cast<const bf16x8*>(Kn + KSWZ(32 + r32, cb)); }
  else { const int ch = (d0 - 8) * 2 + hi; a = *reinterpret_cast<const bf16x8*>(Kr + RSWZ(r32, ch)); b = *reinterpret_cast<const bf16x8*>(Kr + RSWZ(32 + r32, ch)); }
}
__device__ __forceinline__ void qkt(f32x16& p0, f32x16& p1, const char* Kn, const char* Kr, const bf16x8* qr, const char* ql, int r32, int hi) {
  p0 = f32x16{}; p1 = f32x16{};
  bf16x8 ka, kb, na, nb, qc, qn;
  kfrag(ka, kb, Kn, Kr, 0, r32, hi); if (0 >= QREG) qc = qfrag(ql, 0);
#pragma unroll
  for (int d0 = 0; d0 < 12; ++d0) {
    if (d0 + 1 < 12) { kfrag(na, nb, Kn, Kr, d0 + 1, r32, hi); if (d0 + 1 >= QREG) qn = qfrag(ql, d0 + 1); }
    SBAR();
    const bf16x8 q = d0 < QREG ? qr[d0 < QREG ? d0 : 0] : qc;
    p0 = __builtin_amdgcn_mfma_f32_32x32x16_bf16(ka, q, p0, 0, 0, 0);
    p1 = __builtin_amdgcn_mfma_f32_32x32x16_bf16(kb, q, p1, 0, 0, 0);
    SBAR();
    ka = na; kb = nb; qc = qn;
  }
}
__device__ __forceinline__ int v_st(int k, int c) { const int kk = (k & ~0xC) | ((k & 4) << 1) | ((k & 8) >> 1); return ((kk >> 3) * 4 + (c >> 5)) * 512 + ((kk & 7) * 32 + (c & 31)) * 2; }
__device__ __forceinline__ int v_rd_base(int lane) { return ((lane & 3) << 3) | (((lane >> 2) & 3) << 6) | (((lane >> 4) & 1) << 5) | (((lane >> 5) & 1) << 8); }
constexpr int v_rd_off(int d0, int ks, int half) { return d0 * 512 + ks * 4096 + half * 2048; }
template <int OFF> __device__ __forceinline__ s16x4 tr_read(int vb) {
  s16x4 r; asm volatile("ds_read_b64_tr_b16 %0, %1 offset:%2" : "=&v"(r) : "v"(vb), "i"(OFF) : "memory"); return r;
}
#define TRPK(L, H) (bf16x8){L[0], L[1], L[2], L[3], H[0], H[1], H[2], H[3]}
template <int D0> __device__ __forceinline__ void pv_one(f32x16& od, int vb, bf16x8 pa0, bf16x8 pa1, bf16x8 pa2, bf16x8 pa3) {
  const s16x4 l0 = tr_read<v_rd_off(D0, 0, 0)>(vb), h0 = tr_read<v_rd_off(D0, 0, 1)>(vb), l1 = tr_read<v_rd_off(D0, 1, 0)>(vb), h1 = tr_read<v_rd_off(D0, 1, 1)>(vb);
  const s16x4 l2 = tr_read<v_rd_off(D0, 2, 0)>(vb), h2 = tr_read<v_rd_off(D0, 2, 1)>(vb), l3 = tr_read<v_rd_off(D0, 3, 0)>(vb), h3 = tr_read<v_rd_off(D0, 3, 1)>(vb);
  asm volatile("s_waitcnt lgkmcnt(0)" ::: "memory"); SBAR();
  od = __builtin_amdgcn_mfma_f32_32x32x16_bf16(pa0, TRPK(l0, h0), od, 0, 0, 0);
  od = __builtin_amdgcn_mfma_f32_32x32x16_bf16(pa1, TRPK(l1, h1), od, 0, 0, 0);
  od = __builtin_amdgcn_mfma_f32_32x32x16_bf16(pa2, TRPK(l2, h2), od, 0, 0, 0);
  od = __builtin_amdgcn_mfma_f32_32x32x16_bf16(pa3, TRPK(l3, h3), od, 0, 0, 0);
}
__device__ __forceinline__ void pv_d0(f32x16* o, int vb, bf16x8 pa0, bf16x8 pa1, bf16x8 pa2, bf16x8 pa3) {
  pv_one<0>(o[0], vb, pa0, pa1, pa2, pa3); pv_one<1>(o[1], vb, pa0, pa1, pa2, pa3); pv_one<2>(o[2], vb, pa0, pa1, pa2, pa3); pv_one<3>(o[3], vb, pa0, pa1, pa2, pa3);
}

template <int VAR>
__device__ __forceinline__ void attn_body(const bf16_t* __restrict__ Qb, const bf16_t* __restrict__ Kn, const bf16_t* __restrict__ Kr,
                                          bf16_t* __restrict__ Gm, int seq, char* lds, int tid) {
  const int wid = tid >> 6, lane = tid & 63, r32 = lane & 31, hi = lane >> 5;
  char* V_lds = lds + OFF_V; char* K_lds = lds + OFF_KN; char* R_lds = lds + OFF_KR;
  float* ws = (float*)(lds + OFF_WS) + wid * 64; float* li_l = ws; float* al_l = ws + 32;
  float m_reg = -1e30f, l_reg = 0; f32x16 o[4] = {}; bf16x8 qr[QREG > 0 ? QREG : 1];
  char* ql = lds + OFF_QL + wid * (QLDS * 1024) + lane * 16;
  const unsigned qoff = (unsigned)((wid * QBLK + r32) * NQ + hi * 8) * 2u;
#pragma unroll
  for (int d0 = 0; d0 < 12; ++d0) { const bf16x8 qv = *(const bf16x8*)((const char*)Qb + qoff + d0 * 32); if (d0 < QREG) qr[d0 < QREG ? d0 : 0] = qv; else *reinterpret_cast<bf16x8*>(ql + (d0 - QREG) * 1024) = qv; }
  const int sr = tid >> 4, sc = (tid & 15) * 8, vst0 = v_st(sr, sc), vst1 = v_st(32 + sr, sc);
  const int rr_ = tid >> 3, rc_ = tid & 7;
  const int vb0 = (int)(uintptr_t)V_lds + v_rd_base(lane);
  struct { bf16x8 vs0, vs1, ks0, ks1, kr; } sr_[SDEPTH];
  const unsigned voff = (unsigned)(sr * NKV + sc) * 2u, voffr = (unsigned)(rr_ * 64 + rc_ * 8) * 2u;
#define SLOAD(i, k0) do { const char* kb_ = (const char*)(Kn + (long)(k0) * NKV); const char* rb_ = (const char*)(Kr + (long)(k0) * 64); \
    sr_[i].vs0 = *(const bf16x8*)(kb_ + 256 + voff); sr_[i].vs1 = *(const bf16x8*)(kb_ + (32 * NKV * 2 + 256) + voff); \
    sr_[i].ks0 = *(const bf16x8*)(kb_ + voff); sr_[i].ks1 = *(const bf16x8*)(kb_ + 32 * NKV * 2 + voff); \
    sr_[i].kr = *(const bf16x8*)(rb_ + voffr); } while (0)
#define SWRITE(b, i) do { *(bf16x8*)(V_lds + (b) * SHM_V + vst0) = sr_[i].vs0;          \
    *(bf16x8*)(V_lds + (b) * SHM_V + vst1) = sr_[i].vs1; int kc = sc * 2;               \
    *(bf16x8*)(K_lds + (b) * SHM_KN + KSWZ(sr, kc)) = sr_[i].ks0;                       \
    *(bf16x8*)(K_lds + (b) * SHM_KN + KSWZ(32 + sr, kc)) = sr_[i].ks1;                  \
    *(bf16x8*)(R_lds + (b) * SHM_KR + RSWZ(rr_, rc_)) = sr_[i].kr; } while (0)
#define SLOADV(i, k0) do { if constexpr (VAR != 4) SLOAD(i, k0); } while (0)
#define SWRITEV(b, i) do { if constexpr (VAR != 4) SWRITE(b, i); } while (0)
#define SWAIT() do { if constexpr (SDEPTH == 2) asm volatile("s_waitcnt vmcnt(5)" ::: "memory"); else asm volatile("s_waitcnt vmcnt(0)" ::: "memory"); } while (0)
#define RESC(a) do { if (__any((a) < 1.f)) { if (hi == 0) al_l[r32] = (a); asm volatile("s_waitcnt lgkmcnt(0)" ::: "memory"); \
    for (int d = 0; d < 4; ++d) for (int r = 0; r < 16; ++r) o[d][r] *= al_l[crow(r, hi)]; } } while (0)
  f32x16 pA0, pA1, pB0, pB1; float mnA, mnB, alA, alB; bf16x8 pa0, pa1, pa2, pa3; const int NT = seq / KVBLK;
#define QKT(P0, P1, KN, KR) do { if constexpr (VAR == 3) { P0 = o[0]; P1 = o[1]; } else qkt(P0, P1, KN, KR, qr, ql, r32, hi); } while (0)
#define PSM(P0, P1, MN, AL) do { if constexpr (VAR == 1) { MN = m_reg; AL = 1.f; } else partialSM(P0, P1, m_reg, MN, AL); } while (0)
#define FSM(P0, P1, AL) do { if constexpr (VAR == 1) { pa0 = __builtin_bit_cast(bf16x8, (f32x4){P0[0], P0[1], P0[2], P0[3]}); pa1 = __builtin_bit_cast(bf16x8, (f32x4){P0[4], P0[5], P0[6], P0[7]}); \
      pa2 = __builtin_bit_cast(bf16x8, (f32x4){P1[0], P1[1], P1[2], P1[3]}); pa3 = __builtin_bit_cast(bf16x8, (f32x4){P1[4], P1[5], P1[6], P1[7]}); l_reg += P0[8] + P1[9]; } \
    else finishSM(P0, P1, AL, l_reg, pa0, pa1, pa2, pa3); } while (0)
#define PVD(VB) do { if constexpr (VAR == 2) { o[0][0] += __builtin_bit_cast(f32x4, pa0)[0]; o[1][1] += __builtin_bit_cast(f32x4, pa1)[1]; o[2][2] += __builtin_bit_cast(f32x4, pa2)[2]; o[3][3] += __builtin_bit_cast(f32x4, pa3)[3]; } else pv_d0(o, VB, pa0, pa1, pa2, pa3); } while (0)
#define SYNC() do { if constexpr (VAR != 5) __syncthreads(); } while (0)
  constexpr int SE = 0, SO = SDEPTH - 1;
  SLOAD(SE, 0); asm volatile("s_waitcnt vmcnt(0)" ::: "memory"); SWRITE(0, SE); SYNC();
  QKT(pA0, pA1, K_lds, R_lds); PSM(pA0, pA1, mnA, alA);
  SLOAD(SO, KVBLK); if constexpr (SDEPTH == 2) { if (2 < NT) SLOAD(SE, 2 * KVBLK); }
  SWAIT(); SWRITE(1, SO); SYNC();
  for (int j = 1; j + 1 < NT; j += 2) {
    SBAR(); QKT(pB0, pB1, K_lds + SHM_KN, R_lds + SHM_KR);
    FSM(pA0, pA1, alA); SBAR();
    SLOADV(SO, (j + SDEPTH) * KVBLK); SBAR();
    PVD(vb0); PSM(pB0, pB1, mnB, alB);
    SYNC(); SWAIT(); SWRITEV(0, SE);
    RESC(alB); SYNC();
    SBAR(); QKT(pA0, pA1, K_lds, R_lds);
    FSM(pB0, pB1, alB); SBAR();
    if (SDEPTH == 1 || j + 3 < NT) SLOADV(SE, (j + 1 + SDEPTH) * KVBLK); SBAR();
    PVD(vb0 + (int)SHM_V); PSM(pA0, pA1, mnA, alA);
    SYNC(); SWAIT(); SWRITEV(1, SO);
    RESC(alA); SYNC();
  }
  SBAR(); QKT(pB0, pB1, K_lds + SHM_KN, R_lds + SHM_KR);
  FSM(pA0, pA1, alA); SBAR();
  PVD(vb0); PSM(pB0, pB1, mnB, alB);
  SYNC(); RESC(alB);
  FSM(pB0, pB1, alB); SBAR();
  PVD(vb0 + (int)SHM_V);
  SBAR(); asm volatile("" ::: "memory");
  u32x4 gt[8]; const int grow = lane >> 4, gc16 = lane & 15;
  bf16_t* Gw = Gm + (size_t)(wid * QBLK + grow) * DM + gc16 * 8;
#pragma unroll
  for (int i = 0; i < 8; ++i) gt[i] = *(const u32x4*)(Gw + (size_t)(4 * i) * DM);
  if (hi == 0) li_l[r32] = l_reg;
  __syncthreads();
  char* ot = lds + OFF_OT + wid * (32 * OT_PITCH);
#pragma unroll
  for (int r = 0; r < 16; ++r) { const float rl = __builtin_amdgcn_rcpf(li_l[crow(r, hi)]); char* orow = ot + crow(r, hi) * OT_PITCH + r32 * 2;
#pragma unroll
    for (int d0 = 0; d0 < 4; ++d0) *(bf16_t*)(orow + d0 * 64) = f2bf(o[d0][r] * rl); }
  asm volatile("s_waitcnt lgkmcnt(0)" ::: "memory");
#pragma unroll
  for (int i = 0; i < 8; ++i) { const u32x4 ov = *(const u32x4*)(ot + (grow + 4 * i) * OT_PITCH + gc16 * 16); const u32x4 gv = gt[i]; u32x4 w;
#pragma unroll
    for (int e = 0; e < 4; ++e) { const float a0 = __uint_as_float(ov[e] << 16) * __uint_as_float(gv[e] << 16), a1 = __uint_as_float(ov[e] & 0xffff0000u) * __uint_as_float(gv[e] & 0xffff0000u); w[e] = cvt_pk_bf16(a0, a1); }
    *(u32x4*)(Gw + (size_t)(4 * i) * DM) = w; }
#undef SLOAD
#undef SLOADV
#undef SWRITEV
#undef QKT
#undef PSM
#undef FSM
#undef PVD
#undef SYNC
#undef SWRITE
#undef SWAIT
#undef RESC
}
}

template <int VAR = 0>
__device__ __forceinline__ void attn_fast(const Frame& F) {
    const bf16_t* Q = WSP(bf16_t, WS_Q); const bf16_t* KV = WSP(bf16_t, WS_KV); const bf16_t* KR = WSP(bf16_t, WS_KR); bf16_t* MIX = WSP(bf16_t, F.mix_off);
    for (int it = F.vcu; it < NB * NH * (SEQ / 256); it += F.G) {
        const int qb = it & 15, p = it >> 4, h = p & 7, b = p >> 3;
        const size_t t0 = (size_t)b * SEQ, q0 = t0 + (size_t)qb * 256;
        int t = F.tid; asm volatile("" : "+v"(t));
        att::attn_body<VAR>(Q + q0 * NQ + h * DQK, KV + t0 * NKV + h * 256, KR + t0 * 64, MIX + q0 * DM + DF + h * 128, SEQ, F.ldsg, t);
        __syncthreads();
    }
}
namespace fft {
using att::v_st; using att::v_rd_base; using att::v_rd_off; using att::tr_read; using att::crow;
constexpr int OPITCH = 272;
constexpr int F1_T = 0, F1_OUT = 16384, F1_END = F1_OUT + 128 * OPITCH;
constexpr int XPITCH = 528;
constexpr int F2_Z = 0, F2_XL = 32768, F2_YL = F2_XL + 64 * XPITCH, F2_D2 = F2_YL + 64 * XPITCH, F2_END = F2_D2 + 128 * OPITCH;
static_assert(F1_END <= RING_BYTES && F2_END <= RING_BYTES, "FFT LDS must fit the phase scratch");
}
__device__ __forceinline__ void fft1_fast(const Frame& F) {
    using namespace fft;
    const bf16_t* U = WSP(bf16_t, WS_U); const bf16_t* D1 = WSP(bf16_t, WS_D1); bf16_t* Z = WSP(bf16_t, WS_H);
    const int tid = F.tid, wid = tid >> 6, lane = tid & 63, r32 = lane & 31, hi = lane >> 5, half = wid & 1, cb = wid >> 1;
    char* lds = F.ldsg;
    bf16x8 bfr[2][4];
#pragma unroll
    for (int ri = 0; ri < 2; ++ri)
#pragma unroll
        for (int ks = 0; ks < 4; ++ks) bfr[ri][ks] = *(const bf16x8*)(D1 + (ri * 64 + half * 32 + r32) * 64 + 16 * ks + 8 * hi);
    const int sr = tid >> 4, sc = (tid & 15) * 8, vst0 = v_st(sr, sc), vst1 = v_st(32 + sr, sc);
    const int vb = (int)(uintptr_t)(lds + F1_T) + v_rd_base(lane) + cb * 512;
    const int s1p = half * 32 + r32;
    int it = F.bx; if (it >= NB * 64 * NG) return;
    bf16x8 u0, u1;
#define F1_LOAD(IT) do { const int g_ = (IT) & 7, s2_ = ((IT) >> 3) & 63, b_ = (IT) >> 9; const bf16_t* up = U + ((size_t)(b_ * SEQ + s2_)) * DF + g_ * 128 + sc; \
        u0 = *(const bf16x8*)(up + (size_t)(64 * sr) * DF); u1 = *(const bf16x8*)(up + (size_t)(64 * (sr + 32)) * DF); } while (0)
    F1_LOAD(it);
    for (; it < NB * 64 * NG; it += F.G) {
        const int g = it & 7, s2 = (it >> 3) & 63, b = it >> 9;
        *(bf16x8*)(lds + F1_T + vst0) = u0; *(bf16x8*)(lds + F1_T + vst1) = u1;
        __syncthreads();
        if (it + F.G < NB * 64 * NG) F1_LOAD(it + F.G);
        f32x16 acc0 = {}, acc1 = {};
        { const s16x4 l0 = tr_read<v_rd_off(0, 0, 0)>(vb), h0 = tr_read<v_rd_off(0, 0, 1)>(vb), l1 = tr_read<v_rd_off(0, 1, 0)>(vb), h1 = tr_read<v_rd_off(0, 1, 1)>(vb);
          const s16x4 l2 = tr_read<v_rd_off(0, 2, 0)>(vb), h2 = tr_read<v_rd_off(0, 2, 1)>(vb), l3 = tr_read<v_rd_off(0, 3, 0)>(vb), h3 = tr_read<v_rd_off(0, 3, 1)>(vb);
          asm volatile("s_waitcnt lgkmcnt(0)" ::: "memory"); __builtin_amdgcn_sched_barrier(0);
          acc0 = __builtin_amdgcn_mfma_f32_32x32x16_bf16(TRPK(l0, h0), bfr[0][0], acc0, 0, 0, 0); acc1 = __builtin_amdgcn_mfma_f32_32x32x16_bf16(TRPK(l0, h0), bfr[1][0], acc1, 0, 0, 0);
          acc0 = __builtin_amdgcn_mfma_f32_32x32x16_bf16(TRPK(l1, h1), bfr[0][1], acc0, 0, 0, 0); acc1 = __builtin_amdgcn_mfma_f32_32x32x16_bf16(TRPK(l1, h1), bfr[1][1], acc1, 0, 0, 0);
          acc0 = __builtin_amdgcn_mfma_f32_32x32x16_bf16(TRPK(l2, h2), bfr[0][2], acc0, 0, 0, 0); acc1 = __builtin_amdgcn_mfma_f32_32x32x16_bf16(TRPK(l2, h2), bfr[1][2], acc1, 0, 0, 0);
          acc0 = __builtin_amdgcn_mfma_f32_32x32x16_bf16(TRPK(l3, h3), bfr[0][3], acc0, 0, 0, 0); acc1 = __builtin_amdgcn_mfma_f32_32x32x16_bf16(TRPK(l3, h3), bfr[1][3], acc1, 0, 0, 0); }
        float st, ct; sincospif((float)(s2 * s1p) * (1.0f / 2048.0f), &st, &ct);
        char* o0 = lds + F1_OUT + s1p * OPITCH + (cb * 32 + 4 * hi) * 2; char* o1 = o0 + 64 * OPITCH;
#pragma unroll
        for (int q = 0; q < 4; ++q) { float zr[4], zi[4];
#pragma unroll
            for (int j = 0; j < 4; ++j) { const float yr = acc0[4 * q + j], yi = acc1[4 * q + j]; zr[j] = yr * ct + yi * st; zi[j] = yi * ct - yr * st; }
            *(u32x2*)(o0 + q * 16) = (u32x2){cvt_pk_bf16(zr[0], zr[1]), cvt_pk_bf16(zr[2], zr[3])};
            *(u32x2*)(o1 + q * 16) = (u32x2){cvt_pk_bf16(zi[0], zi[1]), cvt_pk_bf16(zi[2], zi[3])}; }
        __syncthreads();
#pragma unroll
        for (int i = 0; i < 4; ++i) { const int q = tid + 512 * i, row = q >> 4, c16 = q & 15, ri = row >> 6, sp = row & 63;
            const u32x4 v = *(const u32x4*)(lds + F1_OUT + row * OPITCH + c16 * 16);
            *(u32x4*)(Z + (((((size_t)(b * 64 + sp) * NG + g) * 2 + ri) * 64 + s2) * 128) + c16 * 8) = v; }
    }
#undef F1_LOAD
    __syncthreads();
}
__device__ __forceinline__ void fft2_fast(const Frame& F, int l) {
    using namespace fft;
    const bf16_t* Z = WSP(bf16_t, WS_H); const bf16_t* D2 = WSP(bf16_t, WS_D2); const bf16_t* wcat = WSP(bf16_t, WS_WCAT) + (size_t)l * NG * 128 * 256; bf16_t* MIX = WSP(bf16_t, F.mix_off);
    const int tid = F.tid, wid = tid >> 6, lane = tid & 63, r32 = lane & 31, hi = lane >> 5, cb = wid & 3, h2 = wid >> 2;
    char* lds = F.ldsg;
    int it = F.bx; if (it >= NB * 64 * NG) return;
#pragma unroll
    for (int i = 0; i < 4; ++i) { const int q = tid + 512 * i, row = q >> 4, c16 = q & 15; *(u32x4*)(lds + F2_D2 + row * OPITCH + c16 * 16) = *(const u32x4*)(D2 + row * 128 + c16 * 8); }
    const int sr = tid >> 4, sc = (tid & 15) * 8, vst0 = v_st(sr, sc), vst1 = v_st(32 + sr, sc);
    const int vb = (int)(uintptr_t)(lds + F2_Z) + v_rd_base(lane) + cb * 512;
    bf16x8 wfr[16]; int gcur = -1;
    bf16x8 z0, z1, z2, z3, g0, g1;
#define F2_LOAD(IT) do { const int g_ = (IT) & 7, sp_ = ((IT) >> 3) & 63, b_ = (IT) >> 9; const bf16_t* zp = Z + ((size_t)(b_ * 64 + sp_) * NG + g_) * (2 * 64 * 128) + sr * 128 + sc; \
        z0 = *(const bf16x8*)(zp); z1 = *(const bf16x8*)(zp + 32 * 128); z2 = *(const bf16x8*)(zp + 64 * 128); z3 = *(const bf16x8*)(zp + 96 * 128); \
        const bf16_t* mp = MIX + ((size_t)(b_ * SEQ + sp_ + 64 * (tid >> 4))) * DM + g_ * 128 + (tid & 15) * 8; g0 = *(const bf16x8*)(mp); g1 = *(const bf16x8*)(mp + (size_t)(64 * 32) * DM); } while (0)
    F2_LOAD(it);
    for (; it < NB * 64 * NG; it += F.G) {
        const int g = it & 7, sp = (it >> 3) & 63, b = it >> 9;
        if (g != gcur) { gcur = g;
#pragma unroll
            for (int ks = 0; ks < 16; ++ks) wfr[ks] = *(const bf16x8*)(wcat + (size_t)(g * 128 + cb * 32 + r32) * 256 + 16 * ks + 8 * hi); }
        *(bf16x8*)(lds + F2_Z + vst0) = z0; *(bf16x8*)(lds + F2_Z + vst1) = z1; *(bf16x8*)(lds + F2_Z + 16384 + vst0) = z2; *(bf16x8*)(lds + F2_Z + 16384 + vst1) = z3;
        const bf16x8 gg0 = g0, gg1 = g1;
        __syncthreads();
        if (it + F.G < NB * 64 * NG) F2_LOAD(it + F.G);
#if defined(FFT2_P1_NAIVE)
        { const bf16_t* Zb = Z + ((size_t)(b * 64 + sp) * NG + g) * (2 * 64 * 128);
          for (int i = 0; i < 32; ++i) { const int o = tid + 512 * i, c = o & 127, rr = o >> 7; float s_ = 0.f;
              for (int k = 0; k < 128; ++k) s_ += bf2f(D2[rr * 128 + k]) * bf2f(Zb[k * 128 + c]);
              *(bf16_t*)(lds + F2_XL + (rr & 63) * XPITCH + ((rr >> 6) * 128 + c) * 2) = f2bf(s_); } }
#else
        f32x16 x0 = {}, x1 = {};
        const char* d2p = lds + F2_D2 + (h2 * 32 + r32) * OPITCH + 16 * hi;
#pragma unroll
        for (int t = 0; t < 2; ++t) {
            const int vbt = vb + t * 16384;
            const s16x4 l0 = tr_read<v_rd_off(0, 0, 0)>(vbt), h0 = tr_read<v_rd_off(0, 0, 1)>(vbt), l1 = tr_read<v_rd_off(0, 1, 0)>(vbt), h1 = tr_read<v_rd_off(0, 1, 1)>(vbt);
            const s16x4 l2 = tr_read<v_rd_off(0, 2, 0)>(vbt), h2_ = tr_read<v_rd_off(0, 2, 1)>(vbt), l3 = tr_read<v_rd_off(0, 3, 0)>(vbt), h3 = tr_read<v_rd_off(0, 3, 1)>(vbt);
            bf16x8 e0[4], e1[4];
#pragma unroll
            for (int ks = 0; ks < 4; ++ks) { e0[ks] = *(const bf16x8*)(d2p + (t * 4 + ks) * 32); e1[ks] = *(const bf16x8*)(d2p + 64 * OPITCH + (t * 4 + ks) * 32); }
            asm volatile("s_waitcnt lgkmcnt(0)" ::: "memory"); __builtin_amdgcn_sched_barrier(0);
            x0 = __builtin_amdgcn_mfma_f32_32x32x16_bf16(TRPK(l0, h0), e0[0], x0, 0, 0, 0); x1 = __builtin_amdgcn_mfma_f32_32x32x16_bf16(TRPK(l0, h0), e1[0], x1, 0, 0, 0);
            x0 = __builtin_amdgcn_mfma_f32_32x32x16_bf16(TRPK(l1, h1), e0[1], x0, 0, 0, 0); x1 = __builtin_amdgcn_mfma_f32_32x32x16_bf16(TRPK(l1, h1), e1[1], x1, 0, 0, 0);
            x0 = __builtin_amdgcn_mfma_f32_32x32x16_bf16(TRPK(l2, h2_), e0[2], x0, 0, 0, 0); x1 = __builtin_amdgcn_mfma_f32_32x32x16_bf16(TRPK(l2, h2_), e1[2], x1, 0, 0, 0);
            x0 = __builtin_amdgcn_mfma_f32_32x32x16_bf16(TRPK(l3, h3), e0[3], x0, 0, 0, 0); x1 = __builtin_amdgcn_mfma_f32_32x32x16_bf16(TRPK(l3, h3), e1[3], x1, 0, 0, 0);
        }
        { char* xr = lds + F2_XL + (h2 * 32 + r32) * XPITCH + (cb * 32 + 4 * hi) * 2;
#pragma unroll
          for (int q = 0; q < 4; ++q) { *(u32x2*)(xr + q * 16) = (u32x2){cvt_pk_bf16(x0[4 * q], x0[4 * q + 1]), cvt_pk_bf16(x0[4 * q + 2], x0[4 * q + 3])};
              *(u32x2*)(xr + 256 + q * 16) = (u32x2){cvt_pk_bf16(x1[4 * q], x1[4 * q + 1]), cvt_pk_bf16(x1[4 * q + 2], x1[4 * q + 3])}; } }
#endif
        __syncthreads();
#if defined(FFT2_P2_NAIVE)
        for (int i = 0; i < 16; ++i) { const int o = tid + 512 * i, d = o & 127, s2p = o >> 7; float s_ = 0.f;
            const bf16_t* wr_ = wcat + (size_t)(g * 128 + d) * 256;
            for (int k = 0; k < 256; ++k) s_ += bf2f(*(const bf16_t*)(lds + F2_XL + s2p * XPITCH + k * 2)) * bf2f(wr_[k]);
            *(float*)(lds + F2_YL + s2p * XPITCH + d * 4) = s_; }
#else
        f32x16 y = {};
        { const char* xb = lds + F2_XL + (h2 * 32 + r32) * XPITCH + 16 * hi;
#pragma unroll
          for (int ks = 0; ks < 16; ++ks) { const bf16x8 xf = *(const bf16x8*)(xb + ks * 32); y = __builtin_amdgcn_mfma_f32_32x32x16_bf16(wfr[ks], xf, y, 0, 0, 0); } }
        { char* yr = lds + F2_YL + (h2 * 32 + r32) * XPITCH + (cb * 32 + 4 * hi) * 4;
#pragma unroll
          for (int q = 0; q < 4; ++q) *(f32x4*)(yr + q * 32) = (f32x4){y[4 * q], y[4 * q + 1], y[4 * q + 2], y[4 * q + 3]}; }
#endif
        __syncthreads();
#pragma unroll
        for (int i = 0; i < 2; ++i) { const int row = (tid >> 4) + 32 * i, c8 = (tid & 15) * 8; const bf16x8 gv = i ? gg1 : gg0;
            const f32x4 ya = *(const f32x4*)(lds + F2_YL + row * XPITCH + c8 * 4), yb = *(const f32x4*)(lds + F2_YL + row * XPITCH + c8 * 4 + 16);
            f32x4 ga = {bf2f((bf16_t)gv[0]), bf2f((bf16_t)gv[1]), bf2f((bf16_t)gv[2]), bf2f((bf16_t)gv[3])}, gb = {bf2f((bf16_t)gv[4]), bf2f((bf16_t)gv[5]), bf2f((bf16_t)gv[6]), bf2f((bf16_t)gv[7])};
            store8_bf16(MIX + ((size_t)(b * SEQ + sp + 64 * row)) * DM + g * 128 + c8, ya * ga, yb * gb); }
    }
#undef F2_LOAD
    __syncthreads();
}
#if PROBE_CHECK
constexpr size_t WS_CHK_GATE = WS_U;
constexpr size_t WS_CHK_CNT = WS_CTL + 15 * 1024;
__device__ __forceinline__ int chk_tok(int i) { return (i * 64 + 37 + (i >> 2) * 4096 / 64 * 0) % MTOK + ((i & 3) * 4096) - ((i & 3) * 4096); }
__device__ __forceinline__ void chk_fail(const Frame& F, float a, float b, float atol, float rtol) { if (!(fabsf(a - b) <= atol + rtol * fabsf(b))) atomicAdd(WSP(unsigned, WS_CHK_CNT), 1u); }
__device__ __forceinline__ void chk_proj(const Frame& F, int l) {
    LAS float* hs = (LAS float*)F.lds;
    LAS float* cs = hs + 2048;
    LAS float* red = cs + 832;
    const float* x = l == 0 ? F.in[0] : WSP(float, WS_R); const float* mod = WSP(float, WS_MOD) + (size_t)l * NB * 3 * DM; const float* w_in = F.in[5] + (size_t)l * DM * NIN;
    for (int i = F.bx; i < 256; i += F.G) {
        const int tok = 64 * i + 37, b = tok >> 12, tid = F.tid;
        float s = 0.f; for (int k = tid; k < DM; k += NTHREADS) s += x[(size_t)tok * DM + k];
        s = wave_sum(s); if (F.lane == 0) red[F.wave] = s; __syncthreads(); float mean = 0.f; for (int w = 0; w < 8; ++w) mean += red[w]; mean *= (1.0f / DM); __syncthreads();
        float q2 = 0.f; for (int k = tid; k < DM; k += NTHREADS) { const float d = x[(size_t)tok * DM + k] - mean; q2 += d * d; }
        q2 = wave_sum(q2); if (F.lane == 0) red[F.wave] = q2; __syncthreads(); float var = 0.f; for (int w = 0; w < 8; ++w) var += red[w]; const float rstd = rsqrtf(var * (1.0f / DM) + NORM_EPS); __syncthreads();
        for (int k = tid; k < DM; k += NTHREADS) hs[k] = bf2f(f2bf((x[(size_t)tok * DM + k] - mean) * rstd * (1.0f + mod[(size_t)b * 3 * DM + DM + k]) + mod[(size_t)b * 3 * DM + k]));
        __syncthreads();
        for (int c = tid; c < 832; c += NTHREADS) { float a = 0.f; for (int k = 0; k < DM; ++k) a += hs[k] * bf2f(f2bf(w_in[(size_t)k * NIN + 2048 + c])); cs[c] = a; }
        __syncthreads();
        float sq = 0.f; for (int c = tid; c < 512; c += NTHREADS) sq += cs[c] * cs[c];
        sq = wave_sum(sq); if (F.lane == 0) red[F.wave] = sq; __syncthreads(); float sq_q = 0.f; for (int w = 0; w < 8; ++w) sq_q += red[w]; __syncthreads();
        float sk = 0.f; for (int c = 512 + tid; c < 768; c += NTHREADS) sk += cs[c] * cs[c];
        sk = wave_sum(sk); if (F.lane == 0) red[F.wave] = sk; __syncthreads(); float sq_k = 0.f; for (int w = 0; w < 8; ++w) sq_k += red[w]; __syncthreads();
        const float rq = rsqrtf(sq_q * (1.0f / QLR) + NORM_EPS), rk = rsqrtf(sq_k * (1.0f / KVLR) + NORM_EPS);
        const float* rc = WSP(float, WS_RCOS) + (size_t)tok * 32; const float* rs = WSP(float, WS_RSIN) + (size_t)tok * 32;
        const int pos = ((const int*)F.in[2])[tok];
        if (tid < 32) { const float ang = (float)pos * powf(10000.0f, -(float)tid / 32.0f); const float c_ = cosf(ang), s_ = sinf(ang); const float x1 = cs[768 + tid], x2 = cs[800 + tid];
            chk_fail(F, bf2f(WSP(bf16_t, WS_KR)[(size_t)tok * 64 + tid]), x1 * c_ - x2 * s_, 0.05f, 0.05f); chk_fail(F, bf2f(WSP(bf16_t, WS_KR)[(size_t)tok * 64 + 32 + tid]), x2 * c_ + x1 * s_, 0.05f, 0.05f);
            chk_fail(F, rc[tid], c_, 0.02f, 0.f); chk_fail(F, rs[tid], s_, 0.02f, 0.f); }
        const float* wq = F.in[7] + (size_t)l * QLR * NQ; const float* gq = F.in[6] + l * QLR;
        for (int n = tid; n < NQ; n += NTHREADS) { const int head = n / DQK, d = n - head * DQK; if (d >= 160) continue;
            float a = 0.f, a2 = 0.f; for (int k = 0; k < QLR; ++k) { const float cn = bf2f(f2bf(cs[k])) * rq * gq[k]; a += cn * wq[(size_t)k * NQ + n]; if (d >= 128) a2 += cn * wq[(size_t)k * NQ + n + 32]; }
            if (d < 128) chk_fail(F, bf2f(WSP(bf16_t, WS_Q)[(size_t)tok * NQ + n]), a, 0.06f, 0.05f);
            else { const int ii = d - 128; const float ang = (float)pos * powf(10000.0f, -(float)ii / 32.0f); const float c_ = cosf(ang), s_ = sinf(ang);
                chk_fail(F, bf2f(WSP(bf16_t, WS_Q)[(size_t)tok * NQ + n]), a * c_ - a2 * s_, 0.06f, 0.05f); chk_fail(F, bf2f(WSP(bf16_t, WS_Q)[(size_t)tok * NQ + n + 32]), a2 * c_ + a * s_, 0.06f, 0.05f); } }
        const float* wk = F.in[9] + (size_t)l * KVLR * NKV; const float* gk = F.in[8] + l * KVLR;
        for (int n = tid; n < NKV; n += NTHREADS) { float a = 0.f; for (int k = 0; k < KVLR; ++k) a += bf2f(f2bf(cs[512 + k])) * rk * gk[k] * wk[(size_t)k * NKV + n];
            chk_fail(F, bf2f(WSP(bf16_t, WS_KV)[(size_t)tok * NKV + n]), a, 0.06f, 0.05f); }
        for (int c = tid; c < 1024; c += NTHREADS) WSP(bf16_t, WS_CHK_GATE)[(size_t)i * 1024 + c] = WSP(bf16_t, WS_MIX)[(size_t)tok * DM + DF + c];
        __syncthreads();
    }
}
__device__ __forceinline__ void chk_attn(const Frame& F) {
    const bf16_t* Q = WSP(bf16_t, WS_Q); const bf16_t* KV = WSP(bf16_t, WS_KV); const bf16_t* KR = WSP(bf16_t, WS_KR); const bf16_t* MIX = WSP(bf16_t, WS_MIX);
    LAS float* qs = (LAS float*)F.lds + F.wave * 192;
    for (int i = F.bx; i < 256; i += F.G) {
        const int tok = 64 * i + 37, b = tok >> 12, h = F.wave;
        for (int dh = 0; dh < 2; ++dh) {
            __builtin_amdgcn_wave_barrier(); asm volatile("" ::: "memory");
            for (int e = 0; e < 3; ++e) qs[F.lane + 64 * e] = bf2f(Q[(size_t)tok * NQ + h * DQK + F.lane + 64 * e]);
            asm volatile("s_waitcnt lgkmcnt(0)" ::: "memory"); __builtin_amdgcn_wave_barrier();
            float m = -1e30f, lsum = 0.f; float o[64];
#pragma unroll
            for (int d = 0; d < 64; ++d) o[d] = 0.f;
            for (int t = 0; t < 64; ++t) {
                const size_t key = (size_t)b * SEQ + F.lane + 64 * t; const bf16_t* kn = KV + key * NKV + h * 256; const bf16_t* kr = KR + key * 64;
                float s = 0.f;
#pragma unroll 2
                for (int c = 0; c < 16; ++c) { const bf16x8 kv = *(const bf16x8*)(kn + c * 8);
#pragma unroll
                    for (int e = 0; e < 8; ++e) s += qs[c * 8 + e] * bf2f((bf16_t)kv[e]); }
#pragma unroll 2
                for (int c = 0; c < 8; ++c) { const bf16x8 kv = *(const bf16x8*)(kr + c * 8);
#pragma unroll
                    for (int e = 0; e < 8; ++e) s += qs[128 + c * 8 + e] * bf2f((bf16_t)kv[e]); }
                s *= ATT_SCALE; const float mn = fmaxf(m, s), a = __expf(m - mn), p = __expf(s - mn); lsum = lsum * a + p; m = mn;
#pragma unroll
                for (int c = 0; c < 8; ++c) { const bf16x8 vv = *(const bf16x8*)(kn + 128 + dh * 64 + c * 8);
#pragma unroll
                    for (int e = 0; e < 8; ++e) o[c * 8 + e] = o[c * 8 + e] * a + p * bf2f((bf16_t)vv[e]); }
            }
            const float Mx = wave_max(m), f = __expf(m - Mx); const float Ls = wave_sum(lsum * f);
            float keep0 = 0.f;
#pragma unroll
            for (int d = 0; d < 64; ++d) { const float od = wave_sum(o[d] * f); if (F.lane == d) keep0 = od; }
            const int col = h * 128 + dh * 64 + F.lane;
            const float ref = keep0 / Ls * bf2f(WSP(bf16_t, WS_CHK_GATE)[(size_t)i * 1024 + col]);
            chk_fail(F, bf2f(MIX[(size_t)tok * DM + DF + col]), ref, 1.5e-3f, 0.05f);
        }
    }
}
__device__ __forceinline__ void chk_finish(const Frame& F) {
    if (F.bx == 0 && F.tid == 0 && __hip_atomic_load(WSP(unsigned, WS_CHK_CNT), __ATOMIC_RELAXED, __HIP_MEMORY_SCOPE_AGENT) != 0u) { for (int k = 0; k < 64; ++k) F.out[k] = __builtin_nanf(""); }
}
#endif
#ifndef DIAG_ONLY
#define DIAG_ONLY -1
#endif
#define DIAG_EN(k) (DIAG_ONLY < 0 || DIAG_ONLY == (k))
#ifndef PROBE_CHECK
#define PROBE_CHECK 0
#endif
#ifndef PROBE_VAR
#define PROBE_VAR 0
#endif
#ifndef PROBE_REP
#define PROBE_REP -1
#endif
struct Args { const float* in[14]; float* out; unsigned char* ws; int ph_lo, ph_hi; };
constexpr int N_PHASES = 2 + 5 * DEPTH;

template <class Epi, class Sched> __device__ __forceinline__ void run_gemm(const Frame& F, const pg8::Gemm& g, const Sched& S, const Epi& E) {
#if IMPL_GEMM
    pg8::gemm_phase<Epi, Sched, PG8_ALIGN, PG8_SP2>(F.lds, g, S, E, F.tid);
#else
    pg8::gemm_phase_naive<Epi, Sched>(g, S, E, F.tid);
#endif
}

#define PH_IN(k) (lo <= (k) && (k) < hi)
#define PH_SEAM(k) do { if (PH_IN(k) && PH_IN((k) + 1)) xcd_barrier(bar); } while (0)
#define PH_ENTER() do { int _t = threadIdx.x; asm volatile("" : "+v"(_t)); F.tid = _t; F.lane = _t & 63; } while (0)

template <int L> __device__ __forceinline__ void layer_phases(Frame& F, const int lo, const int hi, const XcdBarrier& bar) {
    constexpr int P = 2 + 5 * L;
    float* rsq = WSP(float, WS_RSQ) + (size_t)L * MTOK * 2;
    if (PH_IN(P + 0) && DIAG_EN(2)) {
        PH_ENTER();
        pg8::Gemm g{WSP(bf16_t, WS_H), WSP(bf16_t, WS_WIN) + (size_t)L * NINP * DM, MTOK, NINP, DM};
        pg8::StaticOrder S; S.init(MTOK, NINP, F.G, F.bx);
        EpiIn E{WSP(bf16_t, WS_U), WSP(bf16_t, WS_MIX), WSP(bf16_t, WS_CQ), WSP(bf16_t, WS_CKV), WSP(bf16_t, WS_KR), rsq, WSP(float, WS_RCOS), WSP(float, WS_RSIN)};
        run_gemm(F, g, S, E);
        if (PROBE_REP == 2 && L == 0) { xcd_barrier(bar); EpiIn E2 = E; E2.rsq = WSP(float, WS_R); run_gemm(F, g, S, E2); }
        if (PROBE_REP == 12 && L == 0) { xcd_barrier(bar); EpiNone E2; run_gemm(F, g, S, E2); }
    }
    PH_SEAM(P + 0);
    if (PH_IN(P + 1) && DIAG_EN(3)) {
        PH_ENTER();
        { pg8::Gemm g{WSP(bf16_t, WS_CQ), WSP(bf16_t, WS_WQ) + (size_t)L * NQ * QLR, MTOK, NQ, QLR};
          pg8::SplitOrder S; S.init(F.G, F.bx, NQ / 256, 0);
          EpiQ E{WSP(bf16_t, WS_Q), rsq, WSP(float, WS_RCOS), WSP(float, WS_RSIN)};
          run_gemm(F, g, S, E); }
        { pg8::Gemm g{WSP(bf16_t, WS_CKV), WSP(bf16_t, WS_WKV) + (size_t)L * NKV * KVLR, MTOK, NKV, KVLR};
          pg8::SplitOrder S; S.init(F.G, F.bx, NKV / 256, 1);
          EpiKV E{WSP(bf16_t, WS_KV), rsq};
          run_gemm(F, g, S, E); }
        if (PROBE_REP == 3 && L == 0) { xcd_barrier(bar);
          { pg8::Gemm g{WSP(bf16_t, WS_CQ), WSP(bf16_t, WS_WQ) + (size_t)L * NQ * QLR, MTOK, NQ, QLR}; pg8::SplitOrder S; S.init(F.G, F.bx, NQ / 256, 0); EpiQ E{WSP(bf16_t, WS_Q), rsq, WSP(float, WS_RCOS), WSP(float, WS_RSIN)}; run_gemm(F, g, S, E); }
          { pg8::Gemm g{WSP(bf16_t, WS_CKV), WSP(bf16_t, WS_WKV) + (size_t)L * NKV * KVLR, MTOK, NKV, KVLR}; pg8::SplitOrder S; S.init(F.G, F.bx, NKV / 256, 1); EpiKV E{WSP(bf16_t, WS_KV), rsq}; run_gemm(F, g, S, E); } }
#if IMPL_FFT & 1
        fft1_fast(F);
#else
        fft1_naive(F);
#endif
        if (PROBE_REP == 7 && L == 0) { xcd_barrier(bar); fft1_fast(F); }
    }
    PH_SEAM(P + 1);
#if PROBE_CHECK
    if (L == PROBE_CHECK - 1 && PH_IN(P + 2)) { PH_ENTER(); chk_proj(F, L); __syncthreads(); }
#endif
    if (PH_IN(P + 2) && DIAG_EN(4)) {
        PH_ENTER();
#if IMPL_ATTN
        attn_fast(F);
        if (PROBE_REP == 4 && L == 0) { __syncthreads(); F.mix_off = WS_R; attn_fast<PROBE_VAR>(F); F.mix_off = WS_MIX; }
#else
        attn_naive(F);
#endif
        __syncthreads();
#if IMPL_FFT & 2
        fft2_fast(F, L);
        if (PROBE_REP == 8 && L == 0) { __syncthreads(); F.mix_off = WS_R; fft2_fast(F, L); F.mix_off = WS_MIX; }
#else
        fft2_naive(F, L);
#endif
    }
    PH_SEAM(P + 2);
#if PROBE_CHECK
    if (L == PROBE_CHECK - 1 && PH_IN(P + 3)) { PH_ENTER(); chk_attn(F); __syncthreads(); }
#endif
    if (PH_IN(P + 3) && DIAG_EN(5)) {
        PH_ENTER();
        pg8::Gemm g{WSP(bf16_t, WS_MIX), WSP(bf16_t, WS_WOUT) + (size_t)L * DM * DM, MTOK, DM, DM};
        pg8::StaticOrder S; S.init(MTOK, DM, F.G, F.bx);
        EpiOut E{WSP(bf16_t, WS_H), WSP(float, WS_MOD) + (size_t)L * NB * (3 * DM) + 2 * DM};
        run_gemm(F, g, S, E);
        if (PROBE_REP == 5 && L == 0) { xcd_barrier(bar); run_gemm(F, g, S, E); }
        if (PROBE_REP == 15 && L == 0) { xcd_barrier(bar); EpiNone E2; run_gemm(F, g, S, E2); }
    }
    PH_SEAM(P + 3);
    if (PH_IN(P + 4) && DIAG_EN(6)) {
        PH_ENTER();
        if (L + 1 < DEPTH) p_ln_post<true>(F, L); else p_ln_post<false>(F, L);
        if (PROBE_REP == 6 && L + 1 == DEPTH) { xcd_barrier(bar); p_ln_post<false>(F, L); }
    }
    PH_SEAM(P + 4);
}

__global__ void __launch_bounds__(NTHREADS, 2) fwd_kernel(Args args) {
    extern __shared__ __attribute__((aligned(16))) unsigned char lds[];
    Frame F;
    F.in[0] = args.in[0]; F.in[1] = args.in[1]; F.in[2] = args.in[2]; F.in[3] = args.in[3]; F.in[4] = args.in[4]; F.in[5] = args.in[5]; F.in[6] = args.in[6]; F.in[7] = args.in[7]; F.in[8] = args.in[8]; F.in[9] = args.in[9]; F.in[10] = args.in[10]; F.in[11] = args.in[11]; F.in[12] = args.in[12]; F.in[13] = args.in[13];
    F.out = args.out; F.ws = args.ws; F.lds = (LAS unsigned char*)lds; F.ldsg = (char*)lds;
    F.tid = threadIdx.x; F.lane = F.tid & 63; F.wave = __builtin_amdgcn_readfirstlane(F.tid >> 6); F.G = gridDim.x; F.bx = blockIdx.x;
    F.vcu = (F.G % 8 == 0) ? (F.bx % 8) * (F.G / 8) + F.bx / 8 : F.bx; F.mix_off = WS_MIX;
    volatile LAS unsigned* MISC = (volatile LAS unsigned*)(F.lds + MISC_OFF);
    if (F.tid < 64) MISC[F.tid] = 0u;
    __syncthreads();
    const int lo = args.ph_lo, hi = args.ph_hi;
    XcdBarrier bar; bar.bar = WSP(unsigned, WS_CTL); bar.x = 0; bar.st = MISC;
    if (hi - lo > 1) bar = xcd_barrier_post(WSP(unsigned, WS_CTL), MISC);
    if (PH_IN(0) && DIAG_EN(0)) { PH_ENTER(); p0_weights(F); p0_mod(F); p0_tables(F); if (PROBE_REP == 0) { xcd_barrier(bar); p0_weights(F); p0_mod(F); p0_tables(F); } }
    PH_SEAM(0);
    if (PH_IN(1) && DIAG_EN(1)) { PH_ENTER(); p_ln_first(F); if (PROBE_REP == 1) { xcd_barrier(bar); p_ln_first(F); } }
    PH_SEAM(1);
    layer_phases<0>(F, lo, hi, bar);
    layer_phases<1>(F, lo, hi, bar);
#if PROBE_CHECK
    xcd_barrier(bar); chk_finish(F);
#endif
}

extern "C" void kernel_launch(void* const* d_in, const int* in_sizes, int n_in, void* d_out, int out_size, void* d_ws, size_t ws_size, hipStream_t stream) {
    static int grid = 0;
    if (grid == 0) {
        if (n_in != 14 || in_sizes[0] != MTOK * DM || out_size != MTOK * DM || ws_size < WS_END) {
            fprintf(stderr, "kernel_launch: shape mismatch (n_in %d, in0 %d, out %d, ws %zu, need ws >= %zu); nothing launched\n", n_in, n_in > 0 ? in_sizes[0] : -1, out_size, ws_size, (size_t)WS_END); grid = -1; return; }
        int dev = 0, cus = 0, per_cu = 0;
        if (hipGetDevice(&dev) != hipSuccess || hipDeviceGetAttribute(&cus, hipDeviceAttributeMultiprocessorCount, dev) != hipSuccess) { grid = -1; return; }
        if (hipFuncSetAttribute((const void*)fwd_kernel, hipFuncAttributeMaxDynamicSharedMemorySize, LDS_BYTES) != hipSuccess) { fprintf(stderr, "kernel_launch: hipFuncSetAttribute failed\n"); grid = -1; return; }
        if (hipOccupancyMaxActiveBlocksPerMultiprocessor(&per_cu, (const void*)fwd_kernel, NTHREADS, LDS_BYTES) != hipSuccess || per_cu < 1) { fprintf(stderr, "kernel_launch: occupancy query failed (%d)\n", per_cu); (void)hipGetLastError(); per_cu = 1; }
        if (per_cu > 1) per_cu = 1;
        grid = cus * per_cu;
    }
    if (grid < 0) return;
    if (hipMemsetAsync((char*)d_ws + WS_CTL, 0, WS_RSQ - WS_CTL, stream) != hipSuccess) { fprintf(stderr, "kernel_launch: hipMemsetAsync failed\n"); return; }
    Args a{};
    for (int i = 0; i < 14; ++i) a.in[i] = (const float*)d_in[i];
    a.out = (float*)d_out; a.ws = (unsigned char*)d_ws;
#if N_LAUNCH_MODE
    a.ph_lo = 0; a.ph_hi = N_PHASES;
    hipLaunchKernelGGL(fwd_kernel, dim3(grid), dim3(NTHREADS), LDS_BYTES, stream, a);
#else
    for (int ph = 0; ph < N_PHASES; ++ph) { a.ph_lo = ph; a.ph_hi = ph + 1; hipLaunchKernelGGL(fwd_kernel, dim3(grid), dim3(NTHREADS), LDS_BYTES, stream, a); }
#endif
    const hipError_t le = hipPeekAtLastError();
    if (le != hipSuccess) fprintf(stderr, "kernel_launch: launch failed: %s (grid %d)\n", hipGetErrorName(le), grid);
}
```

```cpp
#define IMPL_GEMM 1
#define IMPL_ATTN 1
#define IMPL_FFT 3
#define N_LAUNCH_MODE 1
#include <hip/hip_runtime.h>
#include <cstdio>
#include <cstdint>

#ifndef PROBE_CHECK
#define PROBE_CHECK 0
#endif
#ifndef N_LAUNCH_MODE
#define N_LAUNCH_MODE 1
#endif
#ifndef IMPL_GEMM
#define IMPL_GEMM 1
#endif
#ifndef IMPL_ATTN
#define IMPL_ATTN 1
#endif
#ifndef IMPL_FFT
#define IMPL_FFT 3
#endif

#define LAS __attribute__((address_space(3)))
typedef unsigned short bf16_t;
typedef short bf16x8 __attribute__((ext_vector_type(8)));
typedef short s16x4 __attribute__((ext_vector_type(4)));
typedef float f32x4 __attribute__((ext_vector_type(4)));
typedef float f32x2 __attribute__((ext_vector_type(2)));
typedef float f32x16 __attribute__((ext_vector_type(16)));
typedef unsigned u32x4 __attribute__((ext_vector_type(4)));
typedef unsigned u32x2 __attribute__((ext_vector_type(2)));

constexpr int NB = 4, SEQ = 4096, DM = 2048, MTOK = NB * SEQ, DEPTH = 2;
constexpr int DF = 1024, NG = 8, GD = 128, NH = 8, DV = 128, DNOPE = 128, DROPE = 64, DQK = 192, QLR = 512, KVLR = 256;
constexpr int NIN = 3904, NINP = 4096;
constexpr int NQ = NH * DQK  , NKV = NH * (DNOPE + DV)  ;
constexpr float NORM_EPS = 1e-6f;
constexpr float DN_ALPHA = 1.4142135623730951f;
constexpr float ATT_SCALE = 0.07216878364870322f;

__device__ __forceinline__ float bf2f(bf16_t b) { return __uint_as_float(((unsigned)b) << 16); }
__device__ __forceinline__ bf16_t f2bf(float f) { unsigned u = __float_as_uint(f); u += 0x7FFFu + ((u >> 16) & 1u); return (bf16_t)(u >> 16); }
typedef __bf16 bf16v2_t __attribute__((ext_vector_type(2)));
__device__ __forceinline__ unsigned cvt_pk_bf16(float lo, float hi) { const f32x2 v = {lo, hi}; return __builtin_bit_cast(unsigned, __builtin_convertvector(v, bf16v2_t)); }
__device__ __forceinline__ float silu_f(float z) { return z * __builtin_amdgcn_rcpf(1.0f + __builtin_amdgcn_exp2f(-1.4426950408889634f * z)); }
__device__ __forceinline__ float wave_sum(float v) { for (int o = 32; o > 0; o >>= 1) v += __shfl_xor(v, o); return v; }
__device__ __forceinline__ float wave_max(float v) { for (int o = 32; o > 0; o >>= 1) v = fmaxf(v, __shfl_xor(v, o)); return v; }

constexpr size_t al256(size_t x) { return (x + 255) / 256 * 256; }
constexpr size_t WS_CTL  = 0;
constexpr size_t CTL_BYTES = 16384;
constexpr size_t WS_MOD  = WS_CTL + CTL_BYTES;
constexpr size_t WS_RSQ  = WS_MOD + al256((size_t)DEPTH * NB * 3 * DM * 4);
constexpr size_t WS_RCOS = WS_RSQ + al256((size_t)DEPTH * MTOK * 2 * 4);
constexpr size_t WS_RSIN = WS_RCOS + (size_t)MTOK * 32 * 4;
constexpr size_t WS_D1   = WS_RSIN + (size_t)MTOK * 32 * 4;
constexpr size_t WS_D2   = WS_D1 + 128 * 64 * 2;
constexpr size_t WS_WCAT = WS_D2 + 128 * 128 * 2;
constexpr size_t WS_WIN  = WS_WCAT + (size_t)DEPTH * NG * 128 * 256 * 2;
constexpr size_t WS_WOUT = WS_WIN + (size_t)DEPTH * NINP * DM * 2;
constexpr size_t WS_WQ   = WS_WOUT + (size_t)DEPTH * DM * DM * 2;
constexpr size_t WS_WKV  = WS_WQ + (size_t)DEPTH * NQ * QLR * 2;
constexpr size_t WS_H    = WS_WKV + (size_t)DEPTH * NKV * KVLR * 2;
constexpr size_t WS_U    = WS_H + (size_t)MTOK * DM * 2;
constexpr size_t WS_MIX  = WS_U + (size_t)MTOK * DF * 2;
constexpr size_t WS_CQ   = WS_MIX + (size_t)MTOK * DM * 2;
constexpr size_t WS_CKV  = WS_CQ + (size_t)MTOK * QLR * 2;
constexpr size_t WS_KR   = WS_CKV + (size_t)MTOK * KVLR * 2;
constexpr size_t WS_Q    = WS_KR + (size_t)MTOK * 64 * 2;
constexpr size_t WS_KV   = WS_Q + (size_t)MTOK * NQ * 2;
constexpr size_t WS_R    = WS_KV + (size_t)MTOK * NKV * 2;
constexpr size_t WS_END  = WS_R + (size_t)MTOK * DM * 4;
static_assert(WS_END <= (size_t)4 * MTOK * DM * 4, "workspace map exceeds 4 x largest tensor");

constexpr int RING_BYTES = 155648, MISC_OFF = RING_BYTES, LDS_BYTES = RING_BYTES + 256;
constexpr int NTHREADS = 512;

namespace pg8 {
#define PG8_LAS __attribute__((address_space(3)))
constexpr int BM = 256, BK = 64, HALF = 128, HTB = HALF * BK * 2  , STAGE_BYTES = 8 * HTB, NXCD = 8, WGM = 8;
static_assert(STAGE_BYTES <= RING_BYTES, "GEMM stage ring must fit the LDS phase scratch");

__host__ __device__ __forceinline__ int lds_byte(int r, int c) { const int st = (r >> 4) * 2 + (c >> 5), rr = r & 15, cc = c & 31, ob = rr * 64 + cc * 2; return st * 1024 + (ob ^ (((ob >> 9) & 1) << 5)); }
__host__ __device__ __forceinline__ void stage_rc(int b, int& R, int& C) { const int st = b / 1024, sb = b % 1024, swz = sb ^ (((sb >> 9) & 1) << 5); R = (st >> 1) * 16 + swz / 64; C = (st & 1) * 32 + (swz % 64) / 2; }
__host__ __device__ __forceinline__ int perm32(int rho) { const int n = rho >> 4, i = rho & 15; return 8 * (i >> 2) + 4 * n + (i & 3); }

struct Unit { int pm, pn; };
struct Gemm { const bf16_t* A; const bf16_t* Bt; int M, N, K; };

struct StaticOrder {
    int nM, nN, nwg, G, c;
    __host__ __device__ void init(int M, int N, int G_, int c_) { nM = M / BM; nN = N / BM; nwg = nM * nN; G = G_; c = c_; }
    __host__ __device__ bool next(int i, Unit& u) const {
        const long L = (long)i * G + c; if (L >= nwg) return false;
        int wgid = (int)L; { const int q = nwg / NXCD, r = nwg % NXCD, xcd = wgid % NXCD, off = wgid / NXCD; wgid = (xcd < r ? xcd * (q + 1) : r * (q + 1) + (xcd - r) * q) + off; }
        const int nig = WGM * nN, gid = wgid / nig, fm = gid * WGM, gsz = (nM - fm) < WGM ? (nM - fm) : WGM;
        u.pm = fm + ((wgid % nig) % gsz); u.pn = (wgid % nig) / gsz; return true;
    }
    __device__ __forceinline__ void a_ready(const Unit&) const {}
    __device__ __forceinline__ void done(const Unit&) const {}
};
struct SplitOrder {
    int G, c, nN, kind;
    __device__ void init(int G_, int c_, int nN_, int kind_) { G = G_; c = c_; nN = nN_; kind = kind_; }
    __device__ bool next(int i, Unit& u) const {
        if (G != 256) { const int L = i * G + c; if (L >= 64 * nN) return false; u.pm = L / nN; u.pn = L % nN; return true; }
        const int x = c & 7, v = c >> 3; int li;
        if (kind == 0) { if (v < 16) { if (i >= 2) return false; li = 2 * v + i; } else { if (i >= 1) return false; li = 32 + (v - 16); } }
        else           { if (v < 16) { if (i >= 1) return false; li = v; } else { if (i >= 3) return false; li = 16 + 3 * (v - 16) + i; } }
        u.pm = 8 * x + li / nN; u.pn = li % nN; return true;
    }
    __device__ __forceinline__ void a_ready(const Unit&) const {}
    __device__ __forceinline__ void done(const Unit&) const {}
};
template <class Epi, class Sched, bool ALIGN_EPI = false, bool SP2 = false>
__device__ __forceinline__ void gemm_phase(PG8_LAS unsigned char* lds, const Gemm g, const Sched& S, const Epi& E, const int tid) {
    const int wid = __builtin_amdgcn_readfirstlane(tid >> 6), lane = tid & 63, wr = wid >> 2, wc = wid & 3, fr = lane & 15, fq = lane >> 4;
    const int K = g.K, nt = K / BK;
    unsigned voffA[2], voffB[2];
#pragma unroll
    for (int i = 0; i < 2; ++i) { int R, C; stage_rc(tid * 16 + i * 8192, R, C); const int Rb = Epi::PERM ? ((R & ~31) + perm32(R & 31)) : R;
        voffA[i] = (unsigned)(R * K + C) * 2u; voffB[i] = (unsigned)(Rb * K + C) * 2u; }
    const size_t kstep = (size_t)(BK * 2);
    const size_t hstep = (size_t)HALF * K * 2;
    const size_t tstep = 2 * hstep;
    const unsigned ldsw = (unsigned)wid * 1024u;
    const int aoff = lds_byte(wr * 64 + fr, fq * 8), boff = lds_byte(wc * 32 + fr, fq * 8);
#define PG8_SA(b, h) (((b) * 2 + (h)) * HTB)
#define PG8_SB(b, h) ((4 + (b) * 2 + (h)) * HTB)
#define PG8_STAGE(bufoff, gbase, voff) do { _Pragma("unroll") for (int _i = 0; _i < 2; ++_i) \
        __builtin_amdgcn_global_load_lds((const unsigned*)((const char*)(gbase) + (voff)[_i]), (PG8_LAS unsigned*)(lds + (bufoff) + ldsw + _i * 8192), 16, 0, 0); } while (0)
#define PG8_LDA(dst, b, h) do { _Pragma("unroll") for (int m = 0; m < 4; ++m) _Pragma("unroll") for (int k = 0; k < 2; ++k) dst[m][k] = *(const PG8_LAS bf16x8*)(lds + PG8_SA(b, h) + aoff + m * 2048 + k * 1024); } while (0)
#define PG8_LDB(dst, b, h) do { _Pragma("unroll") for (int n = 0; n < 2; ++n) _Pragma("unroll") for (int k = 0; k < 2; ++k) dst[n][k] = *(const PG8_LAS bf16x8*)(lds + PG8_SB(b, h) + boff + n * 2048 + k * 1024); } while (0)
#define PG8_MMA(ai, bj, At, Bt) do { __builtin_amdgcn_s_setprio(1); _Pragma("unroll") for (int m = 0; m < 4; ++m) _Pragma("unroll") for (int n = 0; n < 2; ++n) _Pragma("unroll") for (int k = 0; k < 2; ++k) \
        acc[ai][bj][m][n] = __builtin_amdgcn_mfma_f32_16x16x32_bf16(Bt[n][k], At[m][k], acc[ai][bj][m][n], 0, 0, 0); __builtin_amdgcn_s_setprio(0); } while (0)
#define PG8_WAIT_V(n) asm volatile("s_waitcnt vmcnt(" #n ")" ::: "memory")
#define PG8_WAIT_L(n) asm volatile("s_waitcnt lgkmcnt(" #n ")" ::: "memory")
#define PG8_BAR __builtin_amdgcn_s_barrier()
#define PG8_SCHED __builtin_amdgcn_sched_barrier(0)
    Unit cur, nxt; int ui = 0;
    if (!S.next(0, cur)) return;
    f32x4 acc[2][2][4][2];
#pragma unroll
    for (int a = 0; a < 2; ++a)
#pragma unroll
        for (int b = 0; b < 2; ++b)
#pragma unroll
            for (int m = 0; m < 4; ++m)
#pragma unroll
                for (int n = 0; n < 2; ++n) acc[a][b][m][n] = (f32x4){0.f, 0.f, 0.f, 0.f};
    bf16x8 At[4][2], B0[2][2], B1[2][2];
    const char* cA = (const char*)g.A + (size_t)cur.pm * tstep; const char* cB = (const char*)g.Bt + (size_t)cur.pn * tstep;
    S.a_ready(cur);
    if constexpr (SP2) {
        PG8_STAGE(PG8_SB(0, 0), cB, voffB); PG8_STAGE(PG8_SB(0, 1), cB + hstep, voffB); PG8_STAGE(PG8_SA(0, 0), cA, voffA); PG8_STAGE(PG8_SA(0, 1), cA + hstep, voffA);
        if (wr == 1) PG8_BAR;
        PG8_WAIT_V(2); PG8_BAR;
        PG8_STAGE(PG8_SB(1, 0), cB + kstep, voffB); PG8_STAGE(PG8_SA(1, 0), cA + kstep, voffA); PG8_STAGE(PG8_SB(1, 1), cB + hstep + kstep, voffB);
        PG8_WAIT_V(6); PG8_BAR;
    } else {
        PG8_STAGE(PG8_SB(0, 0), cB, voffB); PG8_STAGE(PG8_SA(0, 0), cA, voffA); PG8_STAGE(PG8_SB(0, 1), cB + hstep, voffB); PG8_STAGE(PG8_SA(0, 1), cA + hstep, voffA);
        if (wr == 1) PG8_BAR;
        PG8_WAIT_V(4); PG8_BAR;
        PG8_STAGE(PG8_SB(1, 0), cB + kstep, voffB); PG8_STAGE(PG8_SA(1, 0), cA + kstep, voffA); PG8_STAGE(PG8_SB(1, 1), cB + hstep + kstep, voffB);
        PG8_WAIT_V(6); PG8_BAR;
    }
    for (;;) {
        const bool has_next = S.next(ui + 1, nxt);
        const char* nA = has_next ? (const char*)g.A + (size_t)nxt.pm * tstep : cA; const char* nB = has_next ? (const char*)g.Bt + (size_t)nxt.pn * tstep : cB;
        for (int t = 0; t < nt; t += 2) {
            const bool last = (t == nt - 2);
            const char* a1 = cA + (size_t)(t + 1) * kstep;
            const char* a2 = last ? nA : cA + (size_t)(t + 2) * kstep; const char* b2 = last ? nB : cB + (size_t)(t + 2) * kstep;
            const char* a3 = a2 + kstep; const char* b3 = b2 + kstep;
            if (last && has_next) S.a_ready(nxt);
            if constexpr (SP2) {
            PG8_LDB(B0, 0, 0); PG8_LDB(B1, 0, 1); PG8_SCHED; PG8_LDA(At, 0, 0); PG8_STAGE(PG8_SA(1, 1), a1 + hstep, voffA);
            PG8_WAIT_V(8); PG8_WAIT_L(0); PG8_BAR; PG8_MMA(0, 0, At, B0); PG8_MMA(0, 1, At, B1); PG8_BAR; PG8_SCHED;
            PG8_LDA(At, 0, 1); PG8_STAGE(PG8_SB(0, 0), b2, voffB); PG8_STAGE(PG8_SB(0, 1), b2 + hstep, voffB); PG8_STAGE(PG8_SA(0, 0), a2, voffA);
            PG8_WAIT_V(8); PG8_WAIT_L(0); PG8_BAR; PG8_MMA(1, 0, At, B0); PG8_MMA(1, 1, At, B1); PG8_BAR; PG8_SCHED;
            PG8_LDB(B0, 1, 0); PG8_LDB(B1, 1, 1); PG8_SCHED; PG8_LDA(At, 1, 0); PG8_STAGE(PG8_SA(0, 1), a2 + hstep, voffA);
            PG8_WAIT_V(8); PG8_WAIT_L(0); PG8_BAR; PG8_MMA(0, 0, At, B0); PG8_MMA(0, 1, At, B1); PG8_BAR; PG8_SCHED;
            PG8_LDA(At, 1, 1); PG8_STAGE(PG8_SB(1, 0), b3, voffB); PG8_STAGE(PG8_SB(1, 1), b3 + hstep, voffB); PG8_STAGE(PG8_SA(1, 0), a3, voffA);
            PG8_WAIT_V(8); PG8_WAIT_L(0); PG8_BAR; PG8_MMA(1, 0, At, B0); PG8_MMA(1, 1, At, B1); PG8_BAR; PG8_SCHED;
            } else {
            PG8_LDB(B0, 0, 0); PG8_SCHED; PG8_LDA(At, 0, 0); PG8_STAGE(PG8_SA(1, 1), a1 + hstep, voffA);
            PG8_WAIT_L(8); PG8_BAR; PG8_WAIT_L(0); PG8_MMA(0, 0, At, B0); PG8_BAR; PG8_SCHED;
            PG8_LDB(B1, 0, 1); PG8_STAGE(PG8_SB(0, 0), b2, voffB);
            PG8_BAR; PG8_WAIT_L(0); PG8_MMA(0, 1, At, B1); PG8_BAR;
            PG8_LDA(At, 0, 1); PG8_STAGE(PG8_SA(0, 0), a2, voffA);
            PG8_BAR; PG8_WAIT_L(0); PG8_MMA(1, 0, At, B0); PG8_BAR; PG8_SCHED;
            PG8_STAGE(PG8_SB(0, 1), b2 + hstep, voffB);
            PG8_WAIT_V(6); PG8_BAR; PG8_MMA(1, 1, At, B1); PG8_BAR;
            PG8_LDB(B0, 1, 0); PG8_SCHED; PG8_LDA(At, 1, 0); PG8_STAGE(PG8_SA(0, 1), a2 + hstep, voffA);
            PG8_WAIT_L(8); PG8_BAR; PG8_WAIT_L(0); PG8_MMA(0, 0, At, B0); PG8_BAR; PG8_SCHED;
            PG8_LDB(B1, 1, 1); PG8_STAGE(PG8_SB(1, 0), b3, voffB);
            PG8_BAR; PG8_WAIT_L(0); PG8_MMA(0, 1, At, B1); PG8_BAR;
            PG8_LDA(At, 1, 1); PG8_STAGE(PG8_SA(1, 0), a3, voffA);
            PG8_BAR; PG8_WAIT_L(0); PG8_MMA(1, 0, At, B0); PG8_BAR; PG8_SCHED;
            PG8_STAGE(PG8_SB(1, 1), b3 + hstep, voffB);
            PG8_WAIT_V(6); PG8_BAR; PG8_MMA(1, 1, At, B1); PG8_BAR;
            }
        }
        if constexpr (ALIGN_EPI) { if (wr == 0) PG8_BAR; }
        if constexpr (!Epi::AFTER_DRAIN) { E(acc, cur, wr, wc, fr, fq); S.done(cur); }
        if (!has_next) break;
#pragma unroll
        for (int a = 0; a < 2; ++a)
#pragma unroll
            for (int b = 0; b < 2; ++b)
#pragma unroll
                for (int m = 0; m < 4; ++m)
#pragma unroll
                    for (int n = 0; n < 2; ++n) acc[a][b][m][n] = (f32x4){0.f, 0.f, 0.f, 0.f};
        cur = nxt; cA = nA; cB = nB; ++ui;
        if constexpr (ALIGN_EPI) { if (wr == 1) PG8_BAR; }
    }
    PG8_WAIT_V(0);
    if constexpr (!ALIGN_EPI) { if (wr == 0) PG8_BAR; }
    PG8_BAR;
    if constexpr (Epi::AFTER_DRAIN) { E.fused(acc, cur, wr, wc, fr, fq, lds, wid, lane); S.done(cur); }
#undef PG8_SA
#undef PG8_SB
#undef PG8_STAGE
#undef PG8_LDA
#undef PG8_LDB
#undef PG8_MMA
#undef PG8_WAIT_V
#undef PG8_WAIT_L
#undef PG8_BAR
#undef PG8_SCHED
}

template <class Epi, class Sched>
__device__ __forceinline__ void gemm_phase_naive(const Gemm g, const Sched& S, const Epi& E, const int tid) {
    const int wid = __builtin_amdgcn_readfirstlane(tid >> 6), lane = tid & 63, wr = wid >> 2, wc = wid & 3, fr = lane & 15, fq = lane >> 4;
    const int K = g.K;
    Unit cur;
    for (int ui = 0; S.next(ui, cur); ++ui) {
        f32x4 acc[2][2][4][2];
#pragma unroll
        for (int ai = 0; ai < 2; ++ai)
#pragma unroll
            for (int m = 0; m < 4; ++m) {
                const bf16_t* arow = g.A + (size_t)(cur.pm * BM + ai * HALF + wr * 64 + m * 16 + fr) * K;
#pragma unroll
                for (int bj = 0; bj < 2; ++bj)
#pragma unroll
                    for (int n = 0; n < 2; ++n) {
                        const int col = cur.pn * BM + bj * HALF + wc * 32 + (Epi::PERM ? (8 * fq + 4 * n) : (16 * n + 4 * fq));
                        const bf16_t* brow = g.Bt + (size_t)col * K;
                        float s0 = 0.f, s1 = 0.f, s2 = 0.f, s3 = 0.f;
#pragma unroll 1
                        for (int k = 0; k < K; k += 8) {
                            const bf16x8 av = *(const bf16x8*)(arow + k);
                            const bf16x8 b0 = *(const bf16x8*)(brow + k), b1 = *(const bf16x8*)(brow + K + k), b2 = *(const bf16x8*)(brow + 2 * K + k), b3 = *(const bf16x8*)(brow + 3 * K + k);
#pragma unroll
                            for (int e = 0; e < 8; ++e) { const float a = bf2f((bf16_t)av[e]);
                                s0 += a * bf2f((bf16_t)b0[e]); s1 += a * bf2f((bf16_t)b1[e]); s2 += a * bf2f((bf16_t)b2[e]); s3 += a * bf2f((bf16_t)b3[e]); }
                        }
                        acc[ai][bj][m][n] = (f32x4){s0, s1, s2, s3};
                    }
            }
        E(acc, cur, wr, wc, fr, fq);
    }
}
}
#ifndef PG8_SP2
#define PG8_SP2 true
#endif
#ifndef PG8_ALIGN
#define PG8_ALIGN true
#endif
typedef f32x4 AccT[2][2][4][2];

#ifndef EPI_NT
#define EPI_NT 0
#endif
__device__ __forceinline__ void store8_bf16(bf16_t* p, f32x4 v0, f32x4 v1) {
    u32x4 w; w.x = cvt_pk_bf16(v0[0], v0[1]); w.y = cvt_pk_bf16(v0[2], v0[3]); w.z = cvt_pk_bf16(v1[0], v1[1]); w.w = cvt_pk_bf16(v1[2], v1[3]); *(u32x4*)p = w;
}
__device__ __forceinline__ void store4_bf16(bf16_t* p, f32x4 v) { u32x2 w; w.x = cvt_pk_bf16(v[0], v[1]); w.y = cvt_pk_bf16(v[2], v[3]); *(u32x2*)p = w; }
__device__ __forceinline__ void estore8_bf16(bf16_t* p, f32x4 v0, f32x4 v1) {
    u32x4 w; w.x = cvt_pk_bf16(v0[0], v0[1]); w.y = cvt_pk_bf16(v0[2], v0[3]); w.z = cvt_pk_bf16(v1[0], v1[1]); w.w = cvt_pk_bf16(v1[2], v1[3]);
    if (EPI_NT) __builtin_nontemporal_store(w, (u32x4*)p); else *(u32x4*)p = w;
}
__device__ __forceinline__ void estore4_bf16(bf16_t* p, f32x4 v) { u32x2 w; w.x = cvt_pk_bf16(v[0], v[1]); w.y = cvt_pk_bf16(v[2], v[3]); if (EPI_NT) __builtin_nontemporal_store(w, (u32x2*)p); else *(u32x2*)p = w; }
__device__ __forceinline__ f32x4 silu4(f32x4 v) { return (f32x4){silu_f(v[0]), silu_f(v[1]), silu_f(v[2]), silu_f(v[3])}; }
__device__ __forceinline__ float sq4(f32x4 v) { return (v[0] * v[0] + v[1] * v[1]) + (v[2] * v[2] + v[3] * v[3]); }

struct EpiIn {
    static constexpr bool PERM = true, AFTER_DRAIN = false;
    bf16_t* U; bf16_t* MIX; bf16_t* CQ; bf16_t* CKV; bf16_t* KR; float* rsq; const float* rcos; const float* rsin;
    template <int ACT> __device__ __forceinline__ void plain(const AccT& acc, bf16_t* base, int ldc, int row0, int col0) const {
#pragma unroll
        for (int ai = 0; ai < 2; ++ai)
#pragma unroll
            for (int m = 0; m < 4; ++m) { bf16_t* rowp = base + (size_t)(row0 + ai * 128 + m * 16) * ldc + col0;
#pragma unroll
                for (int bj = 0; bj < 2; ++bj) { f32x4 v0 = acc[ai][bj][m][0], v1 = acc[ai][bj][m][1]; if (ACT) { v0 = silu4(v0); v1 = silu4(v1); } estore8_bf16(rowp + bj * 128, v0, v1); } }
    }
    __device__ __forceinline__ void sumsq(const AccT& acc, int row0, int which, int fq) const {
#pragma unroll
        for (int ai = 0; ai < 2; ++ai)
#pragma unroll
            for (int m = 0; m < 4; ++m) { float s = (sq4(acc[ai][0][m][0]) + sq4(acc[ai][0][m][1])) + (sq4(acc[ai][1][m][0]) + sq4(acc[ai][1][m][1]));
                s += __shfl_xor(s, 16); s += __shfl_xor(s, 32);
                if (fq == 0) atomicAdd(rsq + (size_t)(row0 + ai * 128 + m * 16) * 2 + which, s); }
    }
    __device__ __forceinline__ void operator()(const AccT& acc, const pg8::Unit& u, int wr, int wc, int fr, int fq) const {
        const int row0 = u.pm * 256 + wr * 64 + fr, pn = u.pn, cw = wc * 32 + 8 * fq;
        if (pn < 4) plain<0>(acc, U, DF, row0, pn * 256 + cw);
        else if (pn < 8) plain<1>(acc, MIX, DM, row0, (pn - 4) * 256 + cw);
        else if (pn < 10) { plain<0>(acc, CQ, QLR, row0, (pn - 8) * 256 + cw); sumsq(acc, row0, 0, fq); }
        else if (pn == 10) { plain<0>(acc, CKV, KVLR, row0, cw); sumsq(acc, row0, 1, fq); }
        else if (pn == 11) {
            if (wc < 2) { const int i0 = 16 * wc + 4 * fq;
#pragma unroll
                for (int ai = 0; ai < 2; ++ai)
#pragma unroll
                    for (int m = 0; m < 4; ++m) { const size_t row = (size_t)(row0 + ai * 128 + m * 16);
                        const f32x4 c = *(const f32x4*)(rcos + row * 32 + i0), s = *(const f32x4*)(rsin + row * 32 + i0), x1 = acc[ai][0][m][0], x2 = acc[ai][0][m][1];
                        estore4_bf16(KR + row * 64 + i0, x1 * c - x2 * s); estore4_bf16(KR + row * 64 + 32 + i0, x2 * c + x1 * s); } }
        }
        else plain<1>(acc, MIX, DM, row0, DF + (pn - 12) * 256 + cw);
    }
};
struct EpiQ {
    static constexpr bool PERM = true, AFTER_DRAIN = false;
    bf16_t* Q; const float* rsq; const float* rcos; const float* rsin;
    __device__ __forceinline__ void operator()(const AccT& acc, const pg8::Unit& u, int wr, int wc, int fr, int fq) const {
        const int row0 = u.pm * 256 + wr * 64 + fr;
#pragma unroll
        for (int ai = 0; ai < 2; ++ai)
#pragma unroll
            for (int m = 0; m < 4; ++m) { const size_t row = (size_t)(row0 + ai * 128 + m * 16);
                const float rs = rsqrtf(rsq[row * 2 + 0] * (1.0f / QLR) + NORM_EPS);
#pragma unroll
                for (int bj = 0; bj < 2; ++bj) { const int G = u.pn * 8 + bj * 4 + wc, head = G / 6, g6 = G - head * 6;
                    const f32x4 v0 = acc[ai][bj][m][0] * rs, v1 = acc[ai][bj][m][1] * rs;
                    if (g6 < 4) estore8_bf16(Q + row * NQ + head * DQK + g6 * 32 + 8 * fq, v0, v1);
                    else { const int i0 = 16 * (g6 - 4) + 4 * fq; const f32x4 c = *(const f32x4*)(rcos + row * 32 + i0), s = *(const f32x4*)(rsin + row * 32 + i0);

#if defined(PROBE_NEG) && PROBE_NEG == 1
                        estore4_bf16(Q + row * NQ + head * DQK + 128 + i0, v0 * c + v1 * s); estore4_bf16(Q + row * NQ + head * DQK + 160 + i0, v1 * c - v0 * s);
#else
                        estore4_bf16(Q + row * NQ + head * DQK + 128 + i0, v0 * c - v1 * s); estore4_bf16(Q + row * NQ + head * DQK + 160 + i0, v1 * c + v0 * s);
#endif
                    } } }
    }
};
struct EpiKV {
    static constexpr bool PERM = true, AFTER_DRAIN = false;
    bf16_t* KV; const float* rsq;
    __device__ __forceinline__ void operator()(const AccT& acc, const pg8::Unit& u, int wr, int wc, int fr, int fq) const {
        const int row0 = u.pm * 256 + wr * 64 + fr, col0 = u.pn * 256 + wc * 32 + 8 * fq;
#pragma unroll
        for (int ai = 0; ai < 2; ++ai)
#pragma unroll
            for (int m = 0; m < 4; ++m) { const size_t row = (size_t)(row0 + ai * 128 + m * 16);
                const float rs = rsqrtf(rsq[row * 2 + 1] * (1.0f / KVLR) + NORM_EPS);
#pragma unroll
                for (int bj = 0; bj < 2; ++bj) estore8_bf16(KV + row * NKV + col0 + bj * 128, acc[ai][bj][m][0] * rs, acc[ai][bj][m][1] * rs); }
    }
};
struct EpiOut {
    static constexpr bool PERM = true, AFTER_DRAIN = false;
    bf16_t* GY; const float* gate;
    __device__ __forceinline__ void operator()(const AccT& acc, const pg8::Unit& u, int wr, int wc, int fr, int fq) const {
        const int row0 = u.pm * 256 + wr * 64 + fr, col0 = u.pn * 256 + wc * 32 + 8 * fq;
        const float* gp = gate + (size_t)(u.pm >> 4) * (3 * DM) + col0;
        f32x4 gv[2][2];
#pragma unroll
        for (int bj = 0; bj < 2; ++bj)
#pragma unroll
            for (int n = 0; n < 2; ++n) gv[bj][n] = *(const f32x4*)(gp + bj * 128 + n * 4);
#pragma unroll
        for (int ai = 0; ai < 2; ++ai)
#pragma unroll
            for (int m = 0; m < 4; ++m) { bf16_t* rowp = GY + (size_t)(row0 + ai * 128 + m * 16) * DM + col0;
#pragma unroll
                for (int bj = 0; bj < 2; ++bj) estore8_bf16(rowp + bj * 128, gv[bj][0] * acc[ai][bj][m][0], gv[bj][1] * acc[ai][bj][m][1]); }
    }
};

struct EpiNone {
    static constexpr bool PERM = true, AFTER_DRAIN = false;
    __device__ __forceinline__ void operator()(const AccT& acc, const pg8::Unit& u, int wr, int wc, int fr, int fq) const {
#pragma unroll
        for (int ai = 0; ai < 2; ++ai)
#pragma unroll
            for (int bj = 0; bj < 2; ++bj)
#pragma unroll
                for (int m = 0; m < 4; ++m)
#pragma unroll
                    for (int n = 0; n < 2; ++n) asm volatile("" :: "v"(acc[ai][bj][m][n]));
    }
};
#define XB_TMO      128
#define XB_XCNT(j)  (256  + 64 * (j))
#define XB_XSUB(j)  (1280 + 64 * (j))
#define XB_XGEN(j)  (2304 + 64 * (j))
#define XB_TOP      3328
#define XB_TOPGEN   3392
#define XCD_BAR_WORDS 3456
#define XB_SPIN_CAP (1u << 22)
static_assert(XCD_BAR_WORDS * 4 <= CTL_BYTES, "barrier words must fit the control region");
__device__ __forceinline__ unsigned xb_ld(unsigned* p)              { return __hip_atomic_load(p, __ATOMIC_RELAXED, __HIP_MEMORY_SCOPE_AGENT); }
__device__ __forceinline__ unsigned xb_add(unsigned* p, unsigned v) { return __hip_atomic_fetch_add(p, v, __ATOMIC_RELAXED, __HIP_MEMORY_SCOPE_AGENT); }
__device__ __forceinline__ unsigned xb_xcc_id() { return (unsigned)__builtin_amdgcn_s_getreg((3 << 11) | 20) & 0xFu; }
#define XB_SPIN(cond, bar) do { unsigned _sp = 0; while (cond) { __builtin_amdgcn_s_sleep(1); \
    if ((++_sp & 255u) == 0u) { if (xb_ld(&(bar)[XB_TMO])) break; if (_sp > XB_SPIN_CAP) { atomicAdd(&(bar)[XB_TMO], 1u); break; } } } } while (0)
struct XcdBarrier { unsigned* bar; unsigned x; volatile LAS unsigned* st; };
__device__ __forceinline__ XcdBarrier xcd_barrier_post(unsigned* bar, volatile LAS unsigned* st) {
    XcdBarrier b; b.bar = bar; b.x = xb_xcc_id(); b.st = st;
    if (threadIdx.x == 0) (void)xb_add(&bar[XB_XCNT(b.x)], 1u);
    return b;
}
__device__ __forceinline__ void xcd_barrier_complete(unsigned* bar, unsigned x, unsigned& nloc, unsigned& nx) {
    const unsigned G = gridDim.x * gridDim.y * gridDim.z;
    unsigned sum, cnt, mine, sp = 0u;
    for (;;) {
        sum = 0u; cnt = 0u; mine = 0u;
#pragma unroll
        for (unsigned j = 0; j < 16; ++j) { const unsigned c = xb_ld(&bar[XB_XCNT(j)]); sum += c; cnt += (c > 0u) ? 1u : 0u; mine = (j == x) ? c : mine; }
        if (sum == G) break;
        __builtin_amdgcn_s_sleep(1);
        if ((++sp & 255u) == 0u) { if (xb_ld(&bar[XB_TMO])) break; if (sp > XB_SPIN_CAP) { atomicAdd(&bar[XB_TMO], 1u); break; } }
    }
    nloc = mine > 0u ? mine : 1u; nx = cnt > 0u ? cnt : 1u;
}
__device__ __forceinline__ void xcd_barrier(const XcdBarrier& b) {
    asm volatile("s_waitcnt vmcnt(0)" ::: "memory");
    __syncthreads();
    if (threadIdx.x == 0) {
        unsigned* bar = b.bar;
        __builtin_amdgcn_s_waitcnt(0);
        unsigned nloc = b.st[0], nx = b.st[1];
        if (nloc == 0u) { xcd_barrier_complete(bar, b.x, nloc, nx); b.st[0] = nloc; b.st[1] = nx; }
        const unsigned old = xb_add(&bar[XB_XSUB(b.x)], 1u);
        const unsigned gen = old / nloc;
        if (old + 1u == (gen + 1u) * nloc) {
            __builtin_amdgcn_fence(__ATOMIC_RELEASE, "agent");
            asm volatile("s_waitcnt vmcnt(0)" ::: "memory");
            const unsigned og = xb_add(&bar[XB_TOP], 1u);
            const unsigned tg = og / nx;
            if (og + 1u == (tg + 1u) * nx) xb_add(&bar[XB_TOPGEN], 1u);
            else XB_SPIN(xb_ld(&bar[XB_TOPGEN]) == tg, bar);
            __builtin_amdgcn_fence(__ATOMIC_ACQUIRE, "agent");
            xb_add(&bar[XB_XGEN(b.x)], 1u);
            asm volatile("s_waitcnt vmcnt(0)" ::: "memory");
        } else {
            XB_SPIN(xb_ld(&bar[XB_XGEN(b.x)]) == gen, bar);
            __builtin_amdgcn_fence(__ATOMIC_ACQUIRE, "agent");
            asm volatile("s_waitcnt vmcnt(0)" ::: "memory");
        }
    }
    __syncthreads();
}
struct Frame {
    const float* in[14]; float* out; unsigned char* ws;
    LAS unsigned char* lds; char* ldsg;
    int tid, lane, wave, G, bx, vcu; size_t mix_off;
};
#define WSP(T, off) ((T*)(F.ws + (off)))

__device__ __forceinline__ int src_in(int n) {
    if (n < 2816) return n;
    if (n < 3072) { const int c = n - 2816, bj = c >> 7, wc = (c >> 5) & 3, c32 = c & 31; if (bj || wc >= 2) return -1;
        const int fq = c32 >> 3, nn = (c32 >> 2) & 1, j = c32 & 3; return 2816 + 32 * nn + 16 * wc + 4 * fq + j; }
    return n - 192;
}
__device__ __forceinline__ int src_q(int n) {
    const int G = n >> 5, c32 = n & 31, head = G / 6, g6 = G - head * 6;
    if (g6 < 4) return head * DQK + g6 * 32 + c32;
    const int fq = c32 >> 3, nn = (c32 >> 2) & 1, j = c32 & 3; return head * DQK + 128 + 32 * nn + 16 * (g6 - 4) + 4 * fq + j;
}
__device__ __forceinline__ void p0_weights(const Frame& F) {
    constexpr int TIN = 512, TOUT = 256, TQ = 48, TKV = 32, TL = TIN + TOUT + TQ + TKV;
    LAS unsigned* T = (LAS unsigned*)F.lds;
    const int tid = F.tid, n4 = (tid & 15) * 4, kp = tid >> 4;
    for (int it = F.bx; it < DEPTH * TL; it += F.G) {
        const int l = it / TL; int r = it - l * TL, kind, nt, kt, Nsrc, K; const float* W; const float* ksc = nullptr; bf16_t* Bt;
        if (r < TIN) { kind = 0; nt = r >> 3; kt = r & 7; W = F.in[5] + (size_t)l * DM * NIN; Nsrc = NIN; K = DM; Bt = WSP(bf16_t, WS_WIN) + (size_t)l * NINP * DM; }
        else if (r < TIN + TOUT) { r -= TIN; kind = 1; nt = r >> 3; kt = r & 7; W = F.in[11] + (size_t)l * DM * DM; Nsrc = DM; K = DM; Bt = WSP(bf16_t, WS_WOUT) + (size_t)l * DM * DM; }
        else if (r < TIN + TOUT + TQ) { r -= TIN + TOUT; kind = 2; nt = r >> 1; kt = r & 1; W = F.in[7] + (size_t)l * QLR * NQ; Nsrc = NQ; K = QLR; ksc = F.in[6] + l * QLR; Bt = WSP(bf16_t, WS_WQ) + (size_t)l * NQ * QLR; }
        else { r -= TIN + TOUT + TQ; kind = 3; nt = r; kt = 0; W = F.in[9] + (size_t)l * KVLR * NKV; Nsrc = NKV; K = KVLR; ksc = F.in[8] + l * KVLR; Bt = WSP(bf16_t, WS_WKV) + (size_t)l * NKV * KVLR; }
        const int n0 = nt * 64, k0 = kt * 256, n = n0 + n4;
        const int src = kind == 0 ? src_in(n) : (kind == 2 ? src_q(n) : n);
        f32x4 v0[4], v1[4];
#pragma unroll
        for (int i = 0; i < 4; ++i) { const int k = k0 + 2 * (kp + 32 * i);
            v0[i] = src >= 0 ? __builtin_nontemporal_load((const f32x4*)(W + (size_t)k * Nsrc + src)) : (f32x4){0.f, 0.f, 0.f, 0.f}; v1[i] = src >= 0 ? __builtin_nontemporal_load((const f32x4*)(W + (size_t)(k + 1) * Nsrc + src)) : (f32x4){0.f, 0.f, 0.f, 0.f}; }
        if (ksc) {
#pragma unroll
            for (int i = 0; i < 4; ++i) { const int k = k0 + 2 * (kp + 32 * i); v0[i] *= ksc[k]; v1[i] *= ksc[k + 1]; } }
#pragma unroll
        for (int i = 0; i < 4; ++i)
#pragma unroll
            for (int e = 0; e < 4; ++e) T[(n4 + e) * 130 + kp + 32 * i] = cvt_pk_bf16(v0[i][e], v1[i][e]);
        __syncthreads();
#pragma unroll
        for (int i = 0; i < 4; ++i) { const int c = tid + 512 * i, nn = c >> 5, kc = c & 31;
            const u32x2 a = *(const LAS u32x2*)(T + nn * 130 + kc * 4), b = *(const LAS u32x2*)(T + nn * 130 + kc * 4 + 2);
            *(u32x4*)(Bt + (size_t)(n0 + nn) * K + k0 + kc * 8) = (u32x4){a.x, a.y, b.x, b.y}; }
        __syncthreads();
    }
}
__device__ __forceinline__ void p0_mod(const Frame& F) {
    LAS float* red = (LAS float*)(F.lds + 32768);
    const int tid = F.tid;
    float* mod = WSP(float, WS_MOD); const float* cc = F.in[1];
    for (int it = F.bx; it < DEPTH * 96 * 4; it += F.G) {
        const int l = it / 384, rem = it - l * 384, kq = rem & 3, col0 = (rem >> 2) * 64, cg = tid & 15, kl = tid >> 4;
        f32x4 acc[4] = {};
        const float* wp = F.in[3] + ((size_t)l * DM + kq * 512 + kl) * (3 * DM) + col0 + cg * 4;
        f32x4 w[16];
#pragma unroll
        for (int i = 0; i < 16; ++i) w[i] = __builtin_nontemporal_load((const f32x4*)(wp + (size_t)(32 * i) * (3 * DM)));
#pragma unroll
        for (int i = 0; i < 16; ++i) { const int k = kq * 512 + kl + 32 * i;
#pragma unroll
            for (int b = 0; b < 4; ++b) acc[b] += w[i] * silu_f(cc[b * DM + k]); }
#pragma unroll
        for (int b = 0; b < 4; ++b)
#pragma unroll
            for (int j = 0; j < 4; ++j) red[(kl * 16 + cg) * 16 + b * 4 + j] = acc[b][j];
        __syncthreads();
        if (tid < 256) { const int cg2 = tid >> 4, v = tid & 15, b = v >> 2, j = v & 3; float s = 0.f;
            for (int q = 0; q < 32; ++q) s += red[(q * 16 + cg2) * 16 + v];
            const int col = col0 + cg2 * 4 + j; if (kq == 0) s += F.in[4][l * (3 * DM) + col];
            atomicAdd(mod + (size_t)(l * NB + b) * (3 * DM) + col, s); }
        __syncthreads();
    }
}
__device__ __forceinline__ void p0_tables(const Frame& F) {
    constexpr double INVF2PI[32] = {
    0.15915494309189535, 0.11934937021124886, 0.08949940160889101, 0.06711508300522726,
    0.050329212104487035, 0.03774158471741977, 0.0283021958306234, 0.02122365276477766,
    0.015915494309189534, 0.011934937021124886, 0.008949940160889102, 0.006711508300522725,
    0.005032921210448704, 0.003774158471741977, 0.00283021958306234, 0.0021223652764777662,
    0.0015915494309189536, 0.0011934937021124885, 0.0008949940160889102, 0.0006711508300522726,
    0.0005032921210448703, 0.00037741584717419774, 0.00028302195830623395, 0.0002122365276477766,
    0.00015915494309189535, 0.00011934937021124886, 8.949940160889102e-05, 6.711508300522725e-05,
    5.0329212104487035e-05, 3.774158471741978e-05, 2.8302195830623396e-05, 2.122365276477766e-05};
    const int gid = F.bx * NTHREADS + F.tid, NT = F.G * NTHREADS;
    const int* pos = (const int*)F.in[2]; float* rc = WSP(float, WS_RCOS); float* rs = WSP(float, WS_RSIN);
    for (int idx = gid; idx < MTOK * 32; idx += NT) { const int i = idx & 31; double t = (double)pos[idx >> 5] * INVF2PI[i]; t -= floor(t);
        float sn, cs; sincospif((float)(2.0 * t), &sn, &cs); rc[idx] = cs; rs[idx] = sn; }
    bf16_t* D1 = WSP(bf16_t, WS_D1); bf16_t* D2 = WSP(bf16_t, WS_D2);
    for (int idx = gid; idx < 128 * 64; idx += NT) { const int s1 = idx & 63, rr = idx >> 6, ri = rr >> 6, s1p = rr & 63; float sn, cs; sincospif((float)((s1 * s1p) & 63) * (1.0f / 32.0f), &sn, &cs);
        D1[idx] = f2bf((ri ? -sn : cs) * 0.125f); }
    for (int idx = gid; idx < 128 * 128; idx += NT) { const int kk = idx & 127, rr = idx >> 7, ri = kk >> 6, s2 = kk & 63, ro = rr >> 6, s2p = rr & 63; float sn, cs; sincospif((float)((s2 * s2p) & 63) * (1.0f / 32.0f), &sn, &cs);
        const float v = ro == 0 ? (ri == 0 ? cs : sn) : (ri == 0 ? -sn : cs); D2[idx] = f2bf(v * 0.125f); }
    float* rsq = WSP(float, WS_RSQ);
    for (int idx = gid; idx < DEPTH * MTOK * 2; idx += NT) rsq[idx] = 0.f;
    LAS float* ct = (LAS float*)F.lds; LAS float* st = ct + 128;
    if (F.tid < 128) { float sn, cs; sincospif((float)F.tid * (1.0f / 64.0f), &sn, &cs); ct[F.tid] = cs * 0.08838834764831845f; st[F.tid] = sn * 0.08838834764831845f; }
    __syncthreads();
    bf16_t* wcat = WSP(bf16_t, WS_WCAT);
    for (int t = gid; t < DEPTH * NG * 128 * 64; t += NT) { const int k4 = (t & 63) * 4, d = (t >> 6) & 127, lg = t >> 13, ro = k4 >> 7, c0 = k4 & 127;
        const float* w = F.in[10] + (size_t)lg * 128 * 128 + d; LAS float* tb = ro ? st : ct; f32x4 s = {0.f, 0.f, 0.f, 0.f};
        for (int cp0 = 0; cp0 < 128; cp0 += 16) { float wv[16];
#pragma unroll
            for (int u = 0; u < 16; ++u) wv[u] = w[(cp0 + u) * 128];
#pragma unroll
            for (int u = 0; u < 16; ++u) { const int cp = cp0 + u; s += (f32x4){tb[(c0 * cp) & 127], tb[((c0 + 1) * cp) & 127], tb[((c0 + 2) * cp) & 127], tb[((c0 + 3) * cp) & 127]} * wv[u]; } }
        u32x2 o; o.x = cvt_pk_bf16(s[0], s[1]); o.y = cvt_pk_bf16(s[2], s[3]);
        *(u32x2*)(wcat + ((size_t)lg * 128 + d) * 256 + k4) = o; }
    __syncthreads();
}
#ifndef LN_NT
#define LN_NT 1
#endif
#if LN_NT
#define LN_LD(p) __builtin_nontemporal_load((const f32x4*)(p))
#define LN_ST(p, v) __builtin_nontemporal_store((v), (f32x4*)(p))
#else
#define LN_LD(p) (*(const f32x4*)(p))
#define LN_ST(p, v) (*(f32x4*)(p) = (v))
#endif
__device__ __forceinline__ void row_stats(const f32x4 (&v)[8], float& mean, float& rstd) {
    float s = 0.f;
#pragma unroll
    for (int i = 0; i < 8; ++i) s += (v[i][0] + v[i][1]) + (v[i][2] + v[i][3]);
    mean = wave_sum(s) * (1.0f / DM); float q = 0.f;
#pragma unroll
    for (int i = 0; i < 8; ++i) { const f32x4 d = v[i] - mean; q += (d[0] * d[0] + d[1] * d[1]) + (d[2] * d[2] + d[3] * d[3]); }
    rstd = rsqrtf(wave_sum(q) * (1.0f / DM) + NORM_EPS);
}
__device__ __forceinline__ void p_ln_first(const Frame& F) {
    const float* x = F.in[0]; const float* mod = WSP(float, WS_MOD); bf16_t* H = WSP(bf16_t, WS_H);
    const int step = F.G * 8; int row = F.bx * 8 + F.wave;
    f32x4 v[8], vn[8];
    if (row < MTOK) { const float* xr = x + (size_t)row * DM + F.lane * 4;
#pragma unroll
        for (int i = 0; i < 8; ++i) vn[i] = LN_LD(xr + i * 256); }
    for (; row < MTOK; row += step) {
#pragma unroll
        for (int i = 0; i < 8; ++i) v[i] = vn[i];
        if (row + step < MTOK) { const float* xr = x + (size_t)(row + step) * DM + F.lane * 4;
#pragma unroll
            for (int i = 0; i < 8; ++i) vn[i] = LN_LD(xr + i * 256); }
        float mean, rstd; row_stats(v, mean, rstd);
        const float* mp = mod + (size_t)(row >> 12) * (3 * DM) + F.lane * 4;
#pragma unroll
        for (int i = 0; i < 8; ++i) { const f32x4 sh = *(const f32x4*)(mp + i * 256), sc = *(const f32x4*)(mp + DM + i * 256);
            store4_bf16(H + (size_t)row * DM + F.lane * 4 + i * 256, (v[i] - mean) * rstd * (sc + 1.0f) + sh); }
    }
}
template <bool NEXT> __device__ __forceinline__ void p_ln_post(const Frame& F, int l) {
    const float* xs = l == 0 ? F.in[0] : WSP(float, WS_R); float* dst = NEXT ? WSP(float, WS_R) : F.out; const float* g = F.in[12] + l * DM; const float* bb = F.in[13] + l * DM;
    const float* mod = WSP(float, WS_MOD) + (size_t)(l + 1) * NB * (3 * DM); bf16_t* H = WSP(bf16_t, WS_H);
    const int step = F.G * 8; int row = F.bx * 8 + F.wave;
    f32x4 v[8], vn[8]; u32x2 gy[8], gyn[8];
    if (row < MTOK) { const float* xr = xs + (size_t)row * DM + F.lane * 4; const bf16_t* gr = H + (size_t)row * DM + F.lane * 4;
#pragma unroll
        for (int i = 0; i < 8; ++i) { vn[i] = LN_LD(xr + i * 256); gyn[i] = __builtin_nontemporal_load((const u32x2*)(gr + i * 256)); } }
    for (; row < MTOK; row += step) {
#pragma unroll
        for (int i = 0; i < 8; ++i) { const u32x2 q = gyn[i];
            v[i] = vn[i] * DN_ALPHA + (f32x4){__uint_as_float(q.x << 16), __uint_as_float(q.x & 0xffff0000u), __uint_as_float(q.y << 16), __uint_as_float(q.y & 0xffff0000u)}; }
        if (row + step < MTOK) { const float* xr = xs + (size_t)(row + step) * DM + F.lane * 4; const bf16_t* gr = H + (size_t)(row + step) * DM + F.lane * 4;
#pragma unroll
            for (int i = 0; i < 8; ++i) { vn[i] = LN_LD(xr + i * 256); gyn[i] = __builtin_nontemporal_load((const u32x2*)(gr + i * 256)); } }
        float mean, rstd; row_stats(v, mean, rstd);
#pragma unroll
        for (int i = 0; i < 8; ++i) { v[i] = (v[i] - mean) * rstd * *(const f32x4*)(g + F.lane * 4 + i * 256) + *(const f32x4*)(bb + F.lane * 4 + i * 256);
            LN_ST(dst + (size_t)row * DM + F.lane * 4 + i * 256, v[i]); }
        if (NEXT) { row_stats(v, mean, rstd); const float* mp = mod + (size_t)(row >> 12) * (3 * DM) + F.lane * 4;
#pragma unroll
            for (int i = 0; i < 8; ++i) { const f32x4 sh = *(const f32x4*)(mp + i * 256), sc = *(const f32x4*)(mp + DM + i * 256);
                store4_bf16(H + (size_t)row * DM + F.lane * 4 + i * 256, (v[i] - mean) * rstd * (sc + 1.0f) + sh); } }
    }
}
__device__ __forceinline__ void fft1_naive(const Frame& F) {
    const bf16_t* U = WSP(bf16_t, WS_U); const bf16_t* D1 = WSP(bf16_t, WS_D1); bf16_t* Z = WSP(bf16_t, WS_H);
    const int gid = F.bx * NTHREADS + F.tid, NT = F.G * NTHREADS;
    for (int idx = gid; idx < NB * 64 * NG * 64 * 128; idx += NT) {
        const int c = idx & 127, s2 = (idx >> 7) & 63, g = (idx >> 13) & 7, s1p = (idx >> 16) & 63, b = idx >> 22;
        float yr = 0.f, yi = 0.f;
        for (int s1 = 0; s1 < 64; ++s1) { const float u = bf2f(U[(size_t)(b * SEQ + 64 * s1 + s2) * DF + g * 128 + c]); yr += bf2f(D1[s1p * 64 + s1]) * u; yi += bf2f(D1[(64 + s1p) * 64 + s1]) * u; }
        float st, ct; sincospif((float)(s2 * s1p) * (1.0f / 2048.0f), &st, &ct);
        const size_t zo = ((((size_t)(b * 64 + s1p) * NG + g) * 2) * 64 + s2) * 128 + c;
        Z[zo] = f2bf(yr * ct + yi * st); Z[zo + 64 * 128] = f2bf(yi * ct - yr * st);
    }
}
__device__ __forceinline__ void fft2_naive(const Frame& F, int l) {
    const bf16_t* Z = WSP(bf16_t, WS_H); const bf16_t* D2 = WSP(bf16_t, WS_D2); const bf16_t* wcat = WSP(bf16_t, WS_WCAT) + (size_t)l * NG * 128 * 256; bf16_t* MIX = WSP(bf16_t, WS_MIX);
    LAS float* Xs = (LAS float*)F.lds;
    for (int it = F.bx; it < NB * 64 * NG; it += F.G) {
        const int g = it & 7, s1p = (it >> 3) & 63, b = it >> 9;
        const bf16_t* Zb = Z + ((size_t)(b * 64 + s1p) * NG + g) * 2 * 64 * 128;
        for (int i = 0; i < 32; ++i) { const int o = F.tid + 512 * i, c = o & 127, rr = o >> 7; float s = 0.f;
            for (int k = 0; k < 128; ++k) s += bf2f(D2[rr * 128 + k]) * bf2f(Zb[k * 128 + c]);
            Xs[rr * 128 + c] = bf2f(f2bf(s)); }
        __syncthreads();
        for (int i = 0; i < 16; ++i) { const int o = F.tid + 512 * i, d = o & 127, s2p = o >> 7; float s = 0.f;
            const bf16_t* wr = wcat + (size_t)(g * 128 + d) * 256;
            for (int k = 0; k < 256; ++k) s += Xs[((k >> 7) * 64 + s2p) * 128 + (k & 127)] * bf2f(wr[k]);
            const size_t mo = (size_t)(b * SEQ + s1p + 64 * s2p) * DM + g * 128 + d;
            MIX[mo] = f2bf(s * bf2f(MIX[mo])); }
        __syncthreads();
    }
}
__device__ __forceinline__ void attn_naive(const Frame& F) {
    const bf16_t* Q = WSP(bf16_t, WS_Q); const bf16_t* KV = WSP(bf16_t, WS_KV); const bf16_t* KR = WSP(bf16_t, WS_KR); bf16_t* MIX = WSP(bf16_t, WS_MIX);
    LAS float* qs = (LAS float*)F.lds + F.wave * 192;
    for (int it = F.bx * 8 + F.wave; it < MTOK * NH * 2; it += F.G * 8) {
        const int dh = it & 1, h = (it >> 1) & 7, tok = it >> 4, b = tok >> 12;
        __builtin_amdgcn_wave_barrier(); asm volatile("" ::: "memory");
        for (int e = 0; e < 3; ++e) qs[F.lane + 64 * e] = bf2f(Q[(size_t)tok * NQ + h * DQK + F.lane + 64 * e]);
        asm volatile("s_waitcnt lgkmcnt(0)" ::: "memory"); __builtin_amdgcn_wave_barrier();
        float m = -1e30f, lsum = 0.f; float o[64];
#pragma unroll
        for (int d = 0; d < 64; ++d) o[d] = 0.f;
        for (int t = 0; t < 64; ++t) {
            const size_t key = (size_t)b * SEQ + F.lane + 64 * t; const bf16_t* kn = KV + key * NKV + h * 256; const bf16_t* kr = KR + key * 64;
            float s = 0.f;
#pragma unroll 2
            for (int c = 0; c < 16; ++c) { const bf16x8 kv = *(const bf16x8*)(kn + c * 8);
#pragma unroll
                for (int e = 0; e < 8; ++e) s += qs[c * 8 + e] * bf2f((bf16_t)kv[e]); }
#pragma unroll 2
            for (int c = 0; c < 8; ++c) { const bf16x8 kv = *(const bf16x8*)(kr + c * 8);
#pragma unroll
                for (int e = 0; e < 8; ++e) s += qs[128 + c * 8 + e] * bf2f((bf16_t)kv[e]); }
            s *= ATT_SCALE; const float mn = fmaxf(m, s), a = __expf(m - mn), p = __expf(s - mn); lsum = lsum * a + p; m = mn;
#pragma unroll
            for (int c = 0; c < 8; ++c) { const bf16x8 vv = *(const bf16x8*)(kn + 128 + dh * 64 + c * 8);
#pragma unroll
                for (int e = 0; e < 8; ++e) o[c * 8 + e] = o[c * 8 + e] * a + p * bf2f((bf16_t)vv[e]); }
        }
        const float Mx = wave_max(m), f = __expf(m - Mx); const float L = wave_sum(lsum * f);
        float keep0 = 0.f;
#pragma unroll
        for (int d = 0; d < 64; ++d) { const float od = wave_sum(o[d] * f); if (F.lane == d) keep0 = od; }
        const size_t mo = (size_t)tok * DM + DF + h * 128 + dh * 64 + F.lane;
        MIX[mo] = f2bf(keep0 / L * bf2f(MIX[mo]));
    }
}
namespace att {
constexpr int NW = 8, QBLK = 32, KVBLK = 64;
#ifndef ATT_PRIO
#define ATT_PRIO 0
#endif
#ifndef ATT_QSB2
#define ATT_QSB2 1
#endif
#ifndef ATT_SDEPTH
#define ATT_SDEPTH 1
#endif
constexpr int SDEPTH = ATT_SDEPTH;
constexpr float THR = 8.f;
constexpr int SHM_V = KVBLK * 128 * 2, SHM_KN = KVBLK * 128 * 2, SHM_KR = KVBLK * 64 * 2;
#ifndef ATT_QLDS
#define ATT_QLDS 6
#endif
constexpr int QLDS = ATT_QLDS, QREG = 12 - QLDS;
constexpr int OFF_V = 0, OFF_KN = 2 * SHM_V, OFF_KR = OFF_KN + 2 * SHM_KN, OFF_WS = OFF_KR + 2 * SHM_KR, OFF_QL = OFF_WS + NW * 64 * 4, OFF_OT = 0, OT_PITCH = 272, SHM_ATTN = OFF_QL + NW * QLDS * 1024;
static_assert(NW * 32 * OT_PITCH <= OFF_WS, "O tiles reuse the K/V buffers");
static_assert(SHM_ATTN <= RING_BYTES, "attention LDS must fit the phase scratch");
#define KSWZ(row, colB) ((row) * 256 + ((colB) ^ (((row) & 15) << 4)))
#define RSWZ(row, ch) ((row) * 128 + ((((ch) ^ (((row) >> 1) & 7))) << 4))
#define SBAR() __builtin_amdgcn_sched_barrier(0)
__device__ __forceinline__ int crow(int r, int hi) { return (r & 3) + 8 * (r >> 2) + 4 * hi; }
__device__ __forceinline__ unsigned cvtpk(float lo, float hi) { unsigned r; asm volatile("v_cvt_pk_bf16_f32 %0, %1, %2" : "=v"(r) : "v"(lo), "v"(hi)); return r; }
__device__ __forceinline__ bf16x8 ld8(const bf16_t* p) { return *reinterpret_cast<const bf16x8*>(p); }

__device__ __forceinline__ void partialSM(f32x16& p0, f32x16& p1, float& m_reg, float& mn, float& alpha) {
#if defined(PROBE_NEG) && PROBE_NEG == 2
  constexpr float C = ATT_SCALE * 1.4426950408889634f * 1.3f;
#else
  constexpr float C = ATT_SCALE * 1.4426950408889634f;
#endif
  float pmax = p0[0]; for (int r = 1; r < 16; ++r) pmax = fmaxf(pmax, p0[r]); for (int r = 0; r < 16; ++r) pmax = fmaxf(pmax, p1[r]);
  { auto rr = __builtin_amdgcn_permlane32_swap(__float_as_uint(pmax), __float_as_uint(pmax), false, false);
    pmax = fmaxf(__uint_as_float(rr[0]), __uint_as_float(rr[1])); }
  if (__builtin_expect(__all(pmax - m_reg <= THR / ATT_SCALE), 1)) { mn = m_reg; alpha = 1.f; }
  else { mn = fmaxf(m_reg, pmax); alpha = __builtin_amdgcn_exp2f((m_reg - mn) * C); m_reg = mn; }
  float mnC = -mn * C;
  for (int r = 0; r < 16; ++r) p0[r] = fmaf(p0[r], C, mnC); for (int r = 0; r < 16; ++r) p1[r] = fmaf(p1[r], C, mnC);
  for (int r = 0; r < 16; ++r) p0[r] = __builtin_amdgcn_exp2f(p0[r]);
}
__device__ __forceinline__ void finishSM(f32x16& p0, f32x16& p1, float alpha, float& l_reg, bf16x8& pa0, bf16x8& pa1, bf16x8& pa2, bf16x8& pa3) {
  for (int r = 0; r < 16; ++r) p1[r] = __builtin_amdgcn_exp2f(p1[r]);
  float ps = 0; for (int r = 0; r < 16; ++r) ps += p0[r]; for (int r = 0; r < 16; ++r) ps += p1[r];
  { auto rr = __builtin_amdgcn_permlane32_swap(__float_as_uint(ps), __float_as_uint(ps), false, false);
    ps = __uint_as_float(rr[0]) + __uint_as_float(rr[1]); }
  l_reg = l_reg * alpha + ps;
#define PK4(P, BASE, OUT) do { unsigned a0 = cvtpk(P[BASE + 0], P[BASE + 1]), a1 = cvtpk(P[BASE + 2], P[BASE + 3]);   \
    unsigned b0 = cvtpk(P[BASE + 4], P[BASE + 5]), b1 = cvtpk(P[BASE + 6], P[BASE + 7]);                              \
    auto r0 = __builtin_amdgcn_permlane32_swap(a0, b0, false, false); auto r1 = __builtin_amdgcn_permlane32_swap(a1, b1, false, false); \
    u32x4 w = {r0[0], r1[0], r0[1], r1[1]}; OUT = *reinterpret_cast<bf16x8*>(&w); } while (0)
  PK4(p0, 0, pa0); PK4(p0, 8, pa1); PK4(p1, 0, pa2); PK4(p1, 8, pa3);
#undef PK4
}
__device__ __forceinline__ bf16x8 qfrag(const char* ql, int d0) { return *reinterpret_cast<const bf16x8*>(ql + (d0 - QREG) * 1024); }
__device__ __forceinline__ void kfrag(bf16x8& a, bf16x8& b, const char* Kn, const char* Kr, int d0, int r32, int hi) {
  if (d0 < 8) { const int cb = (d0 * 16 + hi * 8) * 2; a = *reinterpret_cast<const bf16x8*>(Kn + KSWZ(r32, cb)); b = *reinterpret_cast<const bf16x8*>(Kn + KSWZ(32 + r32, cb)); }
  else { const int ch = (d0 - 8) * 2 + hi; a = *reinterpret_cast<const bf16x8*>(Kr + RSWZ(r32, ch)); b = *reinterpret_cast<const bf16x8*>(Kr + RSWZ(32 + r32, ch)); }
}
__device__ __forceinline__ void qkt(f32x16& p0, f32x16& p1, const char* Kn, const char* Kr, const bf16x8* qr, const char* ql, int r32, int hi) {
  p0 = f32x16{}; p1 = f32x16{};
  bf16x8 ka, kb, na, nb, qc, qn;
  kfrag(ka, kb, Kn, Kr, 0, r32, hi); if (0 >= QREG) qc = qfrag(ql, 0);
#pragma unroll
  for (int d0 = 0; d0 < 12; ++d0) {
    if (d0 + 1 < 12) { kfrag(na, nb, Kn, Kr, d0 + 1, r32, hi); if (d0 + 1 >= QREG) qn = qfrag(ql, d0 + 1); }
    SBAR();
    const bf16x8 q = d0 < QREG ? qr[d0 < QREG ? d0 : 0] : qc;
    if (ATT_PRIO) __builtin_amdgcn_s_setprio(1);
    p0 = __builtin_amdgcn_mfma_f32_32x32x16_bf16(ka, q, p0, 0, 0, 0);
    p1 = __builtin_amdgcn_mfma_f32_32x32x16_bf16(kb, q, p1, 0, 0, 0);
    if (ATT_PRIO) __builtin_amdgcn_s_setprio(0);
    if (ATT_QSB2) SBAR();
    ka = na; kb = nb; qc = qn;
  }
}
__device__ __forceinline__ int v_st(int k, int c) { const int kk = (k & ~0xC) | ((k & 4) << 1) | ((k & 8) >> 1); return ((kk >> 3) * 4 + (c >> 5)) * 512 + ((kk & 7) * 32 + (c & 31)) * 2; }
__device__ __forceinline__ int v_rd_base(int lane) { return ((lane & 3) << 3) | (((lane >> 2) & 3) << 6) | (((lane >> 4) & 1) << 5) | (((lane >> 5) & 1) << 8); }
constexpr int v_rd_off(int d0, int ks, int half) { return d0 * 512 + ks * 4096 + half * 2048; }
template <int OFF> __device__ __forceinline__ s16x4 tr_read(int vb) {
  s16x4 r; asm volatile("ds_read_b64_tr_b16 %0, %1 offset:%2" : "=&v"(r) : "v"(vb), "i"(OFF) : "memory"); return r;
}
#define TRPK(L, H) (bf16x8){L[0], L[1], L[2], L[3], H[0], H[1], H[2], H[3]}
template <int D0> __device__ __forceinline__ void pv_one(f32x16& od, int vb, bf16x8 pa0, bf16x8 pa1, bf16x8 pa2, bf16x8 pa3) {
  const s16x4 l0 = tr_read<v_rd_off(D0, 0, 0)>(vb), h0 = tr_read<v_rd_off(D0, 0, 1)>(vb), l1 = tr_read<v_rd_off(D0, 1, 0)>(vb), h1 = tr_read<v_rd_off(D0, 1, 1)>(vb);
  const s16x4 l2 = tr_read<v_rd_off(D0, 2, 0)>(vb), h2 = tr_read<v_rd_off(D0, 2, 1)>(vb), l3 = tr_read<v_rd_off(D0, 3, 0)>(vb), h3 = tr_read<v_rd_off(D0, 3, 1)>(vb);
  asm volatile("s_waitcnt lgkmcnt(0)" ::: "memory"); SBAR();
  if (ATT_PRIO) __builtin_amdgcn_s_setprio(1);
  od = __builtin_amdgcn_mfma_f32_32x32x16_bf16(pa0, TRPK(l0, h0), od, 0, 0, 0);
  od = __builtin_amdgcn_mfma_f32_32x32x16_bf16(pa1, TRPK(l1, h1), od, 0, 0, 0);
  od = __builtin_amdgcn_mfma_f32_32x32x16_bf16(pa2, TRPK(l2, h2), od, 0, 0, 0);
  od = __builtin_amdgcn_mfma_f32_32x32x16_bf16(pa3, TRPK(l3, h3), od, 0, 0, 0);
  if (ATT_PRIO) __builtin_amdgcn_s_setprio(0);
}
__device__ __forceinline__ void pv_d0(f32x16* o, int vb, bf16x8 pa0, bf16x8 pa1, bf16x8 pa2, bf16x8 pa3) {
  pv_one<0>(o[0], vb, pa0, pa1, pa2, pa3); pv_one<1>(o[1], vb, pa0, pa1, pa2, pa3); pv_one<2>(o[2], vb, pa0, pa1, pa2, pa3); pv_one<3>(o[3], vb, pa0, pa1, pa2, pa3);
}

template <int VAR>
__device__ __forceinline__ void attn_body(const bf16_t* __restrict__ Qb, const bf16_t* __restrict__ Kn, const bf16_t* __restrict__ Kr,
                                          bf16_t* __restrict__ Gm, int seq, char* lds, int tid) {
  const int wid = tid >> 6, lane = tid & 63, r32 = lane & 31, hi = lane >> 5;
  char* V_lds = lds + OFF_V; char* K_lds = lds + OFF_KN; char* R_lds = lds + OFF_KR;
  float* ws = (float*)(lds + OFF_WS) + wid * 64; float* li_l = ws; float* al_l = ws + 32;
  float m_reg = -1e30f, l_reg = 0; f32x16 o[4] = {}; bf16x8 qr[QREG > 0 ? QREG : 1];
  char* ql = lds + OFF_QL + wid * (QLDS * 1024) + lane * 16;
  const unsigned qoff = (unsigned)((wid * QBLK + r32) * NQ + hi * 8) * 2u;
#pragma unroll
  for (int d0 = 0; d0 < 12; ++d0) { const bf16x8 qv = *(const bf16x8*)((const char*)Qb + qoff + d0 * 32); if (d0 < QREG) qr[d0 < QREG ? d0 : 0] = qv; else *reinterpret_cast<bf16x8*>(ql + (d0 - QREG) * 1024) = qv; }
  const int sr = tid >> 4, sc = (tid & 15) * 8, vst0 = v_st(sr, sc), vst1 = v_st(32 + sr, sc);
  const int rr_ = tid >> 3, rc_ = tid & 7;
  const int vb0 = (int)(uintptr_t)V_lds + v_rd_base(lane);
  struct { bf16x8 vs0, vs1, ks0, ks1, kr; } sr_[SDEPTH];
  const unsigned voff = (unsigned)(sr * NKV + sc) * 2u, voffr = (unsigned)(rr_ * 64 + rc_ * 8) * 2u;
#define SLOAD(i, k0) do { const char* kb_ = (const char*)(Kn + (long)(k0) * NKV); const char* rb_ = (const char*)(Kr + (long)(k0) * 64); \
    sr_[i].vs0 = *(const bf16x8*)(kb_ + 256 + voff); sr_[i].vs1 = *(const bf16x8*)(kb_ + (32 * NKV * 2 + 256) + voff); \
    sr_[i].ks0 = *(const bf16x8*)(kb_ + voff); sr_[i].ks1 = *(const bf16x8*)(kb_ + 32 * NKV * 2 + voff); \
    sr_[i].kr = *(const bf16x8*)(rb_ + voffr); } while (0)
#define SWRITE(b, i) do { *(bf16x8*)(V_lds + (b) * SHM_V + vst0) = sr_[i].vs0;          \
    *(bf16x8*)(V_lds + (b) * SHM_V + vst1) = sr_[i].vs1; int kc = sc * 2;               \
    *(bf16x8*)(K_lds + (b) * SHM_KN + KSWZ(sr, kc)) = sr_[i].ks0;                       \
    *(bf16x8*)(K_lds + (b) * SHM_KN + KSWZ(32 + sr, kc)) = sr_[i].ks1;                  \
    *(bf16x8*)(R_lds + (b) * SHM_KR + RSWZ(rr_, rc_)) = sr_[i].kr; } while (0)
#define SLOADV(i, k0) do { if constexpr (VAR != 4) SLOAD(i, k0); } while (0)
#define SWRITEV(b, i) do { if constexpr (VAR != 4) SWRITE(b, i); } while (0)
#define SWAIT() do { if constexpr (SDEPTH == 2) asm volatile("s_waitcnt vmcnt(5)" ::: "memory"); else asm volatile("s_waitcnt vmcnt(0)" ::: "memory"); } while (0)
#define RESC(a) do { if (__any((a) < 1.f)) { if (hi == 0) al_l[r32] = (a); asm volatile("s_waitcnt lgkmcnt(0)" ::: "memory"); \
    for (int d = 0; d < 4; ++d) for (int r = 0; r < 16; ++r) o[d][r] *= al_l[crow(r, hi)]; } } while (0)
  f32x16 pA0, pA1, pB0, pB1; float mnA, mnB, alA, alB; bf16x8 pa0, pa1, pa2, pa3; const int NT = seq / KVBLK;
#define QKT(P0, P1, KN, KR) do { if constexpr (VAR == 3) { P0 = o[0]; P1 = o[1]; } else qkt(P0, P1, KN, KR, qr, ql, r32, hi); } while (0)
#define PSM(P0, P1, MN, AL) do { if constexpr (VAR == 1) { MN = m_reg; AL = 1.f; } else partialSM(P0, P1, m_reg, MN, AL); } while (0)
#define FSM(P0, P1, AL) do { if constexpr (VAR == 1) { pa0 = __builtin_bit_cast(bf16x8, (f32x4){P0[0], P0[1], P0[2], P0[3]}); pa1 = __builtin_bit_cast(bf16x8, (f32x4){P0[4], P0[5], P0[6], P0[7]}); \
      pa2 = __builtin_bit_cast(bf16x8, (f32x4){P1[0], P1[1], P1[2], P1[3]}); pa3 = __builtin_bit_cast(bf16x8, (f32x4){P1[4], P1[5], P1[6], P1[7]}); l_reg += P0[8] + P1[9]; } \
    else finishSM(P0, P1, AL, l_reg, pa0, pa1, pa2, pa3); } while (0)
#define PVD(VB) do { if constexpr (VAR == 2) { o[0][0] += __builtin_bit_cast(f32x4, pa0)[0]; o[1][1] += __builtin_bit_cast(f32x4, pa1)[1]; o[2][2] += __builtin_bit_cast(f32x4, pa2)[2]; o[3][3] += __builtin_bit_cast(f32x4, pa3)[3]; } else pv_d0(o, VB, pa0, pa1, pa2, pa3); } while (0)
#define SYNC() do { if constexpr (VAR != 5) __syncthreads(); } while (0)
  constexpr int SE = 0, SO = SDEPTH - 1;
  SLOAD(SE, 0); asm volatile("s_waitcnt vmcnt(0)" ::: "memory"); SWRITE(0, SE); SYNC();
  QKT(pA0, pA1, K_lds, R_lds); PSM(pA0, pA1, mnA, alA);
  SLOAD(SO, KVBLK); if constexpr (SDEPTH == 2) { if (2 < NT) SLOAD(SE, 2 * KVBLK); }
  SWAIT(); SWRITE(1, SO); SYNC();
  for (int j = 1; j + 1 < NT; j += 2) {
    SBAR(); QKT(pB0, pB1, K_lds + SHM_KN, R_lds + SHM_KR);
    FSM(pA0, pA1, alA); SBAR();
    SLOADV(SO, (j + SDEPTH) * KVBLK); SBAR();
    PVD(vb0); PSM(pB0, pB1, mnB, alB);
    SYNC(); SWAIT(); SWRITEV(0, SE);
    RESC(alB); SYNC();
    SBAR(); QKT(pA0, pA1, K_lds, R_lds);
    FSM(pB0, pB1, alB); SBAR();
    if (SDEPTH == 1 || j + 3 < NT) SLOADV(SE, (j + 1 + SDEPTH) * KVBLK); SBAR();
    PVD(vb0 + (int)SHM_V); PSM(pA0, pA1, mnA, alA);
    SYNC(); SWAIT(); SWRITEV(1, SO);
    RESC(alA); SYNC();
  }
  SBAR(); QKT(pB0, pB1, K_lds + SHM_KN, R_lds + SHM_KR);
  FSM(pA0, pA1, alA); SBAR();
  PVD(vb0); PSM(pB0, pB1, mnB, alB);
  SYNC(); RESC(alB);
  FSM(pB0, pB1, alB); SBAR();
  PVD(vb0 + (int)SHM_V);
  SBAR(); asm volatile("" ::: "memory");
  u32x4 gt[8]; const int grow = lane >> 4, gc16 = lane & 15;
  bf16_t* Gw = Gm + (size_t)(wid * QBLK + grow) * DM + gc16 * 8;
#pragma unroll
  for (int i = 0; i < 8; ++i) gt[i] = __builtin_nontemporal_load((const u32x4*)(Gw + (size_t)(4 * i) * DM));
  if (hi == 0) li_l[r32] = l_reg;
  __syncthreads();
  char* ot = lds + OFF_OT + wid * (32 * OT_PITCH);
#pragma unroll
  for (int r = 0; r < 16; ++r) { const float rl = __builtin_amdgcn_rcpf(li_l[crow(r, hi)]); char* orow = ot + crow(r, hi) * OT_PITCH + r32 * 2;
#pragma unroll
    for (int d0 = 0; d0 < 4; ++d0) *(bf16_t*)(orow + d0 * 64) = f2bf(o[d0][r] * rl); }
  asm volatile("s_waitcnt lgkmcnt(0)" ::: "memory");
#pragma unroll
  for (int i = 0; i < 8; ++i) { const u32x4 ov = *(const u32x4*)(ot + (grow + 4 * i) * OT_PITCH + gc16 * 16); const u32x4 gv = gt[i]; u32x4 w;
#pragma unroll
    for (int e = 0; e < 4; ++e) { const float a0 = __uint_as_float(ov[e] << 16) * __uint_as_float(gv[e] << 16), a1 = __uint_as_float(ov[e] & 0xffff0000u) * __uint_as_float(gv[e] & 0xffff0000u); w[e] = cvt_pk_bf16(a0, a1); }
    *(u32x4*)(Gw + (size_t)(4 * i) * DM) = w; }
#undef SLOAD
#undef SLOADV
#undef SWRITEV
#undef QKT
#undef PSM
#undef FSM
#undef PVD
#undef SYNC
#undef SWRITE
#undef SWAIT
#undef RESC
}
}

template <int VAR = 0>
__device__ __forceinline__ void attn_fast(const Frame& F) {
    const bf16_t* Q = WSP(bf16_t, WS_Q); const bf16_t* KV = WSP(bf16_t, WS_KV); const bf16_t* KR = WSP(bf16_t, WS_KR); bf16_t* MIX = WSP(bf16_t, F.mix_off);
    for (int it = F.vcu; it < NB * NH * (SEQ / 256); it += F.G) {
        const int qb = it & 15, p = it >> 4, h = p & 7, b = p >> 3;
        const size_t t0 = (size_t)b * SEQ, q0 = t0 + (size_t)qb * 256;
        int t = F.tid; asm volatile("" : "+v"(t));
        att::attn_body<VAR>(Q + q0 * NQ + h * DQK, KV + t0 * NKV + h * 256, KR + t0 * 64, MIX + q0 * DM + DF + h * 128, SEQ, F.ldsg, t);
        __syncthreads();
    }
}
namespace fft {
using att::v_st; using att::v_rd_base; using att::v_rd_off; using att::tr_read; using att::crow;
constexpr int OPITCH = 272;
constexpr int F1_T = 0, F1_OUT = 16384, F1_END = F1_OUT + 128 * OPITCH;
constexpr int XPITCH = 528;
constexpr int F2_Z = 0, F2_XL = 32768, F2_YL = F2_XL + 64 * XPITCH, F2_D2 = F2_YL + 64 * XPITCH, F2_END = F2_D2 + 128 * OPITCH;
static_assert(F1_END <= RING_BYTES && F2_END <= RING_BYTES, "FFT LDS must fit the phase scratch");
}
__device__ __forceinline__ void fft1_fast(const Frame& F) {
    using namespace fft;
    const bf16_t* U = WSP(bf16_t, WS_U); const bf16_t* D1 = WSP(bf16_t, WS_D1); bf16_t* Z = WSP(bf16_t, WS_H);
    const int tid = F.tid, wid = tid >> 6, lane = tid & 63, r32 = lane & 31, hi = lane >> 5, half = wid & 1, cb = wid >> 1;
    char* lds = F.ldsg;
    bf16x8 bfr[2][4];
#pragma unroll
    for (int ri = 0; ri < 2; ++ri)
#pragma unroll
        for (int ks = 0; ks < 4; ++ks) bfr[ri][ks] = *(const bf16x8*)(D1 + (ri * 64 + half * 32 + r32) * 64 + 16 * ks + 8 * hi);
    const int sr = tid >> 4, sc = (tid & 15) * 8, vst0 = v_st(sr, sc), vst1 = v_st(32 + sr, sc);
    const int vb = (int)(uintptr_t)(lds + F1_T) + v_rd_base(lane) + cb * 512;
    const int s1p = half * 32 + r32;
    int it = F.bx; if (it >= NB * 64 * NG) return;
    bf16x8 u0, u1;
#define F1_LOAD(IT) do { const int g_ = (IT) & 7, s2_ = ((IT) >> 3) & 63, b_ = (IT) >> 9; const bf16_t* up = U + ((size_t)(b_ * SEQ + s2_)) * DF + g_ * 128 + sc; \
        u0 = __builtin_nontemporal_load((const bf16x8*)(up + (size_t)(64 * sr) * DF)); u1 = __builtin_nontemporal_load((const bf16x8*)(up + (size_t)(64 * (sr + 32)) * DF)); } while (0)
    F1_LOAD(it);
    for (; it < NB * 64 * NG; it += F.G) {
        const int g = it & 7, s2 = (it >> 3) & 63, b = it >> 9;
        *(bf16x8*)(lds + F1_T + vst0) = u0; *(bf16x8*)(lds + F1_T + vst1) = u1;
        __syncthreads();
        if (it + F.G < NB * 64 * NG) F1_LOAD(it + F.G);
        f32x16 acc0 = {}, acc1 = {};
        { const s16x4 l0 = tr_read<v_rd_off(0, 0, 0)>(vb), h0 = tr_read<v_rd_off(0, 0, 1)>(vb), l1 = tr_read<v_rd_off(0, 1, 0)>(vb), h1 = tr_read<v_rd_off(0, 1, 1)>(vb);
          const s16x4 l2 = tr_read<v_rd_off(0, 2, 0)>(vb), h2 = tr_read<v_rd_off(0, 2, 1)>(vb), l3 = tr_read<v_rd_off(0, 3, 0)>(vb), h3 = tr_read<v_rd_off(0, 3, 1)>(vb);
          asm volatile("s_waitcnt lgkmcnt(0)" ::: "memory"); __builtin_amdgcn_sched_barrier(0);
          acc0 = __builtin_amdgcn_mfma_f32_32x32x16_bf16(TRPK(l0, h0), bfr[0][0], acc0, 0, 0, 0); acc1 = __builtin_amdgcn_mfma_f32_32x32x16_bf16(TRPK(l0, h0), bfr[1][0], acc1, 0, 0, 0);
          acc0 = __builtin_amdgcn_mfma_f32_32x32x16_bf16(TRPK(l1, h1), bfr[0][1], acc0, 0, 0, 0); acc1 = __builtin_amdgcn_mfma_f32_32x32x16_bf16(TRPK(l1, h1), bfr[1][1], acc1, 0, 0, 0);
          acc0 = __builtin_amdgcn_mfma_f32_32x32x16_bf16(TRPK(l2, h2), bfr[0][2], acc0, 0, 0, 0); acc1 = __builtin_amdgcn_mfma_f32_32x32x16_bf16(TRPK(l2, h2), bfr[1][2], acc1, 0, 0, 0);
          acc0 = __builtin_amdgcn_mfma_f32_32x32x16_bf16(TRPK(l3, h3), bfr[0][3], acc0, 0, 0, 0); acc1 = __builtin_amdgcn_mfma_f32_32x32x16_bf16(TRPK(l3, h3), bfr[1][3], acc1, 0, 0, 0); }
        float st, ct; sincospif((float)(s2 * s1p) * (1.0f / 2048.0f), &st, &ct);
        char* o0 = lds + F1_OUT + s1p * OPITCH + (cb * 32 + 4 * hi) * 2; char* o1 = o0 + 64 * OPITCH;
#pragma unroll
        for (int q = 0; q < 4; ++q) { float zr[4], zi[4];
#pragma unroll
            for (int j = 0; j < 4; ++j) { const float yr = acc0[4 * q + j], yi = acc1[4 * q + j]; zr[j] = yr * ct + yi * st; zi[j] = yi * ct - yr * st; }
            *(u32x2*)(o0 + q * 16) = (u32x2){cvt_pk_bf16(zr[0], zr[1]), cvt_pk_bf16(zr[2], zr[3])};
            *(u32x2*)(o1 + q * 16) = (u32x2){cvt_pk_bf16(zi[0], zi[1]), cvt_pk_bf16(zi[2], zi[3])}; }
        __syncthreads();
#pragma unroll
        for (int i = 0; i < 4; ++i) { const int q = tid + 512 * i, row = q >> 4, c16 = q & 15, ri = row >> 6, sp = row & 63;
            const u32x4 v = *(const u32x4*)(lds + F1_OUT + row * OPITCH + c16 * 16);
            *(u32x4*)(Z + (((((size_t)(b * 64 + sp) * NG + g) * 2 + ri) * 64 + s2) * 128) + c16 * 8) = v; }
    }
#undef F1_LOAD
    __syncthreads();
}
__device__ __forceinline__ void fft2_fast(const Frame& F, int l) {
    using namespace fft;
    const bf16_t* Z = WSP(bf16_t, WS_H); const bf16_t* D2 = WSP(bf16_t, WS_D2); const bf16_t* wcat = WSP(bf16_t, WS_WCAT) + (size_t)l * NG * 128 * 256; bf16_t* MIX = WSP(bf16_t, F.mix_off);
    const int tid = F.tid, wid = tid >> 6, lane = tid & 63, r32 = lane & 31, hi = lane >> 5, cb = wid & 3, h2 = wid >> 2;
    char* lds = F.ldsg;
    int it = F.bx; if (it >= NB * 64 * NG) return;
#pragma unroll
    for (int i = 0; i < 4; ++i) { const int q = tid + 512 * i, row = q >> 4, c16 = q & 15; *(u32x4*)(lds + F2_D2 + row * OPITCH + c16 * 16) = *(const u32x4*)(D2 + row * 128 + c16 * 8); }
    const int sr = tid >> 4, sc = (tid & 15) * 8, vst0 = v_st(sr, sc), vst1 = v_st(32 + sr, sc);
    const int vb = (int)(uintptr_t)(lds + F2_Z) + v_rd_base(lane) + cb * 512;
    bf16x8 wfr[16]; int gcur = -1;
    bf16x8 z0, z1, z2, z3, g0, g1;
#define F2_LOAD(IT) do { const int g_ = (IT) & 7, sp_ = ((IT) >> 3) & 63, b_ = (IT) >> 9; const bf16_t* zp = Z + ((size_t)(b_ * 64 + sp_) * NG + g_) * (2 * 64 * 128) + sr * 128 + sc; \
        z0 = __builtin_nontemporal_load((const bf16x8*)(zp)); z1 = __builtin_nontemporal_load((const bf16x8*)(zp + 32 * 128)); z2 = __builtin_nontemporal_load((const bf16x8*)(zp + 64 * 128)); z3 = __builtin_nontemporal_load((const bf16x8*)(zp + 96 * 128)); \
        const bf16_t* mp = MIX + ((size_t)(b_ * SEQ + sp_ + 64 * (tid >> 4))) * DM + g_ * 128 + (tid & 15) * 8; g0 = __builtin_nontemporal_load((const bf16x8*)(mp)); g1 = __builtin_nontemporal_load((const bf16x8*)(mp + (size_t)(64 * 32) * DM)); } while (0)
    F2_LOAD(it);
    for (; it < NB * 64 * NG; it += F.G) {
        const int g = it & 7, sp = (it >> 3) & 63, b = it >> 9;
        if (g != gcur) { gcur = g;
#pragma unroll
            for (int ks = 0; ks < 16; ++ks) wfr[ks] = *(const bf16x8*)(wcat + (size_t)(g * 128 + cb * 32 + r32) * 256 + 16 * ks + 8 * hi); }
        *(bf16x8*)(lds + F2_Z + vst0) = z0; *(bf16x8*)(lds + F2_Z + vst1) = z1; *(bf16x8*)(lds + F2_Z + 16384 + vst0) = z2; *(bf16x8*)(lds + F2_Z + 16384 + vst1) = z3;
        const bf16x8 gg0 = g0, gg1 = g1;
        __syncthreads();
        if (it + F.G < NB * 64 * NG) F2_LOAD(it + F.G);
#if defined(FFT2_P1_NAIVE)
        { const bf16_t* Zb = Z + ((size_t)(b * 64 + sp) * NG + g) * (2 * 64 * 128);
          for (int i = 0; i < 32; ++i) { const int o = tid + 512 * i, c = o & 127, rr = o >> 7; float s_ = 0.f;
              for (int k = 0; k < 128; ++k) s_ += bf2f(D2[rr * 128 + k]) * bf2f(Zb[k * 128 + c]);
              *(bf16_t*)(lds + F2_XL + (rr & 63) * XPITCH + ((rr >> 6) * 128 + c) * 2) = f2bf(s_); } }
#else
        f32x16 x0 = {}, x1 = {};
        const char* d2p = lds + F2_D2 + (h2 * 32 + r32) * OPITCH + 16 * hi;
#pragma unroll
        for (int t = 0; t < 2; ++t) {
            const int vbt = vb + t * 16384;
            const s16x4 l0 = tr_read<v_rd_off(0, 0, 0)>(vbt), h0 = tr_read<v_rd_off(0, 0, 1)>(vbt), l1 = tr_read<v_rd_off(0, 1, 0)>(vbt), h1 = tr_read<v_rd_off(0, 1, 1)>(vbt);
            const s16x4 l2 = tr_read<v_rd_off(0, 2, 0)>(vbt), h2_ = tr_read<v_rd_off(0, 2, 1)>(vbt), l3 = tr_read<v_rd_off(0, 3, 0)>(vbt), h3 = tr_read<v_rd_off(0, 3, 1)>(vbt);
            bf16x8 e0[4], e1[4];
#pragma unroll
            for (int ks = 0; ks < 4; ++ks) { e0[ks] = *(const bf16x8*)(d2p + (t * 4 + ks) * 32); e1[ks] = *(const bf16x8*)(d2p + 64 * OPITCH + (t * 4 + ks) * 32); }
            asm volatile("s_waitcnt lgkmcnt(0)" ::: "memory"); __builtin_amdgcn_sched_barrier(0);
            x0 = __builtin_amdgcn_mfma_f32_32x32x16_bf16(TRPK(l0, h0), e0[0], x0, 0, 0, 0); x1 = __builtin_amdgcn_mfma_f32_32x32x16_bf16(TRPK(l0, h0), e1[0], x1, 0, 0, 0);
            x0 = __builtin_amdgcn_mfma_f32_32x32x16_bf16(TRPK(l1, h1), e0[1], x0, 0, 0, 0); x1 = __builtin_amdgcn_mfma_f32_32x32x16_bf16(TRPK(l1, h1), e1[1], x1, 0, 0, 0);
            x0 = __builtin_amdgcn_mfma_f32_32x32x16_bf16(TRPK(l2, h2_), e0[2], x0, 0, 0, 0); x1 = __builtin_amdgcn_mfma_f32_32x32x16_bf16(TRPK(l2, h2_), e1[2], x1, 0, 0, 0);
            x0 = __builtin_amdgcn_mfma_f32_32x32x16_bf16(TRPK(l3, h3), e0[3], x0, 0, 0, 0); x1 = __builtin_amdgcn_mfma_f32_32x32x16_bf16(TRPK(l3, h3), e1[3], x1, 0, 0, 0);
        }
        { char* xr = lds + F2_XL + (h2 * 32 + r32) * XPITCH + (cb * 32 + 4 * hi) * 2;
#pragma unroll
          for (int q = 0; q < 4; ++q) { *(u32x2*)(xr + q * 16) = (u32x2){cvt_pk_bf16(x0[4 * q], x0[4 * q + 1]), cvt_pk_bf16(x0[4 * q + 2], x0[4 * q + 3])};
              *(u32x2*)(xr + 256 + q * 16) = (u32x2){cvt_pk_bf16(x1[4 * q], x1[4 * q + 1]), cvt_pk_bf16(x1[4 * q + 2], x1[4 * q + 3])}; } }
#endif
        __syncthreads();
#if defined(FFT2_P2_NAIVE)
        for (int i = 0; i < 16; ++i) { const int o = tid + 512 * i, d = o & 127, s2p = o >> 7; float s_ = 0.f;
            const bf16_t* wr_ = wcat + (size_t)(g * 128 + d) * 256;
            for (int k = 0; k < 256; ++k) s_ += bf2f(*(const bf16_t*)(lds + F2_XL + s2p * XPITCH + k * 2)) * bf2f(wr_[k]);
            *(float*)(lds + F2_YL + s2p * XPITCH + d * 4) = s_; }
#else
        f32x16 y = {};
        { const char* xb = lds + F2_XL + (h2 * 32 + r32) * XPITCH + 16 * hi;
#pragma unroll
          for (int ks = 0; ks < 16; ++ks) { const bf16x8 xf = *(const bf16x8*)(xb + ks * 32); y = __builtin_amdgcn_mfma_f32_32x32x16_bf16(wfr[ks], xf, y, 0, 0, 0); } }
        { char* yr = lds + F2_YL + (h2 * 32 + r32) * XPITCH + (cb * 32 + 4 * hi) * 4;
#pragma unroll
          for (int q = 0; q < 4; ++q) *(f32x4*)(yr + q * 32) = (f32x4){y[4 * q], y[4 * q + 1], y[4 * q + 2], y[4 * q + 3]}; }
#endif
        __syncthreads();
#pragma unroll
        for (int i = 0; i < 2; ++i) { const int row = (tid >> 4) + 32 * i, c8 = (tid & 15) * 8; const bf16x8 gv = i ? gg1 : gg0;
            const f32x4 ya = *(const f32x4*)(lds + F2_YL + row * XPITCH + c8 * 4), yb = *(const f32x4*)(lds + F2_YL + row * XPITCH + c8 * 4 + 16);
            f32x4 ga = {bf2f((bf16_t)gv[0]), bf2f((bf16_t)gv[1]), bf2f((bf16_t)gv[2]), bf2f((bf16_t)gv[3])}, gb = {bf2f((bf16_t)gv[4]), bf2f((bf16_t)gv[5]), bf2f((bf16_t)gv[6]), bf2f((bf16_t)gv[7])};
            store8_bf16(MIX + ((size_t)(b * SEQ + sp + 64 * row)) * DM + g * 128 + c8, ya * ga, yb * gb); }
    }
#undef F2_LOAD
    __syncthreads();
}
#if PROBE_CHECK
constexpr size_t WS_CHK_GATE = WS_U;
constexpr size_t WS_CHK_CNT = WS_CTL + 15 * 1024;
__device__ __forceinline__ int chk_tok(int i) { return (i * 64 + 37 + (i >> 2) * 4096 / 64 * 0) % MTOK + ((i & 3) * 4096) - ((i & 3) * 4096); }
__device__ __forceinline__ void chk_fail(const Frame& F, float a, float b, float atol, float rtol) { if (!(fabsf(a - b) <= atol + rtol * fabsf(b))) atomicAdd(WSP(unsigned, WS_CHK_CNT), 1u); }
__device__ __forceinline__ void chk_proj(const Frame& F, int l) {
    LAS float* hs = (LAS float*)F.lds;
    LAS float* cs = hs + 2048;
    LAS float* red = cs + 832;
    const float* x = l == 0 ? F.in[0] : WSP(float, WS_R); const float* mod = WSP(float, WS_MOD) + (size_t)l * NB * 3 * DM; const float* w_in = F.in[5] + (size_t)l * DM * NIN;
    for (int i = F.bx; i < 256; i += F.G) {
        const int tok = 64 * i + 37, b = tok >> 12, tid = F.tid;
        float s = 0.f; for (int k = tid; k < DM; k += NTHREADS) s += x[(size_t)tok * DM + k];
        s = wave_sum(s); if (F.lane == 0) red[F.wave] = s; __syncthreads(); float mean = 0.f; for (int w = 0; w < 8; ++w) mean += red[w]; mean *= (1.0f / DM); __syncthreads();
        float q2 = 0.f; for (int k = tid; k < DM; k += NTHREADS) { const float d = x[(size_t)tok * DM + k] - mean; q2 += d * d; }
        q2 = wave_sum(q2); if (F.lane == 0) red[F.wave] = q2; __syncthreads(); float var = 0.f; for (int w = 0; w < 8; ++w) var += red[w]; const float rstd = rsqrtf(var * (1.0f / DM) + NORM_EPS); __syncthreads();
        for (int k = tid; k < DM; k += NTHREADS) hs[k] = bf2f(f2bf((x[(size_t)tok * DM + k] - mean) * rstd * (1.0f + mod[(size_t)b * 3 * DM + DM + k]) + mod[(size_t)b * 3 * DM + k]));
        __syncthreads();
        for (int c = tid; c < 832; c += NTHREADS) { float a = 0.f; for (int k = 0; k < DM; ++k) a += hs[k] * bf2f(f2bf(w_in[(size_t)k * NIN + 2048 + c])); cs[c] = a; }
        __syncthreads();
        float sq = 0.f; for (int c = tid; c < 512; c += NTHREADS) sq += cs[c] * cs[c];
        sq = wave_sum(sq); if (F.lane == 0) red[F.wave] = sq; __syncthreads(); float sq_q = 0.f; for (int w = 0; w < 8; ++w) sq_q += red[w]; __syncthreads();
        float sk = 0.f; for (int c = 512 + tid; c < 768; c += NTHREADS) sk += cs[c] * cs[c];
        sk = wave_sum(sk); if (F.lane == 0) red[F.wave] = sk; __syncthreads(); float sq_k = 0.f; for (int w = 0; w < 8; ++w) sq_k += red[w]; __syncthreads();
        const float rq = rsqrtf(sq_q * (1.0f / QLR) + NORM_EPS), rk = rsqrtf(sq_k * (1.0f / KVLR) + NORM_EPS);
        const float* rc = WSP(float, WS_RCOS) + (size_t)tok * 32; const float* rs = WSP(float, WS_RSIN) + (size_t)tok * 32;
        const int pos = ((const int*)F.in[2])[tok];
        if (tid < 32) { const float ang = (float)pos * powf(10000.0f, -(float)tid / 32.0f); const float c_ = cosf(ang), s_ = sinf(ang); const float x1 = cs[768 + tid], x2 = cs[800 + tid];
            chk_fail(F, bf2f(WSP(bf16_t, WS_KR)[(size_t)tok * 64 + tid]), x1 * c_ - x2 * s_, 0.05f, 0.05f); chk_fail(F, bf2f(WSP(bf16_t, WS_KR)[(size_t)tok * 64 + 32 + tid]), x2 * c_ + x1 * s_, 0.05f, 0.05f);
            chk_fail(F, rc[tid], c_, 0.02f, 0.f); chk_fail(F, rs[tid], s_, 0.02f, 0.f); }
        const float* wq = F.in[7] + (size_t)l * QLR * NQ; const float* gq = F.in[6] + l * QLR;
        for (int n = tid; n < NQ; n += NTHREADS) { const int head = n / DQK, d = n - head * DQK; if (d >= 160) continue;
            float a = 0.f, a2 = 0.f; for (int k = 0; k < QLR; ++k) { const float cn = bf2f(f2bf(cs[k])) * rq * gq[k]; a += cn * wq[(size_t)k * NQ + n]; if (d >= 128) a2 += cn * wq[(size_t)k * NQ + n + 32]; }
            if (d < 128) chk_fail(F, bf2f(WSP(bf16_t, WS_Q)[(size_t)tok * NQ + n]), a, 0.06f, 0.05f);
            else { const int ii = d - 128; const float ang = (float)pos * powf(10000.0f, -(float)ii / 32.0f); const float c_ = cosf(ang), s_ = sinf(ang);
                chk_fail(F, bf2f(WSP(bf16_t, WS_Q)[(size_t)tok * NQ + n]), a * c_ - a2 * s_, 0.06f, 0.05f); chk_fail(F, bf2f(WSP(bf16_t, WS_Q)[(size_t)tok * NQ + n + 32]), a2 * c_ + a * s_, 0.06f, 0.05f); } }
        const float* wk = F.in[9] + (size_t)l * KVLR * NKV; const float* gk = F.in[8] + l * KVLR;
        for (int n = tid; n < NKV; n += NTHREADS) { float a = 0.f; for (int k = 0; k < KVLR; ++k) a += bf2f(f2bf(cs[512 + k])) * rk * gk[k] * wk[(size_t)k * NKV + n];
            chk_fail(F, bf2f(WSP(bf16_t, WS_KV)[(size_t)tok * NKV + n]), a, 0.06f, 0.05f); }
        for (int c = tid; c < 1024; c += NTHREADS) WSP(bf16_t, WS_CHK_GATE)[(size_t)i * 1024 + c] = WSP(bf16_t, WS_MIX)[(size_t)tok * DM + DF + c];
        __syncthreads();
    }
}
__device__ __forceinline__ void chk_attn(const Frame& F) {
    const bf16_t* Q = WSP(bf16_t, WS_Q); const bf16_t* KV = WSP(bf16_t, WS_KV); const bf16_t* KR = WSP(bf16_t, WS_KR); const bf16_t* MIX = WSP(bf16_t, WS_MIX);
    LAS float* qs = (LAS float*)F.lds + F.wave * 192;
    for (int i = F.bx; i < 256; i += F.G) {
        const int tok = 64 * i + 37, b = tok >> 12, h = F.wave;
        for (int dh = 0; dh < 2; ++dh) {
            __builtin_amdgcn_wave_barrier(); asm volatile("" ::: "memory");
            for (int e = 0; e < 3; ++e) qs[F.lane + 64 * e] = bf2f(Q[(size_t)tok * NQ + h * DQK + F.lane + 64 * e]);
            asm volatile("s_waitcnt lgkmcnt(0)" ::: "memory"); __builtin_amdgcn_wave_barrier();
            float m = -1e30f, lsum = 0.f; float o[64];
#pragma unroll
            for (int d = 0; d < 64; ++d) o[d] = 0.f;
            for (int t = 0; t < 64; ++t) {
                const size_t key = (size_t)b * SEQ + F.lane + 64 * t; const bf16_t* kn = KV + key * NKV + h * 256; const bf16_t* kr = KR + key * 64;
                float s = 0.f;
#pragma unroll 2
                for (int c = 0; c < 16; ++c) { const bf16x8 kv = *(const bf16x8*)(kn + c * 8);
#pragma unroll
                    for (int e = 0; e < 8; ++e) s += qs[c * 8 + e] * bf2f((bf16_t)kv[e]); }
#pragma unroll 2
                for (int c = 0; c < 8; ++c) { const bf16x8 kv = *(const bf16x8*)(kr + c * 8);
#pragma unroll
                    for (int e = 0; e < 8; ++e) s += qs[128 + c * 8 + e] * bf2f((bf16_t)kv[e]); }
                s *= ATT_SCALE; const float mn = fmaxf(m, s), a = __expf(m - mn), p = __expf(s - mn); lsum = lsum * a + p; m = mn;
#pragma unroll
                for (int c = 0; c < 8; ++c) { const bf16x8 vv = *(const bf16x8*)(kn + 128 + dh * 64 + c * 8);
#pragma unroll
                    for (int e = 0; e < 8; ++e) o[c * 8 + e] = o[c * 8 + e] * a + p * bf2f((bf16_t)vv[e]); }
            }
            const float Mx = wave_max(m), f = __expf(m - Mx); const float Ls = wave_sum(lsum * f);
            float keep0 = 0.f;
#pragma unroll
            for (int d = 0; d < 64; ++d) { const float od = wave_sum(o[d] * f); if (F.lane == d) keep0 = od; }
            const int col = h * 128 + dh * 64 + F.lane;
            const float ref = keep0 / Ls * bf2f(WSP(bf16_t, WS_CHK_GATE)[(size_t)i * 1024 + col]);
            chk_fail(F, bf2f(MIX[(size_t)tok * DM + DF + col]), ref, 1.5e-3f, 0.05f);
        }
    }
}
__device__ __forceinline__ void chk_finish(const Frame& F) {
    if (F.bx == 0 && F.tid == 0 && __hip_atomic_load(WSP(unsigned, WS_CHK_CNT), __ATOMIC_RELAXED, __HIP_MEMORY_SCOPE_AGENT) != 0u) { for (int k = 0; k < 64; ++k) F.out[k] = __builtin_nanf(""); }
}
#endif
#ifndef DIAG_ONLY
#define DIAG_ONLY -1
#endif
#define DIAG_EN(k) (DIAG_ONLY < 0 || DIAG_ONLY == (k))
#ifndef PROBE_CHECK
#define PROBE_CHECK 0
#endif
#ifndef PROBE_VAR
#define PROBE_VAR 0
#endif
#ifndef PROBE_REP
#define PROBE_REP -1
#endif
struct Args { const float* in[14]; float* out; unsigned char* ws; int ph_lo, ph_hi; };
constexpr int N_PHASES = 2 + 5 * DEPTH;

template <class Epi, class Sched> __device__ __forceinline__ void run_gemm(const Frame& F, const pg8::Gemm& g, const Sched& S, const Epi& E) {
#if IMPL_GEMM
    pg8::gemm_phase<Epi, Sched, PG8_ALIGN, PG8_SP2>(F.lds, g, S, E, F.tid);
#else
    pg8::gemm_phase_naive<Epi, Sched>(g, S, E, F.tid);
#endif
}

#define PH_IN(k) (lo <= (k) && (k) < hi)
#define PH_SEAM(k) do { if (PH_IN(k) && PH_IN((k) + 1)) xcd_barrier(bar); } while (0)
#define PH_ENTER() do { int _t = threadIdx.x; asm volatile("" : "+v"(_t)); F.tid = _t; F.lane = _t & 63; } while (0)

template <int L> __device__ __forceinline__ void layer_phases(Frame& F, const int lo, const int hi, const XcdBarrier& bar) {
    constexpr int P = 2 + 5 * L;
    float* rsq = WSP(float, WS_RSQ) + (size_t)L * MTOK * 2;
    if (PH_IN(P + 0) && DIAG_EN(2)) {
        PH_ENTER();
        pg8::Gemm g{WSP(bf16_t, WS_H), WSP(bf16_t, WS_WIN) + (size_t)L * NINP * DM, MTOK, NINP, DM};
        pg8::StaticOrder S; S.init(MTOK, NINP, F.G, F.bx);
        EpiIn E{WSP(bf16_t, WS_U), WSP(bf16_t, WS_MIX), WSP(bf16_t, WS_CQ), WSP(bf16_t, WS_CKV), WSP(bf16_t, WS_KR), rsq, WSP(float, WS_RCOS), WSP(float, WS_RSIN)};
        run_gemm(F, g, S, E);
        if (PROBE_REP == 2 && L == 0) { xcd_barrier(bar); EpiIn E2 = E; E2.rsq = WSP(float, WS_R); run_gemm(F, g, S, E2); }
        if (PROBE_REP == 12 && L == 0) { xcd_barrier(bar); EpiNone E2; run_gemm(F, g, S, E2); }
    }
    PH_SEAM(P + 0);
    if (PH_IN(P + 1) && DIAG_EN(3)) {
        PH_ENTER();
        { pg8::Gemm g{WSP(bf16_t, WS_CQ), WSP(bf16_t, WS_WQ) + (size_t)L * NQ * QLR, MTOK, NQ, QLR};
          pg8::SplitOrder S; S.init(F.G, F.bx, NQ / 256, 0);
          EpiQ E{WSP(bf16_t, WS_Q), rsq, WSP(float, WS_RCOS), WSP(float, WS_RSIN)};
          run_gemm(F, g, S, E); }
        { pg8::Gemm g{WSP(bf16_t, WS_CKV), WSP(bf16_t, WS_WKV) + (size_t)L * NKV * KVLR, MTOK, NKV, KVLR};
          pg8::SplitOrder S; S.init(F.G, F.bx, NKV / 256, 1);
          EpiKV E{WSP(bf16_t, WS_KV), rsq};
          run_gemm(F, g, S, E); }
        if (PROBE_REP == 3 && L == 0) { xcd_barrier(bar);
          { pg8::Gemm g{WSP(bf16_t, WS_CQ), WSP(bf16_t, WS_WQ) + (size_t)L * NQ * QLR, MTOK, NQ, QLR}; pg8::SplitOrder S; S.init(F.G, F.bx, NQ / 256, 0); EpiQ E{WSP(bf16_t, WS_Q), rsq, WSP(float, WS_RCOS), WSP(float, WS_RSIN)}; run_gemm(F, g, S, E); }
          { pg8::Gemm g{WSP(bf16_t, WS_CKV), WSP(bf16_t, WS_WKV) + (size_t)L * NKV * KVLR, MTOK, NKV, KVLR}; pg8::SplitOrder S; S.init(F.G, F.bx, NKV / 256, 1); EpiKV E{WSP(bf16_t, WS_KV), rsq}; run_gemm(F, g, S, E); } }
#if IMPL_FFT & 1
        fft1_fast(F);
#else
        fft1_naive(F);
#endif
        if (PROBE_REP == 7 && L == 0) { xcd_barrier(bar); fft1_fast(F); }
    }
    PH_SEAM(P + 1);
#if PROBE_CHECK
    if (L == PROBE_CHECK - 1 && PH_IN(P + 2)) { PH_ENTER(); chk_proj(F, L); __syncthreads(); }
#endif
    if (PH_IN(P + 2) && DIAG_EN(4)) {
        PH_ENTER();
#if IMPL_ATTN
        attn_fast(F);
        if (PROBE_REP == 4 && L == 0) { __syncthreads(); F.mix_off = WS_R; attn_fast<PROBE_VAR>(F); F.mix_off = WS_MIX; }
#else
        attn_naive(F);
#endif
        __syncthreads();
#if IMPL_FFT & 2
        fft2_fast(F, L);
        if (PROBE_REP == 8 && L == 0) { __syncthreads(); F.mix_off = WS_R; fft2_fast(F, L); F.mix_off = WS_MIX; }
#else
        fft2_naive(F, L);
#endif
    }
    PH_SEAM(P + 2);
#if PROBE_CHECK
    if (L == PROBE_CHECK - 1 && PH_IN(P + 3)) { PH_ENTER(); chk_attn(F); __syncthreads(); }
#endif
    if (PH_IN(P + 3) && DIAG_EN(5)) {
        PH_ENTER();
        pg8::Gemm g{WSP(bf16_t, WS_MIX), WSP(bf16_t, WS_WOUT) + (size_t)L * DM * DM, MTOK, DM, DM};
        pg8::StaticOrder S; S.init(MTOK, DM, F.G, F.bx);
        EpiOut E{WSP(bf16_t, WS_H), WSP(float, WS_MOD) + (size_t)L * NB * (3 * DM) + 2 * DM};
        run_gemm(F, g, S, E);
        if (PROBE_REP == 5 && L == 0) { xcd_barrier(bar); run_gemm(F, g, S, E); }
        if (PROBE_REP == 15 && L == 0) { xcd_barrier(bar); EpiNone E2; run_gemm(F, g, S, E2); }
    }
    PH_SEAM(P + 3);
    if (PH_IN(P + 4) && DIAG_EN(6)) {
        PH_ENTER();
        if (L + 1 < DEPTH) p_ln_post<true>(F, L); else p_ln_post<false>(F, L);
        if (PROBE_REP == 6 && L + 1 == DEPTH) { xcd_barrier(bar); p_ln_post<false>(F, L); }
    }
    PH_SEAM(P + 4);
}

__global__ void __launch_bounds__(NTHREADS, 2) fwd_kernel(Args args) {
    extern __shared__ __attribute__((aligned(16))) unsigned char lds[];
    Frame F;
    F.in[0] = args.in[0]; F.in[1] = args.in[1]; F.in[2] = args.in[2]; F.in[3] = args.in[3]; F.in[4] = args.in[4]; F.in[5] = args.in[5]; F.in[6] = args.in[6]; F.in[7] = args.in[7]; F.in[8] = args.in[8]; F.in[9] = args.in[9]; F.in[10] = args.in[10]; F.in[11] = args.in[11]; F.in[12] = args.in[12]; F.in[13] = args.in[13];
    F.out = args.out; F.ws = args.ws; F.lds = (LAS unsigned char*)lds; F.ldsg = (char*)lds;
    F.tid = threadIdx.x; F.lane = F.tid & 63; F.wave = __builtin_amdgcn_readfirstlane(F.tid >> 6); F.G = gridDim.x; F.bx = blockIdx.x;
    F.vcu = (F.G % 8 == 0) ? (F.bx % 8) * (F.G / 8) + F.bx / 8 : F.bx; F.mix_off = WS_MIX;
    volatile LAS unsigned* MISC = (volatile LAS unsigned*)(F.lds + MISC_OFF);
    if (F.tid < 64) MISC[F.tid] = 0u;
    __syncthreads();
    const int lo = args.ph_lo, hi = args.ph_hi;
    XcdBarrier bar; bar.bar = WSP(unsigned, WS_CTL); bar.x = 0; bar.st = MISC;
    if (hi - lo > 1) bar = xcd_barrier_post(WSP(unsigned, WS_CTL), MISC);
    if (PH_IN(0) && DIAG_EN(0)) { PH_ENTER(); p0_weights(F); p0_mod(F); p0_tables(F); if (PROBE_REP == 0) { xcd_barrier(bar); p0_weights(F); p0_mod(F); p0_tables(F); } }
    PH_SEAM(0);
    if (PH_IN(1) && DIAG_EN(1)) { PH_ENTER(); p_ln_first(F); if (PROBE_REP == 1) { xcd_barrier(bar); p_ln_first(F); } }
    PH_SEAM(1);
    layer_phases<0>(F, lo, hi, bar);
    layer_phases<1>(F, lo, hi, bar);
#if PROBE_CHECK
    xcd_barrier(bar); chk_finish(F);
#endif
}

extern "C" void kernel_launch(void* const* d_in, const int* in_sizes, int n_in, void* d_out, int out_size, void* d_ws, size_t ws_size, hipStream_t stream) {
    static int grid = 0;
    if (grid == 0) {
        if (n_in != 14 || in_sizes[0] != MTOK * DM || out_size != MTOK * DM || ws_size < WS_END) {
            fprintf(stderr, "kernel_launch: shape mismatch (n_in %d, in0 %d, out %d, ws %zu, need ws >= %zu); nothing launched\n", n_in, n_in > 0 ? in_sizes[0] : -1, out_size, ws_size, (size_t)WS_END); grid = -1; return; }
        int dev = 0, cus = 0, per_cu = 0;
        if (hipGetDevice(&dev) != hipSuccess || hipDeviceGetAttribute(&cus, hipDeviceAttributeMultiprocessorCount, dev) != hipSuccess) { grid = -1; return; }
        if (hipFuncSetAttribute((const void*)fwd_kernel, hipFuncAttributeMaxDynamicSharedMemorySize, LDS_BYTES) != hipSuccess) { fprintf(stderr, "kernel_launch: hipFuncSetAttribute failed\n"); grid = -1; return; }
        if (hipOccupancyMaxActiveBlocksPerMultiprocessor(&per_cu, (const void*)fwd_kernel, NTHREADS, LDS_BYTES) != hipSuccess || per_cu < 1) { fprintf(stderr, "kernel_launch: occupancy query failed (%d)\n", per_cu); (void)hipGetLastError(); per_cu = 1; }
        if (per_cu > 1) per_cu = 1;
        grid = cus * per_cu;
    }
    if (grid < 0) return;
    if (hipMemsetAsync((char*)d_ws + WS_CTL, 0, WS_RSQ - WS_CTL, stream) != hipSuccess) { fprintf(stderr, "kernel_launch: hipMemsetAsync failed\n"); return; }
    Args a{};
    for (int i = 0; i < 14; ++i) a.in[i] = (const float*)d_in[i];
    a.out = (float*)d_out; a.ws = (unsigned char*)d_ws;
#if N_LAUNCH_MODE
    a.ph_lo = 0; a.ph_hi = N_PHASES;
    hipLaunchKernelGGL(fwd_kernel, dim3(grid), dim3(NTHREADS), LDS_BYTES, stream, a);
#else
    for (int ph = 0; ph < N_PHASES; ++ph) { a.ph_lo = ph; a.ph_hi = ph + 1; hipLaunchKernelGGL(fwd_kernel, dim3(grid), dim3(NTHREADS), LDS_BYTES, stream, a); }
#endif
    const hipError_t le = hipPeekAtLastError();
    if (le != hipSuccess) fprintf(stderr, "kernel_launch: launch failed: %s (grid %d)\n", hipGetErrorName(le), grid);
}
```

```cpp
#define IMPL_GEMM 1
#define IMPL_ATTN 1
#define IMPL_FFT 3
#define N_LAUNCH_MODE 1
#include <hip/hip_runtime.h>
#include <cstdio>
#include <cstdint>

#ifndef PROBE_CHECK
#define PROBE_CHECK 0
#endif
#ifndef N_LAUNCH_MODE
#define N_LAUNCH_MODE 1
#endif
#ifndef IMPL_GEMM
#define IMPL_GEMM 1
#endif
#ifndef IMPL_ATTN
#define IMPL_ATTN 1
#endif
#ifndef IMPL_FFT
#define IMPL_FFT 3
#endif

#define LAS __attribute__((address_space(3)))
typedef unsigned short bf16_t;
typedef short bf16x8 __attribute__((ext_vector_type(8)));
typedef short s16x4 __attribute__((ext_vector_type(4)));
typedef float f32x4 __attribute__((ext_vector_type(4)));
typedef float f32x2 __attribute__((ext_vector_type(2)));
typedef float f32x16 __attribute__((ext_vector_type(16)));
typedef unsigned u32x4 __attribute__((ext_vector_type(4)));
typedef unsigned u32x2 __attribute__((ext_vector_type(2)));

constexpr int NB = 4, SEQ = 4096, DM = 2048, MTOK = NB * SEQ, DEPTH = 2;
constexpr int DF = 1024, NG = 8, GD = 128, NH = 8, DV = 128, DNOPE = 128, DROPE = 64, DQK = 192, QLR = 512, KVLR = 256;
constexpr int NIN = 3904, NINP = 4096;
constexpr int NQ = NH * DQK  , NKV = NH * (DNOPE + DV)  ;
constexpr float NORM_EPS = 1e-6f;
constexpr float DN_ALPHA = 1.4142135623730951f;
constexpr float ATT_SCALE = 0.07216878364870322f;

__device__ __forceinline__ float bf2f(bf16_t b) { return __uint_as_float(((unsigned)b) << 16); }
__device__ __forceinline__ bf16_t f2bf(float f) { unsigned u = __float_as_uint(f); u += 0x7FFFu + ((u >> 16) & 1u); return (bf16_t)(u >> 16); }
typedef __bf16 bf16v2_t __attribute__((ext_vector_type(2)));
__device__ __forceinline__ unsigned cvt_pk_bf16(float lo, float hi) { const f32x2 v = {lo, hi}; return __builtin_bit_cast(unsigned, __builtin_convertvector(v, bf16v2_t)); }
__device__ __forceinline__ float silu_f(float z) { return z * __builtin_amdgcn_rcpf(1.0f + __builtin_amdgcn_exp2f(-1.4426950408889634f * z)); }
__device__ __forceinline__ float wave_sum(float v) { for (int o = 32; o > 0; o >>= 1) v += __shfl_xor(v, o); return v; }
__device__ __forceinline__ float wave_max(float v) { for (int o = 32; o > 0; o >>= 1) v = fmaxf(v, __shfl_xor(v, o)); return v; }

constexpr size_t al256(size_t x) { return (x + 255) / 256 * 256; }
constexpr size_t WS_CTL  = 0;
constexpr size_t CTL_BYTES = 16384;
constexpr size_t WS_MOD  = WS_CTL + CTL_BYTES;
constexpr size_t WS_RSQ  = WS_MOD + al256((size_t)DEPTH * NB * 3 * DM * 4);
constexpr size_t WS_RCOS = WS_RSQ + al256((size_t)DEPTH * MTOK * 2 * 4);
constexpr size_t WS_RSIN = WS_RCOS + (size_t)MTOK * 32 * 4;
constexpr size_t WS_D1   = WS_RSIN + (size_t)MTOK * 32 * 4;
constexpr size_t WS_D2   = WS_D1 + 128 * 64 * 2;
constexpr size_t WS_WCAT = WS_D2 + 128 * 128 * 2;
constexpr size_t WS_WIN  = WS_WCAT + (size_t)DEPTH * NG * 128 * 256 * 2;
constexpr size_t WS_WOUT = WS_WIN + (size_t)DEPTH * NINP * DM * 2;
constexpr size_t WS_WQ   = WS_WOUT + (size_t)DEPTH * DM * DM * 2;
constexpr size_t WS_WKV  = WS_WQ + (size_t)DEPTH * NQ * QLR * 2;
constexpr size_t WS_H    = WS_WKV + (size_t)DEPTH * NKV * KVLR * 2;
constexpr size_t WS_U    = WS_H + (size_t)MTOK * DM * 2;
constexpr size_t WS_MIX  = WS_U + (size_t)MTOK * DF * 2;
constexpr size_t WS_CQ   = WS_MIX + (size_t)MTOK * DM * 2;
constexpr size_t WS_CKV  = WS_CQ + (size_t)MTOK * QLR * 2;
constexpr size_t WS_KR   = WS_CKV + (size_t)MTOK * KVLR * 2;
constexpr size_t WS_Q    = WS_KR + (size_t)MTOK * 64 * 2;
constexpr size_t WS_KV   = WS_Q + (size_t)MTOK * NQ * 2;
constexpr size_t WS_R    = WS_KV + (size_t)MTOK * NKV * 2;
constexpr size_t WS_END  = WS_R + (size_t)MTOK * DM * 4;
static_assert(WS_END <= (size_t)4 * MTOK * DM * 4, "workspace map exceeds 4 x largest tensor");

constexpr int RING_BYTES = 155648, MISC_OFF = RING_BYTES, LDS_BYTES = RING_BYTES + 256;
constexpr int NTHREADS = 512;

namespace pg8 {
#define PG8_LAS __attribute__((address_space(3)))
constexpr int BM = 256, BK = 64, HALF = 128, HTB = HALF * BK * 2  , STAGE_BYTES = 8 * HTB, NXCD = 8, WGM = 8;
static_assert(STAGE_BYTES <= RING_BYTES, "GEMM stage ring must fit the LDS phase scratch");

__host__ __device__ __forceinline__ int lds_byte(int r, int c) { const int st = (r >> 4) * 2 + (c >> 5), rr = r & 15, cc = c & 31, ob = rr * 64 + cc * 2; return st * 1024 + (ob ^ (((ob >> 9) & 1) << 5)); }
__host__ __device__ __forceinline__ void stage_rc(int b, int& R, int& C) { const int st = b / 1024, sb = b % 1024, swz = sb ^ (((sb >> 9) & 1) << 5); R = (st >> 1) * 16 + swz / 64; C = (st & 1) * 32 + (swz % 64) / 2; }
__host__ __device__ __forceinline__ int perm32(int rho) { const int n = rho >> 4, i = rho & 15; return 8 * (i >> 2) + 4 * n + (i & 3); }

struct Unit { int pm, pn; };
struct Gemm { const bf16_t* A; const bf16_t* Bt; int M, N, K; };

struct StaticOrder {
    int nM, nN, nwg, G, c;
    __host__ __device__ void init(int M, int N, int G_, int c_) { nM = M / BM; nN = N / BM; nwg = nM * nN; G = G_; c = c_; }
    __host__ __device__ bool next(int i, Unit& u) const {
        const long L = (long)i * G + c; if (L >= nwg) return false;
        int wgid = (int)L; { const int q = nwg / NXCD, r = nwg % NXCD, xcd = wgid % NXCD, off = wgid / NXCD; wgid = (xcd < r ? xcd * (q + 1) : r * (q + 1) + (xcd - r) * q) + off; }
        const int nig = WGM * nN, gid = wgid / nig, fm = gid * WGM, gsz = (nM - fm) < WGM ? (nM - fm) : WGM;
        u.pm = fm + ((wgid % nig) % gsz); u.pn = (wgid % nig) / gsz; return true;
    }
    __device__ __forceinline__ void a_ready(const Unit&) const {}
    __device__ __forceinline__ void done(const Unit&) const {}
};
struct HotOrder : StaticOrder { int pm0, pn0; __device__ bool next(int i, Unit& u) const { Unit t; if (!StaticOrder::next(i, t)) return false; u.pm = pm0; u.pn = pn0; return true; } };
struct SplitOrder {
    int G, c, nN, kind;
    __device__ void init(int G_, int c_, int nN_, int kind_) { G = G_; c = c_; nN = nN_; kind = kind_; }
    __device__ bool next(int i, Unit& u) const {
        if (G != 256) { const int L = i * G + c; if (L >= 64 * nN) return false; u.pm = L / nN; u.pn = L % nN; return true; }
        const int x = c & 7, v = c >> 3; int li;
        if (kind == 0) { if (v < 16) { if (i >= 2) return false; li = 2 * v + i; } else { if (i >= 1) return false; li = 32 + (v - 16); } }
        else           { if (v < 16) { if (i >= 1) return false; li = v; } else { if (i >= 3) return false; li = 16 + 3 * (v - 16) + i; } }
        u.pm = 8 * x + li / nN; u.pn = li % nN; return true;
    }
    __device__ __forceinline__ void a_ready(const Unit&) const {}
    __device__ __forceinline__ void done(const Unit&) const {}
};
template <class Epi, class Sched, bool ALIGN_EPI = false, bool SP2 = false>
__device__ __forceinline__ void gemm_phase(PG8_LAS unsigned char* lds, const Gemm g, const Sched& S, const Epi& E, const int tid) {
    const int wid = __builtin_amdgcn_readfirstlane(tid >> 6), lane = tid & 63, wr = wid >> 2, wc = wid & 3, fr = lane & 15, fq = lane >> 4;
    const int K = g.K, nt = K / BK;
    unsigned voffA[2], voffB[2];
#pragma unroll
    for (int i = 0; i < 2; ++i) { int R, C; stage_rc(tid * 16 + i * 8192, R, C); const int Rb = Epi::PERM ? ((R & ~31) + perm32(R & 31)) : R;
        voffA[i] = (unsigned)(R * K + C) * 2u; voffB[i] = (unsigned)(Rb * K + C) * 2u; }
    const size_t kstep = (size_t)(BK * 2);
    const size_t hstep = (size_t)HALF * K * 2;
    const size_t tstep = 2 * hstep;
    const unsigned ldsw = (unsigned)wid * 1024u;
    const int aoff = lds_byte(wr * 64 + fr, fq * 8), boff = lds_byte(wc * 32 + fr, fq * 8);
#define PG8_SA(b, h) (((b) * 2 + (h)) * HTB)
#define PG8_SB(b, h) ((4 + (b) * 2 + (h)) * HTB)
#define PG8_STAGE(bufoff, gbase, voff) do { _Pragma("unroll") for (int _i = 0; _i < 2; ++_i) \
        __builtin_amdgcn_global_load_lds((const unsigned*)((const char*)(gbase) + (voff)[_i]), (PG8_LAS unsigned*)(lds + (bufoff) + ldsw + _i * 8192), 16, 0, 0); } while (0)
#define PG8_LDA(dst, b, h) do { _Pragma("unroll") for (int m = 0; m < 4; ++m) _Pragma("unroll") for (int k = 0; k < 2; ++k) dst[m][k] = *(const PG8_LAS bf16x8*)(lds + PG8_SA(b, h) + aoff + m * 2048 + k * 1024); } while (0)
#define PG8_LDB(dst, b, h) do { _Pragma("unroll") for (int n = 0; n < 2; ++n) _Pragma("unroll") for (int k = 0; k < 2; ++k) dst[n][k] = *(const PG8_LAS bf16x8*)(lds + PG8_SB(b, h) + boff + n * 2048 + k * 1024); } while (0)
#define PG8_MMA(ai, bj, At, Bt) do { if (!(skipm & (1 << (bj)))) { __builtin_amdgcn_s_setprio(1); _Pragma("unroll") for (int m = 0; m < 4; ++m) _Pragma("unroll") for (int n = 0; n < 2; ++n) _Pragma("unroll") for (int k = 0; k < 2; ++k) \
        acc[ai][bj][m][n] = __builtin_amdgcn_mfma_f32_16x16x32_bf16(Bt[n][k], At[m][k], acc[ai][bj][m][n], 0, 0, 0); __builtin_amdgcn_s_setprio(0); } } while (0)
#define PG8_WAIT_V(n) asm volatile("s_waitcnt vmcnt(" #n ")" ::: "memory")
#define PG8_WAIT_L(n) asm volatile("s_waitcnt lgkmcnt(" #n ")" ::: "memory")
#define PG8_BAR __builtin_amdgcn_s_barrier()
#define PG8_SCHED __builtin_amdgcn_sched_barrier(0)
    Unit cur, nxt; int ui = 0;
    if (!S.next(0, cur)) return;
    int skipm = Epi::mma_skip(cur.pn, wc);
    f32x4 acc[2][2][4][2];
#pragma unroll
    for (int a = 0; a < 2; ++a)
#pragma unroll
        for (int b = 0; b < 2; ++b)
#pragma unroll
            for (int m = 0; m < 4; ++m)
#pragma unroll
                for (int n = 0; n < 2; ++n) acc[a][b][m][n] = (f32x4){0.f, 0.f, 0.f, 0.f};
    bf16x8 At[4][2], B0[2][2], B1[2][2];
    const char* cA = (const char*)g.A + (size_t)cur.pm * tstep; const char* cB = (const char*)g.Bt + (size_t)cur.pn * tstep;
    S.a_ready(cur);
    if constexpr (SP2) {
        PG8_STAGE(PG8_SB(0, 0), cB, voffB); PG8_STAGE(PG8_SB(0, 1), cB + hstep, voffB); PG8_STAGE(PG8_SA(0, 0), cA, voffA); PG8_STAGE(PG8_SA(0, 1), cA + hstep, voffA);
        if (wr == 1) PG8_BAR;
        PG8_WAIT_V(2); PG8_BAR;
        PG8_STAGE(PG8_SB(1, 0), cB + kstep, voffB); PG8_STAGE(PG8_SA(1, 0), cA + kstep, voffA); PG8_STAGE(PG8_SB(1, 1), cB + hstep + kstep, voffB);
        PG8_WAIT_V(6); PG8_BAR;
    } else {
        PG8_STAGE(PG8_SB(0, 0), cB, voffB); PG8_STAGE(PG8_SA(0, 0), cA, voffA); PG8_STAGE(PG8_SB(0, 1), cB + hstep, voffB); PG8_STAGE(PG8_SA(0, 1), cA + hstep, voffA);
        if (wr == 1) PG8_BAR;
        PG8_WAIT_V(4); PG8_BAR;
        PG8_STAGE(PG8_SB(1, 0), cB + kstep, voffB); PG8_STAGE(PG8_SA(1, 0), cA + kstep, voffA); PG8_STAGE(PG8_SB(1, 1), cB + hstep + kstep, voffB);
        PG8_WAIT_V(6); PG8_BAR;
    }
    for (;;) {
        const bool has_next = S.next(ui + 1, nxt);
        const char* nA = has_next ? (const char*)g.A + (size_t)nxt.pm * tstep : cA; const char* nB = has_next ? (const char*)g.Bt + (size_t)nxt.pn * tstep : cB;
        for (int t = 0; t < nt; t += 2) {
            const bool last = (t == nt - 2);
            const char* a1 = cA + (size_t)(t + 1) * kstep;
            const char* a2 = last ? nA : cA + (size_t)(t + 2) * kstep; const char* b2 = last ? nB : cB + (size_t)(t + 2) * kstep;
            const char* a3 = a2 + kstep; const char* b3 = b2 + kstep;
            if (last && has_next) S.a_ready(nxt);
            if constexpr (SP2) {
            PG8_LDB(B0, 0, 0); PG8_LDB(B1, 0, 1); PG8_SCHED; PG8_LDA(At, 0, 0); PG8_STAGE(PG8_SA(1, 1), a1 + hstep, voffA);
            PG8_WAIT_V(8); PG8_WAIT_L(0); PG8_BAR; PG8_MMA(0, 0, At, B0); PG8_MMA(0, 1, At, B1); PG8_BAR; PG8_SCHED;
            PG8_LDA(At, 0, 1); PG8_STAGE(PG8_SB(0, 0), b2, voffB); PG8_STAGE(PG8_SB(0, 1), b2 + hstep, voffB); PG8_STAGE(PG8_SA(0, 0), a2, voffA);
            PG8_WAIT_V(8); PG8_WAIT_L(0); PG8_BAR; PG8_MMA(1, 0, At, B0); PG8_MMA(1, 1, At, B1); PG8_BAR; PG8_SCHED;
            PG8_LDB(B0, 1, 0); PG8_LDB(B1, 1, 1); PG8_SCHED; PG8_LDA(At, 1, 0); PG8_STAGE(PG8_SA(0, 1), a2 + hstep, voffA);
            PG8_WAIT_V(8); PG8_WAIT_L(0); PG8_BAR; PG8_MMA(0, 0, At, B0); PG8_MMA(0, 1, At, B1); PG8_BAR; PG8_SCHED;
            PG8_LDA(At, 1, 1); PG8_STAGE(PG8_SB(1, 0), b3, voffB); PG8_STAGE(PG8_SB(1, 1), b3 + hstep, voffB); PG8_STAGE(PG8_SA(1, 0), a3, voffA);
            PG8_WAIT_V(8); PG8_WAIT_L(0); PG8_BAR; PG8_MMA(1, 0, At, B0); PG8_MMA(1, 1, At, B1); PG8_BAR; PG8_SCHED;
            } else {
            PG8_LDB(B0, 0, 0); PG8_SCHED; PG8_LDA(At, 0, 0); PG8_STAGE(PG8_SA(1, 1), a1 + hstep, voffA);
            PG8_WAIT_L(8); PG8_BAR; PG8_WAIT_L(0); PG8_MMA(0, 0, At, B0); PG8_BAR; PG8_SCHED;
            PG8_LDB(B1, 0, 1); PG8_STAGE(PG8_SB(0, 0), b2, voffB);
            PG8_BAR; PG8_WAIT_L(0); PG8_MMA(0, 1, At, B1); PG8_BAR;
            PG8_LDA(At, 0, 1); PG8_STAGE(PG8_SA(0, 0), a2, voffA);
            PG8_BAR; PG8_WAIT_L(0); PG8_MMA(1, 0, At, B0); PG8_BAR; PG8_SCHED;
            PG8_STAGE(PG8_SB(0, 1), b2 + hstep, voffB);
            PG8_WAIT_V(6); PG8_BAR; PG8_MMA(1, 1, At, B1); PG8_BAR;
            PG8_LDB(B0, 1, 0); PG8_SCHED; PG8_LDA(At, 1, 0); PG8_STAGE(PG8_SA(0, 1), a2 + hstep, voffA);
            PG8_WAIT_L(8); PG8_BAR; PG8_WAIT_L(0); PG8_MMA(0, 0, At, B0); PG8_BAR; PG8_SCHED;
            PG8_LDB(B1, 1, 1); PG8_STAGE(PG8_SB(1, 0), b3, voffB);
            PG8_BAR; PG8_WAIT_L(0); PG8_MMA(0, 1, At, B1); PG8_BAR;
            PG8_LDA(At, 1, 1); PG8_STAGE(PG8_SA(1, 0), a3, voffA);
            PG8_BAR; PG8_WAIT_L(0); PG8_MMA(1, 0, At, B0); PG8_BAR; PG8_SCHED;
            PG8_STAGE(PG8_SB(1, 1), b3 + hstep, voffB);
            PG8_WAIT_V(6); PG8_BAR; PG8_MMA(1, 1, At, B1); PG8_BAR;
            }
        }
        if constexpr (ALIGN_EPI) { if (wr == 0) PG8_BAR; }
        if constexpr (!Epi::AFTER_DRAIN) { E(acc, cur, wr, wc, fr, fq); S.done(cur); }
        if (!has_next) break;
#pragma unroll
        for (int a = 0; a < 2; ++a)
#pragma unroll
            for (int b = 0; b < 2; ++b)
#pragma unroll
                for (int m = 0; m < 4; ++m)
#pragma unroll
                    for (int n = 0; n < 2; ++n) acc[a][b][m][n] = (f32x4){0.f, 0.f, 0.f, 0.f};
        cur = nxt; cA = nA; cB = nB; ++ui; skipm = Epi::mma_skip(cur.pn, wc);
        if constexpr (ALIGN_EPI) { if (wr == 1) PG8_BAR; }
    }
    PG8_WAIT_V(0);
    if constexpr (!ALIGN_EPI) { if (wr == 0) PG8_BAR; }
    PG8_BAR;
    if constexpr (Epi::AFTER_DRAIN) { E.fused(acc, cur, wr, wc, fr, fq, lds, wid, lane); S.done(cur); }
#undef PG8_SA
#undef PG8_SB
#undef PG8_STAGE
#undef PG8_LDA
#undef PG8_LDB
#undef PG8_MMA
#undef PG8_WAIT_V
#undef PG8_WAIT_L
#undef PG8_BAR
#undef PG8_SCHED
}

template <class Epi, class Sched>
__device__ __forceinline__ void gemm_phase_naive(const Gemm g, const Sched& S, const Epi& E, const int tid) {
    const int wid = __builtin_amdgcn_readfirstlane(tid >> 6), lane = tid & 63, wr = wid >> 2, wc = wid & 3, fr = lane & 15, fq = lane >> 4;
    const int K = g.K;
    Unit cur;
    for (int ui = 0; S.next(ui, cur); ++ui) {
        f32x4 acc[2][2][4][2];
#pragma unroll
        for (int ai = 0; ai < 2; ++ai)
#pragma unroll
            for (int m = 0; m < 4; ++m) {
                const bf16_t* arow = g.A + (size_t)(cur.pm * BM + ai * HALF + wr * 64 + m * 16 + fr) * K;
#pragma unroll
                for (int bj = 0; bj < 2; ++bj)
#pragma unroll
                    for (int n = 0; n < 2; ++n) {
                        const int col = cur.pn * BM + bj * HALF + wc * 32 + (Epi::PERM ? (8 * fq + 4 * n) : (16 * n + 4 * fq));
                        const bf16_t* brow = g.Bt + (size_t)col * K;
                        float s0 = 0.f, s1 = 0.f, s2 = 0.f, s3 = 0.f;
#pragma unroll 1
                        for (int k = 0; k < K; k += 8) {
                            const bf16x8 av = *(const bf16x8*)(arow + k);
                            const bf16x8 b0 = *(const bf16x8*)(brow + k), b1 = *(const bf16x8*)(brow + K + k), b2 = *(const bf16x8*)(brow + 2 * K + k), b3 = *(const bf16x8*)(brow + 3 * K + k);
#pragma unroll
                            for (int e = 0; e < 8; ++e) { const float a = bf2f((bf16_t)av[e]);
                                s0 += a * bf2f((bf16_t)b0[e]); s1 += a * bf2f((bf16_t)b1[e]); s2 += a * bf2f((bf16_t)b2[e]); s3 += a * bf2f((bf16_t)b3[e]); }
                        }
                        acc[ai][bj][m][n] = (f32x4){s0, s1, s2, s3};
                    }
            }
        E(acc, cur, wr, wc, fr, fq);
    }
}
}
#ifndef PG8_SP2
#define PG8_SP2 true
#endif
#ifndef PG8_ALIGN
#define PG8_ALIGN true
#endif
typedef f32x4 AccT[2][2][4][2];

#ifndef EPI_NT
#define EPI_NT 0
#endif
__device__ __forceinline__ void store8_bf16(bf16_t* p, f32x4 v0, f32x4 v1) {
    u32x4 w; w.x = cvt_pk_bf16(v0[0], v0[1]); w.y = cvt_pk_bf16(v0[2], v0[3]); w.z = cvt_pk_bf16(v1[0], v1[1]); w.w = cvt_pk_bf16(v1[2], v1[3]); *(u32x4*)p = w;
}
__device__ __forceinline__ void store4_bf16(bf16_t* p, f32x4 v) { u32x2 w; w.x = cvt_pk_bf16(v[0], v[1]); w.y = cvt_pk_bf16(v[2], v[3]); *(u32x2*)p = w; }
__device__ __forceinline__ void estore8_bf16(bf16_t* p, f32x4 v0, f32x4 v1) {
    u32x4 w; w.x = cvt_pk_bf16(v0[0], v0[1]); w.y = cvt_pk_bf16(v0[2], v0[3]); w.z = cvt_pk_bf16(v1[0], v1[1]); w.w = cvt_pk_bf16(v1[2], v1[3]);
    if (EPI_NT) __builtin_nontemporal_store(w, (u32x4*)p); else *(u32x4*)p = w;
}
__device__ __forceinline__ void estore4_bf16(bf16_t* p, f32x4 v) { u32x2 w; w.x = cvt_pk_bf16(v[0], v[1]); w.y = cvt_pk_bf16(v[2], v[3]); if (EPI_NT) __builtin_nontemporal_store(w, (u32x2*)p); else *(u32x2*)p = w; }
__device__ __forceinline__ f32x4 silu4(f32x4 v) { return (f32x4){silu_f(v[0]), silu_f(v[1]), silu_f(v[2]), silu_f(v[3])}; }
__device__ __forceinline__ float sq4(f32x4 v) { return (v[0] * v[0] + v[1] * v[1]) + (v[2] * v[2] + v[3] * v[3]); }

struct EpiIn {
    static constexpr bool PERM = true, AFTER_DRAIN = false;
    static __device__ __forceinline__ int mma_skip(int pn, int wc) { return pn == 11 ? (wc >= 2 ? 3 : 2) : 0; }
    bf16_t* U; bf16_t* MIX; bf16_t* CQ; bf16_t* CKV; bf16_t* KR; float* rsq; const float* rcos; const float* rsin;
    template <int ACT> __device__ __forceinline__ void plain(const AccT& acc, bf16_t* base, int ldc, int row0, int col0) const {
#pragma unroll
        for (int ai = 0; ai < 2; ++ai)
#pragma unroll
            for (int m = 0; m < 4; ++m) { bf16_t* rowp = base + (size_t)(row0 + ai * 128 + m * 16) * ldc + col0;
#pragma unroll
                for (int bj = 0; bj < 2; ++bj) { f32x4 v0 = acc[ai][bj][m][0], v1 = acc[ai][bj][m][1]; if (ACT) { v0 = silu4(v0); v1 = silu4(v1); } estore8_bf16(rowp + bj * 128, v0, v1); } }
    }
    __device__ __forceinline__ void sumsq(const AccT& acc, int row0, int which, int fq) const {
#pragma unroll
        for (int ai = 0; ai < 2; ++ai)
#pragma unroll
            for (int m = 0; m < 4; ++m) { float s = (sq4(acc[ai][0][m][0]) + sq4(acc[ai][0][m][1])) + (sq4(acc[ai][1][m][0]) + sq4(acc[ai][1][m][1]));
                s += __shfl_xor(s, 16); s += __shfl_xor(s, 32);
                if (fq == 0) atomicAdd(rsq + (size_t)(row0 + ai * 128 + m * 16) * 2 + which, s); }
    }
    __device__ __forceinline__ void operator()(const AccT& acc, const pg8::Unit& u, int wr, int wc, int fr, int fq) const {
        const int row0 = u.pm * 256 + wr * 64 + fr, pn = u.pn, cw = wc * 32 + 8 * fq;
        if (pn < 4) plain<0>(acc, U, DF, row0, pn * 256 + cw);
        else if (pn < 8) plain<1>(acc, MIX, DM, row0, (pn - 4) * 256 + cw);
        else if (pn < 10) { plain<0>(acc, CQ, QLR, row0, (pn - 8) * 256 + cw); sumsq(acc, row0, 0, fq); }
        else if (pn == 10) { plain<0>(acc, CKV, KVLR, row0, cw); sumsq(acc, row0, 1, fq); }
        else if (pn == 11) {
            if (wc < 2) { const int i0 = 16 * wc + 4 * fq;
#pragma unroll
                for (int ai = 0; ai < 2; ++ai)
#pragma unroll
                    for (int m = 0; m < 4; ++m) { const size_t row = (size_t)(row0 + ai * 128 + m * 16);
                        const f32x4 c = *(const f32x4*)(rcos + row * 32 + i0), s = *(const f32x4*)(rsin + row * 32 + i0), x1 = acc[ai][0][m][0], x2 = acc[ai][0][m][1];
                        estore4_bf16(KR + row * 64 + i0, x1 * c - x2 * s); estore4_bf16(KR + row * 64 + 32 + i0, x2 * c + x1 * s); } }
        }
        else plain<1>(acc, MIX, DM, row0, DF + (pn - 12) * 256 + cw);
    }
};
struct EpiQ {
    static constexpr bool PERM = true, AFTER_DRAIN = false;
    static __device__ __forceinline__ int mma_skip(int, int) { return 0; }
    bf16_t* Q; const float* rsq; const float* rcos; const float* rsin;
    __device__ __forceinline__ void operator()(const AccT& acc, const pg8::Unit& u, int wr, int wc, int fr, int fq) const {
        const int row0 = u.pm * 256 + wr * 64 + fr;
#pragma unroll
        for (int ai = 0; ai < 2; ++ai)
#pragma unroll
            for (int m = 0; m < 4; ++m) { const size_t row = (size_t)(row0 + ai * 128 + m * 16);
                const float rs = rsqrtf(rsq[row * 2 + 0] * (1.0f / QLR) + NORM_EPS);
#pragma unroll
                for (int bj = 0; bj < 2; ++bj) { const int G = u.pn * 8 + bj * 4 + wc, head = G / 6, g6 = G - head * 6;
                    const f32x4 v0 = acc[ai][bj][m][0] * rs, v1 = acc[ai][bj][m][1] * rs;
                    if (g6 < 4) estore8_bf16(Q + row * NQ + head * DQK + g6 * 32 + 8 * fq, v0, v1);
                    else { const int i0 = 16 * (g6 - 4) + 4 * fq; const f32x4 c = *(const f32x4*)(rcos + row * 32 + i0), s = *(const f32x4*)(rsin + row * 32 + i0);

#if defined(PROBE_NEG) && PROBE_NEG == 1
                        estore4_bf16(Q + row * NQ + head * DQK + 128 + i0, v0 * c + v1 * s); estore4_bf16(Q + row * NQ + head * DQK + 160 + i0, v1 * c - v0 * s);
#else
                        estore4_bf16(Q + row * NQ + head * DQK + 128 + i0, v0 * c - v1 * s); estore4_bf16(Q + row * NQ + head * DQK + 160 + i0, v1 * c + v0 * s);
#endif
                    } } }
    }
};
struct EpiKV {
    static constexpr bool PERM = true, AFTER_DRAIN = false;
    static __device__ __forceinline__ int mma_skip(int, int) { return 0; }
    bf16_t* KV; const float* rsq;
    __device__ __forceinline__ void operator()(const AccT& acc, const pg8::Unit& u, int wr, int wc, int fr, int fq) const {
        const int row0 = u.pm * 256 + wr * 64 + fr, col0 = u.pn * 256 + wc * 32 + 8 * fq;
#pragma unroll
        for (int ai = 0; ai < 2; ++ai)
#pragma unroll
            for (int m = 0; m < 4; ++m) { const size_t row = (size_t)(row0 + ai * 128 + m * 16);
                const float rs = rsqrtf(rsq[row * 2 + 1] * (1.0f / KVLR) + NORM_EPS);
#pragma unroll
                for (int bj = 0; bj < 2; ++bj) estore8_bf16(KV + row * NKV + col0 + bj * 128, acc[ai][bj][m][0] * rs, acc[ai][bj][m][1] * rs); }
    }
};
struct EpiOut {
    static constexpr bool PERM = true, AFTER_DRAIN = false;
    static __device__ __forceinline__ int mma_skip(int, int) { return 0; }
    bf16_t* GY; const float* gate;
    __device__ __forceinline__ void operator()(const AccT& acc, const pg8::Unit& u, int wr, int wc, int fr, int fq) const {
        const int row0 = u.pm * 256 + wr * 64 + fr, col0 = u.pn * 256 + wc * 32 + 8 * fq;
        const float* gp = gate + (size_t)(u.pm >> 4) * (3 * DM) + col0;
        f32x4 gv[2][2];
#pragma unroll
        for (int bj = 0; bj < 2; ++bj)
#pragma unroll
            for (int n = 0; n < 2; ++n) gv[bj][n] = *(const f32x4*)(gp + bj * 128 + n * 4);
#pragma unroll
        for (int ai = 0; ai < 2; ++ai)
#pragma unroll
            for (int m = 0; m < 4; ++m) { bf16_t* rowp = GY + (size_t)(row0 + ai * 128 + m * 16) * DM + col0;
#pragma unroll
                for (int bj = 0; bj < 2; ++bj) estore8_bf16(rowp + bj * 128, gv[bj][0] * acc[ai][bj][m][0], gv[bj][1] * acc[ai][bj][m][1]); }
    }
};

struct EpiNone {
    static constexpr bool PERM = true, AFTER_DRAIN = false;
    static __device__ __forceinline__ int mma_skip(int, int) { return 0; }
    __device__ __forceinline__ void operator()(const AccT& acc, const pg8::Unit& u, int wr, int wc, int fr, int fq) const {
#pragma unroll
        for (int ai = 0; ai < 2; ++ai)
#pragma unroll
            for (int bj = 0; bj < 2; ++bj)
#pragma unroll
                for (int m = 0; m < 4; ++m)
#pragma unroll
                    for (int n = 0; n < 2; ++n) asm volatile("" :: "v"(acc[ai][bj][m][n]));
    }
};
#define XB_TMO      128
#define XB_XCNT(j)  (256  + 64 * (j))
#define XB_XSUB(j)  (1280 + 64 * (j))
#define XB_XGEN(j)  (2304 + 64 * (j))
#define XB_TOP      3328
#define XB_TOPGEN   3392
#define XCD_BAR_WORDS 3456
#define XB_SPIN_CAP (1u << 22)
static_assert(XCD_BAR_WORDS * 4 <= CTL_BYTES, "barrier words must fit the control region");
__device__ __forceinline__ unsigned xb_ld(unsigned* p)              { return __hip_atomic_load(p, __ATOMIC_RELAXED, __HIP_MEMORY_SCOPE_AGENT); }
__device__ __forceinline__ unsigned xb_add(unsigned* p, unsigned v) { return __hip_atomic_fetch_add(p, v, __ATOMIC_RELAXED, __HIP_MEMORY_SCOPE_AGENT); }
__device__ __forceinline__ unsigned xb_xcc_id() { return (unsigned)__builtin_amdgcn_s_getreg((3 << 11) | 20) & 0xFu; }
#define XB_SPIN(cond, bar) do { unsigned _sp = 0; while (cond) { __builtin_amdgcn_s_sleep(1); \
    if ((++_sp & 255u) == 0u) { if (xb_ld(&(bar)[XB_TMO])) break; if (_sp > XB_SPIN_CAP) { atomicAdd(&(bar)[XB_TMO], 1u); break; } } } } while (0)
struct XcdBarrier { unsigned* bar; unsigned x; volatile LAS unsigned* st; };
__device__ __forceinline__ XcdBarrier xcd_barrier_post(unsigned* bar, volatile LAS unsigned* st) {
    XcdBarrier b; b.bar = bar; b.x = xb_xcc_id(); b.st = st;
    if (threadIdx.x == 0) st[2] = xb_add(&bar[XB_XCNT(b.x)], 1u);
    return b;
}
__device__ __forceinline__ void xcd_barrier_complete(unsigned* bar, unsigned x, unsigned& nloc, unsigned& nx, unsigned& even) {
    const unsigned G = gridDim.x * gridDim.y * gridDim.z;
    unsigned sum, cnt, mine, sp = 0u;
    for (;;) {
        sum = 0u; cnt = 0u; mine = 0u; even = 1u;
#pragma unroll
        for (unsigned j = 0; j < 16; ++j) { const unsigned c = xb_ld(&bar[XB_XCNT(j)]); sum += c; cnt += (c > 0u) ? 1u : 0u; mine = (j == x) ? c : mine; if (c != (j < 8u ? G / 8u : 0u)) even = 0u; }
        if (sum == G) break;
        __builtin_amdgcn_s_sleep(1);
        if ((++sp & 255u) == 0u) { if (xb_ld(&bar[XB_TMO])) break; if (sp > XB_SPIN_CAP) { atomicAdd(&bar[XB_TMO], 1u); break; } }
    }
    nloc = mine > 0u ? mine : 1u; nx = cnt > 0u ? cnt : 1u;
}
__device__ __forceinline__ void xcd_barrier(const XcdBarrier& b) {
    asm volatile("s_waitcnt vmcnt(0)" ::: "memory");
    __syncthreads();
    if (threadIdx.x == 0) {
        unsigned* bar = b.bar;
        __builtin_amdgcn_s_waitcnt(0);
        unsigned nloc = b.st[0], nx = b.st[1];
        if (nloc == 0u) { unsigned even; xcd_barrier_complete(bar, b.x, nloc, nx, even); b.st[0] = nloc; b.st[1] = nx; b.st[3] = (even && (gridDim.x % 8u) == 0u) ? 1u : 2u; }
        const unsigned old = xb_add(&bar[XB_XSUB(b.x)], 1u);
        const unsigned gen = old / nloc;
        if (old + 1u == (gen + 1u) * nloc) {
            __builtin_amdgcn_fence(__ATOMIC_RELEASE, "agent");
            asm volatile("s_waitcnt vmcnt(0)" ::: "memory");
            const unsigned og = xb_add(&bar[XB_TOP], 1u);
            const unsigned tg = og / nx;
            if (og + 1u == (tg + 1u) * nx) xb_add(&bar[XB_TOPGEN], 1u);
            else XB_SPIN(xb_ld(&bar[XB_TOPGEN]) == tg, bar);
            __builtin_amdgcn_fence(__ATOMIC_ACQUIRE, "agent");
            xb_add(&bar[XB_XGEN(b.x)], 1u);
            asm volatile("s_waitcnt vmcnt(0)" ::: "memory");
        } else {
            XB_SPIN(xb_ld(&bar[XB_XGEN(b.x)]) == gen, bar);
            __builtin_amdgcn_fence(__ATOMIC_ACQUIRE, "agent");
            asm volatile("s_waitcnt vmcnt(0)" ::: "memory");
        }
    }
    __syncthreads();
}
struct Frame {
    const float* in[14]; float* out; unsigned char* ws;
    LAS unsigned char* lds; char* ldsg;
    int tid, lane, wave, G, bx, vcu; size_t mix_off;
};
#define WSP(T, off) ((T*)(F.ws + (off)))

__device__ __forceinline__ int src_in(int n) {
    if (n < 2816) return n;
    if (n < 3072) { const int c = n - 2816, bj = c >> 7, wc = (c >> 5) & 3, c32 = c & 31; if (bj || wc >= 2) return -1;
        const int fq = c32 >> 3, nn = (c32 >> 2) & 1, j = c32 & 3; return 2816 + 32 * nn + 16 * wc + 4 * fq + j; }
    return n - 192;
}
__device__ __forceinline__ int src_q(int n) {
    const int G = n >> 5, c32 = n & 31, head = G / 6, g6 = G - head * 6;
    if (g6 < 4) return head * DQK + g6 * 32 + c32;
    const int fq = c32 >> 3, nn = (c32 >> 2) & 1, j = c32 & 3; return head * DQK + 128 + 32 * nn + 16 * (g6 - 4) + 4 * fq + j;
}
__device__ __forceinline__ void p0_weights(const Frame& F) {
    constexpr int TIN = 512, TOUT = 256, TQ = 48, TKV = 32, TL = TIN + TOUT + TQ + TKV;
    LAS unsigned* T = (LAS unsigned*)F.lds;
    const int tid = F.tid, n4 = (tid & 15) * 4, kp = tid >> 4;
    for (int it = F.bx; it < DEPTH * TL; it += F.G) {
        const int l = it / TL; int r = it - l * TL, kind, nt, kt, Nsrc, K; const float* W; const float* ksc = nullptr; bf16_t* Bt;
        if (r < TIN) { kind = 0; nt = r >> 3; kt = r & 7; W = F.in[5] + (size_t)l * DM * NIN; Nsrc = NIN; K = DM; Bt = WSP(bf16_t, WS_WIN) + (size_t)l * NINP * DM; }
        else if (r < TIN + TOUT) { r -= TIN; kind = 1; nt = r >> 3; kt = r & 7; W = F.in[11] + (size_t)l * DM * DM; Nsrc = DM; K = DM; Bt = WSP(bf16_t, WS_WOUT) + (size_t)l * DM * DM; }
        else if (r < TIN + TOUT + TQ) { r -= TIN + TOUT; kind = 2; nt = r >> 1; kt = r & 1; W = F.in[7] + (size_t)l * QLR * NQ; Nsrc = NQ; K = QLR; ksc = F.in[6] + l * QLR; Bt = WSP(bf16_t, WS_WQ) + (size_t)l * NQ * QLR; }
        else { r -= TIN + TOUT + TQ; kind = 3; nt = r; kt = 0; W = F.in[9] + (size_t)l * KVLR * NKV; Nsrc = NKV; K = KVLR; ksc = F.in[8] + l * KVLR; Bt = WSP(bf16_t, WS_WKV) + (size_t)l * NKV * KVLR; }
        const int n0 = nt * 64, k0 = kt * 256, n = n0 + n4;
        const int src = kind == 0 ? src_in(n) : (kind == 2 ? src_q(n) : n);
        f32x4 v0[4], v1[4];
#pragma unroll
        for (int i = 0; i < 4; ++i) { const int k = k0 + 2 * (kp + 32 * i);
            v0[i] = src >= 0 ? __builtin_nontemporal_load((const f32x4*)(W + (size_t)k * Nsrc + src)) : (f32x4){0.f, 0.f, 0.f, 0.f}; v1[i] = src >= 0 ? __builtin_nontemporal_load((const f32x4*)(W + (size_t)(k + 1) * Nsrc + src)) : (f32x4){0.f, 0.f, 0.f, 0.f}; }
        if (ksc) {
#pragma unroll
            for (int i = 0; i < 4; ++i) { const int k = k0 + 2 * (kp + 32 * i); v0[i] *= ksc[k]; v1[i] *= ksc[k + 1]; } }
#pragma unroll
        for (int i = 0; i < 4; ++i)
#pragma unroll
            for (int e = 0; e < 4; ++e) T[(n4 + e) * 130 + kp + 32 * i] = cvt_pk_bf16(v0[i][e], v1[i][e]);
        __syncthreads();
#pragma unroll
        for (int i = 0; i < 4; ++i) { const int c = tid + 512 * i, nn = c >> 5, kc = c & 31;
            const u32x2 a = *(const LAS u32x2*)(T + nn * 130 + kc * 4), b = *(const LAS u32x2*)(T + nn * 130 + kc * 4 + 2);
            *(u32x4*)(Bt + (size_t)(n0 + nn) * K + k0 + kc * 8) = (u32x4){a.x, a.y, b.x, b.y}; }
        __syncthreads();
    }
}
__device__ __forceinline__ void p0_mod(const Frame& F) {
    LAS float* red = (LAS float*)(F.lds + 32768);
    const int tid = F.tid;
    float* mod = WSP(float, WS_MOD); const float* cc = F.in[1];
    for (int it = F.bx; it < DEPTH * 96 * 4; it += F.G) {
        const int l = it / 384, rem = it - l * 384, kq = rem & 3, col0 = (rem >> 2) * 64, cg = tid & 15, kl = tid >> 4;
        f32x4 acc[4] = {};
        const float* wp = F.in[3] + ((size_t)l * DM + kq * 512 + kl) * (3 * DM) + col0 + cg * 4;
        f32x4 w[16];
#pragma unroll
        for (int i = 0; i < 16; ++i) w[i] = __builtin_nontemporal_load((const f32x4*)(wp + (size_t)(32 * i) * (3 * DM)));
#pragma unroll
        for (int i = 0; i < 16; ++i) { const int k = kq * 512 + kl + 32 * i;
#pragma unroll
            for (int b = 0; b < 4; ++b) acc[b] += w[i] * silu_f(cc[b * DM + k]); }
#pragma unroll
        for (int b = 0; b < 4; ++b)
#pragma unroll
            for (int j = 0; j < 4; ++j) red[(kl * 16 + cg) * 16 + b * 4 + j] = acc[b][j];
        __syncthreads();
        if (tid < 256) { const int cg2 = tid >> 4, v = tid & 15, b = v >> 2, j = v & 3; float s = 0.f;
            for (int q = 0; q < 32; ++q) s += red[(q * 16 + cg2) * 16 + v];
            const int col = col0 + cg2 * 4 + j; if (kq == 0) s += F.in[4][l * (3 * DM) + col];
            atomicAdd(mod + (size_t)(l * NB + b) * (3 * DM) + col, s); }
        __syncthreads();
    }
}
__device__ __forceinline__ void p0_tables(const Frame& F) {
    constexpr double INVF2PI[32] = {
    0.15915494309189535, 0.11934937021124886, 0.08949940160889101, 0.06711508300522726,
    0.050329212104487035, 0.03774158471741977, 0.0283021958306234, 0.02122365276477766,
    0.015915494309189534, 0.011934937021124886, 0.008949940160889102, 0.006711508300522725,
    0.005032921210448704, 0.003774158471741977, 0.00283021958306234, 0.0021223652764777662,
    0.0015915494309189536, 0.0011934937021124885, 0.0008949940160889102, 0.0006711508300522726,
    0.0005032921210448703, 0.00037741584717419774, 0.00028302195830623395, 0.0002122365276477766,
    0.00015915494309189535, 0.00011934937021124886, 8.949940160889102e-05, 6.711508300522725e-05,
    5.0329212104487035e-05, 3.774158471741978e-05, 2.8302195830623396e-05, 2.122365276477766e-05};
    const int gid = F.bx * NTHREADS + F.tid, NT = F.G * NTHREADS;
    const int* pos = (const int*)F.in[2]; float* rc = WSP(float, WS_RCOS); float* rs = WSP(float, WS_RSIN);
    for (int idx = gid; idx < MTOK * 32; idx += NT) { const int i = idx & 31; double t = (double)pos[idx >> 5] * INVF2PI[i]; t -= floor(t);
        float sn, cs; sincospif((float)(2.0 * t), &sn, &cs); rc[idx] = cs; rs[idx] = sn; }
    bf16_t* D1 = WSP(bf16_t, WS_D1); bf16_t* D2 = WSP(bf16_t, WS_D2);
    for (int idx = gid; idx < 128 * 64; idx += NT) { const int s1 = idx & 63, rr = idx >> 6, ri = rr >> 6, s1p = rr & 63; float sn, cs; sincospif((float)((s1 * s1p) & 63) * (1.0f / 32.0f), &sn, &cs);
        D1[idx] = f2bf((ri ? -sn : cs) * 0.125f); }
    for (int idx = gid; idx < 128 * 128; idx += NT) { const int kk = idx & 127, rr = idx >> 7, ri = kk >> 6, s2 = kk & 63, ro = rr >> 6, s2p = rr & 63; float sn, cs; sincospif((float)((s2 * s2p) & 63) * (1.0f / 32.0f), &sn, &cs);
        const float v = ro == 0 ? (ri == 0 ? cs : sn) : (ri == 0 ? -sn : cs); D2[idx] = f2bf(v * 0.125f); }
    float* rsq = WSP(float, WS_RSQ);
    for (int idx = gid; idx < DEPTH * MTOK * 2; idx += NT) rsq[idx] = 0.f;
    LAS float* ct = (LAS float*)F.lds; LAS float* st = ct + 128;
    if (F.tid < 128) { float sn, cs; sincospif((float)F.tid * (1.0f / 64.0f), &sn, &cs); ct[F.tid] = cs * 0.08838834764831845f; st[F.tid] = sn * 0.08838834764831845f; }
    __syncthreads();
    bf16_t* wcat = WSP(bf16_t, WS_WCAT);
    for (int t = gid; t < DEPTH * NG * 128 * 64; t += NT) { const int k4 = (t & 63) * 4, d = (t >> 6) & 127, lg = t >> 13, ro = k4 >> 7, c0 = k4 & 127;
        const float* w = F.in[10] + (size_t)lg * 128 * 128 + d; LAS float* tb = ro ? st : ct; f32x4 s = {0.f, 0.f, 0.f, 0.f};
        for (int cp0 = 0; cp0 < 128; cp0 += 16) { float wv[16];
#pragma unroll
            for (int u = 0; u < 16; ++u) wv[u] = w[(cp0 + u) * 128];
#pragma unroll
            for (int u = 0; u < 16; ++u) { const int cp = cp0 + u; s += (f32x4){tb[(c0 * cp) & 127], tb[((c0 + 1) * cp) & 127], tb[((c0 + 2) * cp) & 127], tb[((c0 + 3) * cp) & 127]} * wv[u]; } }
        u32x2 o; o.x = cvt_pk_bf16(s[0], s[1]); o.y = cvt_pk_bf16(s[2], s[3]);
        *(u32x2*)(wcat + ((size_t)lg * 128 + d) * 256 + k4) = o; }
    __syncthreads();
}
#ifndef LN_NT
#define LN_NT 1
#endif
#if LN_NT
#define LN_LD(p) __builtin_nontemporal_load((const f32x4*)(p))
#define LN_ST(p, v) __builtin_nontemporal_store((v), (f32x4*)(p))
#else
#define LN_LD(p) (*(const f32x4*)(p))
#define LN_ST(p, v) (*(f32x4*)(p) = (v))
#endif
__device__ __forceinline__ void row_stats(const f32x4 (&v)[8], float& mean, float& rstd) {
    float s = 0.f;
#pragma unroll
    for (int i = 0; i < 8; ++i) s += (v[i][0] + v[i][1]) + (v[i][2] + v[i][3]);
    mean = wave_sum(s) * (1.0f / DM); float q = 0.f;
#pragma unroll
    for (int i = 0; i < 8; ++i) { const f32x4 d = v[i] - mean; q += (d[0] * d[0] + d[1] * d[1]) + (d[2] * d[2] + d[3] * d[3]); }
    rstd = rsqrtf(wave_sum(q) * (1.0f / DM) + NORM_EPS);
}
__device__ __forceinline__ void p_ln_first(const Frame& F) {
    const float* x = F.in[0]; const float* mod = WSP(float, WS_MOD); bf16_t* H = WSP(bf16_t, WS_H);
    const int step = F.G * 8; int row = F.bx * 8 + F.wave;
    f32x4 v[8], vn[8];
    if (row < MTOK) { const float* xr = x + (size_t)row * DM + F.lane * 4;
#pragma unroll
        for (int i = 0; i < 8; ++i) vn[i] = LN_LD(xr + i * 256); }
    for (; row < MTOK; row += step) {
#pragma unroll
        for (int i = 0; i < 8; ++i) v[i] = vn[i];
        if (row + step < MTOK) { const float* xr = x + (size_t)(row + step) * DM + F.lane * 4;
#pragma unroll
            for (int i = 0; i < 8; ++i) vn[i] = LN_LD(xr + i * 256); }
        float mean, rstd; row_stats(v, mean, rstd);
        const float* mp = mod + (size_t)(row >> 12) * (3 * DM) + F.lane * 4;
#pragma unroll
        for (int i = 0; i < 8; ++i) { const f32x4 sh = *(const f32x4*)(mp + i * 256), sc = *(const f32x4*)(mp + DM + i * 256);
            store4_bf16(H + (size_t)row * DM + F.lane * 4 + i * 256, (v[i] - mean) * rstd * (sc + 1.0f) + sh); }
    }
}
template <bool NEXT> __device__ __forceinline__ void p_ln_post(const Frame& F, int l) {
    const float* xs = l == 0 ? F.in[0] : WSP(float, WS_R); float* dst = NEXT ? WSP(float, WS_R) : F.out; const float* g = F.in[12] + l * DM; const float* bb = F.in[13] + l * DM;
    const float* mod = WSP(float, WS_MOD) + (size_t)(l + 1) * NB * (3 * DM); bf16_t* H = WSP(bf16_t, WS_H);
    const int step = F.G * 8; int row = F.bx * 8 + F.wave;
    f32x4 v[8], vn[8]; u32x2 gy[8], gyn[8];
    if (row < MTOK) { const float* xr = xs + (size_t)row * DM + F.lane * 4; const bf16_t* gr = H + (size_t)row * DM + F.lane * 4;
#pragma unroll
        for (int i = 0; i < 8; ++i) { vn[i] = LN_LD(xr + i * 256); gyn[i] = __builtin_nontemporal_load((const u32x2*)(gr + i * 256)); } }
    for (; row < MTOK; row += step) {
#pragma unroll
        for (int i = 0; i < 8; ++i) { const u32x2 q = gyn[i];
            v[i] = vn[i] * DN_ALPHA + (f32x4){__uint_as_float(q.x << 16), __uint_as_float(q.x & 0xffff0000u), __uint_as_float(q.y << 16), __uint_as_float(q.y & 0xffff0000u)}; }
        if (row + step < MTOK) { const float* xr = xs + (size_t)(row + step) * DM + F.lane * 4; const bf16_t* gr = H + (size_t)(row + step) * DM + F.lane * 4;
#pragma unroll
            for (int i = 0; i < 8; ++i) { vn[i] = LN_LD(xr + i * 256); gyn[i] = __builtin_nontemporal_load((const u32x2*)(gr + i * 256)); } }
        float mean, rstd; row_stats(v, mean, rstd);
#pragma unroll
        for (int i = 0; i < 8; ++i) { v[i] = (v[i] - mean) * rstd * *(const f32x4*)(g + F.lane * 4 + i * 256) + *(const f32x4*)(bb + F.lane * 4 + i * 256);
            LN_ST(dst + (size_t)row * DM + F.lane * 4 + i * 256, v[i]); }
        if (NEXT) { row_stats(v, mean, rstd); const float* mp = mod + (size_t)(row >> 12) * (3 * DM) + F.lane * 4;
#pragma unroll
            for (int i = 0; i < 8; ++i) { const f32x4 sh = *(const f32x4*)(mp + i * 256), sc = *(const f32x4*)(mp + DM + i * 256);
                store4_bf16(H + (size_t)row * DM + F.lane * 4 + i * 256, (v[i] - mean) * rstd * (sc + 1.0f) + sh); } }
    }
}
__device__ __forceinline__ void fft1_naive(const Frame& F) {
    const bf16_t* U = WSP(bf16_t, WS_U); const bf16_t* D1 = WSP(bf16_t, WS_D1); bf16_t* Z = WSP(bf16_t, WS_H);
    const int gid = F.bx * NTHREADS + F.tid, NT = F.G * NTHREADS;
    for (int idx = gid; idx < NB * 64 * NG * 64 * 128; idx += NT) {
        const int c = idx & 127, s2 = (idx >> 7) & 63, g = (idx >> 13) & 7, s1p = (idx >> 16) & 63, b = idx >> 22;
        float yr = 0.f, yi = 0.f;
        for (int s1 = 0; s1 < 64; ++s1) { const float u = bf2f(U[(size_t)(b * SEQ + 64 * s1 + s2) * DF + g * 128 + c]); yr += bf2f(D1[s1p * 64 + s1]) * u; yi += bf2f(D1[(64 + s1p) * 64 + s1]) * u; }
        float st, ct; sincospif((float)(s2 * s1p) * (1.0f / 2048.0f), &st, &ct);
        const size_t zo = ((((size_t)(b * 64 + s1p) * NG + g) * 2) * 64 + s2) * 128 + c;
        Z[zo] = f2bf(yr * ct + yi * st); Z[zo + 64 * 128] = f2bf(yi * ct - yr * st);
    }
}
__device__ __forceinline__ void fft2_naive(const Frame& F, int l) {
    const bf16_t* Z = WSP(bf16_t, WS_H); const bf16_t* D2 = WSP(bf16_t, WS_D2); const bf16_t* wcat = WSP(bf16_t, WS_WCAT) + (size_t)l * NG * 128 * 256; bf16_t* MIX = WSP(bf16_t, WS_MIX);
    LAS float* Xs = (LAS float*)F.lds;
    for (int it = F.bx; it < NB * 64 * NG; it += F.G) {
        const int g = it & 7, s1p = (it >> 3) & 63, b = it >> 9;
        const bf16_t* Zb = Z + ((size_t)(b * 64 + s1p) * NG + g) * 2 * 64 * 128;
        for (int i = 0; i < 32; ++i) { const int o = F.tid + 512 * i, c = o & 127, rr = o >> 7; float s = 0.f;
            for (int k = 0; k < 128; ++k) s += bf2f(D2[rr * 128 + k]) * bf2f(Zb[k * 128 + c]);
            Xs[rr * 128 + c] = bf2f(f2bf(s)); }
        __syncthreads();
        for (int i = 0; i < 16; ++i) { const int o = F.tid + 512 * i, d = o & 127, s2p = o >> 7; float s = 0.f;
            const bf16_t* wr = wcat + (size_t)(g * 128 + d) * 256;
            for (int k = 0; k < 256; ++k) s += Xs[((k >> 7) * 64 + s2p) * 128 + (k & 127)] * bf2f(wr[k]);
            const size_t mo = (size_t)(b * SEQ + s1p + 64 * s2p) * DM + g * 128 + d;
            MIX[mo] = f2bf(s * bf2f(MIX[mo])); }
        __syncthreads();
    }
}
__device__ __forceinline__ void attn_naive(const Frame& F) {
    const bf16_t* Q = WSP(bf16_t, WS_Q); const bf16_t* KV = WSP(bf16_t, WS_KV); const bf16_t* KR = WSP(bf16_t, WS_KR); bf16_t* MIX = WSP(bf16_t, WS_MIX);
    LAS float* qs = (LAS float*)F.lds + F.wave * 192;
    for (int it = F.bx * 8 + F.wave; it < MTOK * NH * 2; it += F.G * 8) {
        const int dh = it & 1, h = (it >> 1) & 7, tok = it >> 4, b = tok >> 12;
        __builtin_amdgcn_wave_barrier(); asm volatile("" ::: "memory");
        for (int e = 0; e < 3; ++e) qs[F.lane + 64 * e] = bf2f(Q[(size_t)tok * NQ + h * DQK + F.lane + 64 * e]);
        asm volatile("s_waitcnt lgkmcnt(0)" ::: "memory"); __builtin_amdgcn_wave_barrier();
        float m = -1e30f, lsum = 0.f; float o[64];
#pragma unroll
        for (int d = 0; d < 64; ++d) o[d] = 0.f;
        for (int t = 0; t < 64; ++t) {
            const size_t key = (size_t)b * SEQ + F.lane + 64 * t; const bf16_t* kn = KV + key * NKV + h * 256; const bf16_t* kr = KR + key * 64;
            float s = 0.f;
#pragma unroll 2
            for (int c = 0; c < 16; ++c) { const bf16x8 kv = *(const bf16x8*)(kn + c * 8);
#pragma unroll
                for (int e = 0; e < 8; ++e) s += qs[c * 8 + e] * bf2f((bf16_t)kv[e]); }
#pragma unroll 2
            for (int c = 0; c < 8; ++c) { const bf16x8 kv = *(const bf16x8*)(kr + c * 8);
#pragma unroll
                for (int e = 0; e < 8; ++e) s += qs[128 + c * 8 + e] * bf2f((bf16_t)kv[e]); }
            s *= ATT_SCALE; const float mn = fmaxf(m, s), a = __expf(m - mn), p = __expf(s - mn); lsum = lsum * a + p; m = mn;
#pragma unroll
            for (int c = 0; c < 8; ++c) { const bf16x8 vv = *(const bf16x8*)(kn + 128 + dh * 64 + c * 8);
#pragma unroll
                for (int e = 0; e < 8; ++e) o[c * 8 + e] = o[c * 8 + e] * a + p * bf2f((bf16_t)vv[e]); }
        }
        const float Mx = wave_max(m), f = __expf(m - Mx); const float L = wave_sum(lsum * f);
        float keep0 = 0.f;
#pragma unroll
        for (int d = 0; d < 64; ++d) { const float od = wave_sum(o[d] * f); if (F.lane == d) keep0 = od; }
        const size_t mo = (size_t)tok * DM + DF + h * 128 + dh * 64 + F.lane;
        MIX[mo] = f2bf(keep0 / L * bf2f(MIX[mo]));
    }
}
namespace att {
constexpr int NW = 8, QBLK = 32, KVBLK = 64;
#ifndef ATT_DMA
#define ATT_DMA 1
#endif
#ifndef ATT_PRIO
#define ATT_PRIO 0
#endif
#ifndef ATT_QSB2
#define ATT_QSB2 1
#endif
#ifndef ATT_SDEPTH
#define ATT_SDEPTH 1
#endif
constexpr int SDEPTH = ATT_SDEPTH;
constexpr float THR = 8.f;
constexpr int SHM_V = KVBLK * 128 * 2, SHM_KN = KVBLK * 128 * 2, SHM_KR = KVBLK * 64 * 2;
#ifndef ATT_QLDS
#define ATT_QLDS 6
#endif
constexpr int QLDS = ATT_QLDS, QREG = 12 - QLDS;
constexpr int OFF_V = 0, OFF_KN = 2 * SHM_V, OFF_KR = OFF_KN + 2 * SHM_KN, OFF_WS = OFF_KR + 2 * SHM_KR, OFF_QL = OFF_WS + NW * 64 * 4, OFF_OT = 0, OT_PITCH = 272, SHM_ATTN = OFF_QL + NW * QLDS * 1024;
static_assert(NW * 32 * OT_PITCH <= OFF_WS, "O tiles reuse the K/V buffers");
static_assert(SHM_ATTN <= RING_BYTES, "attention LDS must fit the phase scratch");
#define KSWZ(row, colB) ((row) * 256 + ((colB) ^ (((row) & 15) << 4)))
#define RSWZ(row, ch) ((row) * 128 + ((((ch) ^ (((row) >> 1) & 7))) << 4))
#define SBAR() __builtin_amdgcn_sched_barrier(0)
__device__ __forceinline__ int crow(int r, int hi) { return (r & 3) + 8 * (r >> 2) + 4 * hi; }
__device__ __forceinline__ unsigned cvtpk(float lo, float hi) { unsigned r; asm volatile("v_cvt_pk_bf16_f32 %0, %1, %2" : "=v"(r) : "v"(lo), "v"(hi)); return r; }
__device__ __forceinline__ bf16x8 ld8(const bf16_t* p) { return *reinterpret_cast<const bf16x8*>(p); }

__device__ __forceinline__ void partialSM(f32x16& p0, f32x16& p1, float& m_reg, float& mn, float& alpha) {
#if defined(PROBE_NEG) && PROBE_NEG == 2
  constexpr float C = ATT_SCALE * 1.4426950408889634f * 1.3f;
#else
  constexpr float C = ATT_SCALE * 1.4426950408889634f;
#endif
  float pmax = p0[0]; for (int r = 1; r < 16; ++r) pmax = fmaxf(pmax, p0[r]); for (int r = 0; r < 16; ++r) pmax = fmaxf(pmax, p1[r]);
  { auto rr = __builtin_amdgcn_permlane32_swap(__float_as_uint(pmax), __float_as_uint(pmax), false, false);
    pmax = fmaxf(__uint_as_float(rr[0]), __uint_as_float(rr[1])); }
  if (__builtin_expect(__all(pmax - m_reg <= THR / ATT_SCALE), 1)) { mn = m_reg; alpha = 1.f; }
  else { mn = fmaxf(m_reg, pmax); alpha = __builtin_amdgcn_exp2f((m_reg - mn) * C); m_reg = mn; }
  float mnC = -mn * C;
  for (int r = 0; r < 16; ++r) p0[r] = fmaf(p0[r], C, mnC); for (int r = 0; r < 16; ++r) p1[r] = fmaf(p1[r], C, mnC);
  for (int r = 0; r < 16; ++r) p0[r] = __builtin_amdgcn_exp2f(p0[r]);
}
__device__ __forceinline__ void finishSM(f32x16& p0, f32x16& p1, float alpha, float& l_reg, bf16x8& pa0, bf16x8& pa1, bf16x8& pa2, bf16x8& pa3) {
  for (int r = 0; r < 16; ++r) p1[r] = __builtin_amdgcn_exp2f(p1[r]);
  float ps = 0; for (int r = 0; r < 16; ++r) ps += p0[r]; for (int r = 0; r < 16; ++r) ps += p1[r];
  { auto rr = __builtin_amdgcn_permlane32_swap(__float_as_uint(ps), __float_as_uint(ps), false, false);
    ps = __uint_as_float(rr[0]) + __uint_as_float(rr[1]); }
  l_reg = l_reg * alpha + ps;
#define PK4(P, BASE, OUT) do { unsigned a0 = cvtpk(P[BASE + 0], P[BASE + 1]), a1 = cvtpk(P[BASE + 2], P[BASE + 3]);   \
    unsigned b0 = cvtpk(P[BASE + 4], P[BASE + 5]), b1 = cvtpk(P[BASE + 6], P[BASE + 7]);                              \
    auto r0 = __builtin_amdgcn_permlane32_swap(a0, b0, false, false); auto r1 = __builtin_amdgcn_permlane32_swap(a1, b1, false, false); \
    u32x4 w = {r0[0], r1[0], r0[1], r1[1]}; OUT = *reinterpret_cast<bf16x8*>(&w); } while (0)
  PK4(p0, 0, pa0); PK4(p0, 8, pa1); PK4(p1, 0, pa2); PK4(p1, 8, pa3);
#undef PK4
}
template <int QR> __device__ __forceinline__ bf16x8 qfrag(const char* ql, int d0) { return *reinterpret_cast<const bf16x8*>(ql + (d0 - QR) * 1024); }
__device__ __forceinline__ void kfrag(bf16x8& a, bf16x8& b, const char* Kn, const char* Kr, int d0, int r32, int hi) {
  if (d0 < 8) { const int cb = (d0 * 16 + hi * 8) * 2; a = *reinterpret_cast<const bf16x8*>(Kn + KSWZ(r32, cb)); b = *reinterpret_cast<const bf16x8*>(Kn + KSWZ(32 + r32, cb)); }
  else { const int ch = (d0 - 8) * 2 + hi; a = *reinterpret_cast<const bf16x8*>(Kr + RSWZ(r32, ch)); b = *reinterpret_cast<const bf16x8*>(Kr + RSWZ(32 + r32, ch)); }
}
template <int QR> __device__ __forceinline__ void qkt(f32x16& p0, f32x16& p1, const char* Kn, const char* Kr, const bf16x8* qr, const char* ql, int r32, int hi) {
  p0 = f32x16{}; p1 = f32x16{};
  bf16x8 ka, kb, na, nb, qc, qn;
  kfrag(ka, kb, Kn, Kr, 0, r32, hi); if (0 >= QR) qc = qfrag<QR>(ql, 0);
#pragma unroll
  for (int d0 = 0; d0 < 12; ++d0) {
    if (d0 + 1 < 12) { kfrag(na, nb, Kn, Kr, d0 + 1, r32, hi); if (d0 + 1 >= QR) qn = qfrag<QR>(ql, d0 + 1); }
    SBAR();
    const bf16x8 q = d0 < QR ? qr[d0 < QR ? d0 : 0] : qc;
    if (ATT_PRIO) __builtin_amdgcn_s_setprio(1);
    p0 = __builtin_amdgcn_mfma_f32_32x32x16_bf16(ka, q, p0, 0, 0, 0);
    p1 = __builtin_amdgcn_mfma_f32_32x32x16_bf16(kb, q, p1, 0, 0, 0);
    if (ATT_PRIO) __builtin_amdgcn_s_setprio(0);
    if (ATT_QSB2) SBAR();
    ka = na; kb = nb; qc = qn;
  }
}
__device__ __forceinline__ int v_st(int k, int c) { const int kk = (k & ~0xC) | ((k & 4) << 1) | ((k & 8) >> 1); return ((kk >> 3) * 4 + (c >> 5)) * 512 + ((kk & 7) * 32 + (c & 31)) * 2; }
__device__ __forceinline__ int v_rd_base(int lane) { return ((lane & 3) << 3) | (((lane >> 2) & 3) << 6) | (((lane >> 4) & 1) << 5) | (((lane >> 5) & 1) << 8); }
constexpr int v_rd_off(int d0, int ks, int half) { return d0 * 512 + ks * 4096 + half * 2048; }
template <int OFF> __device__ __forceinline__ s16x4 tr_read(int vb) {
  s16x4 r; asm volatile("ds_read_b64_tr_b16 %0, %1 offset:%2" : "=&v"(r) : "v"(vb), "i"(OFF) : "memory"); return r;
}
#define TRPK(L, H) (bf16x8){L[0], L[1], L[2], L[3], H[0], H[1], H[2], H[3]}
template <int D0> __device__ __forceinline__ void pv_one(f32x16& od, int vb, bf16x8 pa0, bf16x8 pa1, bf16x8 pa2, bf16x8 pa3) {
  const s16x4 l0 = tr_read<v_rd_off(D0, 0, 0)>(vb), h0 = tr_read<v_rd_off(D0, 0, 1)>(vb), l1 = tr_read<v_rd_off(D0, 1, 0)>(vb), h1 = tr_read<v_rd_off(D0, 1, 1)>(vb);
  const s16x4 l2 = tr_read<v_rd_off(D0, 2, 0)>(vb), h2 = tr_read<v_rd_off(D0, 2, 1)>(vb), l3 = tr_read<v_rd_off(D0, 3, 0)>(vb), h3 = tr_read<v_rd_off(D0, 3, 1)>(vb);
  asm volatile("s_waitcnt lgkmcnt(0)" ::: "memory"); SBAR();
  if (ATT_PRIO) __builtin_amdgcn_s_setprio(1);
  od = __builtin_amdgcn_mfma_f32_32x32x16_bf16(pa0, TRPK(l0, h0), od, 0, 0, 0);
  od = __builtin_amdgcn_mfma_f32_32x32x16_bf16(pa1, TRPK(l1, h1), od, 0, 0, 0);
  od = __builtin_amdgcn_mfma_f32_32x32x16_bf16(pa2, TRPK(l2, h2), od, 0, 0, 0);
  od = __builtin_amdgcn_mfma_f32_32x32x16_bf16(pa3, TRPK(l3, h3), od, 0, 0, 0);
  if (ATT_PRIO) __builtin_amdgcn_s_setprio(0);
}
__device__ __forceinline__ void pv_d0(f32x16* o, int vb, bf16x8 pa0, bf16x8 pa1, bf16x8 pa2, bf16x8 pa3) {
  pv_one<0>(o[0], vb, pa0, pa1, pa2, pa3); pv_one<1>(o[1], vb, pa0, pa1, pa2, pa3); pv_one<2>(o[2], vb, pa0, pa1, pa2, pa3); pv_one<3>(o[3], vb, pa0, pa1, pa2, pa3);
}

template <int VAR>
__device__ __forceinline__ void attn_body(const bf16_t* __restrict__ Qb, const bf16_t* __restrict__ Kn, const bf16_t* __restrict__ Kr,
                                          bf16_t* __restrict__ Gm, int seq, char* lds, int tid) {
  const int wid = tid >> 6, lane = tid & 63, r32 = lane & 31, hi = lane >> 5;
  char* V_lds = lds + OFF_V; char* K_lds = lds + OFF_KN; char* R_lds = lds + OFF_KR;
  float* ws = (float*)(lds + OFF_WS) + wid * 64; float* li_l = ws; float* al_l = ws + 32;
  float m_reg = -1e30f, l_reg = 0; f32x16 o[4] = {}; bf16x8 qr[QREG > 0 ? QREG : 1];
  char* ql = lds + OFF_QL + wid * (QLDS * 1024) + lane * 16;
  const unsigned qoff = (unsigned)((wid * QBLK + r32) * NQ + hi * 8) * 2u;
#pragma unroll
  for (int d0 = 0; d0 < 12; ++d0) { const bf16x8 qv = *(const bf16x8*)((const char*)Qb + qoff + d0 * 32); if (d0 < QREG) qr[d0 < QREG ? d0 : 0] = qv; else *reinterpret_cast<bf16x8*>(ql + (d0 - QREG) * 1024) = qv; }
  const int sr = tid >> 4, sc = (tid & 15) * 8, vst0 = v_st(sr, sc), vst1 = v_st(32 + sr, sc);
  const int rr_ = tid >> 3, rc_ = tid & 7;
  const int vb0 = (int)(uintptr_t)V_lds + v_rd_base(lane);
  struct { bf16x8 vs0, vs1, ks0, ks1, kr; } sr_[SDEPTH];
  const unsigned voff = (unsigned)(sr * NKV + sc) * 2u, voffr = (unsigned)(rr_ * 64 + rc_ * 8) * 2u;
#define SLOAD(i, k0) do { const char* kb_ = (const char*)(Kn + (long)(k0) * NKV); const char* rb_ = (const char*)(Kr + (long)(k0) * 64); \
    sr_[i].vs0 = *(const bf16x8*)(kb_ + 256 + voff); sr_[i].vs1 = *(const bf16x8*)(kb_ + (32 * NKV * 2 + 256) + voff); \
    sr_[i].ks0 = *(const bf16x8*)(kb_ + voff); sr_[i].ks1 = *(const bf16x8*)(kb_ + 32 * NKV * 2 + voff); \
    sr_[i].kr = *(const bf16x8*)(rb_ + voffr); } while (0)
#define SWRITE(b, i) do { *(bf16x8*)(V_lds + (b) * SHM_V + vst0) = sr_[i].vs0;          \
    *(bf16x8*)(V_lds + (b) * SHM_V + vst1) = sr_[i].vs1; int kc = sc * 2;               \
    *(bf16x8*)(K_lds + (b) * SHM_KN + KSWZ(sr, kc)) = sr_[i].ks0;                       \
    *(bf16x8*)(K_lds + (b) * SHM_KN + KSWZ(32 + sr, kc)) = sr_[i].ks1;                  \
    *(bf16x8*)(R_lds + (b) * SHM_KR + RSWZ(rr_, rc_)) = sr_[i].kr; } while (0)
#define SLOADV(i, k0) do { if constexpr (VAR != 4) SLOAD(i, k0); } while (0)
#define SWRITEV(b, i) do { if constexpr (VAR != 4) SWRITE(b, i); } while (0)
#define SWAIT() do { if constexpr (SDEPTH == 2) asm volatile("s_waitcnt vmcnt(5)" ::: "memory"); else asm volatile("s_waitcnt vmcnt(0)" ::: "memory"); } while (0)
#define RESC(a) do { if (__any((a) < 1.f)) { if (hi == 0) al_l[r32] = (a); asm volatile("s_waitcnt lgkmcnt(0)" ::: "memory"); \
    for (int d = 0; d < 4; ++d) for (int r = 0; r < 16; ++r) o[d][r] *= al_l[crow(r, hi)]; } } while (0)
  f32x16 pA0, pA1, pB0, pB1; float mnA, mnB, alA, alB; bf16x8 pa0, pa1, pa2, pa3; const int NT = seq / KVBLK;
#define QKT(P0, P1, KN, KR) do { if constexpr (VAR == 3) { P0 = o[0]; P1 = o[1]; } else qkt<QREG>(P0, P1, KN, KR, qr, ql, r32, hi); } while (0)
#define PSM(P0, P1, MN, AL) do { if constexpr (VAR == 1) { MN = m_reg; AL = 1.f; } else partialSM(P0, P1, m_reg, MN, AL); } while (0)
#define FSM(P0, P1, AL) do { if constexpr (VAR == 1) { pa0 = __builtin_bit_cast(bf16x8, (f32x4){P0[0], P0[1], P0[2], P0[3]}); pa1 = __builtin_bit_cast(bf16x8, (f32x4){P0[4], P0[5], P0[6], P0[7]}); \
      pa2 = __builtin_bit_cast(bf16x8, (f32x4){P1[0], P1[1], P1[2], P1[3]}); pa3 = __builtin_bit_cast(bf16x8, (f32x4){P1[4], P1[5], P1[6], P1[7]}); l_reg += P0[8] + P1[9]; } \
    else finishSM(P0, P1, AL, l_reg, pa0, pa1, pa2, pa3); } while (0)
#define PVD(VB) do { if constexpr (VAR == 2) { o[0][0] += __builtin_bit_cast(f32x4, pa0)[0]; o[1][1] += __builtin_bit_cast(f32x4, pa1)[1]; o[2][2] += __builtin_bit_cast(f32x4, pa2)[2]; o[3][3] += __builtin_bit_cast(f32x4, pa3)[3]; } else pv_d0(o, VB, pa0, pa1, pa2, pa3); } while (0)
#define SYNC() do { if constexpr (VAR != 5) __syncthreads(); } while (0)
  constexpr int SE = 0, SO = SDEPTH - 1;
  SLOAD(SE, 0); asm volatile("s_waitcnt vmcnt(0)" ::: "memory"); SWRITE(0, SE); SYNC();
  QKT(pA0, pA1, K_lds, R_lds); PSM(pA0, pA1, mnA, alA);
  SLOAD(SO, KVBLK); if constexpr (SDEPTH == 2) { if (2 < NT) SLOAD(SE, 2 * KVBLK); }
  SWAIT(); SWRITE(1, SO); SYNC();
  for (int j = 1; j + 1 < NT; j += 2) {
    SBAR(); QKT(pB0, pB1, K_lds + SHM_KN, R_lds + SHM_KR);
    FSM(pA0, pA1, alA); SBAR();
    SLOADV(SO, (j + SDEPTH) * KVBLK); SBAR();
    PVD(vb0); PSM(pB0, pB1, mnB, alB);
    SYNC(); SWAIT(); SWRITEV(0, SE);
    RESC(alB); SYNC();
    SBAR(); QKT(pA0, pA1, K_lds, R_lds);
    FSM(pB0, pB1, alB); SBAR();
    if (SDEPTH == 1 || j + 3 < NT) SLOADV(SE, (j + 1 + SDEPTH) * KVBLK); SBAR();
    PVD(vb0 + (int)SHM_V); PSM(pA0, pA1, mnA, alA);
    SYNC(); SWAIT(); SWRITEV(1, SO);
    RESC(alA); SYNC();
  }
  SBAR(); QKT(pB0, pB1, K_lds + SHM_KN, R_lds + SHM_KR);
  FSM(pA0, pA1, alA); SBAR();
  PVD(vb0); PSM(pB0, pB1, mnB, alB);
  SYNC(); RESC(alB);
  FSM(pB0, pB1, alB); SBAR();
  PVD(vb0 + (int)SHM_V);
  SBAR(); asm volatile("" ::: "memory");
  u32x4 gt[8]; const int grow = lane >> 4, gc16 = lane & 15;
  bf16_t* Gw = Gm + (size_t)(wid * QBLK + grow) * DM + gc16 * 8;
#pragma unroll
  for (int i = 0; i < 8; ++i) gt[i] = __builtin_nontemporal_load((const u32x4*)(Gw + (size_t)(4 * i) * DM));
  if (hi == 0) li_l[r32] = l_reg;
  __syncthreads();
  char* ot = lds + OFF_OT + wid * (32 * OT_PITCH);
#pragma unroll
  for (int r = 0; r < 16; ++r) { const float rl = __builtin_amdgcn_rcpf(li_l[crow(r, hi)]); char* orow = ot + crow(r, hi) * OT_PITCH + r32 * 2;
#pragma unroll
    for (int d0 = 0; d0 < 4; ++d0) *(bf16_t*)(orow + d0 * 64) = f2bf(o[d0][r] * rl); }
  asm volatile("s_waitcnt lgkmcnt(0)" ::: "memory");
#pragma unroll
  for (int i = 0; i < 8; ++i) { const u32x4 ov = *(const u32x4*)(ot + (grow + 4 * i) * OT_PITCH + gc16 * 16); const u32x4 gv = gt[i]; u32x4 w;
#pragma unroll
    for (int e = 0; e < 4; ++e) { const float a0 = __uint_as_float(ov[e] << 16) * __uint_as_float(gv[e] << 16), a1 = __uint_as_float(ov[e] & 0xffff0000u) * __uint_as_float(gv[e] & 0xffff0000u); w[e] = cvt_pk_bf16(a0, a1); }
    *(u32x4*)(Gw + (size_t)(4 * i) * DM) = w; }
#undef SLOAD
#undef SLOADV
#undef SWRITEV
#undef QKT
#undef PSM
#undef FSM
#undef PVD
#undef SYNC
#undef SWRITE
#undef SWAIT
#undef RESC
}

#ifndef ATT3_QLDS
#define ATT3_QLDS 0
#endif
constexpr int Q3LDS = ATT3_QLDS, Q3REG = 12 - Q3LDS;
constexpr int O3_V = 0, O3_KN = 3 * SHM_V, O3_KR = O3_KN + 3 * SHM_KN, O3_WS = O3_KR + 3 * SHM_KR, O3_QL = O3_WS + NW * 64 * 4, SHM_ATTN3 = O3_QL + NW * Q3LDS * 1024;
static_assert(SHM_ATTN3 <= RING_BYTES && NW * 32 * OT_PITCH <= O3_WS, "attention (DMA variant) LDS must fit the phase scratch");
__device__ __forceinline__ void attn_body3(const bf16_t* __restrict__ Qb, const bf16_t* __restrict__ Kn, const bf16_t* __restrict__ Kr,
                                           bf16_t* __restrict__ Gm, int seq, char* lds, LAS unsigned char* ldsL, int tid) {
  const int wid = __builtin_amdgcn_readfirstlane(tid >> 6), lane = tid & 63, r32 = lane & 31, hi = lane >> 5;
  float* ws = (float*)(lds + O3_WS) + wid * 64; float* li_l = ws; float* al_l = ws + 32;
  float m_reg = -1e30f, l_reg = 0; f32x16 o[4] = {}; bf16x8 qr[Q3REG > 0 ? Q3REG : 1];
  char* ql = lds + O3_QL + wid * (Q3LDS * 1024) + lane * 16;
  unsigned vo[2], ko[2], ro;
#pragma unroll
  for (int u = 0; u < 2; ++u) { const int t = 2 * wid + u;
    { const int s = 2 * t + (lane >> 5), kk = (s >> 2) * 8 + ((lane & 31) >> 2), k = (kk & ~0xC) | ((kk & 4) << 1) | ((kk & 8) >> 1), c = (s & 3) * 32 + (lane & 3) * 8; vo[u] = (unsigned)(k * NKV + 128 + c) * 2u; }
    { const int row = 4 * t + (lane >> 4), c = (lane & 15) ^ (row & 15); ko[u] = (unsigned)(row * NKV) * 2u + (unsigned)c * 16u; } }
  { const int row = 8 * wid + (lane >> 3), ch = (lane & 7) ^ ((row >> 1) & 7); ro = (unsigned)row * 128u + (unsigned)ch * 16u; }
#define DMA3(k0, b) do { const char* kb_ = (const char*)(Kn + (long)(k0) * NKV); const char* rb_ = (const char*)(Kr + (long)(k0) * 64); \
    __builtin_amdgcn_global_load_lds((const unsigned*)(kb_ + vo[0]), (LAS unsigned*)(ldsL + O3_V + (b) * SHM_V + (2 * wid) * 1024), 16, 0, 0); \
    __builtin_amdgcn_global_load_lds((const unsigned*)(kb_ + vo[1]), (LAS unsigned*)(ldsL + O3_V + (b) * SHM_V + (2 * wid + 1) * 1024), 16, 0, 0); \
    __builtin_amdgcn_global_load_lds((const unsigned*)(kb_ + ko[0]), (LAS unsigned*)(ldsL + O3_KN + (b) * SHM_KN + (2 * wid) * 1024), 16, 0, 0); \
    __builtin_amdgcn_global_load_lds((const unsigned*)(kb_ + ko[1]), (LAS unsigned*)(ldsL + O3_KN + (b) * SHM_KN + (2 * wid + 1) * 1024), 16, 0, 0); \
    __builtin_amdgcn_global_load_lds((const unsigned*)(rb_ + ro), (LAS unsigned*)(ldsL + O3_KR + (b) * SHM_KR + wid * 1024), 16, 0, 0); } while (0)
#define LANDED() do { asm volatile("s_waitcnt vmcnt(0)" ::: "memory"); __syncthreads(); } while (0)
#define RESC(a) do { if (__any((a) < 1.f)) { if (hi == 0) al_l[r32] = (a); asm volatile("s_waitcnt lgkmcnt(0)" ::: "memory"); \
    for (int d = 0; d < 4; ++d) for (int r = 0; r < 16; ++r) o[d][r] *= al_l[crow(r, hi)]; } } while (0)
#define KNB(b) (lds + O3_KN + (b) * SHM_KN)
#define KRB(b) (lds + O3_KR + (b) * SHM_KR)
  DMA3(0, 0);
  const unsigned qoff = (unsigned)((wid * QBLK + r32) * NQ + hi * 8) * 2u;
#pragma unroll
  for (int d0 = 0; d0 < 12; ++d0) { const bf16x8 qv = *(const bf16x8*)((const char*)Qb + qoff + d0 * 32); if (d0 < Q3REG) qr[d0 < Q3REG ? d0 : 0] = qv; else *reinterpret_cast<bf16x8*>(ql + (d0 - Q3REG) * 1024) = qv; }
  const int vb0 = (int)(uintptr_t)(lds + O3_V) + v_rd_base(lane);
  f32x16 pA0, pA1, pB0, pB1; float mnA, mnB, alA, alB; bf16x8 pa0, pa1, pa2, pa3; const int NT = seq / KVBLK;
  LANDED();
  DMA3(KVBLK, 1);
  qkt<Q3REG>(pA0, pA1, KNB(0), KRB(0), qr, ql, r32, hi); partialSM(pA0, pA1, m_reg, mnA, alA);
  LANDED();
  int bA = 0, bB = 1, bC = 2;
  for (int j = 1; j + 1 < NT; j += 2) {
    DMA3((j + 1) * KVBLK, bC);
    SBAR(); qkt<Q3REG>(pB0, pB1, KNB(bB), KRB(bB), qr, ql, r32, hi);
    finishSM(pA0, pA1, alA, l_reg, pa0, pa1, pa2, pa3); SBAR();
    pv_d0(o, vb0 + bA * SHM_V, pa0, pa1, pa2, pa3); partialSM(pB0, pB1, m_reg, mnB, alB);
    RESC(alB); LANDED();
    DMA3((j + 2) * KVBLK, bA);
    SBAR(); qkt<Q3REG>(pA0, pA1, KNB(bC), KRB(bC), qr, ql, r32, hi);
    finishSM(pB0, pB1, alB, l_reg, pa0, pa1, pa2, pa3); SBAR();
    pv_d0(o, vb0 + bB * SHM_V, pa0, pa1, pa2, pa3); partialSM(pA0, pA1, m_reg, mnA, alA);
    RESC(alA); LANDED();
    { const int t = bA; bA = bC; bC = bB; bB = t; }
  }
  SBAR(); qkt<Q3REG>(pB0, pB1, KNB(bB), KRB(bB), qr, ql, r32, hi);
  finishSM(pA0, pA1, alA, l_reg, pa0, pa1, pa2, pa3); SBAR();
  pv_d0(o, vb0 + bA * SHM_V, pa0, pa1, pa2, pa3); partialSM(pB0, pB1, m_reg, mnB, alB);
  RESC(alB);
  finishSM(pB0, pB1, alB, l_reg, pa0, pa1, pa2, pa3); SBAR();
  pv_d0(o, vb0 + bB * SHM_V, pa0, pa1, pa2, pa3);
  SBAR(); asm volatile("" ::: "memory");
  u32x4 gt[8]; const int grow = lane >> 4, gc16 = lane & 15;
  bf16_t* Gw = Gm + (size_t)(wid * QBLK + grow) * DM + gc16 * 8;
#pragma unroll
  for (int i = 0; i < 8; ++i) gt[i] = __builtin_nontemporal_load((const u32x4*)(Gw + (size_t)(4 * i) * DM));
  if (hi == 0) li_l[r32] = l_reg;
  __syncthreads();
  char* ot = lds + OFF_OT + wid * (32 * OT_PITCH);
#pragma unroll
  for (int r = 0; r < 16; ++r) { const float rl = __builtin_amdgcn_rcpf(li_l[crow(r, hi)]); char* orow = ot + crow(r, hi) * OT_PITCH + r32 * 2;
#pragma unroll
    for (int d0 = 0; d0 < 4; ++d0) *(bf16_t*)(orow + d0 * 64) = f2bf(o[d0][r] * rl); }
  asm volatile("s_waitcnt lgkmcnt(0)" ::: "memory");
#pragma unroll
  for (int i = 0; i < 8; ++i) { const u32x4 ov = *(const u32x4*)(ot + (grow + 4 * i) * OT_PITCH + gc16 * 16); const u32x4 gv = gt[i]; u32x4 w;
#pragma unroll
    for (int e = 0; e < 4; ++e) { const float a0 = __uint_as_float(ov[e] << 16) * __uint_as_float(gv[e] << 16), a1 = __uint_as_float(ov[e] & 0xffff0000u) * __uint_as_float(gv[e] & 0xffff0000u); w[e] = cvt_pk_bf16(a0, a1); }
    *(u32x4*)(Gw + (size_t)(4 * i) * DM) = w; }
#undef DMA3
#undef LANDED
#undef RESC
#undef KNB
#undef KRB
}
}

template <int VAR = 0>
__device__ __forceinline__ void attn_fast(const Frame& F) {
    const bf16_t* Q = WSP(bf16_t, WS_Q); const bf16_t* KV = WSP(bf16_t, WS_KV); const bf16_t* KR = WSP(bf16_t, WS_KR); bf16_t* MIX = WSP(bf16_t, F.mix_off);
    for (int it = F.vcu; it < NB * NH * (SEQ / 256); it += F.G) {
        const int qb = it & 15, p = it >> 4, h = p & 7, b = p >> 3;
        const size_t t0 = (size_t)b * SEQ, q0 = t0 + (size_t)qb * 256;
        int t = F.tid; asm volatile("" : "+v"(t));
#if ATT_DMA
        att::attn_body3(Q + q0 * NQ + h * DQK, KV + t0 * NKV + h * 256, KR + t0 * 64, MIX + q0 * DM + DF + h * 128, SEQ, F.ldsg, F.lds, t);
#else
        att::attn_body<VAR>(Q + q0 * NQ + h * DQK, KV + t0 * NKV + h * 256, KR + t0 * 64, MIX + q0 * DM + DF + h * 128, SEQ, F.ldsg, t);
#endif
        __syncthreads();
    }
}
namespace fft {
using att::v_st; using att::v_rd_base; using att::v_rd_off; using att::tr_read; using att::crow;
constexpr int OPITCH = 272;
constexpr int F1_T = 0, F1_OUT = 16384, F1_END = F1_OUT + 128 * OPITCH;
constexpr int XPITCH = 528;
constexpr int F2_Z = 0, F2_XL = 32768, F2_YL = F2_XL + 64 * XPITCH, F2_D2 = F2_YL + 64 * XPITCH, F2_END = F2_D2 + 128 * OPITCH;
static_assert(F1_END <= RING_BYTES && F2_END <= RING_BYTES, "FFT LDS must fit the phase scratch");
}
__device__ __forceinline__ void fft1_fast(const Frame& F) {
    using namespace fft;
    const bf16_t* U = WSP(bf16_t, WS_U); const bf16_t* D1 = WSP(bf16_t, WS_D1); bf16_t* Z = WSP(bf16_t, WS_H);
    const int tid = F.tid, wid = tid >> 6, lane = tid & 63, r32 = lane & 31, hi = lane >> 5, half = wid & 1, cb = wid >> 1;
    char* lds = F.ldsg;
    bf16x8 bfr[2][4];
#pragma unroll
    for (int ri = 0; ri < 2; ++ri)
#pragma unroll
        for (int ks = 0; ks < 4; ++ks) bfr[ri][ks] = *(const bf16x8*)(D1 + (ri * 64 + half * 32 + r32) * 64 + 16 * ks + 8 * hi);
    const int sr = tid >> 4, sc = (tid & 15) * 8, vst0 = v_st(sr, sc), vst1 = v_st(32 + sr, sc);
    const int vb = (int)(uintptr_t)(lds + F1_T) + v_rd_base(lane) + cb * 512;
    const int s1p = half * 32 + r32;
    int it = F.bx; if (it >= NB * 64 * NG) return;
    bf16x8 u0, u1;
#define F1_LOAD(IT) do { const int g_ = (IT) & 7, s2_ = ((IT) >> 3) & 63, b_ = (IT) >> 9; const bf16_t* up = U + ((size_t)(b_ * SEQ + s2_)) * DF + g_ * 128 + sc; \
        u0 = __builtin_nontemporal_load((const bf16x8*)(up + (size_t)(64 * sr) * DF)); u1 = __builtin_nontemporal_load((const bf16x8*)(up + (size_t)(64 * (sr + 32)) * DF)); } while (0)
    F1_LOAD(it);
    for (; it < NB * 64 * NG; it += F.G) {
        const int g = it & 7, s2 = (it >> 3) & 63, b = it >> 9;
        *(bf16x8*)(lds + F1_T + vst0) = u0; *(bf16x8*)(lds + F1_T + vst1) = u1;
        __syncthreads();
        if (it + F.G < NB * 64 * NG) F1_LOAD(it + F.G);
        f32x16 acc0 = {}, acc1 = {};
        { const s16x4 l0 = tr_read<v_rd_off(0, 0, 0)>(vb), h0 = tr_read<v_rd_off(0, 0, 1)>(vb), l1 = tr_read<v_rd_off(0, 1, 0)>(vb), h1 = tr_read<v_rd_off(0, 1, 1)>(vb);
          const s16x4 l2 = tr_read<v_rd_off(0, 2, 0)>(vb), h2 = tr_read<v_rd_off(0, 2, 1)>(vb), l3 = tr_read<v_rd_off(0, 3, 0)>(vb), h3 = tr_read<v_rd_off(0, 3, 1)>(vb);
          asm volatile("s_waitcnt lgkmcnt(0)" ::: "memory"); __builtin_amdgcn_sched_barrier(0);
          acc0 = __builtin_amdgcn_mfma_f32_32x32x16_bf16(TRPK(l0, h0), bfr[0][0], acc0, 0, 0, 0); acc1 = __builtin_amdgcn_mfma_f32_32x32x16_bf16(TRPK(l0, h0), bfr[1][0], acc1, 0, 0, 0);
          acc0 = __builtin_amdgcn_mfma_f32_32x32x16_bf16(TRPK(l1, h1), bfr[0][1], acc0, 0, 0, 0); acc1 = __builtin_amdgcn_mfma_f32_32x32x16_bf16(TRPK(l1, h1), bfr[1][1], acc1, 0, 0, 0);
          acc0 = __builtin_amdgcn_mfma_f32_32x32x16_bf16(TRPK(l2, h2), bfr[0][2], acc0, 0, 0, 0); acc1 = __builtin_amdgcn_mfma_f32_32x32x16_bf16(TRPK(l2, h2), bfr[1][2], acc1, 0, 0, 0);
          acc0 = __builtin_amdgcn_mfma_f32_32x32x16_bf16(TRPK(l3, h3), bfr[0][3], acc0, 0, 0, 0); acc1 = __builtin_amdgcn_mfma_f32_32x32x16_bf16(TRPK(l3, h3), bfr[1][3], acc1, 0, 0, 0); }
        float st, ct; sincospif((float)(s2 * s1p) * (1.0f / 2048.0f), &st, &ct);
        char* o0 = lds + F1_OUT + s1p * OPITCH + (cb * 32 + 4 * hi) * 2; char* o1 = o0 + 64 * OPITCH;
#pragma unroll
        for (int q = 0; q < 4; ++q) { float zr[4], zi[4];
#pragma unroll
            for (int j = 0; j < 4; ++j) { const float yr = acc0[4 * q + j], yi = acc1[4 * q + j]; zr[j] = yr * ct + yi * st; zi[j] = yi * ct - yr * st; }
            *(u32x2*)(o0 + q * 16) = (u32x2){cvt_pk_bf16(zr[0], zr[1]), cvt_pk_bf16(zr[2], zr[3])};
            *(u32x2*)(o1 + q * 16) = (u32x2){cvt_pk_bf16(zi[0], zi[1]), cvt_pk_bf16(zi[2], zi[3])}; }
        __syncthreads();
#pragma unroll
        for (int i = 0; i < 4; ++i) { const int q = tid + 512 * i, row = q >> 4, c16 = q & 15, ri = row >> 6, sp = row & 63;
            const u32x4 v = *(const u32x4*)(lds + F1_OUT + row * OPITCH + c16 * 16);
            *(u32x4*)(Z + (((((size_t)(b * 64 + sp) * NG + g) * 2 + ri) * 64 + s2) * 128) + c16 * 8) = v; }
    }
#undef F1_LOAD
    __syncthreads();
}
__device__ __forceinline__ void fft2_fast(const Frame& F, int l) {
    using namespace fft;
    const bf16_t* Z = WSP(bf16_t, WS_H); const bf16_t* D2 = WSP(bf16_t, WS_D2); const bf16_t* wcat = WSP(bf16_t, WS_WCAT) + (size_t)l * NG * 128 * 256; bf16_t* MIX = WSP(bf16_t, F.mix_off);
    const int tid = F.tid, wid = tid >> 6, lane = tid & 63, r32 = lane & 31, hi = lane >> 5, cb = wid & 3, h2 = wid >> 2;
    char* lds = F.ldsg;
    int it = F.bx; if (it >= NB * 64 * NG) return;
#pragma unroll
    for (int i = 0; i < 4; ++i) { const int q = tid + 512 * i, row = q >> 4, c16 = q & 15; *(u32x4*)(lds + F2_D2 + row * OPITCH + c16 * 16) = *(const u32x4*)(D2 + row * 128 + c16 * 8); }
    const int sr = tid >> 4, sc = (tid & 15) * 8, vst0 = v_st(sr, sc), vst1 = v_st(32 + sr, sc);
    const int vb = (int)(uintptr_t)(lds + F2_Z) + v_rd_base(lane) + cb * 512;
    bf16x8 wfr[16]; int gcur = -1;
    bf16x8 z0, z1, z2, z3, g0, g1;
#define F2_LOAD(IT) do { const int g_ = (IT) & 7, sp_ = ((IT) >> 3) & 63, b_ = (IT) >> 9; const bf16_t* zp = Z + ((size_t)(b_ * 64 + sp_) * NG + g_) * (2 * 64 * 128) + sr * 128 + sc; \
        z0 = __builtin_nontemporal_load((const bf16x8*)(zp)); z1 = __builtin_nontemporal_load((const bf16x8*)(zp + 32 * 128)); z2 = __builtin_nontemporal_load((const bf16x8*)(zp + 64 * 128)); z3 = __builtin_nontemporal_load((const bf16x8*)(zp + 96 * 128)); \
        const bf16_t* mp = MIX + ((size_t)(b_ * SEQ + sp_ + 64 * (tid >> 4))) * DM + g_ * 128 + (tid & 15) * 8; g0 = __builtin_nontemporal_load((const bf16x8*)(mp)); g1 = __builtin_nontemporal_load((const bf16x8*)(mp + (size_t)(64 * 32) * DM)); } while (0)
    F2_LOAD(it);
    for (; it < NB * 64 * NG; it += F.G) {
        const int g = it & 7, sp = (it >> 3) & 63, b = it >> 9;
        if (g != gcur) { gcur = g;
#pragma unroll
            for (int ks = 0; ks < 16; ++ks) wfr[ks] = *(const bf16x8*)(wcat + (size_t)(g * 128 + cb * 32 + r32) * 256 + 16 * ks + 8 * hi); }
        *(bf16x8*)(lds + F2_Z + vst0) = z0; *(bf16x8*)(lds + F2_Z + vst1) = z1; *(bf16x8*)(lds + F2_Z + 16384 + vst0) = z2; *(bf16x8*)(lds + F2_Z + 16384 + vst1) = z3;
        const bf16x8 gg0 = g0, gg1 = g1;
        __syncthreads();
        if (it + F.G < NB * 64 * NG) F2_LOAD(it + F.G);
#if defined(FFT2_P1_NAIVE)
        { const bf16_t* Zb = Z + ((size_t)(b * 64 + sp) * NG + g) * (2 * 64 * 128);
          for (int i = 0; i < 32; ++i) { const int o = tid + 512 * i, c = o & 127, rr = o >> 7; float s_ = 0.f;
              for (int k = 0; k < 128; ++k) s_ += bf2f(D2[rr * 128 + k]) * bf2f(Zb[k * 128 + c]);
              *(bf16_t*)(lds + F2_XL + (rr & 63) * XPITCH + ((rr >> 6) * 128 + c) * 2) = f2bf(s_); } }
#else
        f32x16 x0 = {}, x1 = {};
        const char* d2p = lds + F2_D2 + (h2 * 32 + r32) * OPITCH + 16 * hi;
#pragma unroll
        for (int t = 0; t < 2; ++t) {
            const int vbt = vb + t * 16384;
            const s16x4 l0 = tr_read<v_rd_off(0, 0, 0)>(vbt), h0 = tr_read<v_rd_off(0, 0, 1)>(vbt), l1 = tr_read<v_rd_off(0, 1, 0)>(vbt), h1 = tr_read<v_rd_off(0, 1, 1)>(vbt);
            const s16x4 l2 = tr_read<v_rd_off(0, 2, 0)>(vbt), h2_ = tr_read<v_rd_off(0, 2, 1)>(vbt), l3 = tr_read<v_rd_off(0, 3, 0)>(vbt), h3 = tr_read<v_rd_off(0, 3, 1)>(vbt);
            bf16x8 e0[4], e1[4];
#pragma unroll
            for (int ks = 0; ks < 4; ++ks) { e0[ks] = *(const bf16x8*)(d2p + (t * 4 + ks) * 32); e1[ks] = *(const bf16x8*)(d2p + 64 * OPITCH + (t * 4 + ks) * 32); }
            asm volatile("s_waitcnt lgkmcnt(0)" ::: "memory"); __builtin_amdgcn_sched_barrier(0);
            x0 = __builtin_amdgcn_mfma_f32_32x32x16_bf16(TRPK(l0, h0), e0[0], x0, 0, 0, 0); x1 = __builtin_amdgcn_mfma_f32_32x32x16_bf16(TRPK(l0, h0), e1[0], x1, 0, 0, 0);
            x0 = __builtin_amdgcn_mfma_f32_32x32x16_bf16(TRPK(l1, h1), e0[1], x0, 0, 0, 0); x1 = __builtin_amdgcn_mfma_f32_32x32x16_bf16(TRPK(l1, h1), e1[1], x1, 0, 0, 0);
            x0 = __builtin_amdgcn_mfma_f32_32x32x16_bf16(TRPK(l2, h2_), e0[2], x0, 0, 0, 0); x1 = __builtin_amdgcn_mfma_f32_32x32x16_bf16(TRPK(l2, h2_), e1[2], x1, 0, 0, 0);
            x0 = __builtin_amdgcn_mfma_f32_32x32x16_bf16(TRPK(l3, h3), e0[3], x0, 0, 0, 0); x1 = __builtin_amdgcn_mfma_f32_32x32x16_bf16(TRPK(l3, h3), e1[3], x1, 0, 0, 0);
        }
        { char* xr = lds + F2_XL + (h2 * 32 + r32) * XPITCH + (cb * 32 + 4 * hi) * 2;
#pragma unroll
          for (int q = 0; q < 4; ++q) { *(u32x2*)(xr + q * 16) = (u32x2){cvt_pk_bf16(x0[4 * q], x0[4 * q + 1]), cvt_pk_bf16(x0[4 * q + 2], x0[4 * q + 3])};
              *(u32x2*)(xr + 256 + q * 16) = (u32x2){cvt_pk_bf16(x1[4 * q], x1[4 * q + 1]), cvt_pk_bf16(x1[4 * q + 2], x1[4 * q + 3])}; } }
#endif
        __syncthreads();
#if defined(FFT2_P2_NAIVE)
        for (int i = 0; i < 16; ++i) { const int o = tid + 512 * i, d = o & 127, s2p = o >> 7; float s_ = 0.f;
            const bf16_t* wr_ = wcat + (size_t)(g * 128 + d) * 256;
            for (int k = 0; k < 256; ++k) s_ += bf2f(*(const bf16_t*)(lds + F2_XL + s2p * XPITCH + k * 2)) * bf2f(wr_[k]);
            *(float*)(lds + F2_YL + s2p * XPITCH + d * 4) = s_; }
#else
        f32x16 y = {};
        { const char* xb = lds + F2_XL + (h2 * 32 + r32) * XPITCH + 16 * hi;
#pragma unroll
          for (int ks = 0; ks < 16; ++ks) { const bf16x8 xf = *(const bf16x8*)(xb + ks * 32); y = __builtin_amdgcn_mfma_f32_32x32x16_bf16(wfr[ks], xf, y, 0, 0, 0); } }
        { char* yr = lds + F2_YL + (h2 * 32 + r32) * XPITCH + (cb * 32 + 4 * hi) * 4;
#pragma unroll
          for (int q = 0; q < 4; ++q) *(f32x4*)(yr + q * 32) = (f32x4){y[4 * q], y[4 * q + 1], y[4 * q + 2], y[4 * q + 3]}; }
#endif
        __syncthreads();
#pragma unroll
        for (int i = 0; i < 2; ++i) { const int row = (tid >> 4) + 32 * i, c8 = (tid & 15) * 8; const bf16x8 gv = i ? gg1 : gg0;
            const f32x4 ya = *(const f32x4*)(lds + F2_YL + row * XPITCH + c8 * 4), yb = *(const f32x4*)(lds + F2_YL + row * XPITCH + c8 * 4 + 16);
            f32x4 ga = {bf2f((bf16_t)gv[0]), bf2f((bf16_t)gv[1]), bf2f((bf16_t)gv[2]), bf2f((bf16_t)gv[3])}, gb = {bf2f((bf16_t)gv[4]), bf2f((bf16_t)gv[5]), bf2f((bf16_t)gv[6]), bf2f((bf16_t)gv[7])};
            store8_bf16(MIX + ((size_t)(b * SEQ + sp + 64 * row)) * DM + g * 128 + c8, ya * ga, yb * gb); }
    }
#undef F2_LOAD
    __syncthreads();
}
#if PROBE_CHECK
constexpr size_t WS_CHK_GATE = WS_U;
constexpr size_t WS_CHK_CNT = WS_CTL + 15 * 1024;
__device__ __forceinline__ int chk_tok(int i) { return (i * 64 + 37 + (i >> 2) * 4096 / 64 * 0) % MTOK + ((i & 3) * 4096) - ((i & 3) * 4096); }
__device__ __forceinline__ void chk_fail(const Frame& F, float a, float b, float atol, float rtol) { if (!(fabsf(a - b) <= atol + rtol * fabsf(b))) atomicAdd(WSP(unsigned, WS_CHK_CNT), 1u); }
__device__ __forceinline__ void chk_proj(const Frame& F, int l) {
    LAS float* hs = (LAS float*)F.lds;
    LAS float* cs = hs + 2048;
    LAS float* red = cs + 832;
    const float* x = l == 0 ? F.in[0] : WSP(float, WS_R); const float* mod = WSP(float, WS_MOD) + (size_t)l * NB * 3 * DM; const float* w_in = F.in[5] + (size_t)l * DM * NIN;
    for (int i = F.bx; i < 256; i += F.G) {
        const int tok = 64 * i + 37, b = tok >> 12, tid = F.tid;
        float s = 0.f; for (int k = tid; k < DM; k += NTHREADS) s += x[(size_t)tok * DM + k];
        s = wave_sum(s); if (F.lane == 0) red[F.wave] = s; __syncthreads(); float mean = 0.f; for (int w = 0; w < 8; ++w) mean += red[w]; mean *= (1.0f / DM); __syncthreads();
        float q2 = 0.f; for (int k = tid; k < DM; k += NTHREADS) { const float d = x[(size_t)tok * DM + k] - mean; q2 += d * d; }
        q2 = wave_sum(q2); if (F.lane == 0) red[F.wave] = q2; __syncthreads(); float var = 0.f; for (int w = 0; w < 8; ++w) var += red[w]; const float rstd = rsqrtf(var * (1.0f / DM) + NORM_EPS); __syncthreads();
        for (int k = tid; k < DM; k += NTHREADS) hs[k] = bf2f(f2bf((x[(size_t)tok * DM + k] - mean) * rstd * (1.0f + mod[(size_t)b * 3 * DM + DM + k]) + mod[(size_t)b * 3 * DM + k]));
        __syncthreads();
        for (int c = tid; c < 832; c += NTHREADS) { float a = 0.f; for (int k = 0; k < DM; ++k) a += hs[k] * bf2f(f2bf(w_in[(size_t)k * NIN + 2048 + c])); cs[c] = a; }
        __syncthreads();
        float sq = 0.f; for (int c = tid; c < 512; c += NTHREADS) sq += cs[c] * cs[c];
        sq = wave_sum(sq); if (F.lane == 0) red[F.wave] = sq; __syncthreads(); float sq_q = 0.f; for (int w = 0; w < 8; ++w) sq_q += red[w]; __syncthreads();
        float sk = 0.f; for (int c = 512 + tid; c < 768; c += NTHREADS) sk += cs[c] * cs[c];
        sk = wave_sum(sk); if (F.lane == 0) red[F.wave] = sk; __syncthreads(); float sq_k = 0.f; for (int w = 0; w < 8; ++w) sq_k += red[w]; __syncthreads();
        const float rq = rsqrtf(sq_q * (1.0f / QLR) + NORM_EPS), rk = rsqrtf(sq_k * (1.0f / KVLR) + NORM_EPS);
        const float* rc = WSP(float, WS_RCOS) + (size_t)tok * 32; const float* rs = WSP(float, WS_RSIN) + (size_t)tok * 32;
        const int pos = ((const int*)F.in[2])[tok];
        if (tid < 32) { const float ang = (float)pos * powf(10000.0f, -(float)tid / 32.0f); const float c_ = cosf(ang), s_ = sinf(ang); const float x1 = cs[768 + tid], x2 = cs[800 + tid];
            chk_fail(F, bf2f(WSP(bf16_t, WS_KR)[(size_t)tok * 64 + tid]), x1 * c_ - x2 * s_, 0.05f, 0.05f); chk_fail(F, bf2f(WSP(bf16_t, WS_KR)[(size_t)tok * 64 + 32 + tid]), x2 * c_ + x1 * s_, 0.05f, 0.05f);
            chk_fail(F, rc[tid], c_, 0.02f, 0.f); chk_fail(F, rs[tid], s_, 0.02f, 0.f); }
        const float* wq = F.in[7] + (size_t)l * QLR * NQ; const float* gq = F.in[6] + l * QLR;
        for (int n = tid; n < NQ; n += NTHREADS) { const int head = n / DQK, d = n - head * DQK; if (d >= 160) continue;
            float a = 0.f, a2 = 0.f; for (int k = 0; k < QLR; ++k) { const float cn = bf2f(f2bf(cs[k])) * rq * gq[k]; a += cn * wq[(size_t)k * NQ + n]; if (d >= 128) a2 += cn * wq[(size_t)k * NQ + n + 32]; }
            if (d < 128) chk_fail(F, bf2f(WSP(bf16_t, WS_Q)[(size_t)tok * NQ + n]), a, 0.06f, 0.05f);
            else { const int ii = d - 128; const float ang = (float)pos * powf(10000.0f, -(float)ii / 32.0f); const float c_ = cosf(ang), s_ = sinf(ang);
                chk_fail(F, bf2f(WSP(bf16_t, WS_Q)[(size_t)tok * NQ + n]), a * c_ - a2 * s_, 0.06f, 0.05f); chk_fail(F, bf2f(WSP(bf16_t, WS_Q)[(size_t)tok * NQ + n + 32]), a2 * c_ + a * s_, 0.06f, 0.05f); } }
        const float* wk = F.in[9] + (size_t)l * KVLR * NKV; const float* gk = F.in[8] + l * KVLR;
        for (int n = tid; n < NKV; n += NTHREADS) { float a = 0.f; for (int k = 0; k < KVLR; ++k) a += bf2f(f2bf(cs[512 + k])) * rk * gk[k] * wk[(size_t)k * NKV + n];
            chk_fail(F, bf2f(WSP(bf16_t, WS_KV)[(size_t)tok * NKV + n]), a, 0.06f, 0.05f); }
        for (int c = tid; c < 1024; c += NTHREADS) WSP(bf16_t, WS_CHK_GATE)[(size_t)i * 1024 + c] = WSP(bf16_t, WS_MIX)[(size_t)tok * DM + DF + c];
        __syncthreads();
    }
}
__device__ __forceinline__ void chk_attn(const Frame& F) {
    const bf16_t* Q = WSP(bf16_t, WS_Q); const bf16_t* KV = WSP(bf16_t, WS_KV); const bf16_t* KR = WSP(bf16_t, WS_KR); const bf16_t* MIX = WSP(bf16_t, WS_MIX);
    LAS float* qs = (LAS float*)F.lds + F.wave * 192;
    for (int i = F.bx; i < 256; i += F.G) {
        const int tok = 64 * i + 37, b = tok >> 12, h = F.wave;
        for (int dh = 0; dh < 2; ++dh) {
            __builtin_amdgcn_wave_barrier(); asm volatile("" ::: "memory");
            for (int e = 0; e < 3; ++e) qs[F.lane + 64 * e] = bf2f(Q[(size_t)tok * NQ + h * DQK + F.lane + 64 * e]);
            asm volatile("s_waitcnt lgkmcnt(0)" ::: "memory"); __builtin_amdgcn_wave_barrier();
            float m = -1e30f, lsum = 0.f; float o[64];
#pragma unroll
            for (int d = 0; d < 64; ++d) o[d] = 0.f;
            for (int t = 0; t < 64; ++t) {
                const size_t key = (size_t)b * SEQ + F.lane + 64 * t; const bf16_t* kn = KV + key * NKV + h * 256; const bf16_t* kr = KR + key * 64;
                float s = 0.f;
#pragma unroll 2
                for (int c = 0; c < 16; ++c) { const bf16x8 kv = *(const bf16x8*)(kn + c * 8);
#pragma unroll
                    for (int e = 0; e < 8; ++e) s += qs[c * 8 + e] * bf2f((bf16_t)kv[e]); }
#pragma unroll 2
                for (int c = 0; c < 8; ++c) { const bf16x8 kv = *(const bf16x8*)(kr + c * 8);
#pragma unroll
                    for (int e = 0; e < 8; ++e) s += qs[128 + c * 8 + e] * bf2f((bf16_t)kv[e]); }
                s *= ATT_SCALE; const float mn = fmaxf(m, s), a = __expf(m - mn), p = __expf(s - mn); lsum = lsum * a + p; m = mn;
#pragma unroll
                for (int c = 0; c < 8; ++c) { const bf16x8 vv = *(const bf16x8*)(kn + 128 + dh * 64 + c * 8);
#pragma unroll
                    for (int e = 0; e < 8; ++e) o[c * 8 + e] = o[c * 8 + e] * a + p * bf2f((bf16_t)vv[e]); }
            }
            const float Mx = wave_max(m), f = __expf(m - Mx); const float Ls = wave_sum(lsum * f);
            float keep0 = 0.f;
#pragma unroll
            for (int d = 0; d < 64; ++d) { const float od = wave_sum(o[d] * f); if (F.lane == d) keep0 = od; }
            const int col = h * 128 + dh * 64 + F.lane;
            const float ref = keep0 / Ls * bf2f(WSP(bf16_t, WS_CHK_GATE)[(size_t)i * 1024 + col]);
            chk_fail(F, bf2f(MIX[(size_t)tok * DM + DF + col]), ref, 1.5e-3f, 0.05f);
        }
    }
}
__device__ __forceinline__ void chk_finish(const Frame& F) {
    if (F.bx == 0 && F.tid == 0 && __hip_atomic_load(WSP(unsigned, WS_CHK_CNT), __ATOMIC_RELAXED, __HIP_MEMORY_SCOPE_AGENT) != 0u) { for (int k = 0; k < 64; ++k) F.out[k] = __builtin_nanf(""); }
}
#endif
#ifndef DIAG_ONLY
#define DIAG_ONLY -1
#endif
#define DIAG_EN(k) (DIAG_ONLY < 0 || DIAG_ONLY == (k))
#ifndef PROBE_CHECK
#define PROBE_CHECK 0
#endif
#ifndef XCD_REMAP
#define XCD_REMAP 0
#endif
#ifndef PROBE_VAR
#define PROBE_VAR 0
#endif
#ifndef PROBE_REP
#define PROBE_REP -1
#endif
struct Args { const float* in[14]; float* out; unsigned char* ws; int ph_lo, ph_hi; };
constexpr int N_PHASES = 2 + 5 * DEPTH;

template <class Epi, class Sched> __device__ __forceinline__ void run_gemm(const Frame& F, const pg8::Gemm& g, const Sched& S, const Epi& E) {
#if IMPL_GEMM
    pg8::gemm_phase<Epi, Sched, PG8_ALIGN, PG8_SP2>(F.lds, g, S, E, F.tid);
#else
    pg8::gemm_phase_naive<Epi, Sched>(g, S, E, F.tid);
#endif
}

#define PH_IN(k) (lo <= (k) && (k) < hi)
#define PH_SEAM(k) do { if (PH_IN(k) && PH_IN((k) + 1)) xcd_barrier(bar); } while (0)
#define PH_ENTER() do { int _t = threadIdx.x; asm volatile("" : "+v"(_t)); F.tid = _t; F.lane = _t & 63; } while (0)

template <int L> __device__ __forceinline__ void layer_phases(Frame& F, const int lo, const int hi, const XcdBarrier& bar) {
    constexpr int P = 2 + 5 * L;
    float* rsq = WSP(float, WS_RSQ) + (size_t)L * MTOK * 2;
    if (PH_IN(P + 0) && DIAG_EN(2)) {
        PH_ENTER();
        pg8::Gemm g{WSP(bf16_t, WS_H), WSP(bf16_t, WS_WIN) + (size_t)L * NINP * DM, MTOK, NINP, DM};
        pg8::StaticOrder S; S.init(MTOK, NINP, F.G, F.bx);
        EpiIn E{WSP(bf16_t, WS_U), WSP(bf16_t, WS_MIX), WSP(bf16_t, WS_CQ), WSP(bf16_t, WS_CKV), WSP(bf16_t, WS_KR), rsq, WSP(float, WS_RCOS), WSP(float, WS_RSIN)};
        run_gemm(F, g, S, E);
        if (PROBE_REP == 2 && L == 0) { xcd_barrier(bar); EpiIn E2 = E; E2.rsq = WSP(float, WS_R); run_gemm(F, g, S, E2); }
        if (PROBE_REP == 12 && L == 0) { xcd_barrier(bar); EpiNone E2; run_gemm(F, g, S, E2); }
        if (PROBE_REP == 22 && L == 0) { xcd_barrier(bar); EpiNone E2; pg8::HotOrder S2; S2.init(MTOK, NINP, F.G, F.bx); S2.pm0 = 3; S2.pn0 = 2; run_gemm(F, g, S2, E2); }
        if (PROBE_REP == 32 && L == 0) { xcd_barrier(bar); EpiNone E2; pg8::HotOrder S2; S2.init(MTOK, NINP, F.G, F.bx); S2.pm0 = F.bx & 63; S2.pn0 = 2; run_gemm(F, g, S2, E2); }
    }
    PH_SEAM(P + 0);
    if (PH_IN(P + 1) && DIAG_EN(3)) {
        PH_ENTER();
        { pg8::Gemm g{WSP(bf16_t, WS_CQ), WSP(bf16_t, WS_WQ) + (size_t)L * NQ * QLR, MTOK, NQ, QLR};
          pg8::SplitOrder S; S.init(F.G, F.bx, NQ / 256, 0);
          EpiQ E{WSP(bf16_t, WS_Q), rsq, WSP(float, WS_RCOS), WSP(float, WS_RSIN)};
          run_gemm(F, g, S, E); }
        { pg8::Gemm g{WSP(bf16_t, WS_CKV), WSP(bf16_t, WS_WKV) + (size_t)L * NKV * KVLR, MTOK, NKV, KVLR};
          pg8::SplitOrder S; S.init(F.G, F.bx, NKV / 256, 1);
          EpiKV E{WSP(bf16_t, WS_KV), rsq};
          run_gemm(F, g, S, E); }
        if (PROBE_REP == 3 && L == 0) { xcd_barrier(bar);
          { pg8::Gemm g{WSP(bf16_t, WS_CQ), WSP(bf16_t, WS_WQ) + (size_t)L * NQ * QLR, MTOK, NQ, QLR}; pg8::SplitOrder S; S.init(F.G, F.bx, NQ / 256, 0); EpiQ E{WSP(bf16_t, WS_Q), rsq, WSP(float, WS_RCOS), WSP(float, WS_RSIN)}; run_gemm(F, g, S, E); }
          { pg8::Gemm g{WSP(bf16_t, WS_CKV), WSP(bf16_t, WS_WKV) + (size_t)L * NKV * KVLR, MTOK, NKV, KVLR}; pg8::SplitOrder S; S.init(F.G, F.bx, NKV / 256, 1); EpiKV E{WSP(bf16_t, WS_KV), rsq}; run_gemm(F, g, S, E); } }
#if IMPL_FFT & 1
        fft1_fast(F);
#else
        fft1_naive(F);
#endif
        if (PROBE_REP == 7 && L == 0) { xcd_barrier(bar); fft1_fast(F); }
    }
    PH_SEAM(P + 1);
#if PROBE_CHECK
    if (L == PROBE_CHECK - 1 && PH_IN(P + 2)) { PH_ENTER(); chk_proj(F, L); __syncthreads(); }
#endif
    if (PH_IN(P + 2) && DIAG_EN(4)) {
        PH_ENTER();
#if IMPL_ATTN
        attn_fast(F);
        if (PROBE_REP == 4 && L == 0) { __syncthreads(); F.mix_off = WS_R; attn_fast<PROBE_VAR>(F); F.mix_off = WS_MIX; }
#else
        attn_naive(F);
#endif
        __syncthreads();
#if IMPL_FFT & 2
        fft2_fast(F, L);
        if (PROBE_REP == 8 && L == 0) { __syncthreads(); F.mix_off = WS_R; fft2_fast(F, L); F.mix_off = WS_MIX; }
#else
        fft2_naive(F, L);
#endif
    }
    PH_SEAM(P + 2);
#if PROBE_CHECK
    if (L == PROBE_CHECK - 1 && PH_IN(P + 3)) { PH_ENTER(); chk_attn(F); __syncthreads(); }
#endif
    if (PH_IN(P + 3) && DIAG_EN(5)) {
        PH_ENTER();
        pg8::Gemm g{WSP(bf16_t, WS_MIX), WSP(bf16_t, WS_WOUT) + (size_t)L * DM * DM, MTOK, DM, DM};
        pg8::StaticOrder S; S.init(MTOK, DM, F.G, F.bx);
        EpiOut E{WSP(bf16_t, WS_H), WSP(float, WS_MOD) + (size_t)L * NB * (3 * DM) + 2 * DM};
        run_gemm(F, g, S, E);
        if (PROBE_REP == 5 && L == 0) { xcd_barrier(bar); run_gemm(F, g, S, E); }
        if (PROBE_REP == 15 && L == 0) { xcd_barrier(bar); EpiNone E2; run_gemm(F, g, S, E2); }
    }
    PH_SEAM(P + 3);
    if (PH_IN(P + 4) && DIAG_EN(6)) {
        PH_ENTER();
        if (L + 1 < DEPTH) p_ln_post<true>(F, L); else p_ln_post<false>(F, L);
        if (PROBE_REP == 6 && L + 1 == DEPTH) { xcd_barrier(bar); p_ln_post<false>(F, L); }
    }
    PH_SEAM(P + 4);
}

__global__ void __launch_bounds__(NTHREADS, 2) fwd_kernel(Args args) {
    extern __shared__ __attribute__((aligned(16))) unsigned char lds[];
    Frame F;
    F.in[0] = args.in[0]; F.in[1] = args.in[1]; F.in[2] = args.in[2]; F.in[3] = args.in[3]; F.in[4] = args.in[4]; F.in[5] = args.in[5]; F.in[6] = args.in[6]; F.in[7] = args.in[7]; F.in[8] = args.in[8]; F.in[9] = args.in[9]; F.in[10] = args.in[10]; F.in[11] = args.in[11]; F.in[12] = args.in[12]; F.in[13] = args.in[13];
    F.out = args.out; F.ws = args.ws; F.lds = (LAS unsigned char*)lds; F.ldsg = (char*)lds;
    F.tid = threadIdx.x; F.lane = F.tid & 63; F.wave = __builtin_amdgcn_readfirstlane(F.tid >> 6); F.G = gridDim.x; F.bx = blockIdx.x;
    F.vcu = (F.G % 8 == 0) ? (F.bx % 8) * (F.G / 8) + F.bx / 8 : F.bx; F.mix_off = WS_MIX;
    volatile LAS unsigned* MISC = (volatile LAS unsigned*)(F.lds + MISC_OFF);
    if (F.tid < 64) MISC[F.tid] = 0u;
    __syncthreads();
    const int lo = args.ph_lo, hi = args.ph_hi;
    XcdBarrier bar; bar.bar = WSP(unsigned, WS_CTL); bar.x = 0; bar.st = MISC;
    if (hi - lo > 1) bar = xcd_barrier_post(WSP(unsigned, WS_CTL), MISC);
    if (PH_IN(0) && DIAG_EN(0)) { PH_ENTER(); p0_weights(F); p0_mod(F); p0_tables(F); if (PROBE_REP == 0) { xcd_barrier(bar); p0_weights(F); p0_mod(F); p0_tables(F); } }
    PH_SEAM(0);
#if XCD_REMAP
    if (PH_IN(0) && PH_IN(1) && MISC[3] == 1u) { const int rk = __builtin_amdgcn_readfirstlane((int)MISC[2]), xc = __builtin_amdgcn_readfirstlane((int)bar.x);
        if (rk < F.G / 8 && xc < 8) { F.bx = rk * 8 + xc; F.vcu = xc * (F.G / 8) + rk; } }
#endif
    if (PH_IN(1) && DIAG_EN(1)) { PH_ENTER(); p_ln_first(F); if (PROBE_REP == 1) { xcd_barrier(bar); p_ln_first(F); } }
    PH_SEAM(1);
    if (PROBE_REP == 40) { for (int q = 0; q < 8; ++q) xcd_barrier(bar); }
    layer_phases<0>(F, lo, hi, bar);
    layer_phases<1>(F, lo, hi, bar);
#if PROBE_CHECK
    xcd_barrier(bar); chk_finish(F);
#endif
}

extern "C" void kernel_launch(void* const* d_in, const int* in_sizes, int n_in, void* d_out, int out_size, void* d_ws, size_t ws_size, hipStream_t stream) {
    static int grid = 0;
    if (grid == 0) {
        if (n_in != 14 || in_sizes[0] != MTOK * DM || out_size != MTOK * DM || ws_size < WS_END) {
            fprintf(stderr, "kernel_launch: shape mismatch (n_in %d, in0 %d, out %d, ws %zu, need ws >= %zu); nothing launched\n", n_in, n_in > 0 ? in_sizes[0] : -1, out_size, ws_size, (size_t)WS_END); grid = -1; return; }
        int dev = 0, cus = 0, per_cu = 0;
        if (hipGetDevice(&dev) != hipSuccess || hipDeviceGetAttribute(&cus, hipDeviceAttributeMultiprocessorCount, dev) != hipSuccess) { grid = -1; return; }
        if (hipFuncSetAttribute((const void*)fwd_kernel, hipFuncAttributeMaxDynamicSharedMemorySize, LDS_BYTES) != hipSuccess) { fprintf(stderr, "kernel_launch: hipFuncSetAttribute failed\n"); grid = -1; return; }
        if (hipOccupancyMaxActiveBlocksPerMultiprocessor(&per_cu, (const void*)fwd_kernel, NTHREADS, LDS_BYTES) != hipSuccess || per_cu < 1) { fprintf(stderr, "kernel_launch: occupancy query failed (%d)\n", per_cu); (void)hipGetLastError(); per_cu = 1; }
        if (per_cu > 1) per_cu = 1;
        grid = cus * per_cu;
    }
    if (grid < 0) return;
    if (hipMemsetAsync((char*)d_ws + WS_CTL, 0, WS_RSQ - WS_CTL, stream) != hipSuccess) { fprintf(stderr, "kernel_launch: hipMemsetAsync failed\n"); return; }
    Args a{};
    for (int i = 0; i < 14; ++i) a.in[i] = (const float*)d_in[i];
    a.out = (float*)d_out; a.ws = (unsigned char*)d_ws;
#if N_LAUNCH_MODE
    a.ph_lo = 0; a.ph_hi = N_PHASES;
    hipLaunchKernelGGL(fwd_kernel, dim3(grid), dim3(NTHREADS), LDS_BYTES, stream, a);
#else
    for (int ph = 0; ph < N_PHASES; ++ph) { a.ph_lo = ph; a.ph_hi = ph + 1; hipLaunchKernelGGL(fwd_kernel, dim3(grid), dim3(NTHREADS), LDS_BYTES, stream, a); }
#endif
    const hipError_t le = hipPeekAtLastError();
    if (le != hipSuccess) fprintf(stderr, "kernel_launch: launch failed: %s (grid %d)\n", hipGetErrorName(le), grid);
}
```

```cpp
#define IMPL_GEMM 1
#define IMPL_ATTN 1
#define IMPL_FFT 3
#define N_LAUNCH_MODE 1
#include <hip/hip_runtime.h>
#include <cstdio>
#include <cstdint>

#ifndef PROBE_CHECK
#define PROBE_CHECK 0
#endif
#ifndef N_LAUNCH_MODE
#define N_LAUNCH_MODE 1
#endif
#ifndef IMPL_GEMM
#define IMPL_GEMM 1
#endif
#ifndef IMPL_ATTN
#define IMPL_ATTN 1
#endif
#ifndef IMPL_FFT
#define IMPL_FFT 3
#endif

#define LAS __attribute__((address_space(3)))
typedef unsigned short bf16_t;
typedef short bf16x8 __attribute__((ext_vector_type(8)));
typedef short s16x4 __attribute__((ext_vector_type(4)));
typedef float f32x4 __attribute__((ext_vector_type(4)));
typedef float f32x2 __attribute__((ext_vector_type(2)));
typedef float f32x16 __attribute__((ext_vector_type(16)));
typedef unsigned u32x4 __attribute__((ext_vector_type(4)));
typedef unsigned u32x2 __attribute__((ext_vector_type(2)));

constexpr int NB = 4, SEQ = 4096, DM = 2048, MTOK = NB * SEQ, DEPTH = 2;
constexpr int DF = 1024, NG = 8, GD = 128, NH = 8, DV = 128, DNOPE = 128, DROPE = 64, DQK = 192, QLR = 512, KVLR = 256;
constexpr int NIN = 3904, NINP = 4096;
constexpr int NQ = NH * DQK  , NKV = NH * (DNOPE + DV)  ;
constexpr float NORM_EPS = 1e-6f;
constexpr float DN_ALPHA = 1.4142135623730951f;
constexpr float ATT_SCALE = 0.07216878364870322f;

__device__ __forceinline__ float bf2f(bf16_t b) { return __uint_as_float(((unsigned)b) << 16); }
__device__ __forceinline__ bf16_t f2bf(float f) { unsigned u = __float_as_uint(f); u += 0x7FFFu + ((u >> 16) & 1u); return (bf16_t)(u >> 16); }
typedef __bf16 bf16v2_t __attribute__((ext_vector_type(2)));
__device__ __forceinline__ unsigned cvt_pk_bf16(float lo, float hi) { const f32x2 v = {lo, hi}; return __builtin_bit_cast(unsigned, __builtin_convertvector(v, bf16v2_t)); }
__device__ __forceinline__ float silu_f(float z) { return z * __builtin_amdgcn_rcpf(1.0f + __builtin_amdgcn_exp2f(-1.4426950408889634f * z)); }
__device__ __forceinline__ float wave_sum(float v) { for (int o = 32; o > 0; o >>= 1) v += __shfl_xor(v, o); return v; }
__device__ __forceinline__ float wave_max(float v) { for (int o = 32; o > 0; o >>= 1) v = fmaxf(v, __shfl_xor(v, o)); return v; }

constexpr size_t al256(size_t x) { return (x + 255) / 256 * 256; }
constexpr size_t WS_CTL  = 0;
constexpr size_t CTL_BYTES = 32768;
constexpr size_t WS_MOD  = WS_CTL + CTL_BYTES;
constexpr size_t WS_RSQ  = WS_MOD + al256((size_t)DEPTH * NB * 3 * DM * 4);
constexpr size_t WS_RCOS = WS_RSQ + al256((size_t)DEPTH * MTOK * 2 * 4);
constexpr size_t WS_RSIN = WS_RCOS + (size_t)MTOK * 32 * 4;
constexpr size_t WS_D1   = WS_RSIN + (size_t)MTOK * 32 * 4;
constexpr size_t WS_D2   = WS_D1 + 128 * 64 * 2;
constexpr size_t WS_WCAT = WS_D2 + 128 * 128 * 2;
constexpr size_t WS_WIN  = WS_WCAT + (size_t)DEPTH * NG * 128 * 256 * 2;
constexpr size_t WS_WOUT = WS_WIN + (size_t)DEPTH * NINP * DM * 2;
constexpr size_t WS_WQ   = WS_WOUT + (size_t)DEPTH * DM * DM * 2;
constexpr size_t WS_WKV  = WS_WQ + (size_t)DEPTH * NQ * QLR * 2;
constexpr size_t WS_H    = WS_WKV + (size_t)DEPTH * NKV * KVLR * 2;
constexpr size_t WS_U    = WS_H + (size_t)MTOK * DM * 2;
constexpr size_t WS_MIX  = WS_U + (size_t)MTOK * DF * 2;
constexpr size_t WS_CQ   = WS_MIX + (size_t)MTOK * DM * 2;
constexpr size_t WS_CKV  = WS_CQ + (size_t)MTOK * QLR * 2;
constexpr size_t WS_KR   = WS_CKV + (size_t)MTOK * KVLR * 2;
constexpr size_t WS_Q    = WS_KR + (size_t)MTOK * 64 * 2;
constexpr size_t WS_KV   = WS_Q + (size_t)MTOK * NQ * 2;
constexpr size_t WS_R    = WS_KV + (size_t)MTOK * NKV * 2;
constexpr size_t WS_END  = WS_R + (size_t)MTOK * DM * 4;
static_assert(WS_END <= (size_t)4 * MTOK * DM * 4, "workspace map exceeds 4 x largest tensor");

constexpr int RING_BYTES = 155648, MISC_OFF = RING_BYTES, LDS_BYTES = RING_BYTES + 256;
constexpr int NTHREADS = 512;

namespace pg8 {
#define PG8_LAS __attribute__((address_space(3)))
constexpr int BM = 256, BK = 64, HALF = 128, HTB = HALF * BK * 2  , STAGE_BYTES = 8 * HTB, NXCD = 8, WGM = 8;
static_assert(STAGE_BYTES <= RING_BYTES, "GEMM stage ring must fit the LDS phase scratch");

__host__ __device__ __forceinline__ int lds_byte(int r, int c) { const int st = (r >> 4) * 2 + (c >> 5), rr = r & 15, cc = c & 31, ob = rr * 64 + cc * 2; return st * 1024 + (ob ^ (((ob >> 9) & 1) << 5)); }
__host__ __device__ __forceinline__ void stage_rc(int b, int& R, int& C) { const int st = b / 1024, sb = b % 1024, swz = sb ^ (((sb >> 9) & 1) << 5); R = (st >> 1) * 16 + swz / 64; C = (st & 1) * 32 + (swz % 64) / 2; }
__host__ __device__ __forceinline__ int perm32(int rho) { const int n = rho >> 4, i = rho & 15; return 8 * (i >> 2) + 4 * n + (i & 3); }

struct Unit { int pm, pn; };
struct Gemm { const bf16_t* A; const bf16_t* Bt; int M, N, K; };

struct StaticOrder {
    int nM, nN, nwg, G, c;
    __host__ __device__ void init(int M, int N, int G_, int c_) { nM = M / BM; nN = N / BM; nwg = nM * nN; G = G_; c = c_; }
    __host__ __device__ bool next(int i, Unit& u) const {
        const long L = (long)i * G + c; if (L >= nwg) return false;
        int wgid = (int)L; { const int q = nwg / NXCD, r = nwg % NXCD, xcd = wgid % NXCD, off = wgid / NXCD; wgid = (xcd < r ? xcd * (q + 1) : r * (q + 1) + (xcd - r) * q) + off; }
        const int nig = WGM * nN, gid = wgid / nig, fm = gid * WGM, gsz = (nM - fm) < WGM ? (nM - fm) : WGM;
        u.pm = fm + ((wgid % nig) % gsz); u.pn = (wgid % nig) / gsz; return true;
    }
    __device__ __forceinline__ void a_ready(const Unit&) const {}
    __device__ __forceinline__ void done(const Unit&) const {}
};
struct HotOrder : StaticOrder { int pm0, pn0; __device__ bool next(int i, Unit& u) const { Unit t; if (!StaticOrder::next(i, t)) return false; u.pm = pm0; u.pn = pn0; return true; } };
struct SplitOrder {
    int G, c, nN, kind;
    __device__ void init(int G_, int c_, int nN_, int kind_) { G = G_; c = c_; nN = nN_; kind = kind_; }
    __device__ bool next(int i, Unit& u) const {
        if (G != 256) { const int L = i * G + c; if (L >= 64 * nN) return false; u.pm = L / nN; u.pn = L % nN; return true; }
        const int x = c & 7, v = c >> 3; int li;
        if (kind == 0) { if (v < 16) { if (i >= 2) return false; li = 2 * v + i; } else { if (i >= 1) return false; li = 32 + (v - 16); } }
        else           { if (v < 16) { if (i >= 1) return false; li = v; } else { if (i >= 3) return false; li = 16 + 3 * (v - 16) + i; } }
        u.pm = 8 * x + li / nN; u.pn = li % nN; return true;
    }
    __device__ __forceinline__ void a_ready(const Unit&) const {}
    __device__ __forceinline__ void done(const Unit&) const {}
};
struct GridOrder {
    int pm0, npm, pn0, pnstep, npn;
    __device__ bool next(int i, Unit& u) const { if (i >= npm * npn) return false; u.pm = pm0 + i / npn; u.pn = pn0 + (i % npn) * pnstep; return true; }
    __device__ __forceinline__ void a_ready(const Unit&) const {}
    __device__ __forceinline__ void done(const Unit&) const {}
};
template <class Epi, class Sched, bool ALIGN_EPI = false, bool SP2 = false>
__device__ __forceinline__ void gemm_phase(PG8_LAS unsigned char* lds, const Gemm g, const Sched& S, const Epi& E, const int tid) {
    const int wid = __builtin_amdgcn_readfirstlane(tid >> 6), lane = tid & 63, wr = wid >> 2, wc = wid & 3, fr = lane & 15, fq = lane >> 4;
    const int K = g.K, nt = K / BK;
    unsigned voffA[2], voffB[2];
#pragma unroll
    for (int i = 0; i < 2; ++i) { int R, C; stage_rc(tid * 16 + i * 8192, R, C); const int Rb = Epi::PERM ? ((R & ~31) + perm32(R & 31)) : R;
        voffA[i] = (unsigned)(R * K + C) * 2u; voffB[i] = (unsigned)(Rb * K + C) * 2u; }
    const size_t kstep = (size_t)(BK * 2);
    const size_t hstep = (size_t)HALF * K * 2;
    const size_t tstep = 2 * hstep;
    const unsigned ldsw = (unsigned)wid * 1024u;
    const int aoff = lds_byte(wr * 64 + fr, fq * 8), boff = lds_byte(wc * 32 + fr, fq * 8);
#define PG8_SA(b, h) (((b) * 2 + (h)) * HTB)
#define PG8_SB(b, h) ((4 + (b) * 2 + (h)) * HTB)
#define PG8_STAGE(bufoff, gbase, voff) do { _Pragma("unroll") for (int _i = 0; _i < 2; ++_i) \
        __builtin_amdgcn_global_load_lds((const unsigned*)((const char*)(gbase) + (voff)[_i]), (PG8_LAS unsigned*)(lds + (bufoff) + ldsw + _i * 8192), 16, 0, 0); } while (0)
#define PG8_LDA(dst, b, h) do { _Pragma("unroll") for (int m = 0; m < 4; ++m) _Pragma("unroll") for (int k = 0; k < 2; ++k) dst[m][k] = *(const PG8_LAS bf16x8*)(lds + PG8_SA(b, h) + aoff + m * 2048 + k * 1024); } while (0)
#define PG8_LDB(dst, b, h) do { _Pragma("unroll") for (int n = 0; n < 2; ++n) _Pragma("unroll") for (int k = 0; k < 2; ++k) dst[n][k] = *(const PG8_LAS bf16x8*)(lds + PG8_SB(b, h) + boff + n * 2048 + k * 1024); } while (0)
#define PG8_MMA(ai, bj, At, Bt) do { if (!(skipm & (1 << (bj)))) { __builtin_amdgcn_s_setprio(1); _Pragma("unroll") for (int m = 0; m < 4; ++m) _Pragma("unroll") for (int n = 0; n < 2; ++n) _Pragma("unroll") for (int k = 0; k < 2; ++k) \
        acc[ai][bj][m][n] = __builtin_amdgcn_mfma_f32_16x16x32_bf16(Bt[n][k], At[m][k], acc[ai][bj][m][n], 0, 0, 0); __builtin_amdgcn_s_setprio(0); } } while (0)
#define PG8_WAIT_V(n) asm volatile("s_waitcnt vmcnt(" #n ")" ::: "memory")
#define PG8_WAIT_L(n) asm volatile("s_waitcnt lgkmcnt(" #n ")" ::: "memory")
#define PG8_BAR __builtin_amdgcn_s_barrier()
#define PG8_SCHED __builtin_amdgcn_sched_barrier(0)
    Unit cur, nxt; int ui = 0;
    if (!S.next(0, cur)) return;
    int skipm = Epi::mma_skip(cur.pn, wc);
    f32x4 acc[2][2][4][2];
#pragma unroll
    for (int a = 0; a < 2; ++a)
#pragma unroll
        for (int b = 0; b < 2; ++b)
#pragma unroll
            for (int m = 0; m < 4; ++m)
#pragma unroll
                for (int n = 0; n < 2; ++n) acc[a][b][m][n] = (f32x4){0.f, 0.f, 0.f, 0.f};
    bf16x8 At[4][2], B0[2][2], B1[2][2];
    const char* cA = (const char*)g.A + (size_t)cur.pm * tstep; const char* cB = (const char*)g.Bt + (size_t)cur.pn * tstep;
    S.a_ready(cur);
    if constexpr (SP2) {
        PG8_STAGE(PG8_SB(0, 0), cB, voffB); PG8_STAGE(PG8_SB(0, 1), cB + hstep, voffB); PG8_STAGE(PG8_SA(0, 0), cA, voffA); PG8_STAGE(PG8_SA(0, 1), cA + hstep, voffA);
        if (wr == 1) PG8_BAR;
        PG8_WAIT_V(2); PG8_BAR;
        PG8_STAGE(PG8_SB(1, 0), cB + kstep, voffB); PG8_STAGE(PG8_SA(1, 0), cA + kstep, voffA); PG8_STAGE(PG8_SB(1, 1), cB + hstep + kstep, voffB);
        PG8_WAIT_V(6); PG8_BAR;
    } else {
        PG8_STAGE(PG8_SB(0, 0), cB, voffB); PG8_STAGE(PG8_SA(0, 0), cA, voffA); PG8_STAGE(PG8_SB(0, 1), cB + hstep, voffB); PG8_STAGE(PG8_SA(0, 1), cA + hstep, voffA);
        if (wr == 1) PG8_BAR;
        PG8_WAIT_V(4); PG8_BAR;
        PG8_STAGE(PG8_SB(1, 0), cB + kstep, voffB); PG8_STAGE(PG8_SA(1, 0), cA + kstep, voffA); PG8_STAGE(PG8_SB(1, 1), cB + hstep + kstep, voffB);
        PG8_WAIT_V(6); PG8_BAR;
    }
    for (;;) {
        const bool has_next = S.next(ui + 1, nxt);
        const char* nA = has_next ? (const char*)g.A + (size_t)nxt.pm * tstep : cA; const char* nB = has_next ? (const char*)g.Bt + (size_t)nxt.pn * tstep : cB;
        for (int t = 0; t < nt; t += 2) {
            const bool last = (t == nt - 2);
            const char* a1 = cA + (size_t)(t + 1) * kstep;
            const char* a2 = last ? nA : cA + (size_t)(t + 2) * kstep; const char* b2 = last ? nB : cB + (size_t)(t + 2) * kstep;
            const char* a3 = a2 + kstep; const char* b3 = b2 + kstep;
            if (last && has_next) S.a_ready(nxt);
            if constexpr (SP2) {
            PG8_LDB(B0, 0, 0); PG8_LDB(B1, 0, 1); PG8_SCHED; PG8_LDA(At, 0, 0); PG8_STAGE(PG8_SA(1, 1), a1 + hstep, voffA);
            PG8_WAIT_V(8); PG8_WAIT_L(0); PG8_BAR; PG8_MMA(0, 0, At, B0); PG8_MMA(0, 1, At, B1); PG8_BAR; PG8_SCHED;
            PG8_LDA(At, 0, 1); PG8_STAGE(PG8_SB(0, 0), b2, voffB); PG8_STAGE(PG8_SB(0, 1), b2 + hstep, voffB); PG8_STAGE(PG8_SA(0, 0), a2, voffA);
            PG8_WAIT_V(8); PG8_WAIT_L(0); PG8_BAR; PG8_MMA(1, 0, At, B0); PG8_MMA(1, 1, At, B1); PG8_BAR; PG8_SCHED;
            PG8_LDB(B0, 1, 0); PG8_LDB(B1, 1, 1); PG8_SCHED; PG8_LDA(At, 1, 0); PG8_STAGE(PG8_SA(0, 1), a2 + hstep, voffA);
            PG8_WAIT_V(8); PG8_WAIT_L(0); PG8_BAR; PG8_MMA(0, 0, At, B0); PG8_MMA(0, 1, At, B1); PG8_BAR; PG8_SCHED;
            PG8_LDA(At, 1, 1); PG8_STAGE(PG8_SB(1, 0), b3, voffB); PG8_STAGE(PG8_SB(1, 1), b3 + hstep, voffB); PG8_STAGE(PG8_SA(1, 0), a3, voffA);
            PG8_WAIT_V(8); PG8_WAIT_L(0); PG8_BAR; PG8_MMA(1, 0, At, B0); PG8_MMA(1, 1, At, B1); PG8_BAR; PG8_SCHED;
            } else {
            PG8_LDB(B0, 0, 0); PG8_SCHED; PG8_LDA(At, 0, 0); PG8_STAGE(PG8_SA(1, 1), a1 + hstep, voffA);
            PG8_WAIT_L(8); PG8_BAR; PG8_WAIT_L(0); PG8_MMA(0, 0, At, B0); PG8_BAR; PG8_SCHED;
            PG8_LDB(B1, 0, 1); PG8_STAGE(PG8_SB(0, 0), b2, voffB);
            PG8_BAR; PG8_WAIT_L(0); PG8_MMA(0, 1, At, B1); PG8_BAR;
            PG8_LDA(At, 0, 1); PG8_STAGE(PG8_SA(0, 0), a2, voffA);
            PG8_BAR; PG8_WAIT_L(0); PG8_MMA(1, 0, At, B0); PG8_BAR; PG8_SCHED;
            PG8_STAGE(PG8_SB(0, 1), b2 + hstep, voffB);
            PG8_WAIT_V(6); PG8_BAR; PG8_MMA(1, 1, At, B1); PG8_BAR;
            PG8_LDB(B0, 1, 0); PG8_SCHED; PG8_LDA(At, 1, 0); PG8_STAGE(PG8_SA(0, 1), a2 + hstep, voffA);
            PG8_WAIT_L(8); PG8_BAR; PG8_WAIT_L(0); PG8_MMA(0, 0, At, B0); PG8_BAR; PG8_SCHED;
            PG8_LDB(B1, 1, 1); PG8_STAGE(PG8_SB(1, 0), b3, voffB);
            PG8_BAR; PG8_WAIT_L(0); PG8_MMA(0, 1, At, B1); PG8_BAR;
            PG8_LDA(At, 1, 1); PG8_STAGE(PG8_SA(1, 0), a3, voffA);
            PG8_BAR; PG8_WAIT_L(0); PG8_MMA(1, 0, At, B0); PG8_BAR; PG8_SCHED;
            PG8_STAGE(PG8_SB(1, 1), b3 + hstep, voffB);
            PG8_WAIT_V(6); PG8_BAR; PG8_MMA(1, 1, At, B1); PG8_BAR;
            }
        }
        if constexpr (ALIGN_EPI) { if (wr == 0) PG8_BAR; }
        if constexpr (!Epi::AFTER_DRAIN) { E(acc, cur, wr, wc, fr, fq); S.done(cur); }
        if (!has_next) break;
#pragma unroll
        for (int a = 0; a < 2; ++a)
#pragma unroll
            for (int b = 0; b < 2; ++b)
#pragma unroll
                for (int m = 0; m < 4; ++m)
#pragma unroll
                    for (int n = 0; n < 2; ++n) acc[a][b][m][n] = (f32x4){0.f, 0.f, 0.f, 0.f};
        cur = nxt; cA = nA; cB = nB; ++ui; skipm = Epi::mma_skip(cur.pn, wc);
        if constexpr (ALIGN_EPI) { if (wr == 1) PG8_BAR; }
    }
    PG8_WAIT_V(0);
    if constexpr (!ALIGN_EPI) { if (wr == 0) PG8_BAR; }
    PG8_BAR;
    if constexpr (Epi::AFTER_DRAIN) { E.fused(acc, cur, wr, wc, fr, fq, lds, wid, lane); S.done(cur); }
#undef PG8_SA
#undef PG8_SB
#undef PG8_STAGE
#undef PG8_LDA
#undef PG8_LDB
#undef PG8_MMA
#undef PG8_WAIT_V
#undef PG8_WAIT_L
#undef PG8_BAR
#undef PG8_SCHED
}

template <class Epi, class Sched>
__device__ __forceinline__ void gemm_phase_naive(const Gemm g, const Sched& S, const Epi& E, const int tid) {
    const int wid = __builtin_amdgcn_readfirstlane(tid >> 6), lane = tid & 63, wr = wid >> 2, wc = wid & 3, fr = lane & 15, fq = lane >> 4;
    const int K = g.K;
    Unit cur;
    for (int ui = 0; S.next(ui, cur); ++ui) {
        f32x4 acc[2][2][4][2];
#pragma unroll
        for (int ai = 0; ai < 2; ++ai)
#pragma unroll
            for (int m = 0; m < 4; ++m) {
                const bf16_t* arow = g.A + (size_t)(cur.pm * BM + ai * HALF + wr * 64 + m * 16 + fr) * K;
#pragma unroll
                for (int bj = 0; bj < 2; ++bj)
#pragma unroll
                    for (int n = 0; n < 2; ++n) {
                        const int col = cur.pn * BM + bj * HALF + wc * 32 + (Epi::PERM ? (8 * fq + 4 * n) : (16 * n + 4 * fq));
                        const bf16_t* brow = g.Bt + (size_t)col * K;
                        float s0 = 0.f, s1 = 0.f, s2 = 0.f, s3 = 0.f;
#pragma unroll 1
                        for (int k = 0; k < K; k += 8) {
                            const bf16x8 av = *(const bf16x8*)(arow + k);
                            const bf16x8 b0 = *(const bf16x8*)(brow + k), b1 = *(const bf16x8*)(brow + K + k), b2 = *(const bf16x8*)(brow + 2 * K + k), b3 = *(const bf16x8*)(brow + 3 * K + k);
#pragma unroll
                            for (int e = 0; e < 8; ++e) { const float a = bf2f((bf16_t)av[e]);
                                s0 += a * bf2f((bf16_t)b0[e]); s1 += a * bf2f((bf16_t)b1[e]); s2 += a * bf2f((bf16_t)b2[e]); s3 += a * bf2f((bf16_t)b3[e]); }
                        }
                        acc[ai][bj][m][n] = (f32x4){s0, s1, s2, s3};
                    }
            }
        E(acc, cur, wr, wc, fr, fq);
    }
}
}
#ifndef PG8_SP2
#define PG8_SP2 true
#endif
#ifndef PG8_ALIGN
#define PG8_ALIGN true
#endif
typedef f32x4 AccT[2][2][4][2];

#ifndef EPI_NT
#define EPI_NT 0
#endif
__device__ __forceinline__ void store8_bf16(bf16_t* p, f32x4 v0, f32x4 v1) {
    u32x4 w; w.x = cvt_pk_bf16(v0[0], v0[1]); w.y = cvt_pk_bf16(v0[2], v0[3]); w.z = cvt_pk_bf16(v1[0], v1[1]); w.w = cvt_pk_bf16(v1[2], v1[3]); *(u32x4*)p = w;
}
__device__ __forceinline__ void store4_bf16(bf16_t* p, f32x4 v) { u32x2 w; w.x = cvt_pk_bf16(v[0], v[1]); w.y = cvt_pk_bf16(v[2], v[3]); *(u32x2*)p = w; }
__device__ __forceinline__ void estore8_bf16(bf16_t* p, f32x4 v0, f32x4 v1) {
    u32x4 w; w.x = cvt_pk_bf16(v0[0], v0[1]); w.y = cvt_pk_bf16(v0[2], v0[3]); w.z = cvt_pk_bf16(v1[0], v1[1]); w.w = cvt_pk_bf16(v1[2], v1[3]);
    if (EPI_NT) __builtin_nontemporal_store(w, (u32x4*)p); else *(u32x4*)p = w;
}
__device__ __forceinline__ void estore4_bf16(bf16_t* p, f32x4 v) { u32x2 w; w.x = cvt_pk_bf16(v[0], v[1]); w.y = cvt_pk_bf16(v[2], v[3]); if (EPI_NT) __builtin_nontemporal_store(w, (u32x2*)p); else *(u32x2*)p = w; }
__device__ __forceinline__ f32x4 silu4(f32x4 v) { return (f32x4){silu_f(v[0]), silu_f(v[1]), silu_f(v[2]), silu_f(v[3])}; }
__device__ __forceinline__ float sq4(f32x4 v) { return (v[0] * v[0] + v[1] * v[1]) + (v[2] * v[2] + v[3] * v[3]); }

#ifndef GATE_IN_EPI
#define GATE_IN_EPI 1
#endif
struct EpiIn {
    static constexpr bool PERM = true, AFTER_DRAIN = false;
    static __device__ __forceinline__ int mma_skip(int pn, int wc) { return pn == 11 ? (wc >= 2 ? 3 : 2) : 0; }
    bf16_t* U; bf16_t* MIX; bf16_t* CQ; bf16_t* CKV; bf16_t* KR; float* rsq; const float* rcos; const float* rsin;
    template <int ACT> __device__ __forceinline__ void plain(const AccT& acc, bf16_t* base, int ldc, int row0, int col0) const {
#pragma unroll
        for (int ai = 0; ai < 2; ++ai)
#pragma unroll
            for (int m = 0; m < 4; ++m) { bf16_t* rowp = base + (size_t)(row0 + ai * 128 + m * 16) * ldc + col0;
#pragma unroll
                for (int bj = 0; bj < 2; ++bj) { f32x4 v0 = acc[ai][bj][m][0], v1 = acc[ai][bj][m][1]; if (ACT) { v0 = silu4(v0); v1 = silu4(v1); } estore8_bf16(rowp + bj * 128, v0, v1); } }
    }
    __device__ __forceinline__ void sumsq(const AccT& acc, int row0, int which, int fq) const {
#pragma unroll
        for (int ai = 0; ai < 2; ++ai)
#pragma unroll
            for (int m = 0; m < 4; ++m) { float s = (sq4(acc[ai][0][m][0]) + sq4(acc[ai][0][m][1])) + (sq4(acc[ai][1][m][0]) + sq4(acc[ai][1][m][1]));
                s += __shfl_xor(s, 16); s += __shfl_xor(s, 32);
                if (fq == 0) atomicAdd(rsq + (size_t)(row0 + ai * 128 + m * 16) * 2 + which, s); }
    }
    __device__ __forceinline__ void operator()(const AccT& acc, const pg8::Unit& u, int wr, int wc, int fr, int fq) const {
        const int row0 = u.pm * 256 + wr * 64 + fr, pn = u.pn, cw = wc * 32 + 8 * fq;
        if (pn < 4) plain<0>(acc, U, DF, row0, pn * 256 + cw);
        else if (pn < 8) plain<GATE_IN_EPI>(acc, MIX, DM, row0, (pn - 4) * 256 + cw);
        else if (pn < 10) { plain<0>(acc, CQ, QLR, row0, (pn - 8) * 256 + cw); sumsq(acc, row0, 0, fq); }
        else if (pn == 10) { plain<0>(acc, CKV, KVLR, row0, cw); sumsq(acc, row0, 1, fq); }
        else if (pn == 11) {
            if (wc < 2) { const int i0 = 16 * wc + 4 * fq;
#pragma unroll
                for (int ai = 0; ai < 2; ++ai) {
                    f32x4 cc[4], ss[4];
#pragma unroll
                    for (int m = 0; m < 4; ++m) { const size_t row = (size_t)(row0 + ai * 128 + m * 16); cc[m] = *(const f32x4*)(rcos + row * 32 + i0); ss[m] = *(const f32x4*)(rsin + row * 32 + i0); }
#pragma unroll
                    for (int m = 0; m < 4; ++m) { const size_t row = (size_t)(row0 + ai * 128 + m * 16);
                        const f32x4 c = cc[m], s = ss[m], x1 = acc[ai][0][m][0], x2 = acc[ai][0][m][1];
                        estore4_bf16(KR + row * 64 + i0, x1 * c - x2 * s); estore4_bf16(KR + row * 64 + 32 + i0, x2 * c + x1 * s); } } }
        }
        else plain<GATE_IN_EPI>(acc, MIX, DM, row0, DF + (pn - 12) * 256 + cw);
    }
};
struct EpiQ {
    static constexpr bool PERM = true, AFTER_DRAIN = false;
    static __device__ __forceinline__ int mma_skip(int, int) { return 0; }
    bf16_t* Q; const float* rsq; const float* rcos; const float* rsin;
    __device__ __forceinline__ void operator()(const AccT& acc, const pg8::Unit& u, int wr, int wc, int fr, int fq) const {
        const int row0 = u.pm * 256 + wr * 64 + fr;
        float rsv[2][4];
        const int G0 = u.pn * 8 + wc, g60 = G0 % 6, g61 = (G0 + 4) % 6, ropeg = g60 >= 4 ? g60 : g61;
        const bool has_rope = g60 >= 4 || g61 >= 4; const int ri0 = 16 * (ropeg - 4) + 4 * fq;
#pragma unroll
        for (int ai = 0; ai < 2; ++ai)
#pragma unroll
            for (int m = 0; m < 4; ++m) rsv[ai][m] = rsq[(size_t)(row0 + ai * 128 + m * 16) * 2 + 0];
#pragma unroll
        for (int ai = 0; ai < 2; ++ai) {
            f32x4 cc[4], ss[4];
            if (has_rope) {
#pragma unroll
                for (int m = 0; m < 4; ++m) { const size_t row = (size_t)(row0 + ai * 128 + m * 16); cc[m] = *(const f32x4*)(rcos + row * 32 + ri0); ss[m] = *(const f32x4*)(rsin + row * 32 + ri0); } }
#pragma unroll
            for (int m = 0; m < 4; ++m) { const size_t row = (size_t)(row0 + ai * 128 + m * 16);
                const float rs = rsqrtf(rsv[ai][m] * (1.0f / QLR) + NORM_EPS);
#pragma unroll
                for (int bj = 0; bj < 2; ++bj) { const int G = u.pn * 8 + bj * 4 + wc, head = G / 6, g6 = G - head * 6;
                    const f32x4 v0 = acc[ai][bj][m][0] * rs, v1 = acc[ai][bj][m][1] * rs;
                    if (g6 < 4) estore8_bf16(Q + row * NQ + head * DQK + g6 * 32 + 8 * fq, v0, v1);
                    else { const int i0 = 16 * (g6 - 4) + 4 * fq; const f32x4 c = cc[m], s = ss[m];

#if defined(PROBE_NEG) && PROBE_NEG == 1
                        estore4_bf16(Q + row * NQ + head * DQK + 128 + i0, v0 * c + v1 * s); estore4_bf16(Q + row * NQ + head * DQK + 160 + i0, v1 * c - v0 * s);
#else
                        estore4_bf16(Q + row * NQ + head * DQK + 128 + i0, v0 * c - v1 * s); estore4_bf16(Q + row * NQ + head * DQK + 160 + i0, v1 * c + v0 * s);
#endif
                    } } } }
    }
};
struct EpiKV {
    static constexpr bool PERM = true, AFTER_DRAIN = false;
    static __device__ __forceinline__ int mma_skip(int, int) { return 0; }
    bf16_t* KV; const float* rsq;
    __device__ __forceinline__ void operator()(const AccT& acc, const pg8::Unit& u, int wr, int wc, int fr, int fq) const {
        const int row0 = u.pm * 256 + wr * 64 + fr, col0 = u.pn * 256 + wc * 32 + 8 * fq;
        float rsv[2][4];
#pragma unroll
        for (int ai = 0; ai < 2; ++ai)
#pragma unroll
            for (int m = 0; m < 4; ++m) rsv[ai][m] = rsq[(size_t)(row0 + ai * 128 + m * 16) * 2 + 1];
#pragma unroll
        for (int ai = 0; ai < 2; ++ai)
#pragma unroll
            for (int m = 0; m < 4; ++m) { const size_t row = (size_t)(row0 + ai * 128 + m * 16);
                const float rs = rsqrtf(rsv[ai][m] * (1.0f / KVLR) + NORM_EPS);
#pragma unroll
                for (int bj = 0; bj < 2; ++bj) estore8_bf16(KV + row * NKV + col0 + bj * 128, acc[ai][bj][m][0] * rs, acc[ai][bj][m][1] * rs); }
    }
};
struct EpiOut {
    static constexpr bool PERM = true, AFTER_DRAIN = false;
    static __device__ __forceinline__ int mma_skip(int, int) { return 0; }
    bf16_t* GY; const float* gate;
    __device__ __forceinline__ void operator()(const AccT& acc, const pg8::Unit& u, int wr, int wc, int fr, int fq) const {
        const int row0 = u.pm * 256 + wr * 64 + fr, col0 = u.pn * 256 + wc * 32 + 8 * fq;
        const float* gp = gate + (size_t)(u.pm >> 4) * (3 * DM) + col0;
        f32x4 gv[2][2];
#pragma unroll
        for (int bj = 0; bj < 2; ++bj)
#pragma unroll
            for (int n = 0; n < 2; ++n) gv[bj][n] = *(const f32x4*)(gp + bj * 128 + n * 4);
#pragma unroll
        for (int ai = 0; ai < 2; ++ai)
#pragma unroll
            for (int m = 0; m < 4; ++m) { bf16_t* rowp = GY + (size_t)(row0 + ai * 128 + m * 16) * DM + col0;
#pragma unroll
                for (int bj = 0; bj < 2; ++bj) estore8_bf16(rowp + bj * 128, gv[bj][0] * acc[ai][bj][m][0], gv[bj][1] * acc[ai][bj][m][1]); }
    }
};

struct EpiNone {
    static constexpr bool PERM = true, AFTER_DRAIN = false;
    static __device__ __forceinline__ int mma_skip(int, int) { return 0; }
    __device__ __forceinline__ void operator()(const AccT& acc, const pg8::Unit& u, int wr, int wc, int fr, int fq) const {
#pragma unroll
        for (int ai = 0; ai < 2; ++ai)
#pragma unroll
            for (int bj = 0; bj < 2; ++bj)
#pragma unroll
                for (int m = 0; m < 4; ++m)
#pragma unroll
                    for (int n = 0; n < 2; ++n) asm volatile("" :: "v"(acc[ai][bj][m][n]));
    }
};
#define XB_TMO      128
#define XB_XCNT(j)  (256  + 64 * (j))
#define XB_XSUB(j)  (1280 + 64 * (j))
#define XB_XGEN(j)  (2304 + 64 * (j))
#define XB_TOP      3328
#define XB_TOPGEN   3392
#define XCD_BAR_WORDS 3456
#define XB_SPIN_CAP (1u << 22)
static_assert(XCD_BAR_WORDS * 4 <= CTL_BYTES, "barrier words must fit the control region");
__device__ __forceinline__ unsigned xb_ld(unsigned* p)              { return __hip_atomic_load(p, __ATOMIC_RELAXED, __HIP_MEMORY_SCOPE_AGENT); }
__device__ __forceinline__ unsigned xb_add(unsigned* p, unsigned v) { return __hip_atomic_fetch_add(p, v, __ATOMIC_RELAXED, __HIP_MEMORY_SCOPE_AGENT); }
__device__ __forceinline__ unsigned xb_xcc_id() { return (unsigned)__builtin_amdgcn_s_getreg((3 << 11) | 20) & 0xFu; }
#define XB_SPIN(cond, bar) do { unsigned _sp = 0; while (cond) { __builtin_amdgcn_s_sleep(1); \
    if ((++_sp & 255u) == 0u) { if (xb_ld(&(bar)[XB_TMO])) break; if (_sp > XB_SPIN_CAP) { atomicAdd(&(bar)[XB_TMO], 1u); break; } } } } while (0)
struct XcdBarrier { unsigned* bar; unsigned x; volatile LAS unsigned* st; };
__device__ __forceinline__ XcdBarrier xcd_barrier_post(unsigned* bar, volatile LAS unsigned* st) {
    XcdBarrier b; b.bar = bar; b.x = xb_xcc_id(); b.st = st;
    if (threadIdx.x == 0) st[2] = xb_add(&bar[XB_XCNT(b.x)], 1u);
    return b;
}
__device__ __forceinline__ void xcd_barrier_complete(unsigned* bar, unsigned x, unsigned& nloc, unsigned& nx, unsigned& even) {
    const unsigned G = gridDim.x * gridDim.y * gridDim.z;
    unsigned sum, cnt, mine, sp = 0u;
    for (;;) {
        sum = 0u; cnt = 0u; mine = 0u; even = 1u;
#pragma unroll
        for (unsigned j = 0; j < 16; ++j) { const unsigned c = xb_ld(&bar[XB_XCNT(j)]); sum += c; cnt += (c > 0u) ? 1u : 0u; mine = (j == x) ? c : mine; if (c != (j < 8u ? G / 8u : 0u)) even = 0u; }
        if (sum == G) break;
        __builtin_amdgcn_s_sleep(1);
        if ((++sp & 255u) == 0u) { if (xb_ld(&bar[XB_TMO])) break; if (sp > XB_SPIN_CAP) { atomicAdd(&bar[XB_TMO], 1u); break; } }
    }
    nloc = mine > 0u ? mine : 1u; nx = cnt > 0u ? cnt : 1u;
}
__device__ __forceinline__ void xcd_barrier(const XcdBarrier& b) {
    asm volatile("s_waitcnt vmcnt(0)" ::: "memory");
    __syncthreads();
    if (threadIdx.x == 0) {
        unsigned* bar = b.bar;
        __builtin_amdgcn_s_waitcnt(0);
        unsigned nloc = b.st[0], nx = b.st[1];
        if (nloc == 0u) { unsigned even; xcd_barrier_complete(bar, b.x, nloc, nx, even); b.st[0] = nloc; b.st[1] = nx; b.st[3] = (even && (gridDim.x % 8u) == 0u) ? 1u : 2u; }
        const unsigned old = xb_add(&bar[XB_XSUB(b.x)], 1u);
        const unsigned gen = old / nloc;
        if (old + 1u == (gen + 1u) * nloc) {
            __builtin_amdgcn_fence(__ATOMIC_RELEASE, "agent");
            asm volatile("s_waitcnt vmcnt(0)" ::: "memory");
            const unsigned og = xb_add(&bar[XB_TOP], 1u);
            const unsigned tg = og / nx;
            if (og + 1u == (tg + 1u) * nx) xb_add(&bar[XB_TOPGEN], 1u);
            else XB_SPIN(xb_ld(&bar[XB_TOPGEN]) == tg, bar);
            __builtin_amdgcn_fence(__ATOMIC_ACQUIRE, "agent");
            xb_add(&bar[XB_XGEN(b.x)], 1u);
            asm volatile("s_waitcnt vmcnt(0)" ::: "memory");
        } else {
            XB_SPIN(xb_ld(&bar[XB_XGEN(b.x)]) == gen, bar);
            __builtin_amdgcn_fence(__ATOMIC_ACQUIRE, "agent");
            asm volatile("s_waitcnt vmcnt(0)" ::: "memory");
        }
    }
    __syncthreads();
}
__device__ __forceinline__ void grp_barrier(unsigned* bar, unsigned* cnt, unsigned target) {
    asm volatile("s_waitcnt vmcnt(0)" ::: "memory");
    __syncthreads();
    if (threadIdx.x == 0) {
        __builtin_amdgcn_fence(__ATOMIC_RELEASE, "agent");
        asm volatile("s_waitcnt vmcnt(0)" ::: "memory");
        xb_add(cnt, 1u);
        XB_SPIN(xb_ld(cnt) < target, bar);
        __builtin_amdgcn_fence(__ATOMIC_ACQUIRE, "agent");
        asm volatile("s_waitcnt vmcnt(0)" ::: "memory");
    }
    __syncthreads();
}
struct Frame {
    const float* in[14]; float* out; unsigned char* ws;
    LAS unsigned char* lds; char* ldsg;
    int tid, lane, wave, G, bx, vcu; size_t mix_off;
};
#define WSP(T, off) ((T*)(F.ws + (off)))

__device__ __forceinline__ int src_in(int n) {
    if (n < 2816) return n;
    if (n < 3072) { const int c = n - 2816, bj = c >> 7, wc = (c >> 5) & 3, c32 = c & 31; if (bj || wc >= 2) return -1;
        const int fq = c32 >> 3, nn = (c32 >> 2) & 1, j = c32 & 3; return 2816 + 32 * nn + 16 * wc + 4 * fq + j; }
    return n - 192;
}
__device__ __forceinline__ int src_q(int n) {
    const int G = n >> 5, c32 = n & 31, head = G / 6, g6 = G - head * 6;
    if (g6 < 4) return head * DQK + g6 * 32 + c32;
    const int fq = c32 >> 3, nn = (c32 >> 2) & 1, j = c32 & 3; return head * DQK + 128 + 32 * nn + 16 * (g6 - 4) + 4 * fq + j;
}
struct WItem { const float* W; const float* ksc; bf16_t* Bt; int Nsrc, K, n0, k0, src; };
__device__ __forceinline__ WItem w_decode(const Frame& F, int it, int n4) {
    constexpr int TIN = 512, TOUT = 256, TQ = 48, TKV = 32, TL = TIN + TOUT + TQ + TKV;
    const int l = it / TL; int r = it - l * TL, kind, nt, kt; WItem w; w.ksc = nullptr;
    if (r < TIN) { kind = 0; nt = r >> 3; kt = r & 7; w.W = F.in[5] + (size_t)l * DM * NIN; w.Nsrc = NIN; w.K = DM; w.Bt = WSP(bf16_t, WS_WIN) + (size_t)l * NINP * DM; }
    else if (r < TIN + TOUT) { r -= TIN; kind = 1; nt = r >> 3; kt = r & 7; w.W = F.in[11] + (size_t)l * DM * DM; w.Nsrc = DM; w.K = DM; w.Bt = WSP(bf16_t, WS_WOUT) + (size_t)l * DM * DM; }
    else if (r < TIN + TOUT + TQ) { r -= TIN + TOUT; kind = 2; nt = r >> 1; kt = r & 1; w.W = F.in[7] + (size_t)l * QLR * NQ; w.Nsrc = NQ; w.K = QLR; w.ksc = F.in[6] + l * QLR; w.Bt = WSP(bf16_t, WS_WQ) + (size_t)l * NQ * QLR; }
    else { r -= TIN + TOUT + TQ; kind = 3; nt = r; kt = 0; w.W = F.in[9] + (size_t)l * KVLR * NKV; w.Nsrc = NKV; w.K = KVLR; w.ksc = F.in[8] + l * KVLR; w.Bt = WSP(bf16_t, WS_WKV) + (size_t)l * NKV * KVLR; }
    w.n0 = nt * 64; w.k0 = kt * 256; const int n = w.n0 + n4;
    w.src = kind == 0 ? src_in(n) : (kind == 2 ? src_q(n) : n);
    return w;
}
__device__ __forceinline__ void p0_weights(const Frame& F, const int it0, const int it1) {
    constexpr int TL = 512 + 256 + 48 + 32;
    LAS unsigned* T = (LAS unsigned*)F.lds;
    const int tid = F.tid, n4 = (tid & 15) * 4, kp = tid >> 4;
    int it = it0 + F.bx; if (it >= it1) return;
    f32x4 a0[4], a1[4]; float s0[4], s1[4];
#define W_LOAD(I) do { _Pragma("unroll") for (int i = 0; i < 4; ++i) { const int k = (I).k0 + 2 * (kp + 32 * i); \
        a0[i] = (I).src >= 0 ? __builtin_nontemporal_load((const f32x4*)((I).W + (size_t)k * (I).Nsrc + (I).src)) : (f32x4){0.f, 0.f, 0.f, 0.f}; \
        a1[i] = (I).src >= 0 ? __builtin_nontemporal_load((const f32x4*)((I).W + (size_t)(k + 1) * (I).Nsrc + (I).src)) : (f32x4){0.f, 0.f, 0.f, 0.f}; \
        s0[i] = (I).ksc ? (I).ksc[k] : 1.0f; s1[i] = (I).ksc ? (I).ksc[k + 1] : 1.0f; } } while (0)
    WItem nx = w_decode(F, it, n4); W_LOAD(nx);
    for (; it < it1; it += F.G) {
        const WItem me = nx; f32x4 v0[4], v1[4];
#pragma unroll
        for (int i = 0; i < 4; ++i) { v0[i] = a0[i] * s0[i]; v1[i] = a1[i] * s1[i]; }
        if (it + F.G < it1) { nx = w_decode(F, it + F.G, n4); W_LOAD(nx); }
#pragma unroll
        for (int i = 0; i < 4; ++i)
#pragma unroll
            for (int e = 0; e < 4; ++e) T[(n4 + e) * 130 + kp + 32 * i] = cvt_pk_bf16(v0[i][e], v1[i][e]);
        __syncthreads();
#pragma unroll
        for (int i = 0; i < 4; ++i) { const int c = tid + 512 * i, nn = c >> 5, kc = c & 31;
            const u32x2 a = *(const LAS u32x2*)(T + nn * 130 + kc * 4), b = *(const LAS u32x2*)(T + nn * 130 + kc * 4 + 2);
            *(u32x4*)(me.Bt + (size_t)(me.n0 + nn) * me.K + me.k0 + kc * 8) = (u32x4){a.x, a.y, b.x, b.y}; }
        __syncthreads();
    }
#undef W_LOAD
}
__device__ __forceinline__ void p0_mod(const Frame& F, const int it0, const int it1) {
    LAS float* red = (LAS float*)(F.lds + 32768);
    LAS float* sl = (LAS float*)(F.lds + 65536);
    const int tid = F.tid, cg = tid & 15, kl = tid >> 4;
    float* mod = WSP(float, WS_MOD); const float* cc = F.in[1];
    int it = it0 + F.bx; if (it >= it1) return;
#pragma unroll
    for (int j = 0; j < 16; ++j) sl[tid + 512 * j] = silu_f(cc[tid + 512 * j]);
    f32x4 wn[16];
#define M_LOAD(IT) do { const int l_ = (IT) / 384, rem_ = (IT) - l_ * 384; const float* wp = F.in[3] + ((size_t)l_ * DM + (rem_ & 3) * 512 + kl) * (3 * DM) + (rem_ >> 2) * 64 + cg * 4; \
        _Pragma("unroll") for (int i = 0; i < 16; ++i) wn[i] = __builtin_nontemporal_load((const f32x4*)(wp + (size_t)(32 * i) * (3 * DM))); } while (0)
    M_LOAD(it);
    __syncthreads();
    for (; it < it1; it += F.G) {
        const int l = it / 384, rem = it - l * 384, kq = rem & 3, col0 = (rem >> 2) * 64;
        f32x4 acc[4] = {}, w[16];
        float bias = 0.f;
        if (tid < 256 && kq == 0) bias = F.in[4][l * (3 * DM) + col0 + (tid >> 4) * 4 + (tid & 3)];
#pragma unroll
        for (int i = 0; i < 16; ++i) w[i] = wn[i];
        if (it + F.G < it1) M_LOAD(it + F.G);
#pragma unroll
        for (int i = 0; i < 16; ++i) { const int k = kq * 512 + kl + 32 * i;
#pragma unroll
            for (int b = 0; b < 4; ++b) acc[b] += w[i] * sl[b * DM + k]; }
#pragma unroll
        for (int b = 0; b < 4; ++b)
#pragma unroll
            for (int j = 0; j < 4; ++j) red[(kl * 16 + cg) * 16 + b * 4 + j] = acc[b][j];
        __syncthreads();
        if (tid < 256) { const int cg2 = tid >> 4, v = tid & 15, b = v >> 2, j = v & 3; float s = 0.f;
            for (int q = 0; q < 32; ++q) s += red[(q * 16 + cg2) * 16 + v];
            const int col = col0 + cg2 * 4 + j; s += bias;
            atomicAdd(mod + (size_t)(l * NB + b) * (3 * DM) + col, s); }
        __syncthreads();
    }
#undef M_LOAD
}
__device__ __forceinline__ void p0_tables(const Frame& F) {
    constexpr double INVF2PI[32] = {
    0.15915494309189535, 0.11934937021124886, 0.08949940160889101, 0.06711508300522726,
    0.050329212104487035, 0.03774158471741977, 0.0283021958306234, 0.02122365276477766,
    0.015915494309189534, 0.011934937021124886, 0.008949940160889102, 0.006711508300522725,
    0.005032921210448704, 0.003774158471741977, 0.00283021958306234, 0.0021223652764777662,
    0.0015915494309189536, 0.0011934937021124885, 0.0008949940160889102, 0.0006711508300522726,
    0.0005032921210448703, 0.00037741584717419774, 0.00028302195830623395, 0.0002122365276477766,
    0.00015915494309189535, 0.00011934937021124886, 8.949940160889102e-05, 6.711508300522725e-05,
    5.0329212104487035e-05, 3.774158471741978e-05, 2.8302195830623396e-05, 2.122365276477766e-05};
    const int gid = F.bx * NTHREADS + F.tid, NT = F.G * NTHREADS;
    const int* pos = (const int*)F.in[2]; float* rc = WSP(float, WS_RCOS); float* rs = WSP(float, WS_RSIN);
    for (int idx = gid; idx < MTOK * 32; idx += NT) { const int i = idx & 31; double t = (double)pos[idx >> 5] * INVF2PI[i]; t -= floor(t);
        float sn, cs; sincospif((float)(2.0 * t), &sn, &cs); rc[idx] = cs; rs[idx] = sn; }
    bf16_t* D1 = WSP(bf16_t, WS_D1); bf16_t* D2 = WSP(bf16_t, WS_D2);
    for (int idx = gid; idx < 128 * 64; idx += NT) { const int s1 = idx & 63, rr = idx >> 6, ri = rr >> 6, s1p = rr & 63; float sn, cs; sincospif((float)((s1 * s1p) & 63) * (1.0f / 32.0f), &sn, &cs);
        D1[idx] = f2bf((ri ? -sn : cs) * 0.125f); }
    for (int idx = gid; idx < 128 * 128; idx += NT) { const int kk = idx & 127, rr = idx >> 7, ri = kk >> 6, s2 = kk & 63, ro = rr >> 6, s2p = rr & 63; float sn, cs; sincospif((float)((s2 * s2p) & 63) * (1.0f / 32.0f), &sn, &cs);
        const float v = ro == 0 ? (ri == 0 ? cs : sn) : (ri == 0 ? -sn : cs); D2[idx] = f2bf(v * 0.125f); }
    float* rsq = WSP(float, WS_RSQ);
    for (int idx = gid; idx < DEPTH * MTOK * 2; idx += NT) rsq[idx] = 0.f;
}
__device__ __forceinline__ void p0_wcat(const Frame& F, const int l0, const int l1) {
    const int gid = F.bx * NTHREADS + F.tid, NT = F.G * NTHREADS;
    LAS float* ct = (LAS float*)F.lds; LAS float* st = ct + 128;
    if (F.tid < 128) { float sn, cs; sincospif((float)F.tid * (1.0f / 64.0f), &sn, &cs); ct[F.tid] = cs * 0.08838834764831845f; st[F.tid] = sn * 0.08838834764831845f; }
    __syncthreads();
    bf16_t* wcat = WSP(bf16_t, WS_WCAT);
    for (int t = l0 * (NG * 128 * 64) + gid; t < l1 * (NG * 128 * 64); t += NT) { const int k4 = (t & 63) * 4, d = (t >> 6) & 127, lg = t >> 13, ro = k4 >> 7, c0 = k4 & 127;
        const float* w = F.in[10] + (size_t)lg * 128 * 128 + d; LAS float* tb = ro ? st : ct; f32x4 s = {0.f, 0.f, 0.f, 0.f};
        for (int cp0 = 0; cp0 < 128; cp0 += 16) { float wv[16];
#pragma unroll
            for (int u = 0; u < 16; ++u) wv[u] = w[(cp0 + u) * 128];
#pragma unroll
            for (int u = 0; u < 16; ++u) { const int cp = cp0 + u; s += (f32x4){tb[(c0 * cp) & 127], tb[((c0 + 1) * cp) & 127], tb[((c0 + 2) * cp) & 127], tb[((c0 + 3) * cp) & 127]} * wv[u]; } }
        u32x2 o; o.x = cvt_pk_bf16(s[0], s[1]); o.y = cvt_pk_bf16(s[2], s[3]);
        *(u32x2*)(wcat + ((size_t)lg * 128 + d) * 256 + k4) = o; }
    __syncthreads();
}
#ifndef LN_NT
#define LN_NT 1
#endif
#if LN_NT
#define LN_LD(p) __builtin_nontemporal_load((const f32x4*)(p))
#define LN_ST(p, v) __builtin_nontemporal_store((v), (f32x4*)(p))
#else
#define LN_LD(p) (*(const f32x4*)(p))
#define LN_ST(p, v) (*(f32x4*)(p) = (v))
#endif
__device__ __forceinline__ void row_stats(const f32x4 (&v)[8], float& mean, float& rstd) {
    float s = 0.f;
#pragma unroll
    for (int i = 0; i < 8; ++i) s += (v[i][0] + v[i][1]) + (v[i][2] + v[i][3]);
    mean = wave_sum(s) * (1.0f / DM); float q = 0.f;
#pragma unroll
    for (int i = 0; i < 8; ++i) { const f32x4 d = v[i] - mean; q += (d[0] * d[0] + d[1] * d[1]) + (d[2] * d[2] + d[3] * d[3]); }
    rstd = rsqrtf(wave_sum(q) * (1.0f / DM) + NORM_EPS);
}
__device__ __forceinline__ void ln_rows(const Frame& F, int& r0, int& r1) { const int rpb = (((MTOK + F.G - 1) / F.G) + 7) & ~7; r0 = F.bx * rpb; r1 = r0 + rpb < MTOK ? r0 + rpb : MTOK; }
__device__ __forceinline__ void p_ln_first(const Frame& F, const int row0, const int row1, const int step) {
    const float* x = F.in[0]; const float* mod = WSP(float, WS_MOD); bf16_t* H = WSP(bf16_t, WS_H);
    for (int seg0 = row0; seg0 < row1; ) {
        const int cb = seg0 >> 12, segend = ((cb + 1) << 12) < row1 ? ((cb + 1) << 12) : row1;
        f32x4 v[8], vn[8], shv[8], scv[8];
        { const float* mp = mod + (size_t)cb * (3 * DM) + F.lane * 4;
#pragma unroll
          for (int i = 0; i < 8; ++i) { shv[i] = *(const f32x4*)(mp + i * 256); scv[i] = *(const f32x4*)(mp + DM + i * 256) + 1.0f; } }
        int row = seg0 + F.wave;
        if (row < segend) { const float* xr = x + (size_t)row * DM + F.lane * 4;
#pragma unroll
            for (int i = 0; i < 8; ++i) vn[i] = LN_LD(xr + i * 256); }
        for (; row < segend; row += step) {
#pragma unroll
            for (int i = 0; i < 8; ++i) v[i] = vn[i];
            if (row + step < segend) { const float* xr = x + (size_t)(row + step) * DM + F.lane * 4;
#pragma unroll
                for (int i = 0; i < 8; ++i) vn[i] = LN_LD(xr + i * 256); }
            float mean, rstd; row_stats(v, mean, rstd);
#pragma unroll
            for (int i = 0; i < 8; ++i) store4_bf16(H + (size_t)row * DM + F.lane * 4 + i * 256, (v[i] - mean) * rstd * scv[i] + shv[i]);
        }
        seg0 = segend;
    }
}
#ifndef LN_DROP_R
#define LN_DROP_R (PROBE_CHECK ? 0 : 1)
#endif
template <bool NEXT> __device__ __forceinline__ void p_ln_post(const Frame& F, int l, const int row0, const int row1, const int step) {
    constexpr bool DROPR = LN_DROP_R && NEXT;
    const float* xs = l == 0 ? F.in[0] : WSP(float, WS_R); float* dst = NEXT ? WSP(float, WS_R) : F.out; const float* g = F.in[12] + l * DM; const float* bb = F.in[13] + l * DM;
    const float* mod = WSP(float, WS_MOD) + (size_t)(l + 1) * NB * (3 * DM); bf16_t* H = WSP(bf16_t, WS_H); const bf16_t* GYs = DROPR ? WSP(bf16_t, WS_R) : WSP(bf16_t, WS_H);
    f32x4 gv[8], bv[8];
#pragma unroll
    for (int i = 0; i < 8; ++i) { gv[i] = *(const f32x4*)(g + F.lane * 4 + i * 256); bv[i] = *(const f32x4*)(bb + F.lane * 4 + i * 256); }
    for (int seg0 = row0; seg0 < row1; ) {
        const int cb = seg0 >> 12, segend = ((cb + 1) << 12) < row1 ? ((cb + 1) << 12) : row1;
        f32x4 v[8], vn[8], shv[8], scv[8]; u32x2 gyn[8];
        if (NEXT) { const float* mp = mod + (size_t)cb * (3 * DM) + F.lane * 4;
#pragma unroll
            for (int i = 0; i < 8; ++i) { shv[i] = *(const f32x4*)(mp + i * 256); scv[i] = *(const f32x4*)(mp + DM + i * 256) + 1.0f; } }
        int row = seg0 + F.wave;
        if (row < segend) { const float* xr = xs + (size_t)row * DM + F.lane * 4; const bf16_t* gr = GYs + (size_t)row * DM + F.lane * 4;
#pragma unroll
            for (int i = 0; i < 8; ++i) { vn[i] = LN_LD(xr + i * 256); gyn[i] = DROPR ? *(const u32x2*)(gr + i * 256) : __builtin_nontemporal_load((const u32x2*)(gr + i * 256)); } }
        for (; row < segend; row += step) {
#pragma unroll
            for (int i = 0; i < 8; ++i) { const u32x2 q = gyn[i];
                v[i] = vn[i] * DN_ALPHA + (f32x4){__uint_as_float(q.x << 16), __uint_as_float(q.x & 0xffff0000u), __uint_as_float(q.y << 16), __uint_as_float(q.y & 0xffff0000u)}; }
            if (row + step < segend) { const float* xr = xs + (size_t)(row + step) * DM + F.lane * 4; const bf16_t* gr = GYs + (size_t)(row + step) * DM + F.lane * 4;
#pragma unroll
                for (int i = 0; i < 8; ++i) { vn[i] = LN_LD(xr + i * 256); gyn[i] = DROPR ? *(const u32x2*)(gr + i * 256) : __builtin_nontemporal_load((const u32x2*)(gr + i * 256)); } }
            float mean, rstd; row_stats(v, mean, rstd);
#pragma unroll
            for (int i = 0; i < 8; ++i) { v[i] = (v[i] - mean) * rstd * gv[i] + bv[i];
                if (!DROPR) LN_ST(dst + (size_t)row * DM + F.lane * 4 + i * 256, v[i]); }
            if (NEXT) { row_stats(v, mean, rstd);
#pragma unroll
                for (int i = 0; i < 8; ++i) store4_bf16(H + (size_t)row * DM + F.lane * 4 + i * 256, (v[i] - mean) * rstd * scv[i] + shv[i]); }
        }
        seg0 = segend;
    }
}
__device__ __forceinline__ void p_ln_last(const Frame& F, const int row0, const int row1, const int step) {
    static_assert(DEPTH == 2, "p_ln_last rebuilds exactly one earlier layer");
    const float* xs = F.in[0]; float* dst = F.out; const bf16_t* GY0 = WSP(bf16_t, WS_R); const bf16_t* GY1 = WSP(bf16_t, WS_H);
    LAS float* pl = (LAS float*)F.lds;
    *(LAS f32x4*)(pl + F.tid * 4) = *(const f32x4*)(F.in[12] + F.tid * 4); *(LAS f32x4*)(pl + DM + F.tid * 4) = *(const f32x4*)(F.in[13] + F.tid * 4);
    *(LAS f32x4*)(pl + 2 * DM + F.tid * 4) = *(const f32x4*)(F.in[12] + DM + F.tid * 4); *(LAS f32x4*)(pl + 3 * DM + F.tid * 4) = *(const f32x4*)(F.in[13] + DM + F.tid * 4);
    __syncthreads();
    f32x4 v[8], vn[8]; u32x2 g0n[8], g1n[8], g1c[8];
    int row = row0 + F.wave;
#define LNL_LOAD(R) do { const float* xr = xs + (size_t)(R) * DM + F.lane * 4; const bf16_t* p0 = GY0 + (size_t)(R) * DM + F.lane * 4; const bf16_t* p1 = GY1 + (size_t)(R) * DM + F.lane * 4; \
        _Pragma("unroll") for (int i = 0; i < 8; ++i) { vn[i] = LN_LD(xr + i * 256); g0n[i] = __builtin_nontemporal_load((const u32x2*)(p0 + i * 256)); g1n[i] = __builtin_nontemporal_load((const u32x2*)(p1 + i * 256)); } } while (0)
#define LNL_UNPK(q) ((f32x4){__uint_as_float((q).x << 16), __uint_as_float((q).x & 0xffff0000u), __uint_as_float((q).y << 16), __uint_as_float((q).y & 0xffff0000u)})
    if (row < row1) LNL_LOAD(row);
    for (; row < row1; row += step) {
        asm volatile("" ::: "memory");
#pragma unroll
        for (int i = 0; i < 8; ++i) { v[i] = vn[i] * DN_ALPHA + LNL_UNPK(g0n[i]); g1c[i] = g1n[i]; }
        if (row + step < row1) LNL_LOAD(row + step);
        float mean, rstd; row_stats(v, mean, rstd);
#pragma unroll
        for (int i = 0; i < 8; ++i) { const f32x4 g0 = *(const LAS f32x4*)(pl + F.lane * 4 + i * 256), b0 = *(const LAS f32x4*)(pl + DM + F.lane * 4 + i * 256);
            v[i] = ((v[i] - mean) * rstd * g0 + b0) * DN_ALPHA + LNL_UNPK(g1c[i]); }
        row_stats(v, mean, rstd);
#pragma unroll
        for (int i = 0; i < 8; ++i) { const f32x4 g1 = *(const LAS f32x4*)(pl + 2 * DM + F.lane * 4 + i * 256), b1 = *(const LAS f32x4*)(pl + 3 * DM + F.lane * 4 + i * 256);
            LN_ST(dst + (size_t)row * DM + F.lane * 4 + i * 256, (v[i] - mean) * rstd * g1 + b1); }
    }
#undef LNL_LOAD
#undef LNL_UNPK
}
__device__ __forceinline__ void fft1_naive(const Frame& F) {
    const bf16_t* U = WSP(bf16_t, WS_U); const bf16_t* D1 = WSP(bf16_t, WS_D1); bf16_t* Z = WSP(bf16_t, WS_H);
    const int gid = F.bx * NTHREADS + F.tid, NT = F.G * NTHREADS;
    for (int idx = gid; idx < NB * 64 * NG * 64 * 128; idx += NT) {
        const int c = idx & 127, s2 = (idx >> 7) & 63, g = (idx >> 13) & 7, s1p = (idx >> 16) & 63, b = idx >> 22;
        float yr = 0.f, yi = 0.f;
        for (int s1 = 0; s1 < 64; ++s1) { const float u = bf2f(U[(size_t)(b * SEQ + 64 * s1 + s2) * DF + g * 128 + c]); yr += bf2f(D1[s1p * 64 + s1]) * u; yi += bf2f(D1[(64 + s1p) * 64 + s1]) * u; }
        float st, ct; sincospif((float)(s2 * s1p) * (1.0f / 2048.0f), &st, &ct);
        const size_t zo = ((((size_t)(b * 64 + s1p) * NG + g) * 2) * 64 + s2) * 128 + c;
        Z[zo] = f2bf(yr * ct + yi * st); Z[zo + 64 * 128] = f2bf(yi * ct - yr * st);
    }
}
__device__ __forceinline__ void fft2_naive(const Frame& F, int l) {
    const bf16_t* Z = WSP(bf16_t, WS_H); const bf16_t* D2 = WSP(bf16_t, WS_D2); const bf16_t* wcat = WSP(bf16_t, WS_WCAT) + (size_t)l * NG * 128 * 256; bf16_t* MIX = WSP(bf16_t, WS_MIX);
    LAS float* Xs = (LAS float*)F.lds;
    for (int it = F.bx; it < NB * 64 * NG; it += F.G) {
        const int g = it & 7, s1p = (it >> 3) & 63, b = it >> 9;
        const bf16_t* Zb = Z + ((size_t)(b * 64 + s1p) * NG + g) * 2 * 64 * 128;
        for (int i = 0; i < 32; ++i) { const int o = F.tid + 512 * i, c = o & 127, rr = o >> 7; float s = 0.f;
            for (int k = 0; k < 128; ++k) s += bf2f(D2[rr * 128 + k]) * bf2f(Zb[k * 128 + c]);
            Xs[rr * 128 + c] = bf2f(f2bf(s)); }
        __syncthreads();
        for (int i = 0; i < 16; ++i) { const int o = F.tid + 512 * i, d = o & 127, s2p = o >> 7; float s = 0.f;
            const bf16_t* wr = wcat + (size_t)(g * 128 + d) * 256;
            for (int k = 0; k < 256; ++k) s += Xs[((k >> 7) * 64 + s2p) * 128 + (k & 127)] * bf2f(wr[k]);
            const size_t mo = (size_t)(b * SEQ + s1p + 64 * s2p) * DM + g * 128 + d;
            MIX[mo] = f2bf(s * (GATE_IN_EPI ? bf2f(MIX[mo]) : silu_f(bf2f(MIX[mo])))); }
        __syncthreads();
    }
}
__device__ __forceinline__ void attn_naive(const Frame& F) {
    const bf16_t* Q = WSP(bf16_t, WS_Q); const bf16_t* KV = WSP(bf16_t, WS_KV); const bf16_t* KR = WSP(bf16_t, WS_KR); bf16_t* MIX = WSP(bf16_t, WS_MIX);
    LAS float* qs = (LAS float*)F.lds + F.wave * 192;
    for (int it = F.bx * 8 + F.wave; it < MTOK * NH * 2; it += F.G * 8) {
        const int dh = it & 1, h = (it >> 1) & 7, tok = it >> 4, b = tok >> 12;
        __builtin_amdgcn_wave_barrier(); asm volatile("" ::: "memory");
        for (int e = 0; e < 3; ++e) qs[F.lane + 64 * e] = bf2f(Q[(size_t)tok * NQ + h * DQK + F.lane + 64 * e]);
        asm volatile("s_waitcnt lgkmcnt(0)" ::: "memory"); __builtin_amdgcn_wave_barrier();
        float m = -1e30f, lsum = 0.f; float o[64];
#pragma unroll
        for (int d = 0; d < 64; ++d) o[d] = 0.f;
        for (int t = 0; t < 64; ++t) {
            const size_t key = (size_t)b * SEQ + F.lane + 64 * t; const bf16_t* kn = KV + key * NKV + h * 256; const bf16_t* kr = KR + key * 64;
            float s = 0.f;
#pragma unroll 2
            for (int c = 0; c < 16; ++c) { const bf16x8 kv = *(const bf16x8*)(kn + c * 8);
#pragma unroll
                for (int e = 0; e < 8; ++e) s += qs[c * 8 + e] * bf2f((bf16_t)kv[e]); }
#pragma unroll 2
            for (int c = 0; c < 8; ++c) { const bf16x8 kv = *(const bf16x8*)(kr + c * 8);
#pragma unroll
                for (int e = 0; e < 8; ++e) s += qs[128 + c * 8 + e] * bf2f((bf16_t)kv[e]); }
            s *= ATT_SCALE; const float mn = fmaxf(m, s), a = __expf(m - mn), p = __expf(s - mn); lsum = lsum * a + p; m = mn;
#pragma unroll
            for (int c = 0; c < 8; ++c) { const bf16x8 vv = *(const bf16x8*)(kn + 128 + dh * 64 + c * 8);
#pragma unroll
                for (int e = 0; e < 8; ++e) o[c * 8 + e] = o[c * 8 + e] * a + p * bf2f((bf16_t)vv[e]); }
        }
        const float Mx = wave_max(m), f = __expf(m - Mx); const float L = wave_sum(lsum * f);
        float keep0 = 0.f;
#pragma unroll
        for (int d = 0; d < 64; ++d) { const float od = wave_sum(o[d] * f); if (F.lane == d) keep0 = od; }
        const size_t mo = (size_t)tok * DM + DF + h * 128 + dh * 64 + F.lane;
        MIX[mo] = f2bf(keep0 / L * (GATE_IN_EPI ? bf2f(MIX[mo]) : silu_f(bf2f(MIX[mo]))));
    }
}
namespace att {
constexpr int NW = 8, QBLK = 32, KVBLK = 64;
#ifndef ATT_STAG
#define ATT_STAG 0
#endif
#ifndef ATT_HYB
#define ATT_HYB 0
#endif
#ifndef ATT_S16
#define ATT_S16 0
#endif
#ifndef ATT_DMA
#define ATT_DMA 0
#endif
#ifndef ATT_SHAPE16
#define ATT_SHAPE16 0
#endif
#ifndef ATT_STAMP
#define ATT_STAMP -1
#endif
#ifndef ATT_SPRIO
#define ATT_SPRIO 0
#endif
#ifndef ATT_PRIO
#define ATT_PRIO 0
#endif
#ifndef ATT_QSB2
#define ATT_QSB2 1
#endif
#ifndef ATT_SDEPTH
#define ATT_SDEPTH 1
#endif
constexpr int SDEPTH = ATT_SDEPTH;
constexpr float THR = 8.f;
constexpr int SHM_V = KVBLK * 128 * 2, SHM_KN = KVBLK * 128 * 2, SHM_KR = KVBLK * 64 * 2;
#ifndef ATT_QLDS
#define ATT_QLDS 6
#endif
constexpr int QLDS = ATT_QLDS, QREG = 12 - QLDS;
constexpr int OFF_V = 0, OFF_KN = 2 * SHM_V, OFF_KR = OFF_KN + 2 * SHM_KN, OFF_WS = OFF_KR + 2 * SHM_KR, OFF_QL = OFF_WS + NW * 64 * 4, OFF_OT = 0, OT_PITCH = 272, SHM_ATTN = OFF_QL + NW * QLDS * 1024;
static_assert(NW * 32 * OT_PITCH <= OFF_WS, "O tiles reuse the K/V buffers");
static_assert(SHM_ATTN <= RING_BYTES, "attention LDS must fit the phase scratch");
#define KSWZ(row, colB) ((row) * 256 + ((colB) ^ (((row) & 15) << 4)))
#define RSWZ(row, ch) ((row) * 128 + ((((ch) ^ (((row) >> 1) & 7))) << 4))
#define SBAR() __builtin_amdgcn_sched_barrier(0)
__device__ __forceinline__ int crow(int r, int hi) { return (r & 3) + 8 * (r >> 2) + 4 * hi; }
__device__ __forceinline__ unsigned cvtpk(float lo, float hi) { unsigned r; asm volatile("v_cvt_pk_bf16_f32 %0, %1, %2" : "=v"(r) : "v"(lo), "v"(hi)); return r; }
__device__ __forceinline__ bf16x8 ld8(const bf16_t* p) { return *reinterpret_cast<const bf16x8*>(p); }


template <bool S16> __device__ __forceinline__ f32x16 mfma_sel(bf16x8 a, bf16x8 b, f32x16 c) {
  if constexpr (S16) {
  f32x4 c0 = {c[0], c[1], c[2], c[3]}, c1 = {c[4], c[5], c[6], c[7]};
  c0 = __builtin_amdgcn_mfma_f32_16x16x32_bf16(a, b, c0, 0, 0, 0); c1 = __builtin_amdgcn_mfma_f32_16x16x32_bf16(a, b, c1, 0, 0, 0);
  c[0] = c0[0]; c[1] = c0[1]; c[2] = c0[2]; c[3] = c0[3]; c[4] = c1[0]; c[5] = c1[1]; c[6] = c1[2]; c[7] = c1[3]; return c;
  } else return __builtin_amdgcn_mfma_f32_32x32x16_bf16(a, b, c, 0, 0, 0);
}
__device__ __forceinline__ void partialSM(f32x16& p0, f32x16& p1, float& m_reg, float& mn, float& alpha) {
#if defined(PROBE_NEG) && PROBE_NEG == 2
  constexpr float C = ATT_SCALE * 1.4426950408889634f * 1.3f;
#else
  constexpr float C = ATT_SCALE * 1.4426950408889634f;
#endif
  float pmax = p0[0]; for (int r = 1; r < 16; ++r) pmax = fmaxf(pmax, p0[r]); for (int r = 0; r < 16; ++r) pmax = fmaxf(pmax, p1[r]);
  { auto rr = __builtin_amdgcn_permlane32_swap(__float_as_uint(pmax), __float_as_uint(pmax), false, false);
    pmax = fmaxf(__uint_as_float(rr[0]), __uint_as_float(rr[1])); }
  if (__builtin_expect(__all(pmax - m_reg <= THR / ATT_SCALE), 1)) { mn = m_reg; alpha = 1.f; }
  else { mn = fmaxf(m_reg, pmax); alpha = __builtin_amdgcn_exp2f((m_reg - mn) * C); m_reg = mn; }
  float mnC = -mn * C;
  for (int r = 0; r < 16; ++r) p0[r] = fmaf(p0[r], C, mnC); for (int r = 0; r < 16; ++r) p1[r] = fmaf(p1[r], C, mnC);
  for (int r = 0; r < 16; ++r) p0[r] = __builtin_amdgcn_exp2f(p0[r]);
}
__device__ __forceinline__ void finishSM(f32x16& p0, f32x16& p1, float alpha, float& l_reg, bf16x8& pa0, bf16x8& pa1, bf16x8& pa2, bf16x8& pa3) {
  for (int r = 0; r < 16; ++r) p1[r] = __builtin_amdgcn_exp2f(p1[r]);
  float ps = 0; for (int r = 0; r < 16; ++r) ps += p0[r]; for (int r = 0; r < 16; ++r) ps += p1[r];
  { auto rr = __builtin_amdgcn_permlane32_swap(__float_as_uint(ps), __float_as_uint(ps), false, false);
    ps = __uint_as_float(rr[0]) + __uint_as_float(rr[1]); }
  l_reg = l_reg * alpha + ps;
#define PK4(P, BASE, OUT) do { unsigned a0 = cvtpk(P[BASE + 0], P[BASE + 1]), a1 = cvtpk(P[BASE + 2], P[BASE + 3]);   \
    unsigned b0 = cvtpk(P[BASE + 4], P[BASE + 5]), b1 = cvtpk(P[BASE + 6], P[BASE + 7]);                              \
    auto r0 = __builtin_amdgcn_permlane32_swap(a0, b0, false, false); auto r1 = __builtin_amdgcn_permlane32_swap(a1, b1, false, false); \
    u32x4 w = {r0[0], r1[0], r0[1], r1[1]}; OUT = *reinterpret_cast<bf16x8*>(&w); } while (0)
  PK4(p0, 0, pa0); PK4(p0, 8, pa1); PK4(p1, 0, pa2); PK4(p1, 8, pa3);
#undef PK4
}
template <int QR> __device__ __forceinline__ bf16x8 qfrag(const char* ql, int d0) { return *reinterpret_cast<const bf16x8*>(ql + (d0 - QR) * 1024); }
__device__ __forceinline__ void kfrag(bf16x8& a, bf16x8& b, const char* Kn, const char* Kr, int d0, int r32, int hi) {
  if (d0 < 8) { const int cb = (d0 * 16 + hi * 8) * 2; a = *reinterpret_cast<const bf16x8*>(Kn + KSWZ(r32, cb)); b = *reinterpret_cast<const bf16x8*>(Kn + KSWZ(32 + r32, cb)); }
  else { const int ch = (d0 - 8) * 2 + hi; a = *reinterpret_cast<const bf16x8*>(Kr + RSWZ(r32, ch)); b = *reinterpret_cast<const bf16x8*>(Kr + RSWZ(32 + r32, ch)); }
}
template <int QR, bool S16 = false> __device__ __forceinline__ void qkt(f32x16& p0, f32x16& p1, const char* Kn, const char* Kr, const bf16x8* qr, const char* ql, int r32, int hi) {
  p0 = f32x16{}; p1 = f32x16{};
  bf16x8 ka, kb, na, nb, qc, qn;
  kfrag(ka, kb, Kn, Kr, 0, r32, hi); if (0 >= QR) qc = qfrag<QR>(ql, 0);
#pragma unroll
  for (int d0 = 0; d0 < 12; ++d0) {
    if (d0 + 1 < 12) { kfrag(na, nb, Kn, Kr, d0 + 1, r32, hi); if (d0 + 1 >= QR) qn = qfrag<QR>(ql, d0 + 1); }
    SBAR();
    const bf16x8 q = d0 < QR ? qr[d0 < QR ? d0 : 0] : qc;
    if (ATT_PRIO) __builtin_amdgcn_s_setprio(1);
    p0 = mfma_sel<S16>(ka, q, p0);
    p1 = mfma_sel<S16>(kb, q, p1);
    if (ATT_PRIO) __builtin_amdgcn_s_setprio(0);
    if (ATT_QSB2) SBAR();
    ka = na; kb = nb; qc = qn;
  }
}
__device__ __forceinline__ int v_st(int k, int c) { const int kk = (k & ~0xC) | ((k & 4) << 1) | ((k & 8) >> 1); return ((kk >> 3) * 4 + (c >> 5)) * 512 + ((kk & 7) * 32 + (c & 31)) * 2; }
__device__ __forceinline__ int v_rd_base(int lane) { return ((lane & 3) << 3) | (((lane >> 2) & 3) << 6) | (((lane >> 4) & 1) << 5) | (((lane >> 5) & 1) << 8); }
constexpr int v_rd_off(int d0, int ks, int half) { return d0 * 512 + ks * 4096 + half * 2048; }
template <int OFF> __device__ __forceinline__ s16x4 tr_read(int vb) {
  s16x4 r; asm volatile("ds_read_b64_tr_b16 %0, %1 offset:%2" : "=&v"(r) : "v"(vb), "i"(OFF) : "memory"); return r;
}
#define TRPK(L, H) (bf16x8){L[0], L[1], L[2], L[3], H[0], H[1], H[2], H[3]}
template <int D0, bool S16 = false> __device__ __forceinline__ void pv_one(f32x16& od, int vb, bf16x8 pa0, bf16x8 pa1, bf16x8 pa2, bf16x8 pa3) {
  const s16x4 l0 = tr_read<v_rd_off(D0, 0, 0)>(vb), h0 = tr_read<v_rd_off(D0, 0, 1)>(vb), l1 = tr_read<v_rd_off(D0, 1, 0)>(vb), h1 = tr_read<v_rd_off(D0, 1, 1)>(vb);
  const s16x4 l2 = tr_read<v_rd_off(D0, 2, 0)>(vb), h2 = tr_read<v_rd_off(D0, 2, 1)>(vb), l3 = tr_read<v_rd_off(D0, 3, 0)>(vb), h3 = tr_read<v_rd_off(D0, 3, 1)>(vb);
  asm volatile("s_waitcnt lgkmcnt(0)" ::: "memory"); SBAR();
  if (ATT_PRIO) __builtin_amdgcn_s_setprio(1);
  od = mfma_sel<S16>(pa0, TRPK(l0, h0), od);
  od = mfma_sel<S16>(pa1, TRPK(l1, h1), od);
  od = mfma_sel<S16>(pa2, TRPK(l2, h2), od);
  od = mfma_sel<S16>(pa3, TRPK(l3, h3), od);
  if (ATT_PRIO) __builtin_amdgcn_s_setprio(0);
}
template <bool S16 = false> __device__ __forceinline__ void pv_d0(f32x16* o, int vb, bf16x8 pa0, bf16x8 pa1, bf16x8 pa2, bf16x8 pa3) {
  pv_one<0, S16>(o[0], vb, pa0, pa1, pa2, pa3); pv_one<1, S16>(o[1], vb, pa0, pa1, pa2, pa3); pv_one<2, S16>(o[2], vb, pa0, pa1, pa2, pa3); pv_one<3, S16>(o[3], vb, pa0, pa1, pa2, pa3);
}

template <int VAR>
__device__ __forceinline__ void attn_body(const bf16_t* __restrict__ Qb, const bf16_t* __restrict__ Kn, const bf16_t* __restrict__ Kr,
                                          bf16_t* __restrict__ Gm, int seq, char* lds, int tid) {
  const int wid = tid >> 6, lane = tid & 63, r32 = lane & 31, hi = lane >> 5;
  char* V_lds = lds + OFF_V; char* K_lds = lds + OFF_KN; char* R_lds = lds + OFF_KR;
  float* ws = (float*)(lds + OFF_WS) + wid * 64; float* li_l = ws; float* al_l = ws + 32;
  float m_reg = -1e30f, l_reg = 0; f32x16 o[4] = {}; bf16x8 qr[QREG > 0 ? QREG : 1];
  char* ql = lds + OFF_QL + wid * (QLDS * 1024) + lane * 16;
  const unsigned qoff = (unsigned)((wid * QBLK + r32) * NQ + hi * 8) * 2u;
#pragma unroll
  for (int d0 = 0; d0 < 12; ++d0) { const bf16x8 qv = *(const bf16x8*)((const char*)Qb + qoff + d0 * 32); if (d0 < QREG) qr[d0 < QREG ? d0 : 0] = qv; else *reinterpret_cast<bf16x8*>(ql + (d0 - QREG) * 1024) = qv; }
  const int sr = tid >> 4, sc = (tid & 15) * 8, vst0 = v_st(sr, sc), vst1 = v_st(32 + sr, sc);
  const int rr_ = tid >> 3, rc_ = tid & 7;
  const int vb0 = (int)(uintptr_t)V_lds + v_rd_base(lane);
  struct { bf16x8 vs0, vs1, ks0, ks1, kr; } sr_[SDEPTH];
  const unsigned voff = (unsigned)(sr * NKV + sc) * 2u, voffr = (unsigned)(rr_ * 64 + rc_ * 8) * 2u;
#define SLOAD(i, k0) do { const char* kb_ = (const char*)(Kn + (long)(k0) * NKV); const char* rb_ = (const char*)(Kr + (long)(k0) * 64); \
    sr_[i].vs0 = *(const bf16x8*)(kb_ + 256 + voff); sr_[i].vs1 = *(const bf16x8*)(kb_ + (32 * NKV * 2 + 256) + voff); \
    sr_[i].ks0 = *(const bf16x8*)(kb_ + voff); sr_[i].ks1 = *(const bf16x8*)(kb_ + 32 * NKV * 2 + voff); \
    sr_[i].kr = *(const bf16x8*)(rb_ + voffr); } while (0)
#define SWRITE(b, i) do { *(bf16x8*)(V_lds + (b) * SHM_V + vst0) = sr_[i].vs0;          \
    *(bf16x8*)(V_lds + (b) * SHM_V + vst1) = sr_[i].vs1; int kc = sc * 2;               \
    *(bf16x8*)(K_lds + (b) * SHM_KN + KSWZ(sr, kc)) = sr_[i].ks0;                       \
    *(bf16x8*)(K_lds + (b) * SHM_KN + KSWZ(32 + sr, kc)) = sr_[i].ks1;                  \
    *(bf16x8*)(R_lds + (b) * SHM_KR + RSWZ(rr_, rc_)) = sr_[i].kr; } while (0)
#define SLOADV(i, k0) do { if constexpr (VAR != 4) SLOAD(i, k0); } while (0)
#define SWRITEV(b, i) do { if constexpr (VAR != 4) SWRITE(b, i); } while (0)
#define SWAIT() do { if constexpr (SDEPTH == 2) asm volatile("s_waitcnt vmcnt(5)" ::: "memory"); else asm volatile("s_waitcnt vmcnt(0)" ::: "memory"); } while (0)
#define RESC(a) do { if (__any((a) < 1.f)) { if (hi == 0) al_l[r32] = (a); asm volatile("s_waitcnt lgkmcnt(0)" ::: "memory"); \
    for (int d = 0; d < 4; ++d) for (int r = 0; r < 16; ++r) o[d][r] *= al_l[crow(r, hi)]; } } while (0)
  f32x16 pA0, pA1, pB0, pB1; float mnA, mnB, alA, alB; bf16x8 pa0, pa1, pa2, pa3; const int NT = seq / KVBLK;
#define QKT(P0, P1, KN, KR) do { if constexpr (VAR == 3) { P0 = o[0]; P1 = o[1]; } else qkt<QREG, VAR == 6>(P0, P1, KN, KR, qr, ql, r32, hi); } while (0)
#define PSM(P0, P1, MN, AL) do { if constexpr (VAR == 1) { MN = m_reg; AL = 1.f; } else partialSM(P0, P1, m_reg, MN, AL); } while (0)
#define FSM(P0, P1, AL) do { if constexpr (VAR == 1) { pa0 = __builtin_bit_cast(bf16x8, (f32x4){P0[0], P0[1], P0[2], P0[3]}); pa1 = __builtin_bit_cast(bf16x8, (f32x4){P0[4], P0[5], P0[6], P0[7]}); \
      pa2 = __builtin_bit_cast(bf16x8, (f32x4){P1[0], P1[1], P1[2], P1[3]}); pa3 = __builtin_bit_cast(bf16x8, (f32x4){P1[4], P1[5], P1[6], P1[7]}); l_reg += P0[8] + P1[9]; } \
    else finishSM(P0, P1, AL, l_reg, pa0, pa1, pa2, pa3); } while (0)
#define PVD(VB) do { if constexpr (VAR == 2) { o[0][0] += __builtin_bit_cast(f32x4, pa0)[0]; o[1][1] += __builtin_bit_cast(f32x4, pa1)[1]; o[2][2] += __builtin_bit_cast(f32x4, pa2)[2]; o[3][3] += __builtin_bit_cast(f32x4, pa3)[3]; } else pv_d0<VAR == 6 || VAR == 8>(o, VB, pa0, pa1, pa2, pa3); } while (0)
#define SYNC() do { if constexpr (VAR != 5) __syncthreads(); } while (0)
  constexpr int SE = 0, SO = SDEPTH - 1;
  SLOAD(SE, 0); asm volatile("s_waitcnt vmcnt(0)" ::: "memory"); SWRITE(0, SE); SYNC();
  QKT(pA0, pA1, K_lds, R_lds); PSM(pA0, pA1, mnA, alA);
  SLOAD(SO, KVBLK); if constexpr (SDEPTH == 2) { if (2 < NT) SLOAD(SE, 2 * KVBLK); }
  SWAIT(); SWRITE(1, SO); SYNC();
#if ATT_STAMP >= 0
  unsigned long long tk_ = 0, sg_[5] = {0, 0, 0, 0, 0};
#define STMP(k) do { SBAR(); const unsigned long long tn_ = __builtin_amdgcn_s_memtime(); SBAR(); if ((k) >= 0) sg_[(k) < 0 ? 0 : (k)] += tn_ - tk_; tk_ = tn_; } while (0)
#else
#define STMP(k) do { } while (0)
#endif
  STMP(-1);
  if (ATT_SPRIO && wid >= 4) __builtin_amdgcn_s_setprio(1);
  for (int j = 1; j + 1 < NT; j += 2) {
    SBAR(); QKT(pB0, pB1, K_lds + SHM_KN, R_lds + SHM_KR);
    FSM(pA0, pA1, alA); SBAR(); STMP(0);
    SLOADV(SO, (j + SDEPTH) * KVBLK); SBAR();
    PVD(vb0); PSM(pB0, pB1, mnB, alB); STMP(1);
    SYNC(); STMP(2); SWAIT(); SWRITEV(0, SE);
    RESC(alB); STMP(3); SYNC(); STMP(4);
    SBAR(); QKT(pA0, pA1, K_lds, R_lds);
    FSM(pB0, pB1, alB); SBAR(); STMP(0);
    if (SDEPTH == 1 || j + 3 < NT) SLOADV(SE, (j + 1 + SDEPTH) * KVBLK); SBAR();
    PVD(vb0 + (int)SHM_V); PSM(pA0, pA1, mnA, alA); STMP(1);
    SYNC(); STMP(2); SWAIT(); SWRITEV(1, SO);
    RESC(alA); STMP(3); SYNC(); STMP(4);
  }
#if ATT_STAMP >= 0
  if (tid == 0) { volatile unsigned* mw = (volatile unsigned*)(lds + RING_BYTES) + 16; for (int k_ = 0; k_ < 5; ++k_) mw[k_] += (unsigned)(sg_[k_] >> 4); }
#endif
#undef STMP
  SBAR(); QKT(pB0, pB1, K_lds + SHM_KN, R_lds + SHM_KR);
  FSM(pA0, pA1, alA); SBAR();
  PVD(vb0); PSM(pB0, pB1, mnB, alB);
  SYNC(); RESC(alB);
  FSM(pB0, pB1, alB); SBAR();
  PVD(vb0 + (int)SHM_V);
  if (ATT_SPRIO) __builtin_amdgcn_s_setprio(0);
  SBAR(); asm volatile("" ::: "memory");
  u32x4 gt[8]; const int grow = lane >> 4, gc16 = lane & 15;
  bf16_t* Gw = Gm + (size_t)(wid * QBLK + grow) * DM + gc16 * 8;
#pragma unroll
  for (int i = 0; i < 8; ++i) gt[i] = __builtin_nontemporal_load((const u32x4*)(Gw + (size_t)(4 * i) * DM));
  if (hi == 0) li_l[r32] = l_reg;
  __syncthreads();
  char* ot = lds + OFF_OT + wid * (32 * OT_PITCH);
#pragma unroll
  for (int r = 0; r < 16; ++r) { const float rl = __builtin_amdgcn_rcpf(li_l[crow(r, hi)]); char* orow = ot + crow(r, hi) * OT_PITCH + r32 * 2;
#pragma unroll
    for (int d0 = 0; d0 < 4; ++d0) *(bf16_t*)(orow + d0 * 64) = f2bf(o[d0][r] * rl); }
  asm volatile("s_waitcnt lgkmcnt(0)" ::: "memory");
#pragma unroll
  for (int i = 0; i < 8; ++i) { const u32x4 ov = *(const u32x4*)(ot + (grow + 4 * i) * OT_PITCH + gc16 * 16); const u32x4 gv = gt[i]; u32x4 w;
#pragma unroll
    for (int e = 0; e < 4; ++e) { const float g0_ = __uint_as_float(gv[e] << 16), g1_ = __uint_as_float(gv[e] & 0xffff0000u); const float a0 = __uint_as_float(ov[e] << 16) * (GATE_IN_EPI ? g0_ : silu_f(g0_)), a1 = __uint_as_float(ov[e] & 0xffff0000u) * (GATE_IN_EPI ? g1_ : silu_f(g1_)); w[e] = cvt_pk_bf16(a0, a1); }
    *(u32x4*)(Gw + (size_t)(4 * i) * DM) = w; }
#undef SLOAD
#undef SLOADV
#undef SWRITEV
#undef QKT
#undef PSM
#undef FSM
#undef PVD
#undef SYNC
#undef SWRITE
#undef SWAIT
#undef RESC
}

#ifndef ATT_ONEBAR
#define ATT_ONEBAR 0
#endif
__device__ __forceinline__ void attn_body5(const bf16_t* __restrict__ Qb, const bf16_t* __restrict__ Kn, const bf16_t* __restrict__ Kr,
                                           bf16_t* __restrict__ Gm, int seq, char* lds, int tid) {
  const int wid = tid >> 6, lane = tid & 63, r32 = lane & 31, hi = lane >> 5;
  char* V_lds = lds + OFF_V; char* K_lds = lds + OFF_KN; char* R_lds = lds + OFF_KR;
  float* ws = (float*)(lds + OFF_WS) + wid * 64; float* li_l = ws; float* al_l = ws + 32;
  float m_reg = -1e30f, l_reg = 0; f32x16 o[4] = {}; bf16x8 qr[QREG > 0 ? QREG : 1];
  char* ql = lds + OFF_QL + wid * (QLDS * 1024) + lane * 16;
  const unsigned qoff = (unsigned)((wid * QBLK + r32) * NQ + hi * 8) * 2u;
#pragma unroll
  for (int d0 = 0; d0 < 12; ++d0) { const bf16x8 qv = *(const bf16x8*)((const char*)Qb + qoff + d0 * 32); if (d0 < QREG) qr[d0 < QREG ? d0 : 0] = qv; else *reinterpret_cast<bf16x8*>(ql + (d0 - QREG) * 1024) = qv; }
  const int sr = tid >> 4, sc = (tid & 15) * 8, vst0 = v_st(sr, sc), vst1 = v_st(32 + sr, sc);
  const int rr_ = tid >> 3, rc_ = tid & 7;
  const int vb0 = (int)(uintptr_t)V_lds + v_rd_base(lane);
  bf16x8 vs0, vs1, ks0, ks1, kr;
  const unsigned voff = (unsigned)(sr * NKV + sc) * 2u, voffr = (unsigned)(rr_ * 64 + rc_ * 8) * 2u;
  const int NT = seq / KVBLK;
#define TCL(t) ((t) < NT ? (t) : NT - 1)
#define KLOAD5(t) do { const long k0_ = (long)TCL(t) * KVBLK; const char* kb_ = (const char*)(Kn + k0_ * NKV); const char* rb_ = (const char*)(Kr + k0_ * 64); \
    ks0 = *(const bf16x8*)(kb_ + voff); ks1 = *(const bf16x8*)(kb_ + 32 * NKV * 2 + voff); kr = *(const bf16x8*)(rb_ + voffr); } while (0)
#define VLOAD5(t) do { const char* kb_ = (const char*)(Kn + (long)TCL(t) * KVBLK * NKV); vs0 = *(const bf16x8*)(kb_ + 256 + voff); vs1 = *(const bf16x8*)(kb_ + (32 * NKV * 2 + 256) + voff); } while (0)
#define KWRITE5(b) do { const int kc = sc * 2; *(bf16x8*)(K_lds + (b) * SHM_KN + KSWZ(sr, kc)) = ks0; *(bf16x8*)(K_lds + (b) * SHM_KN + KSWZ(32 + sr, kc)) = ks1; *(bf16x8*)(R_lds + (b) * SHM_KR + RSWZ(rr_, rc_)) = kr; } while (0)
#define VWRITE5(b) do { *(bf16x8*)(V_lds + (b) * SHM_V + vst0) = vs0; *(bf16x8*)(V_lds + (b) * SHM_V + vst1) = vs1; } while (0)
#define RESC5(a) do { if (__any((a) < 1.f)) { if (hi == 0) al_l[r32] = (a); asm volatile("s_waitcnt lgkmcnt(0)" ::: "memory"); \
    for (int d = 0; d < 4; ++d) for (int r = 0; r < 16; ++r) o[d][r] *= al_l[crow(r, hi)]; } } while (0)
  f32x16 pA0, pA1, pB0, pB1; float mnA, mnB, alA, alB; bf16x8 pa0, pa1, pa2, pa3;
  KLOAD5(0); VLOAD5(0); KWRITE5(0); VWRITE5(0); KLOAD5(1); SBAR(); KWRITE5(1); VLOAD5(1); SBAR();
  __syncthreads();
  qkt<QREG, false>(pA0, pA1, K_lds, R_lds, qr, ql, r32, hi); partialSM(pA0, pA1, m_reg, mnA, alA);
  for (int t = 0; t + 2 < NT; t += 2) {
    SBAR(); VWRITE5(1); KLOAD5(t + 2); SBAR();
    qkt<QREG, false>(pB0, pB1, K_lds + SHM_KN, R_lds + SHM_KR, qr, ql, r32, hi);
    finishSM(pA0, pA1, alA, l_reg, pa0, pa1, pa2, pa3); SBAR();
    KWRITE5(0); VLOAD5(t + 2); SBAR();
    pv_d0<false>(o, vb0, pa0, pa1, pa2, pa3); partialSM(pB0, pB1, m_reg, mnB, alB);
    RESC5(alB);
    __syncthreads();
    SBAR(); VWRITE5(0); KLOAD5(t + 3); SBAR();
    qkt<QREG, false>(pA0, pA1, K_lds, R_lds, qr, ql, r32, hi);
    finishSM(pB0, pB1, alB, l_reg, pa0, pa1, pa2, pa3); SBAR();
    KWRITE5(1); VLOAD5(t + 3); SBAR();
    pv_d0<false>(o, vb0 + (int)SHM_V, pa0, pa1, pa2, pa3); partialSM(pA0, pA1, m_reg, mnA, alA);
    RESC5(alA);
    __syncthreads();
  }
  SBAR(); VWRITE5(1); SBAR();
  qkt<QREG, false>(pB0, pB1, K_lds + SHM_KN, R_lds + SHM_KR, qr, ql, r32, hi);
  finishSM(pA0, pA1, alA, l_reg, pa0, pa1, pa2, pa3); SBAR();
  pv_d0<false>(o, vb0, pa0, pa1, pa2, pa3); partialSM(pB0, pB1, m_reg, mnB, alB);
  RESC5(alB);
  __syncthreads();
  finishSM(pB0, pB1, alB, l_reg, pa0, pa1, pa2, pa3); SBAR();
  pv_d0<false>(o, vb0 + (int)SHM_V, pa0, pa1, pa2, pa3);
  SBAR(); asm volatile("" ::: "memory");
  u32x4 gt[8]; const int grow = lane >> 4, gc16 = lane & 15;
  bf16_t* Gw = Gm + (size_t)(wid * QBLK + grow) * DM + gc16 * 8;
#pragma unroll
  for (int i = 0; i < 8; ++i) gt[i] = __builtin_nontemporal_load((const u32x4*)(Gw + (size_t)(4 * i) * DM));
  if (hi == 0) li_l[r32] = l_reg;
  __syncthreads();
  char* ot = lds + OFF_OT + wid * (32 * OT_PITCH);
#pragma unroll
  for (int r = 0; r < 16; ++r) { const float rl = __builtin_amdgcn_rcpf(li_l[crow(r, hi)]); char* orow = ot + crow(r, hi) * OT_PITCH + r32 * 2;
#pragma unroll
    for (int d0 = 0; d0 < 4; ++d0) *(bf16_t*)(orow + d0 * 64) = f2bf(o[d0][r] * rl); }
  asm volatile("s_waitcnt lgkmcnt(0)" ::: "memory");
#pragma unroll
  for (int i = 0; i < 8; ++i) { const u32x4 ov = *(const u32x4*)(ot + (grow + 4 * i) * OT_PITCH + gc16 * 16); const u32x4 gv = gt[i]; u32x4 w;
#pragma unroll
    for (int e = 0; e < 4; ++e) { const float g0_ = __uint_as_float(gv[e] << 16), g1_ = __uint_as_float(gv[e] & 0xffff0000u); const float a0 = __uint_as_float(ov[e] << 16) * (GATE_IN_EPI ? g0_ : silu_f(g0_)), a1 = __uint_as_float(ov[e] & 0xffff0000u) * (GATE_IN_EPI ? g1_ : silu_f(g1_)); w[e] = cvt_pk_bf16(a0, a1); }
    *(u32x4*)(Gw + (size_t)(4 * i) * DM) = w; }
#undef TCL
#undef KLOAD5
#undef VLOAD5
#undef KWRITE5
#undef VWRITE5
#undef RESC5
}

#ifndef ATT3_QLDS
#define ATT3_QLDS 0
#endif
constexpr int Q3LDS = ATT3_QLDS, Q3REG = 12 - Q3LDS;
constexpr int O3_V = 0, O3_KN = 3 * SHM_V, O3_KR = O3_KN + 3 * SHM_KN, O3_WS = O3_KR + 3 * SHM_KR, O3_QL = O3_WS + NW * 64 * 4, SHM_ATTN3 = O3_QL + NW * Q3LDS * 1024;
static_assert(SHM_ATTN3 <= RING_BYTES && NW * 32 * OT_PITCH <= O3_WS, "attention (DMA variant) LDS must fit the phase scratch");
__device__ __forceinline__ void attn_body3(const bf16_t* __restrict__ Qb, const bf16_t* __restrict__ Kn, const bf16_t* __restrict__ Kr,
                                           bf16_t* __restrict__ Gm, int seq, char* lds, LAS unsigned char* ldsL, int tid) {
  const int wid = __builtin_amdgcn_readfirstlane(tid >> 6), lane = tid & 63, r32 = lane & 31, hi = lane >> 5;
  float* ws = (float*)(lds + O3_WS) + wid * 64; float* li_l = ws; float* al_l = ws + 32;
  float m_reg = -1e30f, l_reg = 0; f32x16 o[4] = {}; bf16x8 qr[Q3REG > 0 ? Q3REG : 1];
  char* ql = lds + O3_QL + wid * (Q3LDS * 1024) + lane * 16;
  unsigned vo[2], ko[2], ro;
#pragma unroll
  for (int u = 0; u < 2; ++u) { const int t = 2 * wid + u;
    { const int s = 2 * t + (lane >> 5), kk = (s >> 2) * 8 + ((lane & 31) >> 2), k = (kk & ~0xC) | ((kk & 4) << 1) | ((kk & 8) >> 1), c = (s & 3) * 32 + (lane & 3) * 8; vo[u] = (unsigned)(k * NKV + 128 + c) * 2u; }
    { const int row = 4 * t + (lane >> 4), c = (lane & 15) ^ (row & 15); ko[u] = (unsigned)(row * NKV) * 2u + (unsigned)c * 16u; } }
  { const int row = 8 * wid + (lane >> 3), ch = (lane & 7) ^ ((row >> 1) & 7); ro = (unsigned)row * 128u + (unsigned)ch * 16u; }
#define DMA3(k0, b) do { const char* kb_ = (const char*)(Kn + (long)(k0) * NKV); const char* rb_ = (const char*)(Kr + (long)(k0) * 64); \
    __builtin_amdgcn_global_load_lds((const unsigned*)(kb_ + vo[0]), (LAS unsigned*)(ldsL + O3_V + (b) * SHM_V + (2 * wid) * 1024), 16, 0, 0); \
    __builtin_amdgcn_global_load_lds((const unsigned*)(kb_ + vo[1]), (LAS unsigned*)(ldsL + O3_V + (b) * SHM_V + (2 * wid + 1) * 1024), 16, 0, 0); \
    __builtin_amdgcn_global_load_lds((const unsigned*)(kb_ + ko[0]), (LAS unsigned*)(ldsL + O3_KN + (b) * SHM_KN + (2 * wid) * 1024), 16, 0, 0); \
    __builtin_amdgcn_global_load_lds((const unsigned*)(kb_ + ko[1]), (LAS unsigned*)(ldsL + O3_KN + (b) * SHM_KN + (2 * wid + 1) * 1024), 16, 0, 0); \
    __builtin_amdgcn_global_load_lds((const unsigned*)(rb_ + ro), (LAS unsigned*)(ldsL + O3_KR + (b) * SHM_KR + wid * 1024), 16, 0, 0); } while (0)
#define LANDED() do { asm volatile("s_waitcnt vmcnt(0)" ::: "memory"); __syncthreads(); } while (0)
#define RESC(a) do { if (__any((a) < 1.f)) { if (hi == 0) al_l[r32] = (a); asm volatile("s_waitcnt lgkmcnt(0)" ::: "memory"); \
    for (int d = 0; d < 4; ++d) for (int r = 0; r < 16; ++r) o[d][r] *= al_l[crow(r, hi)]; } } while (0)
#define KNB(b) (lds + O3_KN + (b) * SHM_KN)
#define KRB(b) (lds + O3_KR + (b) * SHM_KR)
  DMA3(0, 0);
  const unsigned qoff = (unsigned)((wid * QBLK + r32) * NQ + hi * 8) * 2u;
#pragma unroll
  for (int d0 = 0; d0 < 12; ++d0) { const bf16x8 qv = *(const bf16x8*)((const char*)Qb + qoff + d0 * 32); if (d0 < Q3REG) qr[d0 < Q3REG ? d0 : 0] = qv; else *reinterpret_cast<bf16x8*>(ql + (d0 - Q3REG) * 1024) = qv; }
  const int vb0 = (int)(uintptr_t)(lds + O3_V) + v_rd_base(lane);
  f32x16 pA0, pA1, pB0, pB1; float mnA, mnB, alA, alB; bf16x8 pa0, pa1, pa2, pa3; const int NT = seq / KVBLK;
  LANDED();
  DMA3(KVBLK, 1);
  qkt<Q3REG>(pA0, pA1, KNB(0), KRB(0), qr, ql, r32, hi); partialSM(pA0, pA1, m_reg, mnA, alA);
  LANDED();
  int bA = 0, bB = 1, bC = 2;
  for (int j = 1; j + 1 < NT; j += 2) {
    DMA3((j + 1) * KVBLK, bC);
    SBAR(); qkt<Q3REG>(pB0, pB1, KNB(bB), KRB(bB), qr, ql, r32, hi);
    finishSM(pA0, pA1, alA, l_reg, pa0, pa1, pa2, pa3); SBAR();
    pv_d0(o, vb0 + bA * SHM_V, pa0, pa1, pa2, pa3); partialSM(pB0, pB1, m_reg, mnB, alB);
    RESC(alB); LANDED();
    DMA3((j + 2) * KVBLK, bA);
    SBAR(); qkt<Q3REG>(pA0, pA1, KNB(bC), KRB(bC), qr, ql, r32, hi);
    finishSM(pB0, pB1, alB, l_reg, pa0, pa1, pa2, pa3); SBAR();
    pv_d0(o, vb0 + bB * SHM_V, pa0, pa1, pa2, pa3); partialSM(pA0, pA1, m_reg, mnA, alA);
    RESC(alA); LANDED();
    { const int t = bA; bA = bC; bC = bB; bB = t; }
  }
  SBAR(); qkt<Q3REG>(pB0, pB1, KNB(bB), KRB(bB), qr, ql, r32, hi);
  finishSM(pA0, pA1, alA, l_reg, pa0, pa1, pa2, pa3); SBAR();
  pv_d0(o, vb0 + bA * SHM_V, pa0, pa1, pa2, pa3); partialSM(pB0, pB1, m_reg, mnB, alB);
  RESC(alB);
  finishSM(pB0, pB1, alB, l_reg, pa0, pa1, pa2, pa3); SBAR();
  pv_d0(o, vb0 + bB * SHM_V, pa0, pa1, pa2, pa3);
  SBAR(); asm volatile("" ::: "memory");
  u32x4 gt[8]; const int grow = lane >> 4, gc16 = lane & 15;
  bf16_t* Gw = Gm + (size_t)(wid * QBLK + grow) * DM + gc16 * 8;
#pragma unroll
  for (int i = 0; i < 8; ++i) gt[i] = __builtin_nontemporal_load((const u32x4*)(Gw + (size_t)(4 * i) * DM));
  if (hi == 0) li_l[r32] = l_reg;
  __syncthreads();
  char* ot = lds + OFF_OT + wid * (32 * OT_PITCH);
#pragma unroll
  for (int r = 0; r < 16; ++r) { const float rl = __builtin_amdgcn_rcpf(li_l[crow(r, hi)]); char* orow = ot + crow(r, hi) * OT_PITCH + r32 * 2;
#pragma unroll
    for (int d0 = 0; d0 < 4; ++d0) *(bf16_t*)(orow + d0 * 64) = f2bf(o[d0][r] * rl); }
  asm volatile("s_waitcnt lgkmcnt(0)" ::: "memory");
#pragma unroll
  for (int i = 0; i < 8; ++i) { const u32x4 ov = *(const u32x4*)(ot + (grow + 4 * i) * OT_PITCH + gc16 * 16); const u32x4 gv = gt[i]; u32x4 w;
#pragma unroll
    for (int e = 0; e < 4; ++e) { const float g0_ = __uint_as_float(gv[e] << 16), g1_ = __uint_as_float(gv[e] & 0xffff0000u); const float a0 = __uint_as_float(ov[e] << 16) * (GATE_IN_EPI ? g0_ : silu_f(g0_)), a1 = __uint_as_float(ov[e] & 0xffff0000u) * (GATE_IN_EPI ? g1_ : silu_f(g1_)); w[e] = cvt_pk_bf16(a0, a1); }
    *(u32x4*)(Gw + (size_t)(4 * i) * DM) = w; }
#undef DMA3
#undef LANDED
#undef RESC
#undef KNB
#undef KRB
}

#ifndef ATT4_SMFIRST
#define ATT4_SMFIRST 1
#endif
#ifndef ATT4_QLDS
#define ATT4_QLDS 4
#endif
constexpr int Q4LDS = ATT4_QLDS, Q4REG = 12 - Q4LDS;
constexpr int O4_V = 0, O4_KN = 2 * SHM_V, O4_KR = O4_KN + 2 * SHM_KN, O4_WS = O4_KR + 2 * SHM_KR, O4_QL = O4_WS + NW * 64 * 4, SHM_ATTN4 = O4_QL + NW * Q4LDS * 1024;
static_assert(SHM_ATTN4 <= RING_BYTES && NW * 32 * OT_PITCH <= O4_WS, "attention (staggered variant) LDS must fit the phase scratch");
__device__ __forceinline__ void attn_body4(const bf16_t* __restrict__ Qb, const bf16_t* __restrict__ Kn, const bf16_t* __restrict__ Kr,
                                           bf16_t* __restrict__ Gm, int seq, char* lds, LAS unsigned char* ldsL, int tid) {
  const int wid = __builtin_amdgcn_readfirstlane(tid >> 6), lane = tid & 63, r32 = lane & 31, hi = lane >> 5;
  float* ws = (float*)(lds + O4_WS) + wid * 64; float* li_l = ws; float* al_l = ws + 32;
  float m_reg = -1e30f, l_reg = 0; f32x16 o[4] = {}; bf16x8 qr[Q4REG > 0 ? Q4REG : 1];
  char* ql = lds + O4_QL + wid * (Q4LDS * 1024) + lane * 16;
  unsigned vo[2], ko[2], ro;
#pragma unroll
  for (int u = 0; u < 2; ++u) { const int t = 2 * wid + u;
    { const int s = 2 * t + (lane >> 5), kk = (s >> 2) * 8 + ((lane & 31) >> 2), k = (kk & ~0xC) | ((kk & 4) << 1) | ((kk & 8) >> 1), c = (s & 3) * 32 + (lane & 3) * 8; vo[u] = (unsigned)(k * NKV + 128 + c) * 2u; }
    { const int row = 4 * t + (lane >> 4), c = (lane & 15) ^ (row & 15); ko[u] = (unsigned)(row * NKV) * 2u + (unsigned)c * 16u; } }
  { const int row = 8 * wid + (lane >> 3), ch = (lane & 7) ^ ((row >> 1) & 7); ro = (unsigned)row * 128u + (unsigned)ch * 16u; }
#define DMAK(k0, b) do { const char* kb_ = (const char*)(Kn + (long)(k0) * NKV); const char* rb_ = (const char*)(Kr + (long)(k0) * 64); \
    __builtin_amdgcn_global_load_lds((const unsigned*)(kb_ + ko[0]), (LAS unsigned*)(ldsL + O4_KN + (b) * SHM_KN + (2 * wid) * 1024), 16, 0, 0); \
    __builtin_amdgcn_global_load_lds((const unsigned*)(kb_ + ko[1]), (LAS unsigned*)(ldsL + O4_KN + (b) * SHM_KN + (2 * wid + 1) * 1024), 16, 0, 0); \
    __builtin_amdgcn_global_load_lds((const unsigned*)(rb_ + ro), (LAS unsigned*)(ldsL + O4_KR + (b) * SHM_KR + wid * 1024), 16, 0, 0); } while (0)
#define DMAV(k0, b) do { const char* kb_ = (const char*)(Kn + (long)(k0) * NKV); \
    __builtin_amdgcn_global_load_lds((const unsigned*)(kb_ + vo[0]), (LAS unsigned*)(ldsL + O4_V + (b) * SHM_V + (2 * wid) * 1024), 16, 0, 0); \
    __builtin_amdgcn_global_load_lds((const unsigned*)(kb_ + vo[1]), (LAS unsigned*)(ldsL + O4_V + (b) * SHM_V + (2 * wid + 1) * 1024), 16, 0, 0); } while (0)
#define SLOT_END() do { asm volatile("s_waitcnt vmcnt(0)" ::: "memory"); __syncthreads(); } while (0)
#define XBAR() do { asm volatile("s_waitcnt vmcnt(0) lgkmcnt(0)" ::: "memory"); __builtin_amdgcn_s_barrier(); asm volatile("" ::: "memory"); } while (0)
#define RESC(a) do { if (__any((a) < 1.f)) { if (hi == 0) al_l[r32] = (a); asm volatile("s_waitcnt lgkmcnt(0)" ::: "memory"); \
    for (int d = 0; d < 4; ++d) for (int r = 0; r < 16; ++r) o[d][r] *= al_l[crow(r, hi)]; } } while (0)
#if ATT4_SMFIRST
#define B4_ORDER(PV, SM) do { SM; SBAR(); PV; } while (0)
#else
#define B4_ORDER(PV, SM) do { PV; SM; } while (0)
#endif
#define KNB(b) (lds + O4_KN + (b) * SHM_KN)
#define KRB(b) (lds + O4_KR + (b) * SHM_KR)
  DMAK(0, 0);
  const unsigned qoff = (unsigned)((wid * QBLK + r32) * NQ + hi * 8) * 2u;
#pragma unroll
  for (int d0 = 0; d0 < 12; ++d0) { const bf16x8 qv = *(const bf16x8*)((const char*)Qb + qoff + d0 * 32); if (d0 < Q4REG) qr[d0 < Q4REG ? d0 : 0] = qv; else *reinterpret_cast<bf16x8*>(ql + (d0 - Q4REG) * 1024) = qv; }
  const int vb0 = (int)(uintptr_t)(lds + O4_V) + v_rd_base(lane);
  f32x16 pA0, pA1, pB0, pB1; float mnA, mnB, alA, alB; bf16x8 pa0, pa1, pa2, pa3; const int NT = seq / KVBLK;
  SLOT_END();
  if (wid >= 4) XBAR();
  DMAK(KVBLK, 1); qkt<Q4REG>(pA0, pA1, KNB(0), KRB(0), qr, ql, r32, hi); SLOT_END();
  DMAV(0, 0); partialSM(pA0, pA1, m_reg, mnA, alA); SLOT_END();
  for (int j = 1; j + 1 < NT; j += 2) {
    DMAK((j + 1) * KVBLK, 0); SBAR(); qkt<Q4REG>(pB0, pB1, KNB(1), KRB(1), qr, ql, r32, hi);
    finishSM(pA0, pA1, alA, l_reg, pa0, pa1, pa2, pa3); SLOT_END();
    DMAV(j * KVBLK, 1); SBAR(); B4_ORDER(pv_d0(o, vb0, pa0, pa1, pa2, pa3), partialSM(pB0, pB1, m_reg, mnB, alB));
    RESC(alB); SLOT_END();
    DMAK((j + 2) * KVBLK, 1); SBAR(); qkt<Q4REG>(pA0, pA1, KNB(0), KRB(0), qr, ql, r32, hi);
    finishSM(pB0, pB1, alB, l_reg, pa0, pa1, pa2, pa3); SLOT_END();
    DMAV((j + 1) * KVBLK, 0); SBAR(); B4_ORDER(pv_d0(o, vb0 + (int)SHM_V, pa0, pa1, pa2, pa3), partialSM(pA0, pA1, m_reg, mnA, alA));
    RESC(alA); SLOT_END();
  }
  SBAR(); qkt<Q4REG>(pB0, pB1, KNB(1), KRB(1), qr, ql, r32, hi);
  finishSM(pA0, pA1, alA, l_reg, pa0, pa1, pa2, pa3); SLOT_END();
  DMAV((NT - 1) * KVBLK, 1); SBAR(); B4_ORDER(pv_d0(o, vb0, pa0, pa1, pa2, pa3), partialSM(pB0, pB1, m_reg, mnB, alB));
  RESC(alB); SLOT_END();
  finishSM(pB0, pB1, alB, l_reg, pa0, pa1, pa2, pa3); SLOT_END();
  pv_d0(o, vb0 + (int)SHM_V, pa0, pa1, pa2, pa3);
  if (wid < 4) XBAR();
  SBAR(); asm volatile("" ::: "memory");
  u32x4 gt[8]; const int grow = lane >> 4, gc16 = lane & 15;
  bf16_t* Gw = Gm + (size_t)(wid * QBLK + grow) * DM + gc16 * 8;
#pragma unroll
  for (int i = 0; i < 8; ++i) gt[i] = __builtin_nontemporal_load((const u32x4*)(Gw + (size_t)(4 * i) * DM));
  if (hi == 0) li_l[r32] = l_reg;
  __syncthreads();
  char* ot = lds + OFF_OT + wid * (32 * OT_PITCH);
#pragma unroll
  for (int r = 0; r < 16; ++r) { const float rl = __builtin_amdgcn_rcpf(li_l[crow(r, hi)]); char* orow = ot + crow(r, hi) * OT_PITCH + r32 * 2;
#pragma unroll
    for (int d0 = 0; d0 < 4; ++d0) *(bf16_t*)(orow + d0 * 64) = f2bf(o[d0][r] * rl); }
  asm volatile("s_waitcnt lgkmcnt(0)" ::: "memory");
#pragma unroll
  for (int i = 0; i < 8; ++i) { const u32x4 ov = *(const u32x4*)(ot + (grow + 4 * i) * OT_PITCH + gc16 * 16); const u32x4 gv = gt[i]; u32x4 w;
#pragma unroll
    for (int e = 0; e < 4; ++e) { const float g0_ = __uint_as_float(gv[e] << 16), g1_ = __uint_as_float(gv[e] & 0xffff0000u); const float a0 = __uint_as_float(ov[e] << 16) * (GATE_IN_EPI ? g0_ : silu_f(g0_)), a1 = __uint_as_float(ov[e] & 0xffff0000u) * (GATE_IN_EPI ? g1_ : silu_f(g1_)); w[e] = cvt_pk_bf16(a0, a1); }
    *(u32x4*)(Gw + (size_t)(4 * i) * DM) = w; }
#undef DMAK
#undef DMAV
#undef SLOT_END
#undef XBAR
#undef RESC
#undef KNB
#undef KRB
}

#ifndef ATT_STAGR
#define ATT_STAGR 0
#endif
#ifndef ATT6_QLDS
#define ATT6_QLDS 6
#endif
constexpr int Q6LDS = ATT6_QLDS, Q6REG = 12 - Q6LDS;
constexpr int O6_QL = O4_WS + NW * 64 * 4, SHM_ATTN6 = O6_QL + NW * Q6LDS * 1024;
static_assert(SHM_ATTN6 <= RING_BYTES, "attention (staggered register-staged variant) LDS must fit the phase scratch");
__device__ __forceinline__ void attn_body6(const bf16_t* __restrict__ Qb, const bf16_t* __restrict__ Kn, const bf16_t* __restrict__ Kr,
                                           bf16_t* __restrict__ Gm, int seq, char* lds, LAS unsigned char* ldsL, int tid) {
  const int wid = __builtin_amdgcn_readfirstlane(tid >> 6), lane = tid & 63, r32 = lane & 31, hi = lane >> 5;
  float* ws = (float*)(lds + O4_WS) + wid * 64; float* li_l = ws; float* al_l = ws + 32;
  float m_reg = -1e30f, l_reg = 0; f32x16 o[4] = {}; bf16x8 qr[Q6REG > 0 ? Q6REG : 1];
  char* ql = lds + O6_QL + wid * (Q6LDS * 1024) + lane * 16;
  const int sr = tid >> 4, sc = (tid & 15) * 8, vst0 = v_st(sr, sc), vst1 = v_st(32 + sr, sc), rr_ = tid >> 3, rc_ = tid & 7;
  const unsigned voff = (unsigned)(sr * NKV + sc) * 2u, voffr = (unsigned)(rr_ * 64 + rc_ * 8) * 2u;
  bf16x8 sg0, sg1, sg2;
#define DMAK(k0, b) do { const char* kb_ = (const char*)(Kn + (long)(k0) * NKV); const char* rb_ = (const char*)(Kr + (long)(k0) * 64); \
    sg0 = *(const bf16x8*)(kb_ + voff); sg1 = *(const bf16x8*)(kb_ + 32 * NKV * 2 + voff); sg2 = *(const bf16x8*)(rb_ + voffr); } while (0)
#define WRK(b) do { const int kc = sc * 2; *(bf16x8*)(lds + O4_KN + (b) * SHM_KN + KSWZ(sr, kc)) = sg0; *(bf16x8*)(lds + O4_KN + (b) * SHM_KN + KSWZ(32 + sr, kc)) = sg1; \
    *(bf16x8*)(lds + O4_KR + (b) * SHM_KR + RSWZ(rr_, rc_)) = sg2; } while (0)
#define DMAV(k0, b) do { const char* kb_ = (const char*)(Kn + (long)(k0) * NKV); sg0 = *(const bf16x8*)(kb_ + 256 + voff); sg1 = *(const bf16x8*)(kb_ + (32 * NKV * 2 + 256) + voff); } while (0)
#define WRV(b) do { *(bf16x8*)(lds + O4_V + (b) * SHM_V + vst0) = sg0; *(bf16x8*)(lds + O4_V + (b) * SHM_V + vst1) = sg1; } while (0)
#define SLOT_END() do { asm volatile("s_waitcnt vmcnt(0)" ::: "memory"); __syncthreads(); } while (0)
#define XBAR() do { asm volatile("s_waitcnt vmcnt(0) lgkmcnt(0)" ::: "memory"); __builtin_amdgcn_s_barrier(); asm volatile("" ::: "memory"); } while (0)
#define RESC(a) do { if (__any((a) < 1.f)) { if (hi == 0) al_l[r32] = (a); asm volatile("s_waitcnt lgkmcnt(0)" ::: "memory"); \
    for (int d = 0; d < 4; ++d) for (int r = 0; r < 16; ++r) o[d][r] *= al_l[crow(r, hi)]; } } while (0)
#if ATT4_SMFIRST
#define B4_ORDER(PV, SM) do { SM; SBAR(); PV; } while (0)
#else
#define B4_ORDER(PV, SM) do { PV; SM; } while (0)
#endif
#define KNB(b) (lds + O4_KN + (b) * SHM_KN)
#define KRB(b) (lds + O4_KR + (b) * SHM_KR)
  DMAK(0, 0);
  const unsigned qoff = (unsigned)((wid * QBLK + r32) * NQ + hi * 8) * 2u;
#pragma unroll
  for (int d0 = 0; d0 < 12; ++d0) { const bf16x8 qv = *(const bf16x8*)((const char*)Qb + qoff + d0 * 32); if (d0 < Q6REG) qr[d0 < Q6REG ? d0 : 0] = qv; else *reinterpret_cast<bf16x8*>(ql + (d0 - Q6REG) * 1024) = qv; }
  const int vb0 = (int)(uintptr_t)(lds + O4_V) + v_rd_base(lane);
  f32x16 pA0, pA1, pB0, pB1; float mnA, mnB, alA, alB; bf16x8 pa0, pa1, pa2, pa3; const int NT = seq / KVBLK;
  WRK(0); SLOT_END();
  if (wid >= 4) XBAR();
  DMAK(KVBLK, 1); qkt<Q6REG>(pA0, pA1, KNB(0), KRB(0), qr, ql, r32, hi); WRK(1); SLOT_END();
  DMAV(0, 0); partialSM(pA0, pA1, m_reg, mnA, alA); WRV(0); SLOT_END();
  for (int j = 1; j + 1 < NT; j += 2) {
    DMAK((j + 1) * KVBLK, 0); SBAR(); qkt<Q6REG>(pB0, pB1, KNB(1), KRB(1), qr, ql, r32, hi);
    finishSM(pA0, pA1, alA, l_reg, pa0, pa1, pa2, pa3); WRK(0); SLOT_END();
    DMAV(j * KVBLK, 1); SBAR(); B4_ORDER(pv_d0(o, vb0, pa0, pa1, pa2, pa3), partialSM(pB0, pB1, m_reg, mnB, alB));
    RESC(alB); WRV(1); SLOT_END();
    DMAK((j + 2) * KVBLK, 1); SBAR(); qkt<Q6REG>(pA0, pA1, KNB(0), KRB(0), qr, ql, r32, hi);
    finishSM(pB0, pB1, alB, l_reg, pa0, pa1, pa2, pa3); WRK(1); SLOT_END();
    DMAV((j + 1) * KVBLK, 0); SBAR(); B4_ORDER(pv_d0(o, vb0 + (int)SHM_V, pa0, pa1, pa2, pa3), partialSM(pA0, pA1, m_reg, mnA, alA));
    RESC(alA); WRV(0); SLOT_END();
  }
  SBAR(); qkt<Q6REG>(pB0, pB1, KNB(1), KRB(1), qr, ql, r32, hi);
  finishSM(pA0, pA1, alA, l_reg, pa0, pa1, pa2, pa3); SLOT_END();
  DMAV((NT - 1) * KVBLK, 1); SBAR(); B4_ORDER(pv_d0(o, vb0, pa0, pa1, pa2, pa3), partialSM(pB0, pB1, m_reg, mnB, alB));
  RESC(alB); WRV(1); SLOT_END();
  finishSM(pB0, pB1, alB, l_reg, pa0, pa1, pa2, pa3); SLOT_END();
  pv_d0(o, vb0 + (int)SHM_V, pa0, pa1, pa2, pa3);
  if (wid < 4) XBAR();
  SBAR(); asm volatile("" ::: "memory");
  u32x4 gt[8]; const int grow = lane >> 4, gc16 = lane & 15;
  bf16_t* Gw = Gm + (size_t)(wid * QBLK + grow) * DM + gc16 * 8;
#pragma unroll
  for (int i = 0; i < 8; ++i) gt[i] = __builtin_nontemporal_load((const u32x4*)(Gw + (size_t)(4 * i) * DM));
  if (hi == 0) li_l[r32] = l_reg;
  __syncthreads();
  char* ot = lds + OFF_OT + wid * (32 * OT_PITCH);
#pragma unroll
  for (int r = 0; r < 16; ++r) { const float rl = __builtin_amdgcn_rcpf(li_l[crow(r, hi)]); char* orow = ot + crow(r, hi) * OT_PITCH + r32 * 2;
#pragma unroll
    for (int d0 = 0; d0 < 4; ++d0) *(bf16_t*)(orow + d0 * 64) = f2bf(o[d0][r] * rl); }
  asm volatile("s_waitcnt lgkmcnt(0)" ::: "memory");
#pragma unroll
  for (int i = 0; i < 8; ++i) { const u32x4 ov = *(const u32x4*)(ot + (grow + 4 * i) * OT_PITCH + gc16 * 16); const u32x4 gv = gt[i]; u32x4 w;
#pragma unroll
    for (int e = 0; e < 4; ++e) { const float g0_ = __uint_as_float(gv[e] << 16), g1_ = __uint_as_float(gv[e] & 0xffff0000u); const float a0 = __uint_as_float(ov[e] << 16) * (GATE_IN_EPI ? g0_ : silu_f(g0_)), a1 = __uint_as_float(ov[e] & 0xffff0000u) * (GATE_IN_EPI ? g1_ : silu_f(g1_)); w[e] = cvt_pk_bf16(a0, a1); }
    *(u32x4*)(Gw + (size_t)(4 * i) * DM) = w; }
#undef WRK
#undef WRV
#undef DMAK
#undef DMAV
#undef SLOT_END
#undef XBAR
#undef RESC
#undef KNB
#undef KRB
}
}

namespace att16 {
using att::tr_read; using att::ld8;
constexpr int NW = 8, QBLK = 32, KVBLK = 64;
constexpr float THR = 8.f;
#ifndef ATT16_QLDS
#define ATT16_QLDS 8
#endif
constexpr int QLDS = ATT16_QLDS, QREG = 12 - QLDS;
constexpr int SHM_V = KVBLK * 128 * 2, SHM_KN = KVBLK * 128 * 2, SHM_KR = KVBLK * 64 * 2;
constexpr int OFF_V = 0, OFF_KN = 2 * SHM_V, OFF_KR = OFF_KN + 2 * SHM_KN, OFF_WS = OFF_KR + 2 * SHM_KR, OFF_QL = OFF_WS + NW * 64 * 4, OT_PITCH = 272, SHM_ATTN = OFF_QL + NW * QLDS * 1024;
static_assert(SHM_ATTN <= RING_BYTES && NW * 32 * OT_PITCH <= OFF_WS, "attention (16x16 variant) LDS must fit the phase scratch");
__device__ __forceinline__ int v_st(int k, int c) { return ((k >> 3) * 8 + (c >> 4)) * 256 + (k & 7) * 32 + (c & 15) * 2; }
__device__ __forceinline__ int v_rd_base(int lane) { const int g = lane >> 4, c = lane & 15; return (g >> 1) * 2048 + (g & 1) * 128 + (c >> 2) * 32 + (c & 3) * 8; }
constexpr int v_rd_off(int db, int s, int h) { return s * 8192 + h * 4096 + db * 256; }
__device__ __forceinline__ float xmax4(float x) {
  { auto r = __builtin_amdgcn_permlane16_swap(__float_as_uint(x), __float_as_uint(x), false, false); x = fmaxf(__uint_as_float(r[0]), __uint_as_float(r[1])); }
  { auto r = __builtin_amdgcn_permlane32_swap(__float_as_uint(x), __float_as_uint(x), false, false); x = fmaxf(__uint_as_float(r[0]), __uint_as_float(r[1])); }
  return x; }
__device__ __forceinline__ float xsum4(float x) {
  { auto r = __builtin_amdgcn_permlane16_swap(__float_as_uint(x), __float_as_uint(x), false, false); x = __uint_as_float(r[0]) + __uint_as_float(r[1]); }
  { auto r = __builtin_amdgcn_permlane32_swap(__float_as_uint(x), __float_as_uint(x), false, false); x = __uint_as_float(r[0]) + __uint_as_float(r[1]); }
  return x; }
typedef f32x4 PT[2][4];
__device__ __forceinline__ void partialSM(PT& p, float (&m_reg)[2], float (&mn)[2], float (&alpha)[2]) {
  constexpr float C = ATT_SCALE * 1.4426950408889634f;
  float pm[2];
#pragma unroll
  for (int qb = 0; qb < 2; ++qb) { float x = p[qb][0][0];
#pragma unroll
    for (int kb = 0; kb < 4; ++kb)
#pragma unroll
      for (int r = 0; r < 4; ++r) x = fmaxf(x, p[qb][kb][r]);
    pm[qb] = xmax4(x); }
  if (__builtin_expect(__all((pm[0] - m_reg[0] <= THR / ATT_SCALE) && (pm[1] - m_reg[1] <= THR / ATT_SCALE)), 1)) { mn[0] = m_reg[0]; mn[1] = m_reg[1]; alpha[0] = 1.f; alpha[1] = 1.f; }
  else {
#pragma unroll
    for (int qb = 0; qb < 2; ++qb) { mn[qb] = fmaxf(m_reg[qb], pm[qb]); alpha[qb] = __builtin_amdgcn_exp2f((m_reg[qb] - mn[qb]) * C); m_reg[qb] = mn[qb]; } }
#pragma unroll
  for (int qb = 0; qb < 2; ++qb) { const float mnC = -mn[qb] * C;
#pragma unroll
    for (int kb = 0; kb < 4; ++kb)
#pragma unroll
      for (int r = 0; r < 4; ++r) p[qb][kb][r] = fmaf(p[qb][kb][r], C, mnC); }
#pragma unroll
  for (int qb = 0; qb < 2; ++qb)
#pragma unroll
    for (int kb = 0; kb < 2; ++kb)
#pragma unroll
      for (int r = 0; r < 4; ++r) p[qb][kb][r] = __builtin_amdgcn_exp2f(p[qb][kb][r]);
}
__device__ __forceinline__ bf16x8 pack8(f32x4 a, f32x4 b) { u32x4 w = {cvt_pk_bf16(a[0], a[1]), cvt_pk_bf16(a[2], a[3]), cvt_pk_bf16(b[0], b[1]), cvt_pk_bf16(b[2], b[3])}; return __builtin_bit_cast(bf16x8, w); }
__device__ __forceinline__ void finishSM(PT& p, const float (&alpha)[2], float (&l_reg)[2], bf16x8 (&pa)[2][2]) {
#pragma unroll
  for (int qb = 0; qb < 2; ++qb)
#pragma unroll
    for (int kb = 2; kb < 4; ++kb)
#pragma unroll
      for (int r = 0; r < 4; ++r) p[qb][kb][r] = __builtin_amdgcn_exp2f(p[qb][kb][r]);
#pragma unroll
  for (int qb = 0; qb < 2; ++qb) { float ps = 0.f;
#pragma unroll
    for (int kb = 0; kb < 4; ++kb) ps += (p[qb][kb][0] + p[qb][kb][1]) + (p[qb][kb][2] + p[qb][kb][3]);
    l_reg[qb] = l_reg[qb] * alpha[qb] + xsum4(ps);
    pa[qb][0] = pack8(p[qb][0], p[qb][1]); pa[qb][1] = pack8(p[qb][2], p[qb][3]); }
}
__device__ __forceinline__ bf16x8 kfrag(const char* Kn, const char* Kr, int i, int c, int g) {
  const int ks = i >> 2, kb = i & 3, row = 16 * kb + c;
  if (ks < 4) return *reinterpret_cast<const bf16x8*>(Kn + KSWZ(row, (4 * ks + g) * 16));
  return *reinterpret_cast<const bf16x8*>(Kr + RSWZ(row, 4 * (ks - 4) + g));
}
__device__ __forceinline__ bf16x8 qsel(const bf16x8* qr, const char* ql, int f) { return f < QREG ? qr[f < QREG ? f : 0] : *reinterpret_cast<const bf16x8*>(ql + (f - QREG) * 1024); }
__device__ __forceinline__ void qkt(PT& p, const char* Kn, const char* Kr, const bf16x8* qr, const char* ql, int c, int g) {
#pragma unroll
  for (int qb = 0; qb < 2; ++qb)
#pragma unroll
    for (int kb = 0; kb < 4; ++kb) p[qb][kb] = (f32x4){0.f, 0.f, 0.f, 0.f};
  bf16x8 ka = kfrag(Kn, Kr, 0, c, g), kb_ = kfrag(Kn, Kr, 1, c, g), na, nb, q0 = qsel(qr, ql, 0), q1 = qsel(qr, ql, 6), q0n, q1n;
#pragma unroll
  for (int i = 0; i < 12; ++i) { const int ks = i >> 1, k2 = (i & 1) * 2;
    if (i + 1 < 12) { na = kfrag(Kn, Kr, 2 * i + 2, c, g); nb = kfrag(Kn, Kr, 2 * i + 3, c, g); }
    if ((i & 1) == 0 && ks + 1 < 6) { q0n = qsel(qr, ql, ks + 1); q1n = qsel(qr, ql, 6 + ks + 1); }
    SBAR();
    p[0][k2] = __builtin_amdgcn_mfma_f32_16x16x32_bf16(ka, q0, p[0][k2], 0, 0, 0);
    p[1][k2] = __builtin_amdgcn_mfma_f32_16x16x32_bf16(ka, q1, p[1][k2], 0, 0, 0);
    p[0][k2 + 1] = __builtin_amdgcn_mfma_f32_16x16x32_bf16(kb_, q0, p[0][k2 + 1], 0, 0, 0);
    p[1][k2 + 1] = __builtin_amdgcn_mfma_f32_16x16x32_bf16(kb_, q1, p[1][k2 + 1], 0, 0, 0);
    SBAR();
    ka = na; kb_ = nb; if (i & 1) { q0 = q0n; q1 = q1n; } }
}
#define TRPK16(L, H) (bf16x8){L[0], L[1], L[2], L[3], H[0], H[1], H[2], H[3]}
template <int DB> __device__ __forceinline__ void pv_two(f32x4& o00, f32x4& o10, f32x4& o01, f32x4& o11, int vb, const bf16x8 (&pa)[2][2]) {
  const s16x4 l0 = tr_read<v_rd_off(DB, 0, 0)>(vb), h0 = tr_read<v_rd_off(DB, 0, 1)>(vb), l1 = tr_read<v_rd_off(DB, 1, 0)>(vb), h1 = tr_read<v_rd_off(DB, 1, 1)>(vb);
  const s16x4 l2 = tr_read<v_rd_off(DB + 1, 0, 0)>(vb), h2 = tr_read<v_rd_off(DB + 1, 0, 1)>(vb), l3 = tr_read<v_rd_off(DB + 1, 1, 0)>(vb), h3 = tr_read<v_rd_off(DB + 1, 1, 1)>(vb);
  asm volatile("s_waitcnt lgkmcnt(0)" ::: "memory"); SBAR();
  o00 = __builtin_amdgcn_mfma_f32_16x16x32_bf16(pa[0][0], TRPK16(l0, h0), o00, 0, 0, 0);
  o10 = __builtin_amdgcn_mfma_f32_16x16x32_bf16(pa[1][0], TRPK16(l0, h0), o10, 0, 0, 0);
  o01 = __builtin_amdgcn_mfma_f32_16x16x32_bf16(pa[0][0], TRPK16(l2, h2), o01, 0, 0, 0);
  o11 = __builtin_amdgcn_mfma_f32_16x16x32_bf16(pa[1][0], TRPK16(l2, h2), o11, 0, 0, 0);
  o00 = __builtin_amdgcn_mfma_f32_16x16x32_bf16(pa[0][1], TRPK16(l1, h1), o00, 0, 0, 0);
  o10 = __builtin_amdgcn_mfma_f32_16x16x32_bf16(pa[1][1], TRPK16(l1, h1), o10, 0, 0, 0);
  o01 = __builtin_amdgcn_mfma_f32_16x16x32_bf16(pa[0][1], TRPK16(l3, h3), o01, 0, 0, 0);
  o11 = __builtin_amdgcn_mfma_f32_16x16x32_bf16(pa[1][1], TRPK16(l3, h3), o11, 0, 0, 0);
}
typedef f32x4 OT_[2][8];
__device__ __forceinline__ void pv_all(OT_& o, int vb, const bf16x8 (&pa)[2][2]) {
  pv_two<0>(o[0][0], o[1][0], o[0][1], o[1][1], vb, pa); pv_two<2>(o[0][2], o[1][2], o[0][3], o[1][3], vb, pa);
  pv_two<4>(o[0][4], o[1][4], o[0][5], o[1][5], vb, pa); pv_two<6>(o[0][6], o[1][6], o[0][7], o[1][7], vb, pa);
}
template <int VAR>
__device__ __forceinline__ void attn_body(const bf16_t* __restrict__ Qb, const bf16_t* __restrict__ Kn, const bf16_t* __restrict__ Kr,
                                          bf16_t* __restrict__ Gm, int seq, char* lds, int tid) {
  const int wid = tid >> 6, lane = tid & 63, c = lane & 15, g = lane >> 4;
  char* V_lds = lds + OFF_V; char* K_lds = lds + OFF_KN; char* R_lds = lds + OFF_KR;
  float* ws = (float*)(lds + OFF_WS) + wid * 64; float* li_l = ws; float* al_l = ws + 32;
  float m_reg[2] = {-1e30f, -1e30f}, l_reg[2] = {0.f, 0.f}; OT_ o;
#pragma unroll
  for (int qb = 0; qb < 2; ++qb)
#pragma unroll
    for (int db = 0; db < 8; ++db) o[qb][db] = (f32x4){0.f, 0.f, 0.f, 0.f};
  bf16x8 qr[QREG > 0 ? QREG : 1];
  char* ql = lds + OFF_QL + wid * (QLDS * 1024) + lane * 16;
#pragma unroll
  for (int f = 0; f < 12; ++f) { const int qb = f / 6, ks = f - qb * 6;
    const bf16x8 qv = *(const bf16x8*)((const char*)Qb + (unsigned)((wid * QBLK + 16 * qb + c) * NQ + 32 * ks + 8 * g) * 2u);
    if (f < QREG) qr[f < QREG ? f : 0] = qv; else *reinterpret_cast<bf16x8*>(ql + (f - QREG) * 1024) = qv; }
  const int sr = tid >> 4, sc = (tid & 15) * 8, vst0 = v_st(sr, sc), vst1 = v_st(32 + sr, sc);
  const int rr_ = tid >> 3, rc_ = tid & 7;
  const int vb0 = (int)(uintptr_t)V_lds + v_rd_base(lane);
  struct { bf16x8 vs0, vs1, ks0, ks1, kr; } sr_;
  const unsigned voff = (unsigned)(sr * NKV + sc) * 2u, voffr = (unsigned)(rr_ * 64 + rc_ * 8) * 2u;
#define SLOAD(k0) do { const char* kb_ = (const char*)(Kn + (long)(k0) * NKV); const char* rb_ = (const char*)(Kr + (long)(k0) * 64); \
    sr_.vs0 = *(const bf16x8*)(kb_ + 256 + voff); sr_.vs1 = *(const bf16x8*)(kb_ + (32 * NKV * 2 + 256) + voff); \
    sr_.ks0 = *(const bf16x8*)(kb_ + voff); sr_.ks1 = *(const bf16x8*)(kb_ + 32 * NKV * 2 + voff); \
    sr_.kr = *(const bf16x8*)(rb_ + voffr); } while (0)
#define SWRITE(b) do { *(bf16x8*)(V_lds + (b) * SHM_V + vst0) = sr_.vs0; *(bf16x8*)(V_lds + (b) * SHM_V + vst1) = sr_.vs1; const int kc_ = sc * 2; \
    *(bf16x8*)(K_lds + (b) * SHM_KN + KSWZ(sr, kc_)) = sr_.ks0; *(bf16x8*)(K_lds + (b) * SHM_KN + KSWZ(32 + sr, kc_)) = sr_.ks1; \
    *(bf16x8*)(R_lds + (b) * SHM_KR + RSWZ(rr_, rc_)) = sr_.kr; } while (0)
#define SWAIT() asm volatile("s_waitcnt vmcnt(0)" ::: "memory")
#define RESC(a) do { if (__any(((a)[0] < 1.f) || ((a)[1] < 1.f))) { if (g == 0) { al_l[c] = (a)[0]; al_l[16 + c] = (a)[1]; } asm volatile("s_waitcnt lgkmcnt(0)" ::: "memory"); \
    _Pragma("unroll") for (int qb = 0; qb < 2; ++qb) { const f32x4 av = *(const f32x4*)(al_l + 16 * qb + 4 * g); _Pragma("unroll") for (int db = 0; db < 8; ++db) o[qb][db] *= av; } } } while (0)
  PT pA, pB; float mnA[2], mnB[2], alA[2], alB[2]; bf16x8 pa[2][2]; const int NT = seq / KVBLK;
#define QKT(P, KN, KR) do { if constexpr (VAR == 3) { _Pragma("unroll") for (int qb_ = 0; qb_ < 2; ++qb_) _Pragma("unroll") for (int kb_ = 0; kb_ < 4; ++kb_) P[qb_][kb_] = o[qb_][kb_]; } else qkt(P, KN, KR, qr, ql, c, g); } while (0)
#define PSM(P, MN, AL) do { if constexpr (VAR == 1) { MN[0] = m_reg[0]; MN[1] = m_reg[1]; AL[0] = 1.f; AL[1] = 1.f; } else partialSM(P, m_reg, MN, AL); } while (0)
#define FSM(P, AL) do { if constexpr (VAR == 1) { pa[0][0] = __builtin_bit_cast(bf16x8, P[0][0]); pa[0][1] = __builtin_bit_cast(bf16x8, P[0][1]); pa[1][0] = __builtin_bit_cast(bf16x8, P[1][0]); pa[1][1] = __builtin_bit_cast(bf16x8, P[1][1]); l_reg[0] += P[0][2][0]; l_reg[1] += P[1][3][1]; } \
    else finishSM(P, AL, l_reg, pa); } while (0)
#define PVD(VB) do { if constexpr (VAR == 2) { o[0][0] += __builtin_bit_cast(f32x4, pa[0][0]); o[1][1] += __builtin_bit_cast(f32x4, pa[1][1]); o[0][2] += __builtin_bit_cast(f32x4, pa[0][1]); o[1][3] += __builtin_bit_cast(f32x4, pa[1][0]); } else pv_all(o, VB, pa); } while (0)
  SLOAD(0); SWAIT(); SWRITE(0); __syncthreads();
  QKT(pA, K_lds, R_lds); PSM(pA, mnA, alA);
  SLOAD(KVBLK); SWAIT(); SWRITE(1); __syncthreads();
  for (int j = 1; j + 1 < NT; j += 2) {
    SBAR(); QKT(pB, K_lds + SHM_KN, R_lds + SHM_KR);
    FSM(pA, alA); SBAR();
    SLOAD((j + 1) * KVBLK); SBAR();
    PVD(vb0); PSM(pB, mnB, alB);
    __syncthreads(); SWAIT(); SWRITE(0);
    RESC(alB); __syncthreads();
    SBAR(); QKT(pA, K_lds, R_lds);
    FSM(pB, alB); SBAR();
    SLOAD((j + 2) * KVBLK); SBAR();
    PVD(vb0 + (int)SHM_V); PSM(pA, mnA, alA);
    __syncthreads(); SWAIT(); SWRITE(1);
    RESC(alA); __syncthreads();
  }
  SBAR(); QKT(pB, K_lds + SHM_KN, R_lds + SHM_KR);
  FSM(pA, alA); SBAR();
  PVD(vb0); PSM(pB, mnB, alB);
  __syncthreads(); RESC(alB);
  FSM(pB, alB); SBAR();
  PVD(vb0 + (int)SHM_V);
  SBAR(); asm volatile("" ::: "memory");
  u32x4 gt[8]; const int grow = lane >> 4, gc16 = lane & 15;
  bf16_t* Gw = Gm + (size_t)(wid * QBLK + grow) * DM + gc16 * 8;
#pragma unroll
  for (int i = 0; i < 8; ++i) gt[i] = __builtin_nontemporal_load((const u32x4*)(Gw + (size_t)(4 * i) * DM));
  if (g == 0) { li_l[c] = l_reg[0]; li_l[16 + c] = l_reg[1]; }
  __syncthreads();
  char* ot = lds + wid * (32 * OT_PITCH);
#pragma unroll
  for (int qb = 0; qb < 2; ++qb) { const f32x4 lv = *(const f32x4*)(li_l + 16 * qb + 4 * g);
#pragma unroll
    for (int r = 0; r < 4; ++r) { const float rl = __builtin_amdgcn_rcpf(lv[r]); char* orow = ot + (16 * qb + 4 * g + r) * OT_PITCH + c * 2;
#pragma unroll
      for (int db = 0; db < 8; ++db) *(bf16_t*)(orow + db * 32) = f2bf(o[qb][db][r] * rl); } }
  asm volatile("s_waitcnt lgkmcnt(0)" ::: "memory");
#pragma unroll
  for (int i = 0; i < 8; ++i) { const u32x4 ov = *(const u32x4*)(ot + (grow + 4 * i) * OT_PITCH + gc16 * 16); const u32x4 gv = gt[i]; u32x4 w;
#pragma unroll
    for (int e = 0; e < 4; ++e) { const float g0_ = __uint_as_float(gv[e] << 16), g1_ = __uint_as_float(gv[e] & 0xffff0000u); const float a0 = __uint_as_float(ov[e] << 16) * (GATE_IN_EPI ? g0_ : silu_f(g0_)), a1 = __uint_as_float(ov[e] & 0xffff0000u) * (GATE_IN_EPI ? g1_ : silu_f(g1_)); w[e] = cvt_pk_bf16(a0, a1); }
    *(u32x4*)(Gw + (size_t)(4 * i) * DM) = w; }
#undef SLOAD
#undef QKT
#undef PSM
#undef FSM
#undef PVD
#undef SWRITE
#undef SWAIT
#undef RESC
}
}
namespace atth {
using att::tr_read; using att::crow; using att::partialSM; using att::kfrag; using att::qfrag;
constexpr int NW = 8, QBLK = 32, KVBLK = 64;
#ifndef ATTH_QLDS
#define ATTH_QLDS 6
#endif
constexpr int QLDS = ATTH_QLDS, QREG = 12 - QLDS;
constexpr int SHM_V = KVBLK * 128 * 2, SHM_KN = KVBLK * 128 * 2, SHM_KR = KVBLK * 64 * 2;
constexpr int OFF_V = 0, OFF_KN = 2 * SHM_V, OFF_KR = OFF_KN + 2 * SHM_KN, OFF_WS = OFF_KR + 2 * SHM_KR, OFF_QL = OFF_WS + NW * 64 * 4, OT_PITCH = 272, SHM_ATTN = OFF_QL + NW * QLDS * 1024;
static_assert(SHM_ATTN <= RING_BYTES && NW * 32 * OT_PITCH <= OFF_WS, "attention (hybrid variant) LDS must fit the phase scratch");
__device__ __forceinline__ int v_st(int k, int c) { const int kp = (k & ~0x14) | ((k & 4) << 2) | ((k & 16) >> 2); return (c >> 4) * 2048 + kp * 32 + (c & 15) * 2; }
__device__ __forceinline__ int v_rd_base(int lane) { const int g = lane >> 4, c = lane & 15; return (g >> 1) * 512 + (g & 1) * 128 + (c >> 2) * 32 + (c & 3) * 8; }
constexpr int v_rd_off(int db, int s, int h) { return db * 2048 + s * 1024 + h * 256; }
__device__ __forceinline__ void finishSM(f32x16& p0, f32x16& p1, float alpha, float& l_reg, bf16x8 (&pa)[2][2]) {
  for (int r = 0; r < 16; ++r) p1[r] = __builtin_amdgcn_exp2f(p1[r]);
  float ps = 0; for (int r = 0; r < 16; ++r) ps += p0[r]; for (int r = 0; r < 16; ++r) ps += p1[r];
  { auto rr = __builtin_amdgcn_permlane32_swap(__float_as_uint(ps), __float_as_uint(ps), false, false);
    ps = __uint_as_float(rr[0]) + __uint_as_float(rr[1]); }
  l_reg = l_reg * alpha + ps;
#define RELAY(P, S) do { u32x4 wa, wb; \
    _Pragma("unroll") for (int i = 0; i < 4; ++i) { const unsigned a_ = cvt_pk_bf16(P[2 * i], P[2 * i + 1]), b_ = cvt_pk_bf16(P[8 + 2 * i], P[8 + 2 * i + 1]); \
      auto r_ = __builtin_amdgcn_permlane16_swap(a_, b_, false, false); wa[i] = r_[0]; wb[i] = r_[1]; } \
    pa[0][S] = __builtin_bit_cast(bf16x8, wa); pa[1][S] = __builtin_bit_cast(bf16x8, wb); } while (0)
  RELAY(p0, 0); RELAY(p1, 1);
#undef RELAY
}
#define TRPKH(L, H) (bf16x8){L[0], L[1], L[2], L[3], H[0], H[1], H[2], H[3]}
template <int DB> __device__ __forceinline__ void pv_two(f32x4& o00, f32x4& o10, f32x4& o01, f32x4& o11, int vb, const bf16x8 (&pa)[2][2]) {
  const s16x4 l0 = tr_read<v_rd_off(DB, 0, 0)>(vb), h0 = tr_read<v_rd_off(DB, 0, 1)>(vb), l1 = tr_read<v_rd_off(DB, 1, 0)>(vb), h1 = tr_read<v_rd_off(DB, 1, 1)>(vb);
  const s16x4 l2 = tr_read<v_rd_off(DB + 1, 0, 0)>(vb), h2 = tr_read<v_rd_off(DB + 1, 0, 1)>(vb), l3 = tr_read<v_rd_off(DB + 1, 1, 0)>(vb), h3 = tr_read<v_rd_off(DB + 1, 1, 1)>(vb);
  asm volatile("s_waitcnt lgkmcnt(0)" ::: "memory"); SBAR();
  o00 = __builtin_amdgcn_mfma_f32_16x16x32_bf16(pa[0][0], TRPKH(l0, h0), o00, 0, 0, 0);
  o10 = __builtin_amdgcn_mfma_f32_16x16x32_bf16(pa[1][0], TRPKH(l0, h0), o10, 0, 0, 0);
  o01 = __builtin_amdgcn_mfma_f32_16x16x32_bf16(pa[0][0], TRPKH(l2, h2), o01, 0, 0, 0);
  o11 = __builtin_amdgcn_mfma_f32_16x16x32_bf16(pa[1][0], TRPKH(l2, h2), o11, 0, 0, 0);
  o00 = __builtin_amdgcn_mfma_f32_16x16x32_bf16(pa[0][1], TRPKH(l1, h1), o00, 0, 0, 0);
  o10 = __builtin_amdgcn_mfma_f32_16x16x32_bf16(pa[1][1], TRPKH(l1, h1), o10, 0, 0, 0);
  o01 = __builtin_amdgcn_mfma_f32_16x16x32_bf16(pa[0][1], TRPKH(l3, h3), o01, 0, 0, 0);
  o11 = __builtin_amdgcn_mfma_f32_16x16x32_bf16(pa[1][1], TRPKH(l3, h3), o11, 0, 0, 0);
}
typedef f32x4 OT_[2][8];
__device__ __forceinline__ void pv_all(OT_& o, int vb, const bf16x8 (&pa)[2][2]) {
  pv_two<0>(o[0][0], o[1][0], o[0][1], o[1][1], vb, pa); pv_two<2>(o[0][2], o[1][2], o[0][3], o[1][3], vb, pa);
  pv_two<4>(o[0][4], o[1][4], o[0][5], o[1][5], vb, pa); pv_two<6>(o[0][6], o[1][6], o[0][7], o[1][7], vb, pa);
}
__device__ __forceinline__ void attn_body(const bf16_t* __restrict__ Qb, const bf16_t* __restrict__ Kn, const bf16_t* __restrict__ Kr,
                                          bf16_t* __restrict__ Gm, int seq, char* lds, int tid) {
  const int wid = tid >> 6, lane = tid & 63, r32 = lane & 31, hi = lane >> 5, c = lane & 15, g = lane >> 4;
  char* V_lds = lds + OFF_V; char* K_lds = lds + OFF_KN; char* R_lds = lds + OFF_KR;
  float* ws = (float*)(lds + OFF_WS) + wid * 64; float* li_l = ws; float* al_l = ws + 32;
  float m_reg = -1e30f, l_reg = 0; OT_ o;
#pragma unroll
  for (int qb = 0; qb < 2; ++qb)
#pragma unroll
    for (int db = 0; db < 8; ++db) o[qb][db] = (f32x4){0.f, 0.f, 0.f, 0.f};
  bf16x8 qr[QREG > 0 ? QREG : 1];
  char* ql = lds + OFF_QL + wid * (QLDS * 1024) + lane * 16;
  const unsigned qoff = (unsigned)((wid * QBLK + r32) * NQ + hi * 8) * 2u;
#pragma unroll
  for (int d0 = 0; d0 < 12; ++d0) { const bf16x8 qv = *(const bf16x8*)((const char*)Qb + qoff + d0 * 32); if (d0 < QREG) qr[d0 < QREG ? d0 : 0] = qv; else *reinterpret_cast<bf16x8*>(ql + (d0 - QREG) * 1024) = qv; }
  const int sr = tid >> 4, sc = (tid & 15) * 8, vst0 = v_st(sr, sc), vst1 = v_st(32 + sr, sc);
  const int rr_ = tid >> 3, rc_ = tid & 7;
  const int vb0 = (int)(uintptr_t)V_lds + v_rd_base(lane);
  struct { bf16x8 vs0, vs1, ks0, ks1, kr; } sr_;
  const unsigned voff = (unsigned)(sr * NKV + sc) * 2u, voffr = (unsigned)(rr_ * 64 + rc_ * 8) * 2u;
#define SLOAD(k0) do { const char* kb_ = (const char*)(Kn + (long)(k0) * NKV); const char* rb_ = (const char*)(Kr + (long)(k0) * 64); \
    sr_.vs0 = *(const bf16x8*)(kb_ + 256 + voff); sr_.vs1 = *(const bf16x8*)(kb_ + (32 * NKV * 2 + 256) + voff); \
    sr_.ks0 = *(const bf16x8*)(kb_ + voff); sr_.ks1 = *(const bf16x8*)(kb_ + 32 * NKV * 2 + voff); \
    sr_.kr = *(const bf16x8*)(rb_ + voffr); } while (0)
#define SWRITE(b) do { *(bf16x8*)(V_lds + (b) * SHM_V + vst0) = sr_.vs0; *(bf16x8*)(V_lds + (b) * SHM_V + vst1) = sr_.vs1; const int kc_ = sc * 2; \
    *(bf16x8*)(K_lds + (b) * SHM_KN + KSWZ(sr, kc_)) = sr_.ks0; *(bf16x8*)(K_lds + (b) * SHM_KN + KSWZ(32 + sr, kc_)) = sr_.ks1; \
    *(bf16x8*)(R_lds + (b) * SHM_KR + RSWZ(rr_, rc_)) = sr_.kr; } while (0)
#define SWAIT() asm volatile("s_waitcnt vmcnt(0)" ::: "memory")
#define RESC(a) do { if (__any((a) < 1.f)) { if (hi == 0) al_l[r32] = (a); asm volatile("s_waitcnt lgkmcnt(0)" ::: "memory"); \
    _Pragma("unroll") for (int qb = 0; qb < 2; ++qb) { const f32x4 av = *(const f32x4*)(al_l + 16 * qb + 4 * g); _Pragma("unroll") for (int db = 0; db < 8; ++db) o[qb][db] *= av; } } } while (0)
  f32x16 pA0, pA1, pB0, pB1; float mnA, mnB, alA, alB; bf16x8 pa[2][2]; const int NT = seq / KVBLK;
  SLOAD(0); SWAIT(); SWRITE(0); __syncthreads();
  att::qkt<QREG>(pA0, pA1, K_lds, R_lds, qr, ql, r32, hi); partialSM(pA0, pA1, m_reg, mnA, alA);
  SLOAD(KVBLK); SWAIT(); SWRITE(1); __syncthreads();
  for (int j = 1; j + 1 < NT; j += 2) {
    SBAR(); att::qkt<QREG>(pB0, pB1, K_lds + SHM_KN, R_lds + SHM_KR, qr, ql, r32, hi);
    finishSM(pA0, pA1, alA, l_reg, pa); SBAR();
    SLOAD((j + 1) * KVBLK); SBAR();
    pv_all(o, vb0, pa); partialSM(pB0, pB1, m_reg, mnB, alB);
    __syncthreads(); SWAIT(); SWRITE(0);
    RESC(alB); __syncthreads();
    SBAR(); att::qkt<QREG>(pA0, pA1, K_lds, R_lds, qr, ql, r32, hi);
    finishSM(pB0, pB1, alB, l_reg, pa); SBAR();
    SLOAD((j + 2) * KVBLK); SBAR();
    pv_all(o, vb0 + (int)SHM_V, pa); partialSM(pA0, pA1, m_reg, mnA, alA);
    __syncthreads(); SWAIT(); SWRITE(1);
    RESC(alA); __syncthreads();
  }
  SBAR(); att::qkt<QREG>(pB0, pB1, K_lds + SHM_KN, R_lds + SHM_KR, qr, ql, r32, hi);
  finishSM(pA0, pA1, alA, l_reg, pa); SBAR();
  pv_all(o, vb0, pa); partialSM(pB0, pB1, m_reg, mnB, alB);
  __syncthreads(); RESC(alB);
  finishSM(pB0, pB1, alB, l_reg, pa); SBAR();
  pv_all(o, vb0 + (int)SHM_V, pa);
  SBAR(); asm volatile("" ::: "memory");
  u32x4 gt[8]; const int grow = lane >> 4, gc16 = lane & 15;
  bf16_t* Gw = Gm + (size_t)(wid * QBLK + grow) * DM + gc16 * 8;
#pragma unroll
  for (int i = 0; i < 8; ++i) gt[i] = __builtin_nontemporal_load((const u32x4*)(Gw + (size_t)(4 * i) * DM));
  if (hi == 0) li_l[r32] = l_reg;
  __syncthreads();
  char* ot = lds + wid * (32 * OT_PITCH);
#pragma unroll
  for (int qb = 0; qb < 2; ++qb) { const f32x4 lv = *(const f32x4*)(li_l + 16 * qb + 4 * g);
#pragma unroll
    for (int r = 0; r < 4; ++r) { const float rl = __builtin_amdgcn_rcpf(lv[r]); char* orow = ot + (16 * qb + 4 * g + r) * OT_PITCH + c * 2;
#pragma unroll
      for (int db = 0; db < 8; ++db) *(bf16_t*)(orow + db * 32) = f2bf(o[qb][db][r] * rl); } }
  asm volatile("s_waitcnt lgkmcnt(0)" ::: "memory");
#pragma unroll
  for (int i = 0; i < 8; ++i) { const u32x4 ov = *(const u32x4*)(ot + (grow + 4 * i) * OT_PITCH + gc16 * 16); const u32x4 gv = gt[i]; u32x4 w;
#pragma unroll
    for (int e = 0; e < 4; ++e) { const float g0_ = __uint_as_float(gv[e] << 16), g1_ = __uint_as_float(gv[e] & 0xffff0000u); const float a0 = __uint_as_float(ov[e] << 16) * (GATE_IN_EPI ? g0_ : silu_f(g0_)), a1 = __uint_as_float(ov[e] & 0xffff0000u) * (GATE_IN_EPI ? g1_ : silu_f(g1_)); w[e] = cvt_pk_bf16(a0, a1); }
    *(u32x4*)(Gw + (size_t)(4 * i) * DM) = w; }
#undef SLOAD
#undef SWRITE
#undef SWAIT
#undef RESC
}
}
template <int VAR = 0>
__device__ __forceinline__ void attn_fast(const Frame& F) {
    const bf16_t* Q = WSP(bf16_t, WS_Q); const bf16_t* KV = WSP(bf16_t, WS_KV); const bf16_t* KR = WSP(bf16_t, WS_KR); bf16_t* MIX = WSP(bf16_t, F.mix_off);
    for (int it = F.vcu; it < NB * NH * (SEQ / 256); it += F.G) {
        const int qb = it & 15, p = it >> 4, h = p & 7, b = p >> 3;
        const size_t t0 = (size_t)b * SEQ, q0 = t0 + (size_t)qb * 256;
        int t = F.tid; asm volatile("" : "+v"(t));
#if ATT_STAGR
        att::attn_body6(Q + q0 * NQ + h * DQK, KV + t0 * NKV + h * 256, KR + t0 * 64, MIX + q0 * DM + DF + h * 128, SEQ, F.ldsg, F.lds, t);
#elif ATT_ONEBAR
        att::attn_body5(Q + q0 * NQ + h * DQK, KV + t0 * NKV + h * 256, KR + t0 * 64, MIX + q0 * DM + DF + h * 128, SEQ, F.ldsg, t);
#elif ATT_STAG
        att::attn_body4(Q + q0 * NQ + h * DQK, KV + t0 * NKV + h * 256, KR + t0 * 64, MIX + q0 * DM + DF + h * 128, SEQ, F.ldsg, F.lds, t);
#elif ATT_HYB
        atth::attn_body(Q + q0 * NQ + h * DQK, KV + t0 * NKV + h * 256, KR + t0 * 64, MIX + q0 * DM + DF + h * 128, SEQ, F.ldsg, t);
#elif ATT_S16
        att16::attn_body<VAR>(Q + q0 * NQ + h * DQK, KV + t0 * NKV + h * 256, KR + t0 * 64, MIX + q0 * DM + DF + h * 128, SEQ, F.ldsg, t);
#elif ATT_DMA
        att::attn_body3(Q + q0 * NQ + h * DQK, KV + t0 * NKV + h * 256, KR + t0 * 64, MIX + q0 * DM + DF + h * 128, SEQ, F.ldsg, F.lds, t);
#else
        att::attn_body<VAR>(Q + q0 * NQ + h * DQK, KV + t0 * NKV + h * 256, KR + t0 * 64, MIX + q0 * DM + DF + h * 128, SEQ, F.ldsg, t);
#endif
        __syncthreads();
    }
}
namespace fft {
using att::v_st; using att::v_rd_base; using att::v_rd_off; using att::tr_read; using att::crow;
constexpr int OPITCH = 272;
constexpr int F1_T = 0, F1_OUT = 16384, F1_END = F1_OUT + 128 * OPITCH;
constexpr int XPITCH = 528;
constexpr int F2_Z = 0, F2_XL = 32768, F2_YL = F2_XL + 64 * XPITCH, F2_D2 = F2_YL + 64 * XPITCH, F2_END = F2_D2 + 128 * OPITCH;
static_assert(F1_END <= RING_BYTES && F2_END <= RING_BYTES, "FFT LDS must fit the phase scratch");
#ifndef FFT_SYM
#define FFT_SYM 1
#endif
__device__ __forceinline__ void cmirror(bf16x8& re, bf16x8& im, const float c, const float s) {
    const u32x4 r = __builtin_bit_cast(u32x4, re), m = __builtin_bit_cast(u32x4, im); u32x4 orr, oim;
#pragma unroll
    for (int e = 0; e < 4; ++e) { const float r0 = __uint_as_float(r[e] << 16), r1 = __uint_as_float(r[e] & 0xffff0000u), m0 = __uint_as_float(m[e] << 16), m1 = __uint_as_float(m[e] & 0xffff0000u);
        orr[e] = cvt_pk_bf16(r0 * c - m0 * s, r1 * c - m1 * s); oim[e] = cvt_pk_bf16(-(r0 * s + m0 * c), -(r1 * s + m1 * c)); }
    re = __builtin_bit_cast(bf16x8, orr); im = __builtin_bit_cast(bf16x8, oim);
}
#ifndef FFT_DYN
#define FFT_DYN 0
#endif
__device__ __forceinline__ unsigned* qword(const Frame& F, int s, int l, int q) { return WSP(unsigned, WS_CTL) + 3584 + ((s * DEPTH + l) * 8 + q) * 16; }
static_assert(3584 >= XCD_BAR_WORDS && (3584 + 2 * DEPTH * 8 * 16) * 4 <= CTL_BYTES, "queue words must fit the control region behind the barrier words");
__device__ __forceinline__ int q_item(int G, int qg, unsigned idx) { return G >= 64 ? (idx < 256u ? (int)idx * 8 + qg : -1) : (idx < (unsigned)(NB * 64 * NG) ? (int)idx : -1); }
}
__device__ __forceinline__ void fft1_fast(const Frame& F, int l) {
    using namespace fft;
    const bf16_t* U = WSP(bf16_t, WS_U); const bf16_t* D1 = WSP(bf16_t, WS_D1); bf16_t* Z = WSP(bf16_t, WS_H);
    const int tid = F.tid, wid = tid >> 6, lane = tid & 63, r32 = lane & 31, hi = lane >> 5, half = wid & 1, cb = wid >> 1;
    char* lds = F.ldsg;
    bf16x8 bfr[2][4];
#pragma unroll
    for (int ri = 0; ri < 2; ++ri)
#pragma unroll
        for (int ks = 0; ks < 4; ++ks) bfr[ri][ks] = *(const bf16x8*)(D1 + (ri * 64 + half * 32 + r32) * 64 + 16 * ks + 8 * hi);
    const int sr = tid >> 4, sc = (tid & 15) * 8, vst0 = v_st(sr, sc), vst1 = v_st(32 + sr, sc);
    const int vb = (int)(uintptr_t)(lds + F1_T) + v_rd_base(lane) + cb * 512;
    const int s1p = half * 32 + r32;
#if FFT_DYN
    const int qg = F.G >= 64 ? ((F.bx >> 3) & 7) : 0; unsigned* qc = qword(F, 0, l, qg); volatile LAS unsigned* mw = (volatile LAS unsigned*)(F.lds + MISC_OFF);
    unsigned cnx = 0u;
    if (tid == 0) { mw[8] = xb_add(qc, 1u); cnx = xb_add(qc, 1u); }
    __syncthreads();
    int it = q_item(F.G, qg, mw[8]); if (it < 0) return;
#else
    int it = F.bx; if (it >= NB * 64 * NG) return;
#endif
    bf16x8 u0, u1;
#define F1_LOAD(IT) do { const int g_ = (IT) & 7, s2_ = ((IT) >> 3) & 63, b_ = (IT) >> 9; const bf16_t* up = U + ((size_t)(b_ * SEQ + s2_)) * DF + g_ * 128 + sc; \
        u0 = __builtin_nontemporal_load((const bf16x8*)(up + (size_t)(64 * sr) * DF)); u1 = __builtin_nontemporal_load((const bf16x8*)(up + (size_t)(64 * (sr + 32)) * DF)); } while (0)
    F1_LOAD(it);
#if FFT_DYN
    for (int nit = 0; it >= 0; it = nit) {
        const int g = it & 7, s2 = (it >> 3) & 63, b = it >> 9;
        *(bf16x8*)(lds + F1_T + vst0) = u0; *(bf16x8*)(lds + F1_T + vst1) = u1;
        if (tid == 0) mw[8] = cnx;
        __syncthreads();
        nit = q_item(F.G, qg, mw[8]);
        if (nit >= 0) { F1_LOAD(nit); if (tid == 0) cnx = xb_add(qc, 1u); }
#else
    for (; it < NB * 64 * NG; it += F.G) {
        const int g = it & 7, s2 = (it >> 3) & 63, b = it >> 9;
        *(bf16x8*)(lds + F1_T + vst0) = u0; *(bf16x8*)(lds + F1_T + vst1) = u1;
        __syncthreads();
        if (it + F.G < NB * 64 * NG) F1_LOAD(it + F.G);
#endif
        f32x16 acc0 = {}, acc1 = {};
        { const s16x4 l0 = tr_read<v_rd_off(0, 0, 0)>(vb), h0 = tr_read<v_rd_off(0, 0, 1)>(vb), l1 = tr_read<v_rd_off(0, 1, 0)>(vb), h1 = tr_read<v_rd_off(0, 1, 1)>(vb);
          const s16x4 l2 = tr_read<v_rd_off(0, 2, 0)>(vb), h2 = tr_read<v_rd_off(0, 2, 1)>(vb), l3 = tr_read<v_rd_off(0, 3, 0)>(vb), h3 = tr_read<v_rd_off(0, 3, 1)>(vb);
          asm volatile("s_waitcnt lgkmcnt(0)" ::: "memory"); __builtin_amdgcn_sched_barrier(0);
          acc0 = __builtin_amdgcn_mfma_f32_32x32x16_bf16(TRPK(l0, h0), bfr[0][0], acc0, 0, 0, 0); acc1 = __builtin_amdgcn_mfma_f32_32x32x16_bf16(TRPK(l0, h0), bfr[1][0], acc1, 0, 0, 0);
          acc0 = __builtin_amdgcn_mfma_f32_32x32x16_bf16(TRPK(l1, h1), bfr[0][1], acc0, 0, 0, 0); acc1 = __builtin_amdgcn_mfma_f32_32x32x16_bf16(TRPK(l1, h1), bfr[1][1], acc1, 0, 0, 0);
          acc0 = __builtin_amdgcn_mfma_f32_32x32x16_bf16(TRPK(l2, h2), bfr[0][2], acc0, 0, 0, 0); acc1 = __builtin_amdgcn_mfma_f32_32x32x16_bf16(TRPK(l2, h2), bfr[1][2], acc1, 0, 0, 0);
          acc0 = __builtin_amdgcn_mfma_f32_32x32x16_bf16(TRPK(l3, h3), bfr[0][3], acc0, 0, 0, 0); acc1 = __builtin_amdgcn_mfma_f32_32x32x16_bf16(TRPK(l3, h3), bfr[1][3], acc1, 0, 0, 0); }
        float st, ct; sincospif((float)(s2 * s1p) * (1.0f / 2048.0f), &st, &ct);
        char* o0 = lds + F1_OUT + s1p * OPITCH + (cb * 32 + 4 * hi) * 2; char* o1 = o0 + 64 * OPITCH;
#pragma unroll
        for (int q = 0; q < 4; ++q) { float zr[4], zi[4];
#pragma unroll
            for (int j = 0; j < 4; ++j) { const float yr = acc0[4 * q + j], yi = acc1[4 * q + j]; zr[j] = yr * ct + yi * st; zi[j] = yi * ct - yr * st; }
            *(u32x2*)(o0 + q * 16) = (u32x2){cvt_pk_bf16(zr[0], zr[1]), cvt_pk_bf16(zr[2], zr[3])};
            *(u32x2*)(o1 + q * 16) = (u32x2){cvt_pk_bf16(zi[0], zi[1]), cvt_pk_bf16(zi[2], zi[3])}; }
        __syncthreads();
#pragma unroll
        for (int i = 0; i < 4; ++i) { const int q = tid + 512 * i, row = q >> 4, c16 = q & 15, ri = row >> 6, sp = row & 63;
            const u32x4 v = *(const u32x4*)(lds + F1_OUT + row * OPITCH + c16 * 16);
            if (FFT_SYM == 0 || sp <= 32) *(u32x4*)(Z + (((((size_t)(b * 64 + sp) * NG + g) * 2 + ri) * 64 + s2) * 128) + c16 * 8) = v; }
    }
#undef F1_LOAD
    __syncthreads();
}
__device__ __forceinline__ void fft2_fast(const Frame& F, int l) {
    using namespace fft;
    const bf16_t* Z = WSP(bf16_t, WS_H); const bf16_t* D2 = WSP(bf16_t, WS_D2); const bf16_t* wcat = WSP(bf16_t, WS_WCAT) + (size_t)l * NG * 128 * 256; bf16_t* MIX = WSP(bf16_t, F.mix_off);
    const int tid = F.tid, wid = tid >> 6, lane = tid & 63, r32 = lane & 31, hi = lane >> 5, cb = wid & 3, h2 = wid >> 2;
    char* lds = F.ldsg;
#if FFT_DYN
    const int qg = F.G >= 64 ? ((F.bx >> 3) & 7) : 0; unsigned* qc = qword(F, 1, l, qg); volatile LAS unsigned* mw = (volatile LAS unsigned*)(F.lds + MISC_OFF);
    unsigned cnx = 0u;
    if (tid == 0) { mw[8] = xb_add(qc, 1u); cnx = xb_add(qc, 1u); }
    __syncthreads();
    int it = q_item(F.G, qg, mw[8]); if (it < 0) return;
#else
    int it = F.bx; if (it >= NB * 64 * NG) return;
#endif
#pragma unroll
    for (int i = 0; i < 4; ++i) { const int q = tid + 512 * i, row = q >> 4, c16 = q & 15; *(u32x4*)(lds + F2_D2 + row * OPITCH + c16 * 16) = *(const u32x4*)(D2 + row * 128 + c16 * 8); }
    const int sr = tid >> 4, sc = (tid & 15) * 8, vst0 = v_st(sr, sc), vst1 = v_st(32 + sr, sc);
    const int vb = (int)(uintptr_t)(lds + F2_Z) + v_rd_base(lane) + cb * 512;
    bf16x8 wfr[16]; int gcur = -1;
    float ms0, mc0; sincospif((float)sr * (1.0f / 32.0f), &ms0, &mc0);
    bf16x8 z0, z1, z2, z3, g0, g1;
#define F2_LOAD(IT) do { const int g_ = (IT) & 7, sp_ = ((IT) >> 3) & 63, b_ = (IT) >> 9, zs_ = (FFT_SYM && sp_ > 32) ? 64 - sp_ : sp_; const bf16_t* zp = Z + ((size_t)(b_ * 64 + zs_) * NG + g_) * (2 * 64 * 128) + sr * 128 + sc; \
        z0 = __builtin_nontemporal_load((const bf16x8*)(zp)); z1 = __builtin_nontemporal_load((const bf16x8*)(zp + 32 * 128)); z2 = __builtin_nontemporal_load((const bf16x8*)(zp + 64 * 128)); z3 = __builtin_nontemporal_load((const bf16x8*)(zp + 96 * 128)); \
        const bf16_t* mp = MIX + ((size_t)(b_ * SEQ + sp_ + 64 * (tid >> 4))) * DM + g_ * 128 + (tid & 15) * 8; g0 = __builtin_nontemporal_load((const bf16x8*)(mp)); g1 = __builtin_nontemporal_load((const bf16x8*)(mp + (size_t)(64 * 32) * DM)); } while (0)
    F2_LOAD(it);
#if FFT_DYN
    for (int nit = 0; it >= 0; it = nit) {
        const int g = it & 7, sp = (it >> 3) & 63, b = it >> 9;
        if (g != gcur) { gcur = g;
#pragma unroll
            for (int ks = 0; ks < 16; ++ks) wfr[ks] = *(const bf16x8*)(wcat + (size_t)(g * 128 + cb * 32 + r32) * 256 + 16 * ks + 8 * hi); }
#else
    while (it < NB * 64 * NG) {
      { const int g_ = it & 7; gcur = g_;
#pragma unroll
        for (int ks = 0; ks < 16; ++ks) wfr[ks] = *(const bf16x8*)(wcat + (size_t)(g_ * 128 + cb * 32 + r32) * 256 + 16 * ks + 8 * hi);
        __builtin_amdgcn_s_waitcnt(0x0F70); }
      for (; it < NB * 64 * NG && (it & 7) == gcur; it += F.G) {
        const int g = it & 7, sp = (it >> 3) & 63, b = it >> 9;
#endif
        if (FFT_SYM && sp > 32) { cmirror(z0, z2, mc0, ms0); cmirror(z1, z3, -mc0, -ms0); }
        *(bf16x8*)(lds + F2_Z + vst0) = z0; *(bf16x8*)(lds + F2_Z + vst1) = z1; *(bf16x8*)(lds + F2_Z + 16384 + vst0) = z2; *(bf16x8*)(lds + F2_Z + 16384 + vst1) = z3;
        const bf16x8 gg0 = g0, gg1 = g1;
#if FFT_DYN
        if (tid == 0) mw[8] = cnx;
        __syncthreads();
        nit = q_item(F.G, qg, mw[8]);
        if (nit >= 0) { F2_LOAD(nit); if (tid == 0) cnx = xb_add(qc, 1u); }
#else
        __syncthreads();
        if (it + F.G < NB * 64 * NG) F2_LOAD(it + F.G);
#endif
#if defined(FFT2_P1_NAIVE)
        { const bf16_t* Zb = Z + ((size_t)(b * 64 + sp) * NG + g) * (2 * 64 * 128);
          for (int i = 0; i < 32; ++i) { const int o = tid + 512 * i, c = o & 127, rr = o >> 7; float s_ = 0.f;
              for (int k = 0; k < 128; ++k) s_ += bf2f(D2[rr * 128 + k]) * bf2f(Zb[k * 128 + c]);
              *(bf16_t*)(lds + F2_XL + (rr & 63) * XPITCH + ((rr >> 6) * 128 + c) * 2) = f2bf(s_); } }
#else
        f32x16 x0 = {}, x1 = {};
        const char* d2p = lds + F2_D2 + (h2 * 32 + r32) * OPITCH + 16 * hi;
#pragma unroll
        for (int t = 0; t < 2; ++t) {
            const int vbt = vb + t * 16384;
            const s16x4 l0 = tr_read<v_rd_off(0, 0, 0)>(vbt), h0 = tr_read<v_rd_off(0, 0, 1)>(vbt), l1 = tr_read<v_rd_off(0, 1, 0)>(vbt), h1 = tr_read<v_rd_off(0, 1, 1)>(vbt);
            const s16x4 l2 = tr_read<v_rd_off(0, 2, 0)>(vbt), h2_ = tr_read<v_rd_off(0, 2, 1)>(vbt), l3 = tr_read<v_rd_off(0, 3, 0)>(vbt), h3 = tr_read<v_rd_off(0, 3, 1)>(vbt);
            bf16x8 e0[4], e1[4];
#pragma unroll
            for (int ks = 0; ks < 4; ++ks) { e0[ks] = *(const bf16x8*)(d2p + (t * 4 + ks) * 32); e1[ks] = *(const bf16x8*)(d2p + 64 * OPITCH + (t * 4 + ks) * 32); }
            asm volatile("s_waitcnt lgkmcnt(0)" ::: "memory"); __builtin_amdgcn_sched_barrier(0);
            x0 = __builtin_amdgcn_mfma_f32_32x32x16_bf16(TRPK(l0, h0), e0[0], x0, 0, 0, 0); x1 = __builtin_amdgcn_mfma_f32_32x32x16_bf16(TRPK(l0, h0), e1[0], x1, 0, 0, 0);
            x0 = __builtin_amdgcn_mfma_f32_32x32x16_bf16(TRPK(l1, h1), e0[1], x0, 0, 0, 0); x1 = __builtin_amdgcn_mfma_f32_32x32x16_bf16(TRPK(l1, h1), e1[1], x1, 0, 0, 0);
            x0 = __builtin_amdgcn_mfma_f32_32x32x16_bf16(TRPK(l2, h2_), e0[2], x0, 0, 0, 0); x1 = __builtin_amdgcn_mfma_f32_32x32x16_bf16(TRPK(l2, h2_), e1[2], x1, 0, 0, 0);
            x0 = __builtin_amdgcn_mfma_f32_32x32x16_bf16(TRPK(l3, h3), e0[3], x0, 0, 0, 0); x1 = __builtin_amdgcn_mfma_f32_32x32x16_bf16(TRPK(l3, h3), e1[3], x1, 0, 0, 0);
        }
        { char* xr = lds + F2_XL + (h2 * 32 + r32) * XPITCH + (cb * 32 + 4 * hi) * 2;
#pragma unroll
          for (int q = 0; q < 4; ++q) { *(u32x2*)(xr + q * 16) = (u32x2){cvt_pk_bf16(x0[4 * q], x0[4 * q + 1]), cvt_pk_bf16(x0[4 * q + 2], x0[4 * q + 3])};
              *(u32x2*)(xr + 256 + q * 16) = (u32x2){cvt_pk_bf16(x1[4 * q], x1[4 * q + 1]), cvt_pk_bf16(x1[4 * q + 2], x1[4 * q + 3])}; } }
#endif
        __syncthreads();
#if defined(FFT2_P2_NAIVE)
        for (int i = 0; i < 16; ++i) { const int o = tid + 512 * i, d = o & 127, s2p = o >> 7; float s_ = 0.f;
            const bf16_t* wr_ = wcat + (size_t)(g * 128 + d) * 256;
            for (int k = 0; k < 256; ++k) s_ += bf2f(*(const bf16_t*)(lds + F2_XL + s2p * XPITCH + k * 2)) * bf2f(wr_[k]);
            *(float*)(lds + F2_YL + s2p * XPITCH + d * 4) = s_; }
#else
        f32x16 y = {};
        { const char* xb = lds + F2_XL + (h2 * 32 + r32) * XPITCH + 16 * hi;
#pragma unroll
          for (int ks = 0; ks < 16; ++ks) { const bf16x8 xf = *(const bf16x8*)(xb + ks * 32); y = __builtin_amdgcn_mfma_f32_32x32x16_bf16(wfr[ks], xf, y, 0, 0, 0); } }
        { char* yr = lds + F2_YL + (h2 * 32 + r32) * XPITCH + (cb * 32 + 4 * hi) * 4;
#pragma unroll
          for (int q = 0; q < 4; ++q) *(f32x4*)(yr + q * 32) = (f32x4){y[4 * q], y[4 * q + 1], y[4 * q + 2], y[4 * q + 3]}; }
#endif
        __syncthreads();
#pragma unroll
        for (int i = 0; i < 2; ++i) { const int row = (tid >> 4) + 32 * i, c8 = (tid & 15) * 8; const bf16x8 gv = i ? gg1 : gg0;
            const f32x4 ya = *(const f32x4*)(lds + F2_YL + row * XPITCH + c8 * 4), yb = *(const f32x4*)(lds + F2_YL + row * XPITCH + c8 * 4 + 16);
            f32x4 ga = {bf2f((bf16_t)gv[0]), bf2f((bf16_t)gv[1]), bf2f((bf16_t)gv[2]), bf2f((bf16_t)gv[3])}, gb = {bf2f((bf16_t)gv[4]), bf2f((bf16_t)gv[5]), bf2f((bf16_t)gv[6]), bf2f((bf16_t)gv[7])};
            if (!GATE_IN_EPI) { ga = silu4(ga); gb = silu4(gb); }
            store8_bf16(MIX + ((size_t)(b * SEQ + sp + 64 * row)) * DM + g * 128 + c8, ya * ga, yb * gb); }
    }
#if !FFT_DYN
    }
#endif
#undef F2_LOAD
    __syncthreads();
}
#if PROBE_CHECK
constexpr size_t WS_CHK_GATE = WS_U;
constexpr size_t WS_CHK_CNT = WS_CTL + 15 * 1024;
__device__ __forceinline__ int chk_tok(int i) { return (i * 64 + 37 + (i >> 2) * 4096 / 64 * 0) % MTOK + ((i & 3) * 4096) - ((i & 3) * 4096); }
__device__ __forceinline__ void chk_fail(const Frame& F, float a, float b, float atol, float rtol) { if (!(fabsf(a - b) <= atol + rtol * fabsf(b))) atomicAdd(WSP(unsigned, WS_CHK_CNT), 1u); }
__device__ __forceinline__ void chk_proj(const Frame& F, int l) {
    LAS float* hs = (LAS float*)F.lds;
    LAS float* cs = hs + 2048;
    LAS float* red = cs + 832;
    const float* x = l == 0 ? F.in[0] : WSP(float, WS_R); const float* mod = WSP(float, WS_MOD) + (size_t)l * NB * 3 * DM; const float* w_in = F.in[5] + (size_t)l * DM * NIN;
    for (int i = F.bx; i < 256; i += F.G) {
        const int tok = 64 * i + 37, b = tok >> 12, tid = F.tid;
        float s = 0.f; for (int k = tid; k < DM; k += NTHREADS) s += x[(size_t)tok * DM + k];
        s = wave_sum(s); if (F.lane == 0) red[F.wave] = s; __syncthreads(); float mean = 0.f; for (int w = 0; w < 8; ++w) mean += red[w]; mean *= (1.0f / DM); __syncthreads();
        float q2 = 0.f; for (int k = tid; k < DM; k += NTHREADS) { const float d = x[(size_t)tok * DM + k] - mean; q2 += d * d; }
        q2 = wave_sum(q2); if (F.lane == 0) red[F.wave] = q2; __syncthreads(); float var = 0.f; for (int w = 0; w < 8; ++w) var += red[w]; const float rstd = rsqrtf(var * (1.0f / DM) + NORM_EPS); __syncthreads();
        for (int k = tid; k < DM; k += NTHREADS) hs[k] = bf2f(f2bf((x[(size_t)tok * DM + k] - mean) * rstd * (1.0f + mod[(size_t)b * 3 * DM + DM + k]) + mod[(size_t)b * 3 * DM + k]));
        __syncthreads();
        for (int c = tid; c < 832; c += NTHREADS) { float a = 0.f; for (int k = 0; k < DM; ++k) a += hs[k] * bf2f(f2bf(w_in[(size_t)k * NIN + 2048 + c])); cs[c] = a; }
        __syncthreads();
        float sq = 0.f; for (int c = tid; c < 512; c += NTHREADS) sq += cs[c] * cs[c];
        sq = wave_sum(sq); if (F.lane == 0) red[F.wave] = sq; __syncthreads(); float sq_q = 0.f; for (int w = 0; w < 8; ++w) sq_q += red[w]; __syncthreads();
        float sk = 0.f; for (int c = 512 + tid; c < 768; c += NTHREADS) sk += cs[c] * cs[c];
        sk = wave_sum(sk); if (F.lane == 0) red[F.wave] = sk; __syncthreads(); float sq_k = 0.f; for (int w = 0; w < 8; ++w) sq_k += red[w]; __syncthreads();
        const float rq = rsqrtf(sq_q * (1.0f / QLR) + NORM_EPS), rk = rsqrtf(sq_k * (1.0f / KVLR) + NORM_EPS);
        const float* rc = WSP(float, WS_RCOS) + (size_t)tok * 32; const float* rs = WSP(float, WS_RSIN) + (size_t)tok * 32;
        const int pos = ((const int*)F.in[2])[tok];
        if (tid < 32) { const float ang = (float)pos * powf(10000.0f, -(float)tid / 32.0f); const float c_ = cosf(ang), s_ = sinf(ang); const float x1 = cs[768 + tid], x2 = cs[800 + tid];
            chk_fail(F, bf2f(WSP(bf16_t, WS_KR)[(size_t)tok * 64 + tid]), x1 * c_ - x2 * s_, 0.05f, 0.05f); chk_fail(F, bf2f(WSP(bf16_t, WS_KR)[(size_t)tok * 64 + 32 + tid]), x2 * c_ + x1 * s_, 0.05f, 0.05f);
            chk_fail(F, rc[tid], c_, 0.02f, 0.f); chk_fail(F, rs[tid], s_, 0.02f, 0.f); }
        const float* wq = F.in[7] + (size_t)l * QLR * NQ; const float* gq = F.in[6] + l * QLR;
        for (int n = tid; n < NQ; n += NTHREADS) { const int head = n / DQK, d = n - head * DQK; if (d >= 160) continue;
            float a = 0.f, a2 = 0.f; for (int k = 0; k < QLR; ++k) { const float cn = bf2f(f2bf(cs[k])) * rq * gq[k]; a += cn * wq[(size_t)k * NQ + n]; if (d >= 128) a2 += cn * wq[(size_t)k * NQ + n + 32]; }
            if (d < 128) chk_fail(F, bf2f(WSP(bf16_t, WS_Q)[(size_t)tok * NQ + n]), a, 0.06f, 0.05f);
            else { const int ii = d - 128; const float ang = (float)pos * powf(10000.0f, -(float)ii / 32.0f); const float c_ = cosf(ang), s_ = sinf(ang);
                chk_fail(F, bf2f(WSP(bf16_t, WS_Q)[(size_t)tok * NQ + n]), a * c_ - a2 * s_, 0.06f, 0.05f); chk_fail(F, bf2f(WSP(bf16_t, WS_Q)[(size_t)tok * NQ + n + 32]), a2 * c_ + a * s_, 0.06f, 0.05f); } }
        const float* wk = F.in[9] + (size_t)l * KVLR * NKV; const float* gk = F.in[8] + l * KVLR;
        for (int n = tid; n < NKV; n += NTHREADS) { float a = 0.f; for (int k = 0; k < KVLR; ++k) a += bf2f(f2bf(cs[512 + k])) * rk * gk[k] * wk[(size_t)k * NKV + n];
            chk_fail(F, bf2f(WSP(bf16_t, WS_KV)[(size_t)tok * NKV + n]), a, 0.06f, 0.05f); }
        for (int c = tid; c < 1024; c += NTHREADS) WSP(bf16_t, WS_CHK_GATE)[(size_t)i * 1024 + c] = WSP(bf16_t, WS_MIX)[(size_t)tok * DM + DF + c];
        __syncthreads();
    }
}
__device__ __forceinline__ void chk_attn(const Frame& F) {
    const bf16_t* Q = WSP(bf16_t, WS_Q); const bf16_t* KV = WSP(bf16_t, WS_KV); const bf16_t* KR = WSP(bf16_t, WS_KR); const bf16_t* MIX = WSP(bf16_t, WS_MIX);
    LAS float* qs = (LAS float*)F.lds + F.wave * 192;
    for (int i = F.bx; i < 256; i += F.G) {
        const int tok = 64 * i + 37, b = tok >> 12, h = F.wave;
        for (int dh = 0; dh < 2; ++dh) {
            __builtin_amdgcn_wave_barrier(); asm volatile("" ::: "memory");
            for (int e = 0; e < 3; ++e) qs[F.lane + 64 * e] = bf2f(Q[(size_t)tok * NQ + h * DQK + F.lane + 64 * e]);
            asm volatile("s_waitcnt lgkmcnt(0)" ::: "memory"); __builtin_amdgcn_wave_barrier();
            float m = -1e30f, lsum = 0.f; float o[64];
#pragma unroll
            for (int d = 0; d < 64; ++d) o[d] = 0.f;
            for (int t = 0; t < 64; ++t) {
                const size_t key = (size_t)b * SEQ + F.lane + 64 * t; const bf16_t* kn = KV + key * NKV + h * 256; const bf16_t* kr = KR + key * 64;
                float s = 0.f;
#pragma unroll 2
                for (int c = 0; c < 16; ++c) { const bf16x8 kv = *(const bf16x8*)(kn + c * 8);
#pragma unroll
                    for (int e = 0; e < 8; ++e) s += qs[c * 8 + e] * bf2f((bf16_t)kv[e]); }
#pragma unroll 2
                for (int c = 0; c < 8; ++c) { const bf16x8 kv = *(const bf16x8*)(kr + c * 8);
#pragma unroll
                    for (int e = 0; e < 8; ++e) s += qs[128 + c * 8 + e] * bf2f((bf16_t)kv[e]); }
                s *= ATT_SCALE; const float mn = fmaxf(m, s), a = __expf(m - mn), p = __expf(s - mn); lsum = lsum * a + p; m = mn;
#pragma unroll
                for (int c = 0; c < 8; ++c) { const bf16x8 vv = *(const bf16x8*)(kn + 128 + dh * 64 + c * 8);
#pragma unroll
                    for (int e = 0; e < 8; ++e) o[c * 8 + e] = o[c * 8 + e] * a + p * bf2f((bf16_t)vv[e]); }
            }
            const float Mx = wave_max(m), f = __expf(m - Mx); const float Ls = wave_sum(lsum * f);
            float keep0 = 0.f;
#pragma unroll
            for (int d = 0; d < 64; ++d) { const float od = wave_sum(o[d] * f); if (F.lane == d) keep0 = od; }
            const int col = h * 128 + dh * 64 + F.lane;
            const float gz_ = bf2f(WSP(bf16_t, WS_CHK_GATE)[(size_t)i * 1024 + col]); const float ref = keep0 / Ls * (GATE_IN_EPI ? gz_ : gz_ / (1.0f + expf(-gz_)));
            chk_fail(F, bf2f(MIX[(size_t)tok * DM + DF + col]), ref, 1.5e-3f, 0.05f);
        }
    }
}
__device__ __forceinline__ void chk_finish(const Frame& F) {
    if (F.bx == 0 && F.tid == 0 && __hip_atomic_load(WSP(unsigned, WS_CHK_CNT), __ATOMIC_RELAXED, __HIP_MEMORY_SCOPE_AGENT) != 0u) { for (int k = 0; k < 64; ++k) F.out[k] = __builtin_nanf(""); }
}
#endif
#ifndef DIAG_ONLY
#define DIAG_ONLY -1
#endif
#define DIAG_EN(k) (DIAG_ONLY < 0 || DIAG_ONLY == (k))
#ifndef PROBE_CHECK
#define PROBE_CHECK 0
#endif
#ifndef XCD_REMAP
#define XCD_REMAP 0
#endif
#ifndef PROBE_CLK
#define PROBE_CLK 0
#endif
#ifndef PROBE_N
#define PROBE_N 1
#endif
#ifndef PROBE_VAR
#define PROBE_VAR 0
#endif
#ifndef PROBE_REP
#define PROBE_REP -1
#endif
struct Args { const float* in[14]; float* out; unsigned char* ws; int ph_lo, ph_hi; };
constexpr int N_PHASES = 2 + 5 * DEPTH;

template <class Epi, class Sched> __device__ __forceinline__ void run_gemm(const Frame& F, const pg8::Gemm& g, const Sched& S, const Epi& E) {
#if IMPL_GEMM
    pg8::gemm_phase<Epi, Sched, PG8_ALIGN, PG8_SP2>(F.lds, g, S, E, F.tid);
#else
    pg8::gemm_phase_naive<Epi, Sched>(g, S, E, F.tid);
#endif
}

#define PH_IN(k) (lo <= (k) && (k) < hi)
#ifndef PROBE_SKEW
#define PROBE_SKEW 0
#endif
#ifndef PROBE_SKEW_MASK
#define PROBE_SKEW_MASK 0xFFFu
#endif
#ifndef PROBE_SKEW_MUL
#define PROBE_SKEW_MUL 10
#endif
#if PROBE_SKEW
#define PH_STAMP(k) do { __syncthreads(); if (threadIdx.x == 0) __hip_atomic_store(WSP(unsigned long long, WS_END) + (k) * 256 + F.bx, (unsigned long long)__builtin_amdgcn_s_memrealtime(), __ATOMIC_RELAXED, __HIP_MEMORY_SCOPE_AGENT); } while (0)
#else
#define PH_STAMP(k) do {} while (0)
#endif
#define PH_SEAM(k) do { if (PH_IN(k) && PH_IN((k) + 1)) { PH_STAMP(k); xcd_barrier(bar); } } while (0)
#define PH_ENTER() do { int _t = threadIdx.x; asm volatile("" : "+v"(_t)); F.tid = _t; F.lane = _t & 63; } while (0)

#ifndef P0_DEFER
#define P0_DEFER 1
#endif
#ifndef PHASE_STAG
#define PHASE_STAG 1
#endif
#ifndef MERGE_LN
#define MERGE_LN 0
#endif
static_assert(!(MERGE_LN && LN_DROP_R), "the merged region keeps the R stream: build it with -DLN_DROP_R=0");
template <int L> __device__ __forceinline__ void merged_region(Frame& F) {
    const int gi = F.vcu >> 3, m = F.vcu & 7, sA = 2 * gi, typ = gi & 1;
    unsigned* gc = WSP(unsigned, WS_CTL) + 4096 + (L * 32 + gi) * 16; unsigned tgt = 0u;
    const int npass = typ ? 1 : 2, per = typ ? 2 : 1;
    for (int p = 0; p < npass; ++p) {
        PH_ENTER();
        { pg8::Gemm g{WSP(bf16_t, WS_MIX), WSP(bf16_t, WS_WOUT) + (size_t)L * DM * DM, MTOK, DM, DM};
          pg8::GridOrder S{sA + p, per, m, 0, 1};
          EpiOut E{WSP(bf16_t, WS_H), WSP(float, WS_MOD) + (size_t)L * NB * (3 * DM) + 2 * DM};
          run_gemm(F, g, S, E); }
        tgt += 8u; grp_barrier(WSP(unsigned, WS_CTL), gc, tgt);
        PH_ENTER();
        const int r0 = (sA + p) * 256 + m * 32 * per;
        if (L + 1 < DEPTH) p_ln_post<true>(F, L, r0, r0 + 32 * per, 8); else p_ln_post<false>(F, L, r0, r0 + 32 * per, 8);
    }
    if (L + 1 < DEPTH) {
        tgt += 8u; grp_barrier(WSP(unsigned, WS_CTL), gc, tgt);
        PH_ENTER();
        pg8::Gemm g{WSP(bf16_t, WS_H), WSP(bf16_t, WS_WIN) + (size_t)(L + 1) * NINP * DM, MTOK, NINP, DM};
        pg8::GridOrder S{sA, 2, m, 8, 2};
        EpiIn E{WSP(bf16_t, WS_U), WSP(bf16_t, WS_MIX), WSP(bf16_t, WS_CQ), WSP(bf16_t, WS_CKV), WSP(bf16_t, WS_KR), WSP(float, WS_RSQ) + (size_t)(L + 1) * MTOK * 2, WSP(float, WS_RCOS), WSP(float, WS_RSIN)};
        run_gemm(F, g, S, E);
    }
}

template <int L> __device__ __forceinline__ void layer_phases(Frame& F, const int lo, const int hi, const XcdBarrier& bar) {
    constexpr int P = 2 + 5 * L;
    float* rsq = WSP(float, WS_RSQ) + (size_t)L * MTOK * 2;
    const bool mrg = MERGE_LN && (hi - lo == N_PHASES) && F.G == 256;
    const bool defer = P0_DEFER && (hi - lo == N_PHASES) && DEPTH == 2 && L == 0, work_first = (F.bx >> 3) & 1;
    if (PH_IN(P + 0) && DIAG_EN(2) && !(mrg && L > 0)) {
        PH_ENTER();
        pg8::Gemm g{WSP(bf16_t, WS_H), WSP(bf16_t, WS_WIN) + (size_t)L * NINP * DM, MTOK, NINP, DM};
        pg8::StaticOrder S; S.init(MTOK, NINP, F.G, F.bx);
        EpiIn E{WSP(bf16_t, WS_U), WSP(bf16_t, WS_MIX), WSP(bf16_t, WS_CQ), WSP(bf16_t, WS_CKV), WSP(bf16_t, WS_KR), rsq, WSP(float, WS_RCOS), WSP(float, WS_RSIN)};
        unsigned long long ct0 = 0, cr0 = 0;
        if (PROBE_CLK == 1 && L == 0) { ct0 = __builtin_amdgcn_s_memtime(); cr0 = __builtin_amdgcn_s_memrealtime(); }
        if (defer && work_first) { p0_weights(F, 848, 2 * 848); PH_ENTER(); }
        run_gemm(F, g, S, E);
        if (defer && !work_first) { PH_ENTER(); p0_weights(F, 848, 2 * 848); }
        if (PROBE_CLK == 1 && L == 0 && F.bx == 0) { const unsigned long long ct1 = __builtin_amdgcn_s_memtime(), cr1 = __builtin_amdgcn_s_memrealtime();
            const unsigned long long mhz = (ct1 - ct0) * 100ull / (cr1 - cr0); const unsigned long long tend = cr1 + mhz * 10ull;
            while (__builtin_amdgcn_s_memrealtime() < tend) __builtin_amdgcn_s_sleep(8); }
        if (PROBE_REP == 2 && L == 0) { xcd_barrier(bar); EpiIn E2 = E; E2.rsq = WSP(float, WS_R); run_gemm(F, g, S, E2); }
        if (PROBE_REP == 12 && L == 0) { xcd_barrier(bar); EpiNone E2; run_gemm(F, g, S, E2); }
        if (PROBE_REP == 22 && L == 0) { xcd_barrier(bar); EpiNone E2; pg8::HotOrder S2; S2.init(MTOK, NINP, F.G, F.bx); S2.pm0 = 3; S2.pn0 = 2; run_gemm(F, g, S2, E2); }
        if (PROBE_REP == 32 && L == 0) { xcd_barrier(bar); EpiNone E2; pg8::HotOrder S2; S2.init(MTOK, NINP, F.G, F.bx); S2.pm0 = F.bx & 63; S2.pn0 = 2; run_gemm(F, g, S2, E2); }
    }
    if (!(mrg && L > 0)) PH_SEAM(P + 0); else PH_STAMP(P + 0);
    if (PH_IN(P + 1) && DIAG_EN(3)) {
        PH_ENTER();
        const bool fft_first = PHASE_STAG && ((F.bx >> 3) & 1);
#if IMPL_FFT & 1
        if (fft_first) { fft1_fast(F, L); PH_ENTER(); }
#endif
        if (defer && fft_first) { p0_mod(F, 384, 2 * 384); p0_wcat(F, 1, 2); PH_ENTER(); }
        { pg8::Gemm g{WSP(bf16_t, WS_CQ), WSP(bf16_t, WS_WQ) + (size_t)L * NQ * QLR, MTOK, NQ, QLR};
          pg8::SplitOrder S; S.init(F.G, F.bx, NQ / 256, 0);
          EpiQ E{WSP(bf16_t, WS_Q), rsq, WSP(float, WS_RCOS), WSP(float, WS_RSIN)};
          run_gemm(F, g, S, E); }
        { pg8::Gemm g{WSP(bf16_t, WS_CKV), WSP(bf16_t, WS_WKV) + (size_t)L * NKV * KVLR, MTOK, NKV, KVLR};
          pg8::SplitOrder S; S.init(F.G, F.bx, NKV / 256, 1);
          EpiKV E{WSP(bf16_t, WS_KV), rsq};
          run_gemm(F, g, S, E); }
        if (PROBE_REP == 3 && L == 0) { xcd_barrier(bar);
          { pg8::Gemm g{WSP(bf16_t, WS_CQ), WSP(bf16_t, WS_WQ) + (size_t)L * NQ * QLR, MTOK, NQ, QLR}; pg8::SplitOrder S; S.init(F.G, F.bx, NQ / 256, 0); EpiQ E{WSP(bf16_t, WS_Q), rsq, WSP(float, WS_RCOS), WSP(float, WS_RSIN)}; run_gemm(F, g, S, E); }
          { pg8::Gemm g{WSP(bf16_t, WS_CKV), WSP(bf16_t, WS_WKV) + (size_t)L * NKV * KVLR, MTOK, NKV, KVLR}; pg8::SplitOrder S; S.init(F.G, F.bx, NKV / 256, 1); EpiKV E{WSP(bf16_t, WS_KV), rsq}; run_gemm(F, g, S, E); } }
#if IMPL_FFT & 1
        if (!fft_first) fft1_fast(F, L);
#else
        fft1_naive(F);
#endif
        if (defer && !fft_first) { PH_ENTER(); p0_mod(F, 384, 2 * 384); p0_wcat(F, 1, 2); }
        if (PROBE_REP == 7 && L == 0) { xcd_barrier(bar); fft1_fast(F, L); }
    }
    PH_SEAM(P + 1);
#if PROBE_CHECK
    if (L == PROBE_CHECK - 1 && PH_IN(P + 2)) { PH_ENTER(); chk_proj(F, L); __syncthreads(); }
#endif
    if (PH_IN(P + 2) && DIAG_EN(4)) {
        PH_ENTER();
#ifdef PROBE_IDLE
        if (L == 0) { const unsigned long long tend = __builtin_amdgcn_s_memrealtime() + (unsigned long long)PROBE_IDLE * 100ull; while (__builtin_amdgcn_s_memrealtime() < tend) __builtin_amdgcn_s_sleep(32); }
#endif
        const bool fft2_first = PHASE_STAG && ((F.bx >> 3) & 1);
#if IMPL_FFT & 2
        if (fft2_first) { fft2_fast(F, L); PH_ENTER(); }
#endif
#if IMPL_ATTN
        unsigned long long at0 = 0, ar0 = 0;
        if (PROBE_CLK == 2 && L == 0) { at0 = __builtin_amdgcn_s_memtime(); ar0 = __builtin_amdgcn_s_memrealtime(); }
        attn_fast(F);
#if ATT_STAMP >= 0
        if (L == 0 && F.bx == 0 && F.tid == 0) { volatile LAS unsigned* mw = (volatile LAS unsigned*)(F.lds + MISC_OFF) + 16;
            const unsigned long long cyc = (unsigned long long)mw[ATT_STAMP] * 16ull / 124ull; const unsigned long long tend = __builtin_amdgcn_s_memrealtime() + cyc * 10ull;
            while (__builtin_amdgcn_s_memrealtime() < tend) __builtin_amdgcn_s_sleep(8); }
#endif
        if (PROBE_CLK == 2 && L == 0 && F.bx == 0) { const unsigned long long at1 = __builtin_amdgcn_s_memtime(), ar1 = __builtin_amdgcn_s_memrealtime();
            const unsigned long long mhz = (at1 - at0) * 100ull / (ar1 - ar0); const unsigned long long tend = ar1 + mhz * 10ull;
            while (__builtin_amdgcn_s_memrealtime() < tend) __builtin_amdgcn_s_sleep(8); }
        if (PROBE_REP == 4 && L == 0) { __syncthreads(); F.mix_off = WS_R; attn_fast<PROBE_VAR>(F); F.mix_off = WS_MIX; }
#else
        attn_naive(F);
#endif
        __syncthreads();
#if IMPL_FFT & 2
        if (!fft2_first) fft2_fast(F, L);
        if (PROBE_REP == 8 && L == 0) { __syncthreads(); F.mix_off = WS_R; fft2_fast(F, L); F.mix_off = WS_MIX; }
#else
        fft2_naive(F, L);
#endif
    }
    PH_SEAM(P + 2);
#if PROBE_CHECK
    if (L == PROBE_CHECK - 1 && PH_IN(P + 3)) { PH_ENTER(); chk_attn(F); __syncthreads(); }
#endif
    if (mrg) { PH_STAMP(P + 3); merged_region<L>(F); if (L + 1 < DEPTH) { PH_STAMP(P + 4); xcd_barrier(bar); } return; }
    if (PH_IN(P + 3) && DIAG_EN(5)) {
        PH_ENTER();
        pg8::Gemm g{WSP(bf16_t, WS_MIX), WSP(bf16_t, WS_WOUT) + (size_t)L * DM * DM, MTOK, DM, DM};
        pg8::StaticOrder S; S.init(MTOK, DM, F.G, F.bx);
        EpiOut E{(LN_DROP_R && L == 0) ? WSP(bf16_t, WS_R) : WSP(bf16_t, WS_H), WSP(float, WS_MOD) + (size_t)L * NB * (3 * DM) + 2 * DM};
        run_gemm(F, g, S, E);
        if (PROBE_REP == 5 && L == 0) { xcd_barrier(bar); run_gemm(F, g, S, E); }
        if (PROBE_REP == 15 && L == 0) { xcd_barrier(bar); EpiNone E2; run_gemm(F, g, S, E2); }
    }
    PH_SEAM(P + 3);
    if (PH_IN(P + 4) && DIAG_EN(6)) {
        PH_ENTER();
        int r0, r1; ln_rows(F, r0, r1); if (L + 1 < DEPTH) p_ln_post<true>(F, L, r0, r1, 8); else if (LN_DROP_R) p_ln_last(F, r0, r1, 8); else p_ln_post<false>(F, L, r0, r1, 8);
        if (PROBE_REP == 6 && L + 1 == DEPTH) { xcd_barrier(bar); for (int q = 0; q < PROBE_N; ++q) if (PROBE_VAR == 0 || ((F.bx >> 3) % (PROBE_VAR ? PROBE_VAR : 1)) == 0) { int q0, q1; ln_rows(F, q0, q1); p_ln_post<false>(F, L, q0, q1, 8); } }
    }
    PH_SEAM(P + 4);
}

__global__ void __launch_bounds__(NTHREADS, 2) fwd_kernel(Args args) {
    extern __shared__ __attribute__((aligned(16))) unsigned char lds[];
    Frame F;
    F.in[0] = args.in[0]; F.in[1] = args.in[1]; F.in[2] = args.in[2]; F.in[3] = args.in[3]; F.in[4] = args.in[4]; F.in[5] = args.in[5]; F.in[6] = args.in[6]; F.in[7] = args.in[7]; F.in[8] = args.in[8]; F.in[9] = args.in[9]; F.in[10] = args.in[10]; F.in[11] = args.in[11]; F.in[12] = args.in[12]; F.in[13] = args.in[13];
    F.out = args.out; F.ws = args.ws; F.lds = (LAS unsigned char*)lds; F.ldsg = (char*)lds;
    F.tid = threadIdx.x; F.lane = F.tid & 63; F.wave = __builtin_amdgcn_readfirstlane(F.tid >> 6); F.G = gridDim.x; F.bx = blockIdx.x;
    F.vcu = (F.G % 8 == 0) ? (F.bx % 8) * (F.G / 8) + F.bx / 8 : F.bx; F.mix_off = WS_MIX;
    volatile LAS unsigned* MISC = (volatile LAS unsigned*)(F.lds + MISC_OFF);
    if (F.tid < 64) MISC[F.tid] = 0u;
    __syncthreads();
    const int lo = args.ph_lo, hi = args.ph_hi;
    XcdBarrier bar; bar.bar = WSP(unsigned, WS_CTL); bar.x = 0; bar.st = MISC;
    if (hi - lo > 1) bar = xcd_barrier_post(WSP(unsigned, WS_CTL), MISC);
    const bool defer = P0_DEFER && (hi - lo == N_PHASES) && DEPTH == 2;
    if (PH_IN(0) && DIAG_EN(0)) { PH_ENTER(); const int nl = defer ? 1 : DEPTH; p0_weights(F, 0, nl * 848); p0_mod(F, 0, nl * 384); p0_tables(F); p0_wcat(F, 0, nl); }
    PH_SEAM(0);
#if XCD_REMAP
    if (PH_IN(0) && PH_IN(1) && MISC[3] == 1u) { const int rk = __builtin_amdgcn_readfirstlane((int)MISC[2]), xc = __builtin_amdgcn_readfirstlane((int)bar.x);
        if (rk < F.G / 8 && xc < 8) { F.bx = rk * 8 + xc; F.vcu = xc * (F.G / 8) + rk; } }
#endif
    if (PH_IN(1) && DIAG_EN(1)) { PH_ENTER(); int r0, r1; ln_rows(F, r0, r1); p_ln_first(F, r0, r1, 8); if (PROBE_REP == 1) { xcd_barrier(bar); p_ln_first(F, r0, r1, 8); } }
    PH_SEAM(1);
    if (PROBE_REP == 40) { for (int q = 0; q < 8; ++q) xcd_barrier(bar); }
    layer_phases<0>(F, lo, hi, bar);
    layer_phases<1>(F, lo, hi, bar);
#if PROBE_CHECK
    xcd_barrier(bar); chk_finish(F);
#endif
#if PROBE_SKEW
    PH_STAMP(N_PHASES - 1); xcd_barrier(bar);
    if (F.bx == 0 && F.tid < 64) {
        unsigned long long* stp = WSP(unsigned long long, WS_END);
        unsigned long long acc = 0, prevmx = 0;
        for (int k = 0; k < N_PHASES; ++k) {
            unsigned long long mx = 0, mn = ~0ull, sm = 0;
            for (int j = 0; j < 4; ++j) { const unsigned long long v = __hip_atomic_load(stp + k * 256 + F.tid * 4 + j, __ATOMIC_RELAXED, __HIP_MEMORY_SCOPE_AGENT); mx = v > mx ? v : mx; mn = v < mn ? v : mn; sm += v; }
            for (int o = 32; o > 0; o >>= 1) { const unsigned long long a = __shfl_xor(mx, o), b = __shfl_xor(mn, o), c = __shfl_xor(sm, o); mx = a > mx ? a : mx; mn = b < mn ? b : mn; sm += c; }
            if ((PROBE_SKEW_MASK >> k) & 1u) { if (PROBE_SKEW == 1) acc += mx - sm / 256ull; else if (PROBE_SKEW == 2) acc += mx - mn; else if (k > 0) acc += mx - prevmx; }
            prevmx = mx;
        }
        const unsigned long long tend = __builtin_amdgcn_s_memrealtime() + acc * (unsigned long long)PROBE_SKEW_MUL;
        while (__builtin_amdgcn_s_memrealtime() < tend) __builtin_amdgcn_s_sleep(8);
    }
#endif
}

extern "C" void kernel_launch(void* const* d_in, const int* in_sizes, int n_in, void* d_out, int out_size, void* d_ws, size_t ws_size, hipStream_t stream) {
    static int grid = 0;
    if (grid == 0) {
        if (n_in != 14 || in_sizes[0] != MTOK * DM || out_size != MTOK * DM || ws_size < WS_END) {
            fprintf(stderr, "kernel_launch: shape mismatch (n_in %d, in0 %d, out %d, ws %zu, need ws >= %zu); nothing launched\n", n_in, n_in > 0 ? in_sizes[0] : -1, out_size, ws_size, (size_t)WS_END); grid = -1; return; }
        int dev = 0, cus = 0, per_cu = 0;
        if (hipGetDevice(&dev) != hipSuccess || hipDeviceGetAttribute(&cus, hipDeviceAttributeMultiprocessorCount, dev) != hipSuccess) { grid = -1; return; }
        if (hipFuncSetAttribute((const void*)fwd_kernel, hipFuncAttributeMaxDynamicSharedMemorySize, LDS_BYTES) != hipSuccess) { fprintf(stderr, "kernel_launch: hipFuncSetAttribute failed\n"); grid = -1; return; }
        if (hipOccupancyMaxActiveBlocksPerMultiprocessor(&per_cu, (const void*)fwd_kernel, NTHREADS, LDS_BYTES) != hipSuccess || per_cu < 1) { fprintf(stderr, "kernel_launch: occupancy query failed (%d)\n", per_cu); (void)hipGetLastError(); per_cu = 1; }
        if (per_cu > 1) per_cu = 1;
        grid = cus * per_cu;
    }
    if (grid < 0) return;
    if (hipMemsetAsync((char*)d_ws + WS_CTL, 0, WS_RSQ - WS_CTL, stream) != hipSuccess) { fprintf(stderr, "kernel_launch: hipMemsetAsync failed\n"); return; }
    Args a{};
    for (int i = 0; i < 14; ++i) a.in[i] = (const float*)d_in[i];
    a.out = (float*)d_out; a.ws = (unsigned char*)d_ws;
#if N_LAUNCH_MODE
    a.ph_lo = 0; a.ph_hi = N_PHASES;
    hipLaunchKernelGGL(fwd_kernel, dim3(grid), dim3(NTHREADS), LDS_BYTES, stream, a);
#else
    for (int ph = 0; ph < N_PHASES; ++ph) { a.ph_lo = ph; a.ph_hi = ph + 1; hipLaunchKernelGGL(fwd_kernel, dim3(grid), dim3(NTHREADS), LDS_BYTES, stream, a); }
#endif
    const hipError_t le = hipPeekAtLastError();
    if (le != hipSuccess) fprintf(stderr, "kernel_launch: launch failed: %s (grid %d)\n", hipGetErrorName(le), grid);
}
```

```cpp
#define IMPL_GEMM 1
#define IMPL_ATTN 1
#define IMPL_FFT 3
#define N_LAUNCH_MODE 1
#include <hip/hip_runtime.h>
#include <cstdio>
#include <cstdint>

#ifndef PROBE_CHECK
#define PROBE_CHECK 0
#endif
#ifndef N_LAUNCH_MODE
#define N_LAUNCH_MODE 1
#endif
#ifndef IMPL_GEMM
#define IMPL_GEMM 1
#endif
#ifndef IMPL_ATTN
#define IMPL_ATTN 1
#endif
#ifndef IMPL_FFT
#define IMPL_FFT 3
#endif

#define LAS __attribute__((address_space(3)))
typedef unsigned short bf16_t;
typedef short bf16x8 __attribute__((ext_vector_type(8)));
typedef short s16x4 __attribute__((ext_vector_type(4)));
typedef float f32x4 __attribute__((ext_vector_type(4)));
typedef float f32x2 __attribute__((ext_vector_type(2)));
typedef float f32x16 __attribute__((ext_vector_type(16)));
typedef unsigned u32x4 __attribute__((ext_vector_type(4)));
typedef unsigned u32x2 __attribute__((ext_vector_type(2)));

constexpr int NB = 4, SEQ = 4096, DM = 2048, MTOK = NB * SEQ, DEPTH = 2;
constexpr int DF = 1024, NG = 8, GD = 128, NH = 8, DV = 128, DNOPE = 128, DROPE = 64, DQK = 192, QLR = 512, KVLR = 256;
constexpr int NIN = 3904, NINP = 4096;
constexpr int NQ = NH * DQK  , NKV = NH * (DNOPE + DV)  ;
constexpr float NORM_EPS = 1e-6f;
constexpr float DN_ALPHA = 1.4142135623730951f;
constexpr float ATT_SCALE = 0.07216878364870322f;

__device__ __forceinline__ float bf2f(bf16_t b) { return __uint_as_float(((unsigned)b) << 16); }
__device__ __forceinline__ bf16_t f2bf(float f) { unsigned u = __float_as_uint(f); u += 0x7FFFu + ((u >> 16) & 1u); return (bf16_t)(u >> 16); }
typedef __bf16 bf16v2_t __attribute__((ext_vector_type(2)));
__device__ __forceinline__ unsigned cvt_pk_bf16(float lo, float hi) { const f32x2 v = {lo, hi}; return __builtin_bit_cast(unsigned, __builtin_convertvector(v, bf16v2_t)); }
__device__ __forceinline__ float silu_f(float z) { return z * __builtin_amdgcn_rcpf(1.0f + __builtin_amdgcn_exp2f(-1.4426950408889634f * z)); }
__device__ __forceinline__ float wave_sum(float v) { for (int o = 32; o > 0; o >>= 1) v += __shfl_xor(v, o); return v; }
__device__ __forceinline__ float wave_max(float v) { for (int o = 32; o > 0; o >>= 1) v = fmaxf(v, __shfl_xor(v, o)); return v; }

constexpr size_t al256(size_t x) { return (x + 255) / 256 * 256; }
constexpr size_t WS_CTL  = 0;
constexpr size_t CTL_BYTES = 32768;
constexpr size_t WS_MOD  = WS_CTL + CTL_BYTES;
constexpr size_t WS_RSQ  = WS_MOD + al256((size_t)DEPTH * NB * 3 * DM * 4);
constexpr size_t WS_RCOS = WS_RSQ + al256((size_t)DEPTH * MTOK * 2 * 4);
constexpr size_t WS_RSIN = WS_RCOS + (size_t)MTOK * 32 * 4;
constexpr size_t WS_D1   = WS_RSIN + (size_t)MTOK * 32 * 4;
constexpr size_t WS_D2   = WS_D1 + 128 * 64 * 2;
constexpr size_t WS_WCAT = WS_D2 + 128 * 128 * 2;
constexpr size_t WS_WIN  = WS_WCAT + (size_t)DEPTH * NG * 128 * 256 * 2;
constexpr size_t WS_WOUT = WS_WIN + (size_t)DEPTH * NINP * DM * 2;
constexpr size_t WS_WQ   = WS_WOUT + (size_t)DEPTH * DM * DM * 2;
constexpr size_t WS_WKV  = WS_WQ + (size_t)DEPTH * NQ * QLR * 2;
constexpr size_t WS_H    = WS_WKV + (size_t)DEPTH * NKV * KVLR * 2;
constexpr size_t WS_U    = WS_H + (size_t)MTOK * DM * 2;
constexpr size_t WS_MIX  = WS_U + (size_t)MTOK * DF * 2;
constexpr size_t WS_CQ   = WS_MIX + (size_t)MTOK * DM * 2;
constexpr size_t WS_CKV  = WS_CQ + (size_t)MTOK * QLR * 2;
constexpr size_t WS_KR   = WS_CKV + (size_t)MTOK * KVLR * 2;
constexpr size_t WS_Q    = WS_KR + (size_t)MTOK * 64 * 2;
constexpr size_t WS_KV   = WS_Q + (size_t)MTOK * NQ * 2;
constexpr size_t WS_R    = WS_KV + (size_t)MTOK * NKV * 2;
constexpr size_t WS_END  = WS_R + (size_t)MTOK * DM * 4;
static_assert(WS_END <= (size_t)4 * MTOK * DM * 4, "workspace map exceeds 4 x largest tensor");

constexpr int RING_BYTES = 155648, MISC_OFF = RING_BYTES, LDS_BYTES = RING_BYTES + 256;
constexpr int NTHREADS = 512;

namespace pg8 {
#define PG8_LAS __attribute__((address_space(3)))
constexpr int BM = 256, BK = 64, HALF = 128, HTB = HALF * BK * 2  , STAGE_BYTES = 8 * HTB, NXCD = 8, WGM = 8;
static_assert(STAGE_BYTES <= RING_BYTES, "GEMM stage ring must fit the LDS phase scratch");

__host__ __device__ __forceinline__ int lds_byte(int r, int c) { const int st = (r >> 4) * 2 + (c >> 5), rr = r & 15, cc = c & 31, ob = rr * 64 + cc * 2; return st * 1024 + (ob ^ (((ob >> 9) & 1) << 5)); }
__host__ __device__ __forceinline__ void stage_rc(int b, int& R, int& C) { const int st = b / 1024, sb = b % 1024, swz = sb ^ (((sb >> 9) & 1) << 5); R = (st >> 1) * 16 + swz / 64; C = (st & 1) * 32 + (swz % 64) / 2; }
__host__ __device__ __forceinline__ int perm32(int rho) { const int n = rho >> 4, i = rho & 15; return 8 * (i >> 2) + 4 * n + (i & 3); }

struct Unit { int pm, pn; };
struct Gemm { const bf16_t* A; const bf16_t* Bt; int M, N, K; };

struct StaticOrder {
    int nM, nN, nwg, G, c;
    __host__ __device__ void init(int M, int N, int G_, int c_) { nM = M / BM; nN = N / BM; nwg = nM * nN; G = G_; c = c_; }
    __host__ __device__ bool next(int i, Unit& u) const {
        const long L = (long)i * G + c; if (L >= nwg) return false;
        int wgid = (int)L; { const int q = nwg / NXCD, r = nwg % NXCD, xcd = wgid % NXCD, off = wgid / NXCD; wgid = (xcd < r ? xcd * (q + 1) : r * (q + 1) + (xcd - r) * q) + off; }
        const int nig = WGM * nN, gid = wgid / nig, fm = gid * WGM, gsz = (nM - fm) < WGM ? (nM - fm) : WGM;
        u.pm = fm + ((wgid % nig) % gsz); u.pn = (wgid % nig) / gsz; return true;
    }
    __device__ __forceinline__ void a_ready(const Unit&) const {}
    __device__ __forceinline__ void done(const Unit&) const {}
};
struct HotOrder : StaticOrder { int pm0, pn0; __device__ bool next(int i, Unit& u) const { Unit t; if (!StaticOrder::next(i, t)) return false; u.pm = pm0; u.pn = pn0; return true; } };
struct SplitOrder {
    int G, c, nN, kind;
    __device__ void init(int G_, int c_, int nN_, int kind_) { G = G_; c = c_; nN = nN_; kind = kind_; }
    __device__ bool next(int i, Unit& u) const {
        if (G != 256) { const int L = i * G + c; if (L >= 64 * nN) return false; u.pm = L / nN; u.pn = L % nN; return true; }
        const int x = c & 7, v = c >> 3; int li;
        if (kind == 0) { if (v < 16) { if (i >= 2) return false; li = 2 * v + i; } else { if (i >= 1) return false; li = 32 + (v - 16); } }
        else           { if (v < 16) { if (i >= 1) return false; li = v; } else { if (i >= 3) return false; li = 16 + 3 * (v - 16) + i; } }
        u.pm = 8 * x + li / nN; u.pn = li % nN; return true;
    }
    __device__ __forceinline__ void a_ready(const Unit&) const {}
    __device__ __forceinline__ void done(const Unit&) const {}
};
struct GridOrder {
    int pm0, npm, pn0, pnstep, npn;
    __device__ bool next(int i, Unit& u) const { if (i >= npm * npn) return false; u.pm = pm0 + i / npn; u.pn = pn0 + (i % npn) * pnstep; return true; }
    __device__ __forceinline__ void a_ready(const Unit&) const {}
    __device__ __forceinline__ void done(const Unit&) const {}
};
template <class Epi, class Sched, bool ALIGN_EPI = false, bool SP2 = false>
__device__ __forceinline__ void gemm_phase(PG8_LAS unsigned char* lds, const Gemm g, const Sched& S, const Epi& E, const int tid) {
    const int wid = __builtin_amdgcn_readfirstlane(tid >> 6), lane = tid & 63, wr = wid >> 2, wc = wid & 3, fr = lane & 15, fq = lane >> 4;
    const int K = g.K, nt = K / BK;
    unsigned voffA[2], voffB[2];
#pragma unroll
    for (int i = 0; i < 2; ++i) { int R, C; stage_rc(tid * 16 + i * 8192, R, C); const int Rb = Epi::PERM ? ((R & ~31) + perm32(R & 31)) : R;
        voffA[i] = (unsigned)(R * K + C) * 2u; voffB[i] = (unsigned)(Rb * K + C) * 2u; }
    const size_t kstep = (size_t)(BK * 2);
    const size_t hstep = (size_t)HALF * K * 2;
    const size_t tstep = 2 * hstep;
    const unsigned ldsw = (unsigned)wid * 1024u;
    const int aoff = lds_byte(wr * 64 + fr, fq * 8), boff = lds_byte(wc * 32 + fr, fq * 8);
#define PG8_SA(b, h) (((b) * 2 + (h)) * HTB)
#define PG8_SB(b, h) ((4 + (b) * 2 + (h)) * HTB)
#define PG8_STAGE(bufoff, gbase, voff) do { _Pragma("unroll") for (int _i = 0; _i < 2; ++_i) \
        __builtin_amdgcn_global_load_lds((const unsigned*)((const char*)(gbase) + (voff)[_i]), (PG8_LAS unsigned*)(lds + (bufoff) + ldsw + _i * 8192), 16, 0, 0); } while (0)
#define PG8_LDA(dst, b, h) do { _Pragma("unroll") for (int m = 0; m < 4; ++m) _Pragma("unroll") for (int k = 0; k < 2; ++k) dst[m][k] = *(const PG8_LAS bf16x8*)(lds + PG8_SA(b, h) + aoff + m * 2048 + k * 1024); } while (0)
#define PG8_LDB(dst, b, h) do { _Pragma("unroll") for (int n = 0; n < 2; ++n) _Pragma("unroll") for (int k = 0; k < 2; ++k) dst[n][k] = *(const PG8_LAS bf16x8*)(lds + PG8_SB(b, h) + boff + n * 2048 + k * 1024); } while (0)
#define PG8_MMA(ai, bj, At, Bt) do { if (!(skipm & (1 << (bj)))) { __builtin_amdgcn_s_setprio(1); _Pragma("unroll") for (int m = 0; m < 4; ++m) _Pragma("unroll") for (int n = 0; n < 2; ++n) _Pragma("unroll") for (int k = 0; k < 2; ++k) \
        acc[ai][bj][m][n] = __builtin_amdgcn_mfma_f32_16x16x32_bf16(Bt[n][k], At[m][k], acc[ai][bj][m][n], 0, 0, 0); __builtin_amdgcn_s_setprio(0); } } while (0)
#define PG8_WAIT_V(n) asm volatile("s_waitcnt vmcnt(" #n ")" ::: "memory")
#define PG8_WAIT_L(n) asm volatile("s_waitcnt lgkmcnt(" #n ")" ::: "memory")
#define PG8_BAR __builtin_amdgcn_s_barrier()
#define PG8_SCHED __builtin_amdgcn_sched_barrier(0)
    Unit cur, nxt; int ui = 0;
    if (!S.next(0, cur)) return;
    int skipm = Epi::mma_skip(cur.pn, wc);
    f32x4 acc[2][2][4][2];
#pragma unroll
    for (int a = 0; a < 2; ++a)
#pragma unroll
        for (int b = 0; b < 2; ++b)
#pragma unroll
            for (int m = 0; m < 4; ++m)
#pragma unroll
                for (int n = 0; n < 2; ++n) acc[a][b][m][n] = (f32x4){0.f, 0.f, 0.f, 0.f};
    bf16x8 At[4][2], B0[2][2], B1[2][2];
    const char* cA = (const char*)g.A + (size_t)cur.pm * tstep; const char* cB = (const char*)g.Bt + (size_t)cur.pn * tstep;
    S.a_ready(cur);
    if constexpr (SP2) {
        PG8_STAGE(PG8_SB(0, 0), cB, voffB); PG8_STAGE(PG8_SB(0, 1), cB + hstep, voffB); PG8_STAGE(PG8_SA(0, 0), cA, voffA); PG8_STAGE(PG8_SA(0, 1), cA + hstep, voffA);
        if (wr == 1) PG8_BAR;
        PG8_WAIT_V(2); PG8_BAR;
        PG8_STAGE(PG8_SB(1, 0), cB + kstep, voffB); PG8_STAGE(PG8_SA(1, 0), cA + kstep, voffA); PG8_STAGE(PG8_SB(1, 1), cB + hstep + kstep, voffB);
        PG8_WAIT_V(6); PG8_BAR;
    } else {
        PG8_STAGE(PG8_SB(0, 0), cB, voffB); PG8_STAGE(PG8_SA(0, 0), cA, voffA); PG8_STAGE(PG8_SB(0, 1), cB + hstep, voffB); PG8_STAGE(PG8_SA(0, 1), cA + hstep, voffA);
        if (wr == 1) PG8_BAR;
        PG8_WAIT_V(4); PG8_BAR;
        PG8_STAGE(PG8_SB(1, 0), cB + kstep, voffB); PG8_STAGE(PG8_SA(1, 0), cA + kstep, voffA); PG8_STAGE(PG8_SB(1, 1), cB + hstep + kstep, voffB);
        PG8_WAIT_V(6); PG8_BAR;
    }
    for (;;) {
        const bool has_next = S.next(ui + 1, nxt);
        const char* nA = has_next ? (const char*)g.A + (size_t)nxt.pm * tstep : cA; const char* nB = has_next ? (const char*)g.Bt + (size_t)nxt.pn * tstep : cB;
        for (int t = 0; t < nt; t += 2) {
            const bool last = (t == nt - 2);
            const char* a1 = cA + (size_t)(t + 1) * kstep;
            const char* a2 = last ? nA : cA + (size_t)(t + 2) * kstep; const char* b2 = last ? nB : cB + (size_t)(t + 2) * kstep;
            const char* a3 = a2 + kstep; const char* b3 = b2 + kstep;
            if (last && has_next) S.a_ready(nxt);
            if constexpr (SP2) {
            PG8_LDB(B0, 0, 0); PG8_LDB(B1, 0, 1); PG8_SCHED; PG8_LDA(At, 0, 0); PG8_STAGE(PG8_SA(1, 1), a1 + hstep, voffA);
            PG8_WAIT_V(8); PG8_WAIT_L(0); PG8_BAR; PG8_MMA(0, 0, At, B0); PG8_MMA(0, 1, At, B1); PG8_BAR; PG8_SCHED;
            PG8_LDA(At, 0, 1); PG8_STAGE(PG8_SB(0, 0), b2, voffB); PG8_STAGE(PG8_SB(0, 1), b2 + hstep, voffB); PG8_STAGE(PG8_SA(0, 0), a2, voffA);
            PG8_WAIT_V(8); PG8_WAIT_L(0); PG8_BAR; PG8_MMA(1, 0, At, B0); PG8_MMA(1, 1, At, B1); PG8_BAR; PG8_SCHED;
            PG8_LDB(B0, 1, 0); PG8_LDB(B1, 1, 1); PG8_SCHED; PG8_LDA(At, 1, 0); PG8_STAGE(PG8_SA(0, 1), a2 + hstep, voffA);
            PG8_WAIT_V(8); PG8_WAIT_L(0); PG8_BAR; PG8_MMA(0, 0, At, B0); PG8_MMA(0, 1, At, B1); PG8_BAR; PG8_SCHED;
            PG8_LDA(At, 1, 1); PG8_STAGE(PG8_SB(1, 0), b3, voffB); PG8_STAGE(PG8_SB(1, 1), b3 + hstep, voffB); PG8_STAGE(PG8_SA(1, 0), a3, voffA);
            PG8_WAIT_V(8); PG8_WAIT_L(0); PG8_BAR; PG8_MMA(1, 0, At, B0); PG8_MMA(1, 1, At, B1); PG8_BAR; PG8_SCHED;
            } else {
            PG8_LDB(B0, 0, 0); PG8_SCHED; PG8_LDA(At, 0, 0); PG8_STAGE(PG8_SA(1, 1), a1 + hstep, voffA);
            PG8_WAIT_L(8); PG8_BAR; PG8_WAIT_L(0); PG8_MMA(0, 0, At, B0); PG8_BAR; PG8_SCHED;
            PG8_LDB(B1, 0, 1); PG8_STAGE(PG8_SB(0, 0), b2, voffB);
            PG8_BAR; PG8_WAIT_L(0); PG8_MMA(0, 1, At, B1); PG8_BAR;
            PG8_LDA(At, 0, 1); PG8_STAGE(PG8_SA(0, 0), a2, voffA);
            PG8_BAR; PG8_WAIT_L(0); PG8_MMA(1, 0, At, B0); PG8_BAR; PG8_SCHED;
            PG8_STAGE(PG8_SB(0, 1), b2 + hstep, voffB);
            PG8_WAIT_V(6); PG8_BAR; PG8_MMA(1, 1, At, B1); PG8_BAR;
            PG8_LDB(B0, 1, 0); PG8_SCHED; PG8_LDA(At, 1, 0); PG8_STAGE(PG8_SA(0, 1), a2 + hstep, voffA);
            PG8_WAIT_L(8); PG8_BAR; PG8_WAIT_L(0); PG8_MMA(0, 0, At, B0); PG8_BAR; PG8_SCHED;
            PG8_LDB(B1, 1, 1); PG8_STAGE(PG8_SB(1, 0), b3, voffB);
            PG8_BAR; PG8_WAIT_L(0); PG8_MMA(0, 1, At, B1); PG8_BAR;
            PG8_LDA(At, 1, 1); PG8_STAGE(PG8_SA(1, 0), a3, voffA);
            PG8_BAR; PG8_WAIT_L(0); PG8_MMA(1, 0, At, B0); PG8_BAR; PG8_SCHED;
            PG8_STAGE(PG8_SB(1, 1), b3 + hstep, voffB);
            PG8_WAIT_V(6); PG8_BAR; PG8_MMA(1, 1, At, B1); PG8_BAR;
            }
        }
        if constexpr (ALIGN_EPI) { if (wr == 0) PG8_BAR; }
        if constexpr (!Epi::AFTER_DRAIN) { E(acc, cur, wr, wc, fr, fq); S.done(cur); }
        if (!has_next) break;
#pragma unroll
        for (int a = 0; a < 2; ++a)
#pragma unroll
            for (int b = 0; b < 2; ++b)
#pragma unroll
                for (int m = 0; m < 4; ++m)
#pragma unroll
                    for (int n = 0; n < 2; ++n) acc[a][b][m][n] = (f32x4){0.f, 0.f, 0.f, 0.f};
        cur = nxt; cA = nA; cB = nB; ++ui; skipm = Epi::mma_skip(cur.pn, wc);
        if constexpr (ALIGN_EPI) { if (wr == 1) PG8_BAR; }
    }
    PG8_WAIT_V(0);
    if constexpr (!ALIGN_EPI) { if (wr == 0) PG8_BAR; }
    PG8_BAR;
    if constexpr (Epi::AFTER_DRAIN) { E.fused(acc, cur, wr, wc, fr, fq, lds, wid, lane); S.done(cur); }
#undef PG8_SA
#undef PG8_SB
#undef PG8_STAGE
#undef PG8_LDA
#undef PG8_LDB
#undef PG8_MMA
#undef PG8_WAIT_V
#undef PG8_WAIT_L
#undef PG8_BAR
#undef PG8_SCHED
}

template <class Epi, class Sched>
__device__ __forceinline__ void gemm_phase_naive(const Gemm g, const Sched& S, const Epi& E, const int tid) {
    const int wid = __builtin_amdgcn_readfirstlane(tid >> 6), lane = tid & 63, wr = wid >> 2, wc = wid & 3, fr = lane & 15, fq = lane >> 4;
    const int K = g.K;
    Unit cur;
    for (int ui = 0; S.next(ui, cur); ++ui) {
        f32x4 acc[2][2][4][2];
#pragma unroll
        for (int ai = 0; ai < 2; ++ai)
#pragma unroll
            for (int m = 0; m < 4; ++m) {
                const bf16_t* arow = g.A + (size_t)(cur.pm * BM + ai * HALF + wr * 64 + m * 16 + fr) * K;
#pragma unroll
                for (int bj = 0; bj < 2; ++bj)
#pragma unroll
                    for (int n = 0; n < 2; ++n) {
                        const int col = cur.pn * BM + bj * HALF + wc * 32 + (Epi::PERM ? (8 * fq + 4 * n) : (16 * n + 4 * fq));
                        const bf16_t* brow = g.Bt + (size_t)col * K;
                        float s0 = 0.f, s1 = 0.f, s2 = 0.f, s3 = 0.f;
#pragma unroll 1
                        for (int k = 0; k < K; k += 8) {
                            const bf16x8 av = *(const bf16x8*)(arow + k);
                            const bf16x8 b0 = *(const bf16x8*)(brow + k), b1 = *(const bf16x8*)(brow + K + k), b2 = *(const bf16x8*)(brow + 2 * K + k), b3 = *(const bf16x8*)(brow + 3 * K + k);
#pragma unroll
                            for (int e = 0; e < 8; ++e) { const float a = bf2f((bf16_t)av[e]);
                                s0 += a * bf2f((bf16_t)b0[e]); s1 += a * bf2f((bf16_t)b1[e]); s2 += a * bf2f((bf16_t)b2[e]); s3 += a * bf2f((bf16_t)b3[e]); }
                        }
                        acc[ai][bj][m][n] = (f32x4){s0, s1, s2, s3};
                    }
            }
        E(acc, cur, wr, wc, fr, fq);
    }
}
}
#ifndef PG8_SP2
#define PG8_SP2 true
#endif
#ifndef PG8_ALIGN
#define PG8_ALIGN true
#endif
typedef f32x4 AccT[2][2][4][2];

#ifndef EPI_NT
#define EPI_NT 0
#endif
__device__ __forceinline__ void store8_bf16(bf16_t* p, f32x4 v0, f32x4 v1) {
    u32x4 w; w.x = cvt_pk_bf16(v0[0], v0[1]); w.y = cvt_pk_bf16(v0[2], v0[3]); w.z = cvt_pk_bf16(v1[0], v1[1]); w.w = cvt_pk_bf16(v1[2], v1[3]); *(u32x4*)p = w;
}
__device__ __forceinline__ void store4_bf16(bf16_t* p, f32x4 v) { u32x2 w; w.x = cvt_pk_bf16(v[0], v[1]); w.y = cvt_pk_bf16(v[2], v[3]); *(u32x2*)p = w; }
__device__ __forceinline__ void estore8_bf16(bf16_t* p, f32x4 v0, f32x4 v1) {
    u32x4 w; w.x = cvt_pk_bf16(v0[0], v0[1]); w.y = cvt_pk_bf16(v0[2], v0[3]); w.z = cvt_pk_bf16(v1[0], v1[1]); w.w = cvt_pk_bf16(v1[2], v1[3]);
    if (EPI_NT) __builtin_nontemporal_store(w, (u32x4*)p); else *(u32x4*)p = w;
}
__device__ __forceinline__ void estore4_bf16(bf16_t* p, f32x4 v) { u32x2 w; w.x = cvt_pk_bf16(v[0], v[1]); w.y = cvt_pk_bf16(v[2], v[3]); if (EPI_NT) __builtin_nontemporal_store(w, (u32x2*)p); else *(u32x2*)p = w; }
__device__ __forceinline__ f32x4 silu4(f32x4 v) { return (f32x4){silu_f(v[0]), silu_f(v[1]), silu_f(v[2]), silu_f(v[3])}; }
__device__ __forceinline__ float sq4(f32x4 v) { return (v[0] * v[0] + v[1] * v[1]) + (v[2] * v[2] + v[3] * v[3]); }

#ifndef GATE_IN_EPI
#define GATE_IN_EPI 1
#endif
struct EpiIn {
    static constexpr bool PERM = true, AFTER_DRAIN = false;
    static __device__ __forceinline__ int mma_skip(int pn, int wc) { return pn == 11 ? (wc >= 2 ? 3 : 2) : 0; }
    bf16_t* U; bf16_t* MIX; bf16_t* CQ; bf16_t* CKV; bf16_t* KR; float* rsq; const float* rcos; const float* rsin;
    template <int ACT> __device__ __forceinline__ void plain(const AccT& acc, bf16_t* base, int ldc, int row0, int col0) const {
#pragma unroll
        for (int ai = 0; ai < 2; ++ai)
#pragma unroll
            for (int m = 0; m < 4; ++m) { bf16_t* rowp = base + (size_t)(row0 + ai * 128 + m * 16) * ldc + col0;
#pragma unroll
                for (int bj = 0; bj < 2; ++bj) { f32x4 v0 = acc[ai][bj][m][0], v1 = acc[ai][bj][m][1]; if (ACT) { v0 = silu4(v0); v1 = silu4(v1); } estore8_bf16(rowp + bj * 128, v0, v1); } }
    }
    __device__ __forceinline__ void sumsq(const AccT& acc, int row0, int which, int fq) const {
#pragma unroll
        for (int ai = 0; ai < 2; ++ai)
#pragma unroll
            for (int m = 0; m < 4; ++m) { float s = (sq4(acc[ai][0][m][0]) + sq4(acc[ai][0][m][1])) + (sq4(acc[ai][1][m][0]) + sq4(acc[ai][1][m][1]));
                s += __shfl_xor(s, 16); s += __shfl_xor(s, 32);
                if (fq == 0) atomicAdd(rsq + (size_t)(row0 + ai * 128 + m * 16) * 2 + which, s); }
    }
    __device__ __forceinline__ void operator()(const AccT& acc, const pg8::Unit& u, int wr, int wc, int fr, int fq) const {
        const int row0 = u.pm * 256 + wr * 64 + fr, pn = u.pn, cw = wc * 32 + 8 * fq;
        if (pn < 4) plain<0>(acc, U, DF, row0, pn * 256 + cw);
        else if (pn < 8) plain<GATE_IN_EPI>(acc, MIX, DM, row0, (pn - 4) * 256 + cw);
        else if (pn < 10) { plain<0>(acc, CQ, QLR, row0, (pn - 8) * 256 + cw); sumsq(acc, row0, 0, fq); }
        else if (pn == 10) { plain<0>(acc, CKV, KVLR, row0, cw); sumsq(acc, row0, 1, fq); }
        else if (pn == 11) {
            if (wc < 2) { const int i0 = 16 * wc + 4 * fq;
#pragma unroll
                for (int ai = 0; ai < 2; ++ai) {
                    f32x4 cc[4], ss[4];
#pragma unroll
                    for (int m = 0; m < 4; ++m) { const size_t row = (size_t)(row0 + ai * 128 + m * 16); cc[m] = *(const f32x4*)(rcos + row * 32 + i0); ss[m] = *(const f32x4*)(rsin + row * 32 + i0); }
#pragma unroll
                    for (int m = 0; m < 4; ++m) { const size_t row = (size_t)(row0 + ai * 128 + m * 16);
                        const f32x4 c = cc[m], s = ss[m], x1 = acc[ai][0][m][0], x2 = acc[ai][0][m][1];
                        estore4_bf16(KR + row * 64 + i0, x1 * c - x2 * s); estore4_bf16(KR + row * 64 + 32 + i0, x2 * c + x1 * s); } } }
        }
        else plain<GATE_IN_EPI>(acc, MIX, DM, row0, DF + (pn - 12) * 256 + cw);
    }
};
struct EpiQ {
    static constexpr bool PERM = true, AFTER_DRAIN = false;
    static __device__ __forceinline__ int mma_skip(int, int) { return 0; }
    bf16_t* Q; const float* rsq; const float* rcos; const float* rsin;
    __device__ __forceinline__ void operator()(const AccT& acc, const pg8::Unit& u, int wr, int wc, int fr, int fq) const {
        const int row0 = u.pm * 256 + wr * 64 + fr;
        float rsv[2][4];
        const int G0 = u.pn * 8 + wc, g60 = G0 % 6, g61 = (G0 + 4) % 6, ropeg = g60 >= 4 ? g60 : g61;
        const bool has_rope = g60 >= 4 || g61 >= 4; const int ri0 = 16 * (ropeg - 4) + 4 * fq;
#pragma unroll
        for (int ai = 0; ai < 2; ++ai)
#pragma unroll
            for (int m = 0; m < 4; ++m) rsv[ai][m] = rsq[(size_t)(row0 + ai * 128 + m * 16) * 2 + 0];
#pragma unroll
        for (int ai = 0; ai < 2; ++ai) {
            f32x4 cc[4], ss[4];
            if (has_rope) {
#pragma unroll
                for (int m = 0; m < 4; ++m) { const size_t row = (size_t)(row0 + ai * 128 + m * 16); cc[m] = *(const f32x4*)(rcos + row * 32 + ri0); ss[m] = *(const f32x4*)(rsin + row * 32 + ri0); } }
#pragma unroll
            for (int m = 0; m < 4; ++m) { const size_t row = (size_t)(row0 + ai * 128 + m * 16);
                const float rs = rsqrtf(rsv[ai][m] * (1.0f / QLR) + NORM_EPS);
#pragma unroll
                for (int bj = 0; bj < 2; ++bj) { const int G = u.pn * 8 + bj * 4 + wc, head = G / 6, g6 = G - head * 6;
                    const f32x4 v0 = acc[ai][bj][m][0] * rs, v1 = acc[ai][bj][m][1] * rs;
                    if (g6 < 4) estore8_bf16(Q + row * NQ + head * DQK + g6 * 32 + 8 * fq, v0, v1);
                    else { const int i0 = 16 * (g6 - 4) + 4 * fq; const f32x4 c = cc[m], s = ss[m];

#if defined(PROBE_NEG) && PROBE_NEG == 1
                        estore4_bf16(Q + row * NQ + head * DQK + 128 + i0, v0 * c + v1 * s); estore4_bf16(Q + row * NQ + head * DQK + 160 + i0, v1 * c - v0 * s);
#else
                        estore4_bf16(Q + row * NQ + head * DQK + 128 + i0, v0 * c - v1 * s); estore4_bf16(Q + row * NQ + head * DQK + 160 + i0, v1 * c + v0 * s);
#endif
                    } } } }
    }
};
struct EpiKV {
    static constexpr bool PERM = true, AFTER_DRAIN = false;
    static __device__ __forceinline__ int mma_skip(int, int) { return 0; }
    bf16_t* KV; const float* rsq;
    __device__ __forceinline__ void operator()(const AccT& acc, const pg8::Unit& u, int wr, int wc, int fr, int fq) const {
        const int row0 = u.pm * 256 + wr * 64 + fr, col0 = u.pn * 256 + wc * 32 + 8 * fq;
        float rsv[2][4];
#pragma unroll
        for (int ai = 0; ai < 2; ++ai)
#pragma unroll
            for (int m = 0; m < 4; ++m) rsv[ai][m] = rsq[(size_t)(row0 + ai * 128 + m * 16) * 2 + 1];
#pragma unroll
        for (int ai = 0; ai < 2; ++ai)
#pragma unroll
            for (int m = 0; m < 4; ++m) { const size_t row = (size_t)(row0 + ai * 128 + m * 16);
                const float rs = rsqrtf(rsv[ai][m] * (1.0f / KVLR) + NORM_EPS);
#pragma unroll
                for (int bj = 0; bj < 2; ++bj) estore8_bf16(KV + row * NKV + col0 + bj * 128, acc[ai][bj][m][0] * rs, acc[ai][bj][m][1] * rs); }
    }
};
struct EpiOut {
    static constexpr bool PERM = true, AFTER_DRAIN = false;
    static __device__ __forceinline__ int mma_skip(int, int) { return 0; }
    bf16_t* GY; const float* gate;
    __device__ __forceinline__ void operator()(const AccT& acc, const pg8::Unit& u, int wr, int wc, int fr, int fq) const {
        const int row0 = u.pm * 256 + wr * 64 + fr, col0 = u.pn * 256 + wc * 32 + 8 * fq;
        const float* gp = gate + (size_t)(u.pm >> 4) * (3 * DM) + col0;
        f32x4 gv[2][2];
#pragma unroll
        for (int bj = 0; bj < 2; ++bj)
#pragma unroll
            for (int n = 0; n < 2; ++n) gv[bj][n] = *(const f32x4*)(gp + bj * 128 + n * 4);
#pragma unroll
        for (int ai = 0; ai < 2; ++ai)
#pragma unroll
            for (int m = 0; m < 4; ++m) { bf16_t* rowp = GY + (size_t)(row0 + ai * 128 + m * 16) * DM + col0;
#pragma unroll
                for (int bj = 0; bj < 2; ++bj) estore8_bf16(rowp + bj * 128, gv[bj][0] * acc[ai][bj][m][0], gv[bj][1] * acc[ai][bj][m][1]); }
    }
};

struct EpiNone {
    static constexpr bool PERM = true, AFTER_DRAIN = false;
    static __device__ __forceinline__ int mma_skip(int, int) { return 0; }
    __device__ __forceinline__ void operator()(const AccT& acc, const pg8::Unit& u, int wr, int wc, int fr, int fq) const {
#pragma unroll
        for (int ai = 0; ai < 2; ++ai)
#pragma unroll
            for (int bj = 0; bj < 2; ++bj)
#pragma unroll
                for (int m = 0; m < 4; ++m)
#pragma unroll
                    for (int n = 0; n < 2; ++n) asm volatile("" :: "v"(acc[ai][bj][m][n]));
    }
};
#define XB_TMO      128
#define XB_XCNT(j)  (256  + 64 * (j))
#define XB_XSUB(j)  (1280 + 64 * (j))
#define XB_XGEN(j)  (2304 + 64 * (j))
#define XB_TOP      3328
#define XB_TOPGEN   3392
#define XCD_BAR_WORDS 3456
#define XB_SPIN_CAP (1u << 22)
static_assert(XCD_BAR_WORDS * 4 <= CTL_BYTES, "barrier words must fit the control region");
__device__ __forceinline__ unsigned xb_ld(unsigned* p)              { return __hip_atomic_load(p, __ATOMIC_RELAXED, __HIP_MEMORY_SCOPE_AGENT); }
__device__ __forceinline__ unsigned xb_add(unsigned* p, unsigned v) { return __hip_atomic_fetch_add(p, v, __ATOMIC_RELAXED, __HIP_MEMORY_SCOPE_AGENT); }
__device__ __forceinline__ unsigned xb_xcc_id() { return (unsigned)__builtin_amdgcn_s_getreg((3 << 11) | 20) & 0xFu; }
#define XB_SPIN(cond, bar) do { unsigned _sp = 0; while (cond) { __builtin_amdgcn_s_sleep(1); \
    if ((++_sp & 255u) == 0u) { if (xb_ld(&(bar)[XB_TMO])) break; if (_sp > XB_SPIN_CAP) { atomicAdd(&(bar)[XB_TMO], 1u); break; } } } } while (0)
struct XcdBarrier { unsigned* bar; unsigned x; volatile LAS unsigned* st; };
__device__ __forceinline__ XcdBarrier xcd_barrier_post(unsigned* bar, volatile LAS unsigned* st) {
    XcdBarrier b; b.bar = bar; b.x = xb_xcc_id(); b.st = st;
    if (threadIdx.x == 0) st[2] = xb_add(&bar[XB_XCNT(b.x)], 1u);
    return b;
}
__device__ __forceinline__ void xcd_barrier_complete(unsigned* bar, unsigned x, unsigned& nloc, unsigned& nx, unsigned& even) {
    const unsigned G = gridDim.x * gridDim.y * gridDim.z;
    unsigned sum, cnt, mine, sp = 0u;
    for (;;) {
        sum = 0u; cnt = 0u; mine = 0u; even = 1u;
#pragma unroll
        for (unsigned j = 0; j < 16; ++j) { const unsigned c = xb_ld(&bar[XB_XCNT(j)]); sum += c; cnt += (c > 0u) ? 1u : 0u; mine = (j == x) ? c : mine; if (c != (j < 8u ? G / 8u : 0u)) even = 0u; }
        if (sum == G) break;
        __builtin_amdgcn_s_sleep(1);
        if ((++sp & 255u) == 0u) { if (xb_ld(&bar[XB_TMO])) break; if (sp > XB_SPIN_CAP) { atomicAdd(&bar[XB_TMO], 1u); break; } }
    }
    nloc = mine > 0u ? mine : 1u; nx = cnt > 0u ? cnt : 1u;
}
__device__ __forceinline__ void xcd_barrier(const XcdBarrier& b) {
    asm volatile("s_waitcnt vmcnt(0)" ::: "memory");
    __syncthreads();
    if (threadIdx.x == 0) {
        unsigned* bar = b.bar;
        __builtin_amdgcn_s_waitcnt(0);
        unsigned nloc = b.st[0], nx = b.st[1];
        if (nloc == 0u) { unsigned even; xcd_barrier_complete(bar, b.x, nloc, nx, even); b.st[0] = nloc; b.st[1] = nx; b.st[3] = (even && (gridDim.x % 8u) == 0u) ? 1u : 2u; }
        const unsigned old = xb_add(&bar[XB_XSUB(b.x)], 1u);
        const unsigned gen = old / nloc;
        if (old + 1u == (gen + 1u) * nloc) {
            __builtin_amdgcn_fence(__ATOMIC_RELEASE, "agent");
            asm volatile("s_waitcnt vmcnt(0)" ::: "memory");
            const unsigned og = xb_add(&bar[XB_TOP], 1u);
            const unsigned tg = og / nx;
            if (og + 1u == (tg + 1u) * nx) xb_add(&bar[XB_TOPGEN], 1u);
            else XB_SPIN(xb_ld(&bar[XB_TOPGEN]) == tg, bar);
            __builtin_amdgcn_fence(__ATOMIC_ACQUIRE, "agent");
            xb_add(&bar[XB_XGEN(b.x)], 1u);
            asm volatile("s_waitcnt vmcnt(0)" ::: "memory");
        } else {
            XB_SPIN(xb_ld(&bar[XB_XGEN(b.x)]) == gen, bar);
            __builtin_amdgcn_fence(__ATOMIC_ACQUIRE, "agent");
            asm volatile("s_waitcnt vmcnt(0)" ::: "memory");
        }
    }
    __syncthreads();
}
__device__ __forceinline__ void grp_barrier(unsigned* bar, unsigned* cnt, unsigned target) {
    asm volatile("s_waitcnt vmcnt(0)" ::: "memory");
    __syncthreads();
    if (threadIdx.x == 0) {
        __builtin_amdgcn_fence(__ATOMIC_RELEASE, "agent");
        asm volatile("s_waitcnt vmcnt(0)" ::: "memory");
        xb_add(cnt, 1u);
        XB_SPIN(xb_ld(cnt) < target, bar);
        __builtin_amdgcn_fence(__ATOMIC_ACQUIRE, "agent");
        asm volatile("s_waitcnt vmcnt(0)" ::: "memory");
    }
    __syncthreads();
}
struct Frame {
    const float* in[14]; float* out; unsigned char* ws;
    LAS unsigned char* lds; char* ldsg;
    int tid, lane, wave, G, bx, vcu; size_t mix_off;
};
#define WSP(T, off) ((T*)(F.ws + (off)))

__device__ __forceinline__ int src_in(int n) {
    if (n < 2816) return n;
    if (n < 3072) { const int c = n - 2816, bj = c >> 7, wc = (c >> 5) & 3, c32 = c & 31; if (bj || wc >= 2) return -1;
        const int fq = c32 >> 3, nn = (c32 >> 2) & 1, j = c32 & 3; return 2816 + 32 * nn + 16 * wc + 4 * fq + j; }
    return n - 192;
}
__device__ __forceinline__ int src_q(int n) {
    const int G = n >> 5, c32 = n & 31, head = G / 6, g6 = G - head * 6;
    if (g6 < 4) return head * DQK + g6 * 32 + c32;
    const int fq = c32 >> 3, nn = (c32 >> 2) & 1, j = c32 & 3; return head * DQK + 128 + 32 * nn + 16 * (g6 - 4) + 4 * fq + j;
}
struct WItem { const float* W; const float* ksc; bf16_t* Bt; int Nsrc, K, n0, k0, src; };
__device__ __forceinline__ WItem w_decode(const Frame& F, int it, int n4) {
    constexpr int TIN = 512, TOUT = 256, TQ = 48, TKV = 32, TL = TIN + TOUT + TQ + TKV;
    const int l = it / TL; int r = it - l * TL, kind, nt, kt; WItem w; w.ksc = nullptr;
    if (r < TIN) { kind = 0; nt = r >> 3; kt = r & 7; w.W = F.in[5] + (size_t)l * DM * NIN; w.Nsrc = NIN; w.K = DM; w.Bt = WSP(bf16_t, WS_WIN) + (size_t)l * NINP * DM; }
    else if (r < TIN + TOUT) { r -= TIN; kind = 1; nt = r >> 3; kt = r & 7; w.W = F.in[11] + (size_t)l * DM * DM; w.Nsrc = DM; w.K = DM; w.Bt = WSP(bf16_t, WS_WOUT) + (size_t)l * DM * DM; }
    else if (r < TIN + TOUT + TQ) { r -= TIN + TOUT; kind = 2; nt = r >> 1; kt = r & 1; w.W = F.in[7] + (size_t)l * QLR * NQ; w.Nsrc = NQ; w.K = QLR; w.ksc = F.in[6] + l * QLR; w.Bt = WSP(bf16_t, WS_WQ) + (size_t)l * NQ * QLR; }
    else { r -= TIN + TOUT + TQ; kind = 3; nt = r; kt = 0; w.W = F.in[9] + (size_t)l * KVLR * NKV; w.Nsrc = NKV; w.K = KVLR; w.ksc = F.in[8] + l * KVLR; w.Bt = WSP(bf16_t, WS_WKV) + (size_t)l * NKV * KVLR; }
    w.n0 = nt * 64; w.k0 = kt * 256; const int n = w.n0 + n4;
    w.src = kind == 0 ? src_in(n) : (kind == 2 ? src_q(n) : n);
    return w;
}
__device__ __forceinline__ void p0_weights(const Frame& F, const int it0, const int it1) {
    constexpr int TL = 512 + 256 + 48 + 32;
    LAS unsigned* T = (LAS unsigned*)F.lds;
    const int tid = F.tid, n4 = (tid & 15) * 4, kp = tid >> 4;
    int it = it0 + F.bx; if (it >= it1) return;
    f32x4 a0[4], a1[4]; float s0[4], s1[4];
#define W_LOAD(I) do { _Pragma("unroll") for (int i = 0; i < 4; ++i) { const int k = (I).k0 + 2 * (kp + 32 * i); \
        a0[i] = (I).src >= 0 ? __builtin_nontemporal_load((const f32x4*)((I).W + (size_t)k * (I).Nsrc + (I).src)) : (f32x4){0.f, 0.f, 0.f, 0.f}; \
        a1[i] = (I).src >= 0 ? __builtin_nontemporal_load((const f32x4*)((I).W + (size_t)(k + 1) * (I).Nsrc + (I).src)) : (f32x4){0.f, 0.f, 0.f, 0.f}; \
        s0[i] = (I).ksc ? (I).ksc[k] : 1.0f; s1[i] = (I).ksc ? (I).ksc[k + 1] : 1.0f; } } while (0)
    WItem nx = w_decode(F, it, n4); W_LOAD(nx);
    for (; it < it1; it += F.G) {
        const WItem me = nx; f32x4 v0[4], v1[4];
#pragma unroll
        for (int i = 0; i < 4; ++i) { v0[i] = a0[i] * s0[i]; v1[i] = a1[i] * s1[i]; }
        if (it + F.G < it1) { nx = w_decode(F, it + F.G, n4); W_LOAD(nx); }
#pragma unroll
        for (int i = 0; i < 4; ++i)
#pragma unroll
            for (int e = 0; e < 4; ++e) T[(n4 + e) * 130 + kp + 32 * i] = cvt_pk_bf16(v0[i][e], v1[i][e]);
        __syncthreads();
#pragma unroll
        for (int i = 0; i < 4; ++i) { const int c = tid + 512 * i, nn = c >> 5, kc = c & 31;
            const u32x2 a = *(const LAS u32x2*)(T + nn * 130 + kc * 4), b = *(const LAS u32x2*)(T + nn * 130 + kc * 4 + 2);
            *(u32x4*)(me.Bt + (size_t)(me.n0 + nn) * me.K + me.k0 + kc * 8) = (u32x4){a.x, a.y, b.x, b.y}; }
        __syncthreads();
    }
#undef W_LOAD
}
__device__ __forceinline__ void p0_mod(const Frame& F, const int it0, const int it1) {
    LAS float* red = (LAS float*)(F.lds + 32768);
    LAS float* sl = (LAS float*)(F.lds + 65536);
    const int tid = F.tid, cg = tid & 15, kl = tid >> 4;
    float* mod = WSP(float, WS_MOD); const float* cc = F.in[1];
    int it = it0 + F.bx; if (it >= it1) return;
#pragma unroll
    for (int j = 0; j < 16; ++j) sl[tid + 512 * j] = silu_f(cc[tid + 512 * j]);
    f32x4 wn[16];
#define M_LOAD(IT) do { const int l_ = (IT) / 384, rem_ = (IT) - l_ * 384; const float* wp = F.in[3] + ((size_t)l_ * DM + (rem_ & 3) * 512 + kl) * (3 * DM) + (rem_ >> 2) * 64 + cg * 4; \
        _Pragma("unroll") for (int i = 0; i < 16; ++i) wn[i] = __builtin_nontemporal_load((const f32x4*)(wp + (size_t)(32 * i) * (3 * DM))); } while (0)
    M_LOAD(it);
    __syncthreads();
    for (; it < it1; it += F.G) {
        const int l = it / 384, rem = it - l * 384, kq = rem & 3, col0 = (rem >> 2) * 64;
        f32x4 acc[4] = {}, w[16];
        float bias = 0.f;
        if (tid < 256 && kq == 0) bias = F.in[4][l * (3 * DM) + col0 + (tid >> 4) * 4 + (tid & 3)];
#pragma unroll
        for (int i = 0; i < 16; ++i) w[i] = wn[i];
        if (it + F.G < it1) M_LOAD(it + F.G);
#pragma unroll
        for (int i = 0; i < 16; ++i) { const int k = kq * 512 + kl + 32 * i;
#pragma unroll
            for (int b = 0; b < 4; ++b) acc[b] += w[i] * sl[b * DM + k]; }
#pragma unroll
        for (int b = 0; b < 4; ++b)
#pragma unroll
            for (int j = 0; j < 4; ++j) red[(kl * 16 + cg) * 16 + b * 4 + j] = acc[b][j];
        __syncthreads();
        if (tid < 256) { const int cg2 = tid >> 4, v = tid & 15, b = v >> 2, j = v & 3; float s = 0.f;
            for (int q = 0; q < 32; ++q) s += red[(q * 16 + cg2) * 16 + v];
            const int col = col0 + cg2 * 4 + j; s += bias;
            atomicAdd(mod + (size_t)(l * NB + b) * (3 * DM) + col, s); }
        __syncthreads();
    }
#undef M_LOAD
}
__device__ __forceinline__ void p0_tables(const Frame& F) {
    constexpr double INVF2PI[32] = {
    0.15915494309189535, 0.11934937021124886, 0.08949940160889101, 0.06711508300522726,
    0.050329212104487035, 0.03774158471741977, 0.0283021958306234, 0.02122365276477766,
    0.015915494309189534, 0.011934937021124886, 0.008949940160889102, 0.006711508300522725,
    0.005032921210448704, 0.003774158471741977, 0.00283021958306234, 0.0021223652764777662,
    0.0015915494309189536, 0.0011934937021124885, 0.0008949940160889102, 0.0006711508300522726,
    0.0005032921210448703, 0.00037741584717419774, 0.00028302195830623395, 0.0002122365276477766,
    0.00015915494309189535, 0.00011934937021124886, 8.949940160889102e-05, 6.711508300522725e-05,
    5.0329212104487035e-05, 3.774158471741978e-05, 2.8302195830623396e-05, 2.122365276477766e-05};
    const int gid = F.bx * NTHREADS + F.tid, NT = F.G * NTHREADS;
    const int* pos = (const int*)F.in[2]; float* rc = WSP(float, WS_RCOS); float* rs = WSP(float, WS_RSIN);
    for (int idx = gid; idx < MTOK * 32; idx += NT) { const int i = idx & 31; double t = (double)pos[idx >> 5] * INVF2PI[i]; t -= floor(t);
        float sn, cs; sincospif((float)(2.0 * t), &sn, &cs); rc[idx] = cs; rs[idx] = sn; }
    bf16_t* D1 = WSP(bf16_t, WS_D1); bf16_t* D2 = WSP(bf16_t, WS_D2);
    for (int idx = gid; idx < 128 * 64; idx += NT) { const int s1 = idx & 63, rr = idx >> 6, ri = rr >> 6, s1p = rr & 63; float sn, cs; sincospif((float)((s1 * s1p) & 63) * (1.0f / 32.0f), &sn, &cs);
        D1[idx] = f2bf((ri ? -sn : cs) * 0.125f); }
    for (int idx = gid; idx < 128 * 128; idx += NT) { const int kk = idx & 127, rr = idx >> 7, ri = kk >> 6, s2 = kk & 63, ro = rr >> 6, s2p = rr & 63; float sn, cs; sincospif((float)((s2 * s2p) & 63) * (1.0f / 32.0f), &sn, &cs);
        const float v = ro == 0 ? (ri == 0 ? cs : sn) : (ri == 0 ? -sn : cs); D2[idx] = f2bf(v * 0.125f); }
    float* rsq = WSP(float, WS_RSQ);
    for (int idx = gid; idx < DEPTH * MTOK * 2; idx += NT) rsq[idx] = 0.f;
}
__device__ __forceinline__ void p0_wcat(const Frame& F, const int l0, const int l1) {
    const int gid = F.bx * NTHREADS + F.tid, NT = F.G * NTHREADS;
    LAS float* ct = (LAS float*)F.lds; LAS float* st = ct + 128;
    if (F.tid < 128) { float sn, cs; sincospif((float)F.tid * (1.0f / 64.0f), &sn, &cs); ct[F.tid] = cs * 0.08838834764831845f; st[F.tid] = sn * 0.08838834764831845f; }
    __syncthreads();
    bf16_t* wcat = WSP(bf16_t, WS_WCAT);
    for (int t = l0 * (NG * 128 * 64) + gid; t < l1 * (NG * 128 * 64); t += NT) { const int k4 = (t & 63) * 4, d = (t >> 6) & 127, lg = t >> 13, ro = k4 >> 7, c0 = k4 & 127;
        const float* w = F.in[10] + (size_t)lg * 128 * 128 + d; LAS float* tb = ro ? st : ct; f32x4 s = {0.f, 0.f, 0.f, 0.f};
        for (int cp0 = 0; cp0 < 128; cp0 += 16) { float wv[16];
#pragma unroll
            for (int u = 0; u < 16; ++u) wv[u] = w[(cp0 + u) * 128];
#pragma unroll
            for (int u = 0; u < 16; ++u) { const int cp = cp0 + u; s += (f32x4){tb[(c0 * cp) & 127], tb[((c0 + 1) * cp) & 127], tb[((c0 + 2) * cp) & 127], tb[((c0 + 3) * cp) & 127]} * wv[u]; } }
        u32x2 o; o.x = cvt_pk_bf16(s[0], s[1]); o.y = cvt_pk_bf16(s[2], s[3]);
        *(u32x2*)(wcat + ((size_t)lg * 128 + d) * 256 + k4) = o; }
    __syncthreads();
}
#ifndef LN_NT
#define LN_NT 1
#endif
#if LN_NT
#define LN_LD(p) __builtin_nontemporal_load((const f32x4*)(p))
#define LN_ST(p, v) __builtin_nontemporal_store((v), (f32x4*)(p))
#else
#define LN_LD(p) (*(const f32x4*)(p))
#define LN_ST(p, v) (*(f32x4*)(p) = (v))
#endif
__device__ __forceinline__ void row_stats(const f32x4 (&v)[8], float& mean, float& rstd) {
    float s = 0.f;
#pragma unroll
    for (int i = 0; i < 8; ++i) s += (v[i][0] + v[i][1]) + (v[i][2] + v[i][3]);
    mean = wave_sum(s) * (1.0f / DM); float q = 0.f;
#pragma unroll
    for (int i = 0; i < 8; ++i) { const f32x4 d = v[i] - mean; q += (d[0] * d[0] + d[1] * d[1]) + (d[2] * d[2] + d[3] * d[3]); }
    rstd = rsqrtf(wave_sum(q) * (1.0f / DM) + NORM_EPS);
}
__device__ __forceinline__ void ln_rows(const Frame& F, int& r0, int& r1) { const int rpb = (((MTOK + F.G - 1) / F.G) + 7) & ~7; r0 = F.bx * rpb; r1 = r0 + rpb < MTOK ? r0 + rpb : MTOK; }
__device__ __forceinline__ void p_ln_first(const Frame& F, const int row0, const int row1, const int step) {
    const float* x = F.in[0]; const float* mod = WSP(float, WS_MOD); bf16_t* H = WSP(bf16_t, WS_H);
    for (int seg0 = row0; seg0 < row1; ) {
        const int cb = seg0 >> 12, segend = ((cb + 1) << 12) < row1 ? ((cb + 1) << 12) : row1;
        f32x4 v[8], vn[8], shv[8], scv[8];
        { const float* mp = mod + (size_t)cb * (3 * DM) + F.lane * 4;
#pragma unroll
          for (int i = 0; i < 8; ++i) { shv[i] = *(const f32x4*)(mp + i * 256); scv[i] = *(const f32x4*)(mp + DM + i * 256) + 1.0f; } }
        int row = seg0 + F.wave;
        if (row < segend) { const float* xr = x + (size_t)row * DM + F.lane * 4;
#pragma unroll
            for (int i = 0; i < 8; ++i) vn[i] = LN_LD(xr + i * 256); }
        for (; row < segend; row += step) {
#pragma unroll
            for (int i = 0; i < 8; ++i) v[i] = vn[i];
            if (row + step < segend) { const float* xr = x + (size_t)(row + step) * DM + F.lane * 4;
#pragma unroll
                for (int i = 0; i < 8; ++i) vn[i] = LN_LD(xr + i * 256); }
            float mean, rstd; row_stats(v, mean, rstd);
#pragma unroll
            for (int i = 0; i < 8; ++i) store4_bf16(H + (size_t)row * DM + F.lane * 4 + i * 256, (v[i] - mean) * rstd * scv[i] + shv[i]);
        }
        seg0 = segend;
    }
}
#ifndef LN_DROP_R
#define LN_DROP_R (PROBE_CHECK ? 0 : 1)
#endif
template <bool NEXT> __device__ __forceinline__ void p_ln_post(const Frame& F, int l, const int row0, const int row1, const int step) {
    constexpr bool DROPR = LN_DROP_R && NEXT;
    const float* xs = l == 0 ? F.in[0] : WSP(float, WS_R); float* dst = NEXT ? WSP(float, WS_R) : F.out; const float* g = F.in[12] + l * DM; const float* bb = F.in[13] + l * DM;
    const float* mod = WSP(float, WS_MOD) + (size_t)(l + 1) * NB * (3 * DM); bf16_t* H = WSP(bf16_t, WS_H); const bf16_t* GYs = DROPR ? WSP(bf16_t, WS_R) : WSP(bf16_t, WS_H);
    f32x4 gv[8], bv[8];
#pragma unroll
    for (int i = 0; i < 8; ++i) { gv[i] = *(const f32x4*)(g + F.lane * 4 + i * 256); bv[i] = *(const f32x4*)(bb + F.lane * 4 + i * 256); }
    for (int seg0 = row0; seg0 < row1; ) {
        const int cb = seg0 >> 12, segend = ((cb + 1) << 12) < row1 ? ((cb + 1) << 12) : row1;
        f32x4 v[8], vn[8], shv[8], scv[8]; u32x2 gyn[8];
        if (NEXT) { const float* mp = mod + (size_t)cb * (3 * DM) + F.lane * 4;
#pragma unroll
            for (int i = 0; i < 8; ++i) { shv[i] = *(const f32x4*)(mp + i * 256); scv[i] = *(const f32x4*)(mp + DM + i * 256) + 1.0f; } }
        int row = seg0 + F.wave;
        if (row < segend) { const float* xr = xs + (size_t)row * DM + F.lane * 4; const bf16_t* gr = GYs + (size_t)row * DM + F.lane * 4;
#pragma unroll
            for (int i = 0; i < 8; ++i) { vn[i] = LN_LD(xr + i * 256); gyn[i] = DROPR ? *(const u32x2*)(gr + i * 256) : __builtin_nontemporal_load((const u32x2*)(gr + i * 256)); } }
        for (; row < segend; row += step) {
#pragma unroll
            for (int i = 0; i < 8; ++i) { const u32x2 q = gyn[i];
                v[i] = vn[i] * DN_ALPHA + (f32x4){__uint_as_float(q.x << 16), __uint_as_float(q.x & 0xffff0000u), __uint_as_float(q.y << 16), __uint_as_float(q.y & 0xffff0000u)}; }
            if (row + step < segend) { const float* xr = xs + (size_t)(row + step) * DM + F.lane * 4; const bf16_t* gr = GYs + (size_t)(row + step) * DM + F.lane * 4;
#pragma unroll
                for (int i = 0; i < 8; ++i) { vn[i] = LN_LD(xr + i * 256); gyn[i] = DROPR ? *(const u32x2*)(gr + i * 256) : __builtin_nontemporal_load((const u32x2*)(gr + i * 256)); } }
            float mean, rstd; row_stats(v, mean, rstd);
#pragma unroll
            for (int i = 0; i < 8; ++i) { v[i] = (v[i] - mean) * rstd * gv[i] + bv[i];
                if (!DROPR) LN_ST(dst + (size_t)row * DM + F.lane * 4 + i * 256, v[i]); }
            if (NEXT) { row_stats(v, mean, rstd);
#pragma unroll
                for (int i = 0; i < 8; ++i) store4_bf16(H + (size_t)row * DM + F.lane * 4 + i * 256, (v[i] - mean) * rstd * scv[i] + shv[i]); }
        }
        seg0 = segend;
    }
}
__device__ __forceinline__ void p_ln_last(const Frame& F, const int row0, const int row1, const int step) {
    static_assert(DEPTH == 2, "p_ln_last rebuilds exactly one earlier layer");
    const float* xs = F.in[0]; float* dst = F.out; const bf16_t* GY0 = WSP(bf16_t, WS_R); const bf16_t* GY1 = WSP(bf16_t, WS_H);
    LAS float* pl = (LAS float*)F.lds;
    *(LAS f32x4*)(pl + F.tid * 4) = *(const f32x4*)(F.in[12] + F.tid * 4); *(LAS f32x4*)(pl + DM + F.tid * 4) = *(const f32x4*)(F.in[13] + F.tid * 4);
    *(LAS f32x4*)(pl + 2 * DM + F.tid * 4) = *(const f32x4*)(F.in[12] + DM + F.tid * 4); *(LAS f32x4*)(pl + 3 * DM + F.tid * 4) = *(const f32x4*)(F.in[13] + DM + F.tid * 4);
    __syncthreads();
    f32x4 v[8], vn[8]; u32x2 g0n[8], g1n[8], g1c[8];
    int row = row0 + F.wave;
#define LNL_LOAD(R) do { const float* xr = xs + (size_t)(R) * DM + F.lane * 4; const bf16_t* p0 = GY0 + (size_t)(R) * DM + F.lane * 4; const bf16_t* p1 = GY1 + (size_t)(R) * DM + F.lane * 4; \
        _Pragma("unroll") for (int i = 0; i < 8; ++i) { vn[i] = LN_LD(xr + i * 256); g0n[i] = __builtin_nontemporal_load((const u32x2*)(p0 + i * 256)); g1n[i] = __builtin_nontemporal_load((const u32x2*)(p1 + i * 256)); } } while (0)
#define LNL_UNPK(q) ((f32x4){__uint_as_float((q).x << 16), __uint_as_float((q).x & 0xffff0000u), __uint_as_float((q).y << 16), __uint_as_float((q).y & 0xffff0000u)})
    if (row < row1) LNL_LOAD(row);
    for (; row < row1; row += step) {
        asm volatile("" ::: "memory");
#pragma unroll
        for (int i = 0; i < 8; ++i) { v[i] = vn[i] * DN_ALPHA + LNL_UNPK(g0n[i]); g1c[i] = g1n[i]; }
        if (row + step < row1) LNL_LOAD(row + step);
        float mean, rstd; row_stats(v, mean, rstd);
#pragma unroll
        for (int i = 0; i < 8; ++i) { const f32x4 g0 = *(const LAS f32x4*)(pl + F.lane * 4 + i * 256), b0 = *(const LAS f32x4*)(pl + DM + F.lane * 4 + i * 256);
            v[i] = ((v[i] - mean) * rstd * g0 + b0) * DN_ALPHA + LNL_UNPK(g1c[i]); }
        row_stats(v, mean, rstd);
#pragma unroll
        for (int i = 0; i < 8; ++i) { const f32x4 g1 = *(const LAS f32x4*)(pl + 2 * DM + F.lane * 4 + i * 256), b1 = *(const LAS f32x4*)(pl + 3 * DM + F.lane * 4 + i * 256);
            LN_ST(dst + (size_t)row * DM + F.lane * 4 + i * 256, (v[i] - mean) * rstd * g1 + b1); }
    }
#undef LNL_LOAD
#undef LNL_UNPK
}
__device__ __forceinline__ void fft1_naive(const Frame& F) {
    const bf16_t* U = WSP(bf16_t, WS_U); const bf16_t* D1 = WSP(bf16_t, WS_D1); bf16_t* Z = WSP(bf16_t, WS_H);
    const int gid = F.bx * NTHREADS + F.tid, NT = F.G * NTHREADS;
    for (int idx = gid; idx < NB * 64 * NG * 64 * 128; idx += NT) {
        const int c = idx & 127, s2 = (idx >> 7) & 63, g = (idx >> 13) & 7, s1p = (idx >> 16) & 63, b = idx >> 22;
        float yr = 0.f, yi = 0.f;
        for (int s1 = 0; s1 < 64; ++s1) { const float u = bf2f(U[(size_t)(b * SEQ + 64 * s1 + s2) * DF + g * 128 + c]); yr += bf2f(D1[s1p * 64 + s1]) * u; yi += bf2f(D1[(64 + s1p) * 64 + s1]) * u; }
        float st, ct; sincospif((float)(s2 * s1p) * (1.0f / 2048.0f), &st, &ct);
        const size_t zo = ((((size_t)(b * 64 + s1p) * NG + g) * 2) * 64 + s2) * 128 + c;
        Z[zo] = f2bf(yr * ct + yi * st); Z[zo + 64 * 128] = f2bf(yi * ct - yr * st);
    }
}
__device__ __forceinline__ void fft2_naive(const Frame& F, int l) {
    const bf16_t* Z = WSP(bf16_t, WS_H); const bf16_t* D2 = WSP(bf16_t, WS_D2); const bf16_t* wcat = WSP(bf16_t, WS_WCAT) + (size_t)l * NG * 128 * 256; bf16_t* MIX = WSP(bf16_t, WS_MIX);
    LAS float* Xs = (LAS float*)F.lds;
    for (int it = F.bx; it < NB * 64 * NG; it += F.G) {
        const int g = it & 7, s1p = (it >> 3) & 63, b = it >> 9;
        const bf16_t* Zb = Z + ((size_t)(b * 64 + s1p) * NG + g) * 2 * 64 * 128;
        for (int i = 0; i < 32; ++i) { const int o = F.tid + 512 * i, c = o & 127, rr = o >> 7; float s = 0.f;
            for (int k = 0; k < 128; ++k) s += bf2f(D2[rr * 128 + k]) * bf2f(Zb[k * 128 + c]);
            Xs[rr * 128 + c] = bf2f(f2bf(s)); }
        __syncthreads();
        for (int i = 0; i < 16; ++i) { const int o = F.tid + 512 * i, d = o & 127, s2p = o >> 7; float s = 0.f;
            const bf16_t* wr = wcat + (size_t)(g * 128 + d) * 256;
            for (int k = 0; k < 256; ++k) s += Xs[((k >> 7) * 64 + s2p) * 128 + (k & 127)] * bf2f(wr[k]);
            const size_t mo = (size_t)(b * SEQ + s1p + 64 * s2p) * DM + g * 128 + d;
            MIX[mo] = f2bf(s * (GATE_IN_EPI ? bf2f(MIX[mo]) : silu_f(bf2f(MIX[mo])))); }
        __syncthreads();
    }
}
__device__ __forceinline__ void attn_naive(const Frame& F) {
    const bf16_t* Q = WSP(bf16_t, WS_Q); const bf16_t* KV = WSP(bf16_t, WS_KV); const bf16_t* KR = WSP(bf16_t, WS_KR); bf16_t* MIX = WSP(bf16_t, WS_MIX);
    LAS float* qs = (LAS float*)F.lds + F.wave * 192;
    for (int it = F.bx * 8 + F.wave; it < MTOK * NH * 2; it += F.G * 8) {
        const int dh = it & 1, h = (it >> 1) & 7, tok = it >> 4, b = tok >> 12;
        __builtin_amdgcn_wave_barrier(); asm volatile("" ::: "memory");
        for (int e = 0; e < 3; ++e) qs[F.lane + 64 * e] = bf2f(Q[(size_t)tok * NQ + h * DQK + F.lane + 64 * e]);
        asm volatile("s_waitcnt lgkmcnt(0)" ::: "memory"); __builtin_amdgcn_wave_barrier();
        float m = -1e30f, lsum = 0.f; float o[64];
#pragma unroll
        for (int d = 0; d < 64; ++d) o[d] = 0.f;
        for (int t = 0; t < 64; ++t) {
            const size_t key = (size_t)b * SEQ + F.lane + 64 * t; const bf16_t* kn = KV + key * NKV + h * 256; const bf16_t* kr = KR + key * 64;
            float s = 0.f;
#pragma unroll 2
            for (int c = 0; c < 16; ++c) { const bf16x8 kv = *(const bf16x8*)(kn + c * 8);
#pragma unroll
                for (int e = 0; e < 8; ++e) s += qs[c * 8 + e] * bf2f((bf16_t)kv[e]); }
#pragma unroll 2
            for (int c = 0; c < 8; ++c) { const bf16x8 kv = *(const bf16x8*)(kr + c * 8);
#pragma unroll
                for (int e = 0; e < 8; ++e) s += qs[128 + c * 8 + e] * bf2f((bf16_t)kv[e]); }
            s *= ATT_SCALE; const float mn = fmaxf(m, s), a = __expf(m - mn), p = __expf(s - mn); lsum = lsum * a + p; m = mn;
#pragma unroll
            for (int c = 0; c < 8; ++c) { const bf16x8 vv = *(const bf16x8*)(kn + 128 + dh * 64 + c * 8);
#pragma unroll
                for (int e = 0; e < 8; ++e) o[c * 8 + e] = o[c * 8 + e] * a + p * bf2f((bf16_t)vv[e]); }
        }
        const float Mx = wave_max(m), f = __expf(m - Mx); const float L = wave_sum(lsum * f);
        float keep0 = 0.f;
#pragma unroll
        for (int d = 0; d < 64; ++d) { const float od = wave_sum(o[d] * f); if (F.lane == d) keep0 = od; }
        const size_t mo = (size_t)tok * DM + DF + h * 128 + dh * 64 + F.lane;
        MIX[mo] = f2bf(keep0 / L * (GATE_IN_EPI ? bf2f(MIX[mo]) : silu_f(bf2f(MIX[mo]))));
    }
}
namespace att {
constexpr int NW = 8, QBLK = 32, KVBLK = 64;
#ifndef ATT_STAG
#define ATT_STAG 0
#endif
#ifndef ATT_HYB
#define ATT_HYB 0
#endif
#ifndef ATT_S16
#define ATT_S16 0
#endif
#ifndef ATT_DMA
#define ATT_DMA 0
#endif
#ifndef ATT_SHAPE16
#define ATT_SHAPE16 0
#endif
#ifndef ATT_STAMP
#define ATT_STAMP -1
#endif
#ifndef ATT_SPRIO
#define ATT_SPRIO 0
#endif
#ifndef ATT_PRIO
#define ATT_PRIO 0
#endif
#ifndef ATT_QSB2
#define ATT_QSB2 1
#endif
#ifndef ATT_SDEPTH
#define ATT_SDEPTH 1
#endif
constexpr int SDEPTH = ATT_SDEPTH;
constexpr float THR = 8.f;
constexpr int SHM_V = KVBLK * 128 * 2, SHM_KN = KVBLK * 128 * 2, SHM_KR = KVBLK * 64 * 2;
#ifndef ATT_QLDS
#define ATT_QLDS 6
#endif
constexpr int QLDS = ATT_QLDS, QREG = 12 - QLDS;
constexpr int OFF_V = 0, OFF_KN = 2 * SHM_V, OFF_KR = OFF_KN + 2 * SHM_KN, OFF_WS = OFF_KR + 2 * SHM_KR, OFF_QL = OFF_WS + NW * 64 * 4, OFF_OT = 0, OT_PITCH = 272, SHM_ATTN = OFF_QL + NW * QLDS * 1024;
static_assert(NW * 32 * OT_PITCH <= OFF_WS, "O tiles reuse the K/V buffers");
static_assert(SHM_ATTN <= RING_BYTES, "attention LDS must fit the phase scratch");
#define KSWZ(row, colB) ((row) * 256 + ((colB) ^ (((row) & 15) << 4)))
#define RSWZ(row, ch) ((row) * 128 + ((((ch) ^ (((row) >> 1) & 7))) << 4))
#define SBAR() __builtin_amdgcn_sched_barrier(0)
__device__ __forceinline__ int crow(int r, int hi) { return (r & 3) + 8 * (r >> 2) + 4 * hi; }
__device__ __forceinline__ unsigned cvtpk(float lo, float hi) { unsigned r; asm volatile("v_cvt_pk_bf16_f32 %0, %1, %2" : "=v"(r) : "v"(lo), "v"(hi)); return r; }
__device__ __forceinline__ bf16x8 ld8(const bf16_t* p) { return *reinterpret_cast<const bf16x8*>(p); }


template <bool S16> __device__ __forceinline__ f32x16 mfma_sel(bf16x8 a, bf16x8 b, f32x16 c) {
  if constexpr (S16) {
  f32x4 c0 = {c[0], c[1], c[2], c[3]}, c1 = {c[4], c[5], c[6], c[7]};
  c0 = __builtin_amdgcn_mfma_f32_16x16x32_bf16(a, b, c0, 0, 0, 0); c1 = __builtin_amdgcn_mfma_f32_16x16x32_bf16(a, b, c1, 0, 0, 0);
  c[0] = c0[0]; c[1] = c0[1]; c[2] = c0[2]; c[3] = c0[3]; c[4] = c1[0]; c[5] = c1[1]; c[6] = c1[2]; c[7] = c1[3]; return c;
  } else return __builtin_amdgcn_mfma_f32_32x32x16_bf16(a, b, c, 0, 0, 0);
}
__device__ __forceinline__ void partialSM(f32x16& p0, f32x16& p1, float& m_reg, float& mn, float& alpha) {
#if defined(PROBE_NEG) && PROBE_NEG == 2
  constexpr float C = ATT_SCALE * 1.4426950408889634f * 1.3f;
#else
  constexpr float C = ATT_SCALE * 1.4426950408889634f;
#endif
  float pmax = p0[0]; for (int r = 1; r < 16; ++r) pmax = fmaxf(pmax, p0[r]); for (int r = 0; r < 16; ++r) pmax = fmaxf(pmax, p1[r]);
  { auto rr = __builtin_amdgcn_permlane32_swap(__float_as_uint(pmax), __float_as_uint(pmax), false, false);
    pmax = fmaxf(__uint_as_float(rr[0]), __uint_as_float(rr[1])); }
  if (__builtin_expect(__all(pmax - m_reg <= THR / ATT_SCALE), 1)) { mn = m_reg; alpha = 1.f; }
  else { mn = fmaxf(m_reg, pmax); alpha = __builtin_amdgcn_exp2f((m_reg - mn) * C); m_reg = mn; }
  float mnC = -mn * C;
  for (int r = 0; r < 16; ++r) p0[r] = fmaf(p0[r], C, mnC); for (int r = 0; r < 16; ++r) p1[r] = fmaf(p1[r], C, mnC);
  for (int r = 0; r < 16; ++r) p0[r] = __builtin_amdgcn_exp2f(p0[r]);
}
__device__ __forceinline__ void finishSM(f32x16& p0, f32x16& p1, float alpha, float& l_reg, bf16x8& pa0, bf16x8& pa1, bf16x8& pa2, bf16x8& pa3) {
  for (int r = 0; r < 16; ++r) p1[r] = __builtin_amdgcn_exp2f(p1[r]);
  float ps = 0; for (int r = 0; r < 16; ++r) ps += p0[r]; for (int r = 0; r < 16; ++r) ps += p1[r];
  { auto rr = __builtin_amdgcn_permlane32_swap(__float_as_uint(ps), __float_as_uint(ps), false, false);
    ps = __uint_as_float(rr[0]) + __uint_as_float(rr[1]); }
  l_reg = l_reg * alpha + ps;
#define PK4(P, BASE, OUT) do { unsigned a0 = cvtpk(P[BASE + 0], P[BASE + 1]), a1 = cvtpk(P[BASE + 2], P[BASE + 3]);   \
    unsigned b0 = cvtpk(P[BASE + 4], P[BASE + 5]), b1 = cvtpk(P[BASE + 6], P[BASE + 7]);                              \
    auto r0 = __builtin_amdgcn_permlane32_swap(a0, b0, false, false); auto r1 = __builtin_amdgcn_permlane32_swap(a1, b1, false, false); \
    u32x4 w = {r0[0], r1[0], r0[1], r1[1]}; OUT = *reinterpret_cast<bf16x8*>(&w); } while (0)
  PK4(p0, 0, pa0); PK4(p0, 8, pa1); PK4(p1, 0, pa2); PK4(p1, 8, pa3);
#undef PK4
}
template <int QR> __device__ __forceinline__ bf16x8 qfrag(const char* ql, int d0) { return *reinterpret_cast<const bf16x8*>(ql + (d0 - QR) * 1024); }
__device__ __forceinline__ void kfrag(bf16x8& a, bf16x8& b, const char* Kn, const char* Kr, int d0, int r32, int hi) {
  if (d0 < 8) { const int cb = (d0 * 16 + hi * 8) * 2; a = *reinterpret_cast<const bf16x8*>(Kn + KSWZ(r32, cb)); b = *reinterpret_cast<const bf16x8*>(Kn + KSWZ(32 + r32, cb)); }
  else { const int ch = (d0 - 8) * 2 + hi; a = *reinterpret_cast<const bf16x8*>(Kr + RSWZ(r32, ch)); b = *reinterpret_cast<const bf16x8*>(Kr + RSWZ(32 + r32, ch)); }
}
template <int QR, bool S16 = false> __device__ __forceinline__ void qkt(f32x16& p0, f32x16& p1, const char* Kn, const char* Kr, const bf16x8* qr, const char* ql, int r32, int hi) {
  p0 = f32x16{}; p1 = f32x16{};
  bf16x8 ka, kb, na, nb, qc, qn;
  kfrag(ka, kb, Kn, Kr, 0, r32, hi); if (0 >= QR) qc = qfrag<QR>(ql, 0);
#pragma unroll
  for (int d0 = 0; d0 < 12; ++d0) {
    if (d0 + 1 < 12) { kfrag(na, nb, Kn, Kr, d0 + 1, r32, hi); if (d0 + 1 >= QR) qn = qfrag<QR>(ql, d0 + 1); }
    SBAR();
    const bf16x8 q = d0 < QR ? qr[d0 < QR ? d0 : 0] : qc;
    if (ATT_PRIO) __builtin_amdgcn_s_setprio(1);
    p0 = mfma_sel<S16>(ka, q, p0);
    p1 = mfma_sel<S16>(kb, q, p1);
    if (ATT_PRIO) __builtin_amdgcn_s_setprio(0);
    if (ATT_QSB2) SBAR();
    ka = na; kb = nb; qc = qn;
  }
}
__device__ __forceinline__ int v_st(int k, int c) { const int kk = (k & ~0xC) | ((k & 4) << 1) | ((k & 8) >> 1); return ((kk >> 3) * 4 + (c >> 5)) * 512 + ((kk & 7) * 32 + (c & 31)) * 2; }
__device__ __forceinline__ int v_rd_base(int lane) { return ((lane & 3) << 3) | (((lane >> 2) & 3) << 6) | (((lane >> 4) & 1) << 5) | (((lane >> 5) & 1) << 8); }
constexpr int v_rd_off(int d0, int ks, int half) { return d0 * 512 + ks * 4096 + half * 2048; }
template <int OFF> __device__ __forceinline__ s16x4 tr_read(int vb) {
  s16x4 r; asm volatile("ds_read_b64_tr_b16 %0, %1 offset:%2" : "=&v"(r) : "v"(vb), "i"(OFF) : "memory"); return r;
}
#define TRPK(L, H) (bf16x8){L[0], L[1], L[2], L[3], H[0], H[1], H[2], H[3]}
template <int D0, bool S16 = false> __device__ __forceinline__ void pv_one(f32x16& od, int vb, bf16x8 pa0, bf16x8 pa1, bf16x8 pa2, bf16x8 pa3) {
  const s16x4 l0 = tr_read<v_rd_off(D0, 0, 0)>(vb), h0 = tr_read<v_rd_off(D0, 0, 1)>(vb), l1 = tr_read<v_rd_off(D0, 1, 0)>(vb), h1 = tr_read<v_rd_off(D0, 1, 1)>(vb);
  const s16x4 l2 = tr_read<v_rd_off(D0, 2, 0)>(vb), h2 = tr_read<v_rd_off(D0, 2, 1)>(vb), l3 = tr_read<v_rd_off(D0, 3, 0)>(vb), h3 = tr_read<v_rd_off(D0, 3, 1)>(vb);
  asm volatile("s_waitcnt lgkmcnt(0)" ::: "memory"); SBAR();
  if (ATT_PRIO) __builtin_amdgcn_s_setprio(1);
  od = mfma_sel<S16>(pa0, TRPK(l0, h0), od);
  od = mfma_sel<S16>(pa1, TRPK(l1, h1), od);
  od = mfma_sel<S16>(pa2, TRPK(l2, h2), od);
  od = mfma_sel<S16>(pa3, TRPK(l3, h3), od);
  if (ATT_PRIO) __builtin_amdgcn_s_setprio(0);
}
template <bool S16 = false> __device__ __forceinline__ void pv_d0(f32x16* o, int vb, bf16x8 pa0, bf16x8 pa1, bf16x8 pa2, bf16x8 pa3) {
  pv_one<0, S16>(o[0], vb, pa0, pa1, pa2, pa3); pv_one<1, S16>(o[1], vb, pa0, pa1, pa2, pa3); pv_one<2, S16>(o[2], vb, pa0, pa1, pa2, pa3); pv_one<3, S16>(o[3], vb, pa0, pa1, pa2, pa3);
}

template <int VAR>
__device__ __forceinline__ void attn_body(const bf16_t* __restrict__ Qb, const bf16_t* __restrict__ Kn, const bf16_t* __restrict__ Kr,
                                          bf16_t* __restrict__ Gm, int seq, char* lds, int tid) {
  const int wid = tid >> 6, lane = tid & 63, r32 = lane & 31, hi = lane >> 5;
  char* V_lds = lds + OFF_V; char* K_lds = lds + OFF_KN; char* R_lds = lds + OFF_KR;
  float* ws = (float*)(lds + OFF_WS) + wid * 64; float* li_l = ws; float* al_l = ws + 32;
  float m_reg = -1e30f, l_reg = 0; f32x16 o[4] = {}; bf16x8 qr[QREG > 0 ? QREG : 1];
  char* ql = lds + OFF_QL + wid * (QLDS * 1024) + lane * 16;
  const unsigned qoff = (unsigned)((wid * QBLK + r32) * NQ + hi * 8) * 2u;
#pragma unroll
  for (int d0 = 0; d0 < 12; ++d0) { const bf16x8 qv = *(const bf16x8*)((const char*)Qb + qoff + d0 * 32); if (d0 < QREG) qr[d0 < QREG ? d0 : 0] = qv; else *reinterpret_cast<bf16x8*>(ql + (d0 - QREG) * 1024) = qv; }
  const int sr = tid >> 4, sc = (tid & 15) * 8, vst0 = v_st(sr, sc), vst1 = v_st(32 + sr, sc);
  const int rr_ = tid >> 3, rc_ = tid & 7;
  const int vb0 = (int)(uintptr_t)V_lds + v_rd_base(lane);
  struct { bf16x8 vs0, vs1, ks0, ks1, kr; } sr_[SDEPTH];
  const unsigned voff = (unsigned)(sr * NKV + sc) * 2u, voffr = (unsigned)(rr_ * 64 + rc_ * 8) * 2u;
#define SLOAD(i, k0) do { const char* kb_ = (const char*)(Kn + (long)(k0) * NKV); const char* rb_ = (const char*)(Kr + (long)(k0) * 64); \
    sr_[i].vs0 = *(const bf16x8*)(kb_ + 256 + voff); sr_[i].vs1 = *(const bf16x8*)(kb_ + (32 * NKV * 2 + 256) + voff); \
    sr_[i].ks0 = *(const bf16x8*)(kb_ + voff); sr_[i].ks1 = *(const bf16x8*)(kb_ + 32 * NKV * 2 + voff); \
    sr_[i].kr = *(const bf16x8*)(rb_ + voffr); } while (0)
#define SWRITE(b, i) do { *(bf16x8*)(V_lds + (b) * SHM_V + vst0) = sr_[i].vs0;          \
    *(bf16x8*)(V_lds + (b) * SHM_V + vst1) = sr_[i].vs1; int kc = sc * 2;               \
    *(bf16x8*)(K_lds + (b) * SHM_KN + KSWZ(sr, kc)) = sr_[i].ks0;                       \
    *(bf16x8*)(K_lds + (b) * SHM_KN + KSWZ(32 + sr, kc)) = sr_[i].ks1;                  \
    *(bf16x8*)(R_lds + (b) * SHM_KR + RSWZ(rr_, rc_)) = sr_[i].kr; } while (0)
#define SLOADV(i, k0) do { if constexpr (VAR != 4) SLOAD(i, k0); } while (0)
#define SWRITEV(b, i) do { if constexpr (VAR != 4) SWRITE(b, i); } while (0)
#define SWAIT() do { if constexpr (SDEPTH == 2) asm volatile("s_waitcnt vmcnt(5)" ::: "memory"); else asm volatile("s_waitcnt vmcnt(0)" ::: "memory"); } while (0)
#define RESC(a) do { if (__any((a) < 1.f)) { if (hi == 0) al_l[r32] = (a); asm volatile("s_waitcnt lgkmcnt(0)" ::: "memory"); \
    for (int d = 0; d < 4; ++d) for (int r = 0; r < 16; ++r) o[d][r] *= al_l[crow(r, hi)]; } } while (0)
  f32x16 pA0, pA1, pB0, pB1; float mnA, mnB, alA, alB; bf16x8 pa0, pa1, pa2, pa3; const int NT = seq / KVBLK;
#define QKT(P0, P1, KN, KR) do { if constexpr (VAR == 3) { P0 = o[0]; P1 = o[1]; } else qkt<QREG, VAR == 6>(P0, P1, KN, KR, qr, ql, r32, hi); } while (0)
#define PSM(P0, P1, MN, AL) do { if constexpr (VAR == 1) { MN = m_reg; AL = 1.f; } else partialSM(P0, P1, m_reg, MN, AL); } while (0)
#define FSM(P0, P1, AL) do { if constexpr (VAR == 1) { pa0 = __builtin_bit_cast(bf16x8, (f32x4){P0[0], P0[1], P0[2], P0[3]}); pa1 = __builtin_bit_cast(bf16x8, (f32x4){P0[4], P0[5], P0[6], P0[7]}); \
      pa2 = __builtin_bit_cast(bf16x8, (f32x4){P1[0], P1[1], P1[2], P1[3]}); pa3 = __builtin_bit_cast(bf16x8, (f32x4){P1[4], P1[5], P1[6], P1[7]}); l_reg += P0[8] + P1[9]; } \
    else finishSM(P0, P1, AL, l_reg, pa0, pa1, pa2, pa3); } while (0)
#define PVD(VB) do { if constexpr (VAR == 2) { o[0][0] += __builtin_bit_cast(f32x4, pa0)[0]; o[1][1] += __builtin_bit_cast(f32x4, pa1)[1]; o[2][2] += __builtin_bit_cast(f32x4, pa2)[2]; o[3][3] += __builtin_bit_cast(f32x4, pa3)[3]; } else pv_d0<VAR == 6 || VAR == 8>(o, VB, pa0, pa1, pa2, pa3); } while (0)
#define SYNC() do { if constexpr (VAR != 5) __syncthreads(); } while (0)
  constexpr int SE = 0, SO = SDEPTH - 1;
  SLOAD(SE, 0); asm volatile("s_waitcnt vmcnt(0)" ::: "memory"); SWRITE(0, SE); SYNC();
  QKT(pA0, pA1, K_lds, R_lds); PSM(pA0, pA1, mnA, alA);
  SLOAD(SO, KVBLK); if constexpr (SDEPTH == 2) { if (2 < NT) SLOAD(SE, 2 * KVBLK); }
  SWAIT(); SWRITE(1, SO); SYNC();
#if ATT_STAMP >= 0
  unsigned long long tk_ = 0, sg_[5] = {0, 0, 0, 0, 0};
#define STMP(k) do { SBAR(); const unsigned long long tn_ = __builtin_amdgcn_s_memtime(); SBAR(); if ((k) >= 0) sg_[(k) < 0 ? 0 : (k)] += tn_ - tk_; tk_ = tn_; } while (0)
#else
#define STMP(k) do { } while (0)
#endif
  STMP(-1);
  if (ATT_SPRIO && wid >= 4) __builtin_amdgcn_s_setprio(1);
  for (int j = 1; j + 1 < NT; j += 2) {
    SBAR(); QKT(pB0, pB1, K_lds + SHM_KN, R_lds + SHM_KR);
    FSM(pA0, pA1, alA); SBAR(); STMP(0);
    SLOADV(SO, (j + SDEPTH) * KVBLK); SBAR();
    PVD(vb0); PSM(pB0, pB1, mnB, alB); STMP(1);
    SYNC(); STMP(2); SWAIT(); SWRITEV(0, SE);
    RESC(alB); STMP(3); SYNC(); STMP(4);
    SBAR(); QKT(pA0, pA1, K_lds, R_lds);
    FSM(pB0, pB1, alB); SBAR(); STMP(0);
    if (SDEPTH == 1 || j + 3 < NT) SLOADV(SE, (j + 1 + SDEPTH) * KVBLK); SBAR();
    PVD(vb0 + (int)SHM_V); PSM(pA0, pA1, mnA, alA); STMP(1);
    SYNC(); STMP(2); SWAIT(); SWRITEV(1, SO);
    RESC(alA); STMP(3); SYNC(); STMP(4);
  }
#if ATT_STAMP >= 0
  if (tid == 0) { volatile unsigned* mw = (volatile unsigned*)(lds + RING_BYTES) + 16; for (int k_ = 0; k_ < 5; ++k_) mw[k_] += (unsigned)(sg_[k_] >> 4); }
#endif
#undef STMP
  SBAR(); QKT(pB0, pB1, K_lds + SHM_KN, R_lds + SHM_KR);
  FSM(pA0, pA1, alA); SBAR();
  PVD(vb0); PSM(pB0, pB1, mnB, alB);
  SYNC(); RESC(alB);
  FSM(pB0, pB1, alB); SBAR();
  PVD(vb0 + (int)SHM_V);
  if (ATT_SPRIO) __builtin_amdgcn_s_setprio(0);
  SBAR(); asm volatile("" ::: "memory");
  u32x4 gt[8]; const int grow = lane >> 4, gc16 = lane & 15;
  bf16_t* Gw = Gm + (size_t)(wid * QBLK + grow) * DM + gc16 * 8;
#pragma unroll
  for (int i = 0; i < 8; ++i) gt[i] = __builtin_nontemporal_load((const u32x4*)(Gw + (size_t)(4 * i) * DM));
  if (hi == 0) li_l[r32] = l_reg;
  __syncthreads();
  char* ot = lds + OFF_OT + wid * (32 * OT_PITCH);
#pragma unroll
  for (int r = 0; r < 16; ++r) { const float rl = __builtin_amdgcn_rcpf(li_l[crow(r, hi)]); char* orow = ot + crow(r, hi) * OT_PITCH + r32 * 2;
#pragma unroll
    for (int d0 = 0; d0 < 4; ++d0) *(bf16_t*)(orow + d0 * 64) = f2bf(o[d0][r] * rl); }
  asm volatile("s_waitcnt lgkmcnt(0)" ::: "memory");
#pragma unroll
  for (int i = 0; i < 8; ++i) { const u32x4 ov = *(const u32x4*)(ot + (grow + 4 * i) * OT_PITCH + gc16 * 16); const u32x4 gv = gt[i]; u32x4 w;
#pragma unroll
    for (int e = 0; e < 4; ++e) { const float g0_ = __uint_as_float(gv[e] << 16), g1_ = __uint_as_float(gv[e] & 0xffff0000u); const float a0 = __uint_as_float(ov[e] << 16) * (GATE_IN_EPI ? g0_ : silu_f(g0_)), a1 = __uint_as_float(ov[e] & 0xffff0000u) * (GATE_IN_EPI ? g1_ : silu_f(g1_)); w[e] = cvt_pk_bf16(a0, a1); }
    *(u32x4*)(Gw + (size_t)(4 * i) * DM) = w; }
#undef SLOAD
#undef SLOADV
#undef SWRITEV
#undef QKT
#undef PSM
#undef FSM
#undef PVD
#undef SYNC
#undef SWRITE
#undef SWAIT
#undef RESC
}

#ifndef ATT_ONEBAR
#define ATT_ONEBAR 0
#endif
__device__ __forceinline__ void attn_body5(const bf16_t* __restrict__ Qb, const bf16_t* __restrict__ Kn, const bf16_t* __restrict__ Kr,
                                           bf16_t* __restrict__ Gm, int seq, char* lds, int tid) {
  const int wid = tid >> 6, lane = tid & 63, r32 = lane & 31, hi = lane >> 5;
  char* V_lds = lds + OFF_V; char* K_lds = lds + OFF_KN; char* R_lds = lds + OFF_KR;
  float* ws = (float*)(lds + OFF_WS) + wid * 64; float* li_l = ws; float* al_l = ws + 32;
  float m_reg = -1e30f, l_reg = 0; f32x16 o[4] = {}; bf16x8 qr[QREG > 0 ? QREG : 1];
  char* ql = lds + OFF_QL + wid * (QLDS * 1024) + lane * 16;
  const unsigned qoff = (unsigned)((wid * QBLK + r32) * NQ + hi * 8) * 2u;
#pragma unroll
  for (int d0 = 0; d0 < 12; ++d0) { const bf16x8 qv = *(const bf16x8*)((const char*)Qb + qoff + d0 * 32); if (d0 < QREG) qr[d0 < QREG ? d0 : 0] = qv; else *reinterpret_cast<bf16x8*>(ql + (d0 - QREG) * 1024) = qv; }
  const int sr = tid >> 4, sc = (tid & 15) * 8, vst0 = v_st(sr, sc), vst1 = v_st(32 + sr, sc);
  const int rr_ = tid >> 3, rc_ = tid & 7;
  const int vb0 = (int)(uintptr_t)V_lds + v_rd_base(lane);
  bf16x8 vs0, vs1, ks0, ks1, kr;
  const unsigned voff = (unsigned)(sr * NKV + sc) * 2u, voffr = (unsigned)(rr_ * 64 + rc_ * 8) * 2u;
  const int NT = seq / KVBLK;
#define TCL(t) ((t) < NT ? (t) : NT - 1)
#define KLOAD5(t) do { const long k0_ = (long)TCL(t) * KVBLK; const char* kb_ = (const char*)(Kn + k0_ * NKV); const char* rb_ = (const char*)(Kr + k0_ * 64); \
    ks0 = *(const bf16x8*)(kb_ + voff); ks1 = *(const bf16x8*)(kb_ + 32 * NKV * 2 + voff); kr = *(const bf16x8*)(rb_ + voffr); } while (0)
#define VLOAD5(t) do { const char* kb_ = (const char*)(Kn + (long)TCL(t) * KVBLK * NKV); vs0 = *(const bf16x8*)(kb_ + 256 + voff); vs1 = *(const bf16x8*)(kb_ + (32 * NKV * 2 + 256) + voff); } while (0)
#define KWRITE5(b) do { const int kc = sc * 2; *(bf16x8*)(K_lds + (b) * SHM_KN + KSWZ(sr, kc)) = ks0; *(bf16x8*)(K_lds + (b) * SHM_KN + KSWZ(32 + sr, kc)) = ks1; *(bf16x8*)(R_lds + (b) * SHM_KR + RSWZ(rr_, rc_)) = kr; } while (0)
#define VWRITE5(b) do { *(bf16x8*)(V_lds + (b) * SHM_V + vst0) = vs0; *(bf16x8*)(V_lds + (b) * SHM_V + vst1) = vs1; } while (0)
#define RESC5(a) do { if (__any((a) < 1.f)) { if (hi == 0) al_l[r32] = (a); asm volatile("s_waitcnt lgkmcnt(0)" ::: "memory"); \
    for (int d = 0; d < 4; ++d) for (int r = 0; r < 16; ++r) o[d][r] *= al_l[crow(r, hi)]; } } while (0)
  f32x16 pA0, pA1, pB0, pB1; float mnA, mnB, alA, alB; bf16x8 pa0, pa1, pa2, pa3;
  KLOAD5(0); VLOAD5(0); KWRITE5(0); VWRITE5(0); KLOAD5(1); SBAR(); KWRITE5(1); VLOAD5(1); SBAR();
  __syncthreads();
  qkt<QREG, false>(pA0, pA1, K_lds, R_lds, qr, ql, r32, hi); partialSM(pA0, pA1, m_reg, mnA, alA);
  for (int t = 0; t + 2 < NT; t += 2) {
    SBAR(); VWRITE5(1); KLOAD5(t + 2); SBAR();
    qkt<QREG, false>(pB0, pB1, K_lds + SHM_KN, R_lds + SHM_KR, qr, ql, r32, hi);
    finishSM(pA0, pA1, alA, l_reg, pa0, pa1, pa2, pa3); SBAR();
    KWRITE5(0); VLOAD5(t + 2); SBAR();
    pv_d0<false>(o, vb0, pa0, pa1, pa2, pa3); partialSM(pB0, pB1, m_reg, mnB, alB);
    RESC5(alB);
    __syncthreads();
    SBAR(); VWRITE5(0); KLOAD5(t + 3); SBAR();
    qkt<QREG, false>(pA0, pA1, K_lds, R_lds, qr, ql, r32, hi);
    finishSM(pB0, pB1, alB, l_reg, pa0, pa1, pa2, pa3); SBAR();
    KWRITE5(1); VLOAD5(t + 3); SBAR();
    pv_d0<false>(o, vb0 + (int)SHM_V, pa0, pa1, pa2, pa3); partialSM(pA0, pA1, m_reg, mnA, alA);
    RESC5(alA);
    __syncthreads();
  }
  SBAR(); VWRITE5(1); SBAR();
  qkt<QREG, false>(pB0, pB1, K_lds + SHM_KN, R_lds + SHM_KR, qr, ql, r32, hi);
  finishSM(pA0, pA1, alA, l_reg, pa0, pa1, pa2, pa3); SBAR();
  pv_d0<false>(o, vb0, pa0, pa1, pa2, pa3); partialSM(pB0, pB1, m_reg, mnB, alB);
  RESC5(alB);
  __syncthreads();
  finishSM(pB0, pB1, alB, l_reg, pa0, pa1, pa2, pa3); SBAR();
  pv_d0<false>(o, vb0 + (int)SHM_V, pa0, pa1, pa2, pa3);
  SBAR(); asm volatile("" ::: "memory");
  u32x4 gt[8]; const int grow = lane >> 4, gc16 = lane & 15;
  bf16_t* Gw = Gm + (size_t)(wid * QBLK + grow) * DM + gc16 * 8;
#pragma unroll
  for (int i = 0; i < 8; ++i) gt[i] = __builtin_nontemporal_load((const u32x4*)(Gw + (size_t)(4 * i) * DM));
  if (hi == 0) li_l[r32] = l_reg;
  __syncthreads();
  char* ot = lds + OFF_OT + wid * (32 * OT_PITCH);
#pragma unroll
  for (int r = 0; r < 16; ++r) { const float rl = __builtin_amdgcn_rcpf(li_l[crow(r, hi)]); char* orow = ot + crow(r, hi) * OT_PITCH + r32 * 2;
#pragma unroll
    for (int d0 = 0; d0 < 4; ++d0) *(bf16_t*)(orow + d0 * 64) = f2bf(o[d0][r] * rl); }
  asm volatile("s_waitcnt lgkmcnt(0)" ::: "memory");
#pragma unroll
  for (int i = 0; i < 8; ++i) { const u32x4 ov = *(const u32x4*)(ot + (grow + 4 * i) * OT_PITCH + gc16 * 16); const u32x4 gv = gt[i]; u32x4 w;
#pragma unroll
    for (int e = 0; e < 4; ++e) { const float g0_ = __uint_as_float(gv[e] << 16), g1_ = __uint_as_float(gv[e] & 0xffff0000u); const float a0 = __uint_as_float(ov[e] << 16) * (GATE_IN_EPI ? g0_ : silu_f(g0_)), a1 = __uint_as_float(ov[e] & 0xffff0000u) * (GATE_IN_EPI ? g1_ : silu_f(g1_)); w[e] = cvt_pk_bf16(a0, a1); }
    *(u32x4*)(Gw + (size_t)(4 * i) * DM) = w; }
#undef TCL
#undef KLOAD5
#undef VLOAD5
#undef KWRITE5
#undef VWRITE5
#undef RESC5
}

#ifndef ATT3_QLDS
#define ATT3_QLDS 0
#endif
constexpr int Q3LDS = ATT3_QLDS, Q3REG = 12 - Q3LDS;
constexpr int O3_V = 0, O3_KN = 3 * SHM_V, O3_KR = O3_KN + 3 * SHM_KN, O3_WS = O3_KR + 3 * SHM_KR, O3_QL = O3_WS + NW * 64 * 4, SHM_ATTN3 = O3_QL + NW * Q3LDS * 1024;
static_assert(SHM_ATTN3 <= RING_BYTES && NW * 32 * OT_PITCH <= O3_WS, "attention (DMA variant) LDS must fit the phase scratch");
__device__ __forceinline__ void attn_body3(const bf16_t* __restrict__ Qb, const bf16_t* __restrict__ Kn, const bf16_t* __restrict__ Kr,
                                           bf16_t* __restrict__ Gm, int seq, char* lds, LAS unsigned char* ldsL, int tid) {
  const int wid = __builtin_amdgcn_readfirstlane(tid >> 6), lane = tid & 63, r32 = lane & 31, hi = lane >> 5;
  float* ws = (float*)(lds + O3_WS) + wid * 64; float* li_l = ws; float* al_l = ws + 32;
  float m_reg = -1e30f, l_reg = 0; f32x16 o[4] = {}; bf16x8 qr[Q3REG > 0 ? Q3REG : 1];
  char* ql = lds + O3_QL + wid * (Q3LDS * 1024) + lane * 16;
  unsigned vo[2], ko[2], ro;
#pragma unroll
  for (int u = 0; u < 2; ++u) { const int t = 2 * wid + u;
    { const int s = 2 * t + (lane >> 5), kk = (s >> 2) * 8 + ((lane & 31) >> 2), k = (kk & ~0xC) | ((kk & 4) << 1) | ((kk & 8) >> 1), c = (s & 3) * 32 + (lane & 3) * 8; vo[u] = (unsigned)(k * NKV + 128 + c) * 2u; }
    { const int row = 4 * t + (lane >> 4), c = (lane & 15) ^ (row & 15); ko[u] = (unsigned)(row * NKV) * 2u + (unsigned)c * 16u; } }
  { const int row = 8 * wid + (lane >> 3), ch = (lane & 7) ^ ((row >> 1) & 7); ro = (unsigned)row * 128u + (unsigned)ch * 16u; }
#define DMA3(k0, b) do { const char* kb_ = (const char*)(Kn + (long)(k0) * NKV); const char* rb_ = (const char*)(Kr + (long)(k0) * 64); \
    __builtin_amdgcn_global_load_lds((const unsigned*)(kb_ + vo[0]), (LAS unsigned*)(ldsL + O3_V + (b) * SHM_V + (2 * wid) * 1024), 16, 0, 0); \
    __builtin_amdgcn_global_load_lds((const unsigned*)(kb_ + vo[1]), (LAS unsigned*)(ldsL + O3_V + (b) * SHM_V + (2 * wid + 1) * 1024), 16, 0, 0); \
    __builtin_amdgcn_global_load_lds((const unsigned*)(kb_ + ko[0]), (LAS unsigned*)(ldsL + O3_KN + (b) * SHM_KN + (2 * wid) * 1024), 16, 0, 0); \
    __builtin_amdgcn_global_load_lds((const unsigned*)(kb_ + ko[1]), (LAS unsigned*)(ldsL + O3_KN + (b) * SHM_KN + (2 * wid + 1) * 1024), 16, 0, 0); \
    __builtin_amdgcn_global_load_lds((const unsigned*)(rb_ + ro), (LAS unsigned*)(ldsL + O3_KR + (b) * SHM_KR + wid * 1024), 16, 0, 0); } while (0)
#define LANDED() do { asm volatile("s_waitcnt vmcnt(0)" ::: "memory"); __syncthreads(); } while (0)
#define RESC(a) do { if (__any((a) < 1.f)) { if (hi == 0) al_l[r32] = (a); asm volatile("s_waitcnt lgkmcnt(0)" ::: "memory"); \
    for (int d = 0; d < 4; ++d) for (int r = 0; r < 16; ++r) o[d][r] *= al_l[crow(r, hi)]; } } while (0)
#define KNB(b) (lds + O3_KN + (b) * SHM_KN)
#define KRB(b) (lds + O3_KR + (b) * SHM_KR)
  DMA3(0, 0);
  const unsigned qoff = (unsigned)((wid * QBLK + r32) * NQ + hi * 8) * 2u;
#pragma unroll
  for (int d0 = 0; d0 < 12; ++d0) { const bf16x8 qv = *(const bf16x8*)((const char*)Qb + qoff + d0 * 32); if (d0 < Q3REG) qr[d0 < Q3REG ? d0 : 0] = qv; else *reinterpret_cast<bf16x8*>(ql + (d0 - Q3REG) * 1024) = qv; }
  const int vb0 = (int)(uintptr_t)(lds + O3_V) + v_rd_base(lane);
  f32x16 pA0, pA1, pB0, pB1; float mnA, mnB, alA, alB; bf16x8 pa0, pa1, pa2, pa3; const int NT = seq / KVBLK;
  LANDED();
  DMA3(KVBLK, 1);
  qkt<Q3REG>(pA0, pA1, KNB(0), KRB(0), qr, ql, r32, hi); partialSM(pA0, pA1, m_reg, mnA, alA);
  LANDED();
  int bA = 0, bB = 1, bC = 2;
  for (int j = 1; j + 1 < NT; j += 2) {
    DMA3((j + 1) * KVBLK, bC);
    SBAR(); qkt<Q3REG>(pB0, pB1, KNB(bB), KRB(bB), qr, ql, r32, hi);
    finishSM(pA0, pA1, alA, l_reg, pa0, pa1, pa2, pa3); SBAR();
    pv_d0(o, vb0 + bA * SHM_V, pa0, pa1, pa2, pa3); partialSM(pB0, pB1, m_reg, mnB, alB);
    RESC(alB); LANDED();
    DMA3((j + 2) * KVBLK, bA);
    SBAR(); qkt<Q3REG>(pA0, pA1, KNB(bC), KRB(bC), qr, ql, r32, hi);
    finishSM(pB0, pB1, alB, l_reg, pa0, pa1, pa2, pa3); SBAR();
    pv_d0(o, vb0 + bB * SHM_V, pa0, pa1, pa2, pa3); partialSM(pA0, pA1, m_reg, mnA, alA);
    RESC(alA); LANDED();
    { const int t = bA; bA = bC; bC = bB; bB = t; }
  }
  SBAR(); qkt<Q3REG>(pB0, pB1, KNB(bB), KRB(bB), qr, ql, r32, hi);
  finishSM(pA0, pA1, alA, l_reg, pa0, pa1, pa2, pa3); SBAR();
  pv_d0(o, vb0 + bA * SHM_V, pa0, pa1, pa2, pa3); partialSM(pB0, pB1, m_reg, mnB, alB);
  RESC(alB);
  finishSM(pB0, pB1, alB, l_reg, pa0, pa1, pa2, pa3); SBAR();
  pv_d0(o, vb0 + bB * SHM_V, pa0, pa1, pa2, pa3);
  SBAR(); asm volatile("" ::: "memory");
  u32x4 gt[8]; const int grow = lane >> 4, gc16 = lane & 15;
  bf16_t* Gw = Gm + (size_t)(wid * QBLK + grow) * DM + gc16 * 8;
#pragma unroll
  for (int i = 0; i < 8; ++i) gt[i] = __builtin_nontemporal_load((const u32x4*)(Gw + (size_t)(4 * i) * DM));
  if (hi == 0) li_l[r32] = l_reg;
  __syncthreads();
  char* ot = lds + OFF_OT + wid * (32 * OT_PITCH);
#pragma unroll
  for (int r = 0; r < 16; ++r) { const float rl = __builtin_amdgcn_rcpf(li_l[crow(r, hi)]); char* orow = ot + crow(r, hi) * OT_PITCH + r32 * 2;
#pragma unroll
    for (int d0 = 0; d0 < 4; ++d0) *(bf16_t*)(orow + d0 * 64) = f2bf(o[d0][r] * rl); }
  asm volatile("s_waitcnt lgkmcnt(0)" ::: "memory");
#pragma unroll
  for (int i = 0; i < 8; ++i) { const u32x4 ov = *(const u32x4*)(ot + (grow + 4 * i) * OT_PITCH + gc16 * 16); const u32x4 gv = gt[i]; u32x4 w;
#pragma unroll
    for (int e = 0; e < 4; ++e) { const float g0_ = __uint_as_float(gv[e] << 16), g1_ = __uint_as_float(gv[e] & 0xffff0000u); const float a0 = __uint_as_float(ov[e] << 16) * (GATE_IN_EPI ? g0_ : silu_f(g0_)), a1 = __uint_as_float(ov[e] & 0xffff0000u) * (GATE_IN_EPI ? g1_ : silu_f(g1_)); w[e] = cvt_pk_bf16(a0, a1); }
    *(u32x4*)(Gw + (size_t)(4 * i) * DM) = w; }
#undef DMA3
#undef LANDED
#undef RESC
#undef KNB
#undef KRB
}

#ifndef ATT4_SMFIRST
#define ATT4_SMFIRST 1
#endif
#ifndef ATT4_QLDS
#define ATT4_QLDS 4
#endif
constexpr int Q4LDS = ATT4_QLDS, Q4REG = 12 - Q4LDS;
constexpr int O4_V = 0, O4_KN = 2 * SHM_V, O4_KR = O4_KN + 2 * SHM_KN, O4_WS = O4_KR + 2 * SHM_KR, O4_QL = O4_WS + NW * 64 * 4, SHM_ATTN4 = O4_QL + NW * Q4LDS * 1024;
static_assert(SHM_ATTN4 <= RING_BYTES && NW * 32 * OT_PITCH <= O4_WS, "attention (staggered variant) LDS must fit the phase scratch");
__device__ __forceinline__ void attn_body4(const bf16_t* __restrict__ Qb, const bf16_t* __restrict__ Kn, const bf16_t* __restrict__ Kr,
                                           bf16_t* __restrict__ Gm, int seq, char* lds, LAS unsigned char* ldsL, int tid) {
  const int wid = __builtin_amdgcn_readfirstlane(tid >> 6), lane = tid & 63, r32 = lane & 31, hi = lane >> 5;
  float* ws = (float*)(lds + O4_WS) + wid * 64; float* li_l = ws; float* al_l = ws + 32;
  float m_reg = -1e30f, l_reg = 0; f32x16 o[4] = {}; bf16x8 qr[Q4REG > 0 ? Q4REG : 1];
  char* ql = lds + O4_QL + wid * (Q4LDS * 1024) + lane * 16;
  unsigned vo[2], ko[2], ro;
#pragma unroll
  for (int u = 0; u < 2; ++u) { const int t = 2 * wid + u;
    { const int s = 2 * t + (lane >> 5), kk = (s >> 2) * 8 + ((lane & 31) >> 2), k = (kk & ~0xC) | ((kk & 4) << 1) | ((kk & 8) >> 1), c = (s & 3) * 32 + (lane & 3) * 8; vo[u] = (unsigned)(k * NKV + 128 + c) * 2u; }
    { const int row = 4 * t + (lane >> 4), c = (lane & 15) ^ (row & 15); ko[u] = (unsigned)(row * NKV) * 2u + (unsigned)c * 16u; } }
  { const int row = 8 * wid + (lane >> 3), ch = (lane & 7) ^ ((row >> 1) & 7); ro = (unsigned)row * 128u + (unsigned)ch * 16u; }
#define DMAK(k0, b) do { const char* kb_ = (const char*)(Kn + (long)(k0) * NKV); const char* rb_ = (const char*)(Kr + (long)(k0) * 64); \
    __builtin_amdgcn_global_load_lds((const unsigned*)(kb_ + ko[0]), (LAS unsigned*)(ldsL + O4_KN + (b) * SHM_KN + (2 * wid) * 1024), 16, 0, 0); \
    __builtin_amdgcn_global_load_lds((const unsigned*)(kb_ + ko[1]), (LAS unsigned*)(ldsL + O4_KN + (b) * SHM_KN + (2 * wid + 1) * 1024), 16, 0, 0); \
    __builtin_amdgcn_global_load_lds((const unsigned*)(rb_ + ro), (LAS unsigned*)(ldsL + O4_KR + (b) * SHM_KR + wid * 1024), 16, 0, 0); } while (0)
#define DMAV(k0, b) do { const char* kb_ = (const char*)(Kn + (long)(k0) * NKV); \
    __builtin_amdgcn_global_load_lds((const unsigned*)(kb_ + vo[0]), (LAS unsigned*)(ldsL + O4_V + (b) * SHM_V + (2 * wid) * 1024), 16, 0, 0); \
    __builtin_amdgcn_global_load_lds((const unsigned*)(kb_ + vo[1]), (LAS unsigned*)(ldsL + O4_V + (b) * SHM_V + (2 * wid + 1) * 1024), 16, 0, 0); } while (0)
#define SLOT_END() do { asm volatile("s_waitcnt vmcnt(0)" ::: "memory"); __syncthreads(); } while (0)
#define XBAR() do { asm volatile("s_waitcnt vmcnt(0) lgkmcnt(0)" ::: "memory"); __builtin_amdgcn_s_barrier(); asm volatile("" ::: "memory"); } while (0)
#define RESC(a) do { if (__any((a) < 1.f)) { if (hi == 0) al_l[r32] = (a); asm volatile("s_waitcnt lgkmcnt(0)" ::: "memory"); \
    for (int d = 0; d < 4; ++d) for (int r = 0; r < 16; ++r) o[d][r] *= al_l[crow(r, hi)]; } } while (0)
#if ATT4_SMFIRST
#define B4_ORDER(PV, SM) do { SM; SBAR(); PV; } while (0)
#else
#define B4_ORDER(PV, SM) do { PV; SM; } while (0)
#endif
#define KNB(b) (lds + O4_KN + (b) * SHM_KN)
#define KRB(b) (lds + O4_KR + (b) * SHM_KR)
  DMAK(0, 0);
  const unsigned qoff = (unsigned)((wid * QBLK + r32) * NQ + hi * 8) * 2u;
#pragma unroll
  for (int d0 = 0; d0 < 12; ++d0) { const bf16x8 qv = *(const bf16x8*)((const char*)Qb + qoff + d0 * 32); if (d0 < Q4REG) qr[d0 < Q4REG ? d0 : 0] = qv; else *reinterpret_cast<bf16x8*>(ql + (d0 - Q4REG) * 1024) = qv; }
  const int vb0 = (int)(uintptr_t)(lds + O4_V) + v_rd_base(lane);
  f32x16 pA0, pA1, pB0, pB1; float mnA, mnB, alA, alB; bf16x8 pa0, pa1, pa2, pa3; const int NT = seq / KVBLK;
  SLOT_END();
  if (wid >= 4) XBAR();
  DMAK(KVBLK, 1); qkt<Q4REG>(pA0, pA1, KNB(0), KRB(0), qr, ql, r32, hi); SLOT_END();
  DMAV(0, 0); partialSM(pA0, pA1, m_reg, mnA, alA); SLOT_END();
  for (int j = 1; j + 1 < NT; j += 2) {
    DMAK((j + 1) * KVBLK, 0); SBAR(); qkt<Q4REG>(pB0, pB1, KNB(1), KRB(1), qr, ql, r32, hi);
    finishSM(pA0, pA1, alA, l_reg, pa0, pa1, pa2, pa3); SLOT_END();
    DMAV(j * KVBLK, 1); SBAR(); B4_ORDER(pv_d0(o, vb0, pa0, pa1, pa2, pa3), partialSM(pB0, pB1, m_reg, mnB, alB));
    RESC(alB); SLOT_END();
    DMAK((j + 2) * KVBLK, 1); SBAR(); qkt<Q4REG>(pA0, pA1, KNB(0), KRB(0), qr, ql, r32, hi);
    finishSM(pB0, pB1, alB, l_reg, pa0, pa1, pa2, pa3); SLOT_END();
    DMAV((j + 1) * KVBLK, 0); SBAR(); B4_ORDER(pv_d0(o, vb0 + (int)SHM_V, pa0, pa1, pa2, pa3), partialSM(pA0, pA1, m_reg, mnA, alA));
    RESC(alA); SLOT_END();
  }
  SBAR(); qkt<Q4REG>(pB0, pB1, KNB(1), KRB(1), qr, ql, r32, hi);
  finishSM(pA0, pA1, alA, l_reg, pa0, pa1, pa2, pa3); SLOT_END();
  DMAV((NT - 1) * KVBLK, 1); SBAR(); B4_ORDER(pv_d0(o, vb0, pa0, pa1, pa2, pa3), partialSM(pB0, pB1, m_reg, mnB, alB));
  RESC(alB); SLOT_END();
  finishSM(pB0, pB1, alB, l_reg, pa0, pa1, pa2, pa3); SLOT_END();
  pv_d0(o, vb0 + (int)SHM_V, pa0, pa1, pa2, pa3);
  if (wid < 4) XBAR();
  SBAR(); asm volatile("" ::: "memory");
  u32x4 gt[8]; const int grow = lane >> 4, gc16 = lane & 15;
  bf16_t* Gw = Gm + (size_t)(wid * QBLK + grow) * DM + gc16 * 8;
#pragma unroll
  for (int i = 0; i < 8; ++i) gt[i] = __builtin_nontemporal_load((const u32x4*)(Gw + (size_t)(4 * i) * DM));
  if (hi == 0) li_l[r32] = l_reg;
  __syncthreads();
  char* ot = lds + OFF_OT + wid * (32 * OT_PITCH);
#pragma unroll
  for (int r = 0; r < 16; ++r) { const float rl = __builtin_amdgcn_rcpf(li_l[crow(r, hi)]); char* orow = ot + crow(r, hi) * OT_PITCH + r32 * 2;
#pragma unroll
    for (int d0 = 0; d0 < 4; ++d0) *(bf16_t*)(orow + d0 * 64) = f2bf(o[d0][r] * rl); }
  asm volatile("s_waitcnt lgkmcnt(0)" ::: "memory");
#pragma unroll
  for (int i = 0; i < 8; ++i) { const u32x4 ov = *(const u32x4*)(ot + (grow + 4 * i) * OT_PITCH + gc16 * 16); const u32x4 gv = gt[i]; u32x4 w;
#pragma unroll
    for (int e = 0; e < 4; ++e) { const float g0_ = __uint_as_float(gv[e] << 16), g1_ = __uint_as_float(gv[e] & 0xffff0000u); const float a0 = __uint_as_float(ov[e] << 16) * (GATE_IN_EPI ? g0_ : silu_f(g0_)), a1 = __uint_as_float(ov[e] & 0xffff0000u) * (GATE_IN_EPI ? g1_ : silu_f(g1_)); w[e] = cvt_pk_bf16(a0, a1); }
    *(u32x4*)(Gw + (size_t)(4 * i) * DM) = w; }
#undef DMAK
#undef DMAV
#undef SLOT_END
#undef XBAR
#undef RESC
#undef KNB
#undef KRB
}

#ifndef ATT_STAGR
#define ATT_STAGR 0
#endif
#ifndef ATT6_QLDS
#define ATT6_QLDS 6
#endif
constexpr int Q6LDS = ATT6_QLDS, Q6REG = 12 - Q6LDS;
constexpr int O6_QL = O4_WS + NW * 64 * 4, SHM_ATTN6 = O6_QL + NW * Q6LDS * 1024;
static_assert(SHM_ATTN6 <= RING_BYTES, "attention (staggered register-staged variant) LDS must fit the phase scratch");
__device__ __forceinline__ void attn_body6(const bf16_t* __restrict__ Qb, const bf16_t* __restrict__ Kn, const bf16_t* __restrict__ Kr,
                                           bf16_t* __restrict__ Gm, int seq, char* lds, LAS unsigned char* ldsL, int tid) {
  const int wid = __builtin_amdgcn_readfirstlane(tid >> 6), lane = tid & 63, r32 = lane & 31, hi = lane >> 5;
  float* ws = (float*)(lds + O4_WS) + wid * 64; float* li_l = ws; float* al_l = ws + 32;
  float m_reg = -1e30f, l_reg = 0; f32x16 o[4] = {}; bf16x8 qr[Q6REG > 0 ? Q6REG : 1];
  char* ql = lds + O6_QL + wid * (Q6LDS * 1024) + lane * 16;
  const int sr = tid >> 4, sc = (tid & 15) * 8, vst0 = v_st(sr, sc), vst1 = v_st(32 + sr, sc), rr_ = tid >> 3, rc_ = tid & 7;
  const unsigned voff = (unsigned)(sr * NKV + sc) * 2u, voffr = (unsigned)(rr_ * 64 + rc_ * 8) * 2u;
  bf16x8 sg0, sg1, sg2;
#define DMAK(k0, b) do { const char* kb_ = (const char*)(Kn + (long)(k0) * NKV); const char* rb_ = (const char*)(Kr + (long)(k0) * 64); \
    sg0 = *(const bf16x8*)(kb_ + voff); sg1 = *(const bf16x8*)(kb_ + 32 * NKV * 2 + voff); sg2 = *(const bf16x8*)(rb_ + voffr); } while (0)
#define WRK(b) do { const int kc = sc * 2; *(bf16x8*)(lds + O4_KN + (b) * SHM_KN + KSWZ(sr, kc)) = sg0; *(bf16x8*)(lds + O4_KN + (b) * SHM_KN + KSWZ(32 + sr, kc)) = sg1; \
    *(bf16x8*)(lds + O4_KR + (b) * SHM_KR + RSWZ(rr_, rc_)) = sg2; } while (0)
#define DMAV(k0, b) do { const char* kb_ = (const char*)(Kn + (long)(k0) * NKV); sg0 = *(const bf16x8*)(kb_ + 256 + voff); sg1 = *(const bf16x8*)(kb_ + (32 * NKV * 2 + 256) + voff); } while (0)
#define WRV(b) do { *(bf16x8*)(lds + O4_V + (b) * SHM_V + vst0) = sg0; *(bf16x8*)(lds + O4_V + (b) * SHM_V + vst1) = sg1; } while (0)
#define SLOT_END() do { asm volatile("s_waitcnt vmcnt(0)" ::: "memory"); __syncthreads(); } while (0)
#define XBAR() do { asm volatile("s_waitcnt vmcnt(0) lgkmcnt(0)" ::: "memory"); __builtin_amdgcn_s_barrier(); asm volatile("" ::: "memory"); } while (0)
#define RESC(a) do { if (__any((a) < 1.f)) { if (hi == 0) al_l[r32] = (a); asm volatile("s_waitcnt lgkmcnt(0)" ::: "memory"); \
    for (int d = 0; d < 4; ++d) for (int r = 0; r < 16; ++r) o[d][r] *= al_l[crow(r, hi)]; } } while (0)
#if ATT4_SMFIRST
#define B4_ORDER(PV, SM) do { SM; SBAR(); PV; } while (0)
#else
#define B4_ORDER(PV, SM) do { PV; SM; } while (0)
#endif
#define KNB(b) (lds + O4_KN + (b) * SHM_KN)
#define KRB(b) (lds + O4_KR + (b) * SHM_KR)
  DMAK(0, 0);
  const unsigned qoff = (unsigned)((wid * QBLK + r32) * NQ + hi * 8) * 2u;
#pragma unroll
  for (int d0 = 0; d0 < 12; ++d0) { const bf16x8 qv = *(const bf16x8*)((const char*)Qb + qoff + d0 * 32); if (d0 < Q6REG) qr[d0 < Q6REG ? d0 : 0] = qv; else *reinterpret_cast<bf16x8*>(ql + (d0 - Q6REG) * 1024) = qv; }
  const int vb0 = (int)(uintptr_t)(lds + O4_V) + v_rd_base(lane);
  f32x16 pA0, pA1, pB0, pB1; float mnA, mnB, alA, alB; bf16x8 pa0, pa1, pa2, pa3; const int NT = seq / KVBLK;
  WRK(0); SLOT_END();
  if (wid >= 4) XBAR();
  DMAK(KVBLK, 1); qkt<Q6REG>(pA0, pA1, KNB(0), KRB(0), qr, ql, r32, hi); WRK(1); SLOT_END();
  DMAV(0, 0); partialSM(pA0, pA1, m_reg, mnA, alA); WRV(0); SLOT_END();
  for (int j = 1; j + 1 < NT; j += 2) {
    DMAK((j + 1) * KVBLK, 0); SBAR(); qkt<Q6REG>(pB0, pB1, KNB(1), KRB(1), qr, ql, r32, hi);
    finishSM(pA0, pA1, alA, l_reg, pa0, pa1, pa2, pa3); WRK(0); SLOT_END();
    DMAV(j * KVBLK, 1); SBAR(); B4_ORDER(pv_d0(o, vb0, pa0, pa1, pa2, pa3), partialSM(pB0, pB1, m_reg, mnB, alB));
    RESC(alB); WRV(1); SLOT_END();
    DMAK((j + 2) * KVBLK, 1); SBAR(); qkt<Q6REG>(pA0, pA1, KNB(0), KRB(0), qr, ql, r32, hi);
    finishSM(pB0, pB1, alB, l_reg, pa0, pa1, pa2, pa3); WRK(1); SLOT_END();
    DMAV((j + 1) * KVBLK, 0); SBAR(); B4_ORDER(pv_d0(o, vb0 + (int)SHM_V, pa0, pa1, pa2, pa3), partialSM(pA0, pA1, m_reg, mnA, alA));
    RESC(alA); WRV(0); SLOT_END();
  }
  SBAR(); qkt<Q6REG>(pB0, pB1, KNB(1), KRB(1), qr, ql, r32, hi);
  finishSM(pA0, pA1, alA, l_reg, pa0, pa1, pa2, pa3); SLOT_END();
  DMAV((NT - 1) * KVBLK, 1); SBAR(); B4_ORDER(pv_d0(o, vb0, pa0, pa1, pa2, pa3), partialSM(pB0, pB1, m_reg, mnB, alB));
  RESC(alB); WRV(1); SLOT_END();
  finishSM(pB0, pB1, alB, l_reg, pa0, pa1, pa2, pa3); SLOT_END();
  pv_d0(o, vb0 + (int)SHM_V, pa0, pa1, pa2, pa3);
  if (wid < 4) XBAR();
  SBAR(); asm volatile("" ::: "memory");
  u32x4 gt[8]; const int grow = lane >> 4, gc16 = lane & 15;
  bf16_t* Gw = Gm + (size_t)(wid * QBLK + grow) * DM + gc16 * 8;
#pragma unroll
  for (int i = 0; i < 8; ++i) gt[i] = __builtin_nontemporal_load((const u32x4*)(Gw + (size_t)(4 * i) * DM));
  if (hi == 0) li_l[r32] = l_reg;
  __syncthreads();
  char* ot = lds + OFF_OT + wid * (32 * OT_PITCH);
#pragma unroll
  for (int r = 0; r < 16; ++r) { const float rl = __builtin_amdgcn_rcpf(li_l[crow(r, hi)]); char* orow = ot + crow(r, hi) * OT_PITCH + r32 * 2;
#pragma unroll
    for (int d0 = 0; d0 < 4; ++d0) *(bf16_t*)(orow + d0 * 64) = f2bf(o[d0][r] * rl); }
  asm volatile("s_waitcnt lgkmcnt(0)" ::: "memory");
#pragma unroll
  for (int i = 0; i < 8; ++i) { const u32x4 ov = *(const u32x4*)(ot + (grow + 4 * i) * OT_PITCH + gc16 * 16); const u32x4 gv = gt[i]; u32x4 w;
#pragma unroll
    for (int e = 0; e < 4; ++e) { const float g0_ = __uint_as_float(gv[e] << 16), g1_ = __uint_as_float(gv[e] & 0xffff0000u); const float a0 = __uint_as_float(ov[e] << 16) * (GATE_IN_EPI ? g0_ : silu_f(g0_)), a1 = __uint_as_float(ov[e] & 0xffff0000u) * (GATE_IN_EPI ? g1_ : silu_f(g1_)); w[e] = cvt_pk_bf16(a0, a1); }
    *(u32x4*)(Gw + (size_t)(4 * i) * DM) = w; }
#undef WRK
#undef WRV
#undef DMAK
#undef DMAV
#undef SLOT_END
#undef XBAR
#undef RESC
#undef KNB
#undef KRB
}
}

namespace att16 {
using att::tr_read; using att::ld8;
constexpr int NW = 8, QBLK = 32, KVBLK = 64;
constexpr float THR = 8.f;
#ifndef ATT16_QLDS
#define ATT16_QLDS 8
#endif
constexpr int QLDS = ATT16_QLDS, QREG = 12 - QLDS;
constexpr int SHM_V = KVBLK * 128 * 2, SHM_KN = KVBLK * 128 * 2, SHM_KR = KVBLK * 64 * 2;
constexpr int OFF_V = 0, OFF_KN = 2 * SHM_V, OFF_KR = OFF_KN + 2 * SHM_KN, OFF_WS = OFF_KR + 2 * SHM_KR, OFF_QL = OFF_WS + NW * 64 * 4, OT_PITCH = 272, SHM_ATTN = OFF_QL + NW * QLDS * 1024;
static_assert(SHM_ATTN <= RING_BYTES && NW * 32 * OT_PITCH <= OFF_WS, "attention (16x16 variant) LDS must fit the phase scratch");
__device__ __forceinline__ int v_st(int k, int c) { return ((k >> 3) * 8 + (c >> 4)) * 256 + (k & 7) * 32 + (c & 15) * 2; }
__device__ __forceinline__ int v_rd_base(int lane) { const int g = lane >> 4, c = lane & 15; return (g >> 1) * 2048 + (g & 1) * 128 + (c >> 2) * 32 + (c & 3) * 8; }
constexpr int v_rd_off(int db, int s, int h) { return s * 8192 + h * 4096 + db * 256; }
__device__ __forceinline__ float xmax4(float x) {
  { auto r = __builtin_amdgcn_permlane16_swap(__float_as_uint(x), __float_as_uint(x), false, false); x = fmaxf(__uint_as_float(r[0]), __uint_as_float(r[1])); }
  { auto r = __builtin_amdgcn_permlane32_swap(__float_as_uint(x), __float_as_uint(x), false, false); x = fmaxf(__uint_as_float(r[0]), __uint_as_float(r[1])); }
  return x; }
__device__ __forceinline__ float xsum4(float x) {
  { auto r = __builtin_amdgcn_permlane16_swap(__float_as_uint(x), __float_as_uint(x), false, false); x = __uint_as_float(r[0]) + __uint_as_float(r[1]); }
  { auto r = __builtin_amdgcn_permlane32_swap(__float_as_uint(x), __float_as_uint(x), false, false); x = __uint_as_float(r[0]) + __uint_as_float(r[1]); }
  return x; }
typedef f32x4 PT[2][4];
__device__ __forceinline__ void partialSM(PT& p, float (&m_reg)[2], float (&mn)[2], float (&alpha)[2]) {
  constexpr float C = ATT_SCALE * 1.4426950408889634f;
  float pm[2];
#pragma unroll
  for (int qb = 0; qb < 2; ++qb) { float x = p[qb][0][0];
#pragma unroll
    for (int kb = 0; kb < 4; ++kb)
#pragma unroll
      for (int r = 0; r < 4; ++r) x = fmaxf(x, p[qb][kb][r]);
    pm[qb] = xmax4(x); }
  if (__builtin_expect(__all((pm[0] - m_reg[0] <= THR / ATT_SCALE) && (pm[1] - m_reg[1] <= THR / ATT_SCALE)), 1)) { mn[0] = m_reg[0]; mn[1] = m_reg[1]; alpha[0] = 1.f; alpha[1] = 1.f; }
  else {
#pragma unroll
    for (int qb = 0; qb < 2; ++qb) { mn[qb] = fmaxf(m_reg[qb], pm[qb]); alpha[qb] = __builtin_amdgcn_exp2f((m_reg[qb] - mn[qb]) * C); m_reg[qb] = mn[qb]; } }
#pragma unroll
  for (int qb = 0; qb < 2; ++qb) { const float mnC = -mn[qb] * C;
#pragma unroll
    for (int kb = 0; kb < 4; ++kb)
#pragma unroll
      for (int r = 0; r < 4; ++r) p[qb][kb][r] = fmaf(p[qb][kb][r], C, mnC); }
#pragma unroll
  for (int qb = 0; qb < 2; ++qb)
#pragma unroll
    for (int kb = 0; kb < 2; ++kb)
#pragma unroll
      for (int r = 0; r < 4; ++r) p[qb][kb][r] = __builtin_amdgcn_exp2f(p[qb][kb][r]);
}
__device__ __forceinline__ bf16x8 pack8(f32x4 a, f32x4 b) { u32x4 w = {cvt_pk_bf16(a[0], a[1]), cvt_pk_bf16(a[2], a[3]), cvt_pk_bf16(b[0], b[1]), cvt_pk_bf16(b[2], b[3])}; return __builtin_bit_cast(bf16x8, w); }
__device__ __forceinline__ void finishSM(PT& p, const float (&alpha)[2], float (&l_reg)[2], bf16x8 (&pa)[2][2]) {
#pragma unroll
  for (int qb = 0; qb < 2; ++qb)
#pragma unroll
    for (int kb = 2; kb < 4; ++kb)
#pragma unroll
      for (int r = 0; r < 4; ++r) p[qb][kb][r] = __builtin_amdgcn_exp2f(p[qb][kb][r]);
#pragma unroll
  for (int qb = 0; qb < 2; ++qb) { float ps = 0.f;
#pragma unroll
    for (int kb = 0; kb < 4; ++kb) ps += (p[qb][kb][0] + p[qb][kb][1]) + (p[qb][kb][2] + p[qb][kb][3]);
    l_reg[qb] = l_reg[qb] * alpha[qb] + xsum4(ps);
    pa[qb][0] = pack8(p[qb][0], p[qb][1]); pa[qb][1] = pack8(p[qb][2], p[qb][3]); }
}
__device__ __forceinline__ bf16x8 kfrag(const char* Kn, const char* Kr, int i, int c, int g) {
  const int ks = i >> 2, kb = i & 3, row = 16 * kb + c;
  if (ks < 4) return *reinterpret_cast<const bf16x8*>(Kn + KSWZ(row, (4 * ks + g) * 16));
  return *reinterpret_cast<const bf16x8*>(Kr + RSWZ(row, 4 * (ks - 4) + g));
}
__device__ __forceinline__ bf16x8 qsel(const bf16x8* qr, const char* ql, int f) { return f < QREG ? qr[f < QREG ? f : 0] : *reinterpret_cast<const bf16x8*>(ql + (f - QREG) * 1024); }
__device__ __forceinline__ void qkt(PT& p, const char* Kn, const char* Kr, const bf16x8* qr, const char* ql, int c, int g) {
#pragma unroll
  for (int qb = 0; qb < 2; ++qb)
#pragma unroll
    for (int kb = 0; kb < 4; ++kb) p[qb][kb] = (f32x4){0.f, 0.f, 0.f, 0.f};
  bf16x8 ka = kfrag(Kn, Kr, 0, c, g), kb_ = kfrag(Kn, Kr, 1, c, g), na, nb, q0 = qsel(qr, ql, 0), q1 = qsel(qr, ql, 6), q0n, q1n;
#pragma unroll
  for (int i = 0; i < 12; ++i) { const int ks = i >> 1, k2 = (i & 1) * 2;
    if (i + 1 < 12) { na = kfrag(Kn, Kr, 2 * i + 2, c, g); nb = kfrag(Kn, Kr, 2 * i + 3, c, g); }
    if ((i & 1) == 0 && ks + 1 < 6) { q0n = qsel(qr, ql, ks + 1); q1n = qsel(qr, ql, 6 + ks + 1); }
    SBAR();
    p[0][k2] = __builtin_amdgcn_mfma_f32_16x16x32_bf16(ka, q0, p[0][k2], 0, 0, 0);
    p[1][k2] = __builtin_amdgcn_mfma_f32_16x16x32_bf16(ka, q1, p[1][k2], 0, 0, 0);
    p[0][k2 + 1] = __builtin_amdgcn_mfma_f32_16x16x32_bf16(kb_, q0, p[0][k2 + 1], 0, 0, 0);
    p[1][k2 + 1] = __builtin_amdgcn_mfma_f32_16x16x32_bf16(kb_, q1, p[1][k2 + 1], 0, 0, 0);
    SBAR();
    ka = na; kb_ = nb; if (i & 1) { q0 = q0n; q1 = q1n; } }
}
#define TRPK16(L, H) (bf16x8){L[0], L[1], L[2], L[3], H[0], H[1], H[2], H[3]}
template <int DB> __device__ __forceinline__ void pv_two(f32x4& o00, f32x4& o10, f32x4& o01, f32x4& o11, int vb, const bf16x8 (&pa)[2][2]) {
  const s16x4 l0 = tr_read<v_rd_off(DB, 0, 0)>(vb), h0 = tr_read<v_rd_off(DB, 0, 1)>(vb), l1 = tr_read<v_rd_off(DB, 1, 0)>(vb), h1 = tr_read<v_rd_off(DB, 1, 1)>(vb);
  const s16x4 l2 = tr_read<v_rd_off(DB + 1, 0, 0)>(vb), h2 = tr_read<v_rd_off(DB + 1, 0, 1)>(vb), l3 = tr_read<v_rd_off(DB + 1, 1, 0)>(vb), h3 = tr_read<v_rd_off(DB + 1, 1, 1)>(vb);
  asm volatile("s_waitcnt lgkmcnt(0)" ::: "memory"); SBAR();
  o00 = __builtin_amdgcn_mfma_f32_16x16x32_bf16(pa[0][0], TRPK16(l0, h0), o00, 0, 0, 0);
  o10 = __builtin_amdgcn_mfma_f32_16x16x32_bf16(pa[1][0], TRPK16(l0, h0), o10, 0, 0, 0);
  o01 = __builtin_amdgcn_mfma_f32_16x16x32_bf16(pa[0][0], TRPK16(l2, h2), o01, 0, 0, 0);
  o11 = __builtin_amdgcn_mfma_f32_16x16x32_bf16(pa[1][0], TRPK16(l2, h2), o11, 0, 0, 0);
  o00 = __builtin_amdgcn_mfma_f32_16x16x32_bf16(pa[0][1], TRPK16(l1, h1), o00, 0, 0, 0);
  o10 = __builtin_amdgcn_mfma_f32_16x16x32_bf16(pa[1][1], TRPK16(l1, h1), o10, 0, 0, 0);
  o01 = __builtin_amdgcn_mfma_f32_16x16x32_bf16(pa[0][1], TRPK16(l3, h3), o01, 0, 0, 0);
  o11 = __builtin_amdgcn_mfma_f32_16x16x32_bf16(pa[1][1], TRPK16(l3, h3), o11, 0, 0, 0);
}
typedef f32x4 OT_[2][8];
__device__ __forceinline__ void pv_all(OT_& o, int vb, const bf16x8 (&pa)[2][2]) {
  pv_two<0>(o[0][0], o[1][0], o[0][1], o[1][1], vb, pa); pv_two<2>(o[0][2], o[1][2], o[0][3], o[1][3], vb, pa);
  pv_two<4>(o[0][4], o[1][4], o[0][5], o[1][5], vb, pa); pv_two<6>(o[0][6], o[1][6], o[0][7], o[1][7], vb, pa);
}
template <int VAR>
__device__ __forceinline__ void attn_body(const bf16_t* __restrict__ Qb, const bf16_t* __restrict__ Kn, const bf16_t* __restrict__ Kr,
                                          bf16_t* __restrict__ Gm, int seq, char* lds, int tid) {
  const int wid = tid >> 6, lane = tid & 63, c = lane & 15, g = lane >> 4;
  char* V_lds = lds + OFF_V; char* K_lds = lds + OFF_KN; char* R_lds = lds + OFF_KR;
  float* ws = (float*)(lds + OFF_WS) + wid * 64; float* li_l = ws; float* al_l = ws + 32;
  float m_reg[2] = {-1e30f, -1e30f}, l_reg[2] = {0.f, 0.f}; OT_ o;
#pragma unroll
  for (int qb = 0; qb < 2; ++qb)
#pragma unroll
    for (int db = 0; db < 8; ++db) o[qb][db] = (f32x4){0.f, 0.f, 0.f, 0.f};
  bf16x8 qr[QREG > 0 ? QREG : 1];
  char* ql = lds + OFF_QL + wid * (QLDS * 1024) + lane * 16;
#pragma unroll
  for (int f = 0; f < 12; ++f) { const int qb = f / 6, ks = f - qb * 6;
    const bf16x8 qv = *(const bf16x8*)((const char*)Qb + (unsigned)((wid * QBLK + 16 * qb + c) * NQ + 32 * ks + 8 * g) * 2u);
    if (f < QREG) qr[f < QREG ? f : 0] = qv; else *reinterpret_cast<bf16x8*>(ql + (f - QREG) * 1024) = qv; }
  const int sr = tid >> 4, sc = (tid & 15) * 8, vst0 = v_st(sr, sc), vst1 = v_st(32 + sr, sc);
  const int rr_ = tid >> 3, rc_ = tid & 7;
  const int vb0 = (int)(uintptr_t)V_lds + v_rd_base(lane);
  struct { bf16x8 vs0, vs1, ks0, ks1, kr; } sr_;
  const unsigned voff = (unsigned)(sr * NKV + sc) * 2u, voffr = (unsigned)(rr_ * 64 + rc_ * 8) * 2u;
#define SLOAD(k0) do { const char* kb_ = (const char*)(Kn + (long)(k0) * NKV); const char* rb_ = (const char*)(Kr + (long)(k0) * 64); \
    sr_.vs0 = *(const bf16x8*)(kb_ + 256 + voff); sr_.vs1 = *(const bf16x8*)(kb_ + (32 * NKV * 2 + 256) + voff); \
    sr_.ks0 = *(const bf16x8*)(kb_ + voff); sr_.ks1 = *(const bf16x8*)(kb_ + 32 * NKV * 2 + voff); \
    sr_.kr = *(const bf16x8*)(rb_ + voffr); } while (0)
#define SWRITE(b) do { *(bf16x8*)(V_lds + (b) * SHM_V + vst0) = sr_.vs0; *(bf16x8*)(V_lds + (b) * SHM_V + vst1) = sr_.vs1; const int kc_ = sc * 2; \
    *(bf16x8*)(K_lds + (b) * SHM_KN + KSWZ(sr, kc_)) = sr_.ks0; *(bf16x8*)(K_lds + (b) * SHM_KN + KSWZ(32 + sr, kc_)) = sr_.ks1; \
    *(bf16x8*)(R_lds + (b) * SHM_KR + RSWZ(rr_, rc_)) = sr_.kr; } while (0)
#define SWAIT() asm volatile("s_waitcnt vmcnt(0)" ::: "memory")
#define RESC(a) do { if (__any(((a)[0] < 1.f) || ((a)[1] < 1.f))) { if (g == 0) { al_l[c] = (a)[0]; al_l[16 + c] = (a)[1]; } asm volatile("s_waitcnt lgkmcnt(0)" ::: "memory"); \
    _Pragma("unroll") for (int qb = 0; qb < 2; ++qb) { const f32x4 av = *(const f32x4*)(al_l + 16 * qb + 4 * g); _Pragma("unroll") for (int db = 0; db < 8; ++db) o[qb][db] *= av; } } } while (0)
  PT pA, pB; float mnA[2], mnB[2], alA[2], alB[2]; bf16x8 pa[2][2]; const int NT = seq / KVBLK;
#define QKT(P, KN, KR) do { if constexpr (VAR == 3) { _Pragma("unroll") for (int qb_ = 0; qb_ < 2; ++qb_) _Pragma("unroll") for (int kb_ = 0; kb_ < 4; ++kb_) P[qb_][kb_] = o[qb_][kb_]; } else qkt(P, KN, KR, qr, ql, c, g); } while (0)
#define PSM(P, MN, AL) do { if constexpr (VAR == 1) { MN[0] = m_reg[0]; MN[1] = m_reg[1]; AL[0] = 1.f; AL[1] = 1.f; } else partialSM(P, m_reg, MN, AL); } while (0)
#define FSM(P, AL) do { if constexpr (VAR == 1) { pa[0][0] = __builtin_bit_cast(bf16x8, P[0][0]); pa[0][1] = __builtin_bit_cast(bf16x8, P[0][1]); pa[1][0] = __builtin_bit_cast(bf16x8, P[1][0]); pa[1][1] = __builtin_bit_cast(bf16x8, P[1][1]); l_reg[0] += P[0][2][0]; l_reg[1] += P[1][3][1]; } \
    else finishSM(P, AL, l_reg, pa); } while (0)
#define PVD(VB) do { if constexpr (VAR == 2) { o[0][0] += __builtin_bit_cast(f32x4, pa[0][0]); o[1][1] += __builtin_bit_cast(f32x4, pa[1][1]); o[0][2] += __builtin_bit_cast(f32x4, pa[0][1]); o[1][3] += __builtin_bit_cast(f32x4, pa[1][0]); } else pv_all(o, VB, pa); } while (0)
  SLOAD(0); SWAIT(); SWRITE(0); __syncthreads();
  QKT(pA, K_lds, R_lds); PSM(pA, mnA, alA);
  SLOAD(KVBLK); SWAIT(); SWRITE(1); __syncthreads();
  for (int j = 1; j + 1 < NT; j += 2) {
    SBAR(); QKT(pB, K_lds + SHM_KN, R_lds + SHM_KR);
    FSM(pA, alA); SBAR();
    SLOAD((j + 1) * KVBLK); SBAR();
    PVD(vb0); PSM(pB, mnB, alB);
    __syncthreads(); SWAIT(); SWRITE(0);
    RESC(alB); __syncthreads();
    SBAR(); QKT(pA, K_lds, R_lds);
    FSM(pB, alB); SBAR();
    SLOAD((j + 2) * KVBLK); SBAR();
    PVD(vb0 + (int)SHM_V); PSM(pA, mnA, alA);
    __syncthreads(); SWAIT(); SWRITE(1);
    RESC(alA); __syncthreads();
  }
  SBAR(); QKT(pB, K_lds + SHM_KN, R_lds + SHM_KR);
  FSM(pA, alA); SBAR();
  PVD(vb0); PSM(pB, mnB, alB);
  __syncthreads(); RESC(alB);
  FSM(pB, alB); SBAR();
  PVD(vb0 + (int)SHM_V);
  SBAR(); asm volatile("" ::: "memory");
  u32x4 gt[8]; const int grow = lane >> 4, gc16 = lane & 15;
  bf16_t* Gw = Gm + (size_t)(wid * QBLK + grow) * DM + gc16 * 8;
#pragma unroll
  for (int i = 0; i < 8; ++i) gt[i] = __builtin_nontemporal_load((const u32x4*)(Gw + (size_t)(4 * i) * DM));
  if (g == 0) { li_l[c] = l_reg[0]; li_l[16 + c] = l_reg[1]; }
  __syncthreads();
  char* ot = lds + wid * (32 * OT_PITCH);
#pragma unroll
  for (int qb = 0; qb < 2; ++qb) { const f32x4 lv = *(const f32x4*)(li_l + 16 * qb + 4 * g);
#pragma unroll
    for (int r = 0; r < 4; ++r) { const float rl = __builtin_amdgcn_rcpf(lv[r]); char* orow = ot + (16 * qb + 4 * g + r) * OT_PITCH + c * 2;
#pragma unroll
      for (int db = 0; db < 8; ++db) *(bf16_t*)(orow + db * 32) = f2bf(o[qb][db][r] * rl); } }
  asm volatile("s_waitcnt lgkmcnt(0)" ::: "memory");
#pragma unroll
  for (int i = 0; i < 8; ++i) { const u32x4 ov = *(const u32x4*)(ot + (grow + 4 * i) * OT_PITCH + gc16 * 16); const u32x4 gv = gt[i]; u32x4 w;
#pragma unroll
    for (int e = 0; e < 4; ++e) { const float g0_ = __uint_as_float(gv[e] << 16), g1_ = __uint_as_float(gv[e] & 0xffff0000u); const float a0 = __uint_as_float(ov[e] << 16) * (GATE_IN_EPI ? g0_ : silu_f(g0_)), a1 = __uint_as_float(ov[e] & 0xffff0000u) * (GATE_IN_EPI ? g1_ : silu_f(g1_)); w[e] = cvt_pk_bf16(a0, a1); }
    *(u32x4*)(Gw + (size_t)(4 * i) * DM) = w; }
#undef SLOAD
#undef QKT
#undef PSM
#undef FSM
#undef PVD
#undef SWRITE
#undef SWAIT
#undef RESC
}
}
namespace atth {
using att::tr_read; using att::crow; using att::partialSM; using att::kfrag; using att::qfrag;
constexpr int NW = 8, QBLK = 32, KVBLK = 64;
#ifndef ATTH_QLDS
#define ATTH_QLDS 6
#endif
constexpr int QLDS = ATTH_QLDS, QREG = 12 - QLDS;
constexpr int SHM_V = KVBLK * 128 * 2, SHM_KN = KVBLK * 128 * 2, SHM_KR = KVBLK * 64 * 2;
constexpr int OFF_V = 0, OFF_KN = 2 * SHM_V, OFF_KR = OFF_KN + 2 * SHM_KN, OFF_WS = OFF_KR + 2 * SHM_KR, OFF_QL = OFF_WS + NW * 64 * 4, OT_PITCH = 272, SHM_ATTN = OFF_QL + NW * QLDS * 1024;
static_assert(SHM_ATTN <= RING_BYTES && NW * 32 * OT_PITCH <= OFF_WS, "attention (hybrid variant) LDS must fit the phase scratch");
__device__ __forceinline__ int v_st(int k, int c) { const int kp = (k & ~0x14) | ((k & 4) << 2) | ((k & 16) >> 2); return (c >> 4) * 2048 + kp * 32 + (c & 15) * 2; }
__device__ __forceinline__ int v_rd_base(int lane) { const int g = lane >> 4, c = lane & 15; return (g >> 1) * 512 + (g & 1) * 128 + (c >> 2) * 32 + (c & 3) * 8; }
constexpr int v_rd_off(int db, int s, int h) { return db * 2048 + s * 1024 + h * 256; }
__device__ __forceinline__ void finishSM(f32x16& p0, f32x16& p1, float alpha, float& l_reg, bf16x8 (&pa)[2][2]) {
  for (int r = 0; r < 16; ++r) p1[r] = __builtin_amdgcn_exp2f(p1[r]);
  float ps = 0; for (int r = 0; r < 16; ++r) ps += p0[r]; for (int r = 0; r < 16; ++r) ps += p1[r];
  { auto rr = __builtin_amdgcn_permlane32_swap(__float_as_uint(ps), __float_as_uint(ps), false, false);
    ps = __uint_as_float(rr[0]) + __uint_as_float(rr[1]); }
  l_reg = l_reg * alpha + ps;
#define RELAY(P, S) do { u32x4 wa, wb; \
    _Pragma("unroll") for (int i = 0; i < 4; ++i) { const unsigned a_ = cvt_pk_bf16(P[2 * i], P[2 * i + 1]), b_ = cvt_pk_bf16(P[8 + 2 * i], P[8 + 2 * i + 1]); \
      auto r_ = __builtin_amdgcn_permlane16_swap(a_, b_, false, false); wa[i] = r_[0]; wb[i] = r_[1]; } \
    pa[0][S] = __builtin_bit_cast(bf16x8, wa); pa[1][S] = __builtin_bit_cast(bf16x8, wb); } while (0)
  RELAY(p0, 0); RELAY(p1, 1);
#undef RELAY
}
#define TRPKH(L, H) (bf16x8){L[0], L[1], L[2], L[3], H[0], H[1], H[2], H[3]}
template <int DB> __device__ __forceinline__ void pv_two(f32x4& o00, f32x4& o10, f32x4& o01, f32x4& o11, int vb, const bf16x8 (&pa)[2][2]) {
  const s16x4 l0 = tr_read<v_rd_off(DB, 0, 0)>(vb), h0 = tr_read<v_rd_off(DB, 0, 1)>(vb), l1 = tr_read<v_rd_off(DB, 1, 0)>(vb), h1 = tr_read<v_rd_off(DB, 1, 1)>(vb);
  const s16x4 l2 = tr_read<v_rd_off(DB + 1, 0, 0)>(vb), h2 = tr_read<v_rd_off(DB + 1, 0, 1)>(vb), l3 = tr_read<v_rd_off(DB + 1, 1, 0)>(vb), h3 = tr_read<v_rd_off(DB + 1, 1, 1)>(vb);
  asm volatile("s_waitcnt lgkmcnt(0)" ::: "memory"); SBAR();
  o00 = __builtin_amdgcn_mfma_f32_16x16x32_bf16(pa[0][0], TRPKH(l0, h0), o00, 0, 0, 0);
  o10 = __builtin_amdgcn_mfma_f32_16x16x32_bf16(pa[1][0], TRPKH(l0, h0), o10, 0, 0, 0);
  o01 = __builtin_amdgcn_mfma_f32_16x16x32_bf16(pa[0][0], TRPKH(l2, h2), o01, 0, 0, 0);
  o11 = __builtin_amdgcn_mfma_f32_16x16x32_bf16(pa[1][0], TRPKH(l2, h2), o11, 0, 0, 0);
  o00 = __builtin_amdgcn_mfma_f32_16x16x32_bf16(pa[0][1], TRPKH(l1, h1), o00, 0, 0, 0);
  o10 = __builtin_amdgcn_mfma_f32_16x16x32_bf16(pa[1][1], TRPKH(l1, h1), o10, 0, 0, 0);
  o01 = __builtin_amdgcn_mfma_f32_16x16x32_bf16(pa[0][1], TRPKH(l3, h3), o01, 0, 0, 0);
  o11 = __builtin_amdgcn_mfma_f32_16x16x32_bf16(pa[1][1], TRPKH(l3, h3), o11, 0, 0, 0);
}
typedef f32x4 OT_[2][8];
__device__ __forceinline__ void pv_all(OT_& o, int vb, const bf16x8 (&pa)[2][2]) {
  pv_two<0>(o[0][0], o[1][0], o[0][1], o[1][1], vb, pa); pv_two<2>(o[0][2], o[1][2], o[0][3], o[1][3], vb, pa);
  pv_two<4>(o[0][4], o[1][4], o[0][5], o[1][5], vb, pa); pv_two<6>(o[0][6], o[1][6], o[0][7], o[1][7], vb, pa);
}
__device__ __forceinline__ void attn_body(const bf16_t* __restrict__ Qb, const bf16_t* __restrict__ Kn, const bf16_t* __restrict__ Kr,
                                          bf16_t* __restrict__ Gm, int seq, char* lds, int tid) {
  const int wid = tid >> 6, lane = tid & 63, r32 = lane & 31, hi = lane >> 5, c = lane & 15, g = lane >> 4;
  char* V_lds = lds + OFF_V; char* K_lds = lds + OFF_KN; char* R_lds = lds + OFF_KR;
  float* ws = (float*)(lds + OFF_WS) + wid * 64; float* li_l = ws; float* al_l = ws + 32;
  float m_reg = -1e30f, l_reg = 0; OT_ o;
#pragma unroll
  for (int qb = 0; qb < 2; ++qb)
#pragma unroll
    for (int db = 0; db < 8; ++db) o[qb][db] = (f32x4){0.f, 0.f, 0.f, 0.f};
  bf16x8 qr[QREG > 0 ? QREG : 1];
  char* ql = lds + OFF_QL + wid * (QLDS * 1024) + lane * 16;
  const unsigned qoff = (unsigned)((wid * QBLK + r32) * NQ + hi * 8) * 2u;
#pragma unroll
  for (int d0 = 0; d0 < 12; ++d0) { const bf16x8 qv = *(const bf16x8*)((const char*)Qb + qoff + d0 * 32); if (d0 < QREG) qr[d0 < QREG ? d0 : 0] = qv; else *reinterpret_cast<bf16x8*>(ql + (d0 - QREG) * 1024) = qv; }
  const int sr = tid >> 4, sc = (tid & 15) * 8, vst0 = v_st(sr, sc), vst1 = v_st(32 + sr, sc);
  const int rr_ = tid >> 3, rc_ = tid & 7;
  const int vb0 = (int)(uintptr_t)V_lds + v_rd_base(lane);
  struct { bf16x8 vs0, vs1, ks0, ks1, kr; } sr_;
  const unsigned voff = (unsigned)(sr * NKV + sc) * 2u, voffr = (unsigned)(rr_ * 64 + rc_ * 8) * 2u;
#define SLOAD(k0) do { const char* kb_ = (const char*)(Kn + (long)(k0) * NKV); const char* rb_ = (const char*)(Kr + (long)(k0) * 64); \
    sr_.vs0 = *(const bf16x8*)(kb_ + 256 + voff); sr_.vs1 = *(const bf16x8*)(kb_ + (32 * NKV * 2 + 256) + voff); \
    sr_.ks0 = *(const bf16x8*)(kb_ + voff); sr_.ks1 = *(const bf16x8*)(kb_ + 32 * NKV * 2 + voff); \
    sr_.kr = *(const bf16x8*)(rb_ + voffr); } while (0)
#define SWRITE(b) do { *(bf16x8*)(V_lds + (b) * SHM_V + vst0) = sr_.vs0; *(bf16x8*)(V_lds + (b) * SHM_V + vst1) = sr_.vs1; const int kc_ = sc * 2; \
    *(bf16x8*)(K_lds + (b) * SHM_KN + KSWZ(sr, kc_)) = sr_.ks0; *(bf16x8*)(K_lds + (b) * SHM_KN + KSWZ(32 + sr, kc_)) = sr_.ks1; \
    *(bf16x8*)(R_lds + (b) * SHM_KR + RSWZ(rr_, rc_)) = sr_.kr; } while (0)
#define SWAIT() asm volatile("s_waitcnt vmcnt(0)" ::: "memory")
#define RESC(a) do { if (__any((a) < 1.f)) { if (hi == 0) al_l[r32] = (a); asm volatile("s_waitcnt lgkmcnt(0)" ::: "memory"); \
    _Pragma("unroll") for (int qb = 0; qb < 2; ++qb) { const f32x4 av = *(const f32x4*)(al_l + 16 * qb + 4 * g); _Pragma("unroll") for (int db = 0; db < 8; ++db) o[qb][db] *= av; } } } while (0)
  f32x16 pA0, pA1, pB0, pB1; float mnA, mnB, alA, alB; bf16x8 pa[2][2]; const int NT = seq / KVBLK;
  SLOAD(0); SWAIT(); SWRITE(0); __syncthreads();
  att::qkt<QREG>(pA0, pA1, K_lds, R_lds, qr, ql, r32, hi); partialSM(pA0, pA1, m_reg, mnA, alA);
  SLOAD(KVBLK); SWAIT(); SWRITE(1); __syncthreads();
  for (int j = 1; j + 1 < NT; j += 2) {
    SBAR(); att::qkt<QREG>(pB0, pB1, K_lds + SHM_KN, R_lds + SHM_KR, qr, ql, r32, hi);
    finishSM(pA0, pA1, alA, l_reg, pa); SBAR();
    SLOAD((j + 1) * KVBLK); SBAR();
    pv_all(o, vb0, pa); partialSM(pB0, pB1, m_reg, mnB, alB);
    __syncthreads(); SWAIT(); SWRITE(0);
    RESC(alB); __syncthreads();
    SBAR(); att::qkt<QREG>(pA0, pA1, K_lds, R_lds, qr, ql, r32, hi);
    finishSM(pB0, pB1, alB, l_reg, pa); SBAR();
    SLOAD((j + 2) * KVBLK); SBAR();
    pv_all(o, vb0 + (int)SHM_V, pa); partialSM(pA0, pA1, m_reg, mnA, alA);
    __syncthreads(); SWAIT(); SWRITE(1);
    RESC(alA); __syncthreads();
  }
  SBAR(); att::qkt<QREG>(pB0, pB1, K_lds + SHM_KN, R_lds + SHM_KR, qr, ql, r32, hi);
  finishSM(pA0, pA1, alA, l_reg, pa); SBAR();
  pv_all(o, vb0, pa); partialSM(pB0, pB1, m_reg, mnB, alB);
  __syncthreads(); RESC(alB);
  finishSM(pB0, pB1, alB, l_reg, pa); SBAR();
  pv_all(o, vb0 + (int)SHM_V, pa);
  SBAR(); asm volatile("" ::: "memory");
  u32x4 gt[8]; const int grow = lane >> 4, gc16 = lane & 15;
  bf16_t* Gw = Gm + (size_t)(wid * QBLK + grow) * DM + gc16 * 8;
#pragma unroll
  for (int i = 0; i < 8; ++i) gt[i] = __builtin_nontemporal_load((const u32x4*)(Gw + (size_t)(4 * i) * DM));
  if (hi == 0) li_l[r32] = l_reg;
  __syncthreads();
  char* ot = lds + wid * (32 * OT_PITCH);
#pragma unroll
  for (int qb = 0; qb < 2; ++qb) { const f32x4 lv = *(const f32x4*)(li_l + 16 * qb + 4 * g);
#pragma unroll
    for (int r = 0; r < 4; ++r) { const float rl = __builtin_amdgcn_rcpf(lv[r]); char* orow = ot + (16 * qb + 4 * g + r) * OT_PITCH + c * 2;
#pragma unroll
      for (int db = 0; db < 8; ++db) *(bf16_t*)(orow + db * 32) = f2bf(o[qb][db][r] * rl); } }
  asm volatile("s_waitcnt lgkmcnt(0)" ::: "memory");
#pragma unroll
  for (int i = 0; i < 8; ++i) { const u32x4 ov = *(const u32x4*)(ot + (grow + 4 * i) * OT_PITCH + gc16 * 16); const u32x4 gv = gt[i]; u32x4 w;
#pragma unroll
    for (int e = 0; e < 4; ++e) { const float g0_ = __uint_as_float(gv[e] << 16), g1_ = __uint_as_float(gv[e] & 0xffff0000u); const float a0 = __uint_as_float(ov[e] << 16) * (GATE_IN_EPI ? g0_ : silu_f(g0_)), a1 = __uint_as_float(ov[e] & 0xffff0000u) * (GATE_IN_EPI ? g1_ : silu_f(g1_)); w[e] = cvt_pk_bf16(a0, a1); }
    *(u32x4*)(Gw + (size_t)(4 * i) * DM) = w; }
#undef SLOAD
#undef SWRITE
#undef SWAIT
#undef RESC
}
}
template <int VAR = 0>
__device__ __forceinline__ void attn_fast(const Frame& F) {
    const bf16_t* Q = WSP(bf16_t, WS_Q); const bf16_t* KV = WSP(bf16_t, WS_KV); const bf16_t* KR = WSP(bf16_t, WS_KR); bf16_t* MIX = WSP(bf16_t, F.mix_off);
    for (int it = F.vcu; it < NB * NH * (SEQ / 256); it += F.G) {
        const int qb = it & 15, p = it >> 4, h = p & 7, b = p >> 3;
        const size_t t0 = (size_t)b * SEQ, q0 = t0 + (size_t)qb * 256;
        int t = F.tid; asm volatile("" : "+v"(t));
#if ATT_STAGR
        att::attn_body6(Q + q0 * NQ + h * DQK, KV + t0 * NKV + h * 256, KR + t0 * 64, MIX + q0 * DM + DF + h * 128, SEQ, F.ldsg, F.lds, t);
#elif ATT_ONEBAR
        att::attn_body5(Q + q0 * NQ + h * DQK, KV + t0 * NKV + h * 256, KR + t0 * 64, MIX + q0 * DM + DF + h * 128, SEQ, F.ldsg, t);
#elif ATT_STAG
        att::attn_body4(Q + q0 * NQ + h * DQK, KV + t0 * NKV + h * 256, KR + t0 * 64, MIX + q0 * DM + DF + h * 128, SEQ, F.ldsg, F.lds, t);
#elif ATT_HYB
        atth::attn_body(Q + q0 * NQ + h * DQK, KV + t0 * NKV + h * 256, KR + t0 * 64, MIX + q0 * DM + DF + h * 128, SEQ, F.ldsg, t);
#elif ATT_S16
        att16::attn_body<VAR>(Q + q0 * NQ + h * DQK, KV + t0 * NKV + h * 256, KR + t0 * 64, MIX + q0 * DM + DF + h * 128, SEQ, F.ldsg, t);
#elif ATT_DMA
        att::attn_body3(Q + q0 * NQ + h * DQK, KV + t0 * NKV + h * 256, KR + t0 * 64, MIX + q0 * DM + DF + h * 128, SEQ, F.ldsg, F.lds, t);
#else
        att::attn_body<VAR>(Q + q0 * NQ + h * DQK, KV + t0 * NKV + h * 256, KR + t0 * 64, MIX + q0 * DM + DF + h * 128, SEQ, F.ldsg, t);
#endif
        __syncthreads();
    }
}
namespace fft {
using att::v_st; using att::v_rd_base; using att::v_rd_off; using att::tr_read; using att::crow;
constexpr int OPITCH = 272;
constexpr int F1_T = 0, F1_OUT = 16384, F1_END = F1_OUT + 128 * OPITCH;
constexpr int XPITCH = 528;
constexpr int F2_Z = 0, F2_XL = 32768, F2_YL = F2_XL + 64 * XPITCH, F2_D2 = F2_YL + 64 * XPITCH, F2_END = F2_D2 + 128 * OPITCH;
static_assert(F1_END <= RING_BYTES && F2_END <= RING_BYTES, "FFT LDS must fit the phase scratch");
#ifndef FFT_SYM
#define FFT_SYM 1
#endif
__device__ __forceinline__ void cmirror(bf16x8& re, bf16x8& im, const float c, const float s) {
    const u32x4 r = __builtin_bit_cast(u32x4, re), m = __builtin_bit_cast(u32x4, im); u32x4 orr, oim;
#pragma unroll
    for (int e = 0; e < 4; ++e) { const float r0 = __uint_as_float(r[e] << 16), r1 = __uint_as_float(r[e] & 0xffff0000u), m0 = __uint_as_float(m[e] << 16), m1 = __uint_as_float(m[e] & 0xffff0000u);
        orr[e] = cvt_pk_bf16(r0 * c - m0 * s, r1 * c - m1 * s); oim[e] = cvt_pk_bf16(-(r0 * s + m0 * c), -(r1 * s + m1 * c)); }
    re = __builtin_bit_cast(bf16x8, orr); im = __builtin_bit_cast(bf16x8, oim);
}
#ifndef FFT_DYN
#define FFT_DYN 0
#endif
__device__ __forceinline__ unsigned* qword(const Frame& F, int s, int l, int q) { return WSP(unsigned, WS_CTL) + 3584 + ((s * DEPTH + l) * 8 + q) * 16; }
static_assert(3584 >= XCD_BAR_WORDS && (3584 + 2 * DEPTH * 8 * 16) * 4 <= CTL_BYTES, "queue words must fit the control region behind the barrier words");
__device__ __forceinline__ int q_item(int G, int qg, unsigned idx) { return G >= 64 ? (idx < 256u ? (int)idx * 8 + qg : -1) : (idx < (unsigned)(NB * 64 * NG) ? (int)idx : -1); }
}
__device__ __forceinline__ void fft1_fast(const Frame& F, int l) {
    using namespace fft;
    const bf16_t* U = WSP(bf16_t, WS_U); const bf16_t* D1 = WSP(bf16_t, WS_D1); bf16_t* Z = WSP(bf16_t, WS_H);
    const int tid = F.tid, wid = tid >> 6, lane = tid & 63, r32 = lane & 31, hi = lane >> 5, half = wid & 1, cb = wid >> 1;
    char* lds = F.ldsg;
    bf16x8 bfr[2][4];
#pragma unroll
    for (int ri = 0; ri < 2; ++ri)
#pragma unroll
        for (int ks = 0; ks < 4; ++ks) bfr[ri][ks] = *(const bf16x8*)(D1 + (ri * 64 + half * 32 + r32) * 64 + 16 * ks + 8 * hi);
    const int sr = tid >> 4, sc = (tid & 15) * 8, vst0 = v_st(sr, sc), vst1 = v_st(32 + sr, sc);
    const int vb = (int)(uintptr_t)(lds + F1_T) + v_rd_base(lane) + cb * 512;
    const int s1p = half * 32 + r32;
#if FFT_DYN
    const int qg = F.G >= 64 ? ((F.bx >> 3) & 7) : 0; unsigned* qc = qword(F, 0, l, qg); volatile LAS unsigned* mw = (volatile LAS unsigned*)(F.lds + MISC_OFF);
    unsigned cnx = 0u;
    if (tid == 0) { mw[8] = xb_add(qc, 1u); cnx = xb_add(qc, 1u); }
    __syncthreads();
    int it = q_item(F.G, qg, mw[8]); if (it < 0) return;
#else
    int it = F.bx; if (it >= NB * 64 * NG) return;
#endif
    bf16x8 u0, u1;
#define F1_LOAD(IT) do { const int g_ = (IT) & 7, s2_ = ((IT) >> 3) & 63, b_ = (IT) >> 9; const bf16_t* up = U + ((size_t)(b_ * SEQ + s2_)) * DF + g_ * 128 + sc; \
        u0 = __builtin_nontemporal_load((const bf16x8*)(up + (size_t)(64 * sr) * DF)); u1 = __builtin_nontemporal_load((const bf16x8*)(up + (size_t)(64 * (sr + 32)) * DF)); } while (0)
    F1_LOAD(it);
#if FFT_DYN
    for (int nit = 0; it >= 0; it = nit) {
        const int g = it & 7, s2 = (it >> 3) & 63, b = it >> 9;
        *(bf16x8*)(lds + F1_T + vst0) = u0; *(bf16x8*)(lds + F1_T + vst1) = u1;
        if (tid == 0) mw[8] = cnx;
        __syncthreads();
        nit = q_item(F.G, qg, mw[8]);
        if (nit >= 0) { F1_LOAD(nit); if (tid == 0) cnx = xb_add(qc, 1u); }
#else
    for (; it < NB * 64 * NG; it += F.G) {
        const int g = it & 7, s2 = (it >> 3) & 63, b = it >> 9;
        *(bf16x8*)(lds + F1_T + vst0) = u0; *(bf16x8*)(lds + F1_T + vst1) = u1;
        __syncthreads();
        if (it + F.G < NB * 64 * NG) F1_LOAD(it + F.G);
#endif
        f32x16 acc0 = {}, acc1 = {};
        { const s16x4 l0 = tr_read<v_rd_off(0, 0, 0)>(vb), h0 = tr_read<v_rd_off(0, 0, 1)>(vb), l1 = tr_read<v_rd_off(0, 1, 0)>(vb), h1 = tr_read<v_rd_off(0, 1, 1)>(vb);
          const s16x4 l2 = tr_read<v_rd_off(0, 2, 0)>(vb), h2 = tr_read<v_rd_off(0, 2, 1)>(vb), l3 = tr_read<v_rd_off(0, 3, 0)>(vb), h3 = tr_read<v_rd_off(0, 3, 1)>(vb);
          asm volatile("s_waitcnt lgkmcnt(0)" ::: "memory"); __builtin_amdgcn_sched_barrier(0);
          acc0 = __builtin_amdgcn_mfma_f32_32x32x16_bf16(TRPK(l0, h0), bfr[0][0], acc0, 0, 0, 0); acc1 = __builtin_amdgcn_mfma_f32_32x32x16_bf16(TRPK(l0, h0), bfr[1][0], acc1, 0, 0, 0);
          acc0 = __builtin_amdgcn_mfma_f32_32x32x16_bf16(TRPK(l1, h1), bfr[0][1], acc0, 0, 0, 0); acc1 = __builtin_amdgcn_mfma_f32_32x32x16_bf16(TRPK(l1, h1), bfr[1][1], acc1, 0, 0, 0);
          acc0 = __builtin_amdgcn_mfma_f32_32x32x16_bf16(TRPK(l2, h2), bfr[0][2], acc0, 0, 0, 0); acc1 = __builtin_amdgcn_mfma_f32_32x32x16_bf16(TRPK(l2, h2), bfr[1][2], acc1, 0, 0, 0);
          acc0 = __builtin_amdgcn_mfma_f32_32x32x16_bf16(TRPK(l3, h3), bfr[0][3], acc0, 0, 0, 0); acc1 = __builtin_amdgcn_mfma_f32_32x32x16_bf16(TRPK(l3, h3), bfr[1][3], acc1, 0, 0, 0); }
        float st, ct; sincospif((float)(s2 * s1p) * (1.0f / 2048.0f), &st, &ct);
        char* o0 = lds + F1_OUT + s1p * OPITCH + (cb * 32 + 4 * hi) * 2; char* o1 = o0 + 64 * OPITCH;
#pragma unroll
        for (int q = 0; q < 4; ++q) { float zr[4], zi[4];
#pragma unroll
            for (int j = 0; j < 4; ++j) { const float yr = acc0[4 * q + j], yi = acc1[4 * q + j]; zr[j] = yr * ct + yi * st; zi[j] = yi * ct - yr * st; }
            *(u32x2*)(o0 + q * 16) = (u32x2){cvt_pk_bf16(zr[0], zr[1]), cvt_pk_bf16(zr[2], zr[3])};
            *(u32x2*)(o1 + q * 16) = (u32x2){cvt_pk_bf16(zi[0], zi[1]), cvt_pk_bf16(zi[2], zi[3])}; }
        __syncthreads();
#pragma unroll
        for (int i = 0; i < 4; ++i) { const int q = tid + 512 * i, row = q >> 4, c16 = q & 15, ri = row >> 6, sp = row & 63;
            const u32x4 v = *(const u32x4*)(lds + F1_OUT + row * OPITCH + c16 * 16);
            if (FFT_SYM == 0 || sp <= 32) *(u32x4*)(Z + (((((size_t)(b * 64 + sp) * NG + g) * 2 + ri) * 64 + s2) * 128) + c16 * 8) = v; }
    }
#undef F1_LOAD
    __syncthreads();
}
__device__ __forceinline__ void fft2_fast(const Frame& F, int l) {
    using namespace fft;
    const bf16_t* Z = WSP(bf16_t, WS_H); const bf16_t* D2 = WSP(bf16_t, WS_D2); const bf16_t* wcat = WSP(bf16_t, WS_WCAT) + (size_t)l * NG * 128 * 256; bf16_t* MIX = WSP(bf16_t, F.mix_off);
    const int tid = F.tid, wid = tid >> 6, lane = tid & 63, r32 = lane & 31, hi = lane >> 5, cb = wid & 3, h2 = wid >> 2;
    char* lds = F.ldsg;
#if FFT_DYN
    const int qg = F.G >= 64 ? ((F.bx >> 3) & 7) : 0; unsigned* qc = qword(F, 1, l, qg); volatile LAS unsigned* mw = (volatile LAS unsigned*)(F.lds + MISC_OFF);
    unsigned cnx = 0u;
    if (tid == 0) { mw[8] = xb_add(qc, 1u); cnx = xb_add(qc, 1u); }
    __syncthreads();
    int it = q_item(F.G, qg, mw[8]); if (it < 0) return;
#else
    int it = F.bx; if (it >= NB * 64 * NG) return;
#endif
#pragma unroll
    for (int i = 0; i < 4; ++i) { const int q = tid + 512 * i, row = q >> 4, c16 = q & 15; *(u32x4*)(lds + F2_D2 + row * OPITCH + c16 * 16) = *(const u32x4*)(D2 + row * 128 + c16 * 8); }
    const int sr = tid >> 4, sc = (tid & 15) * 8, vst0 = v_st(sr, sc), vst1 = v_st(32 + sr, sc);
    const int vb = (int)(uintptr_t)(lds + F2_Z) + v_rd_base(lane) + cb * 512;
    bf16x8 wfr[16]; int gcur = -1;
    float ms0, mc0; sincospif((float)sr * (1.0f / 32.0f), &ms0, &mc0);
    bf16x8 z0, z1, z2, z3, g0, g1;
#define F2_LOAD(IT) do { const int g_ = (IT) & 7, sp_ = ((IT) >> 3) & 63, b_ = (IT) >> 9, zs_ = (FFT_SYM && sp_ > 32) ? 64 - sp_ : sp_; const bf16_t* zp = Z + ((size_t)(b_ * 64 + zs_) * NG + g_) * (2 * 64 * 128) + sr * 128 + sc; \
        z0 = __builtin_nontemporal_load((const bf16x8*)(zp)); z1 = __builtin_nontemporal_load((const bf16x8*)(zp + 32 * 128)); z2 = __builtin_nontemporal_load((const bf16x8*)(zp + 64 * 128)); z3 = __builtin_nontemporal_load((const bf16x8*)(zp + 96 * 128)); \
        const bf16_t* mp = MIX + ((size_t)(b_ * SEQ + sp_ + 64 * (tid >> 4))) * DM + g_ * 128 + (tid & 15) * 8; g0 = __builtin_nontemporal_load((const bf16x8*)(mp)); g1 = __builtin_nontemporal_load((const bf16x8*)(mp + (size_t)(64 * 32) * DM)); } while (0)
    F2_LOAD(it);
#if FFT_DYN
    for (int nit = 0; it >= 0; it = nit) {
        const int g = it & 7, sp = (it >> 3) & 63, b = it >> 9;
        if (g != gcur) { gcur = g;
#pragma unroll
            for (int ks = 0; ks < 16; ++ks) wfr[ks] = *(const bf16x8*)(wcat + (size_t)(g * 128 + cb * 32 + r32) * 256 + 16 * ks + 8 * hi); }
#else
    while (it < NB * 64 * NG) {
      { const int g_ = it & 7; gcur = g_;
#pragma unroll
        for (int ks = 0; ks < 16; ++ks) wfr[ks] = *(const bf16x8*)(wcat + (size_t)(g_ * 128 + cb * 32 + r32) * 256 + 16 * ks + 8 * hi);
        __builtin_amdgcn_s_waitcnt(0x0F70); }
      for (; it < NB * 64 * NG && (it & 7) == gcur; it += F.G) {
        const int g = it & 7, sp = (it >> 3) & 63, b = it >> 9;
#endif
        if (FFT_SYM && sp > 32) { cmirror(z0, z2, mc0, ms0); cmirror(z1, z3, -mc0, -ms0); }
        *(bf16x8*)(lds + F2_Z + vst0) = z0; *(bf16x8*)(lds + F2_Z + vst1) = z1; *(bf16x8*)(lds + F2_Z + 16384 + vst0) = z2; *(bf16x8*)(lds + F2_Z + 16384 + vst1) = z3;
        const bf16x8 gg0 = g0, gg1 = g1;
#if FFT_DYN
        if (tid == 0) mw[8] = cnx;
        __syncthreads();
        nit = q_item(F.G, qg, mw[8]);
        if (nit >= 0) { F2_LOAD(nit); if (tid == 0) cnx = xb_add(qc, 1u); }
#else
        __syncthreads();
        if (it + F.G < NB * 64 * NG) F2_LOAD(it + F.G);
#endif
#if defined(FFT2_P1_NAIVE)
        { const bf16_t* Zb = Z + ((size_t)(b * 64 + sp) * NG + g) * (2 * 64 * 128);
          for (int i = 0; i < 32; ++i) { const int o = tid + 512 * i, c = o & 127, rr = o >> 7; float s_ = 0.f;
              for (int k = 0; k < 128; ++k) s_ += bf2f(D2[rr * 128 + k]) * bf2f(Zb[k * 128 + c]);
              *(bf16_t*)(lds + F2_XL + (rr & 63) * XPITCH + ((rr >> 6) * 128 + c) * 2) = f2bf(s_); } }
#else
        f32x16 x0 = {}, x1 = {};
        const char* d2p = lds + F2_D2 + (h2 * 32 + r32) * OPITCH + 16 * hi;
#pragma unroll
        for (int t = 0; t < 2; ++t) {
            const int vbt = vb + t * 16384;
            const s16x4 l0 = tr_read<v_rd_off(0, 0, 0)>(vbt), h0 = tr_read<v_rd_off(0, 0, 1)>(vbt), l1 = tr_read<v_rd_off(0, 1, 0)>(vbt), h1 = tr_read<v_rd_off(0, 1, 1)>(vbt);
            const s16x4 l2 = tr_read<v_rd_off(0, 2, 0)>(vbt), h2_ = tr_read<v_rd_off(0, 2, 1)>(vbt), l3 = tr_read<v_rd_off(0, 3, 0)>(vbt), h3 = tr_read<v_rd_off(0, 3, 1)>(vbt);
            bf16x8 e0[4], e1[4];
#pragma unroll
            for (int ks = 0; ks < 4; ++ks) { e0[ks] = *(const bf16x8*)(d2p + (t * 4 + ks) * 32); e1[ks] = *(const bf16x8*)(d2p + 64 * OPITCH + (t * 4 + ks) * 32); }
            asm volatile("s_waitcnt lgkmcnt(0)" ::: "memory"); __builtin_amdgcn_sched_barrier(0);
            x0 = __builtin_amdgcn_mfma_f32_32x32x16_bf16(TRPK(l0, h0), e0[0], x0, 0, 0, 0); x1 = __builtin_amdgcn_mfma_f32_32x32x16_bf16(TRPK(l0, h0), e1[0], x1, 0, 0, 0);
            x0 = __builtin_amdgcn_mfma_f32_32x32x16_bf16(TRPK(l1, h1), e0[1], x0, 0, 0, 0); x1 = __builtin_amdgcn_mfma_f32_32x32x16_bf16(TRPK(l1, h1), e1[1], x1, 0, 0, 0);
            x0 = __builtin_amdgcn_mfma_f32_32x32x16_bf16(TRPK(l2, h2_), e0[2], x0, 0, 0, 0); x1 = __builtin_amdgcn_mfma_f32_32x32x16_bf16(TRPK(l2, h2_), e1[2], x1, 0, 0, 0);
            x0 = __builtin_amdgcn_mfma_f32_32x32x16_bf16(TRPK(l3, h3), e0[3], x0, 0, 0, 0); x1 = __builtin_amdgcn_mfma_f32_32x32x16_bf16(TRPK(l3, h3), e1[3], x1, 0, 0, 0);
        }
        { char* xr = lds + F2_XL + (h2 * 32 + r32) * XPITCH + (cb * 32 + 4 * hi) * 2;
#pragma unroll
          for (int q = 0; q < 4; ++q) { *(u32x2*)(xr + q * 16) = (u32x2){cvt_pk_bf16(x0[4 * q], x0[4 * q + 1]), cvt_pk_bf16(x0[4 * q + 2], x0[4 * q + 3])};
              *(u32x2*)(xr + 256 + q * 16) = (u32x2){cvt_pk_bf16(x1[4 * q], x1[4 * q + 1]), cvt_pk_bf16(x1[4 * q + 2], x1[4 * q + 3])}; } }
#endif
        __syncthreads();
#if defined(FFT2_P2_NAIVE)
        for (int i = 0; i < 16; ++i) { const int o = tid + 512 * i, d = o & 127, s2p = o >> 7; float s_ = 0.f;
            const bf16_t* wr_ = wcat + (size_t)(g * 128 + d) * 256;
            for (int k = 0; k < 256; ++k) s_ += bf2f(*(const bf16_t*)(lds + F2_XL + s2p * XPITCH + k * 2)) * bf2f(wr_[k]);
            *(float*)(lds + F2_YL + s2p * XPITCH + d * 4) = s_; }
#else
        f32x16 y = {};
        { const char* xb = lds + F2_XL + (h2 * 32 + r32) * XPITCH + 16 * hi;
#pragma unroll
          for (int ks = 0; ks < 16; ++ks) { const bf16x8 xf = *(const bf16x8*)(xb + ks * 32); y = __builtin_amdgcn_mfma_f32_32x32x16_bf16(wfr[ks], xf, y, 0, 0, 0); } }
        { char* yr = lds + F2_YL + (h2 * 32 + r32) * XPITCH + (cb * 32 + 4 * hi) * 4;
#pragma unroll
          for (int q = 0; q < 4; ++q) *(f32x4*)(yr + q * 32) = (f32x4){y[4 * q], y[4 * q + 1], y[4 * q + 2], y[4 * q + 3]}; }
#endif
        __syncthreads();
#pragma unroll
        for (int i = 0; i < 2; ++i) { const int row = (tid >> 4) + 32 * i, c8 = (tid & 15) * 8; const bf16x8 gv = i ? gg1 : gg0;
            const f32x4 ya = *(const f32x4*)(lds + F2_YL + row * XPITCH + c8 * 4), yb = *(const f32x4*)(lds + F2_YL + row * XPITCH + c8 * 4 + 16);
            f32x4 ga = {bf2f((bf16_t)gv[0]), bf2f((bf16_t)gv[1]), bf2f((bf16_t)gv[2]), bf2f((bf16_t)gv[3])}, gb = {bf2f((bf16_t)gv[4]), bf2f((bf16_t)gv[5]), bf2f((bf16_t)gv[6]), bf2f((bf16_t)gv[7])};
            if (!GATE_IN_EPI) { ga = silu4(ga); gb = silu4(gb); }
            store8_bf16(MIX + ((size_t)(b * SEQ + sp + 64 * row)) * DM + g * 128 + c8, ya * ga, yb * gb); }
    }
#if !FFT_DYN
    }
#endif
#undef F2_LOAD
    __syncthreads();
}
#if PROBE_CHECK
constexpr size_t WS_CHK_GATE = WS_U;
constexpr size_t WS_CHK_CNT = WS_CTL + 15 * 1024;
__device__ __forceinline__ int chk_tok(int i) { return (i * 64 + 37 + (i >> 2) * 4096 / 64 * 0) % MTOK + ((i & 3) * 4096) - ((i & 3) * 4096); }
__device__ __forceinline__ void chk_fail(const Frame& F, float a, float b, float atol, float rtol) { if (!(fabsf(a - b) <= atol + rtol * fabsf(b))) atomicAdd(WSP(unsigned, WS_CHK_CNT), 1u); }
__device__ __forceinline__ void chk_proj(const Frame& F, int l) {
    LAS float* hs = (LAS float*)F.lds;
    LAS float* cs = hs + 2048;
    LAS float* red = cs + 832;
    const float* x = l == 0 ? F.in[0] : WSP(float, WS_R); const float* mod = WSP(float, WS_MOD) + (size_t)l * NB * 3 * DM; const float* w_in = F.in[5] + (size_t)l * DM * NIN;
    for (int i = F.bx; i < 256; i += F.G) {
        const int tok = 64 * i + 37, b = tok >> 12, tid = F.tid;
        float s = 0.f; for (int k = tid; k < DM; k += NTHREADS) s += x[(size_t)tok * DM + k];
        s = wave_sum(s); if (F.lane == 0) red[F.wave] = s; __syncthreads(); float mean = 0.f; for (int w = 0; w < 8; ++w) mean += red[w]; mean *= (1.0f / DM); __syncthreads();
        float q2 = 0.f; for (int k = tid; k < DM; k += NTHREADS) { const float d = x[(size_t)tok * DM + k] - mean; q2 += d * d; }
        q2 = wave_sum(q2); if (F.lane == 0) red[F.wave] = q2; __syncthreads(); float var = 0.f; for (int w = 0; w < 8; ++w) var += red[w]; const float rstd = rsqrtf(var * (1.0f / DM) + NORM_EPS); __syncthreads();
        for (int k = tid; k < DM; k += NTHREADS) hs[k] = bf2f(f2bf((x[(size_t)tok * DM + k] - mean) * rstd * (1.0f + mod[(size_t)b * 3 * DM + DM + k]) + mod[(size_t)b * 3 * DM + k]));
        __syncthreads();
        for (int c = tid; c < 832; c += NTHREADS) { float a = 0.f; for (int k = 0; k < DM; ++k) a += hs[k] * bf2f(f2bf(w_in[(size_t)k * NIN + 2048 + c])); cs[c] = a; }
        __syncthreads();
        float sq = 0.f; for (int c = tid; c < 512; c += NTHREADS) sq += cs[c] * cs[c];
        sq = wave_sum(sq); if (F.lane == 0) red[F.wave] = sq; __syncthreads(); float sq_q = 0.f; for (int w = 0; w < 8; ++w) sq_q += red[w]; __syncthreads();
        float sk = 0.f; for (int c = 512 + tid; c < 768; c += NTHREADS) sk += cs[c] * cs[c];
        sk = wave_sum(sk); if (F.lane == 0) red[F.wave] = sk; __syncthreads(); float sq_k = 0.f; for (int w = 0; w < 8; ++w) sq_k += red[w]; __syncthreads();
        const float rq = rsqrtf(sq_q * (1.0f / QLR) + NORM_EPS), rk = rsqrtf(sq_k * (1.0f / KVLR) + NORM_EPS);
        const float* rc = WSP(float, WS_RCOS) + (size_t)tok * 32; const float* rs = WSP(float, WS_RSIN) + (size_t)tok * 32;
        const int pos = ((const int*)F.in[2])[tok];
        if (tid < 32) { const float ang = (float)pos * powf(10000.0f, -(float)tid / 32.0f); const float c_ = cosf(ang), s_ = sinf(ang); const float x1 = cs[768 + tid], x2 = cs[800 + tid];
            chk_fail(F, bf2f(WSP(bf16_t, WS_KR)[(size_t)tok * 64 + tid]), x1 * c_ - x2 * s_, 0.05f, 0.05f); chk_fail(F, bf2f(WSP(bf16_t, WS_KR)[(size_t)tok * 64 + 32 + tid]), x2 * c_ + x1 * s_, 0.05f, 0.05f);
            chk_fail(F, rc[tid], c_, 0.02f, 0.f); chk_fail(F, rs[tid], s_, 0.02f, 0.f); }
        const float* wq = F.in[7] + (size_t)l * QLR * NQ; const float* gq = F.in[6] + l * QLR;
        for (int n = tid; n < NQ; n += NTHREADS) { const int head = n / DQK, d = n - head * DQK; if (d >= 160) continue;
            float a = 0.f, a2 = 0.f; for (int k = 0; k < QLR; ++k) { const float cn = bf2f(f2bf(cs[k])) * rq * gq[k]; a += cn * wq[(size_t)k * NQ + n]; if (d >= 128) a2 += cn * wq[(size_t)k * NQ + n + 32]; }
            if (d < 128) chk_fail(F, bf2f(WSP(bf16_t, WS_Q)[(size_t)tok * NQ + n]), a, 0.06f, 0.05f);
            else { const int ii = d - 128; const float ang = (float)pos * powf(10000.0f, -(float)ii / 32.0f); const float c_ = cosf(ang), s_ = sinf(ang);
                chk_fail(F, bf2f(WSP(bf16_t, WS_Q)[(size_t)tok * NQ + n]), a * c_ - a2 * s_, 0.06f, 0.05f); chk_fail(F, bf2f(WSP(bf16_t, WS_Q)[(size_t)tok * NQ + n + 32]), a2 * c_ + a * s_, 0.06f, 0.05f); } }
        const float* wk = F.in[9] + (size_t)l * KVLR * NKV; const float* gk = F.in[8] + l * KVLR;
        for (int n = tid; n < NKV; n += NTHREADS) { float a = 0.f; for (int k = 0; k < KVLR; ++k) a += bf2f(f2bf(cs[512 + k])) * rk * gk[k] * wk[(size_t)k * NKV + n];
            chk_fail(F, bf2f(WSP(bf16_t, WS_KV)[(size_t)tok * NKV + n]), a, 0.06f, 0.05f); }
        for (int c = tid; c < 1024; c += NTHREADS) WSP(bf16_t, WS_CHK_GATE)[(size_t)i * 1024 + c] = WSP(bf16_t, WS_MIX)[(size_t)tok * DM + DF + c];
        __syncthreads();
    }
}
__device__ __forceinline__ void chk_attn(const Frame& F) {
    const bf16_t* Q = WSP(bf16_t, WS_Q); const bf16_t* KV = WSP(bf16_t, WS_KV); const bf16_t* KR = WSP(bf16_t, WS_KR); const bf16_t* MIX = WSP(bf16_t, WS_MIX);
    LAS float* qs = (LAS float*)F.lds + F.wave * 192;
    for (int i = F.bx; i < 256; i += F.G) {
        const int tok = 64 * i + 37, b = tok >> 12, h = F.wave;
        for (int dh = 0; dh < 2; ++dh) {
            __builtin_amdgcn_wave_barrier(); asm volatile("" ::: "memory");
            for (int e = 0; e < 3; ++e) qs[F.lane + 64 * e] = bf2f(Q[(size_t)tok * NQ + h * DQK + F.lane + 64 * e]);
            asm volatile("s_waitcnt lgkmcnt(0)" ::: "memory"); __builtin_amdgcn_wave_barrier();
            float m = -1e30f, lsum = 0.f; float o[64];
#pragma unroll
            for (int d = 0; d < 64; ++d) o[d] = 0.f;
            for (int t = 0; t < 64; ++t) {
                const size_t key = (size_t)b * SEQ + F.lane + 64 * t; const bf16_t* kn = KV + key * NKV + h * 256; const bf16_t* kr = KR + key * 64;
                float s = 0.f;
#pragma unroll 2
                for (int c = 0; c < 16; ++c) { const bf16x8 kv = *(const bf16x8*)(kn + c * 8);
#pragma unroll
                    for (int e = 0; e < 8; ++e) s += qs[c * 8 + e] * bf2f((bf16_t)kv[e]); }
#pragma unroll 2
                for (int c = 0; c < 8; ++c) { const bf16x8 kv = *(const bf16x8*)(kr + c * 8);
#pragma unroll
                    for (int e = 0; e < 8; ++e) s += qs[128 + c * 8 + e] * bf2f((bf16_t)kv[e]); }
                s *= ATT_SCALE; const float mn = fmaxf(m, s), a = __expf(m - mn), p = __expf(s - mn); lsum = lsum * a + p; m = mn;
#pragma unroll
                for (int c = 0; c < 8; ++c) { const bf16x8 vv = *(const bf16x8*)(kn + 128 + dh * 64 + c * 8);
#pragma unroll
                    for (int e = 0; e < 8; ++e) o[c * 8 + e] = o[c * 8 + e] * a + p * bf2f((bf16_t)vv[e]); }
            }
            const float Mx = wave_max(m), f = __expf(m - Mx); const float Ls = wave_sum(lsum * f);
            float keep0 = 0.f;
#pragma unroll
            for (int d = 0; d < 64; ++d) { const float od = wave_sum(o[d] * f); if (F.lane == d) keep0 = od; }
            const int col = h * 128 + dh * 64 + F.lane;
            const float gz_ = bf2f(WSP(bf16_t, WS_CHK_GATE)[(size_t)i * 1024 + col]); const float ref = keep0 / Ls * (GATE_IN_EPI ? gz_ : gz_ / (1.0f + expf(-gz_)));
            chk_fail(F, bf2f(MIX[(size_t)tok * DM + DF + col]), ref, 1.5e-3f, 0.05f);
        }
    }
}
__device__ __forceinline__ void chk_finish(const Frame& F) {
    if (F.bx == 0 && F.tid == 0 && __hip_atomic_load(WSP(unsigned, WS_CHK_CNT), __ATOMIC_RELAXED, __HIP_MEMORY_SCOPE_AGENT) != 0u) { for (int k = 0; k < 64; ++k) F.out[k] = __builtin_nanf(""); }
}
#endif
#ifndef DIAG_ONLY
#define DIAG_ONLY -1
#endif
#define DIAG_EN(k) (DIAG_ONLY < 0 || DIAG_ONLY == (k))
#ifndef PROBE_CHECK
#define PROBE_CHECK 0
#endif
#ifndef XCD_REMAP
#define XCD_REMAP 0
#endif
#ifndef PROBE_CLK
#define PROBE_CLK 0
#endif
#ifndef PROBE_N
#define PROBE_N 1
#endif
#ifndef PROBE_VAR
#define PROBE_VAR 0
#endif
#ifndef PROBE_REP
#define PROBE_REP -1
#endif
struct Args { const float* in[14]; float* out; unsigned char* ws; int ph_lo, ph_hi; };
constexpr int N_PHASES = 2 + 5 * DEPTH;

template <class Epi, class Sched> __device__ __forceinline__ void run_gemm(const Frame& F, const pg8::Gemm& g, const Sched& S, const Epi& E) {
#if IMPL_GEMM
    pg8::gemm_phase<Epi, Sched, PG8_ALIGN, PG8_SP2>(F.lds, g, S, E, F.tid);
#else
    pg8::gemm_phase_naive<Epi, Sched>(g, S, E, F.tid);
#endif
}

#define PH_IN(k) (lo <= (k) && (k) < hi)
#ifndef PROBE_SKEW
#define PROBE_SKEW 0
#endif
#ifndef PROBE_SKEW_MASK
#define PROBE_SKEW_MASK 0xFFFu
#endif
#ifndef PROBE_SKEW_MUL
#define PROBE_SKEW_MUL 10
#endif
#if PROBE_SKEW
#define PH_STAMP(k) do { __syncthreads(); if (threadIdx.x == 0) __hip_atomic_store(WSP(unsigned long long, WS_END) + (k) * 256 + F.bx, (unsigned long long)__builtin_amdgcn_s_memrealtime(), __ATOMIC_RELAXED, __HIP_MEMORY_SCOPE_AGENT); } while (0)
#else
#define PH_STAMP(k) do {} while (0)
#endif
#define PH_SEAM(k) do { if (PH_IN(k) && PH_IN((k) + 1)) { PH_STAMP(k); xcd_barrier(bar); } } while (0)
#define PH_ENTER() do { int _t = threadIdx.x; asm volatile("" : "+v"(_t)); F.tid = _t; F.lane = _t & 63; } while (0)

#ifndef P0_DEFER
#define P0_DEFER 0
#endif
#ifndef ATT_STAG_SHIFT
#define ATT_STAG_SHIFT 7
#endif
#ifndef PHASE_STAG
#define PHASE_STAG 1
#endif
#ifndef MERGE_LN
#define MERGE_LN 0
#endif
static_assert(!(MERGE_LN && LN_DROP_R), "the merged region keeps the R stream: build it with -DLN_DROP_R=0");
template <int L> __device__ __forceinline__ void merged_region(Frame& F) {
    const int gi = F.vcu >> 3, m = F.vcu & 7, sA = 2 * gi, typ = gi & 1;
    unsigned* gc = WSP(unsigned, WS_CTL) + 4096 + (L * 32 + gi) * 16; unsigned tgt = 0u;
    const int npass = typ ? 1 : 2, per = typ ? 2 : 1;
    for (int p = 0; p < npass; ++p) {
        PH_ENTER();
        { pg8::Gemm g{WSP(bf16_t, WS_MIX), WSP(bf16_t, WS_WOUT) + (size_t)L * DM * DM, MTOK, DM, DM};
          pg8::GridOrder S{sA + p, per, m, 0, 1};
          EpiOut E{WSP(bf16_t, WS_H), WSP(float, WS_MOD) + (size_t)L * NB * (3 * DM) + 2 * DM};
          run_gemm(F, g, S, E); }
        tgt += 8u; grp_barrier(WSP(unsigned, WS_CTL), gc, tgt);
        PH_ENTER();
        const int r0 = (sA + p) * 256 + m * 32 * per;
        if (L + 1 < DEPTH) p_ln_post<true>(F, L, r0, r0 + 32 * per, 8); else p_ln_post<false>(F, L, r0, r0 + 32 * per, 8);
    }
    if (L + 1 < DEPTH) {
        tgt += 8u; grp_barrier(WSP(unsigned, WS_CTL), gc, tgt);
        PH_ENTER();
        pg8::Gemm g{WSP(bf16_t, WS_H), WSP(bf16_t, WS_WIN) + (size_t)(L + 1) * NINP * DM, MTOK, NINP, DM};
        pg8::GridOrder S{sA, 2, m, 8, 2};
        EpiIn E{WSP(bf16_t, WS_U), WSP(bf16_t, WS_MIX), WSP(bf16_t, WS_CQ), WSP(bf16_t, WS_CKV), WSP(bf16_t, WS_KR), WSP(float, WS_RSQ) + (size_t)(L + 1) * MTOK * 2, WSP(float, WS_RCOS), WSP(float, WS_RSIN)};
        run_gemm(F, g, S, E);
    }
}

template <int L> __device__ __forceinline__ void layer_phases(Frame& F, const int lo, const int hi, const XcdBarrier& bar) {
    constexpr int P = 2 + 5 * L;
    float* rsq = WSP(float, WS_RSQ) + (size_t)L * MTOK * 2;
    const bool mrg = MERGE_LN && (hi - lo == N_PHASES) && F.G == 256;
    const bool defer = P0_DEFER && (hi - lo == N_PHASES) && DEPTH == 2 && L == 0, work_first = (F.bx >> 3) & 1;
    if (PH_IN(P + 0) && DIAG_EN(2) && !(mrg && L > 0)) {
        PH_ENTER();
        pg8::Gemm g{WSP(bf16_t, WS_H), WSP(bf16_t, WS_WIN) + (size_t)L * NINP * DM, MTOK, NINP, DM};
        pg8::StaticOrder S; S.init(MTOK, NINP, F.G, F.bx);
        EpiIn E{WSP(bf16_t, WS_U), WSP(bf16_t, WS_MIX), WSP(bf16_t, WS_CQ), WSP(bf16_t, WS_CKV), WSP(bf16_t, WS_KR), rsq, WSP(float, WS_RCOS), WSP(float, WS_RSIN)};
        unsigned long long ct0 = 0, cr0 = 0;
        if (PROBE_CLK == 1 && L == 0) { ct0 = __builtin_amdgcn_s_memtime(); cr0 = __builtin_amdgcn_s_memrealtime(); }
        if (defer && work_first) { p0_weights(F, 848, 2 * 848); PH_ENTER(); }
        run_gemm(F, g, S, E);
        if (defer && !work_first) { PH_ENTER(); p0_weights(F, 848, 2 * 848); }
        if (PROBE_CLK == 1 && L == 0 && F.bx == 0) { const unsigned long long ct1 = __builtin_amdgcn_s_memtime(), cr1 = __builtin_amdgcn_s_memrealtime();
            const unsigned long long mhz = (ct1 - ct0) * 100ull / (cr1 - cr0); const unsigned long long tend = cr1 + mhz * 10ull;
            while (__builtin_amdgcn_s_memrealtime() < tend) __builtin_amdgcn_s_sleep(8); }
        if (PROBE_REP == 2 && L == 0) { xcd_barrier(bar); EpiIn E2 = E; E2.rsq = WSP(float, WS_R); run_gemm(F, g, S, E2); }
        if (PROBE_REP == 12 && L == 0) { xcd_barrier(bar); EpiNone E2; run_gemm(F, g, S, E2); }
        if (PROBE_REP == 22 && L == 0) { xcd_barrier(bar); EpiNone E2; pg8::HotOrder S2; S2.init(MTOK, NINP, F.G, F.bx); S2.pm0 = 3; S2.pn0 = 2; run_gemm(F, g, S2, E2); }
        if (PROBE_REP == 32 && L == 0) { xcd_barrier(bar); EpiNone E2; pg8::HotOrder S2; S2.init(MTOK, NINP, F.G, F.bx); S2.pm0 = F.bx & 63; S2.pn0 = 2; run_gemm(F, g, S2, E2); }
    }
    if (!(mrg && L > 0)) PH_SEAM(P + 0); else PH_STAMP(P + 0);
    if (PH_IN(P + 1) && DIAG_EN(3)) {
        PH_ENTER();
        const bool fft_first = PHASE_STAG && ((F.bx >> 3) & 1);
#if IMPL_FFT & 1
        if (fft_first) { fft1_fast(F, L); PH_ENTER(); }
#endif
        if (defer && fft_first) { p0_mod(F, 384, 2 * 384); p0_wcat(F, 1, 2); PH_ENTER(); }
        { pg8::Gemm g{WSP(bf16_t, WS_CQ), WSP(bf16_t, WS_WQ) + (size_t)L * NQ * QLR, MTOK, NQ, QLR};
          pg8::SplitOrder S; S.init(F.G, F.bx, NQ / 256, 0);
          EpiQ E{WSP(bf16_t, WS_Q), rsq, WSP(float, WS_RCOS), WSP(float, WS_RSIN)};
          run_gemm(F, g, S, E); }
        { pg8::Gemm g{WSP(bf16_t, WS_CKV), WSP(bf16_t, WS_WKV) + (size_t)L * NKV * KVLR, MTOK, NKV, KVLR};
          pg8::SplitOrder S; S.init(F.G, F.bx, NKV / 256, 1);
          EpiKV E{WSP(bf16_t, WS_KV), rsq};
          run_gemm(F, g, S, E); }
        if (PROBE_REP == 3 && L == 0) { xcd_barrier(bar);
          { pg8::Gemm g{WSP(bf16_t, WS_CQ), WSP(bf16_t, WS_WQ) + (size_t)L * NQ * QLR, MTOK, NQ, QLR}; pg8::SplitOrder S; S.init(F.G, F.bx, NQ / 256, 0); EpiQ E{WSP(bf16_t, WS_Q), rsq, WSP(float, WS_RCOS), WSP(float, WS_RSIN)}; run_gemm(F, g, S, E); }
          { pg8::Gemm g{WSP(bf16_t, WS_CKV), WSP(bf16_t, WS_WKV) + (size_t)L * NKV * KVLR, MTOK, NKV, KVLR}; pg8::SplitOrder S; S.init(F.G, F.bx, NKV / 256, 1); EpiKV E{WSP(bf16_t, WS_KV), rsq}; run_gemm(F, g, S, E); } }
#if IMPL_FFT & 1
        if (!fft_first) fft1_fast(F, L);
#else
        fft1_naive(F);
#endif
        if (defer && !fft_first) { PH_ENTER(); p0_mod(F, 384, 2 * 384); p0_wcat(F, 1, 2); }
        if (PROBE_REP == 7 && L == 0) { xcd_barrier(bar); fft1_fast(F, L); }
    }
    PH_SEAM(P + 1);
#if PROBE_CHECK
    if (L == PROBE_CHECK - 1 && PH_IN(P + 2)) { PH_ENTER(); chk_proj(F, L); __syncthreads(); }
#endif
    if (PH_IN(P + 2) && DIAG_EN(4)) {
        PH_ENTER();
#ifdef PROBE_IDLE
        if (L == 0) { const unsigned long long tend = __builtin_amdgcn_s_memrealtime() + (unsigned long long)PROBE_IDLE * 100ull; while (__builtin_amdgcn_s_memrealtime() < tend) __builtin_amdgcn_s_sleep(32); }
#endif
        const bool fft2_first = PHASE_STAG && ((F.bx >> ATT_STAG_SHIFT) & 1);
#if IMPL_FFT & 2
        if (fft2_first) { fft2_fast(F, L); PH_ENTER(); }
#endif
#if IMPL_ATTN
        unsigned long long at0 = 0, ar0 = 0;
        if (PROBE_CLK == 2 && L == 0) { at0 = __builtin_amdgcn_s_memtime(); ar0 = __builtin_amdgcn_s_memrealtime(); }
        attn_fast(F);
#if ATT_STAMP >= 0
        if (L == 0 && F.bx == 0 && F.tid == 0) { volatile LAS unsigned* mw = (volatile LAS unsigned*)(F.lds + MISC_OFF) + 16;
            const unsigned long long cyc = (unsigned long long)mw[ATT_STAMP] * 16ull / 124ull; const unsigned long long tend = __builtin_amdgcn_s_memrealtime() + cyc * 10ull;
            while (__builtin_amdgcn_s_memrealtime() < tend) __builtin_amdgcn_s_sleep(8); }
#endif
        if (PROBE_CLK == 2 && L == 0 && F.bx == 0) { const unsigned long long at1 = __builtin_amdgcn_s_memtime(), ar1 = __builtin_amdgcn_s_memrealtime();
            const unsigned long long mhz = (at1 - at0) * 100ull / (ar1 - ar0); const unsigned long long tend = ar1 + mhz * 10ull;
            while (__builtin_amdgcn_s_memrealtime() < tend) __builtin_amdgcn_s_sleep(8); }
        if (PROBE_REP == 4 && L == 0) { __syncthreads(); F.mix_off = WS_R; attn_fast<PROBE_VAR>(F); F.mix_off = WS_MIX; }
#else
        attn_naive(F);
#endif
        __syncthreads();
#if IMPL_FFT & 2
        if (!fft2_first) fft2_fast(F, L);
        if (PROBE_REP == 8 && L == 0) { __syncthreads(); F.mix_off = WS_R; fft2_fast(F, L); F.mix_off = WS_MIX; }
#else
        fft2_naive(F, L);
#endif
    }
    PH_SEAM(P + 2);
#if PROBE_CHECK
    if (L == PROBE_CHECK - 1 && PH_IN(P + 3)) { PH_ENTER(); chk_attn(F); __syncthreads(); }
#endif
    if (mrg) { PH_STAMP(P + 3); merged_region<L>(F); if (L + 1 < DEPTH) { PH_STAMP(P + 4); xcd_barrier(bar); } return; }
    if (PH_IN(P + 3) && DIAG_EN(5)) {
        PH_ENTER();
        pg8::Gemm g{WSP(bf16_t, WS_MIX), WSP(bf16_t, WS_WOUT) + (size_t)L * DM * DM, MTOK, DM, DM};
        pg8::StaticOrder S; S.init(MTOK, DM, F.G, F.bx);
        EpiOut E{(LN_DROP_R && L == 0) ? WSP(bf16_t, WS_R) : WSP(bf16_t, WS_H), WSP(float, WS_MOD) + (size_t)L * NB * (3 * DM) + 2 * DM};
        run_gemm(F, g, S, E);
        if (PROBE_REP == 5 && L == 0) { xcd_barrier(bar); run_gemm(F, g, S, E); }
        if (PROBE_REP == 15 && L == 0) { xcd_barrier(bar); EpiNone E2; run_gemm(F, g, S, E2); }
    }
    PH_SEAM(P + 3);
    if (PH_IN(P + 4) && DIAG_EN(6)) {
        PH_ENTER();
        int r0, r1; ln_rows(F, r0, r1); if (L + 1 < DEPTH) p_ln_post<true>(F, L, r0, r1, 8); else if (LN_DROP_R) p_ln_last(F, r0, r1, 8); else p_ln_post<false>(F, L, r0, r1, 8);
        if (PROBE_REP == 6 && L + 1 == DEPTH) { xcd_barrier(bar); for (int q = 0; q < PROBE_N; ++q) if (PROBE_VAR == 0 || ((F.bx >> 3) % (PROBE_VAR ? PROBE_VAR : 1)) == 0) { int q0, q1; ln_rows(F, q0, q1); p_ln_post<false>(F, L, q0, q1, 8); } }
    }
    PH_SEAM(P + 4);
}

__global__ void __launch_bounds__(NTHREADS, 2) fwd_kernel(Args args) {
    extern __shared__ __attribute__((aligned(16))) unsigned char lds[];
    Frame F;
    F.in[0] = args.in[0]; F.in[1] = args.in[1]; F.in[2] = args.in[2]; F.in[3] = args.in[3]; F.in[4] = args.in[4]; F.in[5] = args.in[5]; F.in[6] = args.in[6]; F.in[7] = args.in[7]; F.in[8] = args.in[8]; F.in[9] = args.in[9]; F.in[10] = args.in[10]; F.in[11] = args.in[11]; F.in[12] = args.in[12]; F.in[13] = args.in[13];
    F.out = args.out; F.ws = args.ws; F.lds = (LAS unsigned char*)lds; F.ldsg = (char*)lds;
    F.tid = threadIdx.x; F.lane = F.tid & 63; F.wave = __builtin_amdgcn_readfirstlane(F.tid >> 6); F.G = gridDim.x; F.bx = blockIdx.x;
    F.vcu = (F.G % 8 == 0) ? (F.bx % 8) * (F.G / 8) + F.bx / 8 : F.bx; F.mix_off = WS_MIX;
    volatile LAS unsigned* MISC = (volatile LAS unsigned*)(F.lds + MISC_OFF);
    if (F.tid < 64) MISC[F.tid] = 0u;
    __syncthreads();
    const int lo = args.ph_lo, hi = args.ph_hi;
    XcdBarrier bar; bar.bar = WSP(unsigned, WS_CTL); bar.x = 0; bar.st = MISC;
    if (hi - lo > 1) bar = xcd_barrier_post(WSP(unsigned, WS_CTL), MISC);
    const bool defer = P0_DEFER && (hi - lo == N_PHASES) && DEPTH == 2;
    if (PH_IN(0) && DIAG_EN(0)) { PH_ENTER(); const int nl = defer ? 1 : DEPTH; p0_weights(F, 0, nl * 848); p0_mod(F, 0, nl * 384); p0_tables(F); p0_wcat(F, 0, nl); }
    PH_SEAM(0);
#if XCD_REMAP
    if (PH_IN(0) && PH_IN(1) && MISC[3] == 1u) { const int rk = __builtin_amdgcn_readfirstlane((int)MISC[2]), xc = __builtin_amdgcn_readfirstlane((int)bar.x);
        if (rk < F.G / 8 && xc < 8) { F.bx = rk * 8 + xc; F.vcu = xc * (F.G / 8) + rk; } }
#endif
    if (PH_IN(1) && DIAG_EN(1)) { PH_ENTER(); int r0, r1; ln_rows(F, r0, r1); p_ln_first(F, r0, r1, 8); if (PROBE_REP == 1) { xcd_barrier(bar); p_ln_first(F, r0, r1, 8); } }
    PH_SEAM(1);
    if (PROBE_REP == 40) { for (int q = 0; q < 8; ++q) xcd_barrier(bar); }
    layer_phases<0>(F, lo, hi, bar);
    layer_phases<1>(F, lo, hi, bar);
#if PROBE_CHECK
    xcd_barrier(bar); chk_finish(F);
#endif
#if PROBE_SKEW
    PH_STAMP(N_PHASES - 1); xcd_barrier(bar);
    if (F.bx == 0 && F.tid < 64) {
        unsigned long long* stp = WSP(unsigned long long, WS_END);
        unsigned long long acc = 0, prevmx = 0;
        for (int k = 0; k < N_PHASES; ++k) {
            unsigned long long mx = 0, mn = ~0ull, sm = 0;
            for (int j = 0; j < 4; ++j) { const unsigned long long v = __hip_atomic_load(stp + k * 256 + F.tid * 4 + j, __ATOMIC_RELAXED, __HIP_MEMORY_SCOPE_AGENT); mx = v > mx ? v : mx; mn = v < mn ? v : mn; sm += v; }
            for (int o = 32; o > 0; o >>= 1) { const unsigned long long a = __shfl_xor(mx, o), b = __shfl_xor(mn, o), c = __shfl_xor(sm, o); mx = a > mx ? a : mx; mn = b < mn ? b : mn; sm += c; }
            if ((PROBE_SKEW_MASK >> k) & 1u) { if (PROBE_SKEW == 1) acc += mx - sm / 256ull; else if (PROBE_SKEW == 2) acc += mx - mn; else if (k > 0) acc += mx - prevmx; }
            prevmx = mx;
        }
        const unsigned long long tend = __builtin_amdgcn_s_memrealtime() + acc * (unsigned long long)PROBE_SKEW_MUL;
        while (__builtin_amdgcn_s_memrealtime() < tend) __builtin_amdgcn_s_sleep(8);
    }
#endif
}

extern "C" void kernel_launch(void* const* d_in, const int* in_sizes, int n_in, void* d_out, int out_size, void* d_ws, size_t ws_size, hipStream_t stream) {
    static int grid = 0;
    if (grid == 0) {
        if (n_in != 14 || in_sizes[0] != MTOK * DM || out_size != MTOK * DM || ws_size < WS_END) {
            fprintf(stderr, "kernel_launch: shape mismatch (n_in %d, in0 %d, out %d, ws %zu, need ws >= %zu); nothing launched\n", n_in, n_in > 0 ? in_sizes[0] : -1, out_size, ws_size, (size_t)WS_END); grid = -1; return; }
        int dev = 0, cus = 0, per_cu = 0;
        if (hipGetDevice(&dev) != hipSuccess || hipDeviceGetAttribute(&cus, hipDeviceAttributeMultiprocessorCount, dev) != hipSuccess) { grid = -1; return; }
        if (hipFuncSetAttribute((const void*)fwd_kernel, hipFuncAttributeMaxDynamicSharedMemorySize, LDS_BYTES) != hipSuccess) { fprintf(stderr, "kernel_launch: hipFuncSetAttribute failed\n"); grid = -1; return; }
        if (hipOccupancyMaxActiveBlocksPerMultiprocessor(&per_cu, (const void*)fwd_kernel, NTHREADS, LDS_BYTES) != hipSuccess || per_cu < 1) { fprintf(stderr, "kernel_launch: occupancy query failed (%d)\n", per_cu); (void)hipGetLastError(); per_cu = 1; }
        if (per_cu > 1) per_cu = 1;
        grid = cus * per_cu;
    }
    if (grid < 0) return;
    if (hipMemsetAsync((char*)d_ws + WS_CTL, 0, WS_RSQ - WS_CTL, stream) != hipSuccess) { fprintf(stderr, "kernel_launch: hipMemsetAsync failed\n"); return; }
    Args a{};
    for (int i = 0; i < 14; ++i) a.in[i] = (const float*)d_in[i];
    a.out = (float*)d_out; a.ws = (unsigned char*)d_ws;
#if N_LAUNCH_MODE
    a.ph_lo = 0; a.ph_hi = N_PHASES;
    hipLaunchKernelGGL(fwd_kernel, dim3(grid), dim3(NTHREADS), LDS_BYTES, stream, a);
#else
    for (int ph = 0; ph < N_PHASES; ++ph) { a.ph_lo = ph; a.ph_hi = ph + 1; hipLaunchKernelGGL(fwd_kernel, dim3(grid), dim3(NTHREADS), LDS_BYTES, stream, a); }
#endif
    const hipError_t le = hipPeekAtLastError();
    if (le != hipSuccess) fprintf(stderr, "kernel_launch: launch failed: %s (grid %d)\n", hipGetErrorName(le), grid);
}
```

```cpp
#define IMPL_GEMM 1
#define IMPL_ATTN 1
#define IMPL_FFT 3
#define N_LAUNCH_MODE 1
#include <hip/hip_runtime.h>
#include <cstdio>
#include <cstdint>

#ifndef PROBE_CHECK
#define PROBE_CHECK 0
#endif
#ifndef N_LAUNCH_MODE
#define N_LAUNCH_MODE 1
#endif
#ifndef IMPL_GEMM
#define IMPL_GEMM 1
#endif
#ifndef IMPL_ATTN
#define IMPL_ATTN 1
#endif
#ifndef IMPL_FFT
#define IMPL_FFT 3
#endif

#define LAS __attribute__((address_space(3)))
typedef unsigned short bf16_t;
typedef short bf16x8 __attribute__((ext_vector_type(8)));
typedef short s16x4 __attribute__((ext_vector_type(4)));
typedef float f32x4 __attribute__((ext_vector_type(4)));
typedef float f32x2 __attribute__((ext_vector_type(2)));
typedef float f32x16 __attribute__((ext_vector_type(16)));
typedef unsigned u32x4 __attribute__((ext_vector_type(4)));
typedef unsigned u32x2 __attribute__((ext_vector_type(2)));

constexpr int NB = 4, SEQ = 4096, DM = 2048, MTOK = NB * SEQ, DEPTH = 2;
constexpr int DF = 1024, NG = 8, GD = 128, NH = 8, DV = 128, DNOPE = 128, DROPE = 64, DQK = 192, QLR = 512, KVLR = 256;
constexpr int NIN = 3904, NINP = 4096;
constexpr int NQ = NH * DQK  , NKV = NH * (DNOPE + DV)  ;
constexpr float NORM_EPS = 1e-6f;
constexpr float DN_ALPHA = 1.4142135623730951f;
constexpr float ATT_SCALE = 0.07216878364870322f;

__device__ __forceinline__ float bf2f(bf16_t b) { return __uint_as_float(((unsigned)b) << 16); }
__device__ __forceinline__ bf16_t f2bf(float f) { unsigned u = __float_as_uint(f); u += 0x7FFFu + ((u >> 16) & 1u); return (bf16_t)(u >> 16); }
typedef __bf16 bf16v2_t __attribute__((ext_vector_type(2)));
__device__ __forceinline__ unsigned cvt_pk_bf16(float lo, float hi) { const f32x2 v = {lo, hi}; return __builtin_bit_cast(unsigned, __builtin_convertvector(v, bf16v2_t)); }
__device__ __forceinline__ float silu_f(float z) { return z * __builtin_amdgcn_rcpf(1.0f + __builtin_amdgcn_exp2f(-1.4426950408889634f * z)); }
__device__ __forceinline__ float wave_sum(float v) { for (int o = 32; o > 0; o >>= 1) v += __shfl_xor(v, o); return v; }
__device__ __forceinline__ float wave_max(float v) { for (int o = 32; o > 0; o >>= 1) v = fmaxf(v, __shfl_xor(v, o)); return v; }

constexpr size_t al256(size_t x) { return (x + 255) / 256 * 256; }
constexpr size_t WS_CTL  = 0;
constexpr size_t CTL_BYTES = 32768;
constexpr size_t WS_MOD  = WS_CTL + CTL_BYTES;
constexpr size_t WS_RSQ  = WS_MOD + al256((size_t)DEPTH * NB * 3 * DM * 4);
constexpr size_t WS_RCOS = WS_RSQ + al256((size_t)DEPTH * MTOK * 2 * 4);
constexpr size_t WS_RSIN = WS_RCOS + (size_t)MTOK * 32 * 4;
constexpr size_t WS_D1   = WS_RSIN + (size_t)MTOK * 32 * 4;
constexpr size_t WS_D2   = WS_D1 + 128 * 64 * 2;
constexpr size_t WS_WCAT = WS_D2 + 128 * 128 * 2;
constexpr size_t WS_WIN  = WS_WCAT + (size_t)DEPTH * NG * 128 * 256 * 2;
constexpr size_t WS_WOUT = WS_WIN + (size_t)DEPTH * NINP * DM * 2;
constexpr size_t WS_WQ   = WS_WOUT + (size_t)DEPTH * DM * DM * 2;
constexpr size_t WS_WKV  = WS_WQ + (size_t)DEPTH * NQ * QLR * 2;
constexpr size_t WS_H    = WS_WKV + (size_t)DEPTH * NKV * KVLR * 2;
constexpr size_t WS_U    = WS_H + (size_t)MTOK * DM * 2;
constexpr size_t WS_MIX  = WS_U + (size_t)MTOK * DF * 2;
constexpr size_t WS_CQ   = WS_MIX + (size_t)MTOK * DM * 2;
constexpr size_t WS_CKV  = WS_CQ + (size_t)MTOK * QLR * 2;
constexpr size_t WS_KR   = WS_CKV + (size_t)MTOK * KVLR * 2;
constexpr size_t WS_Q    = WS_KR + (size_t)MTOK * 64 * 2;
constexpr size_t WS_KV   = WS_Q + (size_t)MTOK * NQ * 2;
constexpr size_t WS_R    = WS_KV + (size_t)MTOK * NKV * 2;
constexpr size_t WS_END  = WS_R + (size_t)MTOK * DM * 4;
static_assert(WS_END <= (size_t)4 * MTOK * DM * 4, "workspace map exceeds 4 x largest tensor");

constexpr int RING_BYTES = 155648, MISC_OFF = RING_BYTES, LDS_BYTES = RING_BYTES + 256;
constexpr int NTHREADS = 512;

namespace pg8 {
#define PG8_LAS __attribute__((address_space(3)))
constexpr int BM = 256, BK = 64, HALF = 128, HTB = HALF * BK * 2  , STAGE_BYTES = 8 * HTB, NXCD = 8, WGM = 8;
static_assert(STAGE_BYTES <= RING_BYTES, "GEMM stage ring must fit the LDS phase scratch");

__host__ __device__ __forceinline__ int lds_byte(int r, int c) { const int st = (r >> 4) * 2 + (c >> 5), rr = r & 15, cc = c & 31, ob = rr * 64 + cc * 2; return st * 1024 + (ob ^ (((ob >> 9) & 1) << 5)); }
__host__ __device__ __forceinline__ void stage_rc(int b, int& R, int& C) { const int st = b / 1024, sb = b % 1024, swz = sb ^ (((sb >> 9) & 1) << 5); R = (st >> 1) * 16 + swz / 64; C = (st & 1) * 32 + (swz % 64) / 2; }
__host__ __device__ __forceinline__ int perm32(int rho) { const int n = rho >> 4, i = rho & 15; return 8 * (i >> 2) + 4 * n + (i & 3); }

struct Unit { int pm, pn; };
struct Gemm { const bf16_t* A; const bf16_t* Bt; int M, N, K; };

struct StaticOrder {
    int nM, nN, nwg, G, c;
    __host__ __device__ void init(int M, int N, int G_, int c_) { nM = M / BM; nN = N / BM; nwg = nM * nN; G = G_; c = c_; }
    __host__ __device__ bool next(int i, Unit& u) const {
        const long L = (long)i * G + c; if (L >= nwg) return false;
        int wgid = (int)L; { const int q = nwg / NXCD, r = nwg % NXCD, xcd = wgid % NXCD, off = wgid / NXCD; wgid = (xcd < r ? xcd * (q + 1) : r * (q + 1) + (xcd - r) * q) + off; }
        const int nig = WGM * nN, gid = wgid / nig, fm = gid * WGM, gsz = (nM - fm) < WGM ? (nM - fm) : WGM;
        u.pm = fm + ((wgid % nig) % gsz); u.pn = (wgid % nig) / gsz; return true;
    }
    __device__ __forceinline__ void a_ready(const Unit&) const {}
    __device__ __forceinline__ void done(const Unit&) const {}
};
struct HotOrder : StaticOrder { int pm0, pn0; __device__ bool next(int i, Unit& u) const { Unit t; if (!StaticOrder::next(i, t)) return false; u.pm = pm0; u.pn = pn0; return true; } };
struct SplitOrder {
    int G, c, nN, kind;
    __device__ void init(int G_, int c_, int nN_, int kind_) { G = G_; c = c_; nN = nN_; kind = kind_; }
    __device__ bool next(int i, Unit& u) const {
        if (G != 256) { const int L = i * G + c; if (L >= 64 * nN) return false; u.pm = L / nN; u.pn = L % nN; return true; }
        const int x = c & 7, v = c >> 3; int li;
        if (kind == 0) { if (v < 16) { if (i >= 2) return false; li = 2 * v + i; } else { if (i >= 1) return false; li = 32 + (v - 16); } }
        else           { if (v < 16) { if (i >= 1) return false; li = v; } else { if (i >= 3) return false; li = 16 + 3 * (v - 16) + i; } }
        u.pm = 8 * x + li / nN; u.pn = li % nN; return true;
    }
    __device__ __forceinline__ void a_ready(const Unit&) const {}
    __device__ __forceinline__ void done(const Unit&) const {}
};
struct GridOrder {
    int pm0, npm, pn0, pnstep, npn;
    __device__ bool next(int i, Unit& u) const { if (i >= npm * npn) return false; u.pm = pm0 + i / npn; u.pn = pn0 + (i % npn) * pnstep; return true; }
    __device__ __forceinline__ void a_ready(const Unit&) const {}
    __device__ __forceinline__ void done(const Unit&) const {}
};
template <class Epi, class Sched, bool ALIGN_EPI = false, bool SP2 = false>
__device__ __forceinline__ void gemm_phase(PG8_LAS unsigned char* lds, const Gemm g, const Sched& S, const Epi& E, const int tid) {
    const int wid = __builtin_amdgcn_readfirstlane(tid >> 6), lane = tid & 63, wr = wid >> 2, wc = wid & 3, fr = lane & 15, fq = lane >> 4;
    const int K = g.K, nt = K / BK;
    unsigned voffA[2], voffB[2];
#pragma unroll
    for (int i = 0; i < 2; ++i) { int R, C; stage_rc(tid * 16 + i * 8192, R, C); const int Rb = Epi::PERM ? ((R & ~31) + perm32(R & 31)) : R;
        voffA[i] = (unsigned)(R * K + C) * 2u; voffB[i] = (unsigned)(Rb * K + C) * 2u; }
    const size_t kstep = (size_t)(BK * 2);
    const size_t hstep = (size_t)HALF * K * 2;
    const size_t tstep = 2 * hstep;
    const unsigned ldsw = (unsigned)wid * 1024u;
    const int aoff = lds_byte(wr * 64 + fr, fq * 8), boff = lds_byte(wc * 32 + fr, fq * 8);
#define PG8_SA(b, h) (((b) * 2 + (h)) * HTB)
#define PG8_SB(b, h) ((4 + (b) * 2 + (h)) * HTB)
#define PG8_STAGE(bufoff, gbase, voff) do { _Pragma("unroll") for (int _i = 0; _i < 2; ++_i) \
        __builtin_amdgcn_global_load_lds((const unsigned*)((const char*)(gbase) + (voff)[_i]), (PG8_LAS unsigned*)(lds + (bufoff) + ldsw + _i * 8192), 16, 0, 0); } while (0)
#define PG8_LDA(dst, b, h) do { _Pragma("unroll") for (int m = 0; m < 4; ++m) _Pragma("unroll") for (int k = 0; k < 2; ++k) dst[m][k] = *(const PG8_LAS bf16x8*)(lds + PG8_SA(b, h) + aoff + m * 2048 + k * 1024); } while (0)
#define PG8_LDB(dst, b, h) do { _Pragma("unroll") for (int n = 0; n < 2; ++n) _Pragma("unroll") for (int k = 0; k < 2; ++k) dst[n][k] = *(const PG8_LAS bf16x8*)(lds + PG8_SB(b, h) + boff + n * 2048 + k * 1024); } while (0)
#define PG8_MMA(ai, bj, At, Bt) do { if (!(skipm & (1 << (bj)))) { __builtin_amdgcn_s_setprio(1); _Pragma("unroll") for (int m = 0; m < 4; ++m) _Pragma("unroll") for (int n = 0; n < 2; ++n) _Pragma("unroll") for (int k = 0; k < 2; ++k) \
        acc[ai][bj][m][n] = __builtin_amdgcn_mfma_f32_16x16x32_bf16(Bt[n][k], At[m][k], acc[ai][bj][m][n], 0, 0, 0); __builtin_amdgcn_s_setprio(0); } } while (0)
#define PG8_WAIT_V(n) asm volatile("s_waitcnt vmcnt(" #n ")" ::: "memory")
#define PG8_WAIT_L(n) asm volatile("s_waitcnt lgkmcnt(" #n ")" ::: "memory")
#define PG8_BAR __builtin_amdgcn_s_barrier()
#define PG8_SCHED __builtin_amdgcn_sched_barrier(0)
    Unit cur, nxt; int ui = 0;
    if (!S.next(0, cur)) return;
    int skipm = Epi::mma_skip(cur.pn, wc);
    f32x4 acc[2][2][4][2];
#pragma unroll
    for (int a = 0; a < 2; ++a)
#pragma unroll
        for (int b = 0; b < 2; ++b)
#pragma unroll
            for (int m = 0; m < 4; ++m)
#pragma unroll
                for (int n = 0; n < 2; ++n) acc[a][b][m][n] = (f32x4){0.f, 0.f, 0.f, 0.f};
    bf16x8 At[4][2], B0[2][2], B1[2][2];
    const char* cA = (const char*)g.A + (size_t)cur.pm * tstep; const char* cB = (const char*)g.Bt + (size_t)cur.pn * tstep;
    S.a_ready(cur);
    if constexpr (SP2) {
        PG8_STAGE(PG8_SB(0, 0), cB, voffB); PG8_STAGE(PG8_SB(0, 1), cB + hstep, voffB); PG8_STAGE(PG8_SA(0, 0), cA, voffA); PG8_STAGE(PG8_SA(0, 1), cA + hstep, voffA);
        if (wr == 1) PG8_BAR;
        PG8_WAIT_V(2); PG8_BAR;
        PG8_STAGE(PG8_SB(1, 0), cB + kstep, voffB); PG8_STAGE(PG8_SA(1, 0), cA + kstep, voffA); PG8_STAGE(PG8_SB(1, 1), cB + hstep + kstep, voffB);
        PG8_WAIT_V(6); PG8_BAR;
    } else {
        PG8_STAGE(PG8_SB(0, 0), cB, voffB); PG8_STAGE(PG8_SA(0, 0), cA, voffA); PG8_STAGE(PG8_SB(0, 1), cB + hstep, voffB); PG8_STAGE(PG8_SA(0, 1), cA + hstep, voffA);
        if (wr == 1) PG8_BAR;
        PG8_WAIT_V(4); PG8_BAR;
        PG8_STAGE(PG8_SB(1, 0), cB + kstep, voffB); PG8_STAGE(PG8_SA(1, 0), cA + kstep, voffA); PG8_STAGE(PG8_SB(1, 1), cB + hstep + kstep, voffB);
        PG8_WAIT_V(6); PG8_BAR;
    }
    for (;;) {
        const bool has_next = S.next(ui + 1, nxt);
        const char* nA = has_next ? (const char*)g.A + (size_t)nxt.pm * tstep : cA; const char* nB = has_next ? (const char*)g.Bt + (size_t)nxt.pn * tstep : cB;
        for (int t = 0; t < nt; t += 2) {
            const bool last = (t == nt - 2);
            const char* a1 = cA + (size_t)(t + 1) * kstep;
            const char* a2 = last ? nA : cA + (size_t)(t + 2) * kstep; const char* b2 = last ? nB : cB + (size_t)(t + 2) * kstep;
            const char* a3 = a2 + kstep; const char* b3 = b2 + kstep;
            if (last && has_next) S.a_ready(nxt);
            if constexpr (SP2) {
            PG8_LDB(B0, 0, 0); PG8_LDB(B1, 0, 1); PG8_SCHED; PG8_LDA(At, 0, 0); PG8_STAGE(PG8_SA(1, 1), a1 + hstep, voffA);
            PG8_WAIT_V(8); PG8_WAIT_L(0); PG8_BAR; PG8_MMA(0, 0, At, B0); PG8_MMA(0, 1, At, B1); PG8_BAR; PG8_SCHED;
            PG8_LDA(At, 0, 1); PG8_STAGE(PG8_SB(0, 0), b2, voffB); PG8_STAGE(PG8_SB(0, 1), b2 + hstep, voffB); PG8_STAGE(PG8_SA(0, 0), a2, voffA);
            PG8_WAIT_V(8); PG8_WAIT_L(0); PG8_BAR; PG8_MMA(1, 0, At, B0); PG8_MMA(1, 1, At, B1); PG8_BAR; PG8_SCHED;
            PG8_LDB(B0, 1, 0); PG8_LDB(B1, 1, 1); PG8_SCHED; PG8_LDA(At, 1, 0); PG8_STAGE(PG8_SA(0, 1), a2 + hstep, voffA);
            PG8_WAIT_V(8); PG8_WAIT_L(0); PG8_BAR; PG8_MMA(0, 0, At, B0); PG8_MMA(0, 1, At, B1); PG8_BAR; PG8_SCHED;
            PG8_LDA(At, 1, 1); PG8_STAGE(PG8_SB(1, 0), b3, voffB); PG8_STAGE(PG8_SB(1, 1), b3 + hstep, voffB); PG8_STAGE(PG8_SA(1, 0), a3, voffA);
            PG8_WAIT_V(8); PG8_WAIT_L(0); PG8_BAR; PG8_MMA(1, 0, At, B0); PG8_MMA(1, 1, At, B1); PG8_BAR; PG8_SCHED;
            } else {
            PG8_LDB(B0, 0, 0); PG8_SCHED; PG8_LDA(At, 0, 0); PG8_STAGE(PG8_SA(1, 1), a1 + hstep, voffA);
            PG8_WAIT_L(8); PG8_BAR; PG8_WAIT_L(0); PG8_MMA(0, 0, At, B0); PG8_BAR; PG8_SCHED;
            PG8_LDB(B1, 0, 1); PG8_STAGE(PG8_SB(0, 0), b2, voffB);
            PG8_BAR; PG8_WAIT_L(0); PG8_MMA(0, 1, At, B1); PG8_BAR;
            PG8_LDA(At, 0, 1); PG8_STAGE(PG8_SA(0, 0), a2, voffA);
            PG8_BAR; PG8_WAIT_L(0); PG8_MMA(1, 0, At, B0); PG8_BAR; PG8_SCHED;
            PG8_STAGE(PG8_SB(0, 1), b2 + hstep, voffB);
            PG8_WAIT_V(6); PG8_BAR; PG8_MMA(1, 1, At, B1); PG8_BAR;
            PG8_LDB(B0, 1, 0); PG8_SCHED; PG8_LDA(At, 1, 0); PG8_STAGE(PG8_SA(0, 1), a2 + hstep, voffA);
            PG8_WAIT_L(8); PG8_BAR; PG8_WAIT_L(0); PG8_MMA(0, 0, At, B0); PG8_BAR; PG8_SCHED;
            PG8_LDB(B1, 1, 1); PG8_STAGE(PG8_SB(1, 0), b3, voffB);
            PG8_BAR; PG8_WAIT_L(0); PG8_MMA(0, 1, At, B1); PG8_BAR;
            PG8_LDA(At, 1, 1); PG8_STAGE(PG8_SA(1, 0), a3, voffA);
            PG8_BAR; PG8_WAIT_L(0); PG8_MMA(1, 0, At, B0); PG8_BAR; PG8_SCHED;
            PG8_STAGE(PG8_SB(1, 1), b3 + hstep, voffB);
            PG8_WAIT_V(6); PG8_BAR; PG8_MMA(1, 1, At, B1); PG8_BAR;
            }
        }
        if constexpr (ALIGN_EPI) { if (wr == 0) PG8_BAR; }
        if constexpr (!Epi::AFTER_DRAIN) { E(acc, cur, wr, wc, fr, fq); S.done(cur); }
        if (!has_next) break;
#pragma unroll
        for (int a = 0; a < 2; ++a)
#pragma unroll
            for (int b = 0; b < 2; ++b)
#pragma unroll
                for (int m = 0; m < 4; ++m)
#pragma unroll
                    for (int n = 0; n < 2; ++n) acc[a][b][m][n] = (f32x4){0.f, 0.f, 0.f, 0.f};
        cur = nxt; cA = nA; cB = nB; ++ui; skipm = Epi::mma_skip(cur.pn, wc);
        if constexpr (ALIGN_EPI) { if (wr == 1) PG8_BAR; }
    }
    PG8_WAIT_V(0);
    if constexpr (!ALIGN_EPI) { if (wr == 0) PG8_BAR; }
    PG8_BAR;
    if constexpr (Epi::AFTER_DRAIN) { E.fused(acc, cur, wr, wc, fr, fq, lds, wid, lane); S.done(cur); }
#undef PG8_SA
#undef PG8_SB
#undef PG8_STAGE
#undef PG8_LDA
#undef PG8_LDB
#undef PG8_MMA
#undef PG8_WAIT_V
#undef PG8_WAIT_L
#undef PG8_BAR
#undef PG8_SCHED
}

template <class Epi, class Sched>
__device__ __forceinline__ void gemm_phase_naive(const Gemm g, const Sched& S, const Epi& E, const int tid) {
    const int wid = __builtin_amdgcn_readfirstlane(tid >> 6), lane = tid & 63, wr = wid >> 2, wc = wid & 3, fr = lane & 15, fq = lane >> 4;
    const int K = g.K;
    Unit cur;
    for (int ui = 0; S.next(ui, cur); ++ui) {
        f32x4 acc[2][2][4][2];
#pragma unroll
        for (int ai = 0; ai < 2; ++ai)
#pragma unroll
            for (int m = 0; m < 4; ++m) {
                const bf16_t* arow = g.A + (size_t)(cur.pm * BM + ai * HALF + wr * 64 + m * 16 + fr) * K;
#pragma unroll
                for (int bj = 0; bj < 2; ++bj)
#pragma unroll
                    for (int n = 0; n < 2; ++n) {
                        const int col = cur.pn * BM + bj * HALF + wc * 32 + (Epi::PERM ? (8 * fq + 4 * n) : (16 * n + 4 * fq));
                        const bf16_t* brow = g.Bt + (size_t)col * K;
                        float s0 = 0.f, s1 = 0.f, s2 = 0.f, s3 = 0.f;
#pragma unroll 1
                        for (int k = 0; k < K; k += 8) {
                            const bf16x8 av = *(const bf16x8*)(arow + k);
                            const bf16x8 b0 = *(const bf16x8*)(brow + k), b1 = *(const bf16x8*)(brow + K + k), b2 = *(const bf16x8*)(brow + 2 * K + k), b3 = *(const bf16x8*)(brow + 3 * K + k);
#pragma unroll
                            for (int e = 0; e < 8; ++e) { const float a = bf2f((bf16_t)av[e]);
                                s0 += a * bf2f((bf16_t)b0[e]); s1 += a * bf2f((bf16_t)b1[e]); s2 += a * bf2f((bf16_t)b2[e]); s3 += a * bf2f((bf16_t)b3[e]); }
                        }
                        acc[ai][bj][m][n] = (f32x4){s0, s1, s2, s3};
                    }
            }
        E(acc, cur, wr, wc, fr, fq);
    }
}
}
#ifndef PG8_SP2
#define PG8_SP2 true
#endif
#ifndef PG8_ALIGN
#define PG8_ALIGN true
#endif
typedef f32x4 AccT[2][2][4][2];

#ifndef EPI_NT
#define EPI_NT 0
#endif
__device__ __forceinline__ void store8_bf16(bf16_t* p, f32x4 v0, f32x4 v1) {
    u32x4 w; w.x = cvt_pk_bf16(v0[0], v0[1]); w.y = cvt_pk_bf16(v0[2], v0[3]); w.z = cvt_pk_bf16(v1[0], v1[1]); w.w = cvt_pk_bf16(v1[2], v1[3]); *(u32x4*)p = w;
}
__device__ __forceinline__ void store4_bf16(bf16_t* p, f32x4 v) { u32x2 w; w.x = cvt_pk_bf16(v[0], v[1]); w.y = cvt_pk_bf16(v[2], v[3]); *(u32x2*)p = w; }
__device__ __forceinline__ void estore8_bf16(bf16_t* p, f32x4 v0, f32x4 v1) {
    u32x4 w; w.x = cvt_pk_bf16(v0[0], v0[1]); w.y = cvt_pk_bf16(v0[2], v0[3]); w.z = cvt_pk_bf16(v1[0], v1[1]); w.w = cvt_pk_bf16(v1[2], v1[3]);
    if (EPI_NT) __builtin_nontemporal_store(w, (u32x4*)p); else *(u32x4*)p = w;
}
__device__ __forceinline__ void estore4_bf16(bf16_t* p, f32x4 v) { u32x2 w; w.x = cvt_pk_bf16(v[0], v[1]); w.y = cvt_pk_bf16(v[2], v[3]); if (EPI_NT) __builtin_nontemporal_store(w, (u32x2*)p); else *(u32x2*)p = w; }
__device__ __forceinline__ f32x4 silu4(f32x4 v) { return (f32x4){silu_f(v[0]), silu_f(v[1]), silu_f(v[2]), silu_f(v[3])}; }
__device__ __forceinline__ float sq4(f32x4 v) { return (v[0] * v[0] + v[1] * v[1]) + (v[2] * v[2] + v[3] * v[3]); }

#ifndef GATE_IN_EPI
#define GATE_IN_EPI 1
#endif
struct EpiIn {
    static constexpr bool PERM = true, AFTER_DRAIN = false;
    static __device__ __forceinline__ int mma_skip(int pn, int wc) { return pn == 11 ? (wc >= 2 ? 3 : 2) : 0; }
    bf16_t* U; bf16_t* MIX; bf16_t* CQ; bf16_t* CKV; bf16_t* KR; float* rsq; const float* rcos; const float* rsin;
    template <int ACT> __device__ __forceinline__ void plain(const AccT& acc, bf16_t* base, int ldc, int row0, int col0) const {
#pragma unroll
        for (int ai = 0; ai < 2; ++ai)
#pragma unroll
            for (int m = 0; m < 4; ++m) { bf16_t* rowp = base + (size_t)(row0 + ai * 128 + m * 16) * ldc + col0;
#pragma unroll
                for (int bj = 0; bj < 2; ++bj) { f32x4 v0 = acc[ai][bj][m][0], v1 = acc[ai][bj][m][1]; if (ACT) { v0 = silu4(v0); v1 = silu4(v1); } estore8_bf16(rowp + bj * 128, v0, v1); } }
    }
    __device__ __forceinline__ void sumsq(const AccT& acc, int row0, int which, int fq) const {
#pragma unroll
        for (int ai = 0; ai < 2; ++ai)
#pragma unroll
            for (int m = 0; m < 4; ++m) { float s = (sq4(acc[ai][0][m][0]) + sq4(acc[ai][0][m][1])) + (sq4(acc[ai][1][m][0]) + sq4(acc[ai][1][m][1]));
                s += __shfl_xor(s, 16); s += __shfl_xor(s, 32);
                if (fq == 0) atomicAdd(rsq + (size_t)(row0 + ai * 128 + m * 16) * 2 + which, s); }
    }
    __device__ __forceinline__ void operator()(const AccT& acc, const pg8::Unit& u, int wr, int wc, int fr, int fq) const {
        const int row0 = u.pm * 256 + wr * 64 + fr, pn = u.pn, cw = wc * 32 + 8 * fq;
        if (pn < 4) plain<0>(acc, U, DF, row0, pn * 256 + cw);
        else if (pn < 8) plain<GATE_IN_EPI>(acc, MIX, DM, row0, (pn - 4) * 256 + cw);
        else if (pn < 10) { plain<0>(acc, CQ, QLR, row0, (pn - 8) * 256 + cw); sumsq(acc, row0, 0, fq); }
        else if (pn == 10) { plain<0>(acc, CKV, KVLR, row0, cw); sumsq(acc, row0, 1, fq); }
        else if (pn == 11) {
            if (wc < 2) { const int i0 = 16 * wc + 4 * fq;
#pragma unroll
                for (int ai = 0; ai < 2; ++ai) {
                    f32x4 cc[4], ss[4];
#pragma unroll
                    for (int m = 0; m < 4; ++m) { const size_t row = (size_t)(row0 + ai * 128 + m * 16); cc[m] = *(const f32x4*)(rcos + row * 32 + i0); ss[m] = *(const f32x4*)(rsin + row * 32 + i0); }
#pragma unroll
                    for (int m = 0; m < 4; ++m) { const size_t row = (size_t)(row0 + ai * 128 + m * 16);
                        const f32x4 c = cc[m], s = ss[m], x1 = acc[ai][0][m][0], x2 = acc[ai][0][m][1];
                        estore4_bf16(KR + row * 64 + i0, x1 * c - x2 * s); estore4_bf16(KR + row * 64 + 32 + i0, x2 * c + x1 * s); } } }
        }
        else plain<GATE_IN_EPI>(acc, MIX, DM, row0, DF + (pn - 12) * 256 + cw);
    }
};
struct EpiQ {
    static constexpr bool PERM = true, AFTER_DRAIN = false;
    static __device__ __forceinline__ int mma_skip(int, int) { return 0; }
    bf16_t* Q; const float* rsq; const float* rcos; const float* rsin;
    __device__ __forceinline__ void operator()(const AccT& acc, const pg8::Unit& u, int wr, int wc, int fr, int fq) const {
        const int row0 = u.pm * 256 + wr * 64 + fr;
        float rsv[2][4];
        const int G0 = u.pn * 8 + wc, g60 = G0 % 6, g61 = (G0 + 4) % 6, ropeg = g60 >= 4 ? g60 : g61;
        const bool has_rope = g60 >= 4 || g61 >= 4; const int ri0 = 16 * (ropeg - 4) + 4 * fq;
#pragma unroll
        for (int ai = 0; ai < 2; ++ai)
#pragma unroll
            for (int m = 0; m < 4; ++m) rsv[ai][m] = rsq[(size_t)(row0 + ai * 128 + m * 16) * 2 + 0];
#pragma unroll
        for (int ai = 0; ai < 2; ++ai) {
            f32x4 cc[4], ss[4];
            if (has_rope) {
#pragma unroll
                for (int m = 0; m < 4; ++m) { const size_t row = (size_t)(row0 + ai * 128 + m * 16); cc[m] = *(const f32x4*)(rcos + row * 32 + ri0); ss[m] = *(const f32x4*)(rsin + row * 32 + ri0); } }
#pragma unroll
            for (int m = 0; m < 4; ++m) { const size_t row = (size_t)(row0 + ai * 128 + m * 16);
                const float rs = rsqrtf(rsv[ai][m] * (1.0f / QLR) + NORM_EPS);
#pragma unroll
                for (int bj = 0; bj < 2; ++bj) { const int G = u.pn * 8 + bj * 4 + wc, head = G / 6, g6 = G - head * 6;
                    const f32x4 v0 = acc[ai][bj][m][0] * rs, v1 = acc[ai][bj][m][1] * rs;
                    if (g6 < 4) estore8_bf16(Q + row * NQ + head * DQK + g6 * 32 + 8 * fq, v0, v1);
                    else { const int i0 = 16 * (g6 - 4) + 4 * fq; const f32x4 c = cc[m], s = ss[m];

#if defined(PROBE_NEG) && PROBE_NEG == 1
                        estore4_bf16(Q + row * NQ + head * DQK + 128 + i0, v0 * c + v1 * s); estore4_bf16(Q + row * NQ + head * DQK + 160 + i0, v1 * c - v0 * s);
#else
                        estore4_bf16(Q + row * NQ + head * DQK + 128 + i0, v0 * c - v1 * s); estore4_bf16(Q + row * NQ + head * DQK + 160 + i0, v1 * c + v0 * s);
#endif
                    } } } }
    }
};
struct EpiKV {
    static constexpr bool PERM = true, AFTER_DRAIN = false;
    static __device__ __forceinline__ int mma_skip(int, int) { return 0; }
    bf16_t* KV; const float* rsq;
    __device__ __forceinline__ void operator()(const AccT& acc, const pg8::Unit& u, int wr, int wc, int fr, int fq) const {
        const int row0 = u.pm * 256 + wr * 64 + fr, col0 = u.pn * 256 + wc * 32 + 8 * fq;
        float rsv[2][4];
#pragma unroll
        for (int ai = 0; ai < 2; ++ai)
#pragma unroll
            for (int m = 0; m < 4; ++m) rsv[ai][m] = rsq[(size_t)(row0 + ai * 128 + m * 16) * 2 + 1];
#pragma unroll
        for (int ai = 0; ai < 2; ++ai)
#pragma unroll
            for (int m = 0; m < 4; ++m) { const size_t row = (size_t)(row0 + ai * 128 + m * 16);
                const float rs = rsqrtf(rsv[ai][m] * (1.0f / KVLR) + NORM_EPS);
#pragma unroll
                for (int bj = 0; bj < 2; ++bj) estore8_bf16(KV + row * NKV + col0 + bj * 128, acc[ai][bj][m][0] * rs, acc[ai][bj][m][1] * rs); }
    }
};
struct EpiOut {
    static constexpr bool PERM = true, AFTER_DRAIN = false;
    static __device__ __forceinline__ int mma_skip(int, int) { return 0; }
    bf16_t* GY; const float* gate;
    __device__ __forceinline__ void operator()(const AccT& acc, const pg8::Unit& u, int wr, int wc, int fr, int fq) const {
        const int row0 = u.pm * 256 + wr * 64 + fr, col0 = u.pn * 256 + wc * 32 + 8 * fq;
        const float* gp = gate + (size_t)(u.pm >> 4) * (3 * DM) + col0;
        f32x4 gv[2][2];
#pragma unroll
        for (int bj = 0; bj < 2; ++bj)
#pragma unroll
            for (int n = 0; n < 2; ++n) gv[bj][n] = *(const f32x4*)(gp + bj * 128 + n * 4);
#pragma unroll
        for (int ai = 0; ai < 2; ++ai)
#pragma unroll
            for (int m = 0; m < 4; ++m) { bf16_t* rowp = GY + (size_t)(row0 + ai * 128 + m * 16) * DM + col0;
#pragma unroll
                for (int bj = 0; bj < 2; ++bj) estore8_bf16(rowp + bj * 128, gv[bj][0] * acc[ai][bj][m][0], gv[bj][1] * acc[ai][bj][m][1]); }
    }
};

struct EpiNone {
    static constexpr bool PERM = true, AFTER_DRAIN = false;
    static __device__ __forceinline__ int mma_skip(int, int) { return 0; }
    __device__ __forceinline__ void operator()(const AccT& acc, const pg8::Unit& u, int wr, int wc, int fr, int fq) const {
#pragma unroll
        for (int ai = 0; ai < 2; ++ai)
#pragma unroll
            for (int bj = 0; bj < 2; ++bj)
#pragma unroll
                for (int m = 0; m < 4; ++m)
#pragma unroll
                    for (int n = 0; n < 2; ++n) asm volatile("" :: "v"(acc[ai][bj][m][n]));
    }
};
#define XB_TMO      128
#define XB_XCNT(j)  (256  + 64 * (j))
#define XB_XSUB(j)  (1280 + 64 * (j))
#define XB_XGEN(j)  (2304 + 64 * (j))
#define XB_TOP      3328
#define XB_TOPGEN   3392
#define XCD_BAR_WORDS 3456
#define XB_SPIN_CAP (1u << 22)
static_assert(XCD_BAR_WORDS * 4 <= CTL_BYTES, "barrier words must fit the control region");
__device__ __forceinline__ unsigned xb_ld(unsigned* p)              { return __hip_atomic_load(p, __ATOMIC_RELAXED, __HIP_MEMORY_SCOPE_AGENT); }
__device__ __forceinline__ unsigned xb_add(unsigned* p, unsigned v) { return __hip_atomic_fetch_add(p, v, __ATOMIC_RELAXED, __HIP_MEMORY_SCOPE_AGENT); }
__device__ __forceinline__ unsigned xb_xcc_id() { return (unsigned)__builtin_amdgcn_s_getreg((3 << 11) | 20) & 0xFu; }
#define XB_SPIN(cond, bar) do { unsigned _sp = 0; while (cond) { __builtin_amdgcn_s_sleep(1); \
    if ((++_sp & 255u) == 0u) { if (xb_ld(&(bar)[XB_TMO])) break; if (_sp > XB_SPIN_CAP) { atomicAdd(&(bar)[XB_TMO], 1u); break; } } } } while (0)
struct XcdBarrier { unsigned* bar; unsigned x; volatile LAS unsigned* st; };
__device__ __forceinline__ XcdBarrier xcd_barrier_post(unsigned* bar, volatile LAS unsigned* st) {
    XcdBarrier b; b.bar = bar; b.x = xb_xcc_id(); b.st = st;
    if (threadIdx.x == 0) st[2] = xb_add(&bar[XB_XCNT(b.x)], 1u);
    return b;
}
__device__ __forceinline__ void xcd_barrier_complete(unsigned* bar, unsigned x, unsigned& nloc, unsigned& nx, unsigned& even) {
    const unsigned G = gridDim.x * gridDim.y * gridDim.z;
    unsigned sum, cnt, mine, sp = 0u;
    for (;;) {
        sum = 0u; cnt = 0u; mine = 0u; even = 1u;
#pragma unroll
        for (unsigned j = 0; j < 16; ++j) { const unsigned c = xb_ld(&bar[XB_XCNT(j)]); sum += c; cnt += (c > 0u) ? 1u : 0u; mine = (j == x) ? c : mine; if (c != (j < 8u ? G / 8u : 0u)) even = 0u; }
        if (sum == G) break;
        __builtin_amdgcn_s_sleep(1);
        if ((++sp & 255u) == 0u) { if (xb_ld(&bar[XB_TMO])) break; if (sp > XB_SPIN_CAP) { atomicAdd(&bar[XB_TMO], 1u); break; } }
    }
    nloc = mine > 0u ? mine : 1u; nx = cnt > 0u ? cnt : 1u;
}
__device__ __forceinline__ void xcd_barrier(const XcdBarrier& b) {
    asm volatile("s_waitcnt vmcnt(0)" ::: "memory");
    __syncthreads();
    if (threadIdx.x == 0) {
        unsigned* bar = b.bar;
        __builtin_amdgcn_s_waitcnt(0);
        unsigned nloc = b.st[0], nx = b.st[1];
        if (nloc == 0u) { unsigned even; xcd_barrier_complete(bar, b.x, nloc, nx, even); b.st[0] = nloc; b.st[1] = nx; b.st[3] = (even && (gridDim.x % 8u) == 0u) ? 1u : 2u; }
        const unsigned old = xb_add(&bar[XB_XSUB(b.x)], 1u);
        const unsigned gen = old / nloc;
        if (old + 1u == (gen + 1u) * nloc) {
            __builtin_amdgcn_fence(__ATOMIC_RELEASE, "agent");
            asm volatile("s_waitcnt vmcnt(0)" ::: "memory");
            const unsigned og = xb_add(&bar[XB_TOP], 1u);
            const unsigned tg = og / nx;
            if (og + 1u == (tg + 1u) * nx) xb_add(&bar[XB_TOPGEN], 1u);
            else XB_SPIN(xb_ld(&bar[XB_TOPGEN]) == tg, bar);
            __builtin_amdgcn_fence(__ATOMIC_ACQUIRE, "agent");
            xb_add(&bar[XB_XGEN(b.x)], 1u);
            asm volatile("s_waitcnt vmcnt(0)" ::: "memory");
        } else {
            XB_SPIN(xb_ld(&bar[XB_XGEN(b.x)]) == gen, bar);
            __builtin_amdgcn_fence(__ATOMIC_ACQUIRE, "agent");
            asm volatile("s_waitcnt vmcnt(0)" ::: "memory");
        }
    }
    __syncthreads();
}
__device__ __forceinline__ void grp_barrier(unsigned* bar, unsigned* cnt, unsigned target) {
    asm volatile("s_waitcnt vmcnt(0)" ::: "memory");
    __syncthreads();
    if (threadIdx.x == 0) {
        __builtin_amdgcn_fence(__ATOMIC_RELEASE, "agent");
        asm volatile("s_waitcnt vmcnt(0)" ::: "memory");
        xb_add(cnt, 1u);
        XB_SPIN(xb_ld(cnt) < target, bar);
        __builtin_amdgcn_fence(__ATOMIC_ACQUIRE, "agent");
        asm volatile("s_waitcnt vmcnt(0)" ::: "memory");
    }
    __syncthreads();
}
struct Frame {
    const float* in[14]; float* out; unsigned char* ws;
    LAS unsigned char* lds; char* ldsg;
    int tid, lane, wave, G, bx, vcu; size_t mix_off;
};
#define WSP(T, off) ((T*)(F.ws + (off)))

__device__ __forceinline__ int src_in(int n) {
    if (n < 2816) return n;
    if (n < 3072) { const int c = n - 2816, bj = c >> 7, wc = (c >> 5) & 3, c32 = c & 31; if (bj || wc >= 2) return -1;
        const int fq = c32 >> 3, nn = (c32 >> 2) & 1, j = c32 & 3; return 2816 + 32 * nn + 16 * wc + 4 * fq + j; }
    return n - 192;
}
__device__ __forceinline__ int src_q(int n) {
    const int G = n >> 5, c32 = n & 31, head = G / 6, g6 = G - head * 6;
    if (g6 < 4) return head * DQK + g6 * 32 + c32;
    const int fq = c32 >> 3, nn = (c32 >> 2) & 1, j = c32 & 3; return head * DQK + 128 + 32 * nn + 16 * (g6 - 4) + 4 * fq + j;
}
struct WItem { const float* W; const float* ksc; bf16_t* Bt; int Nsrc, K, n0, k0, src; };
__device__ __forceinline__ WItem w_decode(const Frame& F, int it, int n4) {
    constexpr int TIN = 512, TOUT = 256, TQ = 48, TKV = 32, TL = TIN + TOUT + TQ + TKV;
    const int l = it / TL; int r = it - l * TL, kind, nt, kt; WItem w; w.ksc = nullptr;
    if (r < TIN) { kind = 0; nt = r >> 3; kt = r & 7; w.W = F.in[5] + (size_t)l * DM * NIN; w.Nsrc = NIN; w.K = DM; w.Bt = WSP(bf16_t, WS_WIN) + (size_t)l * NINP * DM; }
    else if (r < TIN + TOUT) { r -= TIN; kind = 1; nt = r >> 3; kt = r & 7; w.W = F.in[11] + (size_t)l * DM * DM; w.Nsrc = DM; w.K = DM; w.Bt = WSP(bf16_t, WS_WOUT) + (size_t)l * DM * DM; }
    else if (r < TIN + TOUT + TQ) { r -= TIN + TOUT; kind = 2; nt = r >> 1; kt = r & 1; w.W = F.in[7] + (size_t)l * QLR * NQ; w.Nsrc = NQ; w.K = QLR; w.ksc = F.in[6] + l * QLR; w.Bt = WSP(bf16_t, WS_WQ) + (size_t)l * NQ * QLR; }
    else { r -= TIN + TOUT + TQ; kind = 3; nt = r; kt = 0; w.W = F.in[9] + (size_t)l * KVLR * NKV; w.Nsrc = NKV; w.K = KVLR; w.ksc = F.in[8] + l * KVLR; w.Bt = WSP(bf16_t, WS_WKV) + (size_t)l * NKV * KVLR; }
    w.n0 = nt * 64; w.k0 = kt * 256; const int n = w.n0 + n4;
    w.src = kind == 0 ? src_in(n) : (kind == 2 ? src_q(n) : n);
    return w;
}
__device__ __forceinline__ void p0_weights(const Frame& F, const int it0, const int it1) {
    constexpr int TL = 512 + 256 + 48 + 32;
    LAS unsigned* T = (LAS unsigned*)F.lds;
    const int tid = F.tid, n4 = (tid & 15) * 4, kp = tid >> 4;
    int it = it0 + F.bx; if (it >= it1) return;
    f32x4 a0[4], a1[4]; float s0[4], s1[4];
#define W_LOAD(I) do { _Pragma("unroll") for (int i = 0; i < 4; ++i) { const int k = (I).k0 + 2 * (kp + 32 * i); \
        a0[i] = (I).src >= 0 ? __builtin_nontemporal_load((const f32x4*)((I).W + (size_t)k * (I).Nsrc + (I).src)) : (f32x4){0.f, 0.f, 0.f, 0.f}; \
        a1[i] = (I).src >= 0 ? __builtin_nontemporal_load((const f32x4*)((I).W + (size_t)(k + 1) * (I).Nsrc + (I).src)) : (f32x4){0.f, 0.f, 0.f, 0.f}; \
        s0[i] = (I).ksc ? (I).ksc[k] : 1.0f; s1[i] = (I).ksc ? (I).ksc[k + 1] : 1.0f; } } while (0)
    WItem nx = w_decode(F, it, n4); W_LOAD(nx);
    for (; it < it1; it += F.G) {
        const WItem me = nx; f32x4 v0[4], v1[4];
#pragma unroll
        for (int i = 0; i < 4; ++i) { v0[i] = a0[i] * s0[i]; v1[i] = a1[i] * s1[i]; }
        if (it + F.G < it1) { nx = w_decode(F, it + F.G, n4); W_LOAD(nx); }
#pragma unroll
        for (int i = 0; i < 4; ++i)
#pragma unroll
            for (int e = 0; e < 4; ++e) T[(n4 + e) * 130 + kp + 32 * i] = cvt_pk_bf16(v0[i][e], v1[i][e]);
        __syncthreads();
#pragma unroll
        for (int i = 0; i < 4; ++i) { const int c = tid + 512 * i, nn = c >> 5, kc = c & 31;
            const u32x2 a = *(const LAS u32x2*)(T + nn * 130 + kc * 4), b = *(const LAS u32x2*)(T + nn * 130 + kc * 4 + 2);
            *(u32x4*)(me.Bt + (size_t)(me.n0 + nn) * me.K + me.k0 + kc * 8) = (u32x4){a.x, a.y, b.x, b.y}; }
        __syncthreads();
    }
#undef W_LOAD
}
__device__ __forceinline__ void p0_mod(const Frame& F, const int it0, const int it1) {
    LAS float* red = (LAS float*)(F.lds + 32768);
    LAS float* sl = (LAS float*)(F.lds + 65536);
    const int tid = F.tid, cg = tid & 15, kl = tid >> 4;
    float* mod = WSP(float, WS_MOD); const float* cc = F.in[1];
    int it = it0 + F.bx; if (it >= it1) return;
#pragma unroll
    for (int j = 0; j < 16; ++j) sl[tid + 512 * j] = silu_f(cc[tid + 512 * j]);
    f32x4 wn[16];
#define M_LOAD(IT) do { const int l_ = (IT) / 384, rem_ = (IT) - l_ * 384; const float* wp = F.in[3] + ((size_t)l_ * DM + (rem_ & 3) * 512 + kl) * (3 * DM) + (rem_ >> 2) * 64 + cg * 4; \
        _Pragma("unroll") for (int i = 0; i < 16; ++i) wn[i] = __builtin_nontemporal_load((const f32x4*)(wp + (size_t)(32 * i) * (3 * DM))); } while (0)
    M_LOAD(it);
    __syncthreads();
    for (; it < it1; it += F.G) {
        const int l = it / 384, rem = it - l * 384, kq = rem & 3, col0 = (rem >> 2) * 64;
        f32x4 acc[4] = {}, w[16];
        float bias = 0.f;
        if (tid < 256 && kq == 0) bias = F.in[4][l * (3 * DM) + col0 + (tid >> 4) * 4 + (tid & 3)];
#pragma unroll
        for (int i = 0; i < 16; ++i) w[i] = wn[i];
        if (it + F.G < it1) M_LOAD(it + F.G);
#pragma unroll
        for (int i = 0; i < 16; ++i) { const int k = kq * 512 + kl + 32 * i;
#pragma unroll
            for (int b = 0; b < 4; ++b) acc[b] += w[i] * sl[b * DM + k]; }
#pragma unroll
        for (int b = 0; b < 4; ++b)
#pragma unroll
            for (int j = 0; j < 4; ++j) red[(kl * 16 + cg) * 16 + b * 4 + j] = acc[b][j];
        __syncthreads();
        if (tid < 256) { const int cg2 = tid >> 4, v = tid & 15, b = v >> 2, j = v & 3; float s = 0.f;
            for (int q = 0; q < 32; ++q) s += red[(q * 16 + cg2) * 16 + v];
            const int col = col0 + cg2 * 4 + j; s += bias;
            atomicAdd(mod + (size_t)(l * NB + b) * (3 * DM) + col, s); }
        __syncthreads();
    }
#undef M_LOAD
}
__device__ __forceinline__ void p0_tables(const Frame& F) {
    constexpr double INVF2PI[32] = {
    0.15915494309189535, 0.11934937021124886, 0.08949940160889101, 0.06711508300522726,
    0.050329212104487035, 0.03774158471741977, 0.0283021958306234, 0.02122365276477766,
    0.015915494309189534, 0.011934937021124886, 0.008949940160889102, 0.006711508300522725,
    0.005032921210448704, 0.003774158471741977, 0.00283021958306234, 0.0021223652764777662,
    0.0015915494309189536, 0.0011934937021124885, 0.0008949940160889102, 0.0006711508300522726,
    0.0005032921210448703, 0.00037741584717419774, 0.00028302195830623395, 0.0002122365276477766,
    0.00015915494309189535, 0.00011934937021124886, 8.949940160889102e-05, 6.711508300522725e-05,
    5.0329212104487035e-05, 3.774158471741978e-05, 2.8302195830623396e-05, 2.122365276477766e-05};
    const int gid = F.bx * NTHREADS + F.tid, NT = F.G * NTHREADS;
    const int* pos = (const int*)F.in[2]; float* rc = WSP(float, WS_RCOS); float* rs = WSP(float, WS_RSIN);
    for (int idx = gid; idx < MTOK * 32; idx += NT) { const int i = idx & 31; double t = (double)pos[idx >> 5] * INVF2PI[i]; t -= floor(t);
        float sn, cs; sincospif((float)(2.0 * t), &sn, &cs); rc[idx] = cs; rs[idx] = sn; }
    bf16_t* D1 = WSP(bf16_t, WS_D1); bf16_t* D2 = WSP(bf16_t, WS_D2);
    for (int idx = gid; idx < 128 * 64; idx += NT) { const int s1 = idx & 63, rr = idx >> 6, ri = rr >> 6, s1p = rr & 63; float sn, cs; sincospif((float)((s1 * s1p) & 63) * (1.0f / 32.0f), &sn, &cs);
        D1[idx] = f2bf((ri ? -sn : cs) * 0.125f); }
    for (int idx = gid; idx < 128 * 128; idx += NT) { const int kk = idx & 127, rr = idx >> 7, ri = kk >> 6, s2 = kk & 63, ro = rr >> 6, s2p = rr & 63; float sn, cs; sincospif((float)((s2 * s2p) & 63) * (1.0f / 32.0f), &sn, &cs);
        const float v = ro == 0 ? (ri == 0 ? cs : sn) : (ri == 0 ? -sn : cs); D2[idx] = f2bf(v * 0.125f); }
    float* rsq = WSP(float, WS_RSQ);
    for (int idx = gid; idx < DEPTH * MTOK * 2; idx += NT) rsq[idx] = 0.f;
}
__device__ __forceinline__ void p0_wcat(const Frame& F, const int l0, const int l1) {
    const int gid = F.bx * NTHREADS + F.tid, NT = F.G * NTHREADS;
    LAS float* ct = (LAS float*)F.lds; LAS float* st = ct + 128;
    if (F.tid < 128) { float sn, cs; sincospif((float)F.tid * (1.0f / 64.0f), &sn, &cs); ct[F.tid] = cs * 0.08838834764831845f; st[F.tid] = sn * 0.08838834764831845f; }
    __syncthreads();
    bf16_t* wcat = WSP(bf16_t, WS_WCAT);
    for (int t = l0 * (NG * 128 * 64) + gid; t < l1 * (NG * 128 * 64); t += NT) { const int k4 = (t & 63) * 4, d = (t >> 6) & 127, lg = t >> 13, ro = k4 >> 7, c0 = k4 & 127;
        const float* w = F.in[10] + (size_t)lg * 128 * 128 + d; LAS float* tb = ro ? st : ct; f32x4 s = {0.f, 0.f, 0.f, 0.f};
        for (int cp0 = 0; cp0 < 128; cp0 += 16) { float wv[16];
#pragma unroll
            for (int u = 0; u < 16; ++u) wv[u] = w[(cp0 + u) * 128];
#pragma unroll
            for (int u = 0; u < 16; ++u) { const int cp = cp0 + u; s += (f32x4){tb[(c0 * cp) & 127], tb[((c0 + 1) * cp) & 127], tb[((c0 + 2) * cp) & 127], tb[((c0 + 3) * cp) & 127]} * wv[u]; } }
        u32x2 o; o.x = cvt_pk_bf16(s[0], s[1]); o.y = cvt_pk_bf16(s[2], s[3]);
        *(u32x2*)(wcat + ((size_t)lg * 128 + d) * 256 + k4) = o; }
    __syncthreads();
}
#ifndef LN_NT
#define LN_NT 1
#endif
#if LN_NT
#define LN_LD(p) __builtin_nontemporal_load((const f32x4*)(p))
#define LN_ST(p, v) __builtin_nontemporal_store((v), (f32x4*)(p))
#else
#define LN_LD(p) (*(const f32x4*)(p))
#define LN_ST(p, v) (*(f32x4*)(p) = (v))
#endif
__device__ __forceinline__ void row_stats(const f32x4 (&v)[8], float& mean, float& rstd) {
    float s = 0.f;
#pragma unroll
    for (int i = 0; i < 8; ++i) s += (v[i][0] + v[i][1]) + (v[i][2] + v[i][3]);
    mean = wave_sum(s) * (1.0f / DM); float q = 0.f;
#pragma unroll
    for (int i = 0; i < 8; ++i) { const f32x4 d = v[i] - mean; q += (d[0] * d[0] + d[1] * d[1]) + (d[2] * d[2] + d[3] * d[3]); }
    rstd = rsqrtf(wave_sum(q) * (1.0f / DM) + NORM_EPS);
}
__device__ __forceinline__ void ln_rows(const Frame& F, int& r0, int& r1) { const int rpb = (((MTOK + F.G - 1) / F.G) + 7) & ~7; r0 = F.bx * rpb; r1 = r0 + rpb < MTOK ? r0 + rpb : MTOK; }
__device__ __forceinline__ void p_ln_first(const Frame& F, const int row0, const int row1, const int step) {
    const float* x = F.in[0]; const float* mod = WSP(float, WS_MOD); bf16_t* H = WSP(bf16_t, WS_H);
    for (int seg0 = row0; seg0 < row1; ) {
        const int cb = seg0 >> 12, segend = ((cb + 1) << 12) < row1 ? ((cb + 1) << 12) : row1;
        f32x4 v[8], vn[8], shv[8], scv[8];
        { const float* mp = mod + (size_t)cb * (3 * DM) + F.lane * 4;
#pragma unroll
          for (int i = 0; i < 8; ++i) { shv[i] = *(const f32x4*)(mp + i * 256); scv[i] = *(const f32x4*)(mp + DM + i * 256) + 1.0f; } }
        int row = seg0 + F.wave;
        if (row < segend) { const float* xr = x + (size_t)row * DM + F.lane * 4;
#pragma unroll
            for (int i = 0; i < 8; ++i) vn[i] = LN_LD(xr + i * 256); }
        for (; row < segend; row += step) {
#pragma unroll
            for (int i = 0; i < 8; ++i) v[i] = vn[i];
            if (row + step < segend) { const float* xr = x + (size_t)(row + step) * DM + F.lane * 4;
#pragma unroll
                for (int i = 0; i < 8; ++i) vn[i] = LN_LD(xr + i * 256); }
            float mean, rstd; row_stats(v, mean, rstd);
#pragma unroll
            for (int i = 0; i < 8; ++i) store4_bf16(H + (size_t)row * DM + F.lane * 4 + i * 256, (v[i] - mean) * rstd * scv[i] + shv[i]);
        }
        seg0 = segend;
    }
}
#ifndef LN_DROP_R
#define LN_DROP_R (PROBE_CHECK ? 0 : 1)
#endif
template <bool NEXT> __device__ __forceinline__ void p_ln_post(const Frame& F, int l, const int row0, const int row1, const int step) {
    constexpr bool DROPR = LN_DROP_R && NEXT;
    const float* xs = l == 0 ? F.in[0] : WSP(float, WS_R); float* dst = NEXT ? WSP(float, WS_R) : F.out; const float* g = F.in[12] + l * DM; const float* bb = F.in[13] + l * DM;
    const float* mod = WSP(float, WS_MOD) + (size_t)(l + 1) * NB * (3 * DM); bf16_t* H = WSP(bf16_t, WS_H); const bf16_t* GYs = DROPR ? WSP(bf16_t, WS_R) : WSP(bf16_t, WS_H);
    f32x4 gv[8], bv[8];
#pragma unroll
    for (int i = 0; i < 8; ++i) { gv[i] = *(const f32x4*)(g + F.lane * 4 + i * 256); bv[i] = *(const f32x4*)(bb + F.lane * 4 + i * 256); }
    for (int seg0 = row0; seg0 < row1; ) {
        const int cb = seg0 >> 12, segend = ((cb + 1) << 12) < row1 ? ((cb + 1) << 12) : row1;
        f32x4 v[8], vn[8], shv[8], scv[8]; u32x2 gyn[8];
        if (NEXT) { const float* mp = mod + (size_t)cb * (3 * DM) + F.lane * 4;
#pragma unroll
            for (int i = 0; i < 8; ++i) { shv[i] = *(const f32x4*)(mp + i * 256); scv[i] = *(const f32x4*)(mp + DM + i * 256) + 1.0f; } }
        int row = seg0 + F.wave;
        if (row < segend) { const float* xr = xs + (size_t)row * DM + F.lane * 4; const bf16_t* gr = GYs + (size_t)row * DM + F.lane * 4;
#pragma unroll
            for (int i = 0; i < 8; ++i) { vn[i] = LN_LD(xr + i * 256); gyn[i] = DROPR ? *(const u32x2*)(gr + i * 256) : __builtin_nontemporal_load((const u32x2*)(gr + i * 256)); } }
        for (; row < segend; row += step) {
#pragma unroll
            for (int i = 0; i < 8; ++i) { const u32x2 q = gyn[i];
                v[i] = vn[i] * DN_ALPHA + (f32x4){__uint_as_float(q.x << 16), __uint_as_float(q.x & 0xffff0000u), __uint_as_float(q.y << 16), __uint_as_float(q.y & 0xffff0000u)}; }
            if (row + step < segend) { const float* xr = xs + (size_t)(row + step) * DM + F.lane * 4; const bf16_t* gr = GYs + (size_t)(row + step) * DM + F.lane * 4;
#pragma unroll
                for (int i = 0; i < 8; ++i) { vn[i] = LN_LD(xr + i * 256); gyn[i] = DROPR ? *(const u32x2*)(gr + i * 256) : __builtin_nontemporal_load((const u32x2*)(gr + i * 256)); } }
            float mean, rstd; row_stats(v, mean, rstd);
#pragma unroll
            for (int i = 0; i < 8; ++i) { v[i] = (v[i] - mean) * rstd * gv[i] + bv[i];
                if (!DROPR) LN_ST(dst + (size_t)row * DM + F.lane * 4 + i * 256, v[i]); }
            if (NEXT) { row_stats(v, mean, rstd);
#pragma unroll
                for (int i = 0; i < 8; ++i) store4_bf16(H + (size_t)row * DM + F.lane * 4 + i * 256, (v[i] - mean) * rstd * scv[i] + shv[i]); }
        }
        seg0 = segend;
    }
}
__device__ __forceinline__ void p_ln_last(const Frame& F, const int row0, const int row1, const int step) {
    static_assert(DEPTH == 2, "p_ln_last rebuilds exactly one earlier layer");
    const float* xs = F.in[0]; float* dst = F.out; const bf16_t* GY0 = WSP(bf16_t, WS_R); const bf16_t* GY1 = WSP(bf16_t, WS_H);
    LAS float* pl = (LAS float*)F.lds;
    *(LAS f32x4*)(pl + F.tid * 4) = *(const f32x4*)(F.in[12] + F.tid * 4); *(LAS f32x4*)(pl + DM + F.tid * 4) = *(const f32x4*)(F.in[13] + F.tid * 4);
    *(LAS f32x4*)(pl + 2 * DM + F.tid * 4) = *(const f32x4*)(F.in[12] + DM + F.tid * 4); *(LAS f32x4*)(pl + 3 * DM + F.tid * 4) = *(const f32x4*)(F.in[13] + DM + F.tid * 4);
    __syncthreads();
    f32x4 v[8], vn[8]; u32x2 g0n[8], g1n[8], g1c[8];
    int row = row0 + F.wave;
#define LNL_LOAD(R) do { const float* xr = xs + (size_t)(R) * DM + F.lane * 4; const bf16_t* p0 = GY0 + (size_t)(R) * DM + F.lane * 4; const bf16_t* p1 = GY1 + (size_t)(R) * DM + F.lane * 4; \
        _Pragma("unroll") for (int i = 0; i < 8; ++i) { vn[i] = LN_LD(xr + i * 256); g0n[i] = __builtin_nontemporal_load((const u32x2*)(p0 + i * 256)); g1n[i] = __builtin_nontemporal_load((const u32x2*)(p1 + i * 256)); } } while (0)
#define LNL_UNPK(q) ((f32x4){__uint_as_float((q).x << 16), __uint_as_float((q).x & 0xffff0000u), __uint_as_float((q).y << 16), __uint_as_float((q).y & 0xffff0000u)})
    if (row < row1) LNL_LOAD(row);
    for (; row < row1; row += step) {
        asm volatile("" ::: "memory");
#pragma unroll
        for (int i = 0; i < 8; ++i) { v[i] = vn[i] * DN_ALPHA + LNL_UNPK(g0n[i]); g1c[i] = g1n[i]; }
        if (row + step < row1) LNL_LOAD(row + step);
        float mean, rstd; row_stats(v, mean, rstd);
#pragma unroll
        for (int i = 0; i < 8; ++i) { const f32x4 g0 = *(const LAS f32x4*)(pl + F.lane * 4 + i * 256), b0 = *(const LAS f32x4*)(pl + DM + F.lane * 4 + i * 256);
            v[i] = ((v[i] - mean) * rstd * g0 + b0) * DN_ALPHA + LNL_UNPK(g1c[i]); }
        row_stats(v, mean, rstd);
#pragma unroll
        for (int i = 0; i < 8; ++i) { const f32x4 g1 = *(const LAS f32x4*)(pl + 2 * DM + F.lane * 4 + i * 256), b1 = *(const LAS f32x4*)(pl + 3 * DM + F.lane * 4 + i * 256);
            LN_ST(dst + (size_t)row * DM + F.lane * 4 + i * 256, (v[i] - mean) * rstd * g1 + b1); }
    }
#undef LNL_LOAD
#undef LNL_UNPK
}
__device__ __forceinline__ void fft1_naive(const Frame& F) {
    const bf16_t* U = WSP(bf16_t, WS_U); const bf16_t* D1 = WSP(bf16_t, WS_D1); bf16_t* Z = WSP(bf16_t, WS_H);
    const int gid = F.bx * NTHREADS + F.tid, NT = F.G * NTHREADS;
    for (int idx = gid; idx < NB * 64 * NG * 64 * 128; idx += NT) {
        const int c = idx & 127, s2 = (idx >> 7) & 63, g = (idx >> 13) & 7, s1p = (idx >> 16) & 63, b = idx >> 22;
        float yr = 0.f, yi = 0.f;
        for (int s1 = 0; s1 < 64; ++s1) { const float u = bf2f(U[(size_t)(b * SEQ + 64 * s1 + s2) * DF + g * 128 + c]); yr += bf2f(D1[s1p * 64 + s1]) * u; yi += bf2f(D1[(64 + s1p) * 64 + s1]) * u; }
        float st, ct; sincospif((float)(s2 * s1p) * (1.0f / 2048.0f), &st, &ct);
        const size_t zo = ((((size_t)(b * 64 + s1p) * NG + g) * 2) * 64 + s2) * 128 + c;
        Z[zo] = f2bf(yr * ct + yi * st); Z[zo + 64 * 128] = f2bf(yi * ct - yr * st);
    }
}
__device__ __forceinline__ void fft2_naive(const Frame& F, int l) {
    const bf16_t* Z = WSP(bf16_t, WS_H); const bf16_t* D2 = WSP(bf16_t, WS_D2); const bf16_t* wcat = WSP(bf16_t, WS_WCAT) + (size_t)l * NG * 128 * 256; bf16_t* MIX = WSP(bf16_t, WS_MIX);
    LAS float* Xs = (LAS float*)F.lds;
    for (int it = F.bx; it < NB * 64 * NG; it += F.G) {
        const int g = it & 7, s1p = (it >> 3) & 63, b = it >> 9;
        const bf16_t* Zb = Z + ((size_t)(b * 64 + s1p) * NG + g) * 2 * 64 * 128;
        for (int i = 0; i < 32; ++i) { const int o = F.tid + 512 * i, c = o & 127, rr = o >> 7; float s = 0.f;
            for (int k = 0; k < 128; ++k) s += bf2f(D2[rr * 128 + k]) * bf2f(Zb[k * 128 + c]);
            Xs[rr * 128 + c] = bf2f(f2bf(s)); }
        __syncthreads();
        for (int i = 0; i < 16; ++i) { const int o = F.tid + 512 * i, d = o & 127, s2p = o >> 7; float s = 0.f;
            const bf16_t* wr = wcat + (size_t)(g * 128 + d) * 256;
            for (int k = 0; k < 256; ++k) s += Xs[((k >> 7) * 64 + s2p) * 128 + (k & 127)] * bf2f(wr[k]);
            const size_t mo = (size_t)(b * SEQ + s1p + 64 * s2p) * DM + g * 128 + d;
            MIX[mo] = f2bf(s * (GATE_IN_EPI ? bf2f(MIX[mo]) : silu_f(bf2f(MIX[mo])))); }
        __syncthreads();
    }
}
__device__ __forceinline__ void attn_naive(const Frame& F) {
    const bf16_t* Q = WSP(bf16_t, WS_Q); const bf16_t* KV = WSP(bf16_t, WS_KV); const bf16_t* KR = WSP(bf16_t, WS_KR); bf16_t* MIX = WSP(bf16_t, WS_MIX);
    LAS float* qs = (LAS float*)F.lds + F.wave * 192;
    for (int it = F.bx * 8 + F.wave; it < MTOK * NH * 2; it += F.G * 8) {
        const int dh = it & 1, h = (it >> 1) & 7, tok = it >> 4, b = tok >> 12;
        __builtin_amdgcn_wave_barrier(); asm volatile("" ::: "memory");
        for (int e = 0; e < 3; ++e) qs[F.lane + 64 * e] = bf2f(Q[(size_t)tok * NQ + h * DQK + F.lane + 64 * e]);
        asm volatile("s_waitcnt lgkmcnt(0)" ::: "memory"); __builtin_amdgcn_wave_barrier();
        float m = -1e30f, lsum = 0.f; float o[64];
#pragma unroll
        for (int d = 0; d < 64; ++d) o[d] = 0.f;
        for (int t = 0; t < 64; ++t) {
            const size_t key = (size_t)b * SEQ + F.lane + 64 * t; const bf16_t* kn = KV + key * NKV + h * 256; const bf16_t* kr = KR + key * 64;
            float s = 0.f;
#pragma unroll 2
            for (int c = 0; c < 16; ++c) { const bf16x8 kv = *(const bf16x8*)(kn + c * 8);
#pragma unroll
                for (int e = 0; e < 8; ++e) s += qs[c * 8 + e] * bf2f((bf16_t)kv[e]); }
#pragma unroll 2
            for (int c = 0; c < 8; ++c) { const bf16x8 kv = *(const bf16x8*)(kr + c * 8);
#pragma unroll
                for (int e = 0; e < 8; ++e) s += qs[128 + c * 8 + e] * bf2f((bf16_t)kv[e]); }
            s *= ATT_SCALE; const float mn = fmaxf(m, s), a = __expf(m - mn), p = __expf(s - mn); lsum = lsum * a + p; m = mn;
#pragma unroll
            for (int c = 0; c < 8; ++c) { const bf16x8 vv = *(const bf16x8*)(kn + 128 + dh * 64 + c * 8);
#pragma unroll
                for (int e = 0; e < 8; ++e) o[c * 8 + e] = o[c * 8 + e] * a + p * bf2f((bf16_t)vv[e]); }
        }
        const float Mx = wave_max(m), f = __expf(m - Mx); const float L = wave_sum(lsum * f);
        float keep0 = 0.f;
#pragma unroll
        for (int d = 0; d < 64; ++d) { const float od = wave_sum(o[d] * f); if (F.lane == d) keep0 = od; }
        const size_t mo = (size_t)tok * DM + DF + h * 128 + dh * 64 + F.lane;
        MIX[mo] = f2bf(keep0 / L * (GATE_IN_EPI ? bf2f(MIX[mo]) : silu_f(bf2f(MIX[mo]))));
    }
}
namespace att {
constexpr int NW = 8, QBLK = 32, KVBLK = 64;
#ifndef ATT_STAG
#define ATT_STAG 0
#endif
#ifndef ATT_HYB
#define ATT_HYB 0
#endif
#ifndef ATT_S16
#define ATT_S16 0
#endif
#ifndef ATT_DMA
#define ATT_DMA 0
#endif
#ifndef ATT_SHAPE16
#define ATT_SHAPE16 0
#endif
#ifndef ATT_STAMP
#define ATT_STAMP -1
#endif
#ifndef ATT_KVFIRST
#define ATT_KVFIRST 0
#endif
#ifndef ATT_SPRIO
#define ATT_SPRIO 0
#endif
#ifndef ATT_PRIO
#define ATT_PRIO 0
#endif
#ifndef ATT_QSB2
#define ATT_QSB2 1
#endif
#ifndef ATT_SDEPTH
#define ATT_SDEPTH 1
#endif
constexpr int SDEPTH = ATT_SDEPTH;
constexpr float THR = 8.f;
constexpr int SHM_V = KVBLK * 128 * 2, SHM_KN = KVBLK * 128 * 2, SHM_KR = KVBLK * 64 * 2;
#ifndef ATT_QLDS
#define ATT_QLDS 6
#endif
constexpr int QLDS = ATT_QLDS, QREG = 12 - QLDS;
constexpr int OFF_V = 0, OFF_KN = 2 * SHM_V, OFF_KR = OFF_KN + 2 * SHM_KN, OFF_WS = OFF_KR + 2 * SHM_KR, OFF_QL = OFF_WS + NW * 64 * 4, OFF_OT = 0, OT_PITCH = 272, SHM_ATTN = OFF_QL + NW * QLDS * 1024;
static_assert(NW * 32 * OT_PITCH <= OFF_WS, "O tiles reuse the K/V buffers");
static_assert(SHM_ATTN <= RING_BYTES, "attention LDS must fit the phase scratch");
#define KSWZ(row, colB) ((row) * 256 + ((colB) ^ (((row) & 15) << 4)))
#define RSWZ(row, ch) ((row) * 128 + ((((ch) ^ (((row) >> 1) & 7))) << 4))
#define SBAR() __builtin_amdgcn_sched_barrier(0)
__device__ __forceinline__ int crow(int r, int hi) { return (r & 3) + 8 * (r >> 2) + 4 * hi; }
__device__ __forceinline__ unsigned cvtpk(float lo, float hi) { unsigned r; asm volatile("v_cvt_pk_bf16_f32 %0, %1, %2" : "=v"(r) : "v"(lo), "v"(hi)); return r; }
__device__ __forceinline__ bf16x8 ld8(const bf16_t* p) { return *reinterpret_cast<const bf16x8*>(p); }


template <bool S16> __device__ __forceinline__ f32x16 mfma_sel(bf16x8 a, bf16x8 b, f32x16 c) {
  if constexpr (S16) {
  f32x4 c0 = {c[0], c[1], c[2], c[3]}, c1 = {c[4], c[5], c[6], c[7]};
  c0 = __builtin_amdgcn_mfma_f32_16x16x32_bf16(a, b, c0, 0, 0, 0); c1 = __builtin_amdgcn_mfma_f32_16x16x32_bf16(a, b, c1, 0, 0, 0);
  c[0] = c0[0]; c[1] = c0[1]; c[2] = c0[2]; c[3] = c0[3]; c[4] = c1[0]; c[5] = c1[1]; c[6] = c1[2]; c[7] = c1[3]; return c;
  } else return __builtin_amdgcn_mfma_f32_32x32x16_bf16(a, b, c, 0, 0, 0);
}
__device__ __forceinline__ void partialSM(f32x16& p0, f32x16& p1, float& m_reg, float& mn, float& alpha) {
#if defined(PROBE_NEG) && PROBE_NEG == 2
  constexpr float C = ATT_SCALE * 1.4426950408889634f * 1.3f;
#else
  constexpr float C = ATT_SCALE * 1.4426950408889634f;
#endif
  float pmax = p0[0]; for (int r = 1; r < 16; ++r) pmax = fmaxf(pmax, p0[r]); for (int r = 0; r < 16; ++r) pmax = fmaxf(pmax, p1[r]);
  { auto rr = __builtin_amdgcn_permlane32_swap(__float_as_uint(pmax), __float_as_uint(pmax), false, false);
    pmax = fmaxf(__uint_as_float(rr[0]), __uint_as_float(rr[1])); }
  if (__builtin_expect(__all(pmax - m_reg <= THR / ATT_SCALE), 1)) { mn = m_reg; alpha = 1.f; }
  else { mn = fmaxf(m_reg, pmax); alpha = __builtin_amdgcn_exp2f((m_reg - mn) * C); m_reg = mn; }
  float mnC = -mn * C;
  for (int r = 0; r < 16; ++r) p0[r] = fmaf(p0[r], C, mnC); for (int r = 0; r < 16; ++r) p1[r] = fmaf(p1[r], C, mnC);
  for (int r = 0; r < 16; ++r) p0[r] = __builtin_amdgcn_exp2f(p0[r]);
}
__device__ __forceinline__ void finishSM(f32x16& p0, f32x16& p1, float alpha, float& l_reg, bf16x8& pa0, bf16x8& pa1, bf16x8& pa2, bf16x8& pa3) {
  for (int r = 0; r < 16; ++r) p1[r] = __builtin_amdgcn_exp2f(p1[r]);
  float ps = 0; for (int r = 0; r < 16; ++r) ps += p0[r]; for (int r = 0; r < 16; ++r) ps += p1[r];
  { auto rr = __builtin_amdgcn_permlane32_swap(__float_as_uint(ps), __float_as_uint(ps), false, false);
    ps = __uint_as_float(rr[0]) + __uint_as_float(rr[1]); }
  l_reg = l_reg * alpha + ps;
#define PK4(P, BASE, OUT) do { unsigned a0 = cvtpk(P[BASE + 0], P[BASE + 1]), a1 = cvtpk(P[BASE + 2], P[BASE + 3]);   \
    unsigned b0 = cvtpk(P[BASE + 4], P[BASE + 5]), b1 = cvtpk(P[BASE + 6], P[BASE + 7]);                              \
    auto r0 = __builtin_amdgcn_permlane32_swap(a0, b0, false, false); auto r1 = __builtin_amdgcn_permlane32_swap(a1, b1, false, false); \
    u32x4 w = {r0[0], r1[0], r0[1], r1[1]}; OUT = *reinterpret_cast<bf16x8*>(&w); } while (0)
  PK4(p0, 0, pa0); PK4(p0, 8, pa1); PK4(p1, 0, pa2); PK4(p1, 8, pa3);
#undef PK4
}
template <int QR> __device__ __forceinline__ bf16x8 qfrag(const char* ql, int d0) { return *reinterpret_cast<const bf16x8*>(ql + (d0 - QR) * 1024); }
__device__ __forceinline__ void kfrag(bf16x8& a, bf16x8& b, const char* Kn, const char* Kr, int d0, int r32, int hi) {
  if (d0 < 8) { const int cb = (d0 * 16 + hi * 8) * 2; a = *reinterpret_cast<const bf16x8*>(Kn + KSWZ(r32, cb)); b = *reinterpret_cast<const bf16x8*>(Kn + KSWZ(32 + r32, cb)); }
  else { const int ch = (d0 - 8) * 2 + hi; a = *reinterpret_cast<const bf16x8*>(Kr + RSWZ(r32, ch)); b = *reinterpret_cast<const bf16x8*>(Kr + RSWZ(32 + r32, ch)); }
}
template <int QR, bool S16 = false> __device__ __forceinline__ void qkt(f32x16& p0, f32x16& p1, const char* Kn, const char* Kr, const bf16x8* qr, const char* ql, int r32, int hi) {
  p0 = f32x16{}; p1 = f32x16{};
  bf16x8 ka, kb, na, nb, qc, qn;
  kfrag(ka, kb, Kn, Kr, 0, r32, hi); if (0 >= QR) qc = qfrag<QR>(ql, 0);
#pragma unroll
  for (int d0 = 0; d0 < 12; ++d0) {
    if (d0 + 1 < 12) { kfrag(na, nb, Kn, Kr, d0 + 1, r32, hi); if (d0 + 1 >= QR) qn = qfrag<QR>(ql, d0 + 1); }
    SBAR();
    const bf16x8 q = d0 < QR ? qr[d0 < QR ? d0 : 0] : qc;
    if (ATT_PRIO) __builtin_amdgcn_s_setprio(1);
    p0 = mfma_sel<S16>(ka, q, p0);
    p1 = mfma_sel<S16>(kb, q, p1);
    if (ATT_PRIO) __builtin_amdgcn_s_setprio(0);
    if (ATT_QSB2) SBAR();
    ka = na; kb = nb; qc = qn;
  }
}
__device__ __forceinline__ int v_st(int k, int c) { const int kk = (k & ~0xC) | ((k & 4) << 1) | ((k & 8) >> 1); return ((kk >> 3) * 4 + (c >> 5)) * 512 + ((kk & 7) * 32 + (c & 31)) * 2; }
__device__ __forceinline__ int v_rd_base(int lane) { return ((lane & 3) << 3) | (((lane >> 2) & 3) << 6) | (((lane >> 4) & 1) << 5) | (((lane >> 5) & 1) << 8); }
constexpr int v_rd_off(int d0, int ks, int half) { return d0 * 512 + ks * 4096 + half * 2048; }
template <int OFF> __device__ __forceinline__ s16x4 tr_read(int vb) {
  s16x4 r; asm volatile("ds_read_b64_tr_b16 %0, %1 offset:%2" : "=&v"(r) : "v"(vb), "i"(OFF) : "memory"); return r;
}
#define TRPK(L, H) (bf16x8){L[0], L[1], L[2], L[3], H[0], H[1], H[2], H[3]}
template <int D0, bool S16 = false> __device__ __forceinline__ void pv_one(f32x16& od, int vb, bf16x8 pa0, bf16x8 pa1, bf16x8 pa2, bf16x8 pa3) {
  const s16x4 l0 = tr_read<v_rd_off(D0, 0, 0)>(vb), h0 = tr_read<v_rd_off(D0, 0, 1)>(vb), l1 = tr_read<v_rd_off(D0, 1, 0)>(vb), h1 = tr_read<v_rd_off(D0, 1, 1)>(vb);
  const s16x4 l2 = tr_read<v_rd_off(D0, 2, 0)>(vb), h2 = tr_read<v_rd_off(D0, 2, 1)>(vb), l3 = tr_read<v_rd_off(D0, 3, 0)>(vb), h3 = tr_read<v_rd_off(D0, 3, 1)>(vb);
  asm volatile("s_waitcnt lgkmcnt(0)" ::: "memory"); SBAR();
  if (ATT_PRIO) __builtin_amdgcn_s_setprio(1);
  od = mfma_sel<S16>(pa0, TRPK(l0, h0), od);
  od = mfma_sel<S16>(pa1, TRPK(l1, h1), od);
  od = mfma_sel<S16>(pa2, TRPK(l2, h2), od);
  od = mfma_sel<S16>(pa3, TRPK(l3, h3), od);
  if (ATT_PRIO) __builtin_amdgcn_s_setprio(0);
}
template <bool S16 = false> __device__ __forceinline__ void pv_d0(f32x16* o, int vb, bf16x8 pa0, bf16x8 pa1, bf16x8 pa2, bf16x8 pa3) {
  pv_one<0, S16>(o[0], vb, pa0, pa1, pa2, pa3); pv_one<1, S16>(o[1], vb, pa0, pa1, pa2, pa3); pv_one<2, S16>(o[2], vb, pa0, pa1, pa2, pa3); pv_one<3, S16>(o[3], vb, pa0, pa1, pa2, pa3);
}

template <int VAR>
__device__ __forceinline__ void attn_body(const bf16_t* __restrict__ Qb, const bf16_t* __restrict__ Kn, const bf16_t* __restrict__ Kr,
                                          bf16_t* __restrict__ Gm, int seq, char* lds, int tid) {
  const int wid = tid >> 6, lane = tid & 63, r32 = lane & 31, hi = lane >> 5;
  char* V_lds = lds + OFF_V; char* K_lds = lds + OFF_KN; char* R_lds = lds + OFF_KR;
  float* ws = (float*)(lds + OFF_WS) + wid * 64; float* li_l = ws; float* al_l = ws + 32;
  float m_reg = -1e30f, l_reg = 0; f32x16 o[4] = {}; bf16x8 qr[QREG > 0 ? QREG : 1];
  char* ql = lds + OFF_QL + wid * (QLDS * 1024) + lane * 16;
  const unsigned qoff = (unsigned)((wid * QBLK + r32) * NQ + hi * 8) * 2u;
#if !ATT_KVFIRST
#pragma unroll
  for (int d0 = 0; d0 < 12; ++d0) { const bf16x8 qv = *(const bf16x8*)((const char*)Qb + qoff + d0 * 32); if (d0 < QREG) qr[d0 < QREG ? d0 : 0] = qv; else *reinterpret_cast<bf16x8*>(ql + (d0 - QREG) * 1024) = qv; }
#endif
  const int sr = tid >> 4, sc = (tid & 15) * 8, vst0 = v_st(sr, sc), vst1 = v_st(32 + sr, sc);
  const int rr_ = tid >> 3, rc_ = tid & 7;
  const int vb0 = (int)(uintptr_t)V_lds + v_rd_base(lane);
  struct { bf16x8 vs0, vs1, ks0, ks1, kr; } sr_[SDEPTH];
  const unsigned voff = (unsigned)(sr * NKV + sc) * 2u, voffr = (unsigned)(rr_ * 64 + rc_ * 8) * 2u;
#define SLOAD(i, k0) do { const char* kb_ = (const char*)(Kn + (long)(k0) * NKV); const char* rb_ = (const char*)(Kr + (long)(k0) * 64); \
    sr_[i].vs0 = *(const bf16x8*)(kb_ + 256 + voff); sr_[i].vs1 = *(const bf16x8*)(kb_ + (32 * NKV * 2 + 256) + voff); \
    sr_[i].ks0 = *(const bf16x8*)(kb_ + voff); sr_[i].ks1 = *(const bf16x8*)(kb_ + 32 * NKV * 2 + voff); \
    sr_[i].kr = *(const bf16x8*)(rb_ + voffr); } while (0)
#define SWRITE(b, i) do { *(bf16x8*)(V_lds + (b) * SHM_V + vst0) = sr_[i].vs0;          \
    *(bf16x8*)(V_lds + (b) * SHM_V + vst1) = sr_[i].vs1; int kc = sc * 2;               \
    *(bf16x8*)(K_lds + (b) * SHM_KN + KSWZ(sr, kc)) = sr_[i].ks0;                       \
    *(bf16x8*)(K_lds + (b) * SHM_KN + KSWZ(32 + sr, kc)) = sr_[i].ks1;                  \
    *(bf16x8*)(R_lds + (b) * SHM_KR + RSWZ(rr_, rc_)) = sr_[i].kr; } while (0)
#define SLOADV(i, k0) do { if constexpr (VAR != 4) SLOAD(i, k0); } while (0)
#define SWRITEV(b, i) do { if constexpr (VAR != 4) SWRITE(b, i); } while (0)
#define SWAIT() do { if constexpr (SDEPTH == 2) asm volatile("s_waitcnt vmcnt(5)" ::: "memory"); else asm volatile("s_waitcnt vmcnt(0)" ::: "memory"); } while (0)
#define RESC(a) do { if (__any((a) < 1.f)) { if (hi == 0) al_l[r32] = (a); asm volatile("s_waitcnt lgkmcnt(0)" ::: "memory"); \
    for (int d = 0; d < 4; ++d) for (int r = 0; r < 16; ++r) o[d][r] *= al_l[crow(r, hi)]; } } while (0)
  f32x16 pA0, pA1, pB0, pB1; float mnA, mnB, alA, alB; bf16x8 pa0, pa1, pa2, pa3; const int NT = seq / KVBLK;
#define QKT(P0, P1, KN, KR) do { if constexpr (VAR == 3) { P0 = o[0]; P1 = o[1]; } else qkt<QREG, VAR == 6>(P0, P1, KN, KR, qr, ql, r32, hi); } while (0)
#define PSM(P0, P1, MN, AL) do { if constexpr (VAR == 1) { MN = m_reg; AL = 1.f; } else partialSM(P0, P1, m_reg, MN, AL); } while (0)
#define FSM(P0, P1, AL) do { if constexpr (VAR == 1) { pa0 = __builtin_bit_cast(bf16x8, (f32x4){P0[0], P0[1], P0[2], P0[3]}); pa1 = __builtin_bit_cast(bf16x8, (f32x4){P0[4], P0[5], P0[6], P0[7]}); \
      pa2 = __builtin_bit_cast(bf16x8, (f32x4){P1[0], P1[1], P1[2], P1[3]}); pa3 = __builtin_bit_cast(bf16x8, (f32x4){P1[4], P1[5], P1[6], P1[7]}); l_reg += P0[8] + P1[9]; } \
    else finishSM(P0, P1, AL, l_reg, pa0, pa1, pa2, pa3); } while (0)
#define PVD(VB) do { if constexpr (VAR == 2) { o[0][0] += __builtin_bit_cast(f32x4, pa0)[0]; o[1][1] += __builtin_bit_cast(f32x4, pa1)[1]; o[2][2] += __builtin_bit_cast(f32x4, pa2)[2]; o[3][3] += __builtin_bit_cast(f32x4, pa3)[3]; } else pv_d0<VAR == 6 || VAR == 8>(o, VB, pa0, pa1, pa2, pa3); } while (0)
#define SYNC() do { if constexpr (VAR != 5) __syncthreads(); } while (0)
  constexpr int SE = 0, SO = SDEPTH - 1;
  SLOAD(SE, 0);
#if ATT_KVFIRST
#pragma unroll
  for (int d0 = 0; d0 < 12; ++d0) { const bf16x8 qv = *(const bf16x8*)((const char*)Qb + qoff + d0 * 32); if (d0 < QREG) qr[d0 < QREG ? d0 : 0] = qv; else *reinterpret_cast<bf16x8*>(ql + (d0 - QREG) * 1024) = qv; }
#endif
  asm volatile("s_waitcnt vmcnt(0)" ::: "memory"); SWRITE(0, SE); SYNC();
  QKT(pA0, pA1, K_lds, R_lds); PSM(pA0, pA1, mnA, alA);
  SLOAD(SO, KVBLK); if constexpr (SDEPTH == 2) { if (2 < NT) SLOAD(SE, 2 * KVBLK); }
  SWAIT(); SWRITE(1, SO); SYNC();
#if ATT_STAMP >= 0
  unsigned long long tk_ = 0, sg_[5] = {0, 0, 0, 0, 0};
#define STMP(k) do { SBAR(); const unsigned long long tn_ = __builtin_amdgcn_s_memtime(); SBAR(); if ((k) >= 0) sg_[(k) < 0 ? 0 : (k)] += tn_ - tk_; tk_ = tn_; } while (0)
#else
#define STMP(k) do { } while (0)
#endif
  STMP(-1);
  if (ATT_SPRIO && wid >= 4) __builtin_amdgcn_s_setprio(1);
  for (int j = 1; j + 1 < NT; j += 2) {
    SBAR(); QKT(pB0, pB1, K_lds + SHM_KN, R_lds + SHM_KR);
    FSM(pA0, pA1, alA); SBAR(); STMP(0);
    SLOADV(SO, (j + SDEPTH) * KVBLK); SBAR();
    PVD(vb0); PSM(pB0, pB1, mnB, alB); STMP(1);
    SYNC(); STMP(2); SWAIT(); SWRITEV(0, SE);
    RESC(alB); STMP(3); SYNC(); STMP(4);
    SBAR(); QKT(pA0, pA1, K_lds, R_lds);
    FSM(pB0, pB1, alB); SBAR(); STMP(0);
    if (SDEPTH == 1 || j + 3 < NT) SLOADV(SE, (j + 1 + SDEPTH) * KVBLK); SBAR();
    PVD(vb0 + (int)SHM_V); PSM(pA0, pA1, mnA, alA); STMP(1);
    SYNC(); STMP(2); SWAIT(); SWRITEV(1, SO);
    RESC(alA); STMP(3); SYNC(); STMP(4);
  }
#if ATT_STAMP >= 0
  if (tid == 0) { volatile unsigned* mw = (volatile unsigned*)(lds + RING_BYTES) + 16; for (int k_ = 0; k_ < 5; ++k_) mw[k_] += (unsigned)(sg_[k_] >> 4); }
#endif
#undef STMP
  SBAR(); QKT(pB0, pB1, K_lds + SHM_KN, R_lds + SHM_KR);
  FSM(pA0, pA1, alA); SBAR();
  PVD(vb0); PSM(pB0, pB1, mnB, alB);
  SYNC(); RESC(alB);
  FSM(pB0, pB1, alB); SBAR();
  PVD(vb0 + (int)SHM_V);
  if (ATT_SPRIO) __builtin_amdgcn_s_setprio(0);
  SBAR(); asm volatile("" ::: "memory");
  u32x4 gt[8]; const int grow = lane >> 4, gc16 = lane & 15;
  bf16_t* Gw = Gm + (size_t)(wid * QBLK + grow) * DM + gc16 * 8;
#pragma unroll
  for (int i = 0; i < 8; ++i) gt[i] = __builtin_nontemporal_load((const u32x4*)(Gw + (size_t)(4 * i) * DM));
  if (hi == 0) li_l[r32] = l_reg;
  __syncthreads();
  char* ot = lds + OFF_OT + wid * (32 * OT_PITCH);
#pragma unroll
  for (int r = 0; r < 16; ++r) { const float rl = __builtin_amdgcn_rcpf(li_l[crow(r, hi)]); char* orow = ot + crow(r, hi) * OT_PITCH + r32 * 2;
#pragma unroll
    for (int d0 = 0; d0 < 4; ++d0) *(bf16_t*)(orow + d0 * 64) = f2bf(o[d0][r] * rl); }
  asm volatile("s_waitcnt lgkmcnt(0)" ::: "memory");
#pragma unroll
  for (int i = 0; i < 8; ++i) { const u32x4 ov = *(const u32x4*)(ot + (grow + 4 * i) * OT_PITCH + gc16 * 16); const u32x4 gv = gt[i]; u32x4 w;
#pragma unroll
    for (int e = 0; e < 4; ++e) { const float g0_ = __uint_as_float(gv[e] << 16), g1_ = __uint_as_float(gv[e] & 0xffff0000u); const float a0 = __uint_as_float(ov[e] << 16) * (GATE_IN_EPI ? g0_ : silu_f(g0_)), a1 = __uint_as_float(ov[e] & 0xffff0000u) * (GATE_IN_EPI ? g1_ : silu_f(g1_)); w[e] = cvt_pk_bf16(a0, a1); }
    *(u32x4*)(Gw + (size_t)(4 * i) * DM) = w; }
#undef SLOAD
#undef SLOADV
#undef SWRITEV
#undef QKT
#undef PSM
#undef FSM
#undef PVD
#undef SYNC
#undef SWRITE
#undef SWAIT
#undef RESC
}

#ifndef ATT_ONEBAR
#define ATT_ONEBAR 0
#endif
__device__ __forceinline__ void attn_body5(const bf16_t* __restrict__ Qb, const bf16_t* __restrict__ Kn, const bf16_t* __restrict__ Kr,
                                           bf16_t* __restrict__ Gm, int seq, char* lds, int tid) {
  const int wid = tid >> 6, lane = tid & 63, r32 = lane & 31, hi = lane >> 5;
  char* V_lds = lds + OFF_V; char* K_lds = lds + OFF_KN; char* R_lds = lds + OFF_KR;
  float* ws = (float*)(lds + OFF_WS) + wid * 64; float* li_l = ws; float* al_l = ws + 32;
  float m_reg = -1e30f, l_reg = 0; f32x16 o[4] = {}; bf16x8 qr[QREG > 0 ? QREG : 1];
  char* ql = lds + OFF_QL + wid * (QLDS * 1024) + lane * 16;
  const unsigned qoff = (unsigned)((wid * QBLK + r32) * NQ + hi * 8) * 2u;
#pragma unroll
  for (int d0 = 0; d0 < 12; ++d0) { const bf16x8 qv = *(const bf16x8*)((const char*)Qb + qoff + d0 * 32); if (d0 < QREG) qr[d0 < QREG ? d0 : 0] = qv; else *reinterpret_cast<bf16x8*>(ql + (d0 - QREG) * 1024) = qv; }
  const int sr = tid >> 4, sc = (tid & 15) * 8, vst0 = v_st(sr, sc), vst1 = v_st(32 + sr, sc);
  const int rr_ = tid >> 3, rc_ = tid & 7;
  const int vb0 = (int)(uintptr_t)V_lds + v_rd_base(lane);
  bf16x8 vs0, vs1, ks0, ks1, kr;
  const unsigned voff = (unsigned)(sr * NKV + sc) * 2u, voffr = (unsigned)(rr_ * 64 + rc_ * 8) * 2u;
  const int NT = seq / KVBLK;
#define TCL(t) ((t) < NT ? (t) : NT - 1)
#define KLOAD5(t) do { const long k0_ = (long)TCL(t) * KVBLK; const char* kb_ = (const char*)(Kn + k0_ * NKV); const char* rb_ = (const char*)(Kr + k0_ * 64); \
    ks0 = *(const bf16x8*)(kb_ + voff); ks1 = *(const bf16x8*)(kb_ + 32 * NKV * 2 + voff); kr = *(const bf16x8*)(rb_ + voffr); } while (0)
#define VLOAD5(t) do { const char* kb_ = (const char*)(Kn + (long)TCL(t) * KVBLK * NKV); vs0 = *(const bf16x8*)(kb_ + 256 + voff); vs1 = *(const bf16x8*)(kb_ + (32 * NKV * 2 + 256) + voff); } while (0)
#define KWRITE5(b) do { const int kc = sc * 2; *(bf16x8*)(K_lds + (b) * SHM_KN + KSWZ(sr, kc)) = ks0; *(bf16x8*)(K_lds + (b) * SHM_KN + KSWZ(32 + sr, kc)) = ks1; *(bf16x8*)(R_lds + (b) * SHM_KR + RSWZ(rr_, rc_)) = kr; } while (0)
#define VWRITE5(b) do { *(bf16x8*)(V_lds + (b) * SHM_V + vst0) = vs0; *(bf16x8*)(V_lds + (b) * SHM_V + vst1) = vs1; } while (0)
#define RESC5(a) do { if (__any((a) < 1.f)) { if (hi == 0) al_l[r32] = (a); asm volatile("s_waitcnt lgkmcnt(0)" ::: "memory"); \
    for (int d = 0; d < 4; ++d) for (int r = 0; r < 16; ++r) o[d][r] *= al_l[crow(r, hi)]; } } while (0)
  f32x16 pA0, pA1, pB0, pB1; float mnA, mnB, alA, alB; bf16x8 pa0, pa1, pa2, pa3;
  KLOAD5(0); VLOAD5(0); KWRITE5(0); VWRITE5(0); KLOAD5(1); SBAR(); KWRITE5(1); VLOAD5(1); SBAR();
  __syncthreads();
  qkt<QREG, false>(pA0, pA1, K_lds, R_lds, qr, ql, r32, hi); partialSM(pA0, pA1, m_reg, mnA, alA);
  for (int t = 0; t + 2 < NT; t += 2) {
    SBAR(); VWRITE5(1); KLOAD5(t + 2); SBAR();
    qkt<QREG, false>(pB0, pB1, K_lds + SHM_KN, R_lds + SHM_KR, qr, ql, r32, hi);
    finishSM(pA0, pA1, alA, l_reg, pa0, pa1, pa2, pa3); SBAR();
    KWRITE5(0); VLOAD5(t + 2); SBAR();
    pv_d0<false>(o, vb0, pa0, pa1, pa2, pa3); partialSM(pB0, pB1, m_reg, mnB, alB);
    RESC5(alB);
    __syncthreads();
    SBAR(); VWRITE5(0); KLOAD5(t + 3); SBAR();
    qkt<QREG, false>(pA0, pA1, K_lds, R_lds, qr, ql, r32, hi);
    finishSM(pB0, pB1, alB, l_reg, pa0, pa1, pa2, pa3); SBAR();
    KWRITE5(1); VLOAD5(t + 3); SBAR();
    pv_d0<false>(o, vb0 + (int)SHM_V, pa0, pa1, pa2, pa3); partialSM(pA0, pA1, m_reg, mnA, alA);
    RESC5(alA);
    __syncthreads();
  }
  SBAR(); VWRITE5(1); SBAR();
  qkt<QREG, false>(pB0, pB1, K_lds + SHM_KN, R_lds + SHM_KR, qr, ql, r32, hi);
  finishSM(pA0, pA1, alA, l_reg, pa0, pa1, pa2, pa3); SBAR();
  pv_d0<false>(o, vb0, pa0, pa1, pa2, pa3); partialSM(pB0, pB1, m_reg, mnB, alB);
  RESC5(alB);
  __syncthreads();
  finishSM(pB0, pB1, alB, l_reg, pa0, pa1, pa2, pa3); SBAR();
  pv_d0<false>(o, vb0 + (int)SHM_V, pa0, pa1, pa2, pa3);
  SBAR(); asm volatile("" ::: "memory");
  u32x4 gt[8]; const int grow = lane >> 4, gc16 = lane & 15;
  bf16_t* Gw = Gm + (size_t)(wid * QBLK + grow) * DM + gc16 * 8;
#pragma unroll
  for (int i = 0; i < 8; ++i) gt[i] = __builtin_nontemporal_load((const u32x4*)(Gw + (size_t)(4 * i) * DM));
  if (hi == 0) li_l[r32] = l_reg;
  __syncthreads();
  char* ot = lds + OFF_OT + wid * (32 * OT_PITCH);
#pragma unroll
  for (int r = 0; r < 16; ++r) { const float rl = __builtin_amdgcn_rcpf(li_l[crow(r, hi)]); char* orow = ot + crow(r, hi) * OT_PITCH + r32 * 2;
#pragma unroll
    for (int d0 = 0; d0 < 4; ++d0) *(bf16_t*)(orow + d0 * 64) = f2bf(o[d0][r] * rl); }
  asm volatile("s_waitcnt lgkmcnt(0)" ::: "memory");
#pragma unroll
  for (int i = 0; i < 8; ++i) { const u32x4 ov = *(const u32x4*)(ot + (grow + 4 * i) * OT_PITCH + gc16 * 16); const u32x4 gv = gt[i]; u32x4 w;
#pragma unroll
    for (int e = 0; e < 4; ++e) { const float g0_ = __uint_as_float(gv[e] << 16), g1_ = __uint_as_float(gv[e] & 0xffff0000u); const float a0 = __uint_as_float(ov[e] << 16) * (GATE_IN_EPI ? g0_ : silu_f(g0_)), a1 = __uint_as_float(ov[e] & 0xffff0000u) * (GATE_IN_EPI ? g1_ : silu_f(g1_)); w[e] = cvt_pk_bf16(a0, a1); }
    *(u32x4*)(Gw + (size_t)(4 * i) * DM) = w; }
#undef TCL
#undef KLOAD5
#undef VLOAD5
#undef KWRITE5
#undef VWRITE5
#undef RESC5
}

#ifndef ATT3_QLDS
#define ATT3_QLDS 0
#endif
constexpr int Q3LDS = ATT3_QLDS, Q3REG = 12 - Q3LDS;
constexpr int O3_V = 0, O3_KN = 3 * SHM_V, O3_KR = O3_KN + 3 * SHM_KN, O3_WS = O3_KR + 3 * SHM_KR, O3_QL = O3_WS + NW * 64 * 4, SHM_ATTN3 = O3_QL + NW * Q3LDS * 1024;
static_assert(SHM_ATTN3 <= RING_BYTES && NW * 32 * OT_PITCH <= O3_WS, "attention (DMA variant) LDS must fit the phase scratch");
__device__ __forceinline__ void attn_body3(const bf16_t* __restrict__ Qb, const bf16_t* __restrict__ Kn, const bf16_t* __restrict__ Kr,
                                           bf16_t* __restrict__ Gm, int seq, char* lds, LAS unsigned char* ldsL, int tid) {
  const int wid = __builtin_amdgcn_readfirstlane(tid >> 6), lane = tid & 63, r32 = lane & 31, hi = lane >> 5;
  float* ws = (float*)(lds + O3_WS) + wid * 64; float* li_l = ws; float* al_l = ws + 32;
  float m_reg = -1e30f, l_reg = 0; f32x16 o[4] = {}; bf16x8 qr[Q3REG > 0 ? Q3REG : 1];
  char* ql = lds + O3_QL + wid * (Q3LDS * 1024) + lane * 16;
  unsigned vo[2], ko[2], ro;
#pragma unroll
  for (int u = 0; u < 2; ++u) { const int t = 2 * wid + u;
    { const int s = 2 * t + (lane >> 5), kk = (s >> 2) * 8 + ((lane & 31) >> 2), k = (kk & ~0xC) | ((kk & 4) << 1) | ((kk & 8) >> 1), c = (s & 3) * 32 + (lane & 3) * 8; vo[u] = (unsigned)(k * NKV + 128 + c) * 2u; }
    { const int row = 4 * t + (lane >> 4), c = (lane & 15) ^ (row & 15); ko[u] = (unsigned)(row * NKV) * 2u + (unsigned)c * 16u; } }
  { const int row = 8 * wid + (lane >> 3), ch = (lane & 7) ^ ((row >> 1) & 7); ro = (unsigned)row * 128u + (unsigned)ch * 16u; }
#define DMA3(k0, b) do { const char* kb_ = (const char*)(Kn + (long)(k0) * NKV); const char* rb_ = (const char*)(Kr + (long)(k0) * 64); \
    __builtin_amdgcn_global_load_lds((const unsigned*)(kb_ + vo[0]), (LAS unsigned*)(ldsL + O3_V + (b) * SHM_V + (2 * wid) * 1024), 16, 0, 0); \
    __builtin_amdgcn_global_load_lds((const unsigned*)(kb_ + vo[1]), (LAS unsigned*)(ldsL + O3_V + (b) * SHM_V + (2 * wid + 1) * 1024), 16, 0, 0); \
    __builtin_amdgcn_global_load_lds((const unsigned*)(kb_ + ko[0]), (LAS unsigned*)(ldsL + O3_KN + (b) * SHM_KN + (2 * wid) * 1024), 16, 0, 0); \
    __builtin_amdgcn_global_load_lds((const unsigned*)(kb_ + ko[1]), (LAS unsigned*)(ldsL + O3_KN + (b) * SHM_KN + (2 * wid + 1) * 1024), 16, 0, 0); \
    __builtin_amdgcn_global_load_lds((const unsigned*)(rb_ + ro), (LAS unsigned*)(ldsL + O3_KR + (b) * SHM_KR + wid * 1024), 16, 0, 0); } while (0)
#define LANDED() do { asm volatile("s_waitcnt vmcnt(0)" ::: "memory"); __syncthreads(); } while (0)
#define RESC(a) do { if (__any((a) < 1.f)) { if (hi == 0) al_l[r32] = (a); asm volatile("s_waitcnt lgkmcnt(0)" ::: "memory"); \
    for (int d = 0; d < 4; ++d) for (int r = 0; r < 16; ++r) o[d][r] *= al_l[crow(r, hi)]; } } while (0)
#define KNB(b) (lds + O3_KN + (b) * SHM_KN)
#define KRB(b) (lds + O3_KR + (b) * SHM_KR)
  DMA3(0, 0);
  const unsigned qoff = (unsigned)((wid * QBLK + r32) * NQ + hi * 8) * 2u;
#pragma unroll
  for (int d0 = 0; d0 < 12; ++d0) { const bf16x8 qv = *(const bf16x8*)((const char*)Qb + qoff + d0 * 32); if (d0 < Q3REG) qr[d0 < Q3REG ? d0 : 0] = qv; else *reinterpret_cast<bf16x8*>(ql + (d0 - Q3REG) * 1024) = qv; }
  const int vb0 = (int)(uintptr_t)(lds + O3_V) + v_rd_base(lane);
  f32x16 pA0, pA1, pB0, pB1; float mnA, mnB, alA, alB; bf16x8 pa0, pa1, pa2, pa3; const int NT = seq / KVBLK;
  LANDED();
  DMA3(KVBLK, 1);
  qkt<Q3REG>(pA0, pA1, KNB(0), KRB(0), qr, ql, r32, hi); partialSM(pA0, pA1, m_reg, mnA, alA);
  LANDED();
  int bA = 0, bB = 1, bC = 2;
  for (int j = 1; j + 1 < NT; j += 2) {
    DMA3((j + 1) * KVBLK, bC);
    SBAR(); qkt<Q3REG>(pB0, pB1, KNB(bB), KRB(bB), qr, ql, r32, hi);
    finishSM(pA0, pA1, alA, l_reg, pa0, pa1, pa2, pa3); SBAR();
    pv_d0(o, vb0 + bA * SHM_V, pa0, pa1, pa2, pa3); partialSM(pB0, pB1, m_reg, mnB, alB);
    RESC(alB); LANDED();
    DMA3((j + 2) * KVBLK, bA);
    SBAR(); qkt<Q3REG>(pA0, pA1, KNB(bC), KRB(bC), qr, ql, r32, hi);
    finishSM(pB0, pB1, alB, l_reg, pa0, pa1, pa2, pa3); SBAR();
    pv_d0(o, vb0 + bB * SHM_V, pa0, pa1, pa2, pa3); partialSM(pA0, pA1, m_reg, mnA, alA);
    RESC(alA); LANDED();
    { const int t = bA; bA = bC; bC = bB; bB = t; }
  }
  SBAR(); qkt<Q3REG>(pB0, pB1, KNB(bB), KRB(bB), qr, ql, r32, hi);
  finishSM(pA0, pA1, alA, l_reg, pa0, pa1, pa2, pa3); SBAR();
  pv_d0(o, vb0 + bA * SHM_V, pa0, pa1, pa2, pa3); partialSM(pB0, pB1, m_reg, mnB, alB);
  RESC(alB);
  finishSM(pB0, pB1, alB, l_reg, pa0, pa1, pa2, pa3); SBAR();
  pv_d0(o, vb0 + bB * SHM_V, pa0, pa1, pa2, pa3);
  SBAR(); asm volatile("" ::: "memory");
  u32x4 gt[8]; const int grow = lane >> 4, gc16 = lane & 15;
  bf16_t* Gw = Gm + (size_t)(wid * QBLK + grow) * DM + gc16 * 8;
#pragma unroll
  for (int i = 0; i < 8; ++i) gt[i] = __builtin_nontemporal_load((const u32x4*)(Gw + (size_t)(4 * i) * DM));
  if (hi == 0) li_l[r32] = l_reg;
  __syncthreads();
  char* ot = lds + OFF_OT + wid * (32 * OT_PITCH);
#pragma unroll
  for (int r = 0; r < 16; ++r) { const float rl = __builtin_amdgcn_rcpf(li_l[crow(r, hi)]); char* orow = ot + crow(r, hi) * OT_PITCH + r32 * 2;
#pragma unroll
    for (int d0 = 0; d0 < 4; ++d0) *(bf16_t*)(orow + d0 * 64) = f2bf(o[d0][r] * rl); }
  asm volatile("s_waitcnt lgkmcnt(0)" ::: "memory");
#pragma unroll
  for (int i = 0; i < 8; ++i) { const u32x4 ov = *(const u32x4*)(ot + (grow + 4 * i) * OT_PITCH + gc16 * 16); const u32x4 gv = gt[i]; u32x4 w;
#pragma unroll
    for (int e = 0; e < 4; ++e) { const float g0_ = __uint_as_float(gv[e] << 16), g1_ = __uint_as_float(gv[e] & 0xffff0000u); const float a0 = __uint_as_float(ov[e] << 16) * (GATE_IN_EPI ? g0_ : silu_f(g0_)), a1 = __uint_as_float(ov[e] & 0xffff0000u) * (GATE_IN_EPI ? g1_ : silu_f(g1_)); w[e] = cvt_pk_bf16(a0, a1); }
    *(u32x4*)(Gw + (size_t)(4 * i) * DM) = w; }
#undef DMA3
#undef LANDED
#undef RESC
#undef KNB
#undef KRB
}

#ifndef ATT4_SMFIRST
#define ATT4_SMFIRST 1
#endif
#ifndef ATT4_QLDS
#define ATT4_QLDS 4
#endif
constexpr int Q4LDS = ATT4_QLDS, Q4REG = 12 - Q4LDS;
constexpr int O4_V = 0, O4_KN = 2 * SHM_V, O4_KR = O4_KN + 2 * SHM_KN, O4_WS = O4_KR + 2 * SHM_KR, O4_QL = O4_WS + NW * 64 * 4, SHM_ATTN4 = O4_QL + NW * Q4LDS * 1024;
static_assert(SHM_ATTN4 <= RING_BYTES && NW * 32 * OT_PITCH <= O4_WS, "attention (staggered variant) LDS must fit the phase scratch");
__device__ __forceinline__ void attn_body4(const bf16_t* __restrict__ Qb, const bf16_t* __restrict__ Kn, const bf16_t* __restrict__ Kr,
                                           bf16_t* __restrict__ Gm, int seq, char* lds, LAS unsigned char* ldsL, int tid) {
  const int wid = __builtin_amdgcn_readfirstlane(tid >> 6), lane = tid & 63, r32 = lane & 31, hi = lane >> 5;
  float* ws = (float*)(lds + O4_WS) + wid * 64; float* li_l = ws; float* al_l = ws + 32;
  float m_reg = -1e30f, l_reg = 0; f32x16 o[4] = {}; bf16x8 qr[Q4REG > 0 ? Q4REG : 1];
  char* ql = lds + O4_QL + wid * (Q4LDS * 1024) + lane * 16;
  unsigned vo[2], ko[2], ro;
#pragma unroll
  for (int u = 0; u < 2; ++u) { const int t = 2 * wid + u;
    { const int s = 2 * t + (lane >> 5), kk = (s >> 2) * 8 + ((lane & 31) >> 2), k = (kk & ~0xC) | ((kk & 4) << 1) | ((kk & 8) >> 1), c = (s & 3) * 32 + (lane & 3) * 8; vo[u] = (unsigned)(k * NKV + 128 + c) * 2u; }
    { const int row = 4 * t + (lane >> 4), c = (lane & 15) ^ (row & 15); ko[u] = (unsigned)(row * NKV) * 2u + (unsigned)c * 16u; } }
  { const int row = 8 * wid + (lane >> 3), ch = (lane & 7) ^ ((row >> 1) & 7); ro = (unsigned)row * 128u + (unsigned)ch * 16u; }
#define DMAK(k0, b) do { const char* kb_ = (const char*)(Kn + (long)(k0) * NKV); const char* rb_ = (const char*)(Kr + (long)(k0) * 64); \
    __builtin_amdgcn_global_load_lds((const unsigned*)(kb_ + ko[0]), (LAS unsigned*)(ldsL + O4_KN + (b) * SHM_KN + (2 * wid) * 1024), 16, 0, 0); \
    __builtin_amdgcn_global_load_lds((const unsigned*)(kb_ + ko[1]), (LAS unsigned*)(ldsL + O4_KN + (b) * SHM_KN + (2 * wid + 1) * 1024), 16, 0, 0); \
    __builtin_amdgcn_global_load_lds((const unsigned*)(rb_ + ro), (LAS unsigned*)(ldsL + O4_KR + (b) * SHM_KR + wid * 1024), 16, 0, 0); } while (0)
#define DMAV(k0, b) do { const char* kb_ = (const char*)(Kn + (long)(k0) * NKV); \
    __builtin_amdgcn_global_load_lds((const unsigned*)(kb_ + vo[0]), (LAS unsigned*)(ldsL + O4_V + (b) * SHM_V + (2 * wid) * 1024), 16, 0, 0); \
    __builtin_amdgcn_global_load_lds((const unsigned*)(kb_ + vo[1]), (LAS unsigned*)(ldsL + O4_V + (b) * SHM_V + (2 * wid + 1) * 1024), 16, 0, 0); } while (0)
#define SLOT_END() do { asm volatile("s_waitcnt vmcnt(0)" ::: "memory"); __syncthreads(); } while (0)
#define XBAR() do { asm volatile("s_waitcnt vmcnt(0) lgkmcnt(0)" ::: "memory"); __builtin_amdgcn_s_barrier(); asm volatile("" ::: "memory"); } while (0)
#define RESC(a) do { if (__any((a) < 1.f)) { if (hi == 0) al_l[r32] = (a); asm volatile("s_waitcnt lgkmcnt(0)" ::: "memory"); \
    for (int d = 0; d < 4; ++d) for (int r = 0; r < 16; ++r) o[d][r] *= al_l[crow(r, hi)]; } } while (0)
#if ATT4_SMFIRST
#define B4_ORDER(PV, SM) do { SM; SBAR(); PV; } while (0)
#else
#define B4_ORDER(PV, SM) do { PV; SM; } while (0)
#endif
#define KNB(b) (lds + O4_KN + (b) * SHM_KN)
#define KRB(b) (lds + O4_KR + (b) * SHM_KR)
  DMAK(0, 0);
  const unsigned qoff = (unsigned)((wid * QBLK + r32) * NQ + hi * 8) * 2u;
#pragma unroll
  for (int d0 = 0; d0 < 12; ++d0) { const bf16x8 qv = *(const bf16x8*)((const char*)Qb + qoff + d0 * 32); if (d0 < Q4REG) qr[d0 < Q4REG ? d0 : 0] = qv; else *reinterpret_cast<bf16x8*>(ql + (d0 - Q4REG) * 1024) = qv; }
  const int vb0 = (int)(uintptr_t)(lds + O4_V) + v_rd_base(lane);
  f32x16 pA0, pA1, pB0, pB1; float mnA, mnB, alA, alB; bf16x8 pa0, pa1, pa2, pa3; const int NT = seq / KVBLK;
  SLOT_END();
  if (wid >= 4) XBAR();
  DMAK(KVBLK, 1); qkt<Q4REG>(pA0, pA1, KNB(0), KRB(0), qr, ql, r32, hi); SLOT_END();
  DMAV(0, 0); partialSM(pA0, pA1, m_reg, mnA, alA); SLOT_END();
  for (int j = 1; j + 1 < NT; j += 2) {
    DMAK((j + 1) * KVBLK, 0); SBAR(); qkt<Q4REG>(pB0, pB1, KNB(1), KRB(1), qr, ql, r32, hi);
    finishSM(pA0, pA1, alA, l_reg, pa0, pa1, pa2, pa3); SLOT_END();
    DMAV(j * KVBLK, 1); SBAR(); B4_ORDER(pv_d0(o, vb0, pa0, pa1, pa2, pa3), partialSM(pB0, pB1, m_reg, mnB, alB));
    RESC(alB); SLOT_END();
    DMAK((j + 2) * KVBLK, 1); SBAR(); qkt<Q4REG>(pA0, pA1, KNB(0), KRB(0), qr, ql, r32, hi);
    finishSM(pB0, pB1, alB, l_reg, pa0, pa1, pa2, pa3); SLOT_END();
    DMAV((j + 1) * KVBLK, 0); SBAR(); B4_ORDER(pv_d0(o, vb0 + (int)SHM_V, pa0, pa1, pa2, pa3), partialSM(pA0, pA1, m_reg, mnA, alA));
    RESC(alA); SLOT_END();
  }
  SBAR(); qkt<Q4REG>(pB0, pB1, KNB(1), KRB(1), qr, ql, r32, hi);
  finishSM(pA0, pA1, alA, l_reg, pa0, pa1, pa2, pa3); SLOT_END();
  DMAV((NT - 1) * KVBLK, 1); SBAR(); B4_ORDER(pv_d0(o, vb0, pa0, pa1, pa2, pa3), partialSM(pB0, pB1, m_reg, mnB, alB));
  RESC(alB); SLOT_END();
  finishSM(pB0, pB1, alB, l_reg, pa0, pa1, pa2, pa3); SLOT_END();
  pv_d0(o, vb0 + (int)SHM_V, pa0, pa1, pa2, pa3);
  if (wid < 4) XBAR();
  SBAR(); asm volatile("" ::: "memory");
  u32x4 gt[8]; const int grow = lane >> 4, gc16 = lane & 15;
  bf16_t* Gw = Gm + (size_t)(wid * QBLK + grow) * DM + gc16 * 8;
#pragma unroll
  for (int i = 0; i < 8; ++i) gt[i] = __builtin_nontemporal_load((const u32x4*)(Gw + (size_t)(4 * i) * DM));
  if (hi == 0) li_l[r32] = l_reg;
  __syncthreads();
  char* ot = lds + OFF_OT + wid * (32 * OT_PITCH);
#pragma unroll
  for (int r = 0; r < 16; ++r) { const float rl = __builtin_amdgcn_rcpf(li_l[crow(r, hi)]); char* orow = ot + crow(r, hi) * OT_PITCH + r32 * 2;
#pragma unroll
    for (int d0 = 0; d0 < 4; ++d0) *(bf16_t*)(orow + d0 * 64) = f2bf(o[d0][r] * rl); }
  asm volatile("s_waitcnt lgkmcnt(0)" ::: "memory");
#pragma unroll
  for (int i = 0; i < 8; ++i) { const u32x4 ov = *(const u32x4*)(ot + (grow + 4 * i) * OT_PITCH + gc16 * 16); const u32x4 gv = gt[i]; u32x4 w;
#pragma unroll
    for (int e = 0; e < 4; ++e) { const float g0_ = __uint_as_float(gv[e] << 16), g1_ = __uint_as_float(gv[e] & 0xffff0000u); const float a0 = __uint_as_float(ov[e] << 16) * (GATE_IN_EPI ? g0_ : silu_f(g0_)), a1 = __uint_as_float(ov[e] & 0xffff0000u) * (GATE_IN_EPI ? g1_ : silu_f(g1_)); w[e] = cvt_pk_bf16(a0, a1); }
    *(u32x4*)(Gw + (size_t)(4 * i) * DM) = w; }
#undef DMAK
#undef DMAV
#undef SLOT_END
#undef XBAR
#undef RESC
#undef KNB
#undef KRB
}

#ifndef ATT_STAGR
#define ATT_STAGR 0
#endif
#ifndef ATT6_QLDS
#define ATT6_QLDS 6
#endif
constexpr int Q6LDS = ATT6_QLDS, Q6REG = 12 - Q6LDS;
constexpr int O6_QL = O4_WS + NW * 64 * 4, SHM_ATTN6 = O6_QL + NW * Q6LDS * 1024;
static_assert(SHM_ATTN6 <= RING_BYTES, "attention (staggered register-staged variant) LDS must fit the phase scratch");
__device__ __forceinline__ void attn_body6(const bf16_t* __restrict__ Qb, const bf16_t* __restrict__ Kn, const bf16_t* __restrict__ Kr,
                                           bf16_t* __restrict__ Gm, int seq, char* lds, LAS unsigned char* ldsL, int tid) {
  const int wid = __builtin_amdgcn_readfirstlane(tid >> 6), lane = tid & 63, r32 = lane & 31, hi = lane >> 5;
  float* ws = (float*)(lds + O4_WS) + wid * 64; float* li_l = ws; float* al_l = ws + 32;
  float m_reg = -1e30f, l_reg = 0; f32x16 o[4] = {}; bf16x8 qr[Q6REG > 0 ? Q6REG : 1];
  char* ql = lds + O6_QL + wid * (Q6LDS * 1024) + lane * 16;
  const int sr = tid >> 4, sc = (tid & 15) * 8, vst0 = v_st(sr, sc), vst1 = v_st(32 + sr, sc), rr_ = tid >> 3, rc_ = tid & 7;
  const unsigned voff = (unsigned)(sr * NKV + sc) * 2u, voffr = (unsigned)(rr_ * 64 + rc_ * 8) * 2u;
  bf16x8 sg0, sg1, sg2;
#define DMAK(k0, b) do { const char* kb_ = (const char*)(Kn + (long)(k0) * NKV); const char* rb_ = (const char*)(Kr + (long)(k0) * 64); \
    sg0 = *(const bf16x8*)(kb_ + voff); sg1 = *(const bf16x8*)(kb_ + 32 * NKV * 2 + voff); sg2 = *(const bf16x8*)(rb_ + voffr); } while (0)
#define WRK(b) do { const int kc = sc * 2; *(bf16x8*)(lds + O4_KN + (b) * SHM_KN + KSWZ(sr, kc)) = sg0; *(bf16x8*)(lds + O4_KN + (b) * SHM_KN + KSWZ(32 + sr, kc)) = sg1; \
    *(bf16x8*)(lds + O4_KR + (b) * SHM_KR + RSWZ(rr_, rc_)) = sg2; } while (0)
#define DMAV(k0, b) do { const char* kb_ = (const char*)(Kn + (long)(k0) * NKV); sg0 = *(const bf16x8*)(kb_ + 256 + voff); sg1 = *(const bf16x8*)(kb_ + (32 * NKV * 2 + 256) + voff); } while (0)
#define WRV(b) do { *(bf16x8*)(lds + O4_V + (b) * SHM_V + vst0) = sg0; *(bf16x8*)(lds + O4_V + (b) * SHM_V + vst1) = sg1; } while (0)
#define SLOT_END() do { asm volatile("s_waitcnt vmcnt(0)" ::: "memory"); __syncthreads(); } while (0)
#define XBAR() do { asm volatile("s_waitcnt vmcnt(0) lgkmcnt(0)" ::: "memory"); __builtin_amdgcn_s_barrier(); asm volatile("" ::: "memory"); } while (0)
#define RESC(a) do { if (__any((a) < 1.f)) { if (hi == 0) al_l[r32] = (a); asm volatile("s_waitcnt lgkmcnt(0)" ::: "memory"); \
    for (int d = 0; d < 4; ++d) for (int r = 0; r < 16; ++r) o[d][r] *= al_l[crow(r, hi)]; } } while (0)
#if ATT4_SMFIRST
#define B4_ORDER(PV, SM) do { SM; SBAR(); PV; } while (0)
#else
#define B4_ORDER(PV, SM) do { PV; SM; } while (0)
#endif
#define KNB(b) (lds + O4_KN + (b) * SHM_KN)
#define KRB(b) (lds + O4_KR + (b) * SHM_KR)
  DMAK(0, 0);
  const unsigned qoff = (unsigned)((wid * QBLK + r32) * NQ + hi * 8) * 2u;
#pragma unroll
  for (int d0 = 0; d0 < 12; ++d0) { const bf16x8 qv = *(const bf16x8*)((const char*)Qb + qoff + d0 * 32); if (d0 < Q6REG) qr[d0 < Q6REG ? d0 : 0] = qv; else *reinterpret_cast<bf16x8*>(ql + (d0 - Q6REG) * 1024) = qv; }
  const int vb0 = (int)(uintptr_t)(lds + O4_V) + v_rd_base(lane);
  f32x16 pA0, pA1, pB0, pB1; float mnA, mnB, alA, alB; bf16x8 pa0, pa1, pa2, pa3; const int NT = seq / KVBLK;
  WRK(0); SLOT_END();
  if (wid >= 4) XBAR();
  DMAK(KVBLK, 1); qkt<Q6REG>(pA0, pA1, KNB(0), KRB(0), qr, ql, r32, hi); WRK(1); SLOT_END();
  DMAV(0, 0); partialSM(pA0, pA1, m_reg, mnA, alA); WRV(0); SLOT_END();
  for (int j = 1; j + 1 < NT; j += 2) {
    DMAK((j + 1) * KVBLK, 0); SBAR(); qkt<Q6REG>(pB0, pB1, KNB(1), KRB(1), qr, ql, r32, hi);
    finishSM(pA0, pA1, alA, l_reg, pa0, pa1, pa2, pa3); WRK(0); SLOT_END();
    DMAV(j * KVBLK, 1); SBAR(); B4_ORDER(pv_d0(o, vb0, pa0, pa1, pa2, pa3), partialSM(pB0, pB1, m_reg, mnB, alB));
    RESC(alB); WRV(1); SLOT_END();
    DMAK((j + 2) * KVBLK, 1); SBAR(); qkt<Q6REG>(pA0, pA1, KNB(0), KRB(0), qr, ql, r32, hi);
    finishSM(pB0, pB1, alB, l_reg, pa0, pa1, pa2, pa3); WRK(1); SLOT_END();
    DMAV((j + 1) * KVBLK, 0); SBAR(); B4_ORDER(pv_d0(o, vb0 + (int)SHM_V, pa0, pa1, pa2, pa3), partialSM(pA0, pA1, m_reg, mnA, alA));
    RESC(alA); WRV(0); SLOT_END();
  }
  SBAR(); qkt<Q6REG>(pB0, pB1, KNB(1), KRB(1), qr, ql, r32, hi);
  finishSM(pA0, pA1, alA, l_reg, pa0, pa1, pa2, pa3); SLOT_END();
  DMAV((NT - 1) * KVBLK, 1); SBAR(); B4_ORDER(pv_d0(o, vb0, pa0, pa1, pa2, pa3), partialSM(pB0, pB1, m_reg, mnB, alB));
  RESC(alB); WRV(1); SLOT_END();
  finishSM(pB0, pB1, alB, l_reg, pa0, pa1, pa2, pa3); SLOT_END();
  pv_d0(o, vb0 + (int)SHM_V, pa0, pa1, pa2, pa3);
  if (wid < 4) XBAR();
  SBAR(); asm volatile("" ::: "memory");
  u32x4 gt[8]; const int grow = lane >> 4, gc16 = lane & 15;
  bf16_t* Gw = Gm + (size_t)(wid * QBLK + grow) * DM + gc16 * 8;
#pragma unroll
  for (int i = 0; i < 8; ++i) gt[i] = __builtin_nontemporal_load((const u32x4*)(Gw + (size_t)(4 * i) * DM));
  if (hi == 0) li_l[r32] = l_reg;
  __syncthreads();
  char* ot = lds + OFF_OT + wid * (32 * OT_PITCH);
#pragma unroll
  for (int r = 0; r < 16; ++r) { const float rl = __builtin_amdgcn_rcpf(li_l[crow(r, hi)]); char* orow = ot + crow(r, hi) * OT_PITCH + r32 * 2;
#pragma unroll
    for (int d0 = 0; d0 < 4; ++d0) *(bf16_t*)(orow + d0 * 64) = f2bf(o[d0][r] * rl); }
  asm volatile("s_waitcnt lgkmcnt(0)" ::: "memory");
#pragma unroll
  for (int i = 0; i < 8; ++i) { const u32x4 ov = *(const u32x4*)(ot + (grow + 4 * i) * OT_PITCH + gc16 * 16); const u32x4 gv = gt[i]; u32x4 w;
#pragma unroll
    for (int e = 0; e < 4; ++e) { const float g0_ = __uint_as_float(gv[e] << 16), g1_ = __uint_as_float(gv[e] & 0xffff0000u); const float a0 = __uint_as_float(ov[e] << 16) * (GATE_IN_EPI ? g0_ : silu_f(g0_)), a1 = __uint_as_float(ov[e] & 0xffff0000u) * (GATE_IN_EPI ? g1_ : silu_f(g1_)); w[e] = cvt_pk_bf16(a0, a1); }
    *(u32x4*)(Gw + (size_t)(4 * i) * DM) = w; }
#undef WRK
#undef WRV
#undef DMAK
#undef DMAV
#undef SLOT_END
#undef XBAR
#undef RESC
#undef KNB
#undef KRB
}
}

namespace att16 {
using att::tr_read; using att::ld8;
constexpr int NW = 8, QBLK = 32, KVBLK = 64;
constexpr float THR = 8.f;
#ifndef ATT16_QLDS
#define ATT16_QLDS 8
#endif
constexpr int QLDS = ATT16_QLDS, QREG = 12 - QLDS;
constexpr int SHM_V = KVBLK * 128 * 2, SHM_KN = KVBLK * 128 * 2, SHM_KR = KVBLK * 64 * 2;
constexpr int OFF_V = 0, OFF_KN = 2 * SHM_V, OFF_KR = OFF_KN + 2 * SHM_KN, OFF_WS = OFF_KR + 2 * SHM_KR, OFF_QL = OFF_WS + NW * 64 * 4, OT_PITCH = 272, SHM_ATTN = OFF_QL + NW * QLDS * 1024;
static_assert(SHM_ATTN <= RING_BYTES && NW * 32 * OT_PITCH <= OFF_WS, "attention (16x16 variant) LDS must fit the phase scratch");
__device__ __forceinline__ int v_st(int k, int c) { return ((k >> 3) * 8 + (c >> 4)) * 256 + (k & 7) * 32 + (c & 15) * 2; }
__device__ __forceinline__ int v_rd_base(int lane) { const int g = lane >> 4, c = lane & 15; return (g >> 1) * 2048 + (g & 1) * 128 + (c >> 2) * 32 + (c & 3) * 8; }
constexpr int v_rd_off(int db, int s, int h) { return s * 8192 + h * 4096 + db * 256; }
__device__ __forceinline__ float xmax4(float x) {
  { auto r = __builtin_amdgcn_permlane16_swap(__float_as_uint(x), __float_as_uint(x), false, false); x = fmaxf(__uint_as_float(r[0]), __uint_as_float(r[1])); }
  { auto r = __builtin_amdgcn_permlane32_swap(__float_as_uint(x), __float_as_uint(x), false, false); x = fmaxf(__uint_as_float(r[0]), __uint_as_float(r[1])); }
  return x; }
__device__ __forceinline__ float xsum4(float x) {
  { auto r = __builtin_amdgcn_permlane16_swap(__float_as_uint(x), __float_as_uint(x), false, false); x = __uint_as_float(r[0]) + __uint_as_float(r[1]); }
  { auto r = __builtin_amdgcn_permlane32_swap(__float_as_uint(x), __float_as_uint(x), false, false); x = __uint_as_float(r[0]) + __uint_as_float(r[1]); }
  return x; }
typedef f32x4 PT[2][4];
__device__ __forceinline__ void partialSM(PT& p, float (&m_reg)[2], float (&mn)[2], float (&alpha)[2]) {
  constexpr float C = ATT_SCALE * 1.4426950408889634f;
  float pm[2];
#pragma unroll
  for (int qb = 0; qb < 2; ++qb) { float x = p[qb][0][0];
#pragma unroll
    for (int kb = 0; kb < 4; ++kb)
#pragma unroll
      for (int r = 0; r < 4; ++r) x = fmaxf(x, p[qb][kb][r]);
    pm[qb] = xmax4(x); }
  if (__builtin_expect(__all((pm[0] - m_reg[0] <= THR / ATT_SCALE) && (pm[1] - m_reg[1] <= THR / ATT_SCALE)), 1)) { mn[0] = m_reg[0]; mn[1] = m_reg[1]; alpha[0] = 1.f; alpha[1] = 1.f; }
  else {
#pragma unroll
    for (int qb = 0; qb < 2; ++qb) { mn[qb] = fmaxf(m_reg[qb], pm[qb]); alpha[qb] = __builtin_amdgcn_exp2f((m_reg[qb] - mn[qb]) * C); m_reg[qb] = mn[qb]; } }
#pragma unroll
  for (int qb = 0; qb < 2; ++qb) { const float mnC = -mn[qb] * C;
#pragma unroll
    for (int kb = 0; kb < 4; ++kb)
#pragma unroll
      for (int r = 0; r < 4; ++r) p[qb][kb][r] = fmaf(p[qb][kb][r], C, mnC); }
#pragma unroll
  for (int qb = 0; qb < 2; ++qb)
#pragma unroll
    for (int kb = 0; kb < 2; ++kb)
#pragma unroll
      for (int r = 0; r < 4; ++r) p[qb][kb][r] = __builtin_amdgcn_exp2f(p[qb][kb][r]);
}
__device__ __forceinline__ bf16x8 pack8(f32x4 a, f32x4 b) { u32x4 w = {cvt_pk_bf16(a[0], a[1]), cvt_pk_bf16(a[2], a[3]), cvt_pk_bf16(b[0], b[1]), cvt_pk_bf16(b[2], b[3])}; return __builtin_bit_cast(bf16x8, w); }
__device__ __forceinline__ void finishSM(PT& p, const float (&alpha)[2], float (&l_reg)[2], bf16x8 (&pa)[2][2]) {
#pragma unroll
  for (int qb = 0; qb < 2; ++qb)
#pragma unroll
    for (int kb = 2; kb < 4; ++kb)
#pragma unroll
      for (int r = 0; r < 4; ++r) p[qb][kb][r] = __builtin_amdgcn_exp2f(p[qb][kb][r]);
#pragma unroll
  for (int qb = 0; qb < 2; ++qb) { float ps = 0.f;
#pragma unroll
    for (int kb = 0; kb < 4; ++kb) ps += (p[qb][kb][0] + p[qb][kb][1]) + (p[qb][kb][2] + p[qb][kb][3]);
    l_reg[qb] = l_reg[qb] * alpha[qb] + xsum4(ps);
    pa[qb][0] = pack8(p[qb][0], p[qb][1]); pa[qb][1] = pack8(p[qb][2], p[qb][3]); }
}
__device__ __forceinline__ bf16x8 kfrag(const char* Kn, const char* Kr, int i, int c, int g) {
  const int ks = i >> 2, kb = i & 3, row = 16 * kb + c;
  if (ks < 4) return *reinterpret_cast<const bf16x8*>(Kn + KSWZ(row, (4 * ks + g) * 16));
  return *reinterpret_cast<const bf16x8*>(Kr + RSWZ(row, 4 * (ks - 4) + g));
}
__device__ __forceinline__ bf16x8 qsel(const bf16x8* qr, const char* ql, int f) { return f < QREG ? qr[f < QREG ? f : 0] : *reinterpret_cast<const bf16x8*>(ql + (f - QREG) * 1024); }
__device__ __forceinline__ void qkt(PT& p, const char* Kn, const char* Kr, const bf16x8* qr, const char* ql, int c, int g) {
#pragma unroll
  for (int qb = 0; qb < 2; ++qb)
#pragma unroll
    for (int kb = 0; kb < 4; ++kb) p[qb][kb] = (f32x4){0.f, 0.f, 0.f, 0.f};
  bf16x8 ka = kfrag(Kn, Kr, 0, c, g), kb_ = kfrag(Kn, Kr, 1, c, g), na, nb, q0 = qsel(qr, ql, 0), q1 = qsel(qr, ql, 6), q0n, q1n;
#pragma unroll
  for (int i = 0; i < 12; ++i) { const int ks = i >> 1, k2 = (i & 1) * 2;
    if (i + 1 < 12) { na = kfrag(Kn, Kr, 2 * i + 2, c, g); nb = kfrag(Kn, Kr, 2 * i + 3, c, g); }
    if ((i & 1) == 0 && ks + 1 < 6) { q0n = qsel(qr, ql, ks + 1); q1n = qsel(qr, ql, 6 + ks + 1); }
    SBAR();
    p[0][k2] = __builtin_amdgcn_mfma_f32_16x16x32_bf16(ka, q0, p[0][k2], 0, 0, 0);
    p[1][k2] = __builtin_amdgcn_mfma_f32_16x16x32_bf16(ka, q1, p[1][k2], 0, 0, 0);
    p[0][k2 + 1] = __builtin_amdgcn_mfma_f32_16x16x32_bf16(kb_, q0, p[0][k2 + 1], 0, 0, 0);
    p[1][k2 + 1] = __builtin_amdgcn_mfma_f32_16x16x32_bf16(kb_, q1, p[1][k2 + 1], 0, 0, 0);
    SBAR();
    ka = na; kb_ = nb; if (i & 1) { q0 = q0n; q1 = q1n; } }
}
#define TRPK16(L, H) (bf16x8){L[0], L[1], L[2], L[3], H[0], H[1], H[2], H[3]}
template <int DB> __device__ __forceinline__ void pv_two(f32x4& o00, f32x4& o10, f32x4& o01, f32x4& o11, int vb, const bf16x8 (&pa)[2][2]) {
  const s16x4 l0 = tr_read<v_rd_off(DB, 0, 0)>(vb), h0 = tr_read<v_rd_off(DB, 0, 1)>(vb), l1 = tr_read<v_rd_off(DB, 1, 0)>(vb), h1 = tr_read<v_rd_off(DB, 1, 1)>(vb);
  const s16x4 l2 = tr_read<v_rd_off(DB + 1, 0, 0)>(vb), h2 = tr_read<v_rd_off(DB + 1, 0, 1)>(vb), l3 = tr_read<v_rd_off(DB + 1, 1, 0)>(vb), h3 = tr_read<v_rd_off(DB + 1, 1, 1)>(vb);
  asm volatile("s_waitcnt lgkmcnt(0)" ::: "memory"); SBAR();
  o00 = __builtin_amdgcn_mfma_f32_16x16x32_bf16(pa[0][0], TRPK16(l0, h0), o00, 0, 0, 0);
  o10 = __builtin_amdgcn_mfma_f32_16x16x32_bf16(pa[1][0], TRPK16(l0, h0), o10, 0, 0, 0);
  o01 = __builtin_amdgcn_mfma_f32_16x16x32_bf16(pa[0][0], TRPK16(l2, h2), o01, 0, 0, 0);
  o11 = __builtin_amdgcn_mfma_f32_16x16x32_bf16(pa[1][0], TRPK16(l2, h2), o11, 0, 0, 0);
  o00 = __builtin_amdgcn_mfma_f32_16x16x32_bf16(pa[0][1], TRPK16(l1, h1), o00, 0, 0, 0);
  o10 = __builtin_amdgcn_mfma_f32_16x16x32_bf16(pa[1][1], TRPK16(l1, h1), o10, 0, 0, 0);
  o01 = __builtin_amdgcn_mfma_f32_16x16x32_bf16(pa[0][1], TRPK16(l3, h3), o01, 0, 0, 0);
  o11 = __builtin_amdgcn_mfma_f32_16x16x32_bf16(pa[1][1], TRPK16(l3, h3), o11, 0, 0, 0);
}
typedef f32x4 OT_[2][8];
__device__ __forceinline__ void pv_all(OT_& o, int vb, const bf16x8 (&pa)[2][2]) {
  pv_two<0>(o[0][0], o[1][0], o[0][1], o[1][1], vb, pa); pv_two<2>(o[0][2], o[1][2], o[0][3], o[1][3], vb, pa);
  pv_two<4>(o[0][4], o[1][4], o[0][5], o[1][5], vb, pa); pv_two<6>(o[0][6], o[1][6], o[0][7], o[1][7], vb, pa);
}
template <int VAR>
__device__ __forceinline__ void attn_body(const bf16_t* __restrict__ Qb, const bf16_t* __restrict__ Kn, const bf16_t* __restrict__ Kr,
                                          bf16_t* __restrict__ Gm, int seq, char* lds, int tid) {
  const int wid = tid >> 6, lane = tid & 63, c = lane & 15, g = lane >> 4;
  char* V_lds = lds + OFF_V; char* K_lds = lds + OFF_KN; char* R_lds = lds + OFF_KR;
  float* ws = (float*)(lds + OFF_WS) + wid * 64; float* li_l = ws; float* al_l = ws + 32;
  float m_reg[2] = {-1e30f, -1e30f}, l_reg[2] = {0.f, 0.f}; OT_ o;
#pragma unroll
  for (int qb = 0; qb < 2; ++qb)
#pragma unroll
    for (int db = 0; db < 8; ++db) o[qb][db] = (f32x4){0.f, 0.f, 0.f, 0.f};
  bf16x8 qr[QREG > 0 ? QREG : 1];
  char* ql = lds + OFF_QL + wid * (QLDS * 1024) + lane * 16;
#pragma unroll
  for (int f = 0; f < 12; ++f) { const int qb = f / 6, ks = f - qb * 6;
    const bf16x8 qv = *(const bf16x8*)((const char*)Qb + (unsigned)((wid * QBLK + 16 * qb + c) * NQ + 32 * ks + 8 * g) * 2u);
    if (f < QREG) qr[f < QREG ? f : 0] = qv; else *reinterpret_cast<bf16x8*>(ql + (f - QREG) * 1024) = qv; }
  const int sr = tid >> 4, sc = (tid & 15) * 8, vst0 = v_st(sr, sc), vst1 = v_st(32 + sr, sc);
  const int rr_ = tid >> 3, rc_ = tid & 7;
  const int vb0 = (int)(uintptr_t)V_lds + v_rd_base(lane);
  struct { bf16x8 vs0, vs1, ks0, ks1, kr; } sr_;
  const unsigned voff = (unsigned)(sr * NKV + sc) * 2u, voffr = (unsigned)(rr_ * 64 + rc_ * 8) * 2u;
#define SLOAD(k0) do { const char* kb_ = (const char*)(Kn + (long)(k0) * NKV); const char* rb_ = (const char*)(Kr + (long)(k0) * 64); \
    sr_.vs0 = *(const bf16x8*)(kb_ + 256 + voff); sr_.vs1 = *(const bf16x8*)(kb_ + (32 * NKV * 2 + 256) + voff); \
    sr_.ks0 = *(const bf16x8*)(kb_ + voff); sr_.ks1 = *(const bf16x8*)(kb_ + 32 * NKV * 2 + voff); \
    sr_.kr = *(const bf16x8*)(rb_ + voffr); } while (0)
#define SWRITE(b) do { *(bf16x8*)(V_lds + (b) * SHM_V + vst0) = sr_.vs0; *(bf16x8*)(V_lds + (b) * SHM_V + vst1) = sr_.vs1; const int kc_ = sc * 2; \
    *(bf16x8*)(K_lds + (b) * SHM_KN + KSWZ(sr, kc_)) = sr_.ks0; *(bf16x8*)(K_lds + (b) * SHM_KN + KSWZ(32 + sr, kc_)) = sr_.ks1; \
    *(bf16x8*)(R_lds + (b) * SHM_KR + RSWZ(rr_, rc_)) = sr_.kr; } while (0)
#define SWAIT() asm volatile("s_waitcnt vmcnt(0)" ::: "memory")
#define RESC(a) do { if (__any(((a)[0] < 1.f) || ((a)[1] < 1.f))) { if (g == 0) { al_l[c] = (a)[0]; al_l[16 + c] = (a)[1]; } asm volatile("s_waitcnt lgkmcnt(0)" ::: "memory"); \
    _Pragma("unroll") for (int qb = 0; qb < 2; ++qb) { const f32x4 av = *(const f32x4*)(al_l + 16 * qb + 4 * g); _Pragma("unroll") for (int db = 0; db < 8; ++db) o[qb][db] *= av; } } } while (0)
  PT pA, pB; float mnA[2], mnB[2], alA[2], alB[2]; bf16x8 pa[2][2]; const int NT = seq / KVBLK;
#define QKT(P, KN, KR) do { if constexpr (VAR == 3) { _Pragma("unroll") for (int qb_ = 0; qb_ < 2; ++qb_) _Pragma("unroll") for (int kb_ = 0; kb_ < 4; ++kb_) P[qb_][kb_] = o[qb_][kb_]; } else qkt(P, KN, KR, qr, ql, c, g); } while (0)
#define PSM(P, MN, AL) do { if constexpr (VAR == 1) { MN[0] = m_reg[0]; MN[1] = m_reg[1]; AL[0] = 1.f; AL[1] = 1.f; } else partialSM(P, m_reg, MN, AL); } while (0)
#define FSM(P, AL) do { if constexpr (VAR == 1) { pa[0][0] = __builtin_bit_cast(bf16x8, P[0][0]); pa[0][1] = __builtin_bit_cast(bf16x8, P[0][1]); pa[1][0] = __builtin_bit_cast(bf16x8, P[1][0]); pa[1][1] = __builtin_bit_cast(bf16x8, P[1][1]); l_reg[0] += P[0][2][0]; l_reg[1] += P[1][3][1]; } \
    else finishSM(P, AL, l_reg, pa); } while (0)
#define PVD(VB) do { if constexpr (VAR == 2) { o[0][0] += __builtin_bit_cast(f32x4, pa[0][0]); o[1][1] += __builtin_bit_cast(f32x4, pa[1][1]); o[0][2] += __builtin_bit_cast(f32x4, pa[0][1]); o[1][3] += __builtin_bit_cast(f32x4, pa[1][0]); } else pv_all(o, VB, pa); } while (0)
  SLOAD(0); SWAIT(); SWRITE(0); __syncthreads();
  QKT(pA, K_lds, R_lds); PSM(pA, mnA, alA);
  SLOAD(KVBLK); SWAIT(); SWRITE(1); __syncthreads();
  for (int j = 1; j + 1 < NT; j += 2) {
    SBAR(); QKT(pB, K_lds + SHM_KN, R_lds + SHM_KR);
    FSM(pA, alA); SBAR();
    SLOAD((j + 1) * KVBLK); SBAR();
    PVD(vb0); PSM(pB, mnB, alB);
    __syncthreads(); SWAIT(); SWRITE(0);
    RESC(alB); __syncthreads();
    SBAR(); QKT(pA, K_lds, R_lds);
    FSM(pB, alB); SBAR();
    SLOAD((j + 2) * KVBLK); SBAR();
    PVD(vb0 + (int)SHM_V); PSM(pA, mnA, alA);
    __syncthreads(); SWAIT(); SWRITE(1);
    RESC(alA); __syncthreads();
  }
  SBAR(); QKT(pB, K_lds + SHM_KN, R_lds + SHM_KR);
  FSM(pA, alA); SBAR();
  PVD(vb0); PSM(pB, mnB, alB);
  __syncthreads(); RESC(alB);
  FSM(pB, alB); SBAR();
  PVD(vb0 + (int)SHM_V);
  SBAR(); asm volatile("" ::: "memory");
  u32x4 gt[8]; const int grow = lane >> 4, gc16 = lane & 15;
  bf16_t* Gw = Gm + (size_t)(wid * QBLK + grow) * DM + gc16 * 8;
#pragma unroll
  for (int i = 0; i < 8; ++i) gt[i] = __builtin_nontemporal_load((const u32x4*)(Gw + (size_t)(4 * i) * DM));
  if (g == 0) { li_l[c] = l_reg[0]; li_l[16 + c] = l_reg[1]; }
  __syncthreads();
  char* ot = lds + wid * (32 * OT_PITCH);
#pragma unroll
  for (int qb = 0; qb < 2; ++qb) { const f32x4 lv = *(const f32x4*)(li_l + 16 * qb + 4 * g);
#pragma unroll
    for (int r = 0; r < 4; ++r) { const float rl = __builtin_amdgcn_rcpf(lv[r]); char* orow = ot + (16 * qb + 4 * g + r) * OT_PITCH + c * 2;
#pragma unroll
      for (int db = 0; db < 8; ++db) *(bf16_t*)(orow + db * 32) = f2bf(o[qb][db][r] * rl); } }
  asm volatile("s_waitcnt lgkmcnt(0)" ::: "memory");
#pragma unroll
  for (int i = 0; i < 8; ++i) { const u32x4 ov = *(const u32x4*)(ot + (grow + 4 * i) * OT_PITCH + gc16 * 16); const u32x4 gv = gt[i]; u32x4 w;
#pragma unroll
    for (int e = 0; e < 4; ++e) { const float g0_ = __uint_as_float(gv[e] << 16), g1_ = __uint_as_float(gv[e] & 0xffff0000u); const float a0 = __uint_as_float(ov[e] << 16) * (GATE_IN_EPI ? g0_ : silu_f(g0_)), a1 = __uint_as_float(ov[e] & 0xffff0000u) * (GATE_IN_EPI ? g1_ : silu_f(g1_)); w[e] = cvt_pk_bf16(a0, a1); }
    *(u32x4*)(Gw + (size_t)(4 * i) * DM) = w; }
#undef SLOAD
#undef QKT
#undef PSM
#undef FSM
#undef PVD
#undef SWRITE
#undef SWAIT
#undef RESC
}
}
namespace atth {
using att::tr_read; using att::crow; using att::partialSM; using att::kfrag; using att::qfrag;
constexpr int NW = 8, QBLK = 32, KVBLK = 64;
#ifndef ATTH_QLDS
#define ATTH_QLDS 6
#endif
constexpr int QLDS = ATTH_QLDS, QREG = 12 - QLDS;
constexpr int SHM_V = KVBLK * 128 * 2, SHM_KN = KVBLK * 128 * 2, SHM_KR = KVBLK * 64 * 2;
constexpr int OFF_V = 0, OFF_KN = 2 * SHM_V, OFF_KR = OFF_KN + 2 * SHM_KN, OFF_WS = OFF_KR + 2 * SHM_KR, OFF_QL = OFF_WS + NW * 64 * 4, OT_PITCH = 272, SHM_ATTN = OFF_QL + NW * QLDS * 1024;
static_assert(SHM_ATTN <= RING_BYTES && NW * 32 * OT_PITCH <= OFF_WS, "attention (hybrid variant) LDS must fit the phase scratch");
__device__ __forceinline__ int v_st(int k, int c) { const int kp = (k & ~0x14) | ((k & 4) << 2) | ((k & 16) >> 2); return (c >> 4) * 2048 + kp * 32 + (c & 15) * 2; }
__device__ __forceinline__ int v_rd_base(int lane) { const int g = lane >> 4, c = lane & 15; return (g >> 1) * 512 + (g & 1) * 128 + (c >> 2) * 32 + (c & 3) * 8; }
constexpr int v_rd_off(int db, int s, int h) { return db * 2048 + s * 1024 + h * 256; }
__device__ __forceinline__ void finishSM(f32x16& p0, f32x16& p1, float alpha, float& l_reg, bf16x8 (&pa)[2][2]) {
  for (int r = 0; r < 16; ++r) p1[r] = __builtin_amdgcn_exp2f(p1[r]);
  float ps = 0; for (int r = 0; r < 16; ++r) ps += p0[r]; for (int r = 0; r < 16; ++r) ps += p1[r];
  { auto rr = __builtin_amdgcn_permlane32_swap(__float_as_uint(ps), __float_as_uint(ps), false, false);
    ps = __uint_as_float(rr[0]) + __uint_as_float(rr[1]); }
  l_reg = l_reg * alpha + ps;
#define RELAY(P, S) do { u32x4 wa, wb; \
    _Pragma("unroll") for (int i = 0; i < 4; ++i) { const unsigned a_ = cvt_pk_bf16(P[2 * i], P[2 * i + 1]), b_ = cvt_pk_bf16(P[8 + 2 * i], P[8 + 2 * i + 1]); \
      auto r_ = __builtin_amdgcn_permlane16_swap(a_, b_, false, false); wa[i] = r_[0]; wb[i] = r_[1]; } \
    pa[0][S] = __builtin_bit_cast(bf16x8, wa); pa[1][S] = __builtin_bit_cast(bf16x8, wb); } while (0)
  RELAY(p0, 0); RELAY(p1, 1);
#undef RELAY
}
#define TRPKH(L, H) (bf16x8){L[0], L[1], L[2], L[3], H[0], H[1], H[2], H[3]}
template <int DB> __device__ __forceinline__ void pv_two(f32x4& o00, f32x4& o10, f32x4& o01, f32x4& o11, int vb, const bf16x8 (&pa)[2][2]) {
  const s16x4 l0 = tr_read<v_rd_off(DB, 0, 0)>(vb), h0 = tr_read<v_rd_off(DB, 0, 1)>(vb), l1 = tr_read<v_rd_off(DB, 1, 0)>(vb), h1 = tr_read<v_rd_off(DB, 1, 1)>(vb);
  const s16x4 l2 = tr_read<v_rd_off(DB + 1, 0, 0)>(vb), h2 = tr_read<v_rd_off(DB + 1, 0, 1)>(vb), l3 = tr_read<v_rd_off(DB + 1, 1, 0)>(vb), h3 = tr_read<v_rd_off(DB + 1, 1, 1)>(vb);
  asm volatile("s_waitcnt lgkmcnt(0)" ::: "memory"); SBAR();
  o00 = __builtin_amdgcn_mfma_f32_16x16x32_bf16(pa[0][0], TRPKH(l0, h0), o00, 0, 0, 0);
  o10 = __builtin_amdgcn_mfma_f32_16x16x32_bf16(pa[1][0], TRPKH(l0, h0), o10, 0, 0, 0);
  o01 = __builtin_amdgcn_mfma_f32_16x16x32_bf16(pa[0][0], TRPKH(l2, h2), o01, 0, 0, 0);
  o11 = __builtin_amdgcn_mfma_f32_16x16x32_bf16(pa[1][0], TRPKH(l2, h2), o11, 0, 0, 0);
  o00 = __builtin_amdgcn_mfma_f32_16x16x32_bf16(pa[0][1], TRPKH(l1, h1), o00, 0, 0, 0);
  o10 = __builtin_amdgcn_mfma_f32_16x16x32_bf16(pa[1][1], TRPKH(l1, h1), o10, 0, 0, 0);
  o01 = __builtin_amdgcn_mfma_f32_16x16x32_bf16(pa[0][1], TRPKH(l3, h3), o01, 0, 0, 0);
  o11 = __builtin_amdgcn_mfma_f32_16x16x32_bf16(pa[1][1], TRPKH(l3, h3), o11, 0, 0, 0);
}
typedef f32x4 OT_[2][8];
__device__ __forceinline__ void pv_all(OT_& o, int vb, const bf16x8 (&pa)[2][2]) {
  pv_two<0>(o[0][0], o[1][0], o[0][1], o[1][1], vb, pa); pv_two<2>(o[0][2], o[1][2], o[0][3], o[1][3], vb, pa);
  pv_two<4>(o[0][4], o[1][4], o[0][5], o[1][5], vb, pa); pv_two<6>(o[0][6], o[1][6], o[0][7], o[1][7], vb, pa);
}
__device__ __forceinline__ void attn_body(const bf16_t* __restrict__ Qb, const bf16_t* __restrict__ Kn, const bf16_t* __restrict__ Kr,
                                          bf16_t* __restrict__ Gm, int seq, char* lds, int tid) {
  const int wid = tid >> 6, lane = tid & 63, r32 = lane & 31, hi = lane >> 5, c = lane & 15, g = lane >> 4;
  char* V_lds = lds + OFF_V; char* K_lds = lds + OFF_KN; char* R_lds = lds + OFF_KR;
  float* ws = (float*)(lds + OFF_WS) + wid * 64; float* li_l = ws; float* al_l = ws + 32;
  float m_reg = -1e30f, l_reg = 0; OT_ o;
#pragma unroll
  for (int qb = 0; qb < 2; ++qb)
#pragma unroll
    for (int db = 0; db < 8; ++db) o[qb][db] = (f32x4){0.f, 0.f, 0.f, 0.f};
  bf16x8 qr[QREG > 0 ? QREG : 1];
  char* ql = lds + OFF_QL + wid * (QLDS * 1024) + lane * 16;
  const unsigned qoff = (unsigned)((wid * QBLK + r32) * NQ + hi * 8) * 2u;
#pragma unroll
  for (int d0 = 0; d0 < 12; ++d0) { const bf16x8 qv = *(const bf16x8*)((const char*)Qb + qoff + d0 * 32); if (d0 < QREG) qr[d0 < QREG ? d0 : 0] = qv; else *reinterpret_cast<bf16x8*>(ql + (d0 - QREG) * 1024) = qv; }
  const int sr = tid >> 4, sc = (tid & 15) * 8, vst0 = v_st(sr, sc), vst1 = v_st(32 + sr, sc);
  const int rr_ = tid >> 3, rc_ = tid & 7;
  const int vb0 = (int)(uintptr_t)V_lds + v_rd_base(lane);
  struct { bf16x8 vs0, vs1, ks0, ks1, kr; } sr_;
  const unsigned voff = (unsigned)(sr * NKV + sc) * 2u, voffr = (unsigned)(rr_ * 64 + rc_ * 8) * 2u;
#define SLOAD(k0) do { const char* kb_ = (const char*)(Kn + (long)(k0) * NKV); const char* rb_ = (const char*)(Kr + (long)(k0) * 64); \
    sr_.vs0 = *(const bf16x8*)(kb_ + 256 + voff); sr_.vs1 = *(const bf16x8*)(kb_ + (32 * NKV * 2 + 256) + voff); \
    sr_.ks0 = *(const bf16x8*)(kb_ + voff); sr_.ks1 = *(const bf16x8*)(kb_ + 32 * NKV * 2 + voff); \
    sr_.kr = *(const bf16x8*)(rb_ + voffr); } while (0)
#define SWRITE(b) do { *(bf16x8*)(V_lds + (b) * SHM_V + vst0) = sr_.vs0; *(bf16x8*)(V_lds + (b) * SHM_V + vst1) = sr_.vs1; const int kc_ = sc * 2; \
    *(bf16x8*)(K_lds + (b) * SHM_KN + KSWZ(sr, kc_)) = sr_.ks0; *(bf16x8*)(K_lds + (b) * SHM_KN + KSWZ(32 + sr, kc_)) = sr_.ks1; \
    *(bf16x8*)(R_lds + (b) * SHM_KR + RSWZ(rr_, rc_)) = sr_.kr; } while (0)
#define SWAIT() asm volatile("s_waitcnt vmcnt(0)" ::: "memory")
#define RESC(a) do { if (__any((a) < 1.f)) { if (hi == 0) al_l[r32] = (a); asm volatile("s_waitcnt lgkmcnt(0)" ::: "memory"); \
    _Pragma("unroll") for (int qb = 0; qb < 2; ++qb) { const f32x4 av = *(const f32x4*)(al_l + 16 * qb + 4 * g); _Pragma("unroll") for (int db = 0; db < 8; ++db) o[qb][db] *= av; } } } while (0)
  f32x16 pA0, pA1, pB0, pB1; float mnA, mnB, alA, alB; bf16x8 pa[2][2]; const int NT = seq / KVBLK;
  SLOAD(0); SWAIT(); SWRITE(0); __syncthreads();
  att::qkt<QREG>(pA0, pA1, K_lds, R_lds, qr, ql, r32, hi); partialSM(pA0, pA1, m_reg, mnA, alA);
  SLOAD(KVBLK); SWAIT(); SWRITE(1); __syncthreads();
  for (int j = 1; j + 1 < NT; j += 2) {
    SBAR(); att::qkt<QREG>(pB0, pB1, K_lds + SHM_KN, R_lds + SHM_KR, qr, ql, r32, hi);
    finishSM(pA0, pA1, alA, l_reg, pa); SBAR();
    SLOAD((j + 1) * KVBLK); SBAR();
    pv_all(o, vb0, pa); partialSM(pB0, pB1, m_reg, mnB, alB);
    __syncthreads(); SWAIT(); SWRITE(0);
    RESC(alB); __syncthreads();
    SBAR(); att::qkt<QREG>(pA0, pA1, K_lds, R_lds, qr, ql, r32, hi);
    finishSM(pB0, pB1, alB, l_reg, pa); SBAR();
    SLOAD((j + 2) * KVBLK); SBAR();
    pv_all(o, vb0 + (int)SHM_V, pa); partialSM(pA0, pA1, m_reg, mnA, alA);
    __syncthreads(); SWAIT(); SWRITE(1);
    RESC(alA); __syncthreads();
  }
  SBAR(); att::qkt<QREG>(pB0, pB1, K_lds + SHM_KN, R_lds + SHM_KR, qr, ql, r32, hi);
  finishSM(pA0, pA1, alA, l_reg, pa); SBAR();
  pv_all(o, vb0, pa); partialSM(pB0, pB1, m_reg, mnB, alB);
  __syncthreads(); RESC(alB);
  finishSM(pB0, pB1, alB, l_reg, pa); SBAR();
  pv_all(o, vb0 + (int)SHM_V, pa);
  SBAR(); asm volatile("" ::: "memory");
  u32x4 gt[8]; const int grow = lane >> 4, gc16 = lane & 15;
  bf16_t* Gw = Gm + (size_t)(wid * QBLK + grow) * DM + gc16 * 8;
#pragma unroll
  for (int i = 0; i < 8; ++i) gt[i] = __builtin_nontemporal_load((const u32x4*)(Gw + (size_t)(4 * i) * DM));
  if (hi == 0) li_l[r32] = l_reg;
  __syncthreads();
  char* ot = lds + wid * (32 * OT_PITCH);
#pragma unroll
  for (int qb = 0; qb < 2; ++qb) { const f32x4 lv = *(const f32x4*)(li_l + 16 * qb + 4 * g);
#pragma unroll
    for (int r = 0; r < 4; ++r) { const float rl = __builtin_amdgcn_rcpf(lv[r]); char* orow = ot + (16 * qb + 4 * g + r) * OT_PITCH + c * 2;
#pragma unroll
      for (int db = 0; db < 8; ++db) *(bf16_t*)(orow + db * 32) = f2bf(o[qb][db][r] * rl); } }
  asm volatile("s_waitcnt lgkmcnt(0)" ::: "memory");
#pragma unroll
  for (int i = 0; i < 8; ++i) { const u32x4 ov = *(const u32x4*)(ot + (grow + 4 * i) * OT_PITCH + gc16 * 16); const u32x4 gv = gt[i]; u32x4 w;
#pragma unroll
    for (int e = 0; e < 4; ++e) { const float g0_ = __uint_as_float(gv[e] << 16), g1_ = __uint_as_float(gv[e] & 0xffff0000u); const float a0 = __uint_as_float(ov[e] << 16) * (GATE_IN_EPI ? g0_ : silu_f(g0_)), a1 = __uint_as_float(ov[e] & 0xffff0000u) * (GATE_IN_EPI ? g1_ : silu_f(g1_)); w[e] = cvt_pk_bf16(a0, a1); }
    *(u32x4*)(Gw + (size_t)(4 * i) * DM) = w; }
#undef SLOAD
#undef SWRITE
#undef SWAIT
#undef RESC
}
}
template <int VAR = 0>
__device__ __forceinline__ void attn_fast(const Frame& F) {
    const bf16_t* Q = WSP(bf16_t, WS_Q); const bf16_t* KV = WSP(bf16_t, WS_KV); const bf16_t* KR = WSP(bf16_t, WS_KR); bf16_t* MIX = WSP(bf16_t, F.mix_off);
    for (int it = F.vcu; it < NB * NH * (SEQ / 256); it += F.G) {
        const int qb = it & 15, p = it >> 4, h = p & 7, b = p >> 3;
        const size_t t0 = (size_t)b * SEQ, q0 = t0 + (size_t)qb * 256;
        int t = F.tid; asm volatile("" : "+v"(t));
#if ATT_STAGR
        att::attn_body6(Q + q0 * NQ + h * DQK, KV + t0 * NKV + h * 256, KR + t0 * 64, MIX + q0 * DM + DF + h * 128, SEQ, F.ldsg, F.lds, t);
#elif ATT_ONEBAR
        att::attn_body5(Q + q0 * NQ + h * DQK, KV + t0 * NKV + h * 256, KR + t0 * 64, MIX + q0 * DM + DF + h * 128, SEQ, F.ldsg, t);
#elif ATT_STAG
        att::attn_body4(Q + q0 * NQ + h * DQK, KV + t0 * NKV + h * 256, KR + t0 * 64, MIX + q0 * DM + DF + h * 128, SEQ, F.ldsg, F.lds, t);
#elif ATT_HYB
        atth::attn_body(Q + q0 * NQ + h * DQK, KV + t0 * NKV + h * 256, KR + t0 * 64, MIX + q0 * DM + DF + h * 128, SEQ, F.ldsg, t);
#elif ATT_S16
        att16::attn_body<VAR>(Q + q0 * NQ + h * DQK, KV + t0 * NKV + h * 256, KR + t0 * 64, MIX + q0 * DM + DF + h * 128, SEQ, F.ldsg, t);
#elif ATT_DMA
        att::attn_body3(Q + q0 * NQ + h * DQK, KV + t0 * NKV + h * 256, KR + t0 * 64, MIX + q0 * DM + DF + h * 128, SEQ, F.ldsg, F.lds, t);
#else
        att::attn_body<VAR>(Q + q0 * NQ + h * DQK, KV + t0 * NKV + h * 256, KR + t0 * 64, MIX + q0 * DM + DF + h * 128, SEQ, F.ldsg, t);
#endif
        __syncthreads();
    }
}
namespace fft {
using att::v_st; using att::v_rd_base; using att::v_rd_off; using att::tr_read; using att::crow;
constexpr int OPITCH = 272;
constexpr int F1_T = 0, F1_OUT = 16384, F1_END = F1_OUT + 128 * OPITCH;
constexpr int XPITCH = 528;
constexpr int F2_Z = 0, F2_XL = 32768, F2_YL = F2_XL + 64 * XPITCH, F2_D2 = F2_YL + 64 * XPITCH, F2_END = F2_D2 + 128 * OPITCH;
static_assert(F1_END <= RING_BYTES && F2_END <= RING_BYTES, "FFT LDS must fit the phase scratch");
#ifndef FFT_SYM
#define FFT_SYM 1
#endif
__device__ __forceinline__ void cmirror(bf16x8& re, bf16x8& im, const float c, const float s) {
    const u32x4 r = __builtin_bit_cast(u32x4, re), m = __builtin_bit_cast(u32x4, im); u32x4 orr, oim;
#pragma unroll
    for (int e = 0; e < 4; ++e) { const float r0 = __uint_as_float(r[e] << 16), r1 = __uint_as_float(r[e] & 0xffff0000u), m0 = __uint_as_float(m[e] << 16), m1 = __uint_as_float(m[e] & 0xffff0000u);
        orr[e] = cvt_pk_bf16(r0 * c - m0 * s, r1 * c - m1 * s); oim[e] = cvt_pk_bf16(-(r0 * s + m0 * c), -(r1 * s + m1 * c)); }
    re = __builtin_bit_cast(bf16x8, orr); im = __builtin_bit_cast(bf16x8, oim);
}
#ifndef FFT_DYN
#define FFT_DYN 0
#endif
__device__ __forceinline__ unsigned* qword(const Frame& F, int s, int l, int q) { return WSP(unsigned, WS_CTL) + 3584 + ((s * DEPTH + l) * 8 + q) * 16; }
static_assert(3584 >= XCD_BAR_WORDS && (3584 + 2 * DEPTH * 8 * 16) * 4 <= CTL_BYTES, "queue words must fit the control region behind the barrier words");
__device__ __forceinline__ int q_item(int G, int qg, unsigned idx) { return G >= 64 ? (idx < 256u ? (int)idx * 8 + qg : -1) : (idx < (unsigned)(NB * 64 * NG) ? (int)idx : -1); }
}
__device__ __forceinline__ void fft1_fast(const Frame& F, int l) {
    using namespace fft;
    const bf16_t* U = WSP(bf16_t, WS_U); const bf16_t* D1 = WSP(bf16_t, WS_D1); bf16_t* Z = WSP(bf16_t, WS_H);
    const int tid = F.tid, wid = tid >> 6, lane = tid & 63, r32 = lane & 31, hi = lane >> 5, half = wid & 1, cb = wid >> 1;
    char* lds = F.ldsg;
    bf16x8 bfr[2][4];
#pragma unroll
    for (int ri = 0; ri < 2; ++ri)
#pragma unroll
        for (int ks = 0; ks < 4; ++ks) bfr[ri][ks] = *(const bf16x8*)(D1 + (ri * 64 + half * 32 + r32) * 64 + 16 * ks + 8 * hi);
    const int sr = tid >> 4, sc = (tid & 15) * 8, vst0 = v_st(sr, sc), vst1 = v_st(32 + sr, sc);
    const int vb = (int)(uintptr_t)(lds + F1_T) + v_rd_base(lane) + cb * 512;
    const int s1p = half * 32 + r32;
#if FFT_DYN
    const int qg = F.G >= 64 ? ((F.bx >> 3) & 7) : 0; unsigned* qc = qword(F, 0, l, qg); volatile LAS unsigned* mw = (volatile LAS unsigned*)(F.lds + MISC_OFF);
    unsigned cnx = 0u;
    if (tid == 0) { mw[8] = xb_add(qc, 1u); cnx = xb_add(qc, 1u); }
    __syncthreads();
    int it = q_item(F.G, qg, mw[8]); if (it < 0) return;
#else
    int it = F.bx; if (it >= NB * 64 * NG) return;
#endif
    bf16x8 u0, u1;
#define F1_LOAD(IT) do { const int g_ = (IT) & 7, s2_ = ((IT) >> 3) & 63, b_ = (IT) >> 9; const bf16_t* up = U + ((size_t)(b_ * SEQ + s2_)) * DF + g_ * 128 + sc; \
        u0 = __builtin_nontemporal_load((const bf16x8*)(up + (size_t)(64 * sr) * DF)); u1 = __builtin_nontemporal_load((const bf16x8*)(up + (size_t)(64 * (sr + 32)) * DF)); } while (0)
    F1_LOAD(it);
#if FFT_DYN
    for (int nit = 0; it >= 0; it = nit) {
        const int g = it & 7, s2 = (it >> 3) & 63, b = it >> 9;
        *(bf16x8*)(lds + F1_T + vst0) = u0; *(bf16x8*)(lds + F1_T + vst1) = u1;
        if (tid == 0) mw[8] = cnx;
        __syncthreads();
        nit = q_item(F.G, qg, mw[8]);
        if (nit >= 0) { F1_LOAD(nit); if (tid == 0) cnx = xb_add(qc, 1u); }
#else
    for (; it < NB * 64 * NG; it += F.G) {
        const int g = it & 7, s2 = (it >> 3) & 63, b = it >> 9;
        *(bf16x8*)(lds + F1_T + vst0) = u0; *(bf16x8*)(lds + F1_T + vst1) = u1;
        __syncthreads();
        if (it + F.G < NB * 64 * NG) F1_LOAD(it + F.G);
#endif
        f32x16 acc0 = {}, acc1 = {};
        { const s16x4 l0 = tr_read<v_rd_off(0, 0, 0)>(vb), h0 = tr_read<v_rd_off(0, 0, 1)>(vb), l1 = tr_read<v_rd_off(0, 1, 0)>(vb), h1 = tr_read<v_rd_off(0, 1, 1)>(vb);
          const s16x4 l2 = tr_read<v_rd_off(0, 2, 0)>(vb), h2 = tr_read<v_rd_off(0, 2, 1)>(vb), l3 = tr_read<v_rd_off(0, 3, 0)>(vb), h3 = tr_read<v_rd_off(0, 3, 1)>(vb);
          asm volatile("s_waitcnt lgkmcnt(0)" ::: "memory"); __builtin_amdgcn_sched_barrier(0);
          acc0 = __builtin_amdgcn_mfma_f32_32x32x16_bf16(TRPK(l0, h0), bfr[0][0], acc0, 0, 0, 0); acc1 = __builtin_amdgcn_mfma_f32_32x32x16_bf16(TRPK(l0, h0), bfr[1][0], acc1, 0, 0, 0);
          acc0 = __builtin_amdgcn_mfma_f32_32x32x16_bf16(TRPK(l1, h1), bfr[0][1], acc0, 0, 0, 0); acc1 = __builtin_amdgcn_mfma_f32_32x32x16_bf16(TRPK(l1, h1), bfr[1][1], acc1, 0, 0, 0);
          acc0 = __builtin_amdgcn_mfma_f32_32x32x16_bf16(TRPK(l2, h2), bfr[0][2], acc0, 0, 0, 0); acc1 = __builtin_amdgcn_mfma_f32_32x32x16_bf16(TRPK(l2, h2), bfr[1][2], acc1, 0, 0, 0);
          acc0 = __builtin_amdgcn_mfma_f32_32x32x16_bf16(TRPK(l3, h3), bfr[0][3], acc0, 0, 0, 0); acc1 = __builtin_amdgcn_mfma_f32_32x32x16_bf16(TRPK(l3, h3), bfr[1][3], acc1, 0, 0, 0); }
        float st, ct; sincospif((float)(s2 * s1p) * (1.0f / 2048.0f), &st, &ct);
        char* o0 = lds + F1_OUT + s1p * OPITCH + (cb * 32 + 4 * hi) * 2; char* o1 = o0 + 64 * OPITCH;
#pragma unroll
        for (int q = 0; q < 4; ++q) { float zr[4], zi[4];
#pragma unroll
            for (int j = 0; j < 4; ++j) { const float yr = acc0[4 * q + j], yi = acc1[4 * q + j]; zr[j] = yr * ct + yi * st; zi[j] = yi * ct - yr * st; }
            *(u32x2*)(o0 + q * 16) = (u32x2){cvt_pk_bf16(zr[0], zr[1]), cvt_pk_bf16(zr[2], zr[3])};
            *(u32x2*)(o1 + q * 16) = (u32x2){cvt_pk_bf16(zi[0], zi[1]), cvt_pk_bf16(zi[2], zi[3])}; }
        __syncthreads();
#pragma unroll
        for (int i = 0; i < 4; ++i) { const int q = tid + 512 * i, row = q >> 4, c16 = q & 15, ri = row >> 6, sp = row & 63;
            const u32x4 v = *(const u32x4*)(lds + F1_OUT + row * OPITCH + c16 * 16);
            if (FFT_SYM == 0 || sp <= 32) *(u32x4*)(Z + (((((size_t)(b * 64 + sp) * NG + g) * 2 + ri) * 64 + s2) * 128) + c16 * 8) = v; }
    }
#undef F1_LOAD
    __syncthreads();
}
__device__ __forceinline__ void fft2_fast(const Frame& F, int l) {
    using namespace fft;
    const bf16_t* Z = WSP(bf16_t, WS_H); const bf16_t* D2 = WSP(bf16_t, WS_D2); const bf16_t* wcat = WSP(bf16_t, WS_WCAT) + (size_t)l * NG * 128 * 256; bf16_t* MIX = WSP(bf16_t, F.mix_off);
    const int tid = F.tid, wid = tid >> 6, lane = tid & 63, r32 = lane & 31, hi = lane >> 5, cb = wid & 3, h2 = wid >> 2;
    char* lds = F.ldsg;
#if FFT_DYN
    const int qg = F.G >= 64 ? ((F.bx >> 3) & 7) : 0; unsigned* qc = qword(F, 1, l, qg); volatile LAS unsigned* mw = (volatile LAS unsigned*)(F.lds + MISC_OFF);
    unsigned cnx = 0u;
    if (tid == 0) { mw[8] = xb_add(qc, 1u); cnx = xb_add(qc, 1u); }
    __syncthreads();
    int it = q_item(F.G, qg, mw[8]); if (it < 0) return;
#else
    int it = F.bx; if (it >= NB * 64 * NG) return;
#endif
#pragma unroll
    for (int i = 0; i < 4; ++i) { const int q = tid + 512 * i, row = q >> 4, c16 = q & 15; *(u32x4*)(lds + F2_D2 + row * OPITCH + c16 * 16) = *(const u32x4*)(D2 + row * 128 + c16 * 8); }
    const int sr = tid >> 4, sc = (tid & 15) * 8, vst0 = v_st(sr, sc), vst1 = v_st(32 + sr, sc);
    const int vb = (int)(uintptr_t)(lds + F2_Z) + v_rd_base(lane) + cb * 512;
    bf16x8 wfr[16]; int gcur = -1;
    float ms0, mc0; sincospif((float)sr * (1.0f / 32.0f), &ms0, &mc0);
    bf16x8 z0, z1, z2, z3, g0, g1;
#define F2_LOAD(IT) do { const int g_ = (IT) & 7, sp_ = ((IT) >> 3) & 63, b_ = (IT) >> 9, zs_ = (FFT_SYM && sp_ > 32) ? 64 - sp_ : sp_; const bf16_t* zp = Z + ((size_t)(b_ * 64 + zs_) * NG + g_) * (2 * 64 * 128) + sr * 128 + sc; \
        z0 = __builtin_nontemporal_load((const bf16x8*)(zp)); z1 = __builtin_nontemporal_load((const bf16x8*)(zp + 32 * 128)); z2 = __builtin_nontemporal_load((const bf16x8*)(zp + 64 * 128)); z3 = __builtin_nontemporal_load((const bf16x8*)(zp + 96 * 128)); \
        const bf16_t* mp = MIX + ((size_t)(b_ * SEQ + sp_ + 64 * (tid >> 4))) * DM + g_ * 128 + (tid & 15) * 8; g0 = __builtin_nontemporal_load((const bf16x8*)(mp)); g1 = __builtin_nontemporal_load((const bf16x8*)(mp + (size_t)(64 * 32) * DM)); } while (0)
    F2_LOAD(it);
#if FFT_DYN
    for (int nit = 0; it >= 0; it = nit) {
        const int g = it & 7, sp = (it >> 3) & 63, b = it >> 9;
        if (g != gcur) { gcur = g;
#pragma unroll
            for (int ks = 0; ks < 16; ++ks) wfr[ks] = *(const bf16x8*)(wcat + (size_t)(g * 128 + cb * 32 + r32) * 256 + 16 * ks + 8 * hi); }
#else
    while (it < NB * 64 * NG) {
      { const int g_ = it & 7; gcur = g_;
#pragma unroll
        for (int ks = 0; ks < 16; ++ks) wfr[ks] = *(const bf16x8*)(wcat + (size_t)(g_ * 128 + cb * 32 + r32) * 256 + 16 * ks + 8 * hi);
        __builtin_amdgcn_s_waitcnt(0x0F70); }
      for (; it < NB * 64 * NG && (it & 7) == gcur; it += F.G) {
        const int g = it & 7, sp = (it >> 3) & 63, b = it >> 9;
#endif
        if (FFT_SYM && sp > 32) { cmirror(z0, z2, mc0, ms0); cmirror(z1, z3, -mc0, -ms0); }
        *(bf16x8*)(lds + F2_Z + vst0) = z0; *(bf16x8*)(lds + F2_Z + vst1) = z1; *(bf16x8*)(lds + F2_Z + 16384 + vst0) = z2; *(bf16x8*)(lds + F2_Z + 16384 + vst1) = z3;
        const bf16x8 gg0 = g0, gg1 = g1;
#if FFT_DYN
        if (tid == 0) mw[8] = cnx;
        __syncthreads();
        nit = q_item(F.G, qg, mw[8]);
        if (nit >= 0) { F2_LOAD(nit); if (tid == 0) cnx = xb_add(qc, 1u); }
#else
        __syncthreads();
        if (it + F.G < NB * 64 * NG) F2_LOAD(it + F.G);
#endif
#if defined(FFT2_P1_NAIVE)
        { const bf16_t* Zb = Z + ((size_t)(b * 64 + sp) * NG + g) * (2 * 64 * 128);
          for (int i = 0; i < 32; ++i) { const int o = tid + 512 * i, c = o & 127, rr = o >> 7; float s_ = 0.f;
              for (int k = 0; k < 128; ++k) s_ += bf2f(D2[rr * 128 + k]) * bf2f(Zb[k * 128 + c]);
              *(bf16_t*)(lds + F2_XL + (rr & 63) * XPITCH + ((rr >> 6) * 128 + c) * 2) = f2bf(s_); } }
#else
        f32x16 x0 = {}, x1 = {};
        const char* d2p = lds + F2_D2 + (h2 * 32 + r32) * OPITCH + 16 * hi;
#pragma unroll
        for (int t = 0; t < 2; ++t) {
            const int vbt = vb + t * 16384;
            const s16x4 l0 = tr_read<v_rd_off(0, 0, 0)>(vbt), h0 = tr_read<v_rd_off(0, 0, 1)>(vbt), l1 = tr_read<v_rd_off(0, 1, 0)>(vbt), h1 = tr_read<v_rd_off(0, 1, 1)>(vbt);
            const s16x4 l2 = tr_read<v_rd_off(0, 2, 0)>(vbt), h2_ = tr_read<v_rd_off(0, 2, 1)>(vbt), l3 = tr_read<v_rd_off(0, 3, 0)>(vbt), h3 = tr_read<v_rd_off(0, 3, 1)>(vbt);
            bf16x8 e0[4], e1[4];
#pragma unroll
            for (int ks = 0; ks < 4; ++ks) { e0[ks] = *(const bf16x8*)(d2p + (t * 4 + ks) * 32); e1[ks] = *(const bf16x8*)(d2p + 64 * OPITCH + (t * 4 + ks) * 32); }
            asm volatile("s_waitcnt lgkmcnt(0)" ::: "memory"); __builtin_amdgcn_sched_barrier(0);
            x0 = __builtin_amdgcn_mfma_f32_32x32x16_bf16(TRPK(l0, h0), e0[0], x0, 0, 0, 0); x1 = __builtin_amdgcn_mfma_f32_32x32x16_bf16(TRPK(l0, h0), e1[0], x1, 0, 0, 0);
            x0 = __builtin_amdgcn_mfma_f32_32x32x16_bf16(TRPK(l1, h1), e0[1], x0, 0, 0, 0); x1 = __builtin_amdgcn_mfma_f32_32x32x16_bf16(TRPK(l1, h1), e1[1], x1, 0, 0, 0);
            x0 = __builtin_amdgcn_mfma_f32_32x32x16_bf16(TRPK(l2, h2_), e0[2], x0, 0, 0, 0); x1 = __builtin_amdgcn_mfma_f32_32x32x16_bf16(TRPK(l2, h2_), e1[2], x1, 0, 0, 0);
            x0 = __builtin_amdgcn_mfma_f32_32x32x16_bf16(TRPK(l3, h3), e0[3], x0, 0, 0, 0); x1 = __builtin_amdgcn_mfma_f32_32x32x16_bf16(TRPK(l3, h3), e1[3], x1, 0, 0, 0);
        }
        { char* xr = lds + F2_XL + (h2 * 32 + r32) * XPITCH + (cb * 32 + 4 * hi) * 2;
#pragma unroll
          for (int q = 0; q < 4; ++q) { *(u32x2*)(xr + q * 16) = (u32x2){cvt_pk_bf16(x0[4 * q], x0[4 * q + 1]), cvt_pk_bf16(x0[4 * q + 2], x0[4 * q + 3])};
              *(u32x2*)(xr + 256 + q * 16) = (u32x2){cvt_pk_bf16(x1[4 * q], x1[4 * q + 1]), cvt_pk_bf16(x1[4 * q + 2], x1[4 * q + 3])}; } }
#endif
        __syncthreads();
#if defined(FFT2_P2_NAIVE)
        for (int i = 0; i < 16; ++i) { const int o = tid + 512 * i, d = o & 127, s2p = o >> 7; float s_ = 0.f;
            const bf16_t* wr_ = wcat + (size_t)(g * 128 + d) * 256;
            for (int k = 0; k < 256; ++k) s_ += bf2f(*(const bf16_t*)(lds + F2_XL + s2p * XPITCH + k * 2)) * bf2f(wr_[k]);
            *(float*)(lds + F2_YL + s2p * XPITCH + d * 4) = s_; }
#else
        f32x16 y = {};
        { const char* xb = lds + F2_XL + (h2 * 32 + r32) * XPITCH + 16 * hi;
#pragma unroll
          for (int ks = 0; ks < 16; ++ks) { const bf16x8 xf = *(const bf16x8*)(xb + ks * 32); y = __builtin_amdgcn_mfma_f32_32x32x16_bf16(wfr[ks], xf, y, 0, 0, 0); } }
        { char* yr = lds + F2_YL + (h2 * 32 + r32) * XPITCH + (cb * 32 + 4 * hi) * 4;
#pragma unroll
          for (int q = 0; q < 4; ++q) *(f32x4*)(yr + q * 32) = (f32x4){y[4 * q], y[4 * q + 1], y[4 * q + 2], y[4 * q + 3]}; }
#endif
        __syncthreads();
#pragma unroll
        for (int i = 0; i < 2; ++i) { const int row = (tid >> 4) + 32 * i, c8 = (tid & 15) * 8; const bf16x8 gv = i ? gg1 : gg0;
            const f32x4 ya = *(const f32x4*)(lds + F2_YL + row * XPITCH + c8 * 4), yb = *(const f32x4*)(lds + F2_YL + row * XPITCH + c8 * 4 + 16);
            f32x4 ga = {bf2f((bf16_t)gv[0]), bf2f((bf16_t)gv[1]), bf2f((bf16_t)gv[2]), bf2f((bf16_t)gv[3])}, gb = {bf2f((bf16_t)gv[4]), bf2f((bf16_t)gv[5]), bf2f((bf16_t)gv[6]), bf2f((bf16_t)gv[7])};
            if (!GATE_IN_EPI) { ga = silu4(ga); gb = silu4(gb); }
            store8_bf16(MIX + ((size_t)(b * SEQ + sp + 64 * row)) * DM + g * 128 + c8, ya * ga, yb * gb); }
    }
#if !FFT_DYN
    }
#endif
#undef F2_LOAD
    __syncthreads();
}
#if PROBE_CHECK
constexpr size_t WS_CHK_GATE = WS_U;
constexpr size_t WS_CHK_CNT = WS_CTL + 15 * 1024;
__device__ __forceinline__ int chk_tok(int i) { return (i * 64 + 37 + (i >> 2) * 4096 / 64 * 0) % MTOK + ((i & 3) * 4096) - ((i & 3) * 4096); }
__device__ __forceinline__ void chk_fail(const Frame& F, float a, float b, float atol, float rtol) { if (!(fabsf(a - b) <= atol + rtol * fabsf(b))) atomicAdd(WSP(unsigned, WS_CHK_CNT), 1u); }
__device__ __forceinline__ void chk_proj(const Frame& F, int l) {
    LAS float* hs = (LAS float*)F.lds;
    LAS float* cs = hs + 2048;
    LAS float* red = cs + 832;
    const float* x = l == 0 ? F.in[0] : WSP(float, WS_R); const float* mod = WSP(float, WS_MOD) + (size_t)l * NB * 3 * DM; const float* w_in = F.in[5] + (size_t)l * DM * NIN;
    for (int i = F.bx; i < 256; i += F.G) {
        const int tok = 64 * i + 37, b = tok >> 12, tid = F.tid;
        float s = 0.f; for (int k = tid; k < DM; k += NTHREADS) s += x[(size_t)tok * DM + k];
        s = wave_sum(s); if (F.lane == 0) red[F.wave] = s; __syncthreads(); float mean = 0.f; for (int w = 0; w < 8; ++w) mean += red[w]; mean *= (1.0f / DM); __syncthreads();
        float q2 = 0.f; for (int k = tid; k < DM; k += NTHREADS) { const float d = x[(size_t)tok * DM + k] - mean; q2 += d * d; }
        q2 = wave_sum(q2); if (F.lane == 0) red[F.wave] = q2; __syncthreads(); float var = 0.f; for (int w = 0; w < 8; ++w) var += red[w]; const float rstd = rsqrtf(var * (1.0f / DM) + NORM_EPS); __syncthreads();
        for (int k = tid; k < DM; k += NTHREADS) hs[k] = bf2f(f2bf((x[(size_t)tok * DM + k] - mean) * rstd * (1.0f + mod[(size_t)b * 3 * DM + DM + k]) + mod[(size_t)b * 3 * DM + k]));
        __syncthreads();
        for (int c = tid; c < 832; c += NTHREADS) { float a = 0.f; for (int k = 0; k < DM; ++k) a += hs[k] * bf2f(f2bf(w_in[(size_t)k * NIN + 2048 + c])); cs[c] = a; }
        __syncthreads();
        float sq = 0.f; for (int c = tid; c < 512; c += NTHREADS) sq += cs[c] * cs[c];
        sq = wave_sum(sq); if (F.lane == 0) red[F.wave] = sq; __syncthreads(); float sq_q = 0.f; for (int w = 0; w < 8; ++w) sq_q += red[w]; __syncthreads();
        float sk = 0.f; for (int c = 512 + tid; c < 768; c += NTHREADS) sk += cs[c] * cs[c];
        sk = wave_sum(sk); if (F.lane == 0) red[F.wave] = sk; __syncthreads(); float sq_k = 0.f; for (int w = 0; w < 8; ++w) sq_k += red[w]; __syncthreads();
        const float rq = rsqrtf(sq_q * (1.0f / QLR) + NORM_EPS), rk = rsqrtf(sq_k * (1.0f / KVLR) + NORM_EPS);
        const float* rc = WSP(float, WS_RCOS) + (size_t)tok * 32; const float* rs = WSP(float, WS_RSIN) + (size_t)tok * 32;
        const int pos = ((const int*)F.in[2])[tok];
        if (tid < 32) { const float ang = (float)pos * powf(10000.0f, -(float)tid / 32.0f); const float c_ = cosf(ang), s_ = sinf(ang); const float x1 = cs[768 + tid], x2 = cs[800 + tid];
            chk_fail(F, bf2f(WSP(bf16_t, WS_KR)[(size_t)tok * 64 + tid]), x1 * c_ - x2 * s_, 0.05f, 0.05f); chk_fail(F, bf2f(WSP(bf16_t, WS_KR)[(size_t)tok * 64 + 32 + tid]), x2 * c_ + x1 * s_, 0.05f, 0.05f);
            chk_fail(F, rc[tid], c_, 0.02f, 0.f); chk_fail(F, rs[tid], s_, 0.02f, 0.f); }
        const float* wq = F.in[7] + (size_t)l * QLR * NQ; const float* gq = F.in[6] + l * QLR;
        for (int n = tid; n < NQ; n += NTHREADS) { const int head = n / DQK, d = n - head * DQK; if (d >= 160) continue;
            float a = 0.f, a2 = 0.f; for (int k = 0; k < QLR; ++k) { const float cn = bf2f(f2bf(cs[k])) * rq * gq[k]; a += cn * wq[(size_t)k * NQ + n]; if (d >= 128) a2 += cn * wq[(size_t)k * NQ + n + 32]; }
            if (d < 128) chk_fail(F, bf2f(WSP(bf16_t, WS_Q)[(size_t)tok * NQ + n]), a, 0.06f, 0.05f);
            else { const int ii = d - 128; const float ang = (float)pos * powf(10000.0f, -(float)ii / 32.0f); const float c_ = cosf(ang), s_ = sinf(ang);
                chk_fail(F, bf2f(WSP(bf16_t, WS_Q)[(size_t)tok * NQ + n]), a * c_ - a2 * s_, 0.06f, 0.05f); chk_fail(F, bf2f(WSP(bf16_t, WS_Q)[(size_t)tok * NQ + n + 32]), a2 * c_ + a * s_, 0.06f, 0.05f); } }
        const float* wk = F.in[9] + (size_t)l * KVLR * NKV; const float* gk = F.in[8] + l * KVLR;
        for (int n = tid; n < NKV; n += NTHREADS) { float a = 0.f; for (int k = 0; k < KVLR; ++k) a += bf2f(f2bf(cs[512 + k])) * rk * gk[k] * wk[(size_t)k * NKV + n];
            chk_fail(F, bf2f(WSP(bf16_t, WS_KV)[(size_t)tok * NKV + n]), a, 0.06f, 0.05f); }
        for (int c = tid; c < 1024; c += NTHREADS) WSP(bf16_t, WS_CHK_GATE)[(size_t)i * 1024 + c] = WSP(bf16_t, WS_MIX)[(size_t)tok * DM + DF + c];
        __syncthreads();
    }
}
__device__ __forceinline__ void chk_attn(const Frame& F) {
    const bf16_t* Q = WSP(bf16_t, WS_Q); const bf16_t* KV = WSP(bf16_t, WS_KV); const bf16_t* KR = WSP(bf16_t, WS_KR); const bf16_t* MIX = WSP(bf16_t, WS_MIX);
    LAS float* qs = (LAS float*)F.lds + F.wave * 192;
    for (int i = F.bx; i < 256; i += F.G) {
        const int tok = 64 * i + 37, b = tok >> 12, h = F.wave;
        for (int dh = 0; dh < 2; ++dh) {
            __builtin_amdgcn_wave_barrier(); asm volatile("" ::: "memory");
            for (int e = 0; e < 3; ++e) qs[F.lane + 64 * e] = bf2f(Q[(size_t)tok * NQ + h * DQK + F.lane + 64 * e]);
            asm volatile("s_waitcnt lgkmcnt(0)" ::: "memory"); __builtin_amdgcn_wave_barrier();
            float m = -1e30f, lsum = 0.f; float o[64];
#pragma unroll
            for (int d = 0; d < 64; ++d) o[d] = 0.f;
            for (int t = 0; t < 64; ++t) {
                const size_t key = (size_t)b * SEQ + F.lane + 64 * t; const bf16_t* kn = KV + key * NKV + h * 256; const bf16_t* kr = KR + key * 64;
                float s = 0.f;
#pragma unroll 2
                for (int c = 0; c < 16; ++c) { const bf16x8 kv = *(const bf16x8*)(kn + c * 8);
#pragma unroll
                    for (int e = 0; e < 8; ++e) s += qs[c * 8 + e] * bf2f((bf16_t)kv[e]); }
#pragma unroll 2
                for (int c = 0; c < 8; ++c) { const bf16x8 kv = *(const bf16x8*)(kr + c * 8);
#pragma unroll
                    for (int e = 0; e < 8; ++e) s += qs[128 + c * 8 + e] * bf2f((bf16_t)kv[e]); }
                s *= ATT_SCALE; const float mn = fmaxf(m, s), a = __expf(m - mn), p = __expf(s - mn); lsum = lsum * a + p; m = mn;
#pragma unroll
                for (int c = 0; c < 8; ++c) { const bf16x8 vv = *(const bf16x8*)(kn + 128 + dh * 64 + c * 8);
#pragma unroll
                    for (int e = 0; e < 8; ++e) o[c * 8 + e] = o[c * 8 + e] * a + p * bf2f((bf16_t)vv[e]); }
            }
            const float Mx = wave_max(m), f = __expf(m - Mx); const float Ls = wave_sum(lsum * f);
            float keep0 = 0.f;
#pragma unroll
            for (int d = 0; d < 64; ++d) { const float od = wave_sum(o[d] * f); if (F.lane == d) keep0 = od; }
            const int col = h * 128 + dh * 64 + F.lane;
            const float gz_ = bf2f(WSP(bf16_t, WS_CHK_GATE)[(size_t)i * 1024 + col]); const float ref = keep0 / Ls * (GATE_IN_EPI ? gz_ : gz_ / (1.0f + expf(-gz_)));
            chk_fail(F, bf2f(MIX[(size_t)tok * DM + DF + col]), ref, 1.5e-3f, 0.05f);
        }
    }
}
__device__ __forceinline__ void chk_finish(const Frame& F) {
    if (F.bx == 0 && F.tid == 0 && __hip_atomic_load(WSP(unsigned, WS_CHK_CNT), __ATOMIC_RELAXED, __HIP_MEMORY_SCOPE_AGENT) != 0u) { for (int k = 0; k < 64; ++k) F.out[k] = __builtin_nanf(""); }
}
#endif
#ifndef DIAG_ONLY
#define DIAG_ONLY -1
#endif
#define DIAG_EN(k) (DIAG_ONLY < 0 || DIAG_ONLY == (k))
#ifndef PROBE_CHECK
#define PROBE_CHECK 0
#endif
#ifndef XCD_REMAP
#define XCD_REMAP 0
#endif
#ifndef PROBE_CLK
#define PROBE_CLK 0
#endif
#ifndef PROBE_N
#define PROBE_N 1
#endif
#ifndef PROBE_VAR
#define PROBE_VAR 0
#endif
#ifndef PROBE_REP
#define PROBE_REP -1
#endif
struct Args { const float* in[14]; float* out; unsigned char* ws; int ph_lo, ph_hi; };
constexpr int N_PHASES = 2 + 5 * DEPTH;

template <class Epi, class Sched> __device__ __forceinline__ void run_gemm(const Frame& F, const pg8::Gemm& g, const Sched& S, const Epi& E) {
#if IMPL_GEMM
    pg8::gemm_phase<Epi, Sched, PG8_ALIGN, PG8_SP2>(F.lds, g, S, E, F.tid);
#else
    pg8::gemm_phase_naive<Epi, Sched>(g, S, E, F.tid);
#endif
}

#define PH_IN(k) (lo <= (k) && (k) < hi)
#ifndef PROBE_SKEW
#define PROBE_SKEW 0
#endif
#ifndef PROBE_SKEW_MASK
#define PROBE_SKEW_MASK 0xFFFu
#endif
#ifndef PROBE_SKEW_MUL
#define PROBE_SKEW_MUL 10
#endif
#if PROBE_SKEW
#define PH_STAMP(k) do { __syncthreads(); if (threadIdx.x == 0) __hip_atomic_store(WSP(unsigned long long, WS_END) + (k) * 256 + F.bx, (unsigned long long)__builtin_amdgcn_s_memrealtime(), __ATOMIC_RELAXED, __HIP_MEMORY_SCOPE_AGENT); } while (0)
#else
#define PH_STAMP(k) do {} while (0)
#endif
#define PH_SEAM(k) do { if (PH_IN(k) && PH_IN((k) + 1)) { PH_STAMP(k); xcd_barrier(bar); } } while (0)
#define PH_ENTER() do { int _t = threadIdx.x; asm volatile("" : "+v"(_t)); F.tid = _t; F.lane = _t & 63; } while (0)

#ifndef P0_DEFER
#define P0_DEFER 0
#endif
#ifndef ATT_STAG_SHIFT
#define ATT_STAG_SHIFT 3
#endif
#ifndef PHASE_STAG
#define PHASE_STAG 1
#endif
#ifndef MERGE_LN
#define MERGE_LN 0
#endif
static_assert(!(MERGE_LN && LN_DROP_R), "the merged region keeps the R stream: build it with -DLN_DROP_R=0");
template <int L> __device__ __forceinline__ void merged_region(Frame& F) {
    const int gi = F.vcu >> 3, m = F.vcu & 7, sA = 2 * gi, typ = gi & 1;
    unsigned* gc = WSP(unsigned, WS_CTL) + 4096 + (L * 32 + gi) * 16; unsigned tgt = 0u;
    const int npass = typ ? 1 : 2, per = typ ? 2 : 1;
    for (int p = 0; p < npass; ++p) {
        PH_ENTER();
        { pg8::Gemm g{WSP(bf16_t, WS_MIX), WSP(bf16_t, WS_WOUT) + (size_t)L * DM * DM, MTOK, DM, DM};
          pg8::GridOrder S{sA + p, per, m, 0, 1};
          EpiOut E{WSP(bf16_t, WS_H), WSP(float, WS_MOD) + (size_t)L * NB * (3 * DM) + 2 * DM};
          run_gemm(F, g, S, E); }
        tgt += 8u; grp_barrier(WSP(unsigned, WS_CTL), gc, tgt);
        PH_ENTER();
        const int r0 = (sA + p) * 256 + m * 32 * per;
        if (L + 1 < DEPTH) p_ln_post<true>(F, L, r0, r0 + 32 * per, 8); else p_ln_post<false>(F, L, r0, r0 + 32 * per, 8);
    }
    if (L + 1 < DEPTH) {
        tgt += 8u; grp_barrier(WSP(unsigned, WS_CTL), gc, tgt);
        PH_ENTER();
        pg8::Gemm g{WSP(bf16_t, WS_H), WSP(bf16_t, WS_WIN) + (size_t)(L + 1) * NINP * DM, MTOK, NINP, DM};
        pg8::GridOrder S{sA, 2, m, 8, 2};
        EpiIn E{WSP(bf16_t, WS_U), WSP(bf16_t, WS_MIX), WSP(bf16_t, WS_CQ), WSP(bf16_t, WS_CKV), WSP(bf16_t, WS_KR), WSP(float, WS_RSQ) + (size_t)(L + 1) * MTOK * 2, WSP(float, WS_RCOS), WSP(float, WS_RSIN)};
        run_gemm(F, g, S, E);
    }
}

template <int L> __device__ __forceinline__ void layer_phases(Frame& F, const int lo, const int hi, const XcdBarrier& bar) {
    constexpr int P = 2 + 5 * L;
    float* rsq = WSP(float, WS_RSQ) + (size_t)L * MTOK * 2;
    const bool mrg = MERGE_LN && (hi - lo == N_PHASES) && F.G == 256;
    const bool defer = P0_DEFER && (hi - lo == N_PHASES) && DEPTH == 2 && L == 0, work_first = (F.bx >> 3) & 1;
    if (PH_IN(P + 0) && DIAG_EN(2) && !(mrg && L > 0)) {
        PH_ENTER();
        pg8::Gemm g{WSP(bf16_t, WS_H), WSP(bf16_t, WS_WIN) + (size_t)L * NINP * DM, MTOK, NINP, DM};
        pg8::StaticOrder S; S.init(MTOK, NINP, F.G, F.bx);
        EpiIn E{WSP(bf16_t, WS_U), WSP(bf16_t, WS_MIX), WSP(bf16_t, WS_CQ), WSP(bf16_t, WS_CKV), WSP(bf16_t, WS_KR), rsq, WSP(float, WS_RCOS), WSP(float, WS_RSIN)};
        unsigned long long ct0 = 0, cr0 = 0;
        if (PROBE_CLK == 1 && L == 0) { ct0 = __builtin_amdgcn_s_memtime(); cr0 = __builtin_amdgcn_s_memrealtime(); }
        if (defer && work_first) { p0_weights(F, 848, 2 * 848); PH_ENTER(); }
        run_gemm(F, g, S, E);
        if (defer && !work_first) { PH_ENTER(); p0_weights(F, 848, 2 * 848); }
        if (PROBE_CLK == 1 && L == 0 && F.bx == 0) { const unsigned long long ct1 = __builtin_amdgcn_s_memtime(), cr1 = __builtin_amdgcn_s_memrealtime();
            const unsigned long long mhz = (ct1 - ct0) * 100ull / (cr1 - cr0); const unsigned long long tend = cr1 + mhz * 10ull;
            while (__builtin_amdgcn_s_memrealtime() < tend) __builtin_amdgcn_s_sleep(8); }
        if (PROBE_REP == 2 && L == 0) { xcd_barrier(bar); EpiIn E2 = E; E2.rsq = WSP(float, WS_R); run_gemm(F, g, S, E2); }
        if (PROBE_REP == 12 && L == 0) { xcd_barrier(bar); EpiNone E2; run_gemm(F, g, S, E2); }
        if (PROBE_REP == 22 && L == 0) { xcd_barrier(bar); EpiNone E2; pg8::HotOrder S2; S2.init(MTOK, NINP, F.G, F.bx); S2.pm0 = 3; S2.pn0 = 2; run_gemm(F, g, S2, E2); }
        if (PROBE_REP == 32 && L == 0) { xcd_barrier(bar); EpiNone E2; pg8::HotOrder S2; S2.init(MTOK, NINP, F.G, F.bx); S2.pm0 = F.bx & 63; S2.pn0 = 2; run_gemm(F, g, S2, E2); }
    }
    if (!(mrg && L > 0)) PH_SEAM(P + 0); else PH_STAMP(P + 0);
    if (PH_IN(P + 1) && DIAG_EN(3)) {
        PH_ENTER();
        const bool fft_first = PHASE_STAG && ((F.bx >> 3) & 1);
#if IMPL_FFT & 1
        if (fft_first) { fft1_fast(F, L); PH_ENTER(); }
#endif
        if (defer && fft_first) { p0_mod(F, 384, 2 * 384); p0_wcat(F, 1, 2); PH_ENTER(); }
        { pg8::Gemm g{WSP(bf16_t, WS_CQ), WSP(bf16_t, WS_WQ) + (size_t)L * NQ * QLR, MTOK, NQ, QLR};
          pg8::SplitOrder S; S.init(F.G, F.bx, NQ / 256, 0);
          EpiQ E{WSP(bf16_t, WS_Q), rsq, WSP(float, WS_RCOS), WSP(float, WS_RSIN)};
          run_gemm(F, g, S, E); }
        { pg8::Gemm g{WSP(bf16_t, WS_CKV), WSP(bf16_t, WS_WKV) + (size_t)L * NKV * KVLR, MTOK, NKV, KVLR};
          pg8::SplitOrder S; S.init(F.G, F.bx, NKV / 256, 1);
          EpiKV E{WSP(bf16_t, WS_KV), rsq};
          run_gemm(F, g, S, E); }
        if (PROBE_REP == 3 && L == 0) { xcd_barrier(bar);
          { pg8::Gemm g{WSP(bf16_t, WS_CQ), WSP(bf16_t, WS_WQ) + (size_t)L * NQ * QLR, MTOK, NQ, QLR}; pg8::SplitOrder S; S.init(F.G, F.bx, NQ / 256, 0); EpiQ E{WSP(bf16_t, WS_Q), rsq, WSP(float, WS_RCOS), WSP(float, WS_RSIN)}; run_gemm(F, g, S, E); }
          { pg8::Gemm g{WSP(bf16_t, WS_CKV), WSP(bf16_t, WS_WKV) + (size_t)L * NKV * KVLR, MTOK, NKV, KVLR}; pg8::SplitOrder S; S.init(F.G, F.bx, NKV / 256, 1); EpiKV E{WSP(bf16_t, WS_KV), rsq}; run_gemm(F, g, S, E); } }
#if IMPL_FFT & 1
        if (!fft_first) fft1_fast(F, L);
#else
        fft1_naive(F);
#endif
        if (defer && !fft_first) { PH_ENTER(); p0_mod(F, 384, 2 * 384); p0_wcat(F, 1, 2); }
        if (PROBE_REP == 7 && L == 0) { xcd_barrier(bar); fft1_fast(F, L); }
    }
    PH_SEAM(P + 1);
#if PROBE_CHECK
    if (L == PROBE_CHECK - 1 && PH_IN(P + 2)) { PH_ENTER(); chk_proj(F, L); __syncthreads(); }
#endif
    if (PH_IN(P + 2) && DIAG_EN(4)) {
        PH_ENTER();
#ifdef PROBE_IDLE
        if (L == 0) { const unsigned long long tend = __builtin_amdgcn_s_memrealtime() + (unsigned long long)PROBE_IDLE * 100ull; while (__builtin_amdgcn_s_memrealtime() < tend) __builtin_amdgcn_s_sleep(32); }
#endif
        const bool fft2_first = PHASE_STAG && ((F.bx >> ATT_STAG_SHIFT) & 1);
#if IMPL_FFT & 2
        if (fft2_first) { fft2_fast(F, L); PH_ENTER(); }
#endif
#if IMPL_ATTN
        unsigned long long at0 = 0, ar0 = 0;
        if (PROBE_CLK == 2 && L == 0) { at0 = __builtin_amdgcn_s_memtime(); ar0 = __builtin_amdgcn_s_memrealtime(); }
        attn_fast(F);
#if ATT_STAMP >= 0
        if (L == 0 && F.bx == 0 && F.tid == 0) { volatile LAS unsigned* mw = (volatile LAS unsigned*)(F.lds + MISC_OFF) + 16;
            const unsigned long long cyc = (unsigned long long)mw[ATT_STAMP] * 16ull / 124ull; const unsigned long long tend = __builtin_amdgcn_s_memrealtime() + cyc * 10ull;
            while (__builtin_amdgcn_s_memrealtime() < tend) __builtin_amdgcn_s_sleep(8); }
#endif
        if (PROBE_CLK == 2 && L == 0 && F.bx == 0) { const unsigned long long at1 = __builtin_amdgcn_s_memtime(), ar1 = __builtin_amdgcn_s_memrealtime();
            const unsigned long long mhz = (at1 - at0) * 100ull / (ar1 - ar0); const unsigned long long tend = ar1 + mhz * 10ull;
            while (__builtin_amdgcn_s_memrealtime() < tend) __builtin_amdgcn_s_sleep(8); }
        if (PROBE_REP == 4 && L == 0) { __syncthreads(); F.mix_off = WS_R; attn_fast<PROBE_VAR>(F); F.mix_off = WS_MIX; }
#else
        attn_naive(F);
#endif
        __syncthreads();
#if IMPL_FFT & 2
        if (!fft2_first) fft2_fast(F, L);
        if (PROBE_REP == 8 && L == 0) { __syncthreads(); F.mix_off = WS_R; fft2_fast(F, L); F.mix_off = WS_MIX; }
#else
        fft2_naive(F, L);
#endif
    }
    PH_SEAM(P + 2);
#if PROBE_CHECK
    if (L == PROBE_CHECK - 1 && PH_IN(P + 3)) { PH_ENTER(); chk_attn(F); __syncthreads(); }
#endif
    if (mrg) { PH_STAMP(P + 3); merged_region<L>(F); if (L + 1 < DEPTH) { PH_STAMP(P + 4); xcd_barrier(bar); } return; }
    if (PH_IN(P + 3) && DIAG_EN(5)) {
        PH_ENTER();
        pg8::Gemm g{WSP(bf16_t, WS_MIX), WSP(bf16_t, WS_WOUT) + (size_t)L * DM * DM, MTOK, DM, DM};
        pg8::StaticOrder S; S.init(MTOK, DM, F.G, F.bx);
        EpiOut E{(LN_DROP_R && L == 0) ? WSP(bf16_t, WS_R) : WSP(bf16_t, WS_H), WSP(float, WS_MOD) + (size_t)L * NB * (3 * DM) + 2 * DM};
        run_gemm(F, g, S, E);
        if (PROBE_REP == 5 && L == 0) { xcd_barrier(bar); run_gemm(F, g, S, E); }
        if (PROBE_REP == 15 && L == 0) { xcd_barrier(bar); EpiNone E2; run_gemm(F, g, S, E2); }
    }
    PH_SEAM(P + 3);
    if (PH_IN(P + 4) && DIAG_EN(6)) {
        PH_ENTER();
        int r0, r1; ln_rows(F, r0, r1); if (L + 1 < DEPTH) p_ln_post<true>(F, L, r0, r1, 8); else if (LN_DROP_R) p_ln_last(F, r0, r1, 8); else p_ln_post<false>(F, L, r0, r1, 8);
        if (PROBE_REP == 6 && L + 1 == DEPTH) { xcd_barrier(bar); for (int q = 0; q < PROBE_N; ++q) if (PROBE_VAR == 0 || ((F.bx >> 3) % (PROBE_VAR ? PROBE_VAR : 1)) == 0) { int q0, q1; ln_rows(F, q0, q1); p_ln_post<false>(F, L, q0, q1, 8); } }
    }
    PH_SEAM(P + 4);
}

__global__ void __launch_bounds__(NTHREADS, 2) fwd_kernel(Args args) {
    extern __shared__ __attribute__((aligned(16))) unsigned char lds[];
    Frame F;
    F.in[0] = args.in[0]; F.in[1] = args.in[1]; F.in[2] = args.in[2]; F.in[3] = args.in[3]; F.in[4] = args.in[4]; F.in[5] = args.in[5]; F.in[6] = args.in[6]; F.in[7] = args.in[7]; F.in[8] = args.in[8]; F.in[9] = args.in[9]; F.in[10] = args.in[10]; F.in[11] = args.in[11]; F.in[12] = args.in[12]; F.in[13] = args.in[13];
    F.out = args.out; F.ws = args.ws; F.lds = (LAS unsigned char*)lds; F.ldsg = (char*)lds;
    F.tid = threadIdx.x; F.lane = F.tid & 63; F.wave = __builtin_amdgcn_readfirstlane(F.tid >> 6); F.G = gridDim.x; F.bx = blockIdx.x;
    F.vcu = (F.G % 8 == 0) ? (F.bx % 8) * (F.G / 8) + F.bx / 8 : F.bx; F.mix_off = WS_MIX;
    volatile LAS unsigned* MISC = (volatile LAS unsigned*)(F.lds + MISC_OFF);
    if (F.tid < 64) MISC[F.tid] = 0u;
    __syncthreads();
    const int lo = args.ph_lo, hi = args.ph_hi;
    XcdBarrier bar; bar.bar = WSP(unsigned, WS_CTL); bar.x = 0; bar.st = MISC;
    if (hi - lo > 1) bar = xcd_barrier_post(WSP(unsigned, WS_CTL), MISC);
    const bool defer = P0_DEFER && (hi - lo == N_PHASES) && DEPTH == 2;
    if (PH_IN(0) && DIAG_EN(0)) { PH_ENTER(); const int nl = defer ? 1 : DEPTH; p0_weights(F, 0, nl * 848); p0_mod(F, 0, nl * 384); p0_tables(F); p0_wcat(F, 0, nl); }
    PH_SEAM(0);
#if XCD_REMAP
    if (PH_IN(0) && PH_IN(1) && MISC[3] == 1u) { const int rk = __builtin_amdgcn_readfirstlane((int)MISC[2]), xc = __builtin_amdgcn_readfirstlane((int)bar.x);
        if (rk < F.G / 8 && xc < 8) { F.bx = rk * 8 + xc; F.vcu = xc * (F.G / 8) + rk; } }
#endif
    if (PH_IN(1) && DIAG_EN(1)) { PH_ENTER(); int r0, r1; ln_rows(F, r0, r1); p_ln_first(F, r0, r1, 8); if (PROBE_REP == 1) { xcd_barrier(bar); p_ln_first(F, r0, r1, 8); } }
    PH_SEAM(1);
    if (PROBE_REP == 40) { for (int q = 0; q < 8; ++q) xcd_barrier(bar); }
    layer_phases<0>(F, lo, hi, bar);
    layer_phases<1>(F, lo, hi, bar);
#if PROBE_CHECK
    xcd_barrier(bar); chk_finish(F);
#endif
#if PROBE_SKEW
    PH_STAMP(N_PHASES - 1); xcd_barrier(bar);
    if (F.bx == 0 && F.tid < 64) {
        unsigned long long* stp = WSP(unsigned long long, WS_END);
        unsigned long long acc = 0, prevmx = 0;
        for (int k = 0; k < N_PHASES; ++k) {
            unsigned long long mx = 0, mn = ~0ull, sm = 0;
            for (int j = 0; j < 4; ++j) { const unsigned long long v = __hip_atomic_load(stp + k * 256 + F.tid * 4 + j, __ATOMIC_RELAXED, __HIP_MEMORY_SCOPE_AGENT); mx = v > mx ? v : mx; mn = v < mn ? v : mn; sm += v; }
            for (int o = 32; o > 0; o >>= 1) { const unsigned long long a = __shfl_xor(mx, o), b = __shfl_xor(mn, o), c = __shfl_xor(sm, o); mx = a > mx ? a : mx; mn = b < mn ? b : mn; sm += c; }
            if ((PROBE_SKEW_MASK >> k) & 1u) { if (PROBE_SKEW == 1) acc += mx - sm / 256ull; else if (PROBE_SKEW == 2) acc += mx - mn; else if (k > 0) acc += mx - prevmx; }
            prevmx = mx;
        }
        const unsigned long long tend = __builtin_amdgcn_s_memrealtime() + acc * (unsigned long long)PROBE_SKEW_MUL;
        while (__builtin_amdgcn_s_memrealtime() < tend) __builtin_amdgcn_s_sleep(8);
    }
#endif
}

extern "C" void kernel_launch(void* const* d_in, const int* in_sizes, int n_in, void* d_out, int out_size, void* d_ws, size_t ws_size, hipStream_t stream) {
    static int grid = 0;
    if (grid == 0) {
        if (n_in != 14 || in_sizes[0] != MTOK * DM || out_size != MTOK * DM || ws_size < WS_END) {
            fprintf(stderr, "kernel_launch: shape mismatch (n_in %d, in0 %d, out %d, ws %zu, need ws >= %zu); nothing launched\n", n_in, n_in > 0 ? in_sizes[0] : -1, out_size, ws_size, (size_t)WS_END); grid = -1; return; }
        int dev = 0, cus = 0, per_cu = 0;
        if (hipGetDevice(&dev) != hipSuccess || hipDeviceGetAttribute(&cus, hipDeviceAttributeMultiprocessorCount, dev) != hipSuccess) { grid = -1; return; }
        if (hipFuncSetAttribute((const void*)fwd_kernel, hipFuncAttributeMaxDynamicSharedMemorySize, LDS_BYTES) != hipSuccess) { fprintf(stderr, "kernel_launch: hipFuncSetAttribute failed\n"); grid = -1; return; }
        if (hipOccupancyMaxActiveBlocksPerMultiprocessor(&per_cu, (const void*)fwd_kernel, NTHREADS, LDS_BYTES) != hipSuccess || per_cu < 1) { fprintf(stderr, "kernel_launch: occupancy query failed (%d)\n", per_cu); (void)hipGetLastError(); per_cu = 1; }
        if (per_cu > 1) per_cu = 1;
        grid = cus * per_cu;
    }
    if (grid < 0) return;
    if (hipMemsetAsync((char*)d_ws + WS_CTL, 0, WS_RSQ - WS_CTL, stream) != hipSuccess) { fprintf(stderr, "kernel_launch: hipMemsetAsync failed\n"); return; }
    Args a{};
    for (int i = 0; i < 14; ++i) a.in[i] = (const float*)d_in[i];
    a.out = (float*)d_out; a.ws = (unsigned char*)d_ws;
#if N_LAUNCH_MODE
    a.ph_lo = 0; a.ph_hi = N_PHASES;
    hipLaunchKernelGGL(fwd_kernel, dim3(grid), dim3(NTHREADS), LDS_BYTES, stream, a);
#else
    for (int ph = 0; ph < N_PHASES; ++ph) { a.ph_lo = ph; a.ph_hi = ph + 1; hipLaunchKernelGGL(fwd_kernel, dim3(grid), dim3(NTHREADS), LDS_BYTES, stream, a); }
#endif
    const hipError_t le = hipPeekAtLastError();
    if (le != hipSuccess) fprintf(stderr, "kernel_launch: launch failed: %s (grid %d)\n", hipGetErrorName(le), grid);
}
```
